# Optimizing an MI355X kernel written in HIP

```python
import jax, jax.numpy as jnp
from jax import lax
import numpy as np

D_MODEL = 1024
BATCH = 4
SEQ = 4096
DEPTH = 2

GRID_W = 64
CTX_LEN = 256
HEAD_DIM = 64
ROPE_BASE = 10000.0
EPS = 1e-6
NEG = -1e30
A_Q_HEADS = D_MODEL // (2 * HEAD_DIM)
A_KV_HEADS = 2
WINDOW = 128
BLOCK = 128
B_DV = 128
B_DK = 64
B_HEADS = D_MODEL // (2 * B_DV)
GATE_RANK = 16
GATE_TAU = 16.0
GLA_CHUNK = 64
C_HEADS = D_MODEL // HEAD_DIM
NA_ROWS = 8
NA_COLS = 16
NA_QCOLS = 16
NA_KCOLS = 32
D_FF = -(-8 * D_MODEL // (3 * 256)) * 256

A_Q = A_Q_HEADS * HEAD_DIM
A_KV = A_KV_HEADS * HEAD_DIM
B_QK = B_HEADS * B_DK
B_V = B_HEADS * B_DV
AB_SIZES = (A_Q, A_KV, A_KV, B_QK, B_QK, B_V, B_V, GATE_RANK, GATE_RANK)
AB_SPLITS = [int(s) for s in np.cumsum(AB_SIZES)[:-1]]
AB_IN = int(sum(AB_SIZES))
AB_OUT = A_Q + B_V
N_EVEN = (DEPTH + 1) // 2
N_ODD = DEPTH // 2

kernel_name = "hybrid_window_gla_natten_dit_block"


def rms_norm(x, g):
    xf = x.astype(jnp.float32)
    y = xf * lax.rsqrt(jnp.mean(xf * xf, axis=-1, keepdims=True) + EPS)
    return (y * g.astype(jnp.float32)).astype(x.dtype)


def to_heads(t, n):
    b, s, _ = t.shape
    return t.reshape(b, s, n, -1).transpose(0, 2, 1, 3)


def from_heads(t):
    b, n, s, d = t.shape
    return t.transpose(0, 2, 1, 3).reshape(b, s, n * d)


def axial_angles(T):
    nf = HEAD_DIM // 4
    inv = ROPE_BASE ** (-jnp.arange(nf, dtype=jnp.float32) / nf)
    t = jnp.arange(T)
    row = (t // GRID_W).astype(jnp.float32)
    col = (t % GRID_W).astype(jnp.float32)
    return row[:, None] * inv[None, :], col[:, None] * inv[None, :]


def rope_2d(t, ang_r, ang_c):
    half = t.shape[-1] // 2
    def rot(u, ang):
        u1, u2 = jnp.split(u, 2, axis=-1)
        cos = jnp.cos(ang).astype(u.dtype)
        sin = jnp.sin(ang).astype(u.dtype)
        return jnp.concatenate([u1 * cos - u2 * sin, u2 * cos + u1 * sin], axis=-1)
    return jnp.concatenate([rot(t[..., :half], ang_r), rot(t[..., half:], ang_c)], axis=-1)


def window_attention(q, k, v, qc, kc, vc, sink, need_ctx):
    b, hq, T, dh = q.shape
    hkv = k.shape[1]
    g = hq // hkv
    nb = T // BLOCK
    scale = dh ** -0.5
    qb = q.reshape(b, hkv, g, nb, BLOCK, dh)

    def band(t):
        tp = jnp.pad(t, ((0, 0), (0, 0), (BLOCK, BLOCK), (0, 0))).reshape(b, hkv, nb + 2, BLOCK, dh)
        return jnp.concatenate([tp[:, :, :-2], tp[:, :, 1:-1], tp[:, :, 2:]], axis=3)

    kb, vb = band(k), band(v)
    s_loc = jnp.einsum('bhgnqd,bhnkd->bhgnqk', qb, kb).astype(jnp.float32) * scale
    qpos = jnp.arange(nb)[:, None] * BLOCK + jnp.arange(BLOCK)[None, :]
    kpos = (jnp.arange(nb)[:, None] - 1) * BLOCK + jnp.arange(3 * BLOCK)[None, :]
    valid = ((jnp.abs(qpos[:, :, None] - kpos[:, None, :]) <= WINDOW)
             & (kpos >= 0)[:, None, :] & (kpos < T)[:, None, :])
    s_loc = jnp.where(valid, s_loc, NEG)
    s_ctx = jnp.einsum('bhgnqd,bhld->bhgnql', qb, kc).astype(jnp.float32) * scale
    sink_f = sink.astype(jnp.float32).reshape(1, hkv, g, 1, 1, 1)
    sink_l = jnp.broadcast_to(sink_f, s_loc.shape[:-1] + (1,))
    p = jax.nn.softmax(jnp.concatenate([s_loc, s_ctx, sink_l], axis=-1), axis=-1)
    nk = 3 * BLOCK
    L = kc.shape[2]
    o = (jnp.einsum('bhgnqk,bhnkd->bhgnqd', p[..., :nk].astype(v.dtype), vb)
         + jnp.einsum('bhgnql,bhld->bhgnqd', p[..., nk:nk + L].astype(v.dtype), vc))
    o = o.reshape(b, hq, T, dh)
    oc = None
    if need_ctx:
        qcb = qc.reshape(b, hkv, g, L, dh)
        sc = jnp.einsum('bhgqd,bhkd->bhgqk', qcb, kc).astype(jnp.float32) * scale
        sink_c = jnp.broadcast_to(sink.astype(jnp.float32).reshape(1, hkv, g, 1, 1), sc.shape[:-1] + (1,))
        pc = jax.nn.softmax(jnp.concatenate([sc, sink_c], axis=-1), axis=-1)
        oc = jnp.einsum('bhgqk,bhkd->bhgqd', pc[..., :L].astype(vc.dtype), vc).reshape(b, hq, L, dh)
    return o, oc


def gla_chunked(q, k, v, log_a, s0):
    b, h, T, dk = q.shape
    dv = v.shape[-1]
    n = T // GLA_CHUNK
    r = lambda t: t.reshape(b, h, n, GLA_CHUNK, t.shape[-1])
    q, k, v, la = r(q), r(k), r(v), r(log_a)
    cum = jnp.cumsum(la, axis=3)
    cum_last = cum[:, :, :, -1:, :]
    qg = q * jnp.exp(cum)
    kg = k * jnp.exp(-cum)
    kd = k * jnp.exp(cum_last - cum)
    causal = jnp.tril(jnp.ones((GLA_CHUNK, GLA_CHUNK), dtype=bool))
    att = jnp.where(causal, jnp.einsum('bhncd,bhnsd->bhncs', qg, kg), 0.0)
    o = jnp.einsum('bhncs,bhnsv->bhncv', att, v)
    ds = jnp.einsum('bhncd,bhncv->bhndv', kd, v)
    decay = jnp.exp(cum_last[:, :, :, 0, :])

    def step(s, inp):
        dcy, d = inp
        return dcy[..., None] * s + d, s

    s_fin, s_in = lax.scan(step, s0, (jnp.moveaxis(decay, 2, 0), jnp.moveaxis(ds, 2, 0)))
    s_in = jnp.moveaxis(s_in, 0, 2)
    o = o + jnp.einsum('bhncd,bhndv->bhncv', qg, s_in)
    return o.reshape(b, h, T, dv), s_fin


def gla_final_state(k, v, log_a):
    cum = jnp.cumsum(log_a, axis=2)
    kd = k * jnp.exp(cum[:, :, -1:, :] - cum)
    return jnp.einsum('bhtd,bhtv->bhdv', kd, v)


def bidir_gla(q, k, v, lf, lb, qc, kc, vc, lfc, lbc, need_ctx):
    flip = lambda t: t[:, :, ::-1]
    b, h, _, dk = q.shape
    dv = v.shape[-1]
    oc = None
    if need_ctx:
        zero = jnp.zeros((b, h, dk, dv), jnp.float32)
        oc_f, sc_f = gla_chunked(qc, kc, vc, lfc, zero)
        oc_b, sc_b = gla_chunked(flip(qc), flip(kc), flip(vc), flip(lbc), zero)
        oc = oc_f + flip(oc_b)
    else:
        sc_f = gla_final_state(kc, vc, lfc)
        sc_b = gla_final_state(flip(kc), flip(vc), flip(lbc))
    o_f, _ = gla_chunked(q, k, v, lf, sc_f)
    o_b, _ = gla_chunked(flip(q), flip(k), flip(v), flip(lb), sc_b)
    return o_f + flip(o_b), oc


def parallel_window_gla(hl, hc, w_in, w_out, sink, gf_w, gf_b, gb_w, gb_b, norm_g, ang_r, ang_c, need_ctx):
    def project(h):
        aq, ak, av, bq, bk, bv, bo, rf, rb = jnp.split(h @ w_in, AB_SPLITS, axis=-1)
        log_f = jax.nn.log_sigmoid((rf @ gf_w + gf_b).astype(jnp.float32)) / GATE_TAU
        log_b = jax.nn.log_sigmoid((rb @ gb_w + gb_b).astype(jnp.float32)) / GATE_TAU
        a = (to_heads(aq, A_Q_HEADS), to_heads(ak, A_KV_HEADS), to_heads(av, A_KV_HEADS))
        g = (to_heads(bq, B_HEADS).astype(jnp.float32) * B_DK ** -0.5,
             to_heads(bk, B_HEADS).astype(jnp.float32),
             to_heads(bv, B_HEADS).astype(jnp.float32),
             to_heads(log_f, B_HEADS), to_heads(log_b, B_HEADS))
        return a, g, bo

    (aq, ak, av), (bq, bk, bv, lf, lb), bo = project(hl)
    (aqc, akc, avc), (bqc, bkc, bvc, lfc, lbc), boc = project(hc)
    aq = rope_2d(aq, ang_r, ang_c)
    ak = rope_2d(ak, ang_r, ang_c)
    oa, oac = window_attention(aq, ak, av, aqc, akc, avc, sink, need_ctx)
    ob, obc = bidir_gla(bq, bk, bv, lf, lb, bqc, bkc, bvc, lfc, lbc, need_ctx)

    def gla_out(o, og):
        o = o * lax.rsqrt(jnp.mean(o * o, axis=-1, keepdims=True) + EPS)
        o = o * norm_g.astype(jnp.float32).reshape(B_HEADS, 1, B_DV)
        return from_heads(o).astype(og.dtype) * jax.nn.silu(og)

    yl = jnp.concatenate([from_heads(oa), gla_out(ob, bo)], axis=-1) @ w_out
    yc = None
    if need_ctx:
        yc = jnp.concatenate([from_heads(oac), gla_out(obc, boc)], axis=-1) @ w_out
    return yl, yc


def neighbourhood_attention(q, k, v, kc, vc, rel_bias):
    b, h, T, dh = q.shape
    rows = T // GRID_W
    kh = min(NA_ROWS, rows)
    scale = dh ** -0.5
    n_seg = GRID_W // NA_QCOLS
    kg = k.reshape(b, h, rows, GRID_W, dh)
    vg = v.reshape(b, h, rows, GRID_W, dh)
    qcol = np.arange(GRID_W).reshape(n_seg, NA_QCOLS)
    cs = np.clip(qcol - NA_COLS // 2, 0, GRID_W - NA_COLS)
    seg_start = np.clip(np.arange(n_seg) * NA_QCOLS - NA_COLS // 2, 0, GRID_W - NA_KCOLS)
    keycol = seg_start[:, None] + np.arange(NA_KCOLS)[None, :]
    col_ok = (keycol[:, None, :] >= cs[:, :, None]) & (keycol[:, None, :] < cs[:, :, None] + NA_COLS)
    col_off = np.clip(keycol[:, None, :] - qcol[:, :, None] + NA_COLS - 1, 0, 2 * NA_COLS - 2)
    bias_cols = rel_bias.astype(jnp.float32)[:, :, col_off]
    col_ok = jnp.asarray(col_ok)[:, :, None, :]

    def row_block(args):
        r, q_row = args
        rs = jnp.clip(r - kh // 2, 0, rows - kh)
        k_seg = lax.dynamic_slice_in_dim(kg, rs, kh, axis=2)[:, :, :, keycol]
        v_seg = lax.dynamic_slice_in_dim(vg, rs, kh, axis=2)[:, :, :, keycol]
        q_seg = q_row.reshape(b, h, n_seg, NA_QCOLS, dh)
        s = jnp.einsum('bhjqd,bhrjkd->bhjqrk', q_seg, k_seg).astype(jnp.float32) * scale
        row_off = rs + jnp.arange(kh) - r + NA_ROWS - 1
        bias = bias_cols[:, row_off].transpose(0, 2, 3, 1, 4)
        s = jnp.where(col_ok, s + bias[None], NEG)
        s_loc = s.reshape(b, h, n_seg, NA_QCOLS, kh * NA_KCOLS)
        s_ctx = jnp.einsum('bhjqd,bhld->bhjql', q_seg, kc).astype(jnp.float32) * scale
        p = jax.nn.softmax(jnp.concatenate([s_loc, s_ctx], axis=-1), axis=-1)
        nloc = kh * NA_KCOLS
        p_loc = p[..., :nloc].reshape(b, h, n_seg, NA_QCOLS, kh, NA_KCOLS).astype(v.dtype)
        o = (jnp.einsum('bhjqrk,bhrjkd->bhjqd', p_loc, v_seg)
             + jnp.einsum('bhjql,bhld->bhjqd', p[..., nloc:].astype(vc.dtype), vc))
        return o.reshape(b, h, GRID_W, dh)

    q_rows = jnp.moveaxis(q.reshape(b, h, rows, GRID_W, dh), 2, 0)
    out = lax.map(row_block, (jnp.arange(rows), q_rows))
    return jnp.moveaxis(out, 0, 2).reshape(b, h, T, dh)


def neighbourhood_mixer(hl, hc, w_in, w_out, rel_bias, need_ctx):
    q, k, v = [to_heads(t, C_HEADS) for t in jnp.split(hl @ w_in, 3, axis=-1)]
    qc, kc, vc = [to_heads(t, C_HEADS) for t in jnp.split(hc @ w_in, 3, axis=-1)]
    yl = from_heads(neighbourhood_attention(q, k, v, kc, vc, rel_bias)) @ w_out
    yc = None
    if need_ctx:
        sc = jnp.einsum('bhqd,bhkd->bhqk', qc, kc).astype(jnp.float32) * HEAD_DIM ** -0.5
        pc = jax.nn.softmax(sc, axis=-1).astype(vc.dtype)
        yc = from_heads(jnp.einsum('bhqk,bhkd->bhqd', pc, vc)) @ w_out
    return yl, yc


def swiglu(h, w_in, w_out):
    g, u = jnp.split(h @ w_in, 2, axis=-1)
    return (jax.nn.silu(g) * u) @ w_out


def setup_inputs(seed: int = 0) -> dict:
    key = jax.random.key(seed)
    ks = jax.random.split(key, 24)
    f32 = jnp.float32
    nrm = lambda k, shape, fan_in: jax.random.normal(k, shape, f32) * fan_in ** -0.5
    gain = lambda k, shape: 1.0 + 0.02 * jax.random.normal(k, shape, f32)
    return {
        "x": jax.random.normal(ks[0], (BATCH, SEQ, D_MODEL), f32),
        "c": jax.random.normal(ks[1], (BATCH, D_MODEL), f32),
        "ctx": jax.random.normal(ks[2], (BATCH, CTX_LEN, D_MODEL), f32),
        "c_ctx": jax.random.normal(ks[3], (D_MODEL,), f32),
        "w_mod": 0.5 * nrm(ks[4], (DEPTH, D_MODEL, 6 * D_MODEL), D_MODEL),
        "b_mod": 0.02 * jax.random.normal(ks[5], (DEPTH, 6 * D_MODEL), f32),
        "g_mix_pre": gain(ks[6], (DEPTH, D_MODEL)),
        "g_mix_post": gain(ks[7], (DEPTH, D_MODEL)),
        "g_ffn_pre": gain(ks[8], (DEPTH, D_MODEL)),
        "g_ffn_post": gain(ks[9], (DEPTH, D_MODEL)),
        "w_ffn_in": nrm(ks[10], (DEPTH, D_MODEL, 2 * D_FF), D_MODEL),
        "w_ffn_out": nrm(ks[11], (DEPTH, D_FF, D_MODEL), D_FF),
        "ab_w_in": nrm(ks[12], (N_EVEN, D_MODEL, AB_IN), D_MODEL),
        "ab_w_out": nrm(ks[13], (N_EVEN, AB_OUT, D_MODEL), AB_OUT),
        "a_sink": jax.random.normal(ks[14], (N_EVEN, A_Q_HEADS), f32),
        "gla_gate_f_w": nrm(ks[15], (N_EVEN, GATE_RANK, B_QK), GATE_RANK),
        "gla_gate_f_b": 0.1 * jax.random.normal(ks[16], (N_EVEN, B_QK), f32),
        "gla_gate_b_w": nrm(ks[17], (N_EVEN, GATE_RANK, B_QK), GATE_RANK),
        "gla_gate_b_b": 0.1 * jax.random.normal(ks[18], (N_EVEN, B_QK), f32),
        "gla_norm_g": gain(ks[19], (N_EVEN, B_V)),
        "na_w_in": nrm(ks[20], (N_ODD, D_MODEL, 3 * D_MODEL), D_MODEL),
        "na_w_out": nrm(ks[21], (N_ODD, D_MODEL, D_MODEL), D_MODEL),
        "na_rel_bias": 0.1 * jax.random.normal(ks[22], (N_ODD, C_HEADS, 2 * NA_ROWS - 1, 2 * NA_COLS - 1), f32),
    }


def reference(x, c, ctx, c_ctx, w_mod, b_mod, g_mix_pre, g_mix_post, g_ffn_pre, g_ffn_post,
              w_ffn_in, w_ffn_out, ab_w_in, ab_w_out, a_sink, gla_gate_f_w, gla_gate_f_b,
              gla_gate_b_w, gla_gate_b_b, gla_norm_g, na_w_in, na_w_out, na_rel_bias):
    T = x.shape[1]
    ang_r, ang_c = axial_angles(T)
    xl, xc = x, ctx
    for i in range(DEPTH):
        need_ctx = i < DEPTH - 1
        ml = (jax.nn.silu(c) @ w_mod[i] + b_mod[i])[:, None, :]
        mc = jax.nn.silu(c_ctx) @ w_mod[i] + b_mod[i]
        sh1, sc1, gt1, sh2, sc2, gt2 = jnp.split(ml, 6, axis=-1)
        csh1, csc1, cgt1, csh2, csc2, cgt2 = jnp.split(mc, 6, axis=-1)
        hl = rms_norm(xl, g_mix_pre[i]) * (1.0 + sc1) + sh1
        hc = rms_norm(xc, g_mix_pre[i]) * (1.0 + csc1) + csh1
        if i % 2 == 0:
            j = i // 2
            yl, yc = parallel_window_gla(hl, hc, ab_w_in[j], ab_w_out[j], a_sink[j],
                                         gla_gate_f_w[j], gla_gate_f_b[j], gla_gate_b_w[j], gla_gate_b_b[j],
                                         gla_norm_g[j], ang_r, ang_c, need_ctx)
        else:
            j = i // 2
            yl, yc = neighbourhood_mixer(hl, hc, na_w_in[j], na_w_out[j], na_rel_bias[j], need_ctx)
        xl = xl + gt1 * rms_norm(yl, g_mix_post[i])
        fl = swiglu(rms_norm(xl, g_ffn_pre[i]) * (1.0 + sc2) + sh2, w_ffn_in[i], w_ffn_out[i])
        xl = xl + gt2 * rms_norm(fl, g_ffn_post[i])
        if need_ctx:
            xc = xc + cgt1 * rms_norm(yc, g_mix_post[i])
            fc = swiglu(rms_norm(xc, g_ffn_pre[i]) * (1.0 + csc2) + csh2, w_ffn_in[i], w_ffn_out[i])
            xc = xc + cgt2 * rms_norm(fc, g_ffn_post[i])
    return xl
```

```cpp
#include <hip/hip_runtime.h>
#include <hip/hip_cooperative_groups.h>
#include <cstdio>
#include <cstdint>
namespace cg = cooperative_groups;
namespace pg8 {
#define PG8_LAS __attribute__((address_space(3)))
typedef unsigned short bf16_t;
typedef short bf16x8 __attribute__((ext_vector_type(8)));
typedef float f32x4 __attribute__((ext_vector_type(4)));
typedef unsigned u32x4 __attribute__((ext_vector_type(4)));
constexpr int BM = 256, BK = 64, HALF = 128, HTB = HALF * BK * 2  , STAGE_BYTES = 8 * HTB, NXCD = 8, WGM = 8;

__host__ __device__ __forceinline__ int lds_byte(int r, int c) { const int st = (r >> 4) * 2 + (c >> 5), rr = r & 15, cc = c & 31, ob = rr * 64 + cc * 2; return st * 1024 + (ob ^ (((ob >> 9) & 1) << 5)); }
__host__ __device__ __forceinline__ void stage_rc(int b, int& R, int& C) { const int st = b / 1024, sb = b % 1024, swz = sb ^ (((sb >> 9) & 1) << 5); R = (st >> 1) * 16 + swz / 64; C = (st & 1) * 32 + (swz % 64) / 2; }
__host__ __device__ __forceinline__ int perm32(int rho) { const int n = rho >> 4, i = rho & 15; return 8 * (i >> 2) + 4 * n + (i & 3); }

struct Unit { int pm, pn; };
struct Gemm { const bf16_t* A; const bf16_t* Bt; int M, N, K; };

struct StaticOrder {
    int nM, nN, nwg, G, c;
    __host__ __device__ void init(int M, int N, int G_, int c_) { nM = M / BM; nN = N / BM; nwg = nM * nN; G = G_; c = c_; }
    __host__ __device__ bool next(int i, Unit& u) const {
        const long L = (long)i * G + c; if (L >= nwg) return false;
        int wgid = (int)L; { const int q = nwg / NXCD, r = nwg % NXCD, xcd = wgid % NXCD, off = wgid / NXCD; wgid = (xcd < r ? xcd * (q + 1) : r * (q + 1) + (xcd - r) * q) + off; }
        const int nig = WGM * nN, gid = wgid / nig, fm = gid * WGM, gsz = (nM - fm) < WGM ? (nM - fm) : WGM;
        u.pm = fm + ((wgid % nig) % gsz); u.pn = (wgid % nig) / gsz; return true;
    }
    __device__ __forceinline__ void a_ready(const Unit&) const {}
    __device__ __forceinline__ void done(const Unit&) const {}
};

__device__ __forceinline__ unsigned cvt_pk_bf16(float lo, float hi) { unsigned r; asm volatile("v_cvt_pk_bf16_f32 %0, %1, %2" : "=v"(r) : "v"(lo), "v"(hi)); return r; }
template <class Epi, class Sched, bool ALIGN_EPI = false, bool SP2 = false>
__device__ __forceinline__ void gemm_phase(PG8_LAS unsigned char* lds, const Gemm g, const Sched& S, const Epi& E) {
    const int tid = threadIdx.x, wid = __builtin_amdgcn_readfirstlane(tid >> 6), lane = tid & 63, wr = wid >> 2, wc = wid & 3, fr = lane & 15, fq = lane >> 4;
    const int K = g.K, nt = K / BK;
    unsigned voffA[2], voffB[2];
#pragma unroll
    for (int i = 0; i < 2; ++i) { int R, C; stage_rc(tid * 16 + i * 8192, R, C); const int Rb = Epi::PERM ? ((R & ~31) + perm32(R & 31)) : R;
        voffA[i] = (unsigned)(R * K + C) * 2u; voffB[i] = (unsigned)(Rb * K + C) * 2u; }
    const size_t kstep = (size_t)(BK * 2);
    const size_t hstep = (size_t)HALF * K * 2;
    const size_t tstep = 2 * hstep;
    const unsigned ldsw = (unsigned)wid * 1024u;
    const int aoff = lds_byte(wr * 64 + fr, fq * 8), boff = lds_byte(wc * 32 + fr, fq * 8);
#define PG8_SA(b, h) (((b) * 2 + (h)) * HTB)
#define PG8_SB(b, h) ((4 + (b) * 2 + (h)) * HTB)
#define PG8_STAGE(bufoff, gbase, voff) do { _Pragma("unroll") for (int _i = 0; _i < 2; ++_i) \
        __builtin_amdgcn_global_load_lds((const unsigned*)((const char*)(gbase) + (voff)[_i]), (PG8_LAS unsigned*)(lds + (bufoff) + ldsw + _i * 8192), 16, 0, 0); } while (0)
#define PG8_LDA(dst, b, h) do { _Pragma("unroll") for (int m = 0; m < 4; ++m) _Pragma("unroll") for (int k = 0; k < 2; ++k) dst[m][k] = *(const PG8_LAS bf16x8*)(lds + PG8_SA(b, h) + aoff + m * 2048 + k * 1024); } while (0)
#define PG8_LDB(dst, b, h) do { _Pragma("unroll") for (int n = 0; n < 2; ++n) _Pragma("unroll") for (int k = 0; k < 2; ++k) dst[n][k] = *(const PG8_LAS bf16x8*)(lds + PG8_SB(b, h) + boff + n * 2048 + k * 1024); } while (0)
#define PG8_MMA(ai, bj, At, Bt) do { __builtin_amdgcn_s_setprio(1); _Pragma("unroll") for (int m = 0; m < 4; ++m) _Pragma("unroll") for (int n = 0; n < 2; ++n) _Pragma("unroll") for (int k = 0; k < 2; ++k) \
        acc[ai][bj][m][n] = __builtin_amdgcn_mfma_f32_16x16x32_bf16(Bt[n][k], At[m][k], acc[ai][bj][m][n], 0, 0, 0); __builtin_amdgcn_s_setprio(0); } while (0)
#define PG8_WAIT_V(n) asm volatile("s_waitcnt vmcnt(" #n ")" ::: "memory")
#define PG8_WAIT_L(n) asm volatile("s_waitcnt lgkmcnt(" #n ")" ::: "memory")
#define PG8_BAR __builtin_amdgcn_s_barrier()
#define PG8_SCHED __builtin_amdgcn_sched_barrier(0)
    Unit cur, nxt; int ui = 0;
    if (!S.next(0, cur)) return;
    f32x4 acc[2][2][4][2];
#pragma unroll
    for (int a = 0; a < 2; ++a)
#pragma unroll
        for (int b = 0; b < 2; ++b)
#pragma unroll
            for (int m = 0; m < 4; ++m)
#pragma unroll
                for (int n = 0; n < 2; ++n) acc[a][b][m][n] = (f32x4){0.f, 0.f, 0.f, 0.f};
    bf16x8 At[4][2], B0[2][2], B1[2][2];
    const char* cA = (const char*)g.A + (size_t)cur.pm * tstep; const char* cB = (const char*)g.Bt + (size_t)cur.pn * tstep;
    S.a_ready(cur);
    if constexpr (SP2) {
        PG8_STAGE(PG8_SB(0, 0), cB, voffB); PG8_STAGE(PG8_SB(0, 1), cB + hstep, voffB); PG8_STAGE(PG8_SA(0, 0), cA, voffA); PG8_STAGE(PG8_SA(0, 1), cA + hstep, voffA);
        if (wr == 1) PG8_BAR;
        PG8_WAIT_V(2); PG8_BAR;
        PG8_STAGE(PG8_SB(1, 0), cB + kstep, voffB); PG8_STAGE(PG8_SA(1, 0), cA + kstep, voffA); PG8_STAGE(PG8_SB(1, 1), cB + hstep + kstep, voffB);
        PG8_WAIT_V(6); PG8_BAR;
    } else {
        PG8_STAGE(PG8_SB(0, 0), cB, voffB); PG8_STAGE(PG8_SA(0, 0), cA, voffA); PG8_STAGE(PG8_SB(0, 1), cB + hstep, voffB); PG8_STAGE(PG8_SA(0, 1), cA + hstep, voffA);
        if (wr == 1) PG8_BAR;
        PG8_WAIT_V(4); PG8_BAR;
        PG8_STAGE(PG8_SB(1, 0), cB + kstep, voffB); PG8_STAGE(PG8_SA(1, 0), cA + kstep, voffA); PG8_STAGE(PG8_SB(1, 1), cB + hstep + kstep, voffB);
        PG8_WAIT_V(6); PG8_BAR;
    }
    for (;;) {
        const bool has_next = S.next(ui + 1, nxt);
        const char* nA = has_next ? (const char*)g.A + (size_t)nxt.pm * tstep : cA; const char* nB = has_next ? (const char*)g.Bt + (size_t)nxt.pn * tstep : cB;
        for (int t = 0; t < nt; t += 2) {
            const bool last = (t == nt - 2);
            const char* a1 = cA + (size_t)(t + 1) * kstep;
            const char* a2 = last ? nA : cA + (size_t)(t + 2) * kstep; const char* b2 = last ? nB : cB + (size_t)(t + 2) * kstep;
            const char* a3 = a2 + kstep; const char* b3 = b2 + kstep;
            if (last && has_next) S.a_ready(nxt);
            if constexpr (SP2) {
            PG8_LDB(B0, 0, 0); PG8_LDB(B1, 0, 1); PG8_SCHED; PG8_LDA(At, 0, 0); PG8_STAGE(PG8_SA(1, 1), a1 + hstep, voffA);
            PG8_WAIT_V(8); PG8_WAIT_L(0); PG8_BAR; PG8_MMA(0, 0, At, B0); PG8_MMA(0, 1, At, B1); PG8_BAR; PG8_SCHED;
            PG8_LDA(At, 0, 1); PG8_STAGE(PG8_SB(0, 0), b2, voffB); PG8_STAGE(PG8_SB(0, 1), b2 + hstep, voffB); PG8_STAGE(PG8_SA(0, 0), a2, voffA);
            PG8_WAIT_V(8); PG8_WAIT_L(0); PG8_BAR; PG8_MMA(1, 0, At, B0); PG8_MMA(1, 1, At, B1); PG8_BAR; PG8_SCHED;
            PG8_LDB(B0, 1, 0); PG8_LDB(B1, 1, 1); PG8_SCHED; PG8_LDA(At, 1, 0); PG8_STAGE(PG8_SA(0, 1), a2 + hstep, voffA);
            PG8_WAIT_V(8); PG8_WAIT_L(0); PG8_BAR; PG8_MMA(0, 0, At, B0); PG8_MMA(0, 1, At, B1); PG8_BAR; PG8_SCHED;
            PG8_LDA(At, 1, 1); PG8_STAGE(PG8_SB(1, 0), b3, voffB); PG8_STAGE(PG8_SB(1, 1), b3 + hstep, voffB); PG8_STAGE(PG8_SA(1, 0), a3, voffA);
            PG8_WAIT_V(8); PG8_WAIT_L(0); PG8_BAR; PG8_MMA(1, 0, At, B0); PG8_MMA(1, 1, At, B1); PG8_BAR; PG8_SCHED;
            } else {
            PG8_LDB(B0, 0, 0); PG8_SCHED; PG8_LDA(At, 0, 0); PG8_STAGE(PG8_SA(1, 1), a1 + hstep, voffA);
            PG8_WAIT_L(8); PG8_BAR; PG8_WAIT_L(0); PG8_MMA(0, 0, At, B0); PG8_BAR; PG8_SCHED;
            PG8_LDB(B1, 0, 1); PG8_STAGE(PG8_SB(0, 0), b2, voffB);
            PG8_BAR; PG8_WAIT_L(0); PG8_MMA(0, 1, At, B1); PG8_BAR;
            PG8_LDA(At, 0, 1); PG8_STAGE(PG8_SA(0, 0), a2, voffA);
            PG8_BAR; PG8_WAIT_L(0); PG8_MMA(1, 0, At, B0); PG8_BAR; PG8_SCHED;
            PG8_STAGE(PG8_SB(0, 1), b2 + hstep, voffB);
            PG8_WAIT_V(6); PG8_BAR; PG8_MMA(1, 1, At, B1); PG8_BAR;
            PG8_LDB(B0, 1, 0); PG8_SCHED; PG8_LDA(At, 1, 0); PG8_STAGE(PG8_SA(0, 1), a2 + hstep, voffA);
            PG8_WAIT_L(8); PG8_BAR; PG8_WAIT_L(0); PG8_MMA(0, 0, At, B0); PG8_BAR; PG8_SCHED;
            PG8_LDB(B1, 1, 1); PG8_STAGE(PG8_SB(1, 0), b3, voffB);
            PG8_BAR; PG8_WAIT_L(0); PG8_MMA(0, 1, At, B1); PG8_BAR;
            PG8_LDA(At, 1, 1); PG8_STAGE(PG8_SA(1, 0), a3, voffA);
            PG8_BAR; PG8_WAIT_L(0); PG8_MMA(1, 0, At, B0); PG8_BAR; PG8_SCHED;
            PG8_STAGE(PG8_SB(1, 1), b3 + hstep, voffB);
            PG8_WAIT_V(6); PG8_BAR; PG8_MMA(1, 1, At, B1); PG8_BAR;
            }
        }
        if constexpr (ALIGN_EPI) { if (wr == 0) PG8_BAR; }
        if constexpr (!Epi::AFTER_DRAIN) { E(acc, cur, wr, wc, fr, fq); S.done(cur); }
        if (!has_next) break;
#pragma unroll
        for (int a = 0; a < 2; ++a)
#pragma unroll
            for (int b = 0; b < 2; ++b)
#pragma unroll
                for (int m = 0; m < 4; ++m)
#pragma unroll
                    for (int n = 0; n < 2; ++n) acc[a][b][m][n] = (f32x4){0.f, 0.f, 0.f, 0.f};
        cur = nxt; cA = nA; cB = nB; ++ui;
        if constexpr (ALIGN_EPI) { if (wr == 1) PG8_BAR; }
    }
    PG8_WAIT_V(0);
    if constexpr (!ALIGN_EPI) { if (wr == 0) PG8_BAR; }
    PG8_BAR;
    if constexpr (Epi::AFTER_DRAIN) { E.fused(acc, cur, wr, wc, fr, fq, lds, wid, lane); S.done(cur); }
#undef PG8_SA
#undef PG8_SB
#undef PG8_STAGE
#undef PG8_LDA
#undef PG8_LDB
#undef PG8_MMA
#undef PG8_WAIT_V
#undef PG8_WAIT_L
#undef PG8_BAR
#undef PG8_SCHED
}
}
__device__ const float ROPE_COS[1024] = {1.f,1.f,1.f,1.f,1.f,1.f,1.f,1.f,1.f,1.f,1.f,1.f,1.f,1.f,1.f,1.f,0.540302277f,0.846009135f,0.950415254f,0.98423022f,0.995004177f,0.998419285f,0.999500036f,0.999841869f,0.999949992f,0.999984205f,0.999994993f,0.999998391f,0.999999523f,0.999999821f,0.99999994f,1.f,-0.416146845f,0.431462824f,0.806578398f,0.937418282f,0.980066597f,0.993682086f,0.998000681f,0.999367595f,0.999800026f,0.999936759f,0.999979973f,0.999993682f,0.999997973f,0.999999344f,0.999999821f,0.99999994f,-0.989992499f,-0.115966164f,0.582753658f,0.861040652f,0.955336511f,0.985803485f,0.995503366f,0.998577297f,0.999550045f,0.999857724f,0.999954998f,0.999985754f,0.99999553f,0.999998569f,0.999999523f,0.999999881f,-0.653643608f,-0.627679706f,0.301137477f,0.757506192f,0.921060979f,0.974808276f,0.992010653f,0.997471273f,0.999200106f,0.999747038f,0.999920011f,0.999974728f,0.999992013f,0.999997497f,0.999999225f,0.999999762f,0.2836622f,-0.946079254f,-0.0103423381f,0.630080283f,0.87758255f,0.960731268f,0.987526f,0.996049762f,0.998750269f,0.999604762f,0.999875009f,0.999960482f,0.999987483f,0.999996066f,0.999998748f,0.999999583f,0.960170269f,-0.973103702f,-0.3207964f,0.482782036f,0.825335622f,0.943616986f,0.982053936f,0.9943133f,0.998200536f,0.999430835f,0.999819994f,0.999943078f,0.999981999f,0.999994338f,0.999998212f,0.999999404f,0.753902256f,-0.700429797f,-0.599437475f,0.320257008f,0.764842212f,0.923519433f,0.975599885f,0.992262423f,0.997551024f,0.999225318f,0.999755025f,0.999922514f,0.999975502f,0.999992251f,0.999997556f,0.999999225f,-0.145500034f,-0.212036446f,-0.818632424f,0.147631213f,0.696706712f,0.900502324f,0.968170285f,0.989897788f,0.996801734f,0.998988271f,0.999680042f,0.999898791f,0.999967992f,0.999989867f,0.999996781f,0.999998987f,-0.91113025f,0.341660261f,-0.956644177f,-0.0296507962f,0.621609926f,0.874638259f,0.959772646f,0.987220109f,0.995952725f,0.998719573f,0.999595046f,0.99987191f,0.999959528f,0.999987185f,0.999995947f,0.999998748f,-0.839071512f,0.790131867f,-0.999786079f,-0.205997631f,0.540302277f,0.846009135f,0.950415313f,0.98423022f,0.995004177f,0.998419285f,0.999500036f,0.999841869f,0.999949992f,0.999984205f,0.999994993f,0.999998391f,0.00442569796f,0.995257378f,-0.943779767f,-0.375847399f,0.453596085f,0.814705312f,0.940107584f,0.980929136f,0.993956089f,0.998087406f,0.999395072f,0.999808669f,0.999939501f,0.999980867f,0.99999392f,0.999998093f,0.843853951f,0.893861592f,-0.79417938f,-0.53384304f,0.362357706f,0.780825913f,0.92885989f,0.97731787f,0.99280864f,0.997723997f,0.999280095f,0.99977231f,0.999927998f,0.999977231f,0.999992788f,0.999997735f,0.907446802f,0.517172873f,-0.565820515f,-0.675001681f,0.267498761f,0.744477987f,0.916683376f,0.973397553f,0.99156189f,0.997329056f,0.999155104f,0.999732792f,0.999915481f,0.999973297f,0.999991536f,0.999997318f,0.136737213f,-0.0187961515f,-0.28134948f,-0.794870913f,0.16996716f,0.705776393f,0.903590262f,0.969169438f,0.990216017f,0.996902585f,0.999020159f,0.999690115f,0.99990201f,0.999969006f,0.999990225f,0.999996901f,-0.759687901f,-0.548975468f,0.0310223512f,-0.889670432f,0.070737198f,0.6648435f,0.889593601f,0.964634836f,0.988771081f,0.996444523f,0.998875201f,0.999644279f,0.999887526f,0.999964416f,0.999988735f,0.999996424f,-0.957659483f,-0.910081089f,0.340318173f,-0.95641005f,-0.0291995462f,0.621808827f,0.87470746f,0.959795177f,0.987227261f,0.99595499f,0.998720288f,0.999595284f,0.999872029f,0.999959528f,0.999987185f,0.999995947f,-0.275163352f,-0.990897954f,0.615864813f,-0.99298501f,-0.128844544f,0.576808274f,0.858946681f,0.954652011f,0.985584795f,0.995433986f,0.998555362f,0.999543071f,0.999855518f,0.999954283f,0.999985576f,0.99999541f,0.660316706f,-0.766536534f,0.830336154f,-0.998241663f,-0.227202162f,0.529984176f,0.842327058f,0.949207008f,0.983843684f,0.994881511f,0.998380423f,0.999487758f,0.999837995f,0.9999488f,0.999983788f,0.999994874f,0.988704622f,-0.306095392f,0.962463796f,-0.972014248f,-0.323289543f,0.481484592f,0.824865162f,0.943461835f,0.982004225f,0.994297504f,0.998195529f,0.999429286f,0.999819517f,0.999942899f,0.99998194f,0.999994278f,0.408082068f,0.248616725f,0.999144375f,-0.91512996f,-0.416146845f,0.431462824f,0.806578457f,0.937418282f,0.980066597f,0.993682086f,0.998000681f,0.999367595f,0.999800026f,0.999936759f,0.999979973f,0.999993682f,-0.547729254f,0.726760268f,0.936740458f,-0.829382956f,-0.504846215f,0.380077004f,0.787485182f,0.931078374f,0.97803092f,0.993035257f,0.99779582f,0.999302804f,0.999779522f,0.999930263f,0.999977946f,0.999993026f,-0.99996084f,0.981074572f,0.781440377f,-0.717477441f,-0.588501155f,0.327489585f,0.767604589f,0.92444396f,0.975897431f,0.992357016f,0.997581005f,0.999234855f,0.999758005f,0.999923468f,0.999975801f,0.999992371f,-0.53283304f,0.933235765f,0.548645258f,-0.582943261f,-0.666275978f,0.273866832f,0.746956408f,0.917517304f,0.97366637f,0.991647422f,0.997356176f,0.999163687f,0.999735534f,0.999916375f,0.999973536f,0.999991655f,0.424179018f,0.597977161f,0.261441678f,-0.430023283f,-0.737393796f,0.219378278f,0.725561321f,0.910300434f,0.971337974f,0.990906477f,0.997121394f,0.99908942f,0.99971199f,0.999908924f,0.999971211f,0.99999088f,0.991202831f,0.078552261f,-0.0516893305f,-0.263540596f,-0.801143587f,0.164196163f,0.703440726f,0.902795732f,0.968912423f,0.99013412f,0.996876657f,0.999011934f,0.999687493f,0.999901175f,0.999968767f,0.999990106f,0.64691931f,-0.465064496f,-0.359694332f,-0.0887455046f,-0.856888831f,0.108494945f,0.680616796f,0.895005584f,0.966389954f,0.98933053f,0.996621907f,0.998931348f,0.999662042f,0.999893129f,0.999966204f,0.999989331f,-0.292138815f,-0.865450621f,-0.632028639f,0.088848114f,-0.904072165f,0.0524506159f,0.6571123f,0.886932373f,0.963770926f,0.988495648f,0.996357203f,0.998847544f,0.999635518f,0.999884725f,0.999963522f,0.999988496f,-0.962605894f,-0.999293387f,-0.841684937f,0.26363951f,-0.942222297f,-0.00375941908f,0.632950664f,0.878578722f,0.961055458f,0.987629473f,0.996082544f,0.998760641f,0.99960804f,0.999876022f,0.99996078f,0.999987602f,-0.748057544f,-0.825371623f,-0.967871487f,0.430115849f,-0.970958173f,-0.0599575676f,0.608156204f,0.869947195f,0.958243906f,0.986732066f,0.995797932f,0.998670578f,0.999579549f,0.999867022f,0.999957979f,0.999986708f,0.154251456f,-0.397251874f,-0.998075247f,0.583026946f,-0.989992499f,-0.115966164f,0.582753658f,0.861040652f,0.955336511f,0.985803485f,0.995503366f,0.998577297f,0.999550045f,0.999857724f,0.999954998f,0.999985754f,0.914742351f,0.153215483f,-0.929300308f,0.717549205f,-0.999135137f,-0.171608135f,0.556768358f,0.851861775f,0.95233357f,0.984843671f,0.995198846f,0.998480916f,0.999519527f,0.999848068f,0.999951959f,0.999984801f,0.83422339f,0.656495154f,-0.768367112f,0.829440355f,-0.998294771f,-0.226707578f,0.53022635f,0.842413545f,0.949235439f,0.983852804f,0.994884372f,0.998381376f,0.999488056f,0.999838114f,0.9999488f,0.999983788f,-0.0132767474f,0.95758605f,-0.531235278f,0.915171385f,-0.987479806f,-0.281090319f,0.503154159f,0.832698941f,0.946042359f,0.982830763f,0.994559944f,0.998278618f,0.999455571f,0.999827802f,0.999945521f,0.999982774f,-0.848570287f,0.963757515f,-0.241421118f,0.972038329f,-0.966798186f,-0.334584385f,0.475578904f,0.822721004f,0.942754686f,0.981777668f,0.994225562f,0.99817276f,0.999422073f,0.999817252f,0.999942183f,0.999981701f,-0.903692186f,0.673110247f,0.0723346695f,0.998247743f,-0.93645668f,-0.387020677f,0.447528064f,0.812482953f,0.939372718f,0.980693519f,0.993881226f,0.998063743f,0.999387562f,0.999806345f,0.999938726f,0.999980628f,-0.127963692f,0.175156534f,0.378916174f,0.992972851f,-0.896758378f,-0.438233554f,0.419029742f,0.801987886f,0.935896814f,0.979578316f,0.993526995f,0.997951567f,0.999352098f,0.999795079f,0.99993521f,0.999979496f,0.765414059f,-0.376742303f,0.647921681f,0.95638001f,-0.848100007f,-0.488060862f,0.39011243f,0.791239262f,0.93232733f,0.978432178f,0.993162811f,0.997836173f,0.99931556f,0.999783576f,0.999931574f,0.999978364f,0.955073655f,-0.812611222f,0.852673113f,0.889623463f,-0.790967762f,-0.536345184f,0.360805035f,0.780240417f,0.928664625f,0.977255106f,0.992788672f,0.997717679f,0.999278069f,0.999771714f,0.999927819f,0.999977171f,0.266642928f,-0.998210371f,0.972865343f,0.794808388f,-0.72593224f,-0.582933903f,0.331136853f,0.768994927f,0.924909055f,0.976047099f,0.99240464f,0.997596025f,0.999239624f,0.999759495f,0.999923944f,0.999975979f,-0.666938066f,-0.87637943f,0.996578991f,0.674925625f,-0.653643608f,-0.627679706f,0.301137596f,0.757506192f,0.921060979f,0.974808276f,0.992010653f,0.997471273f,0.999200106f,0.999747038f,0.999920011f,0.999974728f,-0.987339258f,-0.484639406f,0.921462357f,0.533756077f,-0.574824035f,-0.670441091f,0.270837069f,0.745777905f,0.917120814f,0.973538578f,0.991606772f,0.997343302f,0.999159634f,0.999734223f,0.999915957f,0.999973416f,-0.399985313f,0.0563609414f,0.754965365f,0.375752151f,-0.490260571f,-0.711082935f,0.240265876f,0.733813822f,0.913088918f,0.972238123f,0.991192937f,0.997212172f,0.999118149f,0.99972111f,0.999911785f,0.999972105f,0.555113316f,0.580003142f,0.513598442f,0.205897167f,-0.400799006f,-0.749476731f,0.209454417f,0.721617639f,0.908965766f,0.970906913f,0.990769207f,0.997077882f,0.999075651f,0.999707639f,0.999907553f,0.999970794f,0.999843299f,0.925014675f,0.221298173f,0.0295478199f,-0.307332784f,-0.785501122f,0.178433523f,0.709193349f,0.904751658f,0.969545007f,0.990335584f,0.996940494f,0.99903214f,0.99969393f,0.999903202f,0.999969363f,0.52532196f,0.985138178f,-0.0929481089f,-0.147732988f,-0.210795805f,-0.819042206f,0.147234216f,0.696544766f,0.90044713f,0.968152404f,0.989892066f,0.996799886f,0.998987675f,0.999679863f,0.999898732f,0.999967992f,-0.432177931f,0.741858006f,-0.397976756f,-0.320354372f,-0.112152621f,-0.849993885f,0.115887694f,0.683675885f,0.89605248f,0.966729224f,0.989438653f,0.996656179f,0.998942196f,0.999665439f,0.999894202f,0.999966562f,-0.992335498f,0.270098448f,-0.663538277f,-0.48287195f,-0.0123883775f,-0.878258407f,0.0844252855f,0.670590878f,0.891568303f,0.965275466f,0.988975346f,0.996509314f,0.998895705f,0.999650776f,0.999889553f,0.999965072f,-0.640144348f,-0.284846604f,-0.863296509f,-0.630159974f,0.0874991715f,-0.903746367f,0.0528784581f,0.657293737f,0.886994898f,0.963791192f,0.988502085f,0.996359289f,0.9988482f,0.999635756f,0.999884784f,0.999963582f,0.300592542f,-0.75206399f,-0.977442741f,-0.757573068f,0.18651247f,-0.926377118f,0.0212787576f,0.643788815f,0.882332861f,0.962276459f,0.98801899f,0.996206105f,0.998799741f,0.999620378f,0.999879956f,0.999962032f,0.964965999f,-0.987659097f,-0.994656444f,-0.861092687f,0.2836622f,-0.946079254f,-0.0103422189f,0.630080283f,0.87758255f,0.960731268f,0.987526f,0.996049762f,0.998750269f,0.999604762f,0.999875009f,0.999960482f,0.742154181f,-0.919073522f,-0.913230121f,-0.937454224f,0.377977669f,-0.96279037f,-0.0419528559f,0.616172493f,0.872744501f,0.959155679f,0.987023175f,0.99589026f,0.998699784f,0.999588788f,0.999869943f,0.999958873f,-0.162990779f,-0.567430019f,-0.741239965f,-0.984248459f,0.468516916f,-0.976457715f,-0.0735215396f,0.602069914f,0.86781919f,0.95754981f,0.986510456f,0.995727658f,0.998648286f,0.999572515f,0.999864817f,0.999957263f,-0.918282807f,-0.0410281904f,-0.495741814f,-1.f,0.554374516f,-0.987038016f,-0.105016708f,0.587776959f,0.862807095f,0.955913603f,0.985987842f,0.995561838f,0.998595834f,0.999555886f,0.999859571f,0.999955595f,-0.829309821f,0.498009592f,-0.201079622f,-0.984212041f,0.634692967f,-0.994497895f,-0.136406869f,0.573298037f,0.857708693f,0.954247177f,0.985455394f,0.995392919f,0.998542368f,0.999538958f,0.999854207f,0.999953866f,0.0221267566f,0.883669317f,0.113521777f,-0.937382519f,0.708669782f,-0.998813629f,-0.167660639f,0.558637917f,0.852524519f,0.95255059f,0.984913111f,0.99522084f,0.99848789f,0.999521732f,0.999848783f,0.999952197f,0.853220105f,0.997174621f,0.416867077f,-0.860988438f,0.775565803f,-0.999971747f,-0.198746875f,0.543801069f,0.847255111f,0.950823903f,0.984360933f,0.995045662f,0.998432398f,0.999504209f,0.99984318f,0.999950409f,0.899866819f,0.803569078f,0.678870201f,-0.757439196f,0.834712923f,-0.997968495f,-0.22963427f,0.528792322f,0.841901004f,0.949067116f,0.983798921f,0.994867265f,0.998375952f,0.999486327f,0.999837577f,0.999948621f,0.119180135f,0.362476677f,0.873550534f,-0.63000071f,0.885519624f,-0.99281019f,-0.260292053f,0.513616323f,0.836462677f,0.947280347f,0.983227074f,0.994685769f,0.998318493f,0.999468148f,0.999831796f,0.999946833f,-0.771080196f,-0.1902491f,0.981602073f,-0.482692331f,0.927478492f,-0.984513164f,-0.290689558f,0.498277903f,0.830940723f,0.945463598f,0.982645452f,0.994501114f,0.998260021f,0.99944967f,0.999825954f,0.999944985f,-0.952412963f,-0.684381902f,0.992308319f,-0.320159167f,0.960170269f,-0.973103702f,-0.3207964f,0.482782036f,0.825335622f,0.943616986f,0.982053936f,0.9943133f,0.998200536f,0.999430835f,0.999819994f,0.999943078f,-0.258101642f,-0.967739642f,0.904607594f,-0.1475292f,0.98326844f,-0.958617806f,-0.350582451f,0.467133403f,0.819648027f,0.941740453f,0.981452644f,0.994122326f,0.998140097f,0.999411702f,0.999813974f,0.99994117f,0.673507154f,-0.953050017f,0.727198064f,0.0297537707f,0.996542096f,-0.941101313f,-0.380017966f,0.451337039f,0.813878477f,0.939834237f,0.980841517f,0.993928254f,0.998078644f,0.999392271f,0.999807835f,0.999939203f,0.985896587f,-0.644837022f,0.477671444f,0.206098333f,0.999858618f,-0.920609534f,-0.409073502f,0.435397953f,0.808027506f,0.937898219f,0.980220556f,0.993731022f,0.998016179f,0.999372482f,0.999801576f,0.999937236f};
__device__ const float ROPE_SIN[1024] = {0.f,0.f,0.f,0.f,0.f,0.f,0.f,0.f,0.f,0.f,0.f,0.f,0.f,0.f,0.f,0.f,0.841470957f,0.533168435f,0.310983598f,0.176892191f,0.0998334214f,0.0562044978f,0.0316175036f,0.0177818574f,0.00999983307f,0.00562338345f,0.00316227227f,0.0017782785f,0.000999999931f,0.000562341243f,0.000316227757f,0.00017782794f,0.909297407f,0.902130723f,0.591127098f,0.348205268f,0.198669329f,0.112231314f,0.0632033944f,0.0355580896f,0.0199986659f,0.011246589f,0.00632451288f,0.00355655141f,0.0019999987f,0.00112468237f,0.000632455456f,0.00035565588f,0.141120002f,0.993253171f,0.812648892f,0.5085361f,0.295520216f,0.167903304f,0.0947260857f,0.0533230826f,0.0299954992f,0.0168694388f,0.00948669016f,0.00533481315f,0.0029999956f,0.00168702309f,0.000948683126f,0.000533483806f,-0.756802499f,0.778471708f,0.953580737f,0.652827978f,0.389418334f,0.223044485f,0.126154065f,0.0710712075f,0.0399893336f,0.0224917568f,0.0126487734f,0.00711305765f,0.00399998948f,0.00224936334f,0.00126491068f,0.000711311703f,-0.958924294f,0.32393527f,0.999946535f,0.776529968f,0.47942555f,0.277480543f,0.157455876f,0.0887968615f,0.0499791652f,0.0281133614f,0.0158107281f,0.00889127981f,0.0049999794f,0.0028117029f,0.00158113812f,0.000889139599f,-0.279415488f,-0.230367512f,0.947148204f,0.875740528f,0.564642489f,0.33103931f,0.188600272f,0.106494442f,0.0599640049f,0.0337340795f,0.0189725272f,0.0106694745f,0.0059999642f,0.00337404152f,0.00189736532f,0.00106696738f,0.656986594f,-0.713721275f,0.800421596f,0.947330713f,0.64421767f,0.383551568f,0.219556093f,0.124158338f,0.0699428469f,0.0393537246f,0.0221341345f,0.0124476347f,0.00699994294f,0.00393637875f,0.00221359241f,0.00124479528f,0.989358246f,-0.977261782f,0.574317753f,0.989042461f,0.717356086f,0.434851229f,0.250292331f,0.141782969f,0.0799146891f,0.0449721329f,0.0252955221f,0.0142257558f,0.0079999147f,0.00449871505f,0.00252981926f,0.00142262306f,0.412118495f,-0.939823508f,0.291259229f,0.999560297f,0.783326924f,0.484776139f,0.280778319f,0.159362778f,0.0898785442f,0.0505891182f,0.0284566563f,0.0160038304f,0.00899987947f,0.00506105041f,0.00284604589f,0.00160045072f,-0.54402113f,-0.612936914f,-0.0206835698f,0.978552461f,0.841470957f,0.533168435f,0.310983568f,0.176892191f,0.099833414f,0.0562044978f,0.0316175036f,0.0177818574f,0.009999834f,0.00562338345f,0.00316227227f,0.0017782785f,-0.999990225f,-0.0972764567f,-0.33057496f,0.926681578f,0.891207397f,0.579875171f,0.340877861f,0.19436565f,0.1097783f,0.0618181042f,0.0347780399f,0.0195598267f,0.0109997792f,0.00618571462f,0.00347849843f,0.00195610616f,-0.536572933f,0.448342979f,-0.60768342f,0.845583618f,0.932039082f,0.624748647f,0.370431304f,0.211777672f,0.119712204f,0.0674297586f,0.0379382223f,0.0213377345f,0.0119997123f,0.0067480444f,0.00379472389f,0.00213393359f,0.420167029f,0.855880976f,-0.824528456f,0.737816215f,0.963558197f,0.667647004f,0.399614304f,0.229122713f,0.129634142f,0.0730392784f,0.0410980321f,0.0231155735f,0.0129996343f,0.00731037185f,0.00411094911f,0.00231176103f,0.990607381f,0.999823332f,-0.959605396f,0.606778562f,0.985449731f,0.708434701f,0.428397775f,0.246395305f,0.139543116f,0.078646481f,0.0442574248f,0.0248933397f,0.0139995432f,0.00787269697f,0.00442717411f,0.00248958869f,0.650287867f,0.835838437f,-0.999518692f,0.456603259f,0.997494996f,0.746982634f,0.456752867f,0.263589978f,0.149438128f,0.0842512026f,0.0474163815f,0.0266710296f,0.0149994381f,0.00843502022f,0.00474339863f,0.00266741589f,-0.287903309f,0.414430231f,-0.940310359f,0.292027086f,0.999573588f,0.783169091f,0.484651238f,0.280701309f,0.159318209f,0.0898532644f,0.0505748577f,0.028448632f,0.015999319f,0.00899733976f,0.00505962269f,0.00284524332f,-0.961397469f,-0.134615138f,-0.78785187f,0.11824052f,0.991664827f,0.81687957f,0.512064993f,0.29772386f,0.169182345f,0.09545248f,0.0537328273f,0.0302261449f,0.0169991814f,0.00955965649f,0.00537584582f,0.00302307028f,-0.750987232f,-0.642200708f,-0.557262897f,-0.0592755191f,0.973847628f,0.84800756f,0.538966715f,0.314652264f,0.179029569f,0.101048686f,0.0568902642f,0.0320035629f,0.0179990288f,0.0101219704f,0.00569206895f,0.00320089748f,0.149877205f,-0.952000856f,-0.271410108f,-0.234921798f,0.946300089f,0.876454532f,0.565329552f,0.331481189f,0.188858896f,0.10664168f,0.060047131f,0.0337808803f,0.0189988576f,0.0106842816f,0.00600829115f,0.00337872445f,0.912945271f,-0.968601942f,0.0413582884f,-0.403158993f,0.909297407f,0.902130723f,0.591127038f,0.348205268f,0.198669314f,0.112231314f,0.0632033944f,0.0355580896f,0.0199986678f,0.011246589f,0.00632451288f,0.00355655141f,0.836655617f,-0.686891198f,0.35002476f,-0.558680534f,0.863209307f,0.924954832f,0.616333544f,0.364819258f,0.208459899f,0.117817394f,0.0663590282f,0.0373351872f,0.0209984574f,0.0118088927f,0.00664073415f,0.00373437814f,-0.00885130931f,-0.193630233f,0.623979926f,-0.696581721f,0.808496356f,0.944854796f,0.640923738f,0.381317884f,0.218229622f,0.123399742f,0.0695140064f,0.0391121693f,0.0219982266f,0.0123711927f,0.00695695449f,0.00391220488f,-0.846220434f,0.359264523f,0.836055279f,-0.812512875f,0.745705247f,0.961767614f,0.664873064f,0.397695929f,0.227977514f,0.128978193f,0.0726682767f,0.0408890247f,0.0229979735f,0.0129334899f,0.00727317436f,0.00409003161f,-0.905578375f,0.801513135f,0.965219259f,-0.902817786f,0.67546314f,0.97563988f,0.688157499f,0.413948208f,0.237702623f,0.134552568f,0.0758218244f,0.0426657498f,0.0239976961f,0.0134957815f,0.0075893933f,0.00426785741f,-0.132351756f,0.996909976f,0.998663187f,-0.964648306f,0.598472118f,0.986427724f,0.710753918f,0.430069596f,0.247403964f,0.140122697f,0.0789746121f,0.0444423407f,0.0249973964f,0.0140580693f,0.00790561177f,0.00444568414f,0.76255846f,0.885276794f,0.933070183f,-0.996054351f,0.515501261f,0.994096994f,0.732639611f,0.446054995f,0.257080555f,0.145688385f,0.0821266174f,0.0462187938f,0.0259970706f,0.0146203535f,0.00822182931f,0.00462350994f,0.956375957f,0.500994205f,0.774945021f,-0.996045172f,0.427379847f,0.99862349f,0.753792703f,0.46189931f,0.266731411f,0.151249468f,0.0852777958f,0.0479951017f,0.0269967206f,0.015182632f,0.00853804592f,0.00480133574f,0.270905793f,-0.0375856608f,0.539968967f,-0.964621305f,0.334988207f,0.999992907f,0.774192095f,0.477597594f,0.276355654f,0.156805754f,0.0884281173f,0.049771253f,0.0279963426f,0.0157449059f,0.0088542616f,0.00497916201f,-0.663633883f,-0.564589798f,0.251445323f,-0.902773678f,0.239249229f,0.998200953f,0.793817401f,0.49314484f,0.28595221f,0.162357092f,0.0915775672f,0.0515472479f,0.0289959367f,0.0163071752f,0.00917047635f,0.00515698735f,-0.988031626f,-0.917709649f,-0.0620148405f,-0.812452853f,0.141120002f,0.993253171f,0.812648892f,0.5085361f,0.295520186f,0.167903304f,0.0947260931f,0.0533230826f,0.029995501f,0.0168694388f,0.00948669016f,0.00533481315f,-0.404037654f,-0.988192797f,-0.369325012f,-0.696507812f,0.0415805206f,0.985165298f,0.830667794f,0.523766637f,0.305058628f,0.173444211f,0.0978736654f,0.055098746f,0.0309950355f,0.0174316969f,0.00980290305f,0.00551263802f,0.551426709f,-0.754330218f,-0.640009403f,-0.5585953f,-0.0583741926f,0.973962843f,0.847856104f,0.538831532f,0.314566553f,0.17897962f,0.101020269f,0.0568742342f,0.0319945402f,0.0179939512f,0.0101191159f,0.00569046335f,0.999911845f,-0.28814739f,-0.847224355f,-0.403064936f,-0.157745644f,0.959681332f,0.864196658f,0.553726017f,0.324043006f,0.184509367f,0.10416586f,0.0586495437f,0.0329940096f,0.0185561981f,0.010435327f,0.00586828869f,0.529082716f,0.266779721f,-0.97042042f,-0.234822124f,-0.255541205f,0.942365825f,0.879673064f,0.568445385f,0.333487093f,0.190033287f,0.107310407f,0.0604246669f,0.0339934528f,0.0191184394f,0.010751537f,0.00604611309f,-0.428182662f,0.739542127f,-0.997380435f,-0.0591726787f,-0.350783229f,0.92207104f,0.894269884f,0.582984984f,0.342897803f,0.195551202f,0.110453881f,0.0621996038f,0.034992855f,0.0196806751f,0.0110677453f,0.00622393796f,-0.991778851f,0.984540582f,-0.925431013f,0.118342586f,-0.442520559f,0.89886117f,0.907972515f,0.597340286f,0.352274209f,0.201062918f,0.113596253f,0.0639743358f,0.0359922275f,0.0202429052f,0.0113839535f,0.0064017619f,-0.643538117f,0.926318109f,-0.761706948f,0.292125374f,-0.529836178f,0.872809589f,0.920767248f,0.611506701f,0.361615449f,0.206568271f,0.116737492f,0.0657488778f,0.036991559f,0.0208051261f,0.0117001599f,0.0065795863f,0.296368569f,0.58280617f,-0.522444785f,0.456694692f,-0.611857831f,0.84399873f,0.932641268f,0.625479698f,0.370920479f,0.212067112f,0.119877554f,0.0675232038f,0.0379908569f,0.0213673431f,0.0120163653f,0.00675741071f,0.963795364f,0.0598003156f,-0.231372014f,0.606860459f,-0.687766254f,0.81251961f,0.943582714f,0.639254928f,0.380188406f,0.217559248f,0.123016424f,0.0692973137f,0.0389901139f,0.0219295528f,0.0123325698f,0.00693523418f,0.745113134f,-0.481621295f,0.0826458037f,0.737885714f,-0.756802499f,0.778471708f,0.953580678f,0.652827978f,0.389418334f,0.223044485f,0.126154065f,0.0710712075f,0.0399893373f,0.0224917568f,0.0126487734f,0.00711305765f,-0.158622667f,-0.874714017f,0.388467699f,0.845638454f,-0.818277061f,0.74196279f,0.962625206f,0.666194677f,0.39860931f,0.228522688f,0.129290432f,0.0728448778f,0.0409885161f,0.0230539497f,0.0129649751f,0.00729088066f,-0.916521549f,-0.998410463f,0.655764699f,0.926720202f,-0.871575892f,0.703108132f,0.970707119f,0.679350674f,0.407760441f,0.233993664f,0.132425532f,0.0746183172f,0.0419876575f,0.0236161388f,0.0132811759f,0.00746870413f,-0.831774771f,-0.814614236f,0.858030677f,0.97857362f,-0.916166008f,0.662030637f,0.977818429f,0.692291796f,0.416870773f,0.23945722f,0.135559291f,0.0763915181f,0.0429867506f,0.0241783205f,0.0135973748f,0.00764652714f,0.0177019257f,-0.37993139f,0.975206196f,0.999563396f,-0.951602101f,0.618860185f,0.983951986f,0.70501405f,0.425939471f,0.244913206f,0.138691694f,0.0781644881f,0.0439858064f,0.0247404929f,0.0139135728f,0.00782434922f,0.850903511f,0.171763569f,0.995670974f,0.989027262f,-0.977530122f,0.57373327f,0.989101648f,0.717513323f,0.434965521f,0.250361472f,0.141822711f,0.0799371973f,0.0449848175f,0.0253026579f,0.0142297689f,0.00800217129f,0.901788354f,0.670557022f,0.917395473f,0.947297752f,-0.993690968f,0.526792526f,0.993262351f,0.72978574f,0.44394809f,0.255801797f,0.144952312f,0.0817096606f,0.0459837839f,0.0258648153f,0.0145459641f,0.0081799943f,0.123573124f,0.962832689f,0.748142362f,0.875690997f,-0.999923289f,0.478186339f,0.996429801f,0.741827428f,0.452886283f,0.261234075f,0.148080453f,0.0834818557f,0.0469827019f,0.0264269635f,0.0148621574f,0.00835781638f,-0.768254638f,0.958573103f,0.504697084f,0.776465356f,-0.99616462f,0.428068399f,0.99860096f,0.753634512f,0.461779177f,0.266658038f,0.151207119f,0.0852537975f,0.0479815714f,0.0269891042f,0.0151783489f,0.00853563752f,-0.953752637f,0.659090102f,0.211200655f,0.652750373f,-0.982452571f,0.376597136f,0.999773562f,0.765203178f,0.470625877f,0.272073567f,0.15433228f,0.087025471f,0.0489803962f,0.0275512375f,0.0154945394f,0.0087134596f,-0.262374848f,0.156619072f,-0.10324046f,0.508447945f,-0.958924294f,0.32393527f,0.999946535f,0.776529968f,0.47942555f,0.277480543f,0.157455891f,0.0887968615f,0.0499791689f,0.0281133596f,0.0158107281f,0.00889127981f,0.670229197f,-0.394086063f,-0.407444149f,0.3481085f,-0.925814748f,0.270249337f,0.99911958f,0.787611187f,0.48817724f,0.282878697f,0.160577938f,0.0905679762f,0.0509778969f,0.0286754742f,0.0161269177f,0.00906910095f,0.986627579f,-0.823421597f,-0.671240151f,0.176790684f,-0.883454502f,0.215709001f,0.997293651f,0.798443377f,0.496880114f,0.28826794f,0.163698375f,0.0923388004f,0.051976569f,0.0292375814f,0.0164431017f,0.00924692024f,0.395925164f,-0.999157965f,-0.868469954f,-0.000103020677f,-0.832267344f,0.160486728f,0.994470477f,0.809023023f,0.505533338f,0.293648034f,0.166817173f,0.0941093415f,0.0529751927f,0.0297996756f,0.0167592876f,0.00942474138f,-0.558789074f,-0.867171526f,-0.979574919f,-0.176993474f,-0.772764444f,0.104756832f,0.990652919f,0.819346905f,0.514135957f,0.29901889f,0.169934288f,0.0958795771f,0.0539737605f,0.0303617641f,0.0170754679f,0.00960256159f,-0.999755144f,-0.468111664f,-0.993535519f,-0.348301649f,-0.705540299f,0.0486960001f,0.985844791f,0.829411685f,0.522687256f,0.304380238f,0.173049718f,0.0976495072f,0.0549722798f,0.0309238415f,0.01739165f,0.00978038087f,-0.521551013f,0.0751182064f,-0.908967435f,-0.508624554f,-0.631266713f,-0.00751878507f,0.980050862f,0.839214146f,0.531186223f,0.30973196f,0.17616342f,0.0994191393f,0.0559707358f,0.0314859077f,0.0177078284f,0.00995820016f,0.436164767f,0.595211506f,-0.734258294f,-0.652905703f,-0.550685287f,-0.0637097955f,0.973276973f,0.848751247f,0.539632022f,0.315073937f,0.179275364f,0.101188451f,0.0569691435f,0.0320479684f,0.0180240069f,0.0101360194f,0.992872655f,0.931992829f,-0.486733496f,-0.776594579f,-0.464602023f,-0.119699396f,0.965529919f,0.858020008f,0.548023939f,0.3204059f,0.182385504f,0.102957435f,0.0579674877f,0.0326100141f,0.0183401816f,0.0103138378f,0.636738002f,0.981735826f,-0.190938011f,-0.87579f,-0.373876572f,-0.175310582f,0.956817448f,0.867017388f,0.55636102f,0.325727791f,0.185493827f,0.104726106f,0.0589657798f,0.0331720486f,0.0186563563f,0.0104916561f,-0.304810613f,0.729123712f,0.12379095f,-0.947363734f,-0.279415488f,-0.230367512f,0.947148204f,0.875740528f,0.564642429f,0.33103931f,0.188600287f,0.106494442f,0.0599640086f,0.0337340795f,0.0189725272f,0.0106694745f,-0.966117799f,0.251952261f,0.426245421f,-0.98905772f,-0.182162598f,-0.284696162f,0.936531842f,0.884186864f,0.572867453f,0.336340427f,0.191704854f,0.108262435f,0.0609621815f,0.0342960916f,0.0192886982f,0.0108472919f,-0.739180684f,-0.302812874f,0.686427653f,-0.999557257f,-0.0830891207f,-0.338124752f,0.924979091f,0.892353535f,0.581035137f,0.341630876f,0.194807529f,0.110030092f,0.0619602874f,0.0348580964f,0.0196048655f,0.0110251084f,0.167355701f,-0.764320076f,0.878538549f,-0.978531301f,0.0168140903f,-0.390484393f,0.912501454f,0.900238097f,0.589144766f,0.346910536f,0.197908238f,0.111797392f,0.0629583374f,0.0354200937f,0.0199210308f,0.0112029258f};
#define DI __device__ __forceinline__
#define LAS __attribute__((address_space(3)))
typedef unsigned short bf16;
typedef short bf16x8 __attribute__((ext_vector_type(8)));
typedef float f32x4 __attribute__((ext_vector_type(4)));
typedef unsigned u32x4 __attribute__((ext_vector_type(4)));
typedef unsigned u32x2 __attribute__((ext_vector_type(2)));

#ifndef COOP
#define COOP 1
#endif

constexpr int D = 1024, NBATCH = 4, SEQ = 4096, CTXL = 256, NLAT = NBATCH * SEQ, NCTX = NBATCH * CTXL, MT = NLAT + NCTX;
constexpr int FF = 2816, KEYS = SEQ + CTXL;
constexpr int LDP0 = 2560, LDP1 = 3072;
constexpr int C_AQ = 0, C_AK = 512, C_AV = 640, C_BQ = 768, C_BK = 1024, C_BV = 1280, C_BO = 1792, C_RF = 2304, C_RB = 2320;
constexpr float LOG2E = 1.4426950408889634f, EPS = 1e-6f;
constexpr int NCHUNK = 68;

constexpr size_t MiB = 1u << 20;
constexpr size_t WS_MOD = 1 * MiB, WS_XC = 2 * MiB, WS_WABI = 6 * MiB, WS_WABO = 11 * MiB, WS_WFI = 13 * MiB, WS_WFO = 35 * MiB, WS_WNI = 46 * MiB, WS_WNO = 52 * MiB;
constexpr size_t WS_HO = 54 * MiB, WS_YF = 88 * MiB, WS_P = 122 * MiB, WS_STC = 224 * MiB, WS_DEC = 228 * MiB, WS_END = 229 * MiB;
constexpr int LDS_BYTES = 147456;
constexpr int NWAVES = 8, NTHR = 512;

DI float bf2f(unsigned short h) { return __uint_as_float(((unsigned)h) << 16); }
DI unsigned pk2(float lo, float hi) { return pg8::cvt_pk_bf16(lo, hi); }
DI float wave_sum(float v) {
#pragma unroll
    for (int o = 1; o < 64; o <<= 1) v += __shfl_xor(v, o);
    return v;
}
DI float fast_exp2(float x) { return __builtin_amdgcn_exp2f(x); }
DI float silu_f(float g) { return g * __builtin_amdgcn_rcpf(1.0f + __expf(-g)); }
DI void unpack8(const bf16x8 v, float (&o)[8]) {
#pragma unroll
    for (int i = 0; i < 8; ++i) o[i] = bf2f((unsigned short)v[i]);
}
DI bf16x8 pack8(const float (&p)[8]) {
    u32x4 w; w.x = pk2(p[0], p[1]); w.y = pk2(p[2], p[3]); w.z = pk2(p[4], p[5]); w.w = pk2(p[6], p[7]);
    return __builtin_bit_cast(bf16x8, w);
}
#define MFMA16(a, b, c) __builtin_amdgcn_mfma_f32_16x16x32_bf16((a), (b), (c), 0, 0, 0)

struct EpiStore {
    static constexpr bool PERM = true, AFTER_DRAIN = false;
    bf16* O; int ldc;
    DI void operator()(const pg8::f32x4 (&acc)[2][2][4][2], const pg8::Unit& u, int wr, int wc, int fr, int fq) const {
        const int row0 = u.pm * 256 + wr * 64 + fr, col0 = u.pn * 256 + wc * 32 + 8 * fq;
#pragma unroll
        for (int ai = 0; ai < 2; ++ai)
#pragma unroll
            for (int m = 0; m < 4; ++m) { bf16* rowp = O + (size_t)(row0 + ai * 128 + m * 16) * ldc + col0;
#pragma unroll
                for (int bj = 0; bj < 2; ++bj) { const pg8::f32x4 v0 = acc[ai][bj][m][0], v1 = acc[ai][bj][m][1];
                    u32x4 w; w.x = pk2(v0[0], v0[1]); w.y = pk2(v0[2], v0[3]); w.z = pk2(v1[0], v1[1]); w.w = pk2(v1[2], v1[3]);
                    *(u32x4*)(rowp + bj * 128) = w; } }
    }
};
struct EpiSwiglu {
    static constexpr bool PERM = true, AFTER_DRAIN = false;
    bf16* O; int ldc;
    DI void operator()(const pg8::f32x4 (&acc)[2][2][4][2], const pg8::Unit& u, int wr, int wc, int fr, int fq) const {
        const int row0 = u.pm * 256 + wr * 64 + fr, col0 = u.pn * 128 + wc * 32 + 8 * fq;
#pragma unroll
        for (int ai = 0; ai < 2; ++ai)
#pragma unroll
            for (int m = 0; m < 4; ++m) { bf16* rowp = O + (size_t)(row0 + ai * 128 + m * 16) * ldc + col0;
                const pg8::f32x4 g0 = acc[ai][0][m][0], g1 = acc[ai][0][m][1], u0 = acc[ai][1][m][0], u1 = acc[ai][1][m][1];
                u32x4 w; w.x = pk2(silu_f(g0[0]) * u0[0], silu_f(g0[1]) * u0[1]); w.y = pk2(silu_f(g0[2]) * u0[2], silu_f(g0[3]) * u0[3]);
                w.z = pk2(silu_f(g1[0]) * u1[0], silu_f(g1[1]) * u1[1]); w.w = pk2(silu_f(g1[2]) * u1[2], silu_f(g1[3]) * u1[3]);
                *(u32x4*)rowp = w; }
    }
};

struct Args { const float* in[23]; float* out; unsigned char* ws; int ph_lo, ph_hi; };
enum { I_X = 0, I_C, I_CTX, I_CCTX, I_WMOD, I_BMOD, I_GMPRE, I_GMPOST, I_GFPRE, I_GFPOST, I_WFI, I_WFO, I_ABWI, I_ABWO, I_SINK, I_GFW, I_GFB, I_GBW, I_GBB, I_GNORM, I_NAWI, I_NAWO, I_RELB };

DI void transpose_item(const float* W, int K, int N, bf16* WT, int k0, int n0, int drow0, LAS float* scr, int lane) {
#pragma unroll 8
    for (int i = 0; i < 32; ++i) { const int kk = 2 * i + (lane >> 5); scr[kk * 33 + (lane & 31)] = W[(size_t)(k0 + kk) * N + n0 + (lane & 31)]; }
    asm volatile("s_waitcnt lgkmcnt(0)" ::: "memory");
    const int c = lane & 7;
#pragma unroll
    for (int j = 0; j < 4; ++j) { const int n = (lane >> 3) + 8 * j; const LAS float* s = scr + (8 * c) * 33 + n;
        u32x4 o; o.x = pk2(s[0 * 33], s[1 * 33]); o.y = pk2(s[2 * 33], s[3 * 33]); o.z = pk2(s[4 * 33], s[5 * 33]); o.w = pk2(s[6 * 33], s[7 * 33]);
        *(u32x4*)(WT + (size_t)(drow0 + n) * K + k0 + 8 * c) = o; }
    asm volatile("s_waitcnt lgkmcnt(0)" ::: "memory");
}
DI void xpose_plain(const float* W, int K, int N, bf16* WT, int item, LAS float* scr, int lane) {
    const int nblk = N / 32, kb = item / nblk, nb = item % nblk;
    transpose_item(W, K, N, WT, 64 * kb, 32 * nb, 32 * nb, scr, lane);
}
DI void xpose_ffnin(const float* W, bf16* WT, int item, LAS float* scr, int lane) {
    const int nblk = 5632 / 32, kb = item / nblk, nb = item % nblk, n0 = 32 * nb;
    const int bj = n0 >= FF ? 1 : 0, cc = n0 - bj * FF, drow0 = 256 * (cc >> 7) + 128 * bj + (cc & 127);
    transpose_item(W, 1024, 5632, WT, 64 * kb, n0, drow0, scr, lane);
}

DI void phase_prologue(const Args& a, LAS unsigned char* lds, int tid, int lane, int wave) {
    unsigned char* ws = a.ws;
    {
        LAS float* sl = (LAS float*)lds;
        LAS float* red = (LAS float*)(lds + 32768);
        for (int i = tid; i < 5 * 1024; i += NTHR) { const int s = i >> 10, k = i & 1023; const float v = s < 4 ? a.in[I_C][s * 1024 + k] : a.in[I_CCTX][k]; sl[i] = v / (1.0f + __expf(-v)); }
        __syncthreads();
        for (int u = blockIdx.x; u < 192; u += gridDim.x) {
            const int layer = u / 96, col = (u % 96) * 64 + lane;
            const float* W = a.in[I_WMOD] + (size_t)layer * 1024 * 6144 + col;
            float acc[5] = {0.f, 0.f, 0.f, 0.f, 0.f};
            const int kb = wave * 128;
#pragma unroll 8
            for (int k = 0; k < 128; ++k) { const float w = W[(size_t)(kb + k) * 6144];
#pragma unroll
                for (int s = 0; s < 5; ++s) acc[s] += sl[s * 1024 + kb + k] * w; }
#pragma unroll
            for (int s = 0; s < 5; ++s) red[(wave * 5 + s) * 64 + lane] = acc[s];
            __syncthreads();
            if (tid < 320) { const int s = tid >> 6, l = tid & 63; float t = 0.f;
#pragma unroll
                for (int w = 0; w < 8; ++w) t += red[(w * 5 + s) * 64 + l];
                const int c2 = (u % 96) * 64 + l;
                ((float*)(ws + WS_MOD))[(size_t)(layer * 5 + s) * 6144 + c2] = t + a.in[I_BMOD][layer * 6144 + c2]; }
            __syncthreads();
        }
        __syncthreads();
    }
    LAS float* scr = (LAS float*)(lds + wave * 16384);
    const int gw = blockIdx.x * NWAVES + wave, NGW = gridDim.x * NWAVES;
    constexpr int I_1 = 16 * 73, I_2 = 16 * 32, I_3 = 16 * 176, I_4 = 44 * 32, I_5 = 16 * 96, I_6 = 16 * 32;
    constexpr int NITEMS = I_1 + I_2 + 2 * I_3 + 2 * I_4 + I_5 + I_6;
    for (int it = gw; it < NITEMS; it += NGW) {
        int r = it;
        if (r < I_1) { xpose_plain(a.in[I_ABWI], 1024, 2336, (bf16*)(ws + WS_WABI), r, scr, lane); continue; } r -= I_1;
        if (r < I_2) { xpose_plain(a.in[I_ABWO], 1024, 1024, (bf16*)(ws + WS_WABO), r, scr, lane); continue; } r -= I_2;
        if (r < I_3) { xpose_ffnin(a.in[I_WFI], (bf16*)(ws + WS_WFI), r, scr, lane); continue; } r -= I_3;
        if (r < I_3) { xpose_ffnin(a.in[I_WFI] + (size_t)1024 * 5632, (bf16*)(ws + WS_WFI) + (size_t)5632 * 1024, r, scr, lane); continue; } r -= I_3;
        if (r < I_4) { xpose_plain(a.in[I_WFO], FF, 1024, (bf16*)(ws + WS_WFO), r, scr, lane); continue; } r -= I_4;
        if (r < I_4) { xpose_plain(a.in[I_WFO] + (size_t)FF * 1024, FF, 1024, (bf16*)(ws + WS_WFO) + (size_t)1024 * FF, r, scr, lane); continue; } r -= I_4;
        if (r < I_5) { xpose_plain(a.in[I_NAWI], 1024, 3072, (bf16*)(ws + WS_WNI), r, scr, lane); continue; } r -= I_5;
        xpose_plain(a.in[I_NAWO], 1024, 1024, (bf16*)(ws + WS_WNO), r, scr, lane);
    }
    { u32x4* z = (u32x4*)((bf16*)(ws + WS_WABI) + (size_t)2336 * 1024); const u32x4 zero = {0u, 0u, 0u, 0u};
      for (int i = blockIdx.x * NTHR + tid; i < 224 * 128; i += gridDim.x * NTHR) z[i] = zero; }
}

DI void row_op(const float* xsrc, const bf16* y, const float* gpost, const float* gate, float* xdst,
               const float* gpre, const float* shift, const float* scale, bf16* hdst, int lane) {
    f32x4 v[4];
#pragma unroll
    for (int j = 0; j < 4; ++j) v[j] = *((const f32x4*)xsrc + lane + 64 * j);
    if (y) {
        f32x4 yv[4]; float s = 0.f;
#pragma unroll
        for (int j = 0; j < 4; ++j) { const u32x2 w = *((const u32x2*)y + lane + 64 * j);
            yv[j] = (f32x4){__uint_as_float(w.x << 16), __uint_as_float(w.x & 0xffff0000u), __uint_as_float(w.y << 16), __uint_as_float(w.y & 0xffff0000u)};
            s += (yv[j].x * yv[j].x + yv[j].y * yv[j].y) + (yv[j].z * yv[j].z + yv[j].w * yv[j].w); }
        const float rstd = __builtin_amdgcn_rsqf(wave_sum(s) * (1.0f / D) + EPS);
#pragma unroll
        for (int j = 0; j < 4; ++j) { const f32x4 gp = *((const f32x4*)gpost + lane + 64 * j), gt = *((const f32x4*)gate + lane + 64 * j);
            v[j] = v[j] + gt * (yv[j] * rstd * gp); }
    }
    if (xdst) {
#pragma unroll
        for (int j = 0; j < 4; ++j) *((f32x4*)xdst + lane + 64 * j) = v[j];
    }
    if (hdst) {
        float s = 0.f;
#pragma unroll
        for (int j = 0; j < 4; ++j) s += (v[j].x * v[j].x + v[j].y * v[j].y) + (v[j].z * v[j].z + v[j].w * v[j].w);
        const float rstd = __builtin_amdgcn_rsqf(wave_sum(s) * (1.0f / D) + EPS);
#pragma unroll
        for (int j = 0; j < 4; ++j) { const f32x4 gp = *((const f32x4*)gpre + lane + 64 * j), sh = *((const f32x4*)shift + lane + 64 * j), sc = *((const f32x4*)scale + lane + 64 * j);
            const f32x4 h = v[j] * rstd * gp * (sc + 1.0f) + sh;
            u32x2 w; w.x = pk2(h.x, h.y); w.y = pk2(h.z, h.w);
            *((u32x2*)hdst + lane + 64 * j) = w; }
    }
}
DI void phase_rows(const Args& a, int mode, int layer, int lane, int wave) {
    unsigned char* ws = a.ws;
    const float* MOD = (const float*)(ws + WS_MOD);
    bf16* H = (bf16*)(ws + WS_HO); const bf16* YF = (const bf16*)(ws + WS_YF); float* XC = (float*)(ws + WS_XC);
    const int gw = blockIdx.x * NWAVES + wave, NGW = gridDim.x * NWAVES;
    const int nrows = (layer == 0) ? MT : NLAT;
    for (int m = gw; m < nrows; m += NGW) {
        const bool lat = m < NLAT; const int s = lat ? (m >> 12) : 4;
        const float* mod = MOD + (size_t)(layer * 5 + s) * 6144;
        float* xcur = lat ? a.out + (size_t)m * D : XC + (size_t)(m - NLAT) * D;
        if (mode == 0) {
            const float* xin = lat ? a.in[I_X] + (size_t)m * D : a.in[I_CTX] + (size_t)(m - NLAT) * D;
            row_op(xin, nullptr, nullptr, nullptr, nullptr, a.in[I_GMPRE], mod, mod + 1024, H + (size_t)m * D, lane);
        } else if (mode == 1) {
            const float* xin = (layer == 0) ? (lat ? a.in[I_X] + (size_t)m * D : a.in[I_CTX] + (size_t)(m - NLAT) * D) : xcur;
            row_op(xin, YF + (size_t)m * D, a.in[I_GMPOST] + layer * D, mod + 2048, xcur, a.in[I_GFPRE] + layer * D, mod + 3072, mod + 4096, H + (size_t)m * D, lane);
        } else {
            if (layer == 0) { const float* mod1 = MOD + (size_t)(5 + s) * 6144;
                row_op(xcur, YF + (size_t)m * D, a.in[I_GFPOST], mod + 5120, xcur, a.in[I_GMPRE] + D, mod1, mod1 + 1024, H + (size_t)m * D, lane); }
            else row_op(xcur, YF + (size_t)m * D, a.in[I_GFPOST] + D, mod + 5120, xcur, nullptr, nullptr, nullptr, nullptr, lane);
        }
    }
}

template <int G, int MODE>
DI void attn_tile(f32x4 (&o)[G][4], float (&mrun)[G], float (&lrun)[G], const bf16x8 (&qf)[G][2],
                  const bf16* kp, int kld, const bf16* vp, int vld, float sc2, int d0, unsigned okmask, const float (&bias)[8], int fr, int fq) {
    bf16x8 kf[2][2], vf[4];
#pragma unroll
    for (int h = 0; h < 2; ++h)
#pragma unroll
        for (int ks = 0; ks < 2; ++ks) kf[h][ks] = *(const bf16x8*)(kp + (size_t)((fr >> 2) * 8 + h * 4 + (fr & 3)) * kld + ks * 32 + fq * 8);
#pragma unroll
    for (int nt = 0; nt < 4; ++nt) vf[nt] = *(const bf16x8*)(vp + (size_t)(nt * 16 + fr) * vld + fq * 8);
#pragma unroll
    for (int g = 0; g < G; ++g) {
        f32x4 s0 = {0.f, 0.f, 0.f, 0.f}, s1 = {0.f, 0.f, 0.f, 0.f};
        s0 = MFMA16(kf[0][0], qf[g][0], s0); s0 = MFMA16(kf[0][1], qf[g][1], s0);
        s1 = MFMA16(kf[1][0], qf[g][0], s1); s1 = MFMA16(kf[1][1], qf[g][1], s1);
        float sv[8] = {s0[0], s0[1], s0[2], s0[3], s1[0], s1[1], s1[2], s1[3]};
        float mx = -1e30f;
#pragma unroll
        for (int i = 0; i < 8; ++i) {
            float t = sv[i] * sc2;
            if (MODE == 1) { const int dd = d0 - i; t = (dd >= -128 && dd <= 128) ? t : -1e30f; }
            if (MODE == 2) { t = ((okmask >> i) & 1u) ? t + bias[i] : -1e30f; }
            sv[i] = t; mx = fmaxf(mx, t);
        }
        mx = fmaxf(mx, __shfl_xor(mx, 16)); mx = fmaxf(mx, __shfl_xor(mx, 32));
        const float mn = fmaxf(mrun[g], mx), alpha = fast_exp2(mrun[g] - mn);
        float p[8], ps = 0.f;
#pragma unroll
        for (int i = 0; i < 8; ++i) { p[i] = fast_exp2(sv[i] - mn); ps += p[i]; }
        ps += __shfl_xor(ps, 16); ps += __shfl_xor(ps, 32);
        lrun[g] = lrun[g] * alpha + ps; mrun[g] = mn;
        const bf16x8 pf = pack8(p);
#pragma unroll
        for (int nt = 0; nt < 4; ++nt) { o[g][nt] = o[g][nt] * alpha; o[g][nt] = MFMA16(vf[nt], pf, o[g][nt]); }
    }
}
template <int G>
DI void attn_store(const f32x4 (&o)[G][4], const float (&lrun)[G], bf16* orow  , int fq) {
#pragma unroll
    for (int g = 0; g < G; ++g) { const float inv = 1.0f / lrun[g];
#pragma unroll
        for (int nt = 0; nt < 4; ++nt) { u32x2 w; w.x = pk2(o[g][nt][0] * inv, o[g][nt][1] * inv); w.y = pk2(o[g][nt][2] * inv, o[g][nt][3] * inv);
            *(u32x2*)(orow + g * 64 + nt * 16 + fq * 4) = w; } }
}

DI void window_attn_tile(const Args& a, int wt, int lane) {
    const bf16* P = (const bf16*)(a.ws + WS_P); const bf16* VtA = (const bf16*)(a.ws + WS_YF); bf16* O = (bf16*)(a.ws + WS_HO);
    const int fr = lane & 15, fq = lane >> 4;
    const bool isctx = wt >= 2048;
    int b, kvh, q0; size_t qrow;
    if (!isctx) { b = wt >> 9; kvh = (wt >> 8) & 1; q0 = (wt & 255) * 16; qrow = (size_t)b * SEQ + q0 + fr; }
    else { const int ct = wt - 2048; b = ct >> 5; kvh = (ct >> 4) & 1; q0 = (ct & 15) * 16; qrow = (size_t)NLAT + b * CTXL + q0 + fr; }
    bf16x8 qf[4][2]; f32x4 o[4][4]; float mrun[4], lrun[4];
#pragma unroll
    for (int g = 0; g < 4; ++g) {
#pragma unroll
        for (int ks = 0; ks < 2; ++ks) qf[g][ks] = *(const bf16x8*)(P + qrow * LDP0 + C_AQ + (kvh * 4 + g) * 64 + ks * 32 + fq * 8);
#pragma unroll
        for (int nt = 0; nt < 4; ++nt) o[g][nt] = (f32x4){0.f, 0.f, 0.f, 0.f};
        mrun[g] = a.in[I_SINK][kvh * 4 + g] * LOG2E; lrun[g] = 1.0f;
    }
    const float sc2 = 0.125f * LOG2E;
    const float nob[8] = {0.f, 0.f, 0.f, 0.f, 0.f, 0.f, 0.f, 0.f};
    const bf16* vbase = VtA + (size_t)((b * 2 + kvh) * 64) * KEYS;
    const bf16* kctx = P + (size_t)(NLAT + b * CTXL) * LDP0 + C_AK + kvh * 64;
    for (int t8 = 0; t8 < 8; ++t8)
        attn_tile<4, 0>(o, mrun, lrun, qf, kctx + (size_t)(t8 * 32) * LDP0, LDP0, vbase + SEQ + t8 * 32, KEYS, sc2, 0, 0u, nob, fr, fq);
    if (!isctx) {
        const int tlo = (q0 - 128 > 0 ? q0 - 128 : 0) & ~31, thi = (q0 + 16 + 128 < SEQ) ? q0 + 16 + 128 : SEQ;
        const bf16* kloc = P + (size_t)(b * SEQ) * LDP0 + C_AK + kvh * 64;
        for (int key0 = tlo; key0 < thi; key0 += 32)
            attn_tile<4, 1>(o, mrun, lrun, qf, kloc + (size_t)key0 * LDP0, LDP0, vbase + key0, KEYS, sc2, q0 + fr - key0 - fq * 8, 0u, nob, fr, fq);
    }
    attn_store<4>(o, lrun, O + qrow * D + (kvh * 4) * 64, fq);
}

DI void na_attn_tile(const Args& a, int id, int lane) {
    const bf16* P = (const bf16*)(a.ws + WS_P); const bf16* VtC = (const bf16*)(a.ws + WS_YF); bf16* O = (bf16*)(a.ws + WS_HO);
    const int fr = lane & 15, fq = lane >> 4;
    const int j = id & 3, r = (id >> 2) & 63, h = (id >> 8) & 15, b = id >> 12;
    const size_t qrow = (size_t)b * SEQ + r * 64 + j * 16 + fr;
    bf16x8 qf[1][2]; f32x4 o[1][4]; float mrun[1], lrun[1];
#pragma unroll
    for (int ks = 0; ks < 2; ++ks) qf[0][ks] = *(const bf16x8*)(P + qrow * LDP1 + h * 64 + ks * 32 + fq * 8);
#pragma unroll
    for (int nt = 0; nt < 4; ++nt) o[0][nt] = (f32x4){0.f, 0.f, 0.f, 0.f};
    mrun[0] = -1e30f; lrun[0] = 0.f;
    const float sc2 = 0.125f * LOG2E;
    const float nob[8] = {0.f, 0.f, 0.f, 0.f, 0.f, 0.f, 0.f, 0.f};
    const bf16* vbase = VtC + (size_t)((b * 16 + h) * 64) * KEYS;
    const bf16* kctx = P + (size_t)(NLAT + b * CTXL) * LDP1 + 1024 + h * 64;
    for (int t8 = 0; t8 < 8; ++t8)
        attn_tile<1, 0>(o, mrun, lrun, qf, kctx + (size_t)(t8 * 32) * LDP1, LDP1, vbase + SEQ + t8 * 32, KEYS, sc2, 0, 0u, nob, fr, fq);
    const int rs = r - 4 < 0 ? 0 : (r - 4 > 56 ? 56 : r - 4);
    const int seg_start = j == 0 ? 0 : (j == 1 ? 8 : (j == 2 ? 24 : 32));
    const int qcol = j * 16 + fr; const int cs = qcol - 8 < 0 ? 0 : (qcol - 8 > 48 ? 48 : qcol - 8);
    unsigned okmask = 0u; int coloff[8];
#pragma unroll
    for (int i = 0; i < 8; ++i) { const int keycol = seg_start + fq * 8 + i; if (keycol >= cs && keycol < cs + 16) okmask |= 1u << i;
        int co = keycol - qcol + 15; co = co < 0 ? 0 : (co > 30 ? 30 : co); coloff[i] = co; }
    const float* relb = a.in[I_RELB] + h * 15 * 31;
    const bf16* kloc = P + (size_t)(b * SEQ) * LDP1 + 1024 + h * 64;
    for (int i = 0; i < 8; ++i) {
        const int R = rs + i, key0 = R * 64 + seg_start;
        const float* rb = relb + (R - r + 7) * 31;
        float bias[8];
#pragma unroll
        for (int e = 0; e < 8; ++e) bias[e] = rb[coloff[e]] * LOG2E;
        attn_tile<1, 2>(o, mrun, lrun, qf, kloc + (size_t)key0 * LDP1, LDP1, vbase + key0, KEYS, sc2, 0, okmask, bias, fr, fq);
    }
    attn_store<1>(o, lrun, O + qrow * D + h * 64, fq);
}

DI void vt_unit(const bf16* P, int ldp, int vcol, int nh, bf16* Vt, int unit, LAS unsigned char* scr, int lane) {
    const int kb = unit % 68, bh = unit / 68, h = bh % nh, b = bh / nh;
    const size_t row0 = kb < 64 ? (size_t)b * SEQ + kb * 64 : (size_t)NLAT + b * CTXL + (kb - 64) * 64;
    LAS unsigned short* t = (LAS unsigned short*)scr;
#pragma unroll
    for (int i = 0; i < 8; ++i) { const int key = (lane >> 3) + 8 * i, ch = lane & 7;
        const u32x4 v = *(const u32x4*)(P + (row0 + key) * ldp + vcol + h * 64 + ch * 8);
        *(LAS u32x4*)(t + key * 72 + ch * 8) = v; }
    asm volatile("s_waitcnt lgkmcnt(0)" ::: "memory");
    bf16* dst = Vt + (size_t)(bh * 64 + lane) * KEYS + kb * 64;
#pragma unroll
    for (int g8 = 0; g8 < 8; ++g8) { unsigned short e[8];
#pragma unroll
        for (int i = 0; i < 8; ++i) e[i] = t[(g8 * 8 + i) * 72 + lane];
        u32x4 w; w.x = e[0] | ((unsigned)e[1] << 16); w.y = e[2] | ((unsigned)e[3] << 16); w.z = e[4] | ((unsigned)e[5] << 16); w.w = e[6] | ((unsigned)e[7] << 16);
        *(u32x4*)(dst + g8 * 8) = w; }
    asm volatile("s_waitcnt lgkmcnt(0)" ::: "memory");
}

constexpr int L_GW = 0, L_CUM = 4608, L_A = 21248, L_B = 30464, L_ATT = 39680, L_VT = 48896, L_SSQ = 67328;
DI size_t chunk_row0(int b, int n) { return n < 64 ? (size_t)b * SEQ + n * 64 : (size_t)NLAT + b * CTXL + (n - 64) * 64; }
DI float* st_ptr(const Args& a, int seq, int n) { return n < 64 ? a.out + (size_t)(seq * 64 + n) * 8192 : (float*)(a.ws + WS_STC) + (size_t)(seq * 4 + (n - 64)) * 8192; }

DI void gla_cum(const Args& a, LAS unsigned char* lds, const bf16* P, size_t row0, int h, int dir, int tid) {
    LAS float* gwl = (LAS float*)(lds + L_GW); LAS float* gbl = gwl + 1024; LAS float* cum = (LAS float*)(lds + L_CUM);
    const float* gw = a.in[dir ? I_GBW : I_GFW]; const float* gb = a.in[dir ? I_GBB : I_GFB];
    for (int i = tid; i < 1024; i += NTHR) gwl[i] = gw[(i >> 6) * 256 + h * 64 + (i & 63)];
    if (tid < 64) gbl[tid] = gb[h * 64 + tid];
    __syncthreads();
    const int c = tid >> 3, dg = tid & 7;
    float rf[16];
    { const bf16* rp = P + (row0 + c) * LDP0 + (dir ? C_RB : C_RF);
      float t0[8], t1[8]; unpack8(*(const bf16x8*)rp, t0); unpack8(*(const bf16x8*)(rp + 8), t1);
#pragma unroll
      for (int i = 0; i < 8; ++i) { rf[i] = t0[i]; rf[8 + i] = t1[i]; } }
#pragma unroll
    for (int dd = 0; dd < 8; ++dd) { const int d = dg * 8 + dd; float x = gbl[d];
#pragma unroll
        for (int rr = 0; rr < 16; ++rr) x += rf[rr] * gwl[rr * 64 + d];
        const float ls = fminf(x, 0.f) - log1pf(__expf(-fabsf(x)));
        cum[c * 65 + d] = ls * (1.0f / 16.0f); }
    __syncthreads();
    if (tid < 64) { float run = 0.f;
        if (dir == 0) { for (int cc = 0; cc < 64; ++cc) { run += cum[cc * 65 + tid]; cum[cc * 65 + tid] = run; } }
        else { for (int cc = 63; cc >= 0; --cc) { run += cum[cc * 65 + tid]; cum[cc * 65 + tid] = run; } } }
    __syncthreads();
}
DI void gla_load_vt(LAS unsigned char* lds, const bf16* P, size_t row0, int h, int tid) {
    LAS unsigned short* vT = (LAS unsigned short*)(lds + L_VT);
    const int c = tid >> 3, dg = tid & 7;
    const bf16* vp = P + (row0 + c) * LDP0 + C_BV + h * 128 + dg * 16;
    const bf16x8 v0 = *(const bf16x8*)vp, v1 = *(const bf16x8*)(vp + 8);
#pragma unroll
    for (int e = 0; e < 8; ++e) { vT[(dg * 16 + e) * 72 + c] = (unsigned short)v0[e]; vT[(dg * 16 + 8 + e) * 72 + c] = (unsigned short)v1[e]; }
}
DI void gla_g1_unit(const Args& a, LAS unsigned char* lds, int unit, int tid, int lane, int wave) {
    const bf16* P = (const bf16*)(a.ws + WS_P);
    const int n = unit % NCHUNK, seq = unit / NCHUNK, dir = seq & 1, h = (seq >> 1) & 3, b = seq >> 3;
    const size_t row0 = chunk_row0(b, n);
    gla_cum(a, lds, P, row0, h, dir, tid);
    LAS float* cum = (LAS float*)(lds + L_CUM); LAS unsigned short* kdT = (LAS unsigned short*)(lds + L_A); LAS unsigned short* vT = (LAS unsigned short*)(lds + L_VT);
    const int cend = dir ? 0 : 63;
    { const int c = tid >> 3, dg = tid & 7; float kk[8]; unpack8(*(const bf16x8*)(P + (row0 + c) * LDP0 + C_BK + h * 64 + dg * 8), kk);
#pragma unroll
      for (int dd = 0; dd < 8; ++dd) { const int d = dg * 8 + dd; const float v = kk[dd] * __expf(cum[cend * 65 + d] - cum[c * 65 + d]); kdT[d * 72 + c] = (unsigned short)(pk2(v, 0.f) & 0xffffu); } }
    gla_load_vt(lds, P, row0, h, tid);
    if (tid < 64) ((float*)(a.ws + WS_DEC))[(size_t)(seq * NCHUNK + n) * 64 + tid] = __expf(cum[cend * 65 + tid]);
    __syncthreads();
    const int fr = lane & 15, fq = lane >> 4;
    bf16x8 av[2];
#pragma unroll
    for (int ks = 0; ks < 2; ++ks) av[ks] = *(const LAS bf16x8*)(vT + (wave * 16 + fr) * 72 + ks * 32 + fq * 8);
    float* st = st_ptr(a, seq, n);
#pragma unroll
    for (int nt = 0; nt < 4; ++nt) { f32x4 acc = {0.f, 0.f, 0.f, 0.f};
#pragma unroll
        for (int ks = 0; ks < 2; ++ks) { const bf16x8 bk = *(const LAS bf16x8*)(kdT + (nt * 16 + fr) * 72 + ks * 32 + fq * 8); acc = MFMA16(av[ks], bk, acc); }
#pragma unroll
        for (int r = 0; r < 4; ++r) st[(wave * 16 + fq * 4 + r) * 64 + nt * 16 + fr] = acc[r]; }
    __syncthreads();
}
DI void gla_scan(const Args& a, int tid) {
    const float* DEC = (const float*)(a.ws + WS_DEC);
    for (int e = blockIdx.x * NTHR + tid; e < 32 * 8192; e += gridDim.x * NTHR) {
        const int seq = e >> 13, el = e & 8191, dk = el & 63, dir = seq & 1;
        float S = 0.f;
        for (int s4 = 0; s4 < NCHUNK; s4 += 4) {
            float* p[4]; float t[4], dc[4];
#pragma unroll
            for (int i = 0; i < 4; ++i) { const int step = s4 + i; const int n = dir == 0 ? (step < 4 ? 64 + step : step - 4) : (step < 4 ? 67 - step : 67 - step);
                p[i] = st_ptr(a, seq, n) + el; t[i] = *p[i]; dc[i] = DEC[(size_t)(seq * NCHUNK + n) * 64 + dk]; }
#pragma unroll
            for (int i = 0; i < 4; ++i) { *p[i] = S; S = dc[i] * S + t[i]; }
        }
    }
}
DI void gla_g3_unit(const Args& a, LAS unsigned char* lds, int unit, int tid, int lane, int wave) {
    const bf16* P = (const bf16*)(a.ws + WS_P); bf16* O = (bf16*)(a.ws + WS_HO);
    const int n = unit % NCHUNK, bh = unit / NCHUNK, h = bh & 3, b = bh >> 2;
    const size_t row0 = chunk_row0(b, n);
    LAS float* cum = (LAS float*)(lds + L_CUM); LAS unsigned short* qg = (LAS unsigned short*)(lds + L_A); LAS unsigned short* kg = (LAS unsigned short*)(lds + L_B);
    LAS unsigned short* att = (LAS unsigned short*)(lds + L_ATT); LAS unsigned short* vT = (LAS unsigned short*)(lds + L_VT); LAS float* ssq = (LAS float*)(lds + L_SSQ);
    const int fr = lane & 15, fq = lane >> 4, ct = wave & 3, dvh = wave >> 2;
    gla_load_vt(lds, P, row0, h, tid);
    f32x4 acc[4];
#pragma unroll
    for (int nt = 0; nt < 4; ++nt) acc[nt] = (f32x4){0.f, 0.f, 0.f, 0.f};
    for (int dir = 0; dir < 2; ++dir) {
        gla_cum(a, lds, P, row0, h, dir, tid);
        { const int c = tid >> 3, dg = tid & 7; float qq[8], kk[8], oq[8], ok[8];
          unpack8(*(const bf16x8*)(P + (row0 + c) * LDP0 + C_BQ + h * 64 + dg * 8), qq); unpack8(*(const bf16x8*)(P + (row0 + c) * LDP0 + C_BK + h * 64 + dg * 8), kk);
#pragma unroll
          for (int dd = 0; dd < 8; ++dd) { const float cu = cum[c * 65 + dg * 8 + dd]; oq[dd] = qq[dd] * 0.125f * __expf(cu); ok[dd] = kk[dd] * __expf(-cu); }
          *(LAS bf16x8*)(qg + c * 72 + dg * 8) = pack8(oq); *(LAS bf16x8*)(kg + c * 72 + dg * 8) = pack8(ok); }
        __syncthreads();
        bf16x8 bq[2];
#pragma unroll
        for (int ks = 0; ks < 2; ++ks) bq[ks] = *(const LAS bf16x8*)(qg + (ct * 16 + fr) * 72 + ks * 32 + fq * 8);
#pragma unroll
        for (int si = 0; si < 2; ++si) { const int st = dvh * 2 + si; f32x4 s = {0.f, 0.f, 0.f, 0.f};
#pragma unroll
            for (int ks = 0; ks < 2; ++ks) { const bf16x8 ak = *(const LAS bf16x8*)(kg + (st * 16 + fr) * 72 + ks * 32 + fq * 8); s = MFMA16(ak, bq[ks], s); }
            const int cpos = ct * 16 + fr; float pv[4];
#pragma unroll
            for (int r = 0; r < 4; ++r) { const int spos = st * 16 + fq * 4 + r; const bool keep = dir == 0 ? (spos <= cpos) : (spos >= cpos); pv[r] = keep ? s[r] : 0.f; }
            u32x2 w; w.x = pk2(pv[0], pv[1]); w.y = pk2(pv[2], pv[3]);
            *(LAS u32x2*)(att + cpos * 72 + st * 16 + fq * 4) = w; }
        __syncthreads();
        bf16x8 ba[2];
#pragma unroll
        for (int ks = 0; ks < 2; ++ks) ba[ks] = *(const LAS bf16x8*)(att + (ct * 16 + fr) * 72 + ks * 32 + fq * 8);
        const float* st = st_ptr(a, (bh * 2 + dir), n);
#pragma unroll
        for (int nt = 0; nt < 4; ++nt) { const int dvt = dvh * 4 + nt;
#pragma unroll
            for (int ks = 0; ks < 2; ++ks) {
                const bf16x8 av = *(const LAS bf16x8*)(vT + (dvt * 16 + fr) * 72 + ks * 32 + fq * 8);
                acc[nt] = MFMA16(av, ba[ks], acc[nt]);
                const f32x4 s0 = *(const f32x4*)(st + (dvt * 16 + fr) * 64 + ks * 32 + fq * 8), s1 = *(const f32x4*)(st + (dvt * 16 + fr) * 64 + ks * 32 + fq * 8 + 4);
                const float sf[8] = {s0[0], s0[1], s0[2], s0[3], s1[0], s1[1], s1[2], s1[3]};
                acc[nt] = MFMA16(pack8(sf), bq[ks], acc[nt]); } }
        __syncthreads();
    }
    float sq = 0.f;
#pragma unroll
    for (int nt = 0; nt < 4; ++nt) sq += (acc[nt][0] * acc[nt][0] + acc[nt][1] * acc[nt][1]) + (acc[nt][2] * acc[nt][2] + acc[nt][3] * acc[nt][3]);
    sq += __shfl_xor(sq, 16); sq += __shfl_xor(sq, 32);
    if (fq == 0) ssq[wave * 16 + fr] = sq;
    __syncthreads();
    const float tot = ssq[wave * 16 + fr] + ssq[(wave ^ 4) * 16 + fr];
    const float rstd = __builtin_amdgcn_rsqf(tot * (1.0f / 128.0f) + EPS);
    const size_t row = row0 + ct * 16 + fr;
#pragma unroll
    for (int nt = 0; nt < 4; ++nt) { const int dv0 = (dvh * 4 + nt) * 16 + fq * 4;
        const f32x4 g4 = *(const f32x4*)(a.in[I_GNORM] + h * 128 + dv0);
        const u32x2 bw = *(const u32x2*)(P + row * LDP0 + C_BO + h * 128 + dv0);
        const float g0 = __uint_as_float(bw.x << 16), g1 = __uint_as_float(bw.x & 0xffff0000u), g2 = __uint_as_float(bw.y << 16), g3 = __uint_as_float(bw.y & 0xffff0000u);
        u32x2 w; w.x = pk2(acc[nt][0] * rstd * g4[0] * silu_f(g0), acc[nt][1] * rstd * g4[1] * silu_f(g1));
        w.y = pk2(acc[nt][2] * rstd * g4[2] * silu_f(g2), acc[nt][3] * rstd * g4[3] * silu_f(g3));
        *(u32x2*)(O + row * D + 512 + h * 128 + dv0) = w; }
    __syncthreads();
}

DI void rope_row(bf16* prow, int t, int lane) {
    const int prow_pos = t >> 6, pcol_pos = t & 63;
#pragma unroll
    for (int i = 0; i < 5; ++i) { const int pi = lane + 64 * i, head = pi >> 5, rem = pi & 31, half = rem >> 4, j = rem & 15;
        const int c1 = head * 64 + half * 32 + j, pos = half ? pcol_pos : prow_pos;
        const float cs = ROPE_COS[pos * 16 + j], sn = ROPE_SIN[pos * 16 + j];
        const float u1 = bf2f(prow[c1]), u2 = bf2f(prow[c1 + 16]);
        prow[c1] = (unsigned short)(pk2(u1 * cs - u2 * sn, 0.f) & 0xffffu); prow[c1 + 16] = (unsigned short)(pk2(u2 * cs + u1 * sn, 0.f) & 0xffffu); }
}

constexpr int NPHASE = 19;
__global__ void __launch_bounds__(NTHR, 2) fwd_kernel(Args a) {
    extern __shared__ __attribute__((aligned(16))) unsigned char lds_raw[];
    LAS unsigned char* lds = (LAS unsigned char*)lds_raw;
    const int tid = threadIdx.x, lane = tid & 63, wave = __builtin_amdgcn_readfirstlane(tid >> 6);
    const int G = gridDim.x, gw = blockIdx.x * NWAVES + wave, NGW = G * NWAVES;
    unsigned char* ws = a.ws;
    const int lo = a.ph_lo, hi = a.ph_hi;
#define IN(k) (lo <= (k) && (k) < hi)
#define SEAM(k) do { if (IN(k) && IN((k) + 1)) { cg::this_grid().sync(); } } while (0)
    bf16* H = (bf16*)(ws + WS_HO); bf16* YF = (bf16*)(ws + WS_YF); bf16* P = (bf16*)(ws + WS_P);

    if (IN(0)) { phase_prologue(a, lds, tid, lane, wave); } SEAM(0);
    if (IN(1)) { phase_rows(a, 0, 0, lane, wave); } SEAM(1);
    if (IN(2)) { pg8::Gemm g{H, (const bf16*)(ws + WS_WABI), MT, LDP0, D}; pg8::StaticOrder S; S.init(MT, LDP0, G, (int)blockIdx.x);
        EpiStore E{P, LDP0}; pg8::gemm_phase<EpiStore, pg8::StaticOrder, true, true>(lds, g, S, E); } SEAM(2);
    if (IN(3)) {
        for (int u = blockIdx.x; u < 32 * NCHUNK; u += G) gla_g1_unit(a, lds, u, tid, lane, wave);
        __syncthreads();
        for (int m = gw; m < NLAT; m += NGW) rope_row(P + (size_t)m * LDP0, m & 4095, lane);
        for (int u = gw; u < NBATCH * 2 * 68; u += NGW) vt_unit(P, LDP0, C_AV, 2, YF, u, lds + wave * 16384, lane);
    } SEAM(3);
    if (IN(4)) {
        for (int wt = gw; wt < 2176; wt += NGW) window_attn_tile(a, wt, lane);
        gla_scan(a, tid);
    } SEAM(4);
    if (IN(5)) { for (int u = blockIdx.x; u < 16 * NCHUNK; u += G) gla_g3_unit(a, lds, u, tid, lane, wave); } SEAM(5);
    if (IN(6)) { pg8::Gemm g{H, (const bf16*)(ws + WS_WABO), MT, D, D}; pg8::StaticOrder S; S.init(MT, D, G, (int)blockIdx.x);
        EpiStore E{YF, D}; pg8::gemm_phase<EpiStore, pg8::StaticOrder, true, true>(lds, g, S, E); } SEAM(6);
    if (IN(7)) { phase_rows(a, 1, 0, lane, wave); } SEAM(7);
    if (IN(8)) { pg8::Gemm g{H, (const bf16*)(ws + WS_WFI), MT, 2 * FF, D}; pg8::StaticOrder S; S.init(MT, 2 * FF, G, (int)blockIdx.x);
        EpiSwiglu E{P, FF}; pg8::gemm_phase<EpiSwiglu, pg8::StaticOrder, true, true>(lds, g, S, E); } SEAM(8);
    if (IN(9)) { pg8::Gemm g{P, (const bf16*)(ws + WS_WFO), MT, D, FF}; pg8::StaticOrder S; S.init(MT, D, G, (int)blockIdx.x);
        EpiStore E{YF, D}; pg8::gemm_phase<EpiStore, pg8::StaticOrder, true, true>(lds, g, S, E); } SEAM(9);
    if (IN(10)) { phase_rows(a, 2, 0, lane, wave); } SEAM(10);
    if (IN(11)) { pg8::Gemm g{H, (const bf16*)(ws + WS_WNI), MT, LDP1, D}; pg8::StaticOrder S; S.init(MT, LDP1, G, (int)blockIdx.x);
        EpiStore E{P, LDP1}; pg8::gemm_phase<EpiStore, pg8::StaticOrder, true, true>(lds, g, S, E); } SEAM(11);
    if (IN(12)) { for (int u = gw; u < NBATCH * 16 * 68; u += NGW) vt_unit(P, LDP1, 2048, 16, YF, u, lds + wave * 16384, lane); } SEAM(12);
    if (IN(13)) { for (int i = 0; i < 8; ++i) { const int id = gw * 8 + i; if (id < 16384) na_attn_tile(a, id, lane); }
        for (int id = NGW * 8 + gw; id < 16384; id += NGW) na_attn_tile(a, id, lane); } SEAM(13);
    if (IN(14)) { pg8::Gemm g{H, (const bf16*)(ws + WS_WNO), NLAT, D, D}; pg8::StaticOrder S; S.init(NLAT, D, G, (int)blockIdx.x);
        EpiStore E{YF, D}; pg8::gemm_phase<EpiStore, pg8::StaticOrder, true, true>(lds, g, S, E); } SEAM(14);
    if (IN(15)) { phase_rows(a, 1, 1, lane, wave); } SEAM(15);
    if (IN(16)) { pg8::Gemm g{H, (const bf16*)(ws + WS_WFI) + (size_t)5632 * 1024, NLAT, 2 * FF, D}; pg8::StaticOrder S; S.init(NLAT, 2 * FF, G, (int)blockIdx.x);
        EpiSwiglu E{P, FF}; pg8::gemm_phase<EpiSwiglu, pg8::StaticOrder, true, true>(lds, g, S, E); } SEAM(16);
    if (IN(17)) { pg8::Gemm g{P, (const bf16*)(ws + WS_WFO) + (size_t)1024 * FF, NLAT, D, FF}; pg8::StaticOrder S; S.init(NLAT, D, G, (int)blockIdx.x);
        EpiStore E{YF, D}; pg8::gemm_phase<EpiStore, pg8::StaticOrder, true, true>(lds, g, S, E); } SEAM(17);
    if (IN(18)) { phase_rows(a, 2, 1, lane, wave); }
#undef IN
#undef SEAM
}

extern "C" void kernel_launch(void* const* d_in, const int* in_sizes, int n_in, void* d_out, int out_size, void* d_ws, size_t ws_size, hipStream_t stream) {
    static int grid = 0;
    if (grid == 0) {
        if (n_in != 23 || out_size != NLAT * D || ws_size < WS_END) { fprintf(stderr, "kernel_launch: unexpected problem shape (n_in %d, out %d, ws %zu)\n", n_in, out_size, ws_size); grid = -1; return; }
        int dev = 0, cus = 0, per_cu = 0;
        (void)hipGetDevice(&dev); (void)hipDeviceGetAttribute(&cus, hipDeviceAttributeMultiprocessorCount, dev);
        if (hipFuncSetAttribute((const void*)fwd_kernel, hipFuncAttributeMaxDynamicSharedMemorySize, LDS_BYTES) != hipSuccess) { fprintf(stderr, "kernel_launch: hipFuncSetAttribute failed\n"); grid = -1; return; }
        (void)hipOccupancyMaxActiveBlocksPerMultiprocessor(&per_cu, (const void*)fwd_kernel, NTHR, LDS_BYTES);
        if (per_cu < 1) per_cu = 1;
        (void)hipGetLastError();
        grid = cus * per_cu;
    }
    if (grid < 0) return;
    Args a{};
    for (int i = 0; i < 23; ++i) a.in[i] = (const float*)d_in[i];
    a.out = (float*)d_out; a.ws = (unsigned char*)d_ws;
#if COOP
    a.ph_lo = 0; a.ph_hi = NPHASE;
    void* args[] = {&a};
    hipError_t e = hipLaunchCooperativeKernel((const void*)fwd_kernel, dim3(grid), dim3(NTHR), args, LDS_BYTES, stream);
    if (e != hipSuccess) fprintf(stderr, "cooperative launch failed: %s (grid %d)\n", hipGetErrorString(e), grid);
#else
    for (int p = 0; p < NPHASE; ++p) { a.ph_lo = p; a.ph_hi = p + 1; hipLaunchKernelGGL(fwd_kernel, dim3(grid), dim3(NTHR), LDS_BYTES, stream, a); }
#endif
}
```

```cpp
#include <hip/hip_runtime.h>
#include <hip/hip_cooperative_groups.h>
#include <cstdio>
#include <cstdint>
namespace cg = cooperative_groups;
namespace pg8 {
#define PG8_LAS __attribute__((address_space(3)))
typedef unsigned short bf16_t;
typedef short bf16x8 __attribute__((ext_vector_type(8)));
typedef float f32x4 __attribute__((ext_vector_type(4)));
typedef unsigned u32x4 __attribute__((ext_vector_type(4)));
constexpr int BM = 256, BK = 64, HALF = 128, HTB = HALF * BK * 2  , STAGE_BYTES = 8 * HTB, NXCD = 8, WGM = 8;

__host__ __device__ __forceinline__ int lds_byte(int r, int c) { const int st = (r >> 4) * 2 + (c >> 5), rr = r & 15, cc = c & 31, ob = rr * 64 + cc * 2; return st * 1024 + (ob ^ (((ob >> 9) & 1) << 5)); }
__host__ __device__ __forceinline__ void stage_rc(int b, int& R, int& C) { const int st = b / 1024, sb = b % 1024, swz = sb ^ (((sb >> 9) & 1) << 5); R = (st >> 1) * 16 + swz / 64; C = (st & 1) * 32 + (swz % 64) / 2; }
__host__ __device__ __forceinline__ int perm32(int rho) { const int n = rho >> 4, i = rho & 15; return 8 * (i >> 2) + 4 * n + (i & 3); }

struct Unit { int pm, pn; };
struct Gemm { const bf16_t* A; const bf16_t* Bt; int M, N, K; };

struct StaticOrder {
    int nM, nN, nwg, G, c;
    __host__ __device__ void init(int M, int N, int G_, int c_) { nM = M / BM; nN = N / BM; nwg = nM * nN; G = G_; c = c_; }
    __host__ __device__ bool next(int i, Unit& u) const {
        const long L = (long)i * G + c; if (L >= nwg) return false;
        int wgid = (int)L; { const int q = nwg / NXCD, r = nwg % NXCD, xcd = wgid % NXCD, off = wgid / NXCD; wgid = (xcd < r ? xcd * (q + 1) : r * (q + 1) + (xcd - r) * q) + off; }
        const int nig = WGM * nN, gid = wgid / nig, fm = gid * WGM, gsz = (nM - fm) < WGM ? (nM - fm) : WGM;
        u.pm = fm + ((wgid % nig) % gsz); u.pn = (wgid % nig) / gsz; return true;
    }
    __device__ __forceinline__ void a_ready(const Unit&) const {}
    __device__ __forceinline__ void done(const Unit&) const {}
};

__device__ __forceinline__ unsigned cvt_pk_bf16(float lo, float hi) { unsigned r; asm volatile("v_cvt_pk_bf16_f32 %0, %1, %2" : "=v"(r) : "v"(lo), "v"(hi)); return r; }
template <class Epi, class Sched, bool ALIGN_EPI = false, bool SP2 = false>
__device__ __forceinline__ void gemm_phase(PG8_LAS unsigned char* lds, const Gemm g, const Sched& S, const Epi& E) {
    const int tid = threadIdx.x, wid = __builtin_amdgcn_readfirstlane(tid >> 6), lane = tid & 63, wr = wid >> 2, wc = wid & 3, fr = lane & 15, fq = lane >> 4;
    const int K = g.K, nt = K / BK;
    unsigned voffA[2], voffB[2];
#pragma unroll
    for (int i = 0; i < 2; ++i) { int R, C; stage_rc(tid * 16 + i * 8192, R, C); const int Rb = Epi::PERM ? ((R & ~31) + perm32(R & 31)) : R;
        voffA[i] = (unsigned)(R * K + C) * 2u; voffB[i] = (unsigned)(Rb * K + C) * 2u; }
    const size_t kstep = (size_t)(BK * 2);
    const size_t hstep = (size_t)HALF * K * 2;
    const size_t tstep = 2 * hstep;
    const unsigned ldsw = (unsigned)wid * 1024u;
    const int aoff = lds_byte(wr * 64 + fr, fq * 8), boff = lds_byte(wc * 32 + fr, fq * 8);
#define PG8_SA(b, h) (((b) * 2 + (h)) * HTB)
#define PG8_SB(b, h) ((4 + (b) * 2 + (h)) * HTB)
#define PG8_STAGE(bufoff, gbase, voff) do { _Pragma("unroll") for (int _i = 0; _i < 2; ++_i) \
        __builtin_amdgcn_global_load_lds((const unsigned*)((const char*)(gbase) + (voff)[_i]), (PG8_LAS unsigned*)(lds + (bufoff) + ldsw + _i * 8192), 16, 0, 0); } while (0)
#define PG8_LDA(dst, b, h) do { _Pragma("unroll") for (int m = 0; m < 4; ++m) _Pragma("unroll") for (int k = 0; k < 2; ++k) dst[m][k] = *(const PG8_LAS bf16x8*)(lds + PG8_SA(b, h) + aoff + m * 2048 + k * 1024); } while (0)
#define PG8_LDB(dst, b, h) do { _Pragma("unroll") for (int n = 0; n < 2; ++n) _Pragma("unroll") for (int k = 0; k < 2; ++k) dst[n][k] = *(const PG8_LAS bf16x8*)(lds + PG8_SB(b, h) + boff + n * 2048 + k * 1024); } while (0)
#define PG8_MMA(ai, bj, At, Bt) do { __builtin_amdgcn_s_setprio(1); _Pragma("unroll") for (int m = 0; m < 4; ++m) _Pragma("unroll") for (int n = 0; n < 2; ++n) _Pragma("unroll") for (int k = 0; k < 2; ++k) \
        acc[ai][bj][m][n] = __builtin_amdgcn_mfma_f32_16x16x32_bf16(Bt[n][k], At[m][k], acc[ai][bj][m][n], 0, 0, 0); __builtin_amdgcn_s_setprio(0); } while (0)
#define PG8_WAIT_V(n) asm volatile("s_waitcnt vmcnt(" #n ")" ::: "memory")
#define PG8_WAIT_L(n) asm volatile("s_waitcnt lgkmcnt(" #n ")" ::: "memory")
#define PG8_BAR __builtin_amdgcn_s_barrier()
#define PG8_SCHED __builtin_amdgcn_sched_barrier(0)
    Unit cur, nxt; int ui = 0;
    if (!S.next(0, cur)) return;
    f32x4 acc[2][2][4][2];
#pragma unroll
    for (int a = 0; a < 2; ++a)
#pragma unroll
        for (int b = 0; b < 2; ++b)
#pragma unroll
            for (int m = 0; m < 4; ++m)
#pragma unroll
                for (int n = 0; n < 2; ++n) acc[a][b][m][n] = (f32x4){0.f, 0.f, 0.f, 0.f};
    bf16x8 At[4][2], B0[2][2], B1[2][2];
    const char* cA = (const char*)g.A + (size_t)cur.pm * tstep; const char* cB = (const char*)g.Bt + (size_t)cur.pn * tstep;
    S.a_ready(cur);
    if constexpr (SP2) {
        PG8_STAGE(PG8_SB(0, 0), cB, voffB); PG8_STAGE(PG8_SB(0, 1), cB + hstep, voffB); PG8_STAGE(PG8_SA(0, 0), cA, voffA); PG8_STAGE(PG8_SA(0, 1), cA + hstep, voffA);
        if (wr == 1) PG8_BAR;
        PG8_WAIT_V(2); PG8_BAR;
        PG8_STAGE(PG8_SB(1, 0), cB + kstep, voffB); PG8_STAGE(PG8_SA(1, 0), cA + kstep, voffA); PG8_STAGE(PG8_SB(1, 1), cB + hstep + kstep, voffB);
        PG8_WAIT_V(6); PG8_BAR;
    } else {
        PG8_STAGE(PG8_SB(0, 0), cB, voffB); PG8_STAGE(PG8_SA(0, 0), cA, voffA); PG8_STAGE(PG8_SB(0, 1), cB + hstep, voffB); PG8_STAGE(PG8_SA(0, 1), cA + hstep, voffA);
        if (wr == 1) PG8_BAR;
        PG8_WAIT_V(4); PG8_BAR;
        PG8_STAGE(PG8_SB(1, 0), cB + kstep, voffB); PG8_STAGE(PG8_SA(1, 0), cA + kstep, voffA); PG8_STAGE(PG8_SB(1, 1), cB + hstep + kstep, voffB);
        PG8_WAIT_V(6); PG8_BAR;
    }
    for (;;) {
        const bool has_next = S.next(ui + 1, nxt);
        const char* nA = has_next ? (const char*)g.A + (size_t)nxt.pm * tstep : cA; const char* nB = has_next ? (const char*)g.Bt + (size_t)nxt.pn * tstep : cB;
        for (int t = 0; t < nt; t += 2) {
            const bool last = (t == nt - 2);
            const char* a1 = cA + (size_t)(t + 1) * kstep;
            const char* a2 = last ? nA : cA + (size_t)(t + 2) * kstep; const char* b2 = last ? nB : cB + (size_t)(t + 2) * kstep;
            const char* a3 = a2 + kstep; const char* b3 = b2 + kstep;
            if (last && has_next) S.a_ready(nxt);
            if constexpr (SP2) {
            PG8_LDB(B0, 0, 0); PG8_LDB(B1, 0, 1); PG8_SCHED; PG8_LDA(At, 0, 0); PG8_STAGE(PG8_SA(1, 1), a1 + hstep, voffA);
            PG8_WAIT_V(8); PG8_WAIT_L(0); PG8_BAR; PG8_MMA(0, 0, At, B0); PG8_MMA(0, 1, At, B1); PG8_BAR; PG8_SCHED;
            PG8_LDA(At, 0, 1); PG8_STAGE(PG8_SB(0, 0), b2, voffB); PG8_STAGE(PG8_SB(0, 1), b2 + hstep, voffB); PG8_STAGE(PG8_SA(0, 0), a2, voffA);
            PG8_WAIT_V(8); PG8_WAIT_L(0); PG8_BAR; PG8_MMA(1, 0, At, B0); PG8_MMA(1, 1, At, B1); PG8_BAR; PG8_SCHED;
            PG8_LDB(B0, 1, 0); PG8_LDB(B1, 1, 1); PG8_SCHED; PG8_LDA(At, 1, 0); PG8_STAGE(PG8_SA(0, 1), a2 + hstep, voffA);
            PG8_WAIT_V(8); PG8_WAIT_L(0); PG8_BAR; PG8_MMA(0, 0, At, B0); PG8_MMA(0, 1, At, B1); PG8_BAR; PG8_SCHED;
            PG8_LDA(At, 1, 1); PG8_STAGE(PG8_SB(1, 0), b3, voffB); PG8_STAGE(PG8_SB(1, 1), b3 + hstep, voffB); PG8_STAGE(PG8_SA(1, 0), a3, voffA);
            PG8_WAIT_V(8); PG8_WAIT_L(0); PG8_BAR; PG8_MMA(1, 0, At, B0); PG8_MMA(1, 1, At, B1); PG8_BAR; PG8_SCHED;
            } else {
            PG8_LDB(B0, 0, 0); PG8_SCHED; PG8_LDA(At, 0, 0); PG8_STAGE(PG8_SA(1, 1), a1 + hstep, voffA);
            PG8_WAIT_L(8); PG8_BAR; PG8_WAIT_L(0); PG8_MMA(0, 0, At, B0); PG8_BAR; PG8_SCHED;
            PG8_LDB(B1, 0, 1); PG8_STAGE(PG8_SB(0, 0), b2, voffB);
            PG8_BAR; PG8_WAIT_L(0); PG8_MMA(0, 1, At, B1); PG8_BAR;
            PG8_LDA(At, 0, 1); PG8_STAGE(PG8_SA(0, 0), a2, voffA);
            PG8_BAR; PG8_WAIT_L(0); PG8_MMA(1, 0, At, B0); PG8_BAR; PG8_SCHED;
            PG8_STAGE(PG8_SB(0, 1), b2 + hstep, voffB);
            PG8_WAIT_V(6); PG8_BAR; PG8_MMA(1, 1, At, B1); PG8_BAR;
            PG8_LDB(B0, 1, 0); PG8_SCHED; PG8_LDA(At, 1, 0); PG8_STAGE(PG8_SA(0, 1), a2 + hstep, voffA);
            PG8_WAIT_L(8); PG8_BAR; PG8_WAIT_L(0); PG8_MMA(0, 0, At, B0); PG8_BAR; PG8_SCHED;
            PG8_LDB(B1, 1, 1); PG8_STAGE(PG8_SB(1, 0), b3, voffB);
            PG8_BAR; PG8_WAIT_L(0); PG8_MMA(0, 1, At, B1); PG8_BAR;
            PG8_LDA(At, 1, 1); PG8_STAGE(PG8_SA(1, 0), a3, voffA);
            PG8_BAR; PG8_WAIT_L(0); PG8_MMA(1, 0, At, B0); PG8_BAR; PG8_SCHED;
            PG8_STAGE(PG8_SB(1, 1), b3 + hstep, voffB);
            PG8_WAIT_V(6); PG8_BAR; PG8_MMA(1, 1, At, B1); PG8_BAR;
            }
        }
        if constexpr (ALIGN_EPI) { if (wr == 0) PG8_BAR; }
        if constexpr (!Epi::AFTER_DRAIN) { E(acc, cur, wr, wc, fr, fq); S.done(cur); }
        if (!has_next) break;
#pragma unroll
        for (int a = 0; a < 2; ++a)
#pragma unroll
            for (int b = 0; b < 2; ++b)
#pragma unroll
                for (int m = 0; m < 4; ++m)
#pragma unroll
                    for (int n = 0; n < 2; ++n) acc[a][b][m][n] = (f32x4){0.f, 0.f, 0.f, 0.f};
        cur = nxt; cA = nA; cB = nB; ++ui;
        if constexpr (ALIGN_EPI) { if (wr == 1) PG8_BAR; }
    }
    PG8_WAIT_V(0);
    if constexpr (!ALIGN_EPI) { if (wr == 0) PG8_BAR; }
    PG8_BAR;
    if constexpr (Epi::AFTER_DRAIN) { E.fused(acc, cur, wr, wc, fr, fq, lds, wid, lane); S.done(cur); }
#undef PG8_SA
#undef PG8_SB
#undef PG8_STAGE
#undef PG8_LDA
#undef PG8_LDB
#undef PG8_MMA
#undef PG8_WAIT_V
#undef PG8_WAIT_L
#undef PG8_BAR
#undef PG8_SCHED
}
}
__device__ const float ROPE_COS[1024] = {1.f,1.f,1.f,1.f,1.f,1.f,1.f,1.f,1.f,1.f,1.f,1.f,1.f,1.f,1.f,1.f,0.540302277f,0.846009135f,0.950415254f,0.98423022f,0.995004177f,0.998419285f,0.999500036f,0.999841869f,0.999949992f,0.999984205f,0.999994993f,0.999998391f,0.999999523f,0.999999821f,0.99999994f,1.f,-0.416146845f,0.431462824f,0.806578398f,0.937418282f,0.980066597f,0.993682086f,0.998000681f,0.999367595f,0.999800026f,0.999936759f,0.999979973f,0.999993682f,0.999997973f,0.999999344f,0.999999821f,0.99999994f,-0.989992499f,-0.115966164f,0.582753658f,0.861040652f,0.955336511f,0.985803485f,0.995503366f,0.998577297f,0.999550045f,0.999857724f,0.999954998f,0.999985754f,0.99999553f,0.999998569f,0.999999523f,0.999999881f,-0.653643608f,-0.627679706f,0.301137477f,0.757506192f,0.921060979f,0.974808276f,0.992010653f,0.997471273f,0.999200106f,0.999747038f,0.999920011f,0.999974728f,0.999992013f,0.999997497f,0.999999225f,0.999999762f,0.2836622f,-0.946079254f,-0.0103423381f,0.630080283f,0.87758255f,0.960731268f,0.987526f,0.996049762f,0.998750269f,0.999604762f,0.999875009f,0.999960482f,0.999987483f,0.999996066f,0.999998748f,0.999999583f,0.960170269f,-0.973103702f,-0.3207964f,0.482782036f,0.825335622f,0.943616986f,0.982053936f,0.9943133f,0.998200536f,0.999430835f,0.999819994f,0.999943078f,0.999981999f,0.999994338f,0.999998212f,0.999999404f,0.753902256f,-0.700429797f,-0.599437475f,0.320257008f,0.764842212f,0.923519433f,0.975599885f,0.992262423f,0.997551024f,0.999225318f,0.999755025f,0.999922514f,0.999975502f,0.999992251f,0.999997556f,0.999999225f,-0.145500034f,-0.212036446f,-0.818632424f,0.147631213f,0.696706712f,0.900502324f,0.968170285f,0.989897788f,0.996801734f,0.998988271f,0.999680042f,0.999898791f,0.999967992f,0.999989867f,0.999996781f,0.999998987f,-0.91113025f,0.341660261f,-0.956644177f,-0.0296507962f,0.621609926f,0.874638259f,0.959772646f,0.987220109f,0.995952725f,0.998719573f,0.999595046f,0.99987191f,0.999959528f,0.999987185f,0.999995947f,0.999998748f,-0.839071512f,0.790131867f,-0.999786079f,-0.205997631f,0.540302277f,0.846009135f,0.950415313f,0.98423022f,0.995004177f,0.998419285f,0.999500036f,0.999841869f,0.999949992f,0.999984205f,0.999994993f,0.999998391f,0.00442569796f,0.995257378f,-0.943779767f,-0.375847399f,0.453596085f,0.814705312f,0.940107584f,0.980929136f,0.993956089f,0.998087406f,0.999395072f,0.999808669f,0.999939501f,0.999980867f,0.99999392f,0.999998093f,0.843853951f,0.893861592f,-0.79417938f,-0.53384304f,0.362357706f,0.780825913f,0.92885989f,0.97731787f,0.99280864f,0.997723997f,0.999280095f,0.99977231f,0.999927998f,0.999977231f,0.999992788f,0.999997735f,0.907446802f,0.517172873f,-0.565820515f,-0.675001681f,0.267498761f,0.744477987f,0.916683376f,0.973397553f,0.99156189f,0.997329056f,0.999155104f,0.999732792f,0.999915481f,0.999973297f,0.999991536f,0.999997318f,0.136737213f,-0.0187961515f,-0.28134948f,-0.794870913f,0.16996716f,0.705776393f,0.903590262f,0.969169438f,0.990216017f,0.996902585f,0.999020159f,0.999690115f,0.99990201f,0.999969006f,0.999990225f,0.999996901f,-0.759687901f,-0.548975468f,0.0310223512f,-0.889670432f,0.070737198f,0.6648435f,0.889593601f,0.964634836f,0.988771081f,0.996444523f,0.998875201f,0.999644279f,0.999887526f,0.999964416f,0.999988735f,0.999996424f,-0.957659483f,-0.910081089f,0.340318173f,-0.95641005f,-0.0291995462f,0.621808827f,0.87470746f,0.959795177f,0.987227261f,0.99595499f,0.998720288f,0.999595284f,0.999872029f,0.999959528f,0.999987185f,0.999995947f,-0.275163352f,-0.990897954f,0.615864813f,-0.99298501f,-0.128844544f,0.576808274f,0.858946681f,0.954652011f,0.985584795f,0.995433986f,0.998555362f,0.999543071f,0.999855518f,0.999954283f,0.999985576f,0.99999541f,0.660316706f,-0.766536534f,0.830336154f,-0.998241663f,-0.227202162f,0.529984176f,0.842327058f,0.949207008f,0.983843684f,0.994881511f,0.998380423f,0.999487758f,0.999837995f,0.9999488f,0.999983788f,0.999994874f,0.988704622f,-0.306095392f,0.962463796f,-0.972014248f,-0.323289543f,0.481484592f,0.824865162f,0.943461835f,0.982004225f,0.994297504f,0.998195529f,0.999429286f,0.999819517f,0.999942899f,0.99998194f,0.999994278f,0.408082068f,0.248616725f,0.999144375f,-0.91512996f,-0.416146845f,0.431462824f,0.806578457f,0.937418282f,0.980066597f,0.993682086f,0.998000681f,0.999367595f,0.999800026f,0.999936759f,0.999979973f,0.999993682f,-0.547729254f,0.726760268f,0.936740458f,-0.829382956f,-0.504846215f,0.380077004f,0.787485182f,0.931078374f,0.97803092f,0.993035257f,0.99779582f,0.999302804f,0.999779522f,0.999930263f,0.999977946f,0.999993026f,-0.99996084f,0.981074572f,0.781440377f,-0.717477441f,-0.588501155f,0.327489585f,0.767604589f,0.92444396f,0.975897431f,0.992357016f,0.997581005f,0.999234855f,0.999758005f,0.999923468f,0.999975801f,0.999992371f,-0.53283304f,0.933235765f,0.548645258f,-0.582943261f,-0.666275978f,0.273866832f,0.746956408f,0.917517304f,0.97366637f,0.991647422f,0.997356176f,0.999163687f,0.999735534f,0.999916375f,0.999973536f,0.999991655f,0.424179018f,0.597977161f,0.261441678f,-0.430023283f,-0.737393796f,0.219378278f,0.725561321f,0.910300434f,0.971337974f,0.990906477f,0.997121394f,0.99908942f,0.99971199f,0.999908924f,0.999971211f,0.99999088f,0.991202831f,0.078552261f,-0.0516893305f,-0.263540596f,-0.801143587f,0.164196163f,0.703440726f,0.902795732f,0.968912423f,0.99013412f,0.996876657f,0.999011934f,0.999687493f,0.999901175f,0.999968767f,0.999990106f,0.64691931f,-0.465064496f,-0.359694332f,-0.0887455046f,-0.856888831f,0.108494945f,0.680616796f,0.895005584f,0.966389954f,0.98933053f,0.996621907f,0.998931348f,0.999662042f,0.999893129f,0.999966204f,0.999989331f,-0.292138815f,-0.865450621f,-0.632028639f,0.088848114f,-0.904072165f,0.0524506159f,0.6571123f,0.886932373f,0.963770926f,0.988495648f,0.996357203f,0.998847544f,0.999635518f,0.999884725f,0.999963522f,0.999988496f,-0.962605894f,-0.999293387f,-0.841684937f,0.26363951f,-0.942222297f,-0.00375941908f,0.632950664f,0.878578722f,0.961055458f,0.987629473f,0.996082544f,0.998760641f,0.99960804f,0.999876022f,0.99996078f,0.999987602f,-0.748057544f,-0.825371623f,-0.967871487f,0.430115849f,-0.970958173f,-0.0599575676f,0.608156204f,0.869947195f,0.958243906f,0.986732066f,0.995797932f,0.998670578f,0.999579549f,0.999867022f,0.999957979f,0.999986708f,0.154251456f,-0.397251874f,-0.998075247f,0.583026946f,-0.989992499f,-0.115966164f,0.582753658f,0.861040652f,0.955336511f,0.985803485f,0.995503366f,0.998577297f,0.999550045f,0.999857724f,0.999954998f,0.999985754f,0.914742351f,0.153215483f,-0.929300308f,0.717549205f,-0.999135137f,-0.171608135f,0.556768358f,0.851861775f,0.95233357f,0.984843671f,0.995198846f,0.998480916f,0.999519527f,0.999848068f,0.999951959f,0.999984801f,0.83422339f,0.656495154f,-0.768367112f,0.829440355f,-0.998294771f,-0.226707578f,0.53022635f,0.842413545f,0.949235439f,0.983852804f,0.994884372f,0.998381376f,0.999488056f,0.999838114f,0.9999488f,0.999983788f,-0.0132767474f,0.95758605f,-0.531235278f,0.915171385f,-0.987479806f,-0.281090319f,0.503154159f,0.832698941f,0.946042359f,0.982830763f,0.994559944f,0.998278618f,0.999455571f,0.999827802f,0.999945521f,0.999982774f,-0.848570287f,0.963757515f,-0.241421118f,0.972038329f,-0.966798186f,-0.334584385f,0.475578904f,0.822721004f,0.942754686f,0.981777668f,0.994225562f,0.99817276f,0.999422073f,0.999817252f,0.999942183f,0.999981701f,-0.903692186f,0.673110247f,0.0723346695f,0.998247743f,-0.93645668f,-0.387020677f,0.447528064f,0.812482953f,0.939372718f,0.980693519f,0.993881226f,0.998063743f,0.999387562f,0.999806345f,0.999938726f,0.999980628f,-0.127963692f,0.175156534f,0.378916174f,0.992972851f,-0.896758378f,-0.438233554f,0.419029742f,0.801987886f,0.935896814f,0.979578316f,0.993526995f,0.997951567f,0.999352098f,0.999795079f,0.99993521f,0.999979496f,0.765414059f,-0.376742303f,0.647921681f,0.95638001f,-0.848100007f,-0.488060862f,0.39011243f,0.791239262f,0.93232733f,0.978432178f,0.993162811f,0.997836173f,0.99931556f,0.999783576f,0.999931574f,0.999978364f,0.955073655f,-0.812611222f,0.852673113f,0.889623463f,-0.790967762f,-0.536345184f,0.360805035f,0.780240417f,0.928664625f,0.977255106f,0.992788672f,0.997717679f,0.999278069f,0.999771714f,0.999927819f,0.999977171f,0.266642928f,-0.998210371f,0.972865343f,0.794808388f,-0.72593224f,-0.582933903f,0.331136853f,0.768994927f,0.924909055f,0.976047099f,0.99240464f,0.997596025f,0.999239624f,0.999759495f,0.999923944f,0.999975979f,-0.666938066f,-0.87637943f,0.996578991f,0.674925625f,-0.653643608f,-0.627679706f,0.301137596f,0.757506192f,0.921060979f,0.974808276f,0.992010653f,0.997471273f,0.999200106f,0.999747038f,0.999920011f,0.999974728f,-0.987339258f,-0.484639406f,0.921462357f,0.533756077f,-0.574824035f,-0.670441091f,0.270837069f,0.745777905f,0.917120814f,0.973538578f,0.991606772f,0.997343302f,0.999159634f,0.999734223f,0.999915957f,0.999973416f,-0.399985313f,0.0563609414f,0.754965365f,0.375752151f,-0.490260571f,-0.711082935f,0.240265876f,0.733813822f,0.913088918f,0.972238123f,0.991192937f,0.997212172f,0.999118149f,0.99972111f,0.999911785f,0.999972105f,0.555113316f,0.580003142f,0.513598442f,0.205897167f,-0.400799006f,-0.749476731f,0.209454417f,0.721617639f,0.908965766f,0.970906913f,0.990769207f,0.997077882f,0.999075651f,0.999707639f,0.999907553f,0.999970794f,0.999843299f,0.925014675f,0.221298173f,0.0295478199f,-0.307332784f,-0.785501122f,0.178433523f,0.709193349f,0.904751658f,0.969545007f,0.990335584f,0.996940494f,0.99903214f,0.99969393f,0.999903202f,0.999969363f,0.52532196f,0.985138178f,-0.0929481089f,-0.147732988f,-0.210795805f,-0.819042206f,0.147234216f,0.696544766f,0.90044713f,0.968152404f,0.989892066f,0.996799886f,0.998987675f,0.999679863f,0.999898732f,0.999967992f,-0.432177931f,0.741858006f,-0.397976756f,-0.320354372f,-0.112152621f,-0.849993885f,0.115887694f,0.683675885f,0.89605248f,0.966729224f,0.989438653f,0.996656179f,0.998942196f,0.999665439f,0.999894202f,0.999966562f,-0.992335498f,0.270098448f,-0.663538277f,-0.48287195f,-0.0123883775f,-0.878258407f,0.0844252855f,0.670590878f,0.891568303f,0.965275466f,0.988975346f,0.996509314f,0.998895705f,0.999650776f,0.999889553f,0.999965072f,-0.640144348f,-0.284846604f,-0.863296509f,-0.630159974f,0.0874991715f,-0.903746367f,0.0528784581f,0.657293737f,0.886994898f,0.963791192f,0.988502085f,0.996359289f,0.9988482f,0.999635756f,0.999884784f,0.999963582f,0.300592542f,-0.75206399f,-0.977442741f,-0.757573068f,0.18651247f,-0.926377118f,0.0212787576f,0.643788815f,0.882332861f,0.962276459f,0.98801899f,0.996206105f,0.998799741f,0.999620378f,0.999879956f,0.999962032f,0.964965999f,-0.987659097f,-0.994656444f,-0.861092687f,0.2836622f,-0.946079254f,-0.0103422189f,0.630080283f,0.87758255f,0.960731268f,0.987526f,0.996049762f,0.998750269f,0.999604762f,0.999875009f,0.999960482f,0.742154181f,-0.919073522f,-0.913230121f,-0.937454224f,0.377977669f,-0.96279037f,-0.0419528559f,0.616172493f,0.872744501f,0.959155679f,0.987023175f,0.99589026f,0.998699784f,0.999588788f,0.999869943f,0.999958873f,-0.162990779f,-0.567430019f,-0.741239965f,-0.984248459f,0.468516916f,-0.976457715f,-0.0735215396f,0.602069914f,0.86781919f,0.95754981f,0.986510456f,0.995727658f,0.998648286f,0.999572515f,0.999864817f,0.999957263f,-0.918282807f,-0.0410281904f,-0.495741814f,-1.f,0.554374516f,-0.987038016f,-0.105016708f,0.587776959f,0.862807095f,0.955913603f,0.985987842f,0.995561838f,0.998595834f,0.999555886f,0.999859571f,0.999955595f,-0.829309821f,0.498009592f,-0.201079622f,-0.984212041f,0.634692967f,-0.994497895f,-0.136406869f,0.573298037f,0.857708693f,0.954247177f,0.985455394f,0.995392919f,0.998542368f,0.999538958f,0.999854207f,0.999953866f,0.0221267566f,0.883669317f,0.113521777f,-0.937382519f,0.708669782f,-0.998813629f,-0.167660639f,0.558637917f,0.852524519f,0.95255059f,0.984913111f,0.99522084f,0.99848789f,0.999521732f,0.999848783f,0.999952197f,0.853220105f,0.997174621f,0.416867077f,-0.860988438f,0.775565803f,-0.999971747f,-0.198746875f,0.543801069f,0.847255111f,0.950823903f,0.984360933f,0.995045662f,0.998432398f,0.999504209f,0.99984318f,0.999950409f,0.899866819f,0.803569078f,0.678870201f,-0.757439196f,0.834712923f,-0.997968495f,-0.22963427f,0.528792322f,0.841901004f,0.949067116f,0.983798921f,0.994867265f,0.998375952f,0.999486327f,0.999837577f,0.999948621f,0.119180135f,0.362476677f,0.873550534f,-0.63000071f,0.885519624f,-0.99281019f,-0.260292053f,0.513616323f,0.836462677f,0.947280347f,0.983227074f,0.994685769f,0.998318493f,0.999468148f,0.999831796f,0.999946833f,-0.771080196f,-0.1902491f,0.981602073f,-0.482692331f,0.927478492f,-0.984513164f,-0.290689558f,0.498277903f,0.830940723f,0.945463598f,0.982645452f,0.994501114f,0.998260021f,0.99944967f,0.999825954f,0.999944985f,-0.952412963f,-0.684381902f,0.992308319f,-0.320159167f,0.960170269f,-0.973103702f,-0.3207964f,0.482782036f,0.825335622f,0.943616986f,0.982053936f,0.9943133f,0.998200536f,0.999430835f,0.999819994f,0.999943078f,-0.258101642f,-0.967739642f,0.904607594f,-0.1475292f,0.98326844f,-0.958617806f,-0.350582451f,0.467133403f,0.819648027f,0.941740453f,0.981452644f,0.994122326f,0.998140097f,0.999411702f,0.999813974f,0.99994117f,0.673507154f,-0.953050017f,0.727198064f,0.0297537707f,0.996542096f,-0.941101313f,-0.380017966f,0.451337039f,0.813878477f,0.939834237f,0.980841517f,0.993928254f,0.998078644f,0.999392271f,0.999807835f,0.999939203f,0.985896587f,-0.644837022f,0.477671444f,0.206098333f,0.999858618f,-0.920609534f,-0.409073502f,0.435397953f,0.808027506f,0.937898219f,0.980220556f,0.993731022f,0.998016179f,0.999372482f,0.999801576f,0.999937236f};
__device__ const float ROPE_SIN[1024] = {0.f,0.f,0.f,0.f,0.f,0.f,0.f,0.f,0.f,0.f,0.f,0.f,0.f,0.f,0.f,0.f,0.841470957f,0.533168435f,0.310983598f,0.176892191f,0.0998334214f,0.0562044978f,0.0316175036f,0.0177818574f,0.00999983307f,0.00562338345f,0.00316227227f,0.0017782785f,0.000999999931f,0.000562341243f,0.000316227757f,0.00017782794f,0.909297407f,0.902130723f,0.591127098f,0.348205268f,0.198669329f,0.112231314f,0.0632033944f,0.0355580896f,0.0199986659f,0.011246589f,0.00632451288f,0.00355655141f,0.0019999987f,0.00112468237f,0.000632455456f,0.00035565588f,0.141120002f,0.993253171f,0.812648892f,0.5085361f,0.295520216f,0.167903304f,0.0947260857f,0.0533230826f,0.0299954992f,0.0168694388f,0.00948669016f,0.00533481315f,0.0029999956f,0.00168702309f,0.000948683126f,0.000533483806f,-0.756802499f,0.778471708f,0.953580737f,0.652827978f,0.389418334f,0.223044485f,0.126154065f,0.0710712075f,0.0399893336f,0.0224917568f,0.0126487734f,0.00711305765f,0.00399998948f,0.00224936334f,0.00126491068f,0.000711311703f,-0.958924294f,0.32393527f,0.999946535f,0.776529968f,0.47942555f,0.277480543f,0.157455876f,0.0887968615f,0.0499791652f,0.0281133614f,0.0158107281f,0.00889127981f,0.0049999794f,0.0028117029f,0.00158113812f,0.000889139599f,-0.279415488f,-0.230367512f,0.947148204f,0.875740528f,0.564642489f,0.33103931f,0.188600272f,0.106494442f,0.0599640049f,0.0337340795f,0.0189725272f,0.0106694745f,0.0059999642f,0.00337404152f,0.00189736532f,0.00106696738f,0.656986594f,-0.713721275f,0.800421596f,0.947330713f,0.64421767f,0.383551568f,0.219556093f,0.124158338f,0.0699428469f,0.0393537246f,0.0221341345f,0.0124476347f,0.00699994294f,0.00393637875f,0.00221359241f,0.00124479528f,0.989358246f,-0.977261782f,0.574317753f,0.989042461f,0.717356086f,0.434851229f,0.250292331f,0.141782969f,0.0799146891f,0.0449721329f,0.0252955221f,0.0142257558f,0.0079999147f,0.00449871505f,0.00252981926f,0.00142262306f,0.412118495f,-0.939823508f,0.291259229f,0.999560297f,0.783326924f,0.484776139f,0.280778319f,0.159362778f,0.0898785442f,0.0505891182f,0.0284566563f,0.0160038304f,0.00899987947f,0.00506105041f,0.00284604589f,0.00160045072f,-0.54402113f,-0.612936914f,-0.0206835698f,0.978552461f,0.841470957f,0.533168435f,0.310983568f,0.176892191f,0.099833414f,0.0562044978f,0.0316175036f,0.0177818574f,0.009999834f,0.00562338345f,0.00316227227f,0.0017782785f,-0.999990225f,-0.0972764567f,-0.33057496f,0.926681578f,0.891207397f,0.579875171f,0.340877861f,0.19436565f,0.1097783f,0.0618181042f,0.0347780399f,0.0195598267f,0.0109997792f,0.00618571462f,0.00347849843f,0.00195610616f,-0.536572933f,0.448342979f,-0.60768342f,0.845583618f,0.932039082f,0.624748647f,0.370431304f,0.211777672f,0.119712204f,0.0674297586f,0.0379382223f,0.0213377345f,0.0119997123f,0.0067480444f,0.00379472389f,0.00213393359f,0.420167029f,0.855880976f,-0.824528456f,0.737816215f,0.963558197f,0.667647004f,0.399614304f,0.229122713f,0.129634142f,0.0730392784f,0.0410980321f,0.0231155735f,0.0129996343f,0.00731037185f,0.00411094911f,0.00231176103f,0.990607381f,0.999823332f,-0.959605396f,0.606778562f,0.985449731f,0.708434701f,0.428397775f,0.246395305f,0.139543116f,0.078646481f,0.0442574248f,0.0248933397f,0.0139995432f,0.00787269697f,0.00442717411f,0.00248958869f,0.650287867f,0.835838437f,-0.999518692f,0.456603259f,0.997494996f,0.746982634f,0.456752867f,0.263589978f,0.149438128f,0.0842512026f,0.0474163815f,0.0266710296f,0.0149994381f,0.00843502022f,0.00474339863f,0.00266741589f,-0.287903309f,0.414430231f,-0.940310359f,0.292027086f,0.999573588f,0.783169091f,0.484651238f,0.280701309f,0.159318209f,0.0898532644f,0.0505748577f,0.028448632f,0.015999319f,0.00899733976f,0.00505962269f,0.00284524332f,-0.961397469f,-0.134615138f,-0.78785187f,0.11824052f,0.991664827f,0.81687957f,0.512064993f,0.29772386f,0.169182345f,0.09545248f,0.0537328273f,0.0302261449f,0.0169991814f,0.00955965649f,0.00537584582f,0.00302307028f,-0.750987232f,-0.642200708f,-0.557262897f,-0.0592755191f,0.973847628f,0.84800756f,0.538966715f,0.314652264f,0.179029569f,0.101048686f,0.0568902642f,0.0320035629f,0.0179990288f,0.0101219704f,0.00569206895f,0.00320089748f,0.149877205f,-0.952000856f,-0.271410108f,-0.234921798f,0.946300089f,0.876454532f,0.565329552f,0.331481189f,0.188858896f,0.10664168f,0.060047131f,0.0337808803f,0.0189988576f,0.0106842816f,0.00600829115f,0.00337872445f,0.912945271f,-0.968601942f,0.0413582884f,-0.403158993f,0.909297407f,0.902130723f,0.591127038f,0.348205268f,0.198669314f,0.112231314f,0.0632033944f,0.0355580896f,0.0199986678f,0.011246589f,0.00632451288f,0.00355655141f,0.836655617f,-0.686891198f,0.35002476f,-0.558680534f,0.863209307f,0.924954832f,0.616333544f,0.364819258f,0.208459899f,0.117817394f,0.0663590282f,0.0373351872f,0.0209984574f,0.0118088927f,0.00664073415f,0.00373437814f,-0.00885130931f,-0.193630233f,0.623979926f,-0.696581721f,0.808496356f,0.944854796f,0.640923738f,0.381317884f,0.218229622f,0.123399742f,0.0695140064f,0.0391121693f,0.0219982266f,0.0123711927f,0.00695695449f,0.00391220488f,-0.846220434f,0.359264523f,0.836055279f,-0.812512875f,0.745705247f,0.961767614f,0.664873064f,0.397695929f,0.227977514f,0.128978193f,0.0726682767f,0.0408890247f,0.0229979735f,0.0129334899f,0.00727317436f,0.00409003161f,-0.905578375f,0.801513135f,0.965219259f,-0.902817786f,0.67546314f,0.97563988f,0.688157499f,0.413948208f,0.237702623f,0.134552568f,0.0758218244f,0.0426657498f,0.0239976961f,0.0134957815f,0.0075893933f,0.00426785741f,-0.132351756f,0.996909976f,0.998663187f,-0.964648306f,0.598472118f,0.986427724f,0.710753918f,0.430069596f,0.247403964f,0.140122697f,0.0789746121f,0.0444423407f,0.0249973964f,0.0140580693f,0.00790561177f,0.00444568414f,0.76255846f,0.885276794f,0.933070183f,-0.996054351f,0.515501261f,0.994096994f,0.732639611f,0.446054995f,0.257080555f,0.145688385f,0.0821266174f,0.0462187938f,0.0259970706f,0.0146203535f,0.00822182931f,0.00462350994f,0.956375957f,0.500994205f,0.774945021f,-0.996045172f,0.427379847f,0.99862349f,0.753792703f,0.46189931f,0.266731411f,0.151249468f,0.0852777958f,0.0479951017f,0.0269967206f,0.015182632f,0.00853804592f,0.00480133574f,0.270905793f,-0.0375856608f,0.539968967f,-0.964621305f,0.334988207f,0.999992907f,0.774192095f,0.477597594f,0.276355654f,0.156805754f,0.0884281173f,0.049771253f,0.0279963426f,0.0157449059f,0.0088542616f,0.00497916201f,-0.663633883f,-0.564589798f,0.251445323f,-0.902773678f,0.239249229f,0.998200953f,0.793817401f,0.49314484f,0.28595221f,0.162357092f,0.0915775672f,0.0515472479f,0.0289959367f,0.0163071752f,0.00917047635f,0.00515698735f,-0.988031626f,-0.917709649f,-0.0620148405f,-0.812452853f,0.141120002f,0.993253171f,0.812648892f,0.5085361f,0.295520186f,0.167903304f,0.0947260931f,0.0533230826f,0.029995501f,0.0168694388f,0.00948669016f,0.00533481315f,-0.404037654f,-0.988192797f,-0.369325012f,-0.696507812f,0.0415805206f,0.985165298f,0.830667794f,0.523766637f,0.305058628f,0.173444211f,0.0978736654f,0.055098746f,0.0309950355f,0.0174316969f,0.00980290305f,0.00551263802f,0.551426709f,-0.754330218f,-0.640009403f,-0.5585953f,-0.0583741926f,0.973962843f,0.847856104f,0.538831532f,0.314566553f,0.17897962f,0.101020269f,0.0568742342f,0.0319945402f,0.0179939512f,0.0101191159f,0.00569046335f,0.999911845f,-0.28814739f,-0.847224355f,-0.403064936f,-0.157745644f,0.959681332f,0.864196658f,0.553726017f,0.324043006f,0.184509367f,0.10416586f,0.0586495437f,0.0329940096f,0.0185561981f,0.010435327f,0.00586828869f,0.529082716f,0.266779721f,-0.97042042f,-0.234822124f,-0.255541205f,0.942365825f,0.879673064f,0.568445385f,0.333487093f,0.190033287f,0.107310407f,0.0604246669f,0.0339934528f,0.0191184394f,0.010751537f,0.00604611309f,-0.428182662f,0.739542127f,-0.997380435f,-0.0591726787f,-0.350783229f,0.92207104f,0.894269884f,0.582984984f,0.342897803f,0.195551202f,0.110453881f,0.0621996038f,0.034992855f,0.0196806751f,0.0110677453f,0.00622393796f,-0.991778851f,0.984540582f,-0.925431013f,0.118342586f,-0.442520559f,0.89886117f,0.907972515f,0.597340286f,0.352274209f,0.201062918f,0.113596253f,0.0639743358f,0.0359922275f,0.0202429052f,0.0113839535f,0.0064017619f,-0.643538117f,0.926318109f,-0.761706948f,0.292125374f,-0.529836178f,0.872809589f,0.920767248f,0.611506701f,0.361615449f,0.206568271f,0.116737492f,0.0657488778f,0.036991559f,0.0208051261f,0.0117001599f,0.0065795863f,0.296368569f,0.58280617f,-0.522444785f,0.456694692f,-0.611857831f,0.84399873f,0.932641268f,0.625479698f,0.370920479f,0.212067112f,0.119877554f,0.0675232038f,0.0379908569f,0.0213673431f,0.0120163653f,0.00675741071f,0.963795364f,0.0598003156f,-0.231372014f,0.606860459f,-0.687766254f,0.81251961f,0.943582714f,0.639254928f,0.380188406f,0.217559248f,0.123016424f,0.0692973137f,0.0389901139f,0.0219295528f,0.0123325698f,0.00693523418f,0.745113134f,-0.481621295f,0.0826458037f,0.737885714f,-0.756802499f,0.778471708f,0.953580678f,0.652827978f,0.389418334f,0.223044485f,0.126154065f,0.0710712075f,0.0399893373f,0.0224917568f,0.0126487734f,0.00711305765f,-0.158622667f,-0.874714017f,0.388467699f,0.845638454f,-0.818277061f,0.74196279f,0.962625206f,0.666194677f,0.39860931f,0.228522688f,0.129290432f,0.0728448778f,0.0409885161f,0.0230539497f,0.0129649751f,0.00729088066f,-0.916521549f,-0.998410463f,0.655764699f,0.926720202f,-0.871575892f,0.703108132f,0.970707119f,0.679350674f,0.407760441f,0.233993664f,0.132425532f,0.0746183172f,0.0419876575f,0.0236161388f,0.0132811759f,0.00746870413f,-0.831774771f,-0.814614236f,0.858030677f,0.97857362f,-0.916166008f,0.662030637f,0.977818429f,0.692291796f,0.416870773f,0.23945722f,0.135559291f,0.0763915181f,0.0429867506f,0.0241783205f,0.0135973748f,0.00764652714f,0.0177019257f,-0.37993139f,0.975206196f,0.999563396f,-0.951602101f,0.618860185f,0.983951986f,0.70501405f,0.425939471f,0.244913206f,0.138691694f,0.0781644881f,0.0439858064f,0.0247404929f,0.0139135728f,0.00782434922f,0.850903511f,0.171763569f,0.995670974f,0.989027262f,-0.977530122f,0.57373327f,0.989101648f,0.717513323f,0.434965521f,0.250361472f,0.141822711f,0.0799371973f,0.0449848175f,0.0253026579f,0.0142297689f,0.00800217129f,0.901788354f,0.670557022f,0.917395473f,0.947297752f,-0.993690968f,0.526792526f,0.993262351f,0.72978574f,0.44394809f,0.255801797f,0.144952312f,0.0817096606f,0.0459837839f,0.0258648153f,0.0145459641f,0.0081799943f,0.123573124f,0.962832689f,0.748142362f,0.875690997f,-0.999923289f,0.478186339f,0.996429801f,0.741827428f,0.452886283f,0.261234075f,0.148080453f,0.0834818557f,0.0469827019f,0.0264269635f,0.0148621574f,0.00835781638f,-0.768254638f,0.958573103f,0.504697084f,0.776465356f,-0.99616462f,0.428068399f,0.99860096f,0.753634512f,0.461779177f,0.266658038f,0.151207119f,0.0852537975f,0.0479815714f,0.0269891042f,0.0151783489f,0.00853563752f,-0.953752637f,0.659090102f,0.211200655f,0.652750373f,-0.982452571f,0.376597136f,0.999773562f,0.765203178f,0.470625877f,0.272073567f,0.15433228f,0.087025471f,0.0489803962f,0.0275512375f,0.0154945394f,0.0087134596f,-0.262374848f,0.156619072f,-0.10324046f,0.508447945f,-0.958924294f,0.32393527f,0.999946535f,0.776529968f,0.47942555f,0.277480543f,0.157455891f,0.0887968615f,0.0499791689f,0.0281133596f,0.0158107281f,0.00889127981f,0.670229197f,-0.394086063f,-0.407444149f,0.3481085f,-0.925814748f,0.270249337f,0.99911958f,0.787611187f,0.48817724f,0.282878697f,0.160577938f,0.0905679762f,0.0509778969f,0.0286754742f,0.0161269177f,0.00906910095f,0.986627579f,-0.823421597f,-0.671240151f,0.176790684f,-0.883454502f,0.215709001f,0.997293651f,0.798443377f,0.496880114f,0.28826794f,0.163698375f,0.0923388004f,0.051976569f,0.0292375814f,0.0164431017f,0.00924692024f,0.395925164f,-0.999157965f,-0.868469954f,-0.000103020677f,-0.832267344f,0.160486728f,0.994470477f,0.809023023f,0.505533338f,0.293648034f,0.166817173f,0.0941093415f,0.0529751927f,0.0297996756f,0.0167592876f,0.00942474138f,-0.558789074f,-0.867171526f,-0.979574919f,-0.176993474f,-0.772764444f,0.104756832f,0.990652919f,0.819346905f,0.514135957f,0.29901889f,0.169934288f,0.0958795771f,0.0539737605f,0.0303617641f,0.0170754679f,0.00960256159f,-0.999755144f,-0.468111664f,-0.993535519f,-0.348301649f,-0.705540299f,0.0486960001f,0.985844791f,0.829411685f,0.522687256f,0.304380238f,0.173049718f,0.0976495072f,0.0549722798f,0.0309238415f,0.01739165f,0.00978038087f,-0.521551013f,0.0751182064f,-0.908967435f,-0.508624554f,-0.631266713f,-0.00751878507f,0.980050862f,0.839214146f,0.531186223f,0.30973196f,0.17616342f,0.0994191393f,0.0559707358f,0.0314859077f,0.0177078284f,0.00995820016f,0.436164767f,0.595211506f,-0.734258294f,-0.652905703f,-0.550685287f,-0.0637097955f,0.973276973f,0.848751247f,0.539632022f,0.315073937f,0.179275364f,0.101188451f,0.0569691435f,0.0320479684f,0.0180240069f,0.0101360194f,0.992872655f,0.931992829f,-0.486733496f,-0.776594579f,-0.464602023f,-0.119699396f,0.965529919f,0.858020008f,0.548023939f,0.3204059f,0.182385504f,0.102957435f,0.0579674877f,0.0326100141f,0.0183401816f,0.0103138378f,0.636738002f,0.981735826f,-0.190938011f,-0.87579f,-0.373876572f,-0.175310582f,0.956817448f,0.867017388f,0.55636102f,0.325727791f,0.185493827f,0.104726106f,0.0589657798f,0.0331720486f,0.0186563563f,0.0104916561f,-0.304810613f,0.729123712f,0.12379095f,-0.947363734f,-0.279415488f,-0.230367512f,0.947148204f,0.875740528f,0.564642429f,0.33103931f,0.188600287f,0.106494442f,0.0599640086f,0.0337340795f,0.0189725272f,0.0106694745f,-0.966117799f,0.251952261f,0.426245421f,-0.98905772f,-0.182162598f,-0.284696162f,0.936531842f,0.884186864f,0.572867453f,0.336340427f,0.191704854f,0.108262435f,0.0609621815f,0.0342960916f,0.0192886982f,0.0108472919f,-0.739180684f,-0.302812874f,0.686427653f,-0.999557257f,-0.0830891207f,-0.338124752f,0.924979091f,0.892353535f,0.581035137f,0.341630876f,0.194807529f,0.110030092f,0.0619602874f,0.0348580964f,0.0196048655f,0.0110251084f,0.167355701f,-0.764320076f,0.878538549f,-0.978531301f,0.0168140903f,-0.390484393f,0.912501454f,0.900238097f,0.589144766f,0.346910536f,0.197908238f,0.111797392f,0.0629583374f,0.0354200937f,0.0199210308f,0.0112029258f};
#define LAS __attribute__((address_space(3)))
#define XB_TMO      128
#define XB_XCNT(j)  (256  + 64 * (j))
#define XB_XSUB(j)  (1280 + 64 * (j))
#define XB_XGEN(j)  (2304 + 64 * (j))
#define XB_TOP      3328
#define XB_TOPGEN   3392
#define XCD_BAR_WORDS 3456
#define XB_SPIN_CAP (1u << 18)

__device__ __forceinline__ unsigned xb_ld(unsigned* p)              { return __hip_atomic_load(p, __ATOMIC_RELAXED, __HIP_MEMORY_SCOPE_AGENT); }
__device__ __forceinline__ unsigned xb_add(unsigned* p, unsigned v) { return __hip_atomic_fetch_add(p, v, __ATOMIC_RELAXED, __HIP_MEMORY_SCOPE_AGENT); }
__device__ __forceinline__ unsigned xb_xcc_id() { return (unsigned)__builtin_amdgcn_s_getreg((3 << 11) | 20) & 0xFu; }
#define XB_SPIN(cond, bar) do { unsigned _sp = 0; while (cond) { __builtin_amdgcn_s_sleep(1); \
    if ((++_sp & 255u) == 0u) { if (xb_ld(&(bar)[XB_TMO])) break; if (_sp > XB_SPIN_CAP) { atomicAdd(&(bar)[XB_TMO], 1u); break; } } } } while (0)

struct XcdBarrier {
    unsigned* bar; unsigned x;
    volatile LAS unsigned* st;
};

__device__ __forceinline__ XcdBarrier xcd_barrier_post(unsigned* bar, volatile LAS unsigned* st) {
    XcdBarrier b; b.bar = bar; b.x = xb_xcc_id(); b.st = st;
    if (threadIdx.x == 0) (void)xb_add(&bar[XB_XCNT(b.x)], 1u);
    return b;
}
__device__ __forceinline__ void xcd_barrier_complete(unsigned* bar, unsigned x, unsigned& nloc, unsigned& nx) {
    const unsigned G = gridDim.x * gridDim.y * gridDim.z;
    unsigned sum, cnt, mine, sp = 0u;
    for (;;) {
        sum = 0u; cnt = 0u; mine = 0u;
#pragma unroll
        for (unsigned j = 0; j < 16; ++j) { const unsigned c = xb_ld(&bar[XB_XCNT(j)]); sum += c; cnt += (c > 0u) ? 1u : 0u; mine = (j == x) ? c : mine; }
        if (sum == G) break;
        __builtin_amdgcn_s_sleep(1);
        if ((++sp & 255u) == 0u) { if (xb_ld(&bar[XB_TMO])) break; if (sp > XB_SPIN_CAP) { atomicAdd(&bar[XB_TMO], 1u); break; } }
    }
    nloc = mine > 0u ? mine : 1u; nx = cnt > 0u ? cnt : 1u;
}

__device__ __forceinline__ void xcd_barrier(const XcdBarrier& b) {
    asm volatile("s_waitcnt vmcnt(0)" ::: "memory");
    __syncthreads();
    if (threadIdx.x == 0) {
        unsigned* bar = b.bar;
        __builtin_amdgcn_s_waitcnt(0);
        unsigned nloc = b.st[0], nx = b.st[1];
        if (nloc == 0u) { xcd_barrier_complete(bar, b.x, nloc, nx); b.st[0] = nloc; b.st[1] = nx; }
        const unsigned old = xb_add(&bar[XB_XSUB(b.x)], 1u);
        const unsigned gen = old / nloc;
        if (old + 1u == (gen + 1u) * nloc) {
            __builtin_amdgcn_fence(__ATOMIC_RELEASE, "agent");
            asm volatile("s_waitcnt vmcnt(0)" ::: "memory");
            const unsigned og = xb_add(&bar[XB_TOP], 1u);
            const unsigned tg = og / nx;
            if (og + 1u == (tg + 1u) * nx) xb_add(&bar[XB_TOPGEN], 1u);
            else XB_SPIN(xb_ld(&bar[XB_TOPGEN]) == tg, bar);
            __builtin_amdgcn_fence(__ATOMIC_ACQUIRE, "agent");
            xb_add(&bar[XB_XGEN(b.x)], 1u);
            asm volatile("s_waitcnt vmcnt(0)" ::: "memory");
        } else {
            XB_SPIN(xb_ld(&bar[XB_XGEN(b.x)]) == gen, bar);
            __builtin_amdgcn_fence(__ATOMIC_ACQUIRE, "agent");
            asm volatile("s_waitcnt vmcnt(0)" ::: "memory");
        }
    }
    __syncthreads();
}

#define DI __device__ __forceinline__
#define LAS __attribute__((address_space(3)))
typedef unsigned short bf16;
typedef short bf16x8 __attribute__((ext_vector_type(8)));
typedef float f32x4 __attribute__((ext_vector_type(4)));
typedef unsigned u32x4 __attribute__((ext_vector_type(4)));
typedef unsigned u32x2 __attribute__((ext_vector_type(2)));

#ifndef COOP
#define COOP 1
#endif

constexpr int D = 1024, NBATCH = 4, SEQ = 4096, CTXL = 256, NLAT = NBATCH * SEQ, NCTX = NBATCH * CTXL, MT = NLAT + NCTX;
constexpr int FF = 2816, KEYS = SEQ + CTXL;
constexpr int LDP0 = 2560, LDP1 = 3072;
constexpr int C_AQ = 0, C_AK = 512, C_AV = 640, C_BQ = 768, C_BK = 1024, C_BV = 1280, C_BO = 1792, C_RF = 2304, C_RB = 2320;
constexpr float LOG2E = 1.4426950408889634f, EPS = 1e-6f;
constexpr int NCHUNK = 68;

constexpr size_t MiB = 1u << 20;
constexpr size_t WS_CTL = 0, WS_MOD = 1 * MiB, WS_XC = 2 * MiB, WS_WABI = 6 * MiB, WS_WABO = 11 * MiB, WS_WFI = 13 * MiB, WS_WFO = 35 * MiB, WS_WNI = 46 * MiB, WS_WNO = 52 * MiB;
constexpr size_t WS_HO = 54 * MiB, WS_YF = 88 * MiB, WS_P = 122 * MiB, WS_STC = 224 * MiB, WS_DEC = 228 * MiB, WS_END = 229 * MiB;
constexpr int LDS_BYTES = 147456;
constexpr int NWAVES = 8, NTHR = 512;

DI float bf2f(unsigned short h) { return __uint_as_float(((unsigned)h) << 16); }
DI unsigned pk2(float lo, float hi) { return pg8::cvt_pk_bf16(lo, hi); }
DI float wave_sum(float v) {
#pragma unroll
    for (int o = 1; o < 64; o <<= 1) v += __shfl_xor(v, o);
    return v;
}
DI float fast_exp2(float x) { return __builtin_amdgcn_exp2f(x); }
DI float silu_f(float g) { return g * __builtin_amdgcn_rcpf(1.0f + __expf(-g)); }
DI void unpack8(const bf16x8 v, float (&o)[8]) {
#pragma unroll
    for (int i = 0; i < 8; ++i) o[i] = bf2f((unsigned short)v[i]);
}
DI bf16x8 pack8(const float (&p)[8]) {
    u32x4 w; w.x = pk2(p[0], p[1]); w.y = pk2(p[2], p[3]); w.z = pk2(p[4], p[5]); w.w = pk2(p[6], p[7]);
    return __builtin_bit_cast(bf16x8, w);
}
#define MFMA16(a, b, c) __builtin_amdgcn_mfma_f32_16x16x32_bf16((a), (b), (c), 0, 0, 0)

struct EpiStore {
    static constexpr bool PERM = true, AFTER_DRAIN = false;
    bf16* O; int ldc;
    DI void operator()(const pg8::f32x4 (&acc)[2][2][4][2], const pg8::Unit& u, int wr, int wc, int fr, int fq) const {
        const int row0 = u.pm * 256 + wr * 64 + fr, col0 = u.pn * 256 + wc * 32 + 8 * fq;
#pragma unroll
        for (int ai = 0; ai < 2; ++ai)
#pragma unroll
            for (int m = 0; m < 4; ++m) { bf16* rowp = O + (size_t)(row0 + ai * 128 + m * 16) * ldc + col0;
#pragma unroll
                for (int bj = 0; bj < 2; ++bj) { const pg8::f32x4 v0 = acc[ai][bj][m][0], v1 = acc[ai][bj][m][1];
                    u32x4 w; w.x = pk2(v0[0], v0[1]); w.y = pk2(v0[2], v0[3]); w.z = pk2(v1[0], v1[1]); w.w = pk2(v1[2], v1[3]);
                    *(u32x4*)(rowp + bj * 128) = w; } }
    }
};
struct EpiSwiglu {
    static constexpr bool PERM = true, AFTER_DRAIN = false;
    bf16* O; int ldc;
    DI void operator()(const pg8::f32x4 (&acc)[2][2][4][2], const pg8::Unit& u, int wr, int wc, int fr, int fq) const {
        const int row0 = u.pm * 256 + wr * 64 + fr, col0 = u.pn * 128 + wc * 32 + 8 * fq;
#pragma unroll
        for (int ai = 0; ai < 2; ++ai)
#pragma unroll
            for (int m = 0; m < 4; ++m) { bf16* rowp = O + (size_t)(row0 + ai * 128 + m * 16) * ldc + col0;
                const pg8::f32x4 g0 = acc[ai][0][m][0], g1 = acc[ai][0][m][1], u0 = acc[ai][1][m][0], u1 = acc[ai][1][m][1];
                u32x4 w; w.x = pk2(silu_f(g0[0]) * u0[0], silu_f(g0[1]) * u0[1]); w.y = pk2(silu_f(g0[2]) * u0[2], silu_f(g0[3]) * u0[3]);
                w.z = pk2(silu_f(g1[0]) * u1[0], silu_f(g1[1]) * u1[1]); w.w = pk2(silu_f(g1[2]) * u1[2], silu_f(g1[3]) * u1[3]);
                *(u32x4*)rowp = w; }
    }
};

struct Args { const float* in[23]; float* out; unsigned char* ws; int ph_lo, ph_hi; };
enum { I_X = 0, I_C, I_CTX, I_CCTX, I_WMOD, I_BMOD, I_GMPRE, I_GMPOST, I_GFPRE, I_GFPOST, I_WFI, I_WFO, I_ABWI, I_ABWO, I_SINK, I_GFW, I_GFB, I_GBW, I_GBB, I_GNORM, I_NAWI, I_NAWO, I_RELB };

DI void transpose_item(const float* W, int K, int N, bf16* WT, int k0, int n0, int drow0, LAS float* scr, int lane) {
#pragma unroll 8
    for (int i = 0; i < 32; ++i) { const int kk = 2 * i + (lane >> 5); scr[kk * 33 + (lane & 31)] = W[(size_t)(k0 + kk) * N + n0 + (lane & 31)]; }
    asm volatile("s_waitcnt lgkmcnt(0)" ::: "memory");
    const int c = lane & 7;
#pragma unroll
    for (int j = 0; j < 4; ++j) { const int n = (lane >> 3) + 8 * j; const LAS float* s = scr + (8 * c) * 33 + n;
        u32x4 o; o.x = pk2(s[0 * 33], s[1 * 33]); o.y = pk2(s[2 * 33], s[3 * 33]); o.z = pk2(s[4 * 33], s[5 * 33]); o.w = pk2(s[6 * 33], s[7 * 33]);
        *(u32x4*)(WT + (size_t)(drow0 + n) * K + k0 + 8 * c) = o; }
    asm volatile("s_waitcnt lgkmcnt(0)" ::: "memory");
}
DI void xpose_plain(const float* W, int K, int N, bf16* WT, int item, LAS float* scr, int lane) {
    const int nblk = N / 32, kb = item / nblk, nb = item % nblk;
    transpose_item(W, K, N, WT, 64 * kb, 32 * nb, 32 * nb, scr, lane);
}
DI void xpose_ffnin(const float* W, bf16* WT, int item, LAS float* scr, int lane) {
    const int nblk = 5632 / 32, kb = item / nblk, nb = item % nblk, n0 = 32 * nb;
    const int bj = n0 >= FF ? 1 : 0, cc = n0 - bj * FF, drow0 = 256 * (cc >> 7) + 128 * bj + (cc & 127);
    transpose_item(W, 1024, 5632, WT, 64 * kb, n0, drow0, scr, lane);
}

DI void phase_prologue(const Args& a, LAS unsigned char* lds, int tid, int lane, int wave) {
    unsigned char* ws = a.ws;
    {
        LAS float* sl = (LAS float*)lds;
        LAS float* red = (LAS float*)(lds + 32768);
        for (int i = tid; i < 5 * 1024; i += NTHR) { const int s = i >> 10, k = i & 1023; const float v = s < 4 ? a.in[I_C][s * 1024 + k] : a.in[I_CCTX][k]; sl[i] = v / (1.0f + __expf(-v)); }
        __syncthreads();
        for (int u = blockIdx.x; u < 192; u += gridDim.x) {
            const int layer = u / 96, col = (u % 96) * 64 + lane;
            const float* W = a.in[I_WMOD] + (size_t)layer * 1024 * 6144 + col;
            float acc[5] = {0.f, 0.f, 0.f, 0.f, 0.f};
            const int kb = wave * 128;
#pragma unroll 8
            for (int k = 0; k < 128; ++k) { const float w = W[(size_t)(kb + k) * 6144];
#pragma unroll
                for (int s = 0; s < 5; ++s) acc[s] += sl[s * 1024 + kb + k] * w; }
#pragma unroll
            for (int s = 0; s < 5; ++s) red[(wave * 5 + s) * 64 + lane] = acc[s];
            __syncthreads();
            if (tid < 320) { const int s = tid >> 6, l = tid & 63; float t = 0.f;
#pragma unroll
                for (int w = 0; w < 8; ++w) t += red[(w * 5 + s) * 64 + l];
                const int c2 = (u % 96) * 64 + l;
                ((float*)(ws + WS_MOD))[(size_t)(layer * 5 + s) * 6144 + c2] = t + a.in[I_BMOD][layer * 6144 + c2]; }
            __syncthreads();
        }
        __syncthreads();
    }
    LAS float* scr = (LAS float*)(lds + wave * 16384);
    const int gw = blockIdx.x * NWAVES + wave, NGW = gridDim.x * NWAVES;
    constexpr int I_1 = 16 * 73, I_2 = 16 * 32, I_3 = 16 * 176, I_4 = 44 * 32, I_5 = 16 * 96, I_6 = 16 * 32;
    constexpr int NITEMS = I_1 + I_2 + 2 * I_3 + 2 * I_4 + I_5 + I_6;
    for (int it = gw; it < NITEMS; it += NGW) {
        int r = it;
        if (r < I_1) { xpose_plain(a.in[I_ABWI], 1024, 2336, (bf16*)(ws + WS_WABI), r, scr, lane); continue; } r -= I_1;
        if (r < I_2) { xpose_plain(a.in[I_ABWO], 1024, 1024, (bf16*)(ws + WS_WABO), r, scr, lane); continue; } r -= I_2;
        if (r < I_3) { xpose_ffnin(a.in[I_WFI], (bf16*)(ws + WS_WFI), r, scr, lane); continue; } r -= I_3;
        if (r < I_3) { xpose_ffnin(a.in[I_WFI] + (size_t)1024 * 5632, (bf16*)(ws + WS_WFI) + (size_t)5632 * 1024, r, scr, lane); continue; } r -= I_3;
        if (r < I_4) { xpose_plain(a.in[I_WFO], FF, 1024, (bf16*)(ws + WS_WFO), r, scr, lane); continue; } r -= I_4;
        if (r < I_4) { xpose_plain(a.in[I_WFO] + (size_t)FF * 1024, FF, 1024, (bf16*)(ws + WS_WFO) + (size_t)1024 * FF, r, scr, lane); continue; } r -= I_4;
        if (r < I_5) { xpose_plain(a.in[I_NAWI], 1024, 3072, (bf16*)(ws + WS_WNI), r, scr, lane); continue; } r -= I_5;
        xpose_plain(a.in[I_NAWO], 1024, 1024, (bf16*)(ws + WS_WNO), r, scr, lane);
    }
    { u32x4* z = (u32x4*)((bf16*)(ws + WS_WABI) + (size_t)2336 * 1024); const u32x4 zero = {0u, 0u, 0u, 0u};
      for (int i = blockIdx.x * NTHR + tid; i < 224 * 128; i += gridDim.x * NTHR) z[i] = zero; }
}

DI void row_op(const float* xsrc, const bf16* y, const float* gpost, const float* gate, float* xdst,
               const float* gpre, const float* shift, const float* scale, bf16* hdst, int lane) {
    f32x4 v[4];
#pragma unroll
    for (int j = 0; j < 4; ++j) v[j] = *((const f32x4*)xsrc + lane + 64 * j);
    if (y) {
        f32x4 yv[4]; float s = 0.f;
#pragma unroll
        for (int j = 0; j < 4; ++j) { const u32x2 w = *((const u32x2*)y + lane + 64 * j);
            yv[j] = (f32x4){__uint_as_float(w.x << 16), __uint_as_float(w.x & 0xffff0000u), __uint_as_float(w.y << 16), __uint_as_float(w.y & 0xffff0000u)};
            s += (yv[j].x * yv[j].x + yv[j].y * yv[j].y) + (yv[j].z * yv[j].z + yv[j].w * yv[j].w); }
        const float rstd = __builtin_amdgcn_rsqf(wave_sum(s) * (1.0f / D) + EPS);
#pragma unroll
        for (int j = 0; j < 4; ++j) { const f32x4 gp = *((const f32x4*)gpost + lane + 64 * j), gt = *((const f32x4*)gate + lane + 64 * j);
            v[j] = v[j] + gt * (yv[j] * rstd * gp); }
    }
    if (xdst) {
#pragma unroll
        for (int j = 0; j < 4; ++j) *((f32x4*)xdst + lane + 64 * j) = v[j];
    }
    if (hdst) {
        float s = 0.f;
#pragma unroll
        for (int j = 0; j < 4; ++j) s += (v[j].x * v[j].x + v[j].y * v[j].y) + (v[j].z * v[j].z + v[j].w * v[j].w);
        const float rstd = __builtin_amdgcn_rsqf(wave_sum(s) * (1.0f / D) + EPS);
#pragma unroll
        for (int j = 0; j < 4; ++j) { const f32x4 gp = *((const f32x4*)gpre + lane + 64 * j), sh = *((const f32x4*)shift + lane + 64 * j), sc = *((const f32x4*)scale + lane + 64 * j);
            const f32x4 h = v[j] * rstd * gp * (sc + 1.0f) + sh;
            u32x2 w; w.x = pk2(h.x, h.y); w.y = pk2(h.z, h.w);
            *((u32x2*)hdst + lane + 64 * j) = w; }
    }
}
DI void phase_rows(const Args& a, int mode, int layer, int lane, int wave) {
    unsigned char* ws = a.ws;
    const float* MOD = (const float*)(ws + WS_MOD);
    bf16* H = (bf16*)(ws + WS_HO); const bf16* YF = (const bf16*)(ws + WS_YF); float* XC = (float*)(ws + WS_XC);
    const int gw = blockIdx.x * NWAVES + wave, NGW = gridDim.x * NWAVES;
    const int nrows = (layer == 0) ? MT : NLAT;
    for (int m = gw; m < nrows; m += NGW) {
        const bool lat = m < NLAT; const int s = lat ? (m >> 12) : 4;
        const float* mod = MOD + (size_t)(layer * 5 + s) * 6144;
        float* xcur = lat ? a.out + (size_t)m * D : XC + (size_t)(m - NLAT) * D;
        if (mode == 0) {
            const float* xin = lat ? a.in[I_X] + (size_t)m * D : a.in[I_CTX] + (size_t)(m - NLAT) * D;
            row_op(xin, nullptr, nullptr, nullptr, nullptr, a.in[I_GMPRE], mod, mod + 1024, H + (size_t)m * D, lane);
        } else if (mode == 1) {
            const float* xin = (layer == 0) ? (lat ? a.in[I_X] + (size_t)m * D : a.in[I_CTX] + (size_t)(m - NLAT) * D) : xcur;
            row_op(xin, YF + (size_t)m * D, a.in[I_GMPOST] + layer * D, mod + 2048, xcur, a.in[I_GFPRE] + layer * D, mod + 3072, mod + 4096, H + (size_t)m * D, lane);
        } else {
            if (layer == 0) { const float* mod1 = MOD + (size_t)(5 + s) * 6144;
                row_op(xcur, YF + (size_t)m * D, a.in[I_GFPOST], mod + 5120, xcur, a.in[I_GMPRE] + D, mod1, mod1 + 1024, H + (size_t)m * D, lane); }
            else row_op(xcur, YF + (size_t)m * D, a.in[I_GFPOST] + D, mod + 5120, xcur, nullptr, nullptr, nullptr, nullptr, lane);
        }
    }
}

template <int G, int MODE>
DI void attn_tile(f32x4 (&o)[G][4], float (&mrun)[G], float (&lrun)[G], const bf16x8 (&qf)[G][2],
                  const bf16* kp, int kld, const bf16* vp, int vld, float sc2, int d0, unsigned okmask, const float (&bias)[8], int fr, int fq) {
    bf16x8 kf[2][2], vf[4];
#pragma unroll
    for (int h = 0; h < 2; ++h)
#pragma unroll
        for (int ks = 0; ks < 2; ++ks) kf[h][ks] = *(const bf16x8*)(kp + (size_t)((fr >> 2) * 8 + h * 4 + (fr & 3)) * kld + ks * 32 + fq * 8);
#pragma unroll
    for (int nt = 0; nt < 4; ++nt) vf[nt] = *(const bf16x8*)(vp + (size_t)(nt * 16 + fr) * vld + fq * 8);
#pragma unroll
    for (int g = 0; g < G; ++g) {
        f32x4 s0 = {0.f, 0.f, 0.f, 0.f}, s1 = {0.f, 0.f, 0.f, 0.f};
        s0 = MFMA16(kf[0][0], qf[g][0], s0); s0 = MFMA16(kf[0][1], qf[g][1], s0);
        s1 = MFMA16(kf[1][0], qf[g][0], s1); s1 = MFMA16(kf[1][1], qf[g][1], s1);
        float sv[8] = {s0[0], s0[1], s0[2], s0[3], s1[0], s1[1], s1[2], s1[3]};
        float mx = -1e30f;
#pragma unroll
        for (int i = 0; i < 8; ++i) {
            float t = sv[i] * sc2;
            if (MODE == 1) { const int dd = d0 - i; t = (dd >= -128 && dd <= 128) ? t : -1e30f; }
            if (MODE == 2) { t = ((okmask >> i) & 1u) ? t + bias[i] : -1e30f; }
            sv[i] = t; mx = fmaxf(mx, t);
        }
        mx = fmaxf(mx, __shfl_xor(mx, 16)); mx = fmaxf(mx, __shfl_xor(mx, 32));
        const float mn = fmaxf(mrun[g], mx), alpha = fast_exp2(mrun[g] - mn);
        float p[8], ps = 0.f;
#pragma unroll
        for (int i = 0; i < 8; ++i) { p[i] = fast_exp2(sv[i] - mn); ps += p[i]; }
        ps += __shfl_xor(ps, 16); ps += __shfl_xor(ps, 32);
        lrun[g] = lrun[g] * alpha + ps; mrun[g] = mn;
        const bf16x8 pf = pack8(p);
#pragma unroll
        for (int nt = 0; nt < 4; ++nt) { o[g][nt] = o[g][nt] * alpha; o[g][nt] = MFMA16(vf[nt], pf, o[g][nt]); }
    }
}
template <int G>
DI void attn_store(const f32x4 (&o)[G][4], const float (&lrun)[G], bf16* orow  , int fq) {
#pragma unroll
    for (int g = 0; g < G; ++g) { const float inv = 1.0f / lrun[g];
#pragma unroll
        for (int nt = 0; nt < 4; ++nt) { u32x2 w; w.x = pk2(o[g][nt][0] * inv, o[g][nt][1] * inv); w.y = pk2(o[g][nt][2] * inv, o[g][nt][3] * inv);
            *(u32x2*)(orow + g * 64 + nt * 16 + fq * 4) = w; } }
}

DI void window_attn_tile(const Args& a, int wt, int lane) {
    const bf16* P = (const bf16*)(a.ws + WS_P); const bf16* VtA = (const bf16*)(a.ws + WS_YF); bf16* O = (bf16*)(a.ws + WS_HO);
    const int fr = lane & 15, fq = lane >> 4;
    const bool isctx = wt >= 2048;
    int b, kvh, q0; size_t qrow;
    if (!isctx) { b = wt >> 9; kvh = (wt >> 8) & 1; q0 = (wt & 255) * 16; qrow = (size_t)b * SEQ + q0 + fr; }
    else { const int ct = wt - 2048; b = ct >> 5; kvh = (ct >> 4) & 1; q0 = (ct & 15) * 16; qrow = (size_t)NLAT + b * CTXL + q0 + fr; }
    bf16x8 qf[4][2]; f32x4 o[4][4]; float mrun[4], lrun[4];
#pragma unroll
    for (int g = 0; g < 4; ++g) {
#pragma unroll
        for (int ks = 0; ks < 2; ++ks) qf[g][ks] = *(const bf16x8*)(P + qrow * LDP0 + C_AQ + (kvh * 4 + g) * 64 + ks * 32 + fq * 8);
#pragma unroll
        for (int nt = 0; nt < 4; ++nt) o[g][nt] = (f32x4){0.f, 0.f, 0.f, 0.f};
        mrun[g] = a.in[I_SINK][kvh * 4 + g] * LOG2E; lrun[g] = 1.0f;
    }
    const float sc2 = 0.125f * LOG2E;
    const float nob[8] = {0.f, 0.f, 0.f, 0.f, 0.f, 0.f, 0.f, 0.f};
    const bf16* vbase = VtA + (size_t)((b * 2 + kvh) * 64) * KEYS;
    const bf16* kctx = P + (size_t)(NLAT + b * CTXL) * LDP0 + C_AK + kvh * 64;
    for (int t8 = 0; t8 < 8; ++t8)
        attn_tile<4, 0>(o, mrun, lrun, qf, kctx + (size_t)(t8 * 32) * LDP0, LDP0, vbase + SEQ + t8 * 32, KEYS, sc2, 0, 0u, nob, fr, fq);
    if (!isctx) {
        const int tlo = (q0 - 128 > 0 ? q0 - 128 : 0) & ~31, thi = (q0 + 16 + 128 < SEQ) ? q0 + 16 + 128 : SEQ;
        const bf16* kloc = P + (size_t)(b * SEQ) * LDP0 + C_AK + kvh * 64;
        for (int key0 = tlo; key0 < thi; key0 += 32)
            attn_tile<4, 1>(o, mrun, lrun, qf, kloc + (size_t)key0 * LDP0, LDP0, vbase + key0, KEYS, sc2, q0 + fr - key0 - fq * 8, 0u, nob, fr, fq);
    }
    attn_store<4>(o, lrun, O + qrow * D + (kvh * 4) * 64, fq);
}

DI void na_attn_tile(const Args& a, int id, int lane) {
    const bf16* P = (const bf16*)(a.ws + WS_P); const bf16* VtC = (const bf16*)(a.ws + WS_YF); bf16* O = (bf16*)(a.ws + WS_HO);
    const int fr = lane & 15, fq = lane >> 4;
    const int j = id & 3, r = (id >> 2) & 63, h = (id >> 8) & 15, b = id >> 12;
    const size_t qrow = (size_t)b * SEQ + r * 64 + j * 16 + fr;
    bf16x8 qf[1][2]; f32x4 o[1][4]; float mrun[1], lrun[1];
#pragma unroll
    for (int ks = 0; ks < 2; ++ks) qf[0][ks] = *(const bf16x8*)(P + qrow * LDP1 + h * 64 + ks * 32 + fq * 8);
#pragma unroll
    for (int nt = 0; nt < 4; ++nt) o[0][nt] = (f32x4){0.f, 0.f, 0.f, 0.f};
    mrun[0] = -1e30f; lrun[0] = 0.f;
    const float sc2 = 0.125f * LOG2E;
    const float nob[8] = {0.f, 0.f, 0.f, 0.f, 0.f, 0.f, 0.f, 0.f};
    const bf16* vbase = VtC + (size_t)((b * 16 + h) * 64) * KEYS;
    const bf16* kctx = P + (size_t)(NLAT + b * CTXL) * LDP1 + 1024 + h * 64;
    for (int t8 = 0; t8 < 8; ++t8)
        attn_tile<1, 0>(o, mrun, lrun, qf, kctx + (size_t)(t8 * 32) * LDP1, LDP1, vbase + SEQ + t8 * 32, KEYS, sc2, 0, 0u, nob, fr, fq);
    const int rs = r - 4 < 0 ? 0 : (r - 4 > 56 ? 56 : r - 4);
    const int seg_start = j == 0 ? 0 : (j == 1 ? 8 : (j == 2 ? 24 : 32));
    const int qcol = j * 16 + fr; const int cs = qcol - 8 < 0 ? 0 : (qcol - 8 > 48 ? 48 : qcol - 8);
    unsigned okmask = 0u; int coloff[8];
#pragma unroll
    for (int i = 0; i < 8; ++i) { const int keycol = seg_start + fq * 8 + i; if (keycol >= cs && keycol < cs + 16) okmask |= 1u << i;
        int co = keycol - qcol + 15; co = co < 0 ? 0 : (co > 30 ? 30 : co); coloff[i] = co; }
    const float* relb = a.in[I_RELB] + h * 15 * 31;
    const bf16* kloc = P + (size_t)(b * SEQ) * LDP1 + 1024 + h * 64;
    for (int i = 0; i < 8; ++i) {
        const int R = rs + i, key0 = R * 64 + seg_start;
        const float* rb = relb + (R - r + 7) * 31;
        float bias[8];
#pragma unroll
        for (int e = 0; e < 8; ++e) bias[e] = rb[coloff[e]] * LOG2E;
        attn_tile<1, 2>(o, mrun, lrun, qf, kloc + (size_t)key0 * LDP1, LDP1, vbase + key0, KEYS, sc2, 0, okmask, bias, fr, fq);
    }
    attn_store<1>(o, lrun, O + qrow * D + h * 64, fq);
}

DI void vt_unit(const bf16* P, int ldp, int vcol, int nh, bf16* Vt, int unit, LAS unsigned char* scr, int lane) {
    const int kb = unit % 68, bh = unit / 68, h = bh % nh, b = bh / nh;
    const size_t row0 = kb < 64 ? (size_t)b * SEQ + kb * 64 : (size_t)NLAT + b * CTXL + (kb - 64) * 64;
    LAS unsigned short* t = (LAS unsigned short*)scr;
#pragma unroll
    for (int i = 0; i < 8; ++i) { const int key = (lane >> 3) + 8 * i, ch = lane & 7;
        const u32x4 v = *(const u32x4*)(P + (row0 + key) * ldp + vcol + h * 64 + ch * 8);
        *(LAS u32x4*)(t + key * 72 + ch * 8) = v; }
    asm volatile("s_waitcnt lgkmcnt(0)" ::: "memory");
    bf16* dst = Vt + (size_t)(bh * 64 + lane) * KEYS + kb * 64;
#pragma unroll
    for (int g8 = 0; g8 < 8; ++g8) { unsigned short e[8];
#pragma unroll
        for (int i = 0; i < 8; ++i) e[i] = t[(g8 * 8 + i) * 72 + lane];
        u32x4 w; w.x = e[0] | ((unsigned)e[1] << 16); w.y = e[2] | ((unsigned)e[3] << 16); w.z = e[4] | ((unsigned)e[5] << 16); w.w = e[6] | ((unsigned)e[7] << 16);
        *(u32x4*)(dst + g8 * 8) = w; }
    asm volatile("s_waitcnt lgkmcnt(0)" ::: "memory");
}

constexpr int L_GW = 0, L_CUM = 4608, L_A = 21248, L_B = 30464, L_ATT = 39680, L_VT = 48896, L_SSQ = 67328;
DI size_t chunk_row0(int b, int n) { return n < 64 ? (size_t)b * SEQ + n * 64 : (size_t)NLAT + b * CTXL + (n - 64) * 64; }
DI float* st_ptr(const Args& a, int seq, int n) { return n < 64 ? a.out + (size_t)(seq * 64 + n) * 8192 : (float*)(a.ws + WS_STC) + (size_t)(seq * 4 + (n - 64)) * 8192; }

DI void gla_cum(const Args& a, LAS unsigned char* lds, const bf16* P, size_t row0, int h, int dir, int tid) {
    LAS float* gwl = (LAS float*)(lds + L_GW); LAS float* gbl = gwl + 1024; LAS float* cum = (LAS float*)(lds + L_CUM);
    const float* gw = a.in[dir ? I_GBW : I_GFW]; const float* gb = a.in[dir ? I_GBB : I_GFB];
    for (int i = tid; i < 1024; i += NTHR) gwl[i] = gw[(i >> 6) * 256 + h * 64 + (i & 63)];
    if (tid < 64) gbl[tid] = gb[h * 64 + tid];
    __syncthreads();
    const int c = tid >> 3, dg = tid & 7;
    float rf[16];
    { const bf16* rp = P + (row0 + c) * LDP0 + (dir ? C_RB : C_RF);
      float t0[8], t1[8]; unpack8(*(const bf16x8*)rp, t0); unpack8(*(const bf16x8*)(rp + 8), t1);
#pragma unroll
      for (int i = 0; i < 8; ++i) { rf[i] = t0[i]; rf[8 + i] = t1[i]; } }
#pragma unroll
    for (int dd = 0; dd < 8; ++dd) { const int d = dg * 8 + dd; float x = gbl[d];
#pragma unroll
        for (int rr = 0; rr < 16; ++rr) x += rf[rr] * gwl[rr * 64 + d];
        const float ls = fminf(x, 0.f) - log1pf(__expf(-fabsf(x)));
        cum[c * 65 + d] = ls * (1.0f / 16.0f); }
    __syncthreads();
    if (tid < 64) { float run = 0.f;
        if (dir == 0) { for (int cc = 0; cc < 64; ++cc) { run += cum[cc * 65 + tid]; cum[cc * 65 + tid] = run; } }
        else { for (int cc = 63; cc >= 0; --cc) { run += cum[cc * 65 + tid]; cum[cc * 65 + tid] = run; } } }
    __syncthreads();
}
DI void gla_load_vt(LAS unsigned char* lds, const bf16* P, size_t row0, int h, int tid) {
    LAS unsigned short* vT = (LAS unsigned short*)(lds + L_VT);
    const int c = tid >> 3, dg = tid & 7;
    const bf16* vp = P + (row0 + c) * LDP0 + C_BV + h * 128 + dg * 16;
    const bf16x8 v0 = *(const bf16x8*)vp, v1 = *(const bf16x8*)(vp + 8);
#pragma unroll
    for (int e = 0; e < 8; ++e) { vT[(dg * 16 + e) * 72 + c] = (unsigned short)v0[e]; vT[(dg * 16 + 8 + e) * 72 + c] = (unsigned short)v1[e]; }
}
DI void gla_g1_unit(const Args& a, LAS unsigned char* lds, int unit, int tid, int lane, int wave) {
    const bf16* P = (const bf16*)(a.ws + WS_P);
    const int n = unit % NCHUNK, seq = unit / NCHUNK, dir = seq & 1, h = (seq >> 1) & 3, b = seq >> 3;
    const size_t row0 = chunk_row0(b, n);
    gla_cum(a, lds, P, row0, h, dir, tid);
    LAS float* cum = (LAS float*)(lds + L_CUM); LAS unsigned short* kdT = (LAS unsigned short*)(lds + L_A); LAS unsigned short* vT = (LAS unsigned short*)(lds + L_VT);
    const int cend = dir ? 0 : 63;
    { const int c = tid >> 3, dg = tid & 7; float kk[8]; unpack8(*(const bf16x8*)(P + (row0 + c) * LDP0 + C_BK + h * 64 + dg * 8), kk);
#pragma unroll
      for (int dd = 0; dd < 8; ++dd) { const int d = dg * 8 + dd; const float v = kk[dd] * __expf(cum[cend * 65 + d] - cum[c * 65 + d]); kdT[d * 72 + c] = (unsigned short)(pk2(v, 0.f) & 0xffffu); } }
    gla_load_vt(lds, P, row0, h, tid);
    if (tid < 64) ((float*)(a.ws + WS_DEC))[(size_t)(seq * NCHUNK + n) * 64 + tid] = __expf(cum[cend * 65 + tid]);
    __syncthreads();
    const int fr = lane & 15, fq = lane >> 4;
    bf16x8 av[2];
#pragma unroll
    for (int ks = 0; ks < 2; ++ks) av[ks] = *(const LAS bf16x8*)(vT + (wave * 16 + fr) * 72 + ks * 32 + fq * 8);
    float* st = st_ptr(a, seq, n);
#pragma unroll
    for (int nt = 0; nt < 4; ++nt) { f32x4 acc = {0.f, 0.f, 0.f, 0.f};
#pragma unroll
        for (int ks = 0; ks < 2; ++ks) { const bf16x8 bk = *(const LAS bf16x8*)(kdT + (nt * 16 + fr) * 72 + ks * 32 + fq * 8); acc = MFMA16(av[ks], bk, acc); }
#pragma unroll
        for (int r = 0; r < 4; ++r) st[(wave * 16 + fq * 4 + r) * 64 + nt * 16 + fr] = acc[r]; }
    __syncthreads();
}
DI void gla_scan(const Args& a, int tid) {
    const float* DEC = (const float*)(a.ws + WS_DEC);
    for (int e = blockIdx.x * NTHR + tid; e < 32 * 8192; e += gridDim.x * NTHR) {
        const int seq = e >> 13, el = e & 8191, dk = el & 63, dir = seq & 1;
        float S = 0.f;
        for (int s4 = 0; s4 < NCHUNK; s4 += 4) {
            float* p[4]; float t[4], dc[4];
#pragma unroll
            for (int i = 0; i < 4; ++i) { const int step = s4 + i; const int n = dir == 0 ? (step < 4 ? 64 + step : step - 4) : (step < 4 ? 67 - step : 67 - step);
                p[i] = st_ptr(a, seq, n) + el; t[i] = *p[i]; dc[i] = DEC[(size_t)(seq * NCHUNK + n) * 64 + dk]; }
#pragma unroll
            for (int i = 0; i < 4; ++i) { *p[i] = S; S = dc[i] * S + t[i]; }
        }
    }
}
DI void gla_g3_unit(const Args& a, LAS unsigned char* lds, int unit, int tid, int lane, int wave) {
    const bf16* P = (const bf16*)(a.ws + WS_P); bf16* O = (bf16*)(a.ws + WS_HO);
    const int n = unit % NCHUNK, bh = unit / NCHUNK, h = bh & 3, b = bh >> 2;
    const size_t row0 = chunk_row0(b, n);
    LAS float* cum = (LAS float*)(lds + L_CUM); LAS unsigned short* qg = (LAS unsigned short*)(lds + L_A); LAS unsigned short* kg = (LAS unsigned short*)(lds + L_B);
    LAS unsigned short* att = (LAS unsigned short*)(lds + L_ATT); LAS unsigned short* vT = (LAS unsigned short*)(lds + L_VT); LAS float* ssq = (LAS float*)(lds + L_SSQ);
    const int fr = lane & 15, fq = lane >> 4, ct = wave & 3, dvh = wave >> 2;
    gla_load_vt(lds, P, row0, h, tid);
    f32x4 acc[4];
#pragma unroll
    for (int nt = 0; nt < 4; ++nt) acc[nt] = (f32x4){0.f, 0.f, 0.f, 0.f};
    for (int dir = 0; dir < 2; ++dir) {
        gla_cum(a, lds, P, row0, h, dir, tid);
        { const int c = tid >> 3, dg = tid & 7; float qq[8], kk[8], oq[8], ok[8];
          unpack8(*(const bf16x8*)(P + (row0 + c) * LDP0 + C_BQ + h * 64 + dg * 8), qq); unpack8(*(const bf16x8*)(P + (row0 + c) * LDP0 + C_BK + h * 64 + dg * 8), kk);
#pragma unroll
          for (int dd = 0; dd < 8; ++dd) { const float cu = cum[c * 65 + dg * 8 + dd]; oq[dd] = qq[dd] * 0.125f * __expf(cu); ok[dd] = kk[dd] * __expf(-cu); }
          *(LAS bf16x8*)(qg + c * 72 + dg * 8) = pack8(oq); *(LAS bf16x8*)(kg + c * 72 + dg * 8) = pack8(ok); }
        __syncthreads();
        bf16x8 bq[2];
#pragma unroll
        for (int ks = 0; ks < 2; ++ks) bq[ks] = *(const LAS bf16x8*)(qg + (ct * 16 + fr) * 72 + ks * 32 + fq * 8);
#pragma unroll
        for (int si = 0; si < 2; ++si) { const int st = dvh * 2 + si; f32x4 s = {0.f, 0.f, 0.f, 0.f};
#pragma unroll
            for (int ks = 0; ks < 2; ++ks) { const bf16x8 ak = *(const LAS bf16x8*)(kg + (st * 16 + fr) * 72 + ks * 32 + fq * 8); s = MFMA16(ak, bq[ks], s); }
            const int cpos = ct * 16 + fr; float pv[4];
#pragma unroll
            for (int r = 0; r < 4; ++r) { const int spos = st * 16 + fq * 4 + r; const bool keep = dir == 0 ? (spos <= cpos) : (spos >= cpos); pv[r] = keep ? s[r] : 0.f; }
            u32x2 w; w.x = pk2(pv[0], pv[1]); w.y = pk2(pv[2], pv[3]);
            *(LAS u32x2*)(att + cpos * 72 + st * 16 + fq * 4) = w; }
        __syncthreads();
        bf16x8 ba[2];
#pragma unroll
        for (int ks = 0; ks < 2; ++ks) ba[ks] = *(const LAS bf16x8*)(att + (ct * 16 + fr) * 72 + ks * 32 + fq * 8);
        const float* st = st_ptr(a, (bh * 2 + dir), n);
#pragma unroll
        for (int nt = 0; nt < 4; ++nt) { const int dvt = dvh * 4 + nt;
#pragma unroll
            for (int ks = 0; ks < 2; ++ks) {
                const bf16x8 av = *(const LAS bf16x8*)(vT + (dvt * 16 + fr) * 72 + ks * 32 + fq * 8);
                acc[nt] = MFMA16(av, ba[ks], acc[nt]);
                const f32x4 s0 = *(const f32x4*)(st + (dvt * 16 + fr) * 64 + ks * 32 + fq * 8), s1 = *(const f32x4*)(st + (dvt * 16 + fr) * 64 + ks * 32 + fq * 8 + 4);
                const float sf[8] = {s0[0], s0[1], s0[2], s0[3], s1[0], s1[1], s1[2], s1[3]};
                acc[nt] = MFMA16(pack8(sf), bq[ks], acc[nt]); } }
        __syncthreads();
    }
    float sq = 0.f;
#pragma unroll
    for (int nt = 0; nt < 4; ++nt) sq += (acc[nt][0] * acc[nt][0] + acc[nt][1] * acc[nt][1]) + (acc[nt][2] * acc[nt][2] + acc[nt][3] * acc[nt][3]);
    sq += __shfl_xor(sq, 16); sq += __shfl_xor(sq, 32);
    if (fq == 0) ssq[wave * 16 + fr] = sq;
    __syncthreads();
    const float tot = ssq[wave * 16 + fr] + ssq[(wave ^ 4) * 16 + fr];
    const float rstd = __builtin_amdgcn_rsqf(tot * (1.0f / 128.0f) + EPS);
    const size_t row = row0 + ct * 16 + fr;
#pragma unroll
    for (int nt = 0; nt < 4; ++nt) { const int dv0 = (dvh * 4 + nt) * 16 + fq * 4;
        const f32x4 g4 = *(const f32x4*)(a.in[I_GNORM] + h * 128 + dv0);
        const u32x2 bw = *(const u32x2*)(P + row * LDP0 + C_BO + h * 128 + dv0);
        const float g0 = __uint_as_float(bw.x << 16), g1 = __uint_as_float(bw.x & 0xffff0000u), g2 = __uint_as_float(bw.y << 16), g3 = __uint_as_float(bw.y & 0xffff0000u);
        u32x2 w; w.x = pk2(acc[nt][0] * rstd * g4[0] * silu_f(g0), acc[nt][1] * rstd * g4[1] * silu_f(g1));
        w.y = pk2(acc[nt][2] * rstd * g4[2] * silu_f(g2), acc[nt][3] * rstd * g4[3] * silu_f(g3));
        *(u32x2*)(O + row * D + 512 + h * 128 + dv0) = w; }
    __syncthreads();
}

DI void rope_row(bf16* prow, int t, int lane) {
    const int prow_pos = t >> 6, pcol_pos = t & 63;
#pragma unroll
    for (int i = 0; i < 5; ++i) { const int pi = lane + 64 * i, head = pi >> 5, rem = pi & 31, half = rem >> 4, j = rem & 15;
        const int c1 = head * 64 + half * 32 + j, pos = half ? pcol_pos : prow_pos;
        const float cs = ROPE_COS[pos * 16 + j], sn = ROPE_SIN[pos * 16 + j];
        const float u1 = bf2f(prow[c1]), u2 = bf2f(prow[c1 + 16]);
        prow[c1] = (unsigned short)(pk2(u1 * cs - u2 * sn, 0.f) & 0xffffu); prow[c1 + 16] = (unsigned short)(pk2(u2 * cs + u1 * sn, 0.f) & 0xffffu); }
}

constexpr int NPHASE = 19;
#ifndef PROBE_MASK
#define PROBE_MASK 0u
#endif
#define REPS(k) (((PROBE_MASK >> (k)) & 1u) ? 2 : 1)
__global__ void __launch_bounds__(NTHR, 2) fwd_kernel(Args a) {
    extern __shared__ __attribute__((aligned(16))) unsigned char lds_raw[];
    LAS unsigned char* lds = (LAS unsigned char*)lds_raw;
    const int tid = threadIdx.x, lane = tid & 63, wave = __builtin_amdgcn_readfirstlane(tid >> 6);
    const int G = gridDim.x, gw = blockIdx.x * NWAVES + wave, NGW = G * NWAVES;
    unsigned char* ws = a.ws;
    const int lo = a.ph_lo, hi = a.ph_hi;
#define IN(k) (lo <= (k) && (k) < hi)
#ifndef PROBE_SYNC
#define PROBE_SYNC 1
#endif
    volatile LAS unsigned* MISC = (volatile LAS unsigned*)(lds + 131072 + 320);
    if (tid < 32) MISC[tid] = 0u;
    __syncthreads();
    unsigned* barw = (unsigned*)(ws + WS_CTL);
    XcdBarrier xbar; xbar.bar = barw; xbar.x = 0; xbar.st = MISC + 8;
#define SEAM(k) do { if (IN(k) && IN((k) + 1)) { for (int sr_ = 0; sr_ < PROBE_SYNC; ++sr_) { if ((k) == 0) { cg::this_grid().sync(); if (sr_ == 0) xbar = xcd_barrier_post(barw, MISC + 8); } else xcd_barrier(xbar); } } } while (0)
    bf16* H = (bf16*)(ws + WS_HO); bf16* YF = (bf16*)(ws + WS_YF); bf16* P = (bf16*)(ws + WS_P);

    if (IN(0)) { if (blockIdx.x == 0) { for (int i = tid; i < XCD_BAR_WORDS; i += NTHR) barw[i] = 0u; }
        for (int rep = 0; rep < REPS(0); ++rep) { phase_prologue(a, lds, tid, lane, wave); __syncthreads(); } } SEAM(0);
    if (IN(1)) { for (int rep = 0; rep < REPS(1); ++rep) phase_rows(a, 0, 0, lane, wave); } SEAM(1);
    if (IN(2)) { pg8::Gemm g{H, (const bf16*)(ws + WS_WABI), MT, LDP0, D}; pg8::StaticOrder S; S.init(MT, LDP0, G, (int)blockIdx.x);
        EpiStore E{P, LDP0}; pg8::gemm_phase<EpiStore, pg8::StaticOrder, true, true>(lds, g, S, E); if (REPS(2) > 1) { pg8::gemm_phase<EpiStore, pg8::StaticOrder, true, true>(lds, g, S, E); } } SEAM(2);
    if (IN(3)) {
        for (int rep = 0; rep < REPS(3); ++rep) for (int u = blockIdx.x; u < 32 * NCHUNK; u += G) gla_g1_unit(a, lds, u, tid, lane, wave);
        __syncthreads();
        for (int m = gw; m < NLAT; m += NGW) rope_row(P + (size_t)m * LDP0, m & 4095, lane);
        for (int u = gw; u < NBATCH * 2 * 68; u += NGW) vt_unit(P, LDP0, C_AV, 2, YF, u, lds + wave * 16384, lane);
    } SEAM(3);
    if (IN(4)) {
        for (int rep = 0; rep < REPS(4); ++rep) for (int wt = gw; wt < 2176; wt += NGW) window_attn_tile(a, wt, lane);
        gla_scan(a, tid);
    } SEAM(4);
    if (IN(5)) { for (int rep = 0; rep < REPS(5); ++rep) for (int u = blockIdx.x; u < 16 * NCHUNK; u += G) gla_g3_unit(a, lds, u, tid, lane, wave); } SEAM(5);
    if (IN(6)) { pg8::Gemm g{H, (const bf16*)(ws + WS_WABO), MT, D, D}; pg8::StaticOrder S; S.init(MT, D, G, (int)blockIdx.x);
        EpiStore E{YF, D}; pg8::gemm_phase<EpiStore, pg8::StaticOrder, true, true>(lds, g, S, E); if (REPS(6) > 1) { pg8::gemm_phase<EpiStore, pg8::StaticOrder, true, true>(lds, g, S, E); } } SEAM(6);
    if (IN(7)) { for (int rep = 0; rep < REPS(7); ++rep) phase_rows(a, 1, 0, lane, wave); } SEAM(7);
    if (IN(8)) { pg8::Gemm g{H, (const bf16*)(ws + WS_WFI), MT, 2 * FF, D}; pg8::StaticOrder S; S.init(MT, 2 * FF, G, (int)blockIdx.x);
        EpiSwiglu E{P, FF}; pg8::gemm_phase<EpiSwiglu, pg8::StaticOrder, true, true>(lds, g, S, E); if (REPS(8) > 1) { pg8::gemm_phase<EpiSwiglu, pg8::StaticOrder, true, true>(lds, g, S, E); } } SEAM(8);
    if (IN(9)) { pg8::Gemm g{P, (const bf16*)(ws + WS_WFO), MT, D, FF}; pg8::StaticOrder S; S.init(MT, D, G, (int)blockIdx.x);
        EpiStore E{YF, D}; pg8::gemm_phase<EpiStore, pg8::StaticOrder, true, true>(lds, g, S, E); if (REPS(9) > 1) { pg8::gemm_phase<EpiStore, pg8::StaticOrder, true, true>(lds, g, S, E); } } SEAM(9);
    if (IN(10)) { phase_rows(a, 2, 0, lane, wave); } SEAM(10);
    if (IN(11)) { pg8::Gemm g{H, (const bf16*)(ws + WS_WNI), MT, LDP1, D}; pg8::StaticOrder S; S.init(MT, LDP1, G, (int)blockIdx.x);
        EpiStore E{P, LDP1}; pg8::gemm_phase<EpiStore, pg8::StaticOrder, true, true>(lds, g, S, E); if (REPS(11) > 1) { pg8::gemm_phase<EpiStore, pg8::StaticOrder, true, true>(lds, g, S, E); } } SEAM(11);
    if (IN(12)) { for (int rep = 0; rep < REPS(12); ++rep) for (int u = gw; u < NBATCH * 16 * 68; u += NGW) vt_unit(P, LDP1, 2048, 16, YF, u, lds + wave * 16384, lane); } SEAM(12);
    if (IN(13)) { for (int rep = 0; rep < REPS(13); ++rep) for (int i = 0; i < 8; ++i) { const int id = gw * 8 + i; if (id < 16384) na_attn_tile(a, id, lane); }
        for (int id = NGW * 8 + gw; id < 16384; id += NGW) na_attn_tile(a, id, lane); } SEAM(13);
    if (IN(14)) { pg8::Gemm g{H, (const bf16*)(ws + WS_WNO), NLAT, D, D}; pg8::StaticOrder S; S.init(NLAT, D, G, (int)blockIdx.x);
        EpiStore E{YF, D}; pg8::gemm_phase<EpiStore, pg8::StaticOrder, true, true>(lds, g, S, E); if (REPS(14) > 1) { pg8::gemm_phase<EpiStore, pg8::StaticOrder, true, true>(lds, g, S, E); } } SEAM(14);
    if (IN(15)) { phase_rows(a, 1, 1, lane, wave); } SEAM(15);
    if (IN(16)) { pg8::Gemm g{H, (const bf16*)(ws + WS_WFI) + (size_t)5632 * 1024, NLAT, 2 * FF, D}; pg8::StaticOrder S; S.init(NLAT, 2 * FF, G, (int)blockIdx.x);
        EpiSwiglu E{P, FF}; pg8::gemm_phase<EpiSwiglu, pg8::StaticOrder, true, true>(lds, g, S, E); if (REPS(16) > 1) { pg8::gemm_phase<EpiSwiglu, pg8::StaticOrder, true, true>(lds, g, S, E); } } SEAM(16);
    if (IN(17)) { pg8::Gemm g{P, (const bf16*)(ws + WS_WFO) + (size_t)1024 * FF, NLAT, D, FF}; pg8::StaticOrder S; S.init(NLAT, D, G, (int)blockIdx.x);
        EpiStore E{YF, D}; pg8::gemm_phase<EpiStore, pg8::StaticOrder, true, true>(lds, g, S, E); if (REPS(17) > 1) { pg8::gemm_phase<EpiStore, pg8::StaticOrder, true, true>(lds, g, S, E); } } SEAM(17);
    if (IN(18)) { phase_rows(a, 2, 1, lane, wave); }
#undef IN
#undef SEAM
}

extern "C" void kernel_launch(void* const* d_in, const int* in_sizes, int n_in, void* d_out, int out_size, void* d_ws, size_t ws_size, hipStream_t stream) {
    static int grid = 0;
    if (grid == 0) {
        if (n_in != 23 || out_size != NLAT * D || ws_size < WS_END) { fprintf(stderr, "kernel_launch: unexpected problem shape (n_in %d, out %d, ws %zu)\n", n_in, out_size, ws_size); grid = -1; return; }
        int dev = 0, cus = 0, per_cu = 0;
        (void)hipGetDevice(&dev); (void)hipDeviceGetAttribute(&cus, hipDeviceAttributeMultiprocessorCount, dev);
        if (hipFuncSetAttribute((const void*)fwd_kernel, hipFuncAttributeMaxDynamicSharedMemorySize, LDS_BYTES) != hipSuccess) { fprintf(stderr, "kernel_launch: hipFuncSetAttribute failed\n"); grid = -1; return; }
        (void)hipOccupancyMaxActiveBlocksPerMultiprocessor(&per_cu, (const void*)fwd_kernel, NTHR, LDS_BYTES);
        if (per_cu < 1) per_cu = 1;
        (void)hipGetLastError();
        grid = cus * per_cu;
    }
    if (grid < 0) return;
    Args a{};
    for (int i = 0; i < 23; ++i) a.in[i] = (const float*)d_in[i];
    a.out = (float*)d_out; a.ws = (unsigned char*)d_ws;
#if COOP
    a.ph_lo = 0; a.ph_hi = NPHASE;
    void* args[] = {&a};
    hipError_t e = hipLaunchCooperativeKernel((const void*)fwd_kernel, dim3(grid), dim3(NTHR), args, LDS_BYTES, stream);
    if (e != hipSuccess) fprintf(stderr, "cooperative launch failed: %s (grid %d)\n", hipGetErrorString(e), grid);
#else
    for (int p = 0; p < NPHASE; ++p) { a.ph_lo = p; a.ph_hi = p + 1; hipLaunchKernelGGL(fwd_kernel, dim3(grid), dim3(NTHR), LDS_BYTES, stream, a); }
#endif
}
```

```cpp
#include <hip/hip_runtime.h>
#include <hip/hip_cooperative_groups.h>
#include <cstdio>
#include <cstdint>
namespace cg = cooperative_groups;
namespace pg8 {
#define PG8_LAS __attribute__((address_space(3)))
typedef unsigned short bf16_t;
typedef short bf16x8 __attribute__((ext_vector_type(8)));
typedef float f32x4 __attribute__((ext_vector_type(4)));
typedef unsigned u32x4 __attribute__((ext_vector_type(4)));
constexpr int BM = 256, BK = 64, HALF = 128, HTB = HALF * BK * 2  , STAGE_BYTES = 8 * HTB, NXCD = 8, WGM = 8;

__host__ __device__ __forceinline__ int lds_byte(int r, int c) { const int st = (r >> 4) * 2 + (c >> 5), rr = r & 15, cc = c & 31, ob = rr * 64 + cc * 2; return st * 1024 + (ob ^ (((ob >> 9) & 1) << 5)); }
__host__ __device__ __forceinline__ void stage_rc(int b, int& R, int& C) { const int st = b / 1024, sb = b % 1024, swz = sb ^ (((sb >> 9) & 1) << 5); R = (st >> 1) * 16 + swz / 64; C = (st & 1) * 32 + (swz % 64) / 2; }
__host__ __device__ __forceinline__ int perm32(int rho) { const int n = rho >> 4, i = rho & 15; return 8 * (i >> 2) + 4 * n + (i & 3); }

struct Unit { int pm, pn; };
struct Gemm { const bf16_t* A; const bf16_t* Bt; int M, N, K; };

struct StaticOrder {
    int nM, nN, nwg, G, c;
    __host__ __device__ void init(int M, int N, int G_, int c_) { nM = M / BM; nN = N / BM; nwg = nM * nN; G = G_; c = c_; }
    __host__ __device__ bool next(int i, Unit& u) const {
        const long L = (long)i * G + c; if (L >= nwg) return false;
        int wgid = (int)L; { const int q = nwg / NXCD, r = nwg % NXCD, xcd = wgid % NXCD, off = wgid / NXCD; wgid = (xcd < r ? xcd * (q + 1) : r * (q + 1) + (xcd - r) * q) + off; }
        const int nig = WGM * nN, gid = wgid / nig, fm = gid * WGM, gsz = (nM - fm) < WGM ? (nM - fm) : WGM;
        u.pm = fm + ((wgid % nig) % gsz); u.pn = (wgid % nig) / gsz; return true;
    }
    __device__ __forceinline__ void a_ready(const Unit&) const {}
    __device__ __forceinline__ void done(const Unit&) const {}
};

__device__ __forceinline__ unsigned cvt_pk_bf16(float lo, float hi) { unsigned r; asm volatile("v_cvt_pk_bf16_f32 %0, %1, %2" : "=v"(r) : "v"(lo), "v"(hi)); return r; }
template <class Epi, class Sched, bool ALIGN_EPI = false, bool SP2 = false>
__device__ __forceinline__ void gemm_phase(PG8_LAS unsigned char* lds, const Gemm g, const Sched& S, const Epi& E) {
    const int tid = threadIdx.x, wid = __builtin_amdgcn_readfirstlane(tid >> 6), lane = tid & 63, wr = wid >> 2, wc = wid & 3, fr = lane & 15, fq = lane >> 4;
    const int K = g.K, nt = K / BK;
    unsigned voffA[2], voffB[2];
#pragma unroll
    for (int i = 0; i < 2; ++i) { int R, C; stage_rc(tid * 16 + i * 8192, R, C); const int Rb = Epi::PERM ? ((R & ~31) + perm32(R & 31)) : R;
        voffA[i] = (unsigned)(R * K + C) * 2u; voffB[i] = (unsigned)(Rb * K + C) * 2u; }
    const size_t kstep = (size_t)(BK * 2);
    const size_t hstep = (size_t)HALF * K * 2;
    const size_t tstep = 2 * hstep;
    const unsigned ldsw = (unsigned)wid * 1024u;
    const int aoff = lds_byte(wr * 64 + fr, fq * 8), boff = lds_byte(wc * 32 + fr, fq * 8);
#define PG8_SA(b, h) (((b) * 2 + (h)) * HTB)
#define PG8_SB(b, h) ((4 + (b) * 2 + (h)) * HTB)
#define PG8_STAGE(bufoff, gbase, voff) do { _Pragma("unroll") for (int _i = 0; _i < 2; ++_i) \
        __builtin_amdgcn_global_load_lds((const unsigned*)((const char*)(gbase) + (voff)[_i]), (PG8_LAS unsigned*)(lds + (bufoff) + ldsw + _i * 8192), 16, 0, 0); } while (0)
#define PG8_LDA(dst, b, h) do { _Pragma("unroll") for (int m = 0; m < 4; ++m) _Pragma("unroll") for (int k = 0; k < 2; ++k) dst[m][k] = *(const PG8_LAS bf16x8*)(lds + PG8_SA(b, h) + aoff + m * 2048 + k * 1024); } while (0)
#define PG8_LDB(dst, b, h) do { _Pragma("unroll") for (int n = 0; n < 2; ++n) _Pragma("unroll") for (int k = 0; k < 2; ++k) dst[n][k] = *(const PG8_LAS bf16x8*)(lds + PG8_SB(b, h) + boff + n * 2048 + k * 1024); } while (0)
#define PG8_MMA(ai, bj, At, Bt) do { __builtin_amdgcn_s_setprio(1); _Pragma("unroll") for (int m = 0; m < 4; ++m) _Pragma("unroll") for (int n = 0; n < 2; ++n) _Pragma("unroll") for (int k = 0; k < 2; ++k) \
        acc[ai][bj][m][n] = __builtin_amdgcn_mfma_f32_16x16x32_bf16(Bt[n][k], At[m][k], acc[ai][bj][m][n], 0, 0, 0); __builtin_amdgcn_s_setprio(0); } while (0)
#define PG8_WAIT_V(n) asm volatile("s_waitcnt vmcnt(" #n ")" ::: "memory")
#define PG8_WAIT_L(n) asm volatile("s_waitcnt lgkmcnt(" #n ")" ::: "memory")
#define PG8_BAR __builtin_amdgcn_s_barrier()
#define PG8_SCHED __builtin_amdgcn_sched_barrier(0)
    Unit cur, nxt; int ui = 0;
    if (!S.next(0, cur)) return;
    f32x4 acc[2][2][4][2];
#pragma unroll
    for (int a = 0; a < 2; ++a)
#pragma unroll
        for (int b = 0; b < 2; ++b)
#pragma unroll
            for (int m = 0; m < 4; ++m)
#pragma unroll
                for (int n = 0; n < 2; ++n) acc[a][b][m][n] = (f32x4){0.f, 0.f, 0.f, 0.f};
    bf16x8 At[4][2], B0[2][2], B1[2][2];
    const char* cA = (const char*)g.A + (size_t)cur.pm * tstep; const char* cB = (const char*)g.Bt + (size_t)cur.pn * tstep;
    S.a_ready(cur);
    if constexpr (SP2) {
        PG8_STAGE(PG8_SB(0, 0), cB, voffB); PG8_STAGE(PG8_SB(0, 1), cB + hstep, voffB); PG8_STAGE(PG8_SA(0, 0), cA, voffA); PG8_STAGE(PG8_SA(0, 1), cA + hstep, voffA);
        if (wr == 1) PG8_BAR;
        PG8_WAIT_V(2); PG8_BAR;
        PG8_STAGE(PG8_SB(1, 0), cB + kstep, voffB); PG8_STAGE(PG8_SA(1, 0), cA + kstep, voffA); PG8_STAGE(PG8_SB(1, 1), cB + hstep + kstep, voffB);
        PG8_WAIT_V(6); PG8_BAR;
    } else {
        PG8_STAGE(PG8_SB(0, 0), cB, voffB); PG8_STAGE(PG8_SA(0, 0), cA, voffA); PG8_STAGE(PG8_SB(0, 1), cB + hstep, voffB); PG8_STAGE(PG8_SA(0, 1), cA + hstep, voffA);
        if (wr == 1) PG8_BAR;
        PG8_WAIT_V(4); PG8_BAR;
        PG8_STAGE(PG8_SB(1, 0), cB + kstep, voffB); PG8_STAGE(PG8_SA(1, 0), cA + kstep, voffA); PG8_STAGE(PG8_SB(1, 1), cB + hstep + kstep, voffB);
        PG8_WAIT_V(6); PG8_BAR;
    }
    for (;;) {
        const bool has_next = S.next(ui + 1, nxt);
        const char* nA = has_next ? (const char*)g.A + (size_t)nxt.pm * tstep : cA; const char* nB = has_next ? (const char*)g.Bt + (size_t)nxt.pn * tstep : cB;
        for (int t = 0; t < nt; t += 2) {
            const bool last = (t == nt - 2);
            const char* a1 = cA + (size_t)(t + 1) * kstep;
            const char* a2 = last ? nA : cA + (size_t)(t + 2) * kstep; const char* b2 = last ? nB : cB + (size_t)(t + 2) * kstep;
            const char* a3 = a2 + kstep; const char* b3 = b2 + kstep;
            if (last && has_next) S.a_ready(nxt);
            if constexpr (SP2) {
            PG8_LDB(B0, 0, 0); PG8_LDB(B1, 0, 1); PG8_SCHED; PG8_LDA(At, 0, 0); PG8_STAGE(PG8_SA(1, 1), a1 + hstep, voffA);
            PG8_WAIT_V(8); PG8_WAIT_L(0); PG8_BAR; PG8_MMA(0, 0, At, B0); PG8_MMA(0, 1, At, B1); PG8_BAR; PG8_SCHED;
            PG8_LDA(At, 0, 1); PG8_STAGE(PG8_SB(0, 0), b2, voffB); PG8_STAGE(PG8_SB(0, 1), b2 + hstep, voffB); PG8_STAGE(PG8_SA(0, 0), a2, voffA);
            PG8_WAIT_V(8); PG8_WAIT_L(0); PG8_BAR; PG8_MMA(1, 0, At, B0); PG8_MMA(1, 1, At, B1); PG8_BAR; PG8_SCHED;
            PG8_LDB(B0, 1, 0); PG8_LDB(B1, 1, 1); PG8_SCHED; PG8_LDA(At, 1, 0); PG8_STAGE(PG8_SA(0, 1), a2 + hstep, voffA);
            PG8_WAIT_V(8); PG8_WAIT_L(0); PG8_BAR; PG8_MMA(0, 0, At, B0); PG8_MMA(0, 1, At, B1); PG8_BAR; PG8_SCHED;
            PG8_LDA(At, 1, 1); PG8_STAGE(PG8_SB(1, 0), b3, voffB); PG8_STAGE(PG8_SB(1, 1), b3 + hstep, voffB); PG8_STAGE(PG8_SA(1, 0), a3, voffA);
            PG8_WAIT_V(8); PG8_WAIT_L(0); PG8_BAR; PG8_MMA(1, 0, At, B0); PG8_MMA(1, 1, At, B1); PG8_BAR; PG8_SCHED;
            } else {
            PG8_LDB(B0, 0, 0); PG8_SCHED; PG8_LDA(At, 0, 0); PG8_STAGE(PG8_SA(1, 1), a1 + hstep, voffA);
            PG8_WAIT_L(8); PG8_BAR; PG8_WAIT_L(0); PG8_MMA(0, 0, At, B0); PG8_BAR; PG8_SCHED;
            PG8_LDB(B1, 0, 1); PG8_STAGE(PG8_SB(0, 0), b2, voffB);
            PG8_BAR; PG8_WAIT_L(0); PG8_MMA(0, 1, At, B1); PG8_BAR;
            PG8_LDA(At, 0, 1); PG8_STAGE(PG8_SA(0, 0), a2, voffA);
            PG8_BAR; PG8_WAIT_L(0); PG8_MMA(1, 0, At, B0); PG8_BAR; PG8_SCHED;
            PG8_STAGE(PG8_SB(0, 1), b2 + hstep, voffB);
            PG8_WAIT_V(6); PG8_BAR; PG8_MMA(1, 1, At, B1); PG8_BAR;
            PG8_LDB(B0, 1, 0); PG8_SCHED; PG8_LDA(At, 1, 0); PG8_STAGE(PG8_SA(0, 1), a2 + hstep, voffA);
            PG8_WAIT_L(8); PG8_BAR; PG8_WAIT_L(0); PG8_MMA(0, 0, At, B0); PG8_BAR; PG8_SCHED;
            PG8_LDB(B1, 1, 1); PG8_STAGE(PG8_SB(1, 0), b3, voffB);
            PG8_BAR; PG8_WAIT_L(0); PG8_MMA(0, 1, At, B1); PG8_BAR;
            PG8_LDA(At, 1, 1); PG8_STAGE(PG8_SA(1, 0), a3, voffA);
            PG8_BAR; PG8_WAIT_L(0); PG8_MMA(1, 0, At, B0); PG8_BAR; PG8_SCHED;
            PG8_STAGE(PG8_SB(1, 1), b3 + hstep, voffB);
            PG8_WAIT_V(6); PG8_BAR; PG8_MMA(1, 1, At, B1); PG8_BAR;
            }
        }
        if constexpr (ALIGN_EPI) { if (wr == 0) PG8_BAR; }
        if constexpr (!Epi::AFTER_DRAIN) { E(acc, cur, wr, wc, fr, fq); S.done(cur); }
        if (!has_next) break;
#pragma unroll
        for (int a = 0; a < 2; ++a)
#pragma unroll
            for (int b = 0; b < 2; ++b)
#pragma unroll
                for (int m = 0; m < 4; ++m)
#pragma unroll
                    for (int n = 0; n < 2; ++n) acc[a][b][m][n] = (f32x4){0.f, 0.f, 0.f, 0.f};
        cur = nxt; cA = nA; cB = nB; ++ui;
        if constexpr (ALIGN_EPI) { if (wr == 1) PG8_BAR; }
    }
    PG8_WAIT_V(0);
    if constexpr (!ALIGN_EPI) { if (wr == 0) PG8_BAR; }
    PG8_BAR;
    if constexpr (Epi::AFTER_DRAIN) { E.fused(acc, cur, wr, wc, fr, fq, lds, wid, lane); S.done(cur); }
#undef PG8_SA
#undef PG8_SB
#undef PG8_STAGE
#undef PG8_LDA
#undef PG8_LDB
#undef PG8_MMA
#undef PG8_WAIT_V
#undef PG8_WAIT_L
#undef PG8_BAR
#undef PG8_SCHED
}
}
__device__ const float ROPE_COS[1024] = {1.f,1.f,1.f,1.f,1.f,1.f,1.f,1.f,1.f,1.f,1.f,1.f,1.f,1.f,1.f,1.f,0.540302277f,0.846009135f,0.950415254f,0.98423022f,0.995004177f,0.998419285f,0.999500036f,0.999841869f,0.999949992f,0.999984205f,0.999994993f,0.999998391f,0.999999523f,0.999999821f,0.99999994f,1.f,-0.416146845f,0.431462824f,0.806578398f,0.937418282f,0.980066597f,0.993682086f,0.998000681f,0.999367595f,0.999800026f,0.999936759f,0.999979973f,0.999993682f,0.999997973f,0.999999344f,0.999999821f,0.99999994f,-0.989992499f,-0.115966164f,0.582753658f,0.861040652f,0.955336511f,0.985803485f,0.995503366f,0.998577297f,0.999550045f,0.999857724f,0.999954998f,0.999985754f,0.99999553f,0.999998569f,0.999999523f,0.999999881f,-0.653643608f,-0.627679706f,0.301137477f,0.757506192f,0.921060979f,0.974808276f,0.992010653f,0.997471273f,0.999200106f,0.999747038f,0.999920011f,0.999974728f,0.999992013f,0.999997497f,0.999999225f,0.999999762f,0.2836622f,-0.946079254f,-0.0103423381f,0.630080283f,0.87758255f,0.960731268f,0.987526f,0.996049762f,0.998750269f,0.999604762f,0.999875009f,0.999960482f,0.999987483f,0.999996066f,0.999998748f,0.999999583f,0.960170269f,-0.973103702f,-0.3207964f,0.482782036f,0.825335622f,0.943616986f,0.982053936f,0.9943133f,0.998200536f,0.999430835f,0.999819994f,0.999943078f,0.999981999f,0.999994338f,0.999998212f,0.999999404f,0.753902256f,-0.700429797f,-0.599437475f,0.320257008f,0.764842212f,0.923519433f,0.975599885f,0.992262423f,0.997551024f,0.999225318f,0.999755025f,0.999922514f,0.999975502f,0.999992251f,0.999997556f,0.999999225f,-0.145500034f,-0.212036446f,-0.818632424f,0.147631213f,0.696706712f,0.900502324f,0.968170285f,0.989897788f,0.996801734f,0.998988271f,0.999680042f,0.999898791f,0.999967992f,0.999989867f,0.999996781f,0.999998987f,-0.91113025f,0.341660261f,-0.956644177f,-0.0296507962f,0.621609926f,0.874638259f,0.959772646f,0.987220109f,0.995952725f,0.998719573f,0.999595046f,0.99987191f,0.999959528f,0.999987185f,0.999995947f,0.999998748f,-0.839071512f,0.790131867f,-0.999786079f,-0.205997631f,0.540302277f,0.846009135f,0.950415313f,0.98423022f,0.995004177f,0.998419285f,0.999500036f,0.999841869f,0.999949992f,0.999984205f,0.999994993f,0.999998391f,0.00442569796f,0.995257378f,-0.943779767f,-0.375847399f,0.453596085f,0.814705312f,0.940107584f,0.980929136f,0.993956089f,0.998087406f,0.999395072f,0.999808669f,0.999939501f,0.999980867f,0.99999392f,0.999998093f,0.843853951f,0.893861592f,-0.79417938f,-0.53384304f,0.362357706f,0.780825913f,0.92885989f,0.97731787f,0.99280864f,0.997723997f,0.999280095f,0.99977231f,0.999927998f,0.999977231f,0.999992788f,0.999997735f,0.907446802f,0.517172873f,-0.565820515f,-0.675001681f,0.267498761f,0.744477987f,0.916683376f,0.973397553f,0.99156189f,0.997329056f,0.999155104f,0.999732792f,0.999915481f,0.999973297f,0.999991536f,0.999997318f,0.136737213f,-0.0187961515f,-0.28134948f,-0.794870913f,0.16996716f,0.705776393f,0.903590262f,0.969169438f,0.990216017f,0.996902585f,0.999020159f,0.999690115f,0.99990201f,0.999969006f,0.999990225f,0.999996901f,-0.759687901f,-0.548975468f,0.0310223512f,-0.889670432f,0.070737198f,0.6648435f,0.889593601f,0.964634836f,0.988771081f,0.996444523f,0.998875201f,0.999644279f,0.999887526f,0.999964416f,0.999988735f,0.999996424f,-0.957659483f,-0.910081089f,0.340318173f,-0.95641005f,-0.0291995462f,0.621808827f,0.87470746f,0.959795177f,0.987227261f,0.99595499f,0.998720288f,0.999595284f,0.999872029f,0.999959528f,0.999987185f,0.999995947f,-0.275163352f,-0.990897954f,0.615864813f,-0.99298501f,-0.128844544f,0.576808274f,0.858946681f,0.954652011f,0.985584795f,0.995433986f,0.998555362f,0.999543071f,0.999855518f,0.999954283f,0.999985576f,0.99999541f,0.660316706f,-0.766536534f,0.830336154f,-0.998241663f,-0.227202162f,0.529984176f,0.842327058f,0.949207008f,0.983843684f,0.994881511f,0.998380423f,0.999487758f,0.999837995f,0.9999488f,0.999983788f,0.999994874f,0.988704622f,-0.306095392f,0.962463796f,-0.972014248f,-0.323289543f,0.481484592f,0.824865162f,0.943461835f,0.982004225f,0.994297504f,0.998195529f,0.999429286f,0.999819517f,0.999942899f,0.99998194f,0.999994278f,0.408082068f,0.248616725f,0.999144375f,-0.91512996f,-0.416146845f,0.431462824f,0.806578457f,0.937418282f,0.980066597f,0.993682086f,0.998000681f,0.999367595f,0.999800026f,0.999936759f,0.999979973f,0.999993682f,-0.547729254f,0.726760268f,0.936740458f,-0.829382956f,-0.504846215f,0.380077004f,0.787485182f,0.931078374f,0.97803092f,0.993035257f,0.99779582f,0.999302804f,0.999779522f,0.999930263f,0.999977946f,0.999993026f,-0.99996084f,0.981074572f,0.781440377f,-0.717477441f,-0.588501155f,0.327489585f,0.767604589f,0.92444396f,0.975897431f,0.992357016f,0.997581005f,0.999234855f,0.999758005f,0.999923468f,0.999975801f,0.999992371f,-0.53283304f,0.933235765f,0.548645258f,-0.582943261f,-0.666275978f,0.273866832f,0.746956408f,0.917517304f,0.97366637f,0.991647422f,0.997356176f,0.999163687f,0.999735534f,0.999916375f,0.999973536f,0.999991655f,0.424179018f,0.597977161f,0.261441678f,-0.430023283f,-0.737393796f,0.219378278f,0.725561321f,0.910300434f,0.971337974f,0.990906477f,0.997121394f,0.99908942f,0.99971199f,0.999908924f,0.999971211f,0.99999088f,0.991202831f,0.078552261f,-0.0516893305f,-0.263540596f,-0.801143587f,0.164196163f,0.703440726f,0.902795732f,0.968912423f,0.99013412f,0.996876657f,0.999011934f,0.999687493f,0.999901175f,0.999968767f,0.999990106f,0.64691931f,-0.465064496f,-0.359694332f,-0.0887455046f,-0.856888831f,0.108494945f,0.680616796f,0.895005584f,0.966389954f,0.98933053f,0.996621907f,0.998931348f,0.999662042f,0.999893129f,0.999966204f,0.999989331f,-0.292138815f,-0.865450621f,-0.632028639f,0.088848114f,-0.904072165f,0.0524506159f,0.6571123f,0.886932373f,0.963770926f,0.988495648f,0.996357203f,0.998847544f,0.999635518f,0.999884725f,0.999963522f,0.999988496f,-0.962605894f,-0.999293387f,-0.841684937f,0.26363951f,-0.942222297f,-0.00375941908f,0.632950664f,0.878578722f,0.961055458f,0.987629473f,0.996082544f,0.998760641f,0.99960804f,0.999876022f,0.99996078f,0.999987602f,-0.748057544f,-0.825371623f,-0.967871487f,0.430115849f,-0.970958173f,-0.0599575676f,0.608156204f,0.869947195f,0.958243906f,0.986732066f,0.995797932f,0.998670578f,0.999579549f,0.999867022f,0.999957979f,0.999986708f,0.154251456f,-0.397251874f,-0.998075247f,0.583026946f,-0.989992499f,-0.115966164f,0.582753658f,0.861040652f,0.955336511f,0.985803485f,0.995503366f,0.998577297f,0.999550045f,0.999857724f,0.999954998f,0.999985754f,0.914742351f,0.153215483f,-0.929300308f,0.717549205f,-0.999135137f,-0.171608135f,0.556768358f,0.851861775f,0.95233357f,0.984843671f,0.995198846f,0.998480916f,0.999519527f,0.999848068f,0.999951959f,0.999984801f,0.83422339f,0.656495154f,-0.768367112f,0.829440355f,-0.998294771f,-0.226707578f,0.53022635f,0.842413545f,0.949235439f,0.983852804f,0.994884372f,0.998381376f,0.999488056f,0.999838114f,0.9999488f,0.999983788f,-0.0132767474f,0.95758605f,-0.531235278f,0.915171385f,-0.987479806f,-0.281090319f,0.503154159f,0.832698941f,0.946042359f,0.982830763f,0.994559944f,0.998278618f,0.999455571f,0.999827802f,0.999945521f,0.999982774f,-0.848570287f,0.963757515f,-0.241421118f,0.972038329f,-0.966798186f,-0.334584385f,0.475578904f,0.822721004f,0.942754686f,0.981777668f,0.994225562f,0.99817276f,0.999422073f,0.999817252f,0.999942183f,0.999981701f,-0.903692186f,0.673110247f,0.0723346695f,0.998247743f,-0.93645668f,-0.387020677f,0.447528064f,0.812482953f,0.939372718f,0.980693519f,0.993881226f,0.998063743f,0.999387562f,0.999806345f,0.999938726f,0.999980628f,-0.127963692f,0.175156534f,0.378916174f,0.992972851f,-0.896758378f,-0.438233554f,0.419029742f,0.801987886f,0.935896814f,0.979578316f,0.993526995f,0.997951567f,0.999352098f,0.999795079f,0.99993521f,0.999979496f,0.765414059f,-0.376742303f,0.647921681f,0.95638001f,-0.848100007f,-0.488060862f,0.39011243f,0.791239262f,0.93232733f,0.978432178f,0.993162811f,0.997836173f,0.99931556f,0.999783576f,0.999931574f,0.999978364f,0.955073655f,-0.812611222f,0.852673113f,0.889623463f,-0.790967762f,-0.536345184f,0.360805035f,0.780240417f,0.928664625f,0.977255106f,0.992788672f,0.997717679f,0.999278069f,0.999771714f,0.999927819f,0.999977171f,0.266642928f,-0.998210371f,0.972865343f,0.794808388f,-0.72593224f,-0.582933903f,0.331136853f,0.768994927f,0.924909055f,0.976047099f,0.99240464f,0.997596025f,0.999239624f,0.999759495f,0.999923944f,0.999975979f,-0.666938066f,-0.87637943f,0.996578991f,0.674925625f,-0.653643608f,-0.627679706f,0.301137596f,0.757506192f,0.921060979f,0.974808276f,0.992010653f,0.997471273f,0.999200106f,0.999747038f,0.999920011f,0.999974728f,-0.987339258f,-0.484639406f,0.921462357f,0.533756077f,-0.574824035f,-0.670441091f,0.270837069f,0.745777905f,0.917120814f,0.973538578f,0.991606772f,0.997343302f,0.999159634f,0.999734223f,0.999915957f,0.999973416f,-0.399985313f,0.0563609414f,0.754965365f,0.375752151f,-0.490260571f,-0.711082935f,0.240265876f,0.733813822f,0.913088918f,0.972238123f,0.991192937f,0.997212172f,0.999118149f,0.99972111f,0.999911785f,0.999972105f,0.555113316f,0.580003142f,0.513598442f,0.205897167f,-0.400799006f,-0.749476731f,0.209454417f,0.721617639f,0.908965766f,0.970906913f,0.990769207f,0.997077882f,0.999075651f,0.999707639f,0.999907553f,0.999970794f,0.999843299f,0.925014675f,0.221298173f,0.0295478199f,-0.307332784f,-0.785501122f,0.178433523f,0.709193349f,0.904751658f,0.969545007f,0.990335584f,0.996940494f,0.99903214f,0.99969393f,0.999903202f,0.999969363f,0.52532196f,0.985138178f,-0.0929481089f,-0.147732988f,-0.210795805f,-0.819042206f,0.147234216f,0.696544766f,0.90044713f,0.968152404f,0.989892066f,0.996799886f,0.998987675f,0.999679863f,0.999898732f,0.999967992f,-0.432177931f,0.741858006f,-0.397976756f,-0.320354372f,-0.112152621f,-0.849993885f,0.115887694f,0.683675885f,0.89605248f,0.966729224f,0.989438653f,0.996656179f,0.998942196f,0.999665439f,0.999894202f,0.999966562f,-0.992335498f,0.270098448f,-0.663538277f,-0.48287195f,-0.0123883775f,-0.878258407f,0.0844252855f,0.670590878f,0.891568303f,0.965275466f,0.988975346f,0.996509314f,0.998895705f,0.999650776f,0.999889553f,0.999965072f,-0.640144348f,-0.284846604f,-0.863296509f,-0.630159974f,0.0874991715f,-0.903746367f,0.0528784581f,0.657293737f,0.886994898f,0.963791192f,0.988502085f,0.996359289f,0.9988482f,0.999635756f,0.999884784f,0.999963582f,0.300592542f,-0.75206399f,-0.977442741f,-0.757573068f,0.18651247f,-0.926377118f,0.0212787576f,0.643788815f,0.882332861f,0.962276459f,0.98801899f,0.996206105f,0.998799741f,0.999620378f,0.999879956f,0.999962032f,0.964965999f,-0.987659097f,-0.994656444f,-0.861092687f,0.2836622f,-0.946079254f,-0.0103422189f,0.630080283f,0.87758255f,0.960731268f,0.987526f,0.996049762f,0.998750269f,0.999604762f,0.999875009f,0.999960482f,0.742154181f,-0.919073522f,-0.913230121f,-0.937454224f,0.377977669f,-0.96279037f,-0.0419528559f,0.616172493f,0.872744501f,0.959155679f,0.987023175f,0.99589026f,0.998699784f,0.999588788f,0.999869943f,0.999958873f,-0.162990779f,-0.567430019f,-0.741239965f,-0.984248459f,0.468516916f,-0.976457715f,-0.0735215396f,0.602069914f,0.86781919f,0.95754981f,0.986510456f,0.995727658f,0.998648286f,0.999572515f,0.999864817f,0.999957263f,-0.918282807f,-0.0410281904f,-0.495741814f,-1.f,0.554374516f,-0.987038016f,-0.105016708f,0.587776959f,0.862807095f,0.955913603f,0.985987842f,0.995561838f,0.998595834f,0.999555886f,0.999859571f,0.999955595f,-0.829309821f,0.498009592f,-0.201079622f,-0.984212041f,0.634692967f,-0.994497895f,-0.136406869f,0.573298037f,0.857708693f,0.954247177f,0.985455394f,0.995392919f,0.998542368f,0.999538958f,0.999854207f,0.999953866f,0.0221267566f,0.883669317f,0.113521777f,-0.937382519f,0.708669782f,-0.998813629f,-0.167660639f,0.558637917f,0.852524519f,0.95255059f,0.984913111f,0.99522084f,0.99848789f,0.999521732f,0.999848783f,0.999952197f,0.853220105f,0.997174621f,0.416867077f,-0.860988438f,0.775565803f,-0.999971747f,-0.198746875f,0.543801069f,0.847255111f,0.950823903f,0.984360933f,0.995045662f,0.998432398f,0.999504209f,0.99984318f,0.999950409f,0.899866819f,0.803569078f,0.678870201f,-0.757439196f,0.834712923f,-0.997968495f,-0.22963427f,0.528792322f,0.841901004f,0.949067116f,0.983798921f,0.994867265f,0.998375952f,0.999486327f,0.999837577f,0.999948621f,0.119180135f,0.362476677f,0.873550534f,-0.63000071f,0.885519624f,-0.99281019f,-0.260292053f,0.513616323f,0.836462677f,0.947280347f,0.983227074f,0.994685769f,0.998318493f,0.999468148f,0.999831796f,0.999946833f,-0.771080196f,-0.1902491f,0.981602073f,-0.482692331f,0.927478492f,-0.984513164f,-0.290689558f,0.498277903f,0.830940723f,0.945463598f,0.982645452f,0.994501114f,0.998260021f,0.99944967f,0.999825954f,0.999944985f,-0.952412963f,-0.684381902f,0.992308319f,-0.320159167f,0.960170269f,-0.973103702f,-0.3207964f,0.482782036f,0.825335622f,0.943616986f,0.982053936f,0.9943133f,0.998200536f,0.999430835f,0.999819994f,0.999943078f,-0.258101642f,-0.967739642f,0.904607594f,-0.1475292f,0.98326844f,-0.958617806f,-0.350582451f,0.467133403f,0.819648027f,0.941740453f,0.981452644f,0.994122326f,0.998140097f,0.999411702f,0.999813974f,0.99994117f,0.673507154f,-0.953050017f,0.727198064f,0.0297537707f,0.996542096f,-0.941101313f,-0.380017966f,0.451337039f,0.813878477f,0.939834237f,0.980841517f,0.993928254f,0.998078644f,0.999392271f,0.999807835f,0.999939203f,0.985896587f,-0.644837022f,0.477671444f,0.206098333f,0.999858618f,-0.920609534f,-0.409073502f,0.435397953f,0.808027506f,0.937898219f,0.980220556f,0.993731022f,0.998016179f,0.999372482f,0.999801576f,0.999937236f};
__device__ const float ROPE_SIN[1024] = {0.f,0.f,0.f,0.f,0.f,0.f,0.f,0.f,0.f,0.f,0.f,0.f,0.f,0.f,0.f,0.f,0.841470957f,0.533168435f,0.310983598f,0.176892191f,0.0998334214f,0.0562044978f,0.0316175036f,0.0177818574f,0.00999983307f,0.00562338345f,0.00316227227f,0.0017782785f,0.000999999931f,0.000562341243f,0.000316227757f,0.00017782794f,0.909297407f,0.902130723f,0.591127098f,0.348205268f,0.198669329f,0.112231314f,0.0632033944f,0.0355580896f,0.0199986659f,0.011246589f,0.00632451288f,0.00355655141f,0.0019999987f,0.00112468237f,0.000632455456f,0.00035565588f,0.141120002f,0.993253171f,0.812648892f,0.5085361f,0.295520216f,0.167903304f,0.0947260857f,0.0533230826f,0.0299954992f,0.0168694388f,0.00948669016f,0.00533481315f,0.0029999956f,0.00168702309f,0.000948683126f,0.000533483806f,-0.756802499f,0.778471708f,0.953580737f,0.652827978f,0.389418334f,0.223044485f,0.126154065f,0.0710712075f,0.0399893336f,0.0224917568f,0.0126487734f,0.00711305765f,0.00399998948f,0.00224936334f,0.00126491068f,0.000711311703f,-0.958924294f,0.32393527f,0.999946535f,0.776529968f,0.47942555f,0.277480543f,0.157455876f,0.0887968615f,0.0499791652f,0.0281133614f,0.0158107281f,0.00889127981f,0.0049999794f,0.0028117029f,0.00158113812f,0.000889139599f,-0.279415488f,-0.230367512f,0.947148204f,0.875740528f,0.564642489f,0.33103931f,0.188600272f,0.106494442f,0.0599640049f,0.0337340795f,0.0189725272f,0.0106694745f,0.0059999642f,0.00337404152f,0.00189736532f,0.00106696738f,0.656986594f,-0.713721275f,0.800421596f,0.947330713f,0.64421767f,0.383551568f,0.219556093f,0.124158338f,0.0699428469f,0.0393537246f,0.0221341345f,0.0124476347f,0.00699994294f,0.00393637875f,0.00221359241f,0.00124479528f,0.989358246f,-0.977261782f,0.574317753f,0.989042461f,0.717356086f,0.434851229f,0.250292331f,0.141782969f,0.0799146891f,0.0449721329f,0.0252955221f,0.0142257558f,0.0079999147f,0.00449871505f,0.00252981926f,0.00142262306f,0.412118495f,-0.939823508f,0.291259229f,0.999560297f,0.783326924f,0.484776139f,0.280778319f,0.159362778f,0.0898785442f,0.0505891182f,0.0284566563f,0.0160038304f,0.00899987947f,0.00506105041f,0.00284604589f,0.00160045072f,-0.54402113f,-0.612936914f,-0.0206835698f,0.978552461f,0.841470957f,0.533168435f,0.310983568f,0.176892191f,0.099833414f,0.0562044978f,0.0316175036f,0.0177818574f,0.009999834f,0.00562338345f,0.00316227227f,0.0017782785f,-0.999990225f,-0.0972764567f,-0.33057496f,0.926681578f,0.891207397f,0.579875171f,0.340877861f,0.19436565f,0.1097783f,0.0618181042f,0.0347780399f,0.0195598267f,0.0109997792f,0.00618571462f,0.00347849843f,0.00195610616f,-0.536572933f,0.448342979f,-0.60768342f,0.845583618f,0.932039082f,0.624748647f,0.370431304f,0.211777672f,0.119712204f,0.0674297586f,0.0379382223f,0.0213377345f,0.0119997123f,0.0067480444f,0.00379472389f,0.00213393359f,0.420167029f,0.855880976f,-0.824528456f,0.737816215f,0.963558197f,0.667647004f,0.399614304f,0.229122713f,0.129634142f,0.0730392784f,0.0410980321f,0.0231155735f,0.0129996343f,0.00731037185f,0.00411094911f,0.00231176103f,0.990607381f,0.999823332f,-0.959605396f,0.606778562f,0.985449731f,0.708434701f,0.428397775f,0.246395305f,0.139543116f,0.078646481f,0.0442574248f,0.0248933397f,0.0139995432f,0.00787269697f,0.00442717411f,0.00248958869f,0.650287867f,0.835838437f,-0.999518692f,0.456603259f,0.997494996f,0.746982634f,0.456752867f,0.263589978f,0.149438128f,0.0842512026f,0.0474163815f,0.0266710296f,0.0149994381f,0.00843502022f,0.00474339863f,0.00266741589f,-0.287903309f,0.414430231f,-0.940310359f,0.292027086f,0.999573588f,0.783169091f,0.484651238f,0.280701309f,0.159318209f,0.0898532644f,0.0505748577f,0.028448632f,0.015999319f,0.00899733976f,0.00505962269f,0.00284524332f,-0.961397469f,-0.134615138f,-0.78785187f,0.11824052f,0.991664827f,0.81687957f,0.512064993f,0.29772386f,0.169182345f,0.09545248f,0.0537328273f,0.0302261449f,0.0169991814f,0.00955965649f,0.00537584582f,0.00302307028f,-0.750987232f,-0.642200708f,-0.557262897f,-0.0592755191f,0.973847628f,0.84800756f,0.538966715f,0.314652264f,0.179029569f,0.101048686f,0.0568902642f,0.0320035629f,0.0179990288f,0.0101219704f,0.00569206895f,0.00320089748f,0.149877205f,-0.952000856f,-0.271410108f,-0.234921798f,0.946300089f,0.876454532f,0.565329552f,0.331481189f,0.188858896f,0.10664168f,0.060047131f,0.0337808803f,0.0189988576f,0.0106842816f,0.00600829115f,0.00337872445f,0.912945271f,-0.968601942f,0.0413582884f,-0.403158993f,0.909297407f,0.902130723f,0.591127038f,0.348205268f,0.198669314f,0.112231314f,0.0632033944f,0.0355580896f,0.0199986678f,0.011246589f,0.00632451288f,0.00355655141f,0.836655617f,-0.686891198f,0.35002476f,-0.558680534f,0.863209307f,0.924954832f,0.616333544f,0.364819258f,0.208459899f,0.117817394f,0.0663590282f,0.0373351872f,0.0209984574f,0.0118088927f,0.00664073415f,0.00373437814f,-0.00885130931f,-0.193630233f,0.623979926f,-0.696581721f,0.808496356f,0.944854796f,0.640923738f,0.381317884f,0.218229622f,0.123399742f,0.0695140064f,0.0391121693f,0.0219982266f,0.0123711927f,0.00695695449f,0.00391220488f,-0.846220434f,0.359264523f,0.836055279f,-0.812512875f,0.745705247f,0.961767614f,0.664873064f,0.397695929f,0.227977514f,0.128978193f,0.0726682767f,0.0408890247f,0.0229979735f,0.0129334899f,0.00727317436f,0.00409003161f,-0.905578375f,0.801513135f,0.965219259f,-0.902817786f,0.67546314f,0.97563988f,0.688157499f,0.413948208f,0.237702623f,0.134552568f,0.0758218244f,0.0426657498f,0.0239976961f,0.0134957815f,0.0075893933f,0.00426785741f,-0.132351756f,0.996909976f,0.998663187f,-0.964648306f,0.598472118f,0.986427724f,0.710753918f,0.430069596f,0.247403964f,0.140122697f,0.0789746121f,0.0444423407f,0.0249973964f,0.0140580693f,0.00790561177f,0.00444568414f,0.76255846f,0.885276794f,0.933070183f,-0.996054351f,0.515501261f,0.994096994f,0.732639611f,0.446054995f,0.257080555f,0.145688385f,0.0821266174f,0.0462187938f,0.0259970706f,0.0146203535f,0.00822182931f,0.00462350994f,0.956375957f,0.500994205f,0.774945021f,-0.996045172f,0.427379847f,0.99862349f,0.753792703f,0.46189931f,0.266731411f,0.151249468f,0.0852777958f,0.0479951017f,0.0269967206f,0.015182632f,0.00853804592f,0.00480133574f,0.270905793f,-0.0375856608f,0.539968967f,-0.964621305f,0.334988207f,0.999992907f,0.774192095f,0.477597594f,0.276355654f,0.156805754f,0.0884281173f,0.049771253f,0.0279963426f,0.0157449059f,0.0088542616f,0.00497916201f,-0.663633883f,-0.564589798f,0.251445323f,-0.902773678f,0.239249229f,0.998200953f,0.793817401f,0.49314484f,0.28595221f,0.162357092f,0.0915775672f,0.0515472479f,0.0289959367f,0.0163071752f,0.00917047635f,0.00515698735f,-0.988031626f,-0.917709649f,-0.0620148405f,-0.812452853f,0.141120002f,0.993253171f,0.812648892f,0.5085361f,0.295520186f,0.167903304f,0.0947260931f,0.0533230826f,0.029995501f,0.0168694388f,0.00948669016f,0.00533481315f,-0.404037654f,-0.988192797f,-0.369325012f,-0.696507812f,0.0415805206f,0.985165298f,0.830667794f,0.523766637f,0.305058628f,0.173444211f,0.0978736654f,0.055098746f,0.0309950355f,0.0174316969f,0.00980290305f,0.00551263802f,0.551426709f,-0.754330218f,-0.640009403f,-0.5585953f,-0.0583741926f,0.973962843f,0.847856104f,0.538831532f,0.314566553f,0.17897962f,0.101020269f,0.0568742342f,0.0319945402f,0.0179939512f,0.0101191159f,0.00569046335f,0.999911845f,-0.28814739f,-0.847224355f,-0.403064936f,-0.157745644f,0.959681332f,0.864196658f,0.553726017f,0.324043006f,0.184509367f,0.10416586f,0.0586495437f,0.0329940096f,0.0185561981f,0.010435327f,0.00586828869f,0.529082716f,0.266779721f,-0.97042042f,-0.234822124f,-0.255541205f,0.942365825f,0.879673064f,0.568445385f,0.333487093f,0.190033287f,0.107310407f,0.0604246669f,0.0339934528f,0.0191184394f,0.010751537f,0.00604611309f,-0.428182662f,0.739542127f,-0.997380435f,-0.0591726787f,-0.350783229f,0.92207104f,0.894269884f,0.582984984f,0.342897803f,0.195551202f,0.110453881f,0.0621996038f,0.034992855f,0.0196806751f,0.0110677453f,0.00622393796f,-0.991778851f,0.984540582f,-0.925431013f,0.118342586f,-0.442520559f,0.89886117f,0.907972515f,0.597340286f,0.352274209f,0.201062918f,0.113596253f,0.0639743358f,0.0359922275f,0.0202429052f,0.0113839535f,0.0064017619f,-0.643538117f,0.926318109f,-0.761706948f,0.292125374f,-0.529836178f,0.872809589f,0.920767248f,0.611506701f,0.361615449f,0.206568271f,0.116737492f,0.0657488778f,0.036991559f,0.0208051261f,0.0117001599f,0.0065795863f,0.296368569f,0.58280617f,-0.522444785f,0.456694692f,-0.611857831f,0.84399873f,0.932641268f,0.625479698f,0.370920479f,0.212067112f,0.119877554f,0.0675232038f,0.0379908569f,0.0213673431f,0.0120163653f,0.00675741071f,0.963795364f,0.0598003156f,-0.231372014f,0.606860459f,-0.687766254f,0.81251961f,0.943582714f,0.639254928f,0.380188406f,0.217559248f,0.123016424f,0.0692973137f,0.0389901139f,0.0219295528f,0.0123325698f,0.00693523418f,0.745113134f,-0.481621295f,0.0826458037f,0.737885714f,-0.756802499f,0.778471708f,0.953580678f,0.652827978f,0.389418334f,0.223044485f,0.126154065f,0.0710712075f,0.0399893373f,0.0224917568f,0.0126487734f,0.00711305765f,-0.158622667f,-0.874714017f,0.388467699f,0.845638454f,-0.818277061f,0.74196279f,0.962625206f,0.666194677f,0.39860931f,0.228522688f,0.129290432f,0.0728448778f,0.0409885161f,0.0230539497f,0.0129649751f,0.00729088066f,-0.916521549f,-0.998410463f,0.655764699f,0.926720202f,-0.871575892f,0.703108132f,0.970707119f,0.679350674f,0.407760441f,0.233993664f,0.132425532f,0.0746183172f,0.0419876575f,0.0236161388f,0.0132811759f,0.00746870413f,-0.831774771f,-0.814614236f,0.858030677f,0.97857362f,-0.916166008f,0.662030637f,0.977818429f,0.692291796f,0.416870773f,0.23945722f,0.135559291f,0.0763915181f,0.0429867506f,0.0241783205f,0.0135973748f,0.00764652714f,0.0177019257f,-0.37993139f,0.975206196f,0.999563396f,-0.951602101f,0.618860185f,0.983951986f,0.70501405f,0.425939471f,0.244913206f,0.138691694f,0.0781644881f,0.0439858064f,0.0247404929f,0.0139135728f,0.00782434922f,0.850903511f,0.171763569f,0.995670974f,0.989027262f,-0.977530122f,0.57373327f,0.989101648f,0.717513323f,0.434965521f,0.250361472f,0.141822711f,0.0799371973f,0.0449848175f,0.0253026579f,0.0142297689f,0.00800217129f,0.901788354f,0.670557022f,0.917395473f,0.947297752f,-0.993690968f,0.526792526f,0.993262351f,0.72978574f,0.44394809f,0.255801797f,0.144952312f,0.0817096606f,0.0459837839f,0.0258648153f,0.0145459641f,0.0081799943f,0.123573124f,0.962832689f,0.748142362f,0.875690997f,-0.999923289f,0.478186339f,0.996429801f,0.741827428f,0.452886283f,0.261234075f,0.148080453f,0.0834818557f,0.0469827019f,0.0264269635f,0.0148621574f,0.00835781638f,-0.768254638f,0.958573103f,0.504697084f,0.776465356f,-0.99616462f,0.428068399f,0.99860096f,0.753634512f,0.461779177f,0.266658038f,0.151207119f,0.0852537975f,0.0479815714f,0.0269891042f,0.0151783489f,0.00853563752f,-0.953752637f,0.659090102f,0.211200655f,0.652750373f,-0.982452571f,0.376597136f,0.999773562f,0.765203178f,0.470625877f,0.272073567f,0.15433228f,0.087025471f,0.0489803962f,0.0275512375f,0.0154945394f,0.0087134596f,-0.262374848f,0.156619072f,-0.10324046f,0.508447945f,-0.958924294f,0.32393527f,0.999946535f,0.776529968f,0.47942555f,0.277480543f,0.157455891f,0.0887968615f,0.0499791689f,0.0281133596f,0.0158107281f,0.00889127981f,0.670229197f,-0.394086063f,-0.407444149f,0.3481085f,-0.925814748f,0.270249337f,0.99911958f,0.787611187f,0.48817724f,0.282878697f,0.160577938f,0.0905679762f,0.0509778969f,0.0286754742f,0.0161269177f,0.00906910095f,0.986627579f,-0.823421597f,-0.671240151f,0.176790684f,-0.883454502f,0.215709001f,0.997293651f,0.798443377f,0.496880114f,0.28826794f,0.163698375f,0.0923388004f,0.051976569f,0.0292375814f,0.0164431017f,0.00924692024f,0.395925164f,-0.999157965f,-0.868469954f,-0.000103020677f,-0.832267344f,0.160486728f,0.994470477f,0.809023023f,0.505533338f,0.293648034f,0.166817173f,0.0941093415f,0.0529751927f,0.0297996756f,0.0167592876f,0.00942474138f,-0.558789074f,-0.867171526f,-0.979574919f,-0.176993474f,-0.772764444f,0.104756832f,0.990652919f,0.819346905f,0.514135957f,0.29901889f,0.169934288f,0.0958795771f,0.0539737605f,0.0303617641f,0.0170754679f,0.00960256159f,-0.999755144f,-0.468111664f,-0.993535519f,-0.348301649f,-0.705540299f,0.0486960001f,0.985844791f,0.829411685f,0.522687256f,0.304380238f,0.173049718f,0.0976495072f,0.0549722798f,0.0309238415f,0.01739165f,0.00978038087f,-0.521551013f,0.0751182064f,-0.908967435f,-0.508624554f,-0.631266713f,-0.00751878507f,0.980050862f,0.839214146f,0.531186223f,0.30973196f,0.17616342f,0.0994191393f,0.0559707358f,0.0314859077f,0.0177078284f,0.00995820016f,0.436164767f,0.595211506f,-0.734258294f,-0.652905703f,-0.550685287f,-0.0637097955f,0.973276973f,0.848751247f,0.539632022f,0.315073937f,0.179275364f,0.101188451f,0.0569691435f,0.0320479684f,0.0180240069f,0.0101360194f,0.992872655f,0.931992829f,-0.486733496f,-0.776594579f,-0.464602023f,-0.119699396f,0.965529919f,0.858020008f,0.548023939f,0.3204059f,0.182385504f,0.102957435f,0.0579674877f,0.0326100141f,0.0183401816f,0.0103138378f,0.636738002f,0.981735826f,-0.190938011f,-0.87579f,-0.373876572f,-0.175310582f,0.956817448f,0.867017388f,0.55636102f,0.325727791f,0.185493827f,0.104726106f,0.0589657798f,0.0331720486f,0.0186563563f,0.0104916561f,-0.304810613f,0.729123712f,0.12379095f,-0.947363734f,-0.279415488f,-0.230367512f,0.947148204f,0.875740528f,0.564642429f,0.33103931f,0.188600287f,0.106494442f,0.0599640086f,0.0337340795f,0.0189725272f,0.0106694745f,-0.966117799f,0.251952261f,0.426245421f,-0.98905772f,-0.182162598f,-0.284696162f,0.936531842f,0.884186864f,0.572867453f,0.336340427f,0.191704854f,0.108262435f,0.0609621815f,0.0342960916f,0.0192886982f,0.0108472919f,-0.739180684f,-0.302812874f,0.686427653f,-0.999557257f,-0.0830891207f,-0.338124752f,0.924979091f,0.892353535f,0.581035137f,0.341630876f,0.194807529f,0.110030092f,0.0619602874f,0.0348580964f,0.0196048655f,0.0110251084f,0.167355701f,-0.764320076f,0.878538549f,-0.978531301f,0.0168140903f,-0.390484393f,0.912501454f,0.900238097f,0.589144766f,0.346910536f,0.197908238f,0.111797392f,0.0629583374f,0.0354200937f,0.0199210308f,0.0112029258f};
#define LAS __attribute__((address_space(3)))
#define XB_TMO      128
#define XB_XCNT(j)  (256  + 64 * (j))
#define XB_XSUB(j)  (1280 + 64 * (j))
#define XB_XGEN(j)  (2304 + 64 * (j))
#define XB_TOP      3328
#define XB_TOPGEN   3392
#define XCD_BAR_WORDS 3456
#define XB_SPIN_CAP (1u << 18)

__device__ __forceinline__ unsigned xb_ld(unsigned* p)              { return __hip_atomic_load(p, __ATOMIC_RELAXED, __HIP_MEMORY_SCOPE_AGENT); }
__device__ __forceinline__ unsigned xb_add(unsigned* p, unsigned v) { return __hip_atomic_fetch_add(p, v, __ATOMIC_RELAXED, __HIP_MEMORY_SCOPE_AGENT); }
__device__ __forceinline__ unsigned xb_xcc_id() { return (unsigned)__builtin_amdgcn_s_getreg((3 << 11) | 20) & 0xFu; }
#define XB_SPIN(cond, bar) do { unsigned _sp = 0; while (cond) { __builtin_amdgcn_s_sleep(1); \
    if ((++_sp & 255u) == 0u) { if (xb_ld(&(bar)[XB_TMO])) break; if (_sp > XB_SPIN_CAP) { atomicAdd(&(bar)[XB_TMO], 1u); break; } } } } while (0)

struct XcdBarrier {
    unsigned* bar; unsigned x;
    volatile LAS unsigned* st;
};

__device__ __forceinline__ XcdBarrier xcd_barrier_post(unsigned* bar, volatile LAS unsigned* st) {
    XcdBarrier b; b.bar = bar; b.x = xb_xcc_id(); b.st = st;
    if (threadIdx.x == 0) (void)xb_add(&bar[XB_XCNT(b.x)], 1u);
    return b;
}
__device__ __forceinline__ void xcd_barrier_complete(unsigned* bar, unsigned x, unsigned& nloc, unsigned& nx) {
    const unsigned G = gridDim.x * gridDim.y * gridDim.z;
    unsigned sum, cnt, mine, sp = 0u;
    for (;;) {
        sum = 0u; cnt = 0u; mine = 0u;
#pragma unroll
        for (unsigned j = 0; j < 16; ++j) { const unsigned c = xb_ld(&bar[XB_XCNT(j)]); sum += c; cnt += (c > 0u) ? 1u : 0u; mine = (j == x) ? c : mine; }
        if (sum == G) break;
        __builtin_amdgcn_s_sleep(1);
        if ((++sp & 255u) == 0u) { if (xb_ld(&bar[XB_TMO])) break; if (sp > XB_SPIN_CAP) { atomicAdd(&bar[XB_TMO], 1u); break; } }
    }
    nloc = mine > 0u ? mine : 1u; nx = cnt > 0u ? cnt : 1u;
}

__device__ __forceinline__ void xcd_barrier(const XcdBarrier& b) {
    asm volatile("s_waitcnt vmcnt(0)" ::: "memory");
    __syncthreads();
    if (threadIdx.x == 0) {
        unsigned* bar = b.bar;
        __builtin_amdgcn_s_waitcnt(0);
        unsigned nloc = b.st[0], nx = b.st[1];
        if (nloc == 0u) { xcd_barrier_complete(bar, b.x, nloc, nx); b.st[0] = nloc; b.st[1] = nx; }
        const unsigned old = xb_add(&bar[XB_XSUB(b.x)], 1u);
        const unsigned gen = old / nloc;
        if (old + 1u == (gen + 1u) * nloc) {
            __builtin_amdgcn_fence(__ATOMIC_RELEASE, "agent");
            asm volatile("s_waitcnt vmcnt(0)" ::: "memory");
            const unsigned og = xb_add(&bar[XB_TOP], 1u);
            const unsigned tg = og / nx;
            if (og + 1u == (tg + 1u) * nx) xb_add(&bar[XB_TOPGEN], 1u);
            else XB_SPIN(xb_ld(&bar[XB_TOPGEN]) == tg, bar);
            __builtin_amdgcn_fence(__ATOMIC_ACQUIRE, "agent");
            xb_add(&bar[XB_XGEN(b.x)], 1u);
            asm volatile("s_waitcnt vmcnt(0)" ::: "memory");
        } else {
            XB_SPIN(xb_ld(&bar[XB_XGEN(b.x)]) == gen, bar);
            __builtin_amdgcn_fence(__ATOMIC_ACQUIRE, "agent");
            asm volatile("s_waitcnt vmcnt(0)" ::: "memory");
        }
    }
    __syncthreads();
}

#define DI __device__ __forceinline__
#define LAS __attribute__((address_space(3)))
typedef unsigned short bf16;
typedef short bf16x8 __attribute__((ext_vector_type(8)));
typedef float f32x4 __attribute__((ext_vector_type(4)));
typedef unsigned u32x4 __attribute__((ext_vector_type(4)));
typedef unsigned u32x2 __attribute__((ext_vector_type(2)));

#ifndef COOP
#define COOP 1
#endif

constexpr int D = 1024, NBATCH = 4, SEQ = 4096, CTXL = 256, NLAT = NBATCH * SEQ, NCTX = NBATCH * CTXL, MT = NLAT + NCTX;
constexpr int FF = 2816, KEYS = SEQ + CTXL;
constexpr int LDP0 = 2560, LDP1 = 3072;
constexpr int C_AQ = 0, C_AK = 512, C_AV = 640, C_BQ = 768, C_BK = 1024, C_BV = 1280, C_BO = 1792, C_RF = 2304, C_RB = 2320;
constexpr float LOG2E = 1.4426950408889634f, EPS = 1e-6f;
constexpr int NCHUNK = 68;

constexpr size_t MiB = 1u << 20;
constexpr size_t WS_CTL = 0, WS_MOD = 1 * MiB, WS_XC = 2 * MiB, WS_WABI = 6 * MiB, WS_WABO = 11 * MiB, WS_WFI = 13 * MiB, WS_WFO = 35 * MiB, WS_WNI = 46 * MiB, WS_WNO = 52 * MiB;
constexpr size_t WS_HO = 54 * MiB, WS_YF = 88 * MiB, WS_P = 122 * MiB, WS_STC = 224 * MiB, WS_DEC = 228 * MiB, WS_END = 229 * MiB;
constexpr int LDS_BYTES = 147456;
constexpr int NWAVES = 8, NTHR = 512;

DI float bf2f(unsigned short h) { return __uint_as_float(((unsigned)h) << 16); }
DI unsigned pk2(float lo, float hi) { return pg8::cvt_pk_bf16(lo, hi); }
DI float wave_sum(float v) {
#pragma unroll
    for (int o = 1; o < 64; o <<= 1) v += __shfl_xor(v, o);
    return v;
}
DI float fast_exp2(float x) { return __builtin_amdgcn_exp2f(x); }
DI float silu_f(float g) { return g * __builtin_amdgcn_rcpf(1.0f + __expf(-g)); }
DI void unpack8(const bf16x8 v, float (&o)[8]) {
#pragma unroll
    for (int i = 0; i < 8; ++i) o[i] = bf2f((unsigned short)v[i]);
}
DI bf16x8 pack8(const float (&p)[8]) {
    u32x4 w; w.x = pk2(p[0], p[1]); w.y = pk2(p[2], p[3]); w.z = pk2(p[4], p[5]); w.w = pk2(p[6], p[7]);
    return __builtin_bit_cast(bf16x8, w);
}
#define MFMA16(a, b, c) __builtin_amdgcn_mfma_f32_16x16x32_bf16((a), (b), (c), 0, 0, 0)

struct EpiStore {
    static constexpr bool PERM = true, AFTER_DRAIN = false;
    bf16* O; int ldc;
    DI void operator()(const pg8::f32x4 (&acc)[2][2][4][2], const pg8::Unit& u, int wr, int wc, int fr, int fq) const {
        const int row0 = u.pm * 256 + wr * 64 + fr, col0 = u.pn * 256 + wc * 32 + 8 * fq;
#pragma unroll
        for (int ai = 0; ai < 2; ++ai)
#pragma unroll
            for (int m = 0; m < 4; ++m) { bf16* rowp = O + (size_t)(row0 + ai * 128 + m * 16) * ldc + col0;
#pragma unroll
                for (int bj = 0; bj < 2; ++bj) { const pg8::f32x4 v0 = acc[ai][bj][m][0], v1 = acc[ai][bj][m][1];
                    u32x4 w; w.x = pk2(v0[0], v0[1]); w.y = pk2(v0[2], v0[3]); w.z = pk2(v1[0], v1[1]); w.w = pk2(v1[2], v1[3]);
                    *(u32x4*)(rowp + bj * 128) = w; } }
    }
};
struct EpiSwiglu {
    static constexpr bool PERM = true, AFTER_DRAIN = false;
    bf16* O; int ldc;
    DI void operator()(const pg8::f32x4 (&acc)[2][2][4][2], const pg8::Unit& u, int wr, int wc, int fr, int fq) const {
        const int row0 = u.pm * 256 + wr * 64 + fr, col0 = u.pn * 128 + wc * 32 + 8 * fq;
#pragma unroll
        for (int ai = 0; ai < 2; ++ai)
#pragma unroll
            for (int m = 0; m < 4; ++m) { bf16* rowp = O + (size_t)(row0 + ai * 128 + m * 16) * ldc + col0;
                const pg8::f32x4 g0 = acc[ai][0][m][0], g1 = acc[ai][0][m][1], u0 = acc[ai][1][m][0], u1 = acc[ai][1][m][1];
                u32x4 w; w.x = pk2(silu_f(g0[0]) * u0[0], silu_f(g0[1]) * u0[1]); w.y = pk2(silu_f(g0[2]) * u0[2], silu_f(g0[3]) * u0[3]);
                w.z = pk2(silu_f(g1[0]) * u1[0], silu_f(g1[1]) * u1[1]); w.w = pk2(silu_f(g1[2]) * u1[2], silu_f(g1[3]) * u1[3]);
                *(u32x4*)rowp = w; }
    }
};

struct Args { const float* in[23]; float* out; unsigned char* ws; int ph_lo, ph_hi; };
enum { I_X = 0, I_C, I_CTX, I_CCTX, I_WMOD, I_BMOD, I_GMPRE, I_GMPOST, I_GFPRE, I_GFPOST, I_WFI, I_WFO, I_ABWI, I_ABWO, I_SINK, I_GFW, I_GFB, I_GBW, I_GBB, I_GNORM, I_NAWI, I_NAWO, I_RELB };

DI void transpose_item(const float* W, int K, int N, bf16* WT, int k0, int n0, int drow0, LAS float* scr, int lane) {
#pragma unroll 8
    for (int i = 0; i < 32; ++i) { const int kk = 2 * i + (lane >> 5); scr[kk * 33 + (lane & 31)] = W[(size_t)(k0 + kk) * N + n0 + (lane & 31)]; }
    asm volatile("s_waitcnt lgkmcnt(0)" ::: "memory");
    const int c = lane & 7;
#pragma unroll
    for (int j = 0; j < 4; ++j) { const int n = (lane >> 3) + 8 * j; const LAS float* s = scr + (8 * c) * 33 + n;
        u32x4 o; o.x = pk2(s[0 * 33], s[1 * 33]); o.y = pk2(s[2 * 33], s[3 * 33]); o.z = pk2(s[4 * 33], s[5 * 33]); o.w = pk2(s[6 * 33], s[7 * 33]);
        *(u32x4*)(WT + (size_t)(drow0 + n) * K + k0 + 8 * c) = o; }
    asm volatile("s_waitcnt lgkmcnt(0)" ::: "memory");
}
DI void xpose_plain(const float* W, int K, int N, bf16* WT, int item, LAS float* scr, int lane) {
    const int nblk = N / 32, kb = item / nblk, nb = item % nblk;
    transpose_item(W, K, N, WT, 64 * kb, 32 * nb, 32 * nb, scr, lane);
}
DI void xpose_ffnin(const float* W, bf16* WT, int item, LAS float* scr, int lane) {
    const int nblk = 5632 / 32, kb = item / nblk, nb = item % nblk, n0 = 32 * nb;
    const int bj = n0 >= FF ? 1 : 0, cc = n0 - bj * FF, drow0 = 256 * (cc >> 7) + 128 * bj + (cc & 127);
    transpose_item(W, 1024, 5632, WT, 64 * kb, n0, drow0, scr, lane);
}

DI void phase_prologue(const Args& a, LAS unsigned char* lds, int tid, int lane, int wave) {
    unsigned char* ws = a.ws;
    {
        LAS float* sl = (LAS float*)lds;
        LAS float* red = (LAS float*)(lds + 32768);
        for (int i = tid; i < 5 * 1024; i += NTHR) { const int s = i >> 10, k = i & 1023; const float v = s < 4 ? a.in[I_C][s * 1024 + k] : a.in[I_CCTX][k]; sl[i] = v / (1.0f + __expf(-v)); }
        __syncthreads();
        for (int u = blockIdx.x; u < 192; u += gridDim.x) {
            const int layer = u / 96, col = (u % 96) * 64 + lane;
            const float* W = a.in[I_WMOD] + (size_t)layer * 1024 * 6144 + col;
            float acc[5] = {0.f, 0.f, 0.f, 0.f, 0.f};
            const int kb = wave * 128;
#pragma unroll 8
            for (int k = 0; k < 128; ++k) { const float w = W[(size_t)(kb + k) * 6144];
#pragma unroll
                for (int s = 0; s < 5; ++s) acc[s] += sl[s * 1024 + kb + k] * w; }
#pragma unroll
            for (int s = 0; s < 5; ++s) red[(wave * 5 + s) * 64 + lane] = acc[s];
            __syncthreads();
            if (tid < 320) { const int s = tid >> 6, l = tid & 63; float t = 0.f;
#pragma unroll
                for (int w = 0; w < 8; ++w) t += red[(w * 5 + s) * 64 + l];
                const int c2 = (u % 96) * 64 + l;
                ((float*)(ws + WS_MOD))[(size_t)(layer * 5 + s) * 6144 + c2] = t + a.in[I_BMOD][layer * 6144 + c2]; }
            __syncthreads();
        }
        __syncthreads();
    }
    LAS float* scr = (LAS float*)(lds + wave * 16384);
    const int gw = blockIdx.x * NWAVES + wave, NGW = gridDim.x * NWAVES;
    constexpr int I_1 = 16 * 73, I_2 = 16 * 32, I_3 = 16 * 176, I_4 = 44 * 32, I_5 = 16 * 96, I_6 = 16 * 32;
    constexpr int NITEMS = I_1 + I_2 + 2 * I_3 + 2 * I_4 + I_5 + I_6;
    for (int it = gw; it < NITEMS; it += NGW) {
        int r = it;
        if (r < I_1) { xpose_plain(a.in[I_ABWI], 1024, 2336, (bf16*)(ws + WS_WABI), r, scr, lane); continue; } r -= I_1;
        if (r < I_2) { xpose_plain(a.in[I_ABWO], 1024, 1024, (bf16*)(ws + WS_WABO), r, scr, lane); continue; } r -= I_2;
        if (r < I_3) { xpose_ffnin(a.in[I_WFI], (bf16*)(ws + WS_WFI), r, scr, lane); continue; } r -= I_3;
        if (r < I_3) { xpose_ffnin(a.in[I_WFI] + (size_t)1024 * 5632, (bf16*)(ws + WS_WFI) + (size_t)5632 * 1024, r, scr, lane); continue; } r -= I_3;
        if (r < I_4) { xpose_plain(a.in[I_WFO], FF, 1024, (bf16*)(ws + WS_WFO), r, scr, lane); continue; } r -= I_4;
        if (r < I_4) { xpose_plain(a.in[I_WFO] + (size_t)FF * 1024, FF, 1024, (bf16*)(ws + WS_WFO) + (size_t)1024 * FF, r, scr, lane); continue; } r -= I_4;
        if (r < I_5) { xpose_plain(a.in[I_NAWI], 1024, 3072, (bf16*)(ws + WS_WNI), r, scr, lane); continue; } r -= I_5;
        xpose_plain(a.in[I_NAWO], 1024, 1024, (bf16*)(ws + WS_WNO), r, scr, lane);
    }
    { u32x4* z = (u32x4*)((bf16*)(ws + WS_WABI) + (size_t)2336 * 1024); const u32x4 zero = {0u, 0u, 0u, 0u};
      for (int i = blockIdx.x * NTHR + tid; i < 224 * 128; i += gridDim.x * NTHR) z[i] = zero; }
}

DI void row_op(const float* xsrc, const bf16* y, const float* gpost, const float* gate, float* xdst,
               const float* gpre, const float* shift, const float* scale, bf16* hdst, int lane) {
    f32x4 v[4];
#pragma unroll
    for (int j = 0; j < 4; ++j) v[j] = *((const f32x4*)xsrc + lane + 64 * j);
    if (y) {
        f32x4 yv[4]; float s = 0.f;
#pragma unroll
        for (int j = 0; j < 4; ++j) { const u32x2 w = *((const u32x2*)y + lane + 64 * j);
            yv[j] = (f32x4){__uint_as_float(w.x << 16), __uint_as_float(w.x & 0xffff0000u), __uint_as_float(w.y << 16), __uint_as_float(w.y & 0xffff0000u)};
            s += (yv[j].x * yv[j].x + yv[j].y * yv[j].y) + (yv[j].z * yv[j].z + yv[j].w * yv[j].w); }
        const float rstd = __builtin_amdgcn_rsqf(wave_sum(s) * (1.0f / D) + EPS);
#pragma unroll
        for (int j = 0; j < 4; ++j) { const f32x4 gp = *((const f32x4*)gpost + lane + 64 * j), gt = *((const f32x4*)gate + lane + 64 * j);
            v[j] = v[j] + gt * (yv[j] * rstd * gp); }
    }
    if (xdst) {
#pragma unroll
        for (int j = 0; j < 4; ++j) *((f32x4*)xdst + lane + 64 * j) = v[j];
    }
    if (hdst) {
        float s = 0.f;
#pragma unroll
        for (int j = 0; j < 4; ++j) s += (v[j].x * v[j].x + v[j].y * v[j].y) + (v[j].z * v[j].z + v[j].w * v[j].w);
        const float rstd = __builtin_amdgcn_rsqf(wave_sum(s) * (1.0f / D) + EPS);
#pragma unroll
        for (int j = 0; j < 4; ++j) { const f32x4 gp = *((const f32x4*)gpre + lane + 64 * j), sh = *((const f32x4*)shift + lane + 64 * j), sc = *((const f32x4*)scale + lane + 64 * j);
            const f32x4 h = v[j] * rstd * gp * (sc + 1.0f) + sh;
            u32x2 w; w.x = pk2(h.x, h.y); w.y = pk2(h.z, h.w);
            *((u32x2*)hdst + lane + 64 * j) = w; }
    }
}
DI void phase_rows(const Args& a, int mode, int layer, int lane, int wave) {
    unsigned char* ws = a.ws;
    const float* MOD = (const float*)(ws + WS_MOD);
    bf16* H = (bf16*)(ws + WS_HO); const bf16* YF = (const bf16*)(ws + WS_YF); float* XC = (float*)(ws + WS_XC);
    const int gw = blockIdx.x * NWAVES + wave, NGW = gridDim.x * NWAVES;
    const int nrows = (layer == 0) ? MT : NLAT;
    for (int m = gw; m < nrows; m += NGW) {
        const bool lat = m < NLAT; const int s = lat ? (m >> 12) : 4;
        const float* mod = MOD + (size_t)(layer * 5 + s) * 6144;
        float* xcur = lat ? a.out + (size_t)m * D : XC + (size_t)(m - NLAT) * D;
        if (mode == 0) {
            const float* xin = lat ? a.in[I_X] + (size_t)m * D : a.in[I_CTX] + (size_t)(m - NLAT) * D;
            row_op(xin, nullptr, nullptr, nullptr, nullptr, a.in[I_GMPRE], mod, mod + 1024, H + (size_t)m * D, lane);
        } else if (mode == 1) {
            const float* xin = (layer == 0) ? (lat ? a.in[I_X] + (size_t)m * D : a.in[I_CTX] + (size_t)(m - NLAT) * D) : xcur;
            row_op(xin, YF + (size_t)m * D, a.in[I_GMPOST] + layer * D, mod + 2048, xcur, a.in[I_GFPRE] + layer * D, mod + 3072, mod + 4096, H + (size_t)m * D, lane);
        } else {
            if (layer == 0) { const float* mod1 = MOD + (size_t)(5 + s) * 6144;
                row_op(xcur, YF + (size_t)m * D, a.in[I_GFPOST], mod + 5120, xcur, a.in[I_GMPRE] + D, mod1, mod1 + 1024, H + (size_t)m * D, lane); }
            else row_op(xcur, YF + (size_t)m * D, a.in[I_GFPOST] + D, mod + 5120, xcur, nullptr, nullptr, nullptr, nullptr, lane);
        }
    }
}

struct KVFrag { bf16x8 kf[2][2]; bf16x8 vf[4]; };
DI void kv_load(KVFrag& f, const bf16* kp, int kld, const bf16* vp, int vld, int fr, int fq) {
#pragma unroll
    for (int h = 0; h < 2; ++h)
#pragma unroll
        for (int ks = 0; ks < 2; ++ks) f.kf[h][ks] = *(const bf16x8*)(kp + (size_t)((fr >> 2) * 8 + h * 4 + (fr & 3)) * kld + ks * 32 + fq * 8);
#pragma unroll
    for (int nt = 0; nt < 4; ++nt) f.vf[nt] = *(const bf16x8*)(vp + (size_t)(nt * 16 + fr) * vld + fq * 8);
}
template <int MODE>
DI void attn_one(f32x4 (&o)[4], float& mrun, float& lrun, const bf16x8 (&qf)[2], const KVFrag& f, float sc2, int d0, unsigned okmask, const float (&bias)[8]) {
    f32x4 s0 = {0.f, 0.f, 0.f, 0.f}, s1 = {0.f, 0.f, 0.f, 0.f};
    s0 = MFMA16(f.kf[0][0], qf[0], s0); s0 = MFMA16(f.kf[0][1], qf[1], s0);
    s1 = MFMA16(f.kf[1][0], qf[0], s1); s1 = MFMA16(f.kf[1][1], qf[1], s1);
    float sv[8] = {s0[0], s0[1], s0[2], s0[3], s1[0], s1[1], s1[2], s1[3]};
    float mx = -1e30f;
#pragma unroll
    for (int i = 0; i < 8; ++i) {
        float t = sv[i] * sc2;
        if (MODE == 1) { const int dd = d0 - i; t = (dd >= -128 && dd <= 128) ? t : -1e30f; }
        if (MODE == 2) { t = ((okmask >> i) & 1u) ? t + bias[i] : -1e30f; }
        sv[i] = t; mx = fmaxf(mx, t);
    }
    mx = fmaxf(mx, __shfl_xor(mx, 16)); mx = fmaxf(mx, __shfl_xor(mx, 32));
    const float mn = fmaxf(mrun, mx), alpha = fast_exp2(mrun - mn);
    float p[8], ps = 0.f;
#pragma unroll
    for (int i = 0; i < 8; ++i) { p[i] = fast_exp2(sv[i] - mn); ps += p[i]; }
    ps += __shfl_xor(ps, 16); ps += __shfl_xor(ps, 32);
    lrun = lrun * alpha + ps; mrun = mn;
    const bf16x8 pf = pack8(p);
#pragma unroll
    for (int nt = 0; nt < 4; ++nt) { o[nt] = o[nt] * alpha; o[nt] = MFMA16(f.vf[nt], pf, o[nt]); }
}
DI void attn_store1(const f32x4 (&o)[4], float lrun, bf16* op, int fq) {
    const float inv = 1.0f / lrun;
#pragma unroll
    for (int nt = 0; nt < 4; ++nt) { u32x2 w; w.x = pk2(o[nt][0] * inv, o[nt][1] * inv); w.y = pk2(o[nt][2] * inv, o[nt][3] * inv);
        *(u32x2*)(op + nt * 16 + fq * 4) = w; }
}

DI void window_attn_tile(const Args& a, int wt, int lane) {
    const bf16* P = (const bf16*)(a.ws + WS_P); const bf16* VtA = (const bf16*)(a.ws + WS_YF); bf16* O = (bf16*)(a.ws + WS_HO);
    const int fr = lane & 15, fq = lane >> 4;
    const bool isctx = wt >= 2048;
    int b, kvh, q0; size_t qrow;
    if (!isctx) { b = wt >> 9; kvh = (wt >> 8) & 1; q0 = (wt & 255) * 16; qrow = (size_t)b * SEQ + q0 + fr; }
    else { const int ct = wt - 2048; b = ct >> 5; kvh = (ct >> 4) & 1; q0 = (ct & 15) * 16; qrow = (size_t)NLAT + b * CTXL + q0 + fr; }
    bf16x8 qf[4][2]; f32x4 o[4][4]; float mrun[4], lrun[4];
#pragma unroll
    for (int g = 0; g < 4; ++g) {
#pragma unroll
        for (int ks = 0; ks < 2; ++ks) qf[g][ks] = *(const bf16x8*)(P + qrow * LDP0 + C_AQ + (kvh * 4 + g) * 64 + ks * 32 + fq * 8);
#pragma unroll
        for (int nt = 0; nt < 4; ++nt) o[g][nt] = (f32x4){0.f, 0.f, 0.f, 0.f};
        mrun[g] = a.in[I_SINK][kvh * 4 + g] * LOG2E; lrun[g] = 1.0f;
    }
    const float sc2 = 0.125f * LOG2E;
    const float nob[8] = {0.f, 0.f, 0.f, 0.f, 0.f, 0.f, 0.f, 0.f};
    const bf16* vbase = VtA + (size_t)((b * 2 + kvh) * 64) * KEYS;
    const bf16* kctx = P + (size_t)(NLAT + b * CTXL) * LDP0 + C_AK + kvh * 64;
    const bf16* kloc = P + (size_t)(b * SEQ) * LDP0 + C_AK + kvh * 64;
    const int tlo = (q0 - 128 > 0 ? q0 - 128 : 0) & ~31, thi = (q0 + 16 + 128 < SEQ) ? q0 + 16 + 128 : SEQ;
    const int ntile = isctx ? 8 : 8 + (thi - tlo + 31) / 32;
#define WIN_LOAD(F, t) do { const int t_ = (t); if (t_ < 8) kv_load(F, kctx + (size_t)(t_ * 32) * LDP0, LDP0, vbase + SEQ + t_ * 32, KEYS, fr, fq); \
        else { const int k0_ = tlo + (t_ - 8) * 32; kv_load(F, kloc + (size_t)k0_ * LDP0, LDP0, vbase + k0_, KEYS, fr, fq); } } while (0)
#define WIN_PROC(F, t) do { const int t_ = (t); const int d0_ = t_ < 8 ? 0 : q0 + fr - (tlo + (t_ - 8) * 32) - fq * 8; \
        _Pragma("unroll") for (int g = 0; g < 4; ++g) attn_one<1>(o[g], mrun[g], lrun[g], qf[g], F, sc2, d0_, 0u, nob); } while (0)
    KVFrag A, B;
    WIN_LOAD(A, 0);
    for (int t = 0; t < ntile; t += 2) {
        if (t + 1 < ntile) WIN_LOAD(B, t + 1);
        WIN_PROC(A, t);
        if (t + 1 < ntile) { if (t + 2 < ntile) WIN_LOAD(A, t + 2); WIN_PROC(B, t + 1); }
    }
#undef WIN_LOAD
#undef WIN_PROC
#pragma unroll
    for (int g = 0; g < 4; ++g) attn_store1(o[g], lrun[g], O + qrow * D + (kvh * 4 + g) * 64, fq);
}

template <int NR>
DI void na_attn_group(const Args& a, int gid, int lane, LAS float* btab  ) {
    const bf16* P = (const bf16*)(a.ws + WS_P); const bf16* VtC = (const bf16*)(a.ws + WS_YF); bf16* O = (bf16*)(a.ws + WS_HO);
    const int fr = lane & 15, fq = lane >> 4;
    constexpr int NRG = 64 / NR; const int j = gid & 3, r0 = ((gid >> 2) % NRG) * NR, h = ((gid >> 2) / NRG) & 15, b = (gid >> 2) / (NRG * 16);
    { const float* relb = a.in[I_RELB] + h * 465;
      for (int i = lane; i < 465; i += 64) btab[i] = relb[i] * LOG2E;
      asm volatile("s_waitcnt vmcnt(0) lgkmcnt(0)" ::: "memory"); }
    bf16x8 qf[NR][2]; f32x4 o[NR][4]; float mrun[NR], lrun[NR];
#pragma unroll
    for (int qi = 0; qi < NR; ++qi) { const size_t qrow = (size_t)b * SEQ + (r0 + qi) * 64 + j * 16 + fr;
#pragma unroll
        for (int ks = 0; ks < 2; ++ks) qf[qi][ks] = *(const bf16x8*)(P + qrow * LDP1 + h * 64 + ks * 32 + fq * 8);
#pragma unroll
        for (int nt = 0; nt < 4; ++nt) o[qi][nt] = (f32x4){0.f, 0.f, 0.f, 0.f};
        mrun[qi] = -1e30f; lrun[qi] = 0.f; }
    const float sc2 = 0.125f * LOG2E;
    const float nob[8] = {0.f, 0.f, 0.f, 0.f, 0.f, 0.f, 0.f, 0.f};
    const bf16* vbase = VtC + (size_t)((b * 16 + h) * 64) * KEYS;
    const bf16* kctx = P + (size_t)(NLAT + b * CTXL) * LDP1 + 1024 + h * 64;
    const bf16* kloc = P + (size_t)(b * SEQ) * LDP1 + 1024 + h * 64;
    const int seg_start = j == 0 ? 0 : (j == 1 ? 8 : (j == 2 ? 24 : 32));
    const int qcol = j * 16 + fr; const int cs = qcol - 8 < 0 ? 0 : (qcol - 8 > 48 ? 48 : qcol - 8);
    unsigned okmask = 0u; int coloff[8];
#pragma unroll
    for (int i = 0; i < 8; ++i) { const int keycol = seg_start + fq * 8 + i; if (keycol >= cs && keycol < cs + 16) okmask |= 1u << i;
        int co = keycol - qcol + 15; co = co < 0 ? 0 : (co > 30 ? 30 : co); coloff[i] = co; }
    const int rsa = r0 - 4 < 0 ? 0 : (r0 - 4 > 56 ? 56 : r0 - 4);
    const int rsb = r0 + NR - 1 - 4 < 0 ? 0 : (r0 + NR - 1 - 4 > 56 ? 56 : r0 + NR - 1 - 4);
    const int nloc = rsb + 8 - rsa, ntile = 8 + nloc;
#define NA_LOAD(F, t) do { const int t_ = (t); if (t_ < 8) kv_load(F, kctx + (size_t)(t_ * 32) * LDP1, LDP1, vbase + SEQ + t_ * 32, KEYS, fr, fq); \
        else { const int k0_ = (rsa + t_ - 8) * 64 + seg_start; kv_load(F, kloc + (size_t)k0_ * LDP1, LDP1, vbase + k0_, KEYS, fr, fq); } } while (0)
#define NA_PROC(F, t) do { const int t_ = (t); \
        if (t_ < 8) { _Pragma("unroll") for (int qi = 0; qi < NR; ++qi) attn_one<0>(o[qi], mrun[qi], lrun[qi], qf[qi], F, sc2, 0, 0u, nob); } \
        else { const int R_ = rsa + t_ - 8; \
            _Pragma("unroll") for (int qi = 0; qi < NR; ++qi) { const int r_ = r0 + qi; const int rs_ = r_ - 4 < 0 ? 0 : (r_ - 4 > 56 ? 56 : r_ - 4); \
                if (R_ >= rs_ && R_ < rs_ + 8) { const LAS float* rb_ = btab + (R_ - r_ + 7) * 31; float bias_[8]; \
                    _Pragma("unroll") for (int e = 0; e < 8; ++e) bias_[e] = rb_[coloff[e]]; \
                    attn_one<2>(o[qi], mrun[qi], lrun[qi], qf[qi], F, sc2, 0, okmask, bias_); } } } } while (0)
    KVFrag A, B;
    NA_LOAD(A, 0);
    for (int t = 0; t < ntile; t += 2) {
        if (t + 1 < ntile) NA_LOAD(B, t + 1);
        NA_PROC(A, t);
        if (t + 1 < ntile) { if (t + 2 < ntile) NA_LOAD(A, t + 2); NA_PROC(B, t + 1); }
    }
#undef NA_LOAD
#undef NA_PROC
#pragma unroll
    for (int qi = 0; qi < NR; ++qi) attn_store1(o[qi], lrun[qi], O + ((size_t)b * SEQ + (r0 + qi) * 64 + j * 16 + fr) * D + h * 64, fq);
}

DI void vt_unit(const bf16* P, int ldp, int vcol, int nh, bf16* Vt, int unit, LAS unsigned char* scr, int lane) {
    const int kb = unit % 68, bh = unit / 68, h = bh % nh, b = bh / nh;
    const size_t row0 = kb < 64 ? (size_t)b * SEQ + kb * 64 : (size_t)NLAT + b * CTXL + (kb - 64) * 64;
    LAS unsigned short* t = (LAS unsigned short*)scr;
#pragma unroll
    for (int i = 0; i < 8; ++i) { const int key = (lane >> 3) + 8 * i, ch = lane & 7;
        const u32x4 v = *(const u32x4*)(P + (row0 + key) * ldp + vcol + h * 64 + ch * 8);
        *(LAS u32x4*)(t + key * 72 + ch * 8) = v; }
    asm volatile("s_waitcnt lgkmcnt(0)" ::: "memory");
    bf16* dst = Vt + (size_t)(bh * 64 + lane) * KEYS + kb * 64;
#pragma unroll
    for (int g8 = 0; g8 < 8; ++g8) { unsigned short e[8];
#pragma unroll
        for (int i = 0; i < 8; ++i) e[i] = t[(g8 * 8 + i) * 72 + lane];
        u32x4 w; w.x = e[0] | ((unsigned)e[1] << 16); w.y = e[2] | ((unsigned)e[3] << 16); w.z = e[4] | ((unsigned)e[5] << 16); w.w = e[6] | ((unsigned)e[7] << 16);
        *(u32x4*)(dst + g8 * 8) = w; }
    asm volatile("s_waitcnt lgkmcnt(0)" ::: "memory");
}

constexpr int L_GW = 0, L_CUM = 4608, L_A = 21248, L_B = 30464, L_ATT = 39680, L_VT = 48896, L_SSQ = 67328, L_TOT = 67840;
DI size_t chunk_row0(int b, int n) { return n < 64 ? (size_t)b * SEQ + n * 64 : (size_t)NLAT + b * CTXL + (n - 64) * 64; }
DI float* st_ptr(const Args& a, int seq, int n) { return n < 64 ? a.out + (size_t)(seq * 64 + n) * 8192 : (float*)(a.ws + WS_STC) + (size_t)(seq * 4 + (n - 64)) * 8192; }

DI void gla_cum(const Args& a, LAS unsigned char* lds, const bf16* P, size_t row0, int h, int dir, int tid) {
    LAS float* rfl = (LAS float*)(lds + L_GW); LAS float* tot = (LAS float*)(lds + L_TOT); LAS float* cum = (LAS float*)(lds + L_CUM);
    const float* gw = a.in[dir ? I_GBW : I_GFW]; const float* gb = a.in[dir ? I_GBB : I_GFB];
    const int lane = tid & 63, w = tid >> 6;
    { const int c = tid >> 3, r2 = (tid & 7) * 2; const unsigned v = *(const unsigned*)(P + (row0 + c) * LDP0 + (dir ? C_RB : C_RF) + r2);
      rfl[c * 16 + r2] = __uint_as_float(v << 16); rfl[c * 16 + r2 + 1] = __uint_as_float(v & 0xffff0000u); }
    float gwr[16];
#pragma unroll
    for (int r = 0; r < 16; ++r) gwr[r] = gw[r * 256 + h * 64 + lane];
    const float gbv = gb[h * 64 + lane];
    __syncthreads();
    float la[8];
#pragma unroll
    for (int i = 0; i < 8; ++i) { const int c = w * 8 + i; float x = gbv;
#pragma unroll
        for (int r = 0; r < 16; ++r) x += rfl[c * 16 + r] * gwr[r];
        la[i] = (fminf(x, 0.f) - log1pf(__expf(-fabsf(x)))) * (1.0f / 16.0f); }
    if (dir == 0) {
#pragma unroll
        for (int i = 1; i < 8; ++i) la[i] += la[i - 1];
        tot[w * 64 + lane] = la[7];
    } else {
#pragma unroll
        for (int i = 6; i >= 0; --i) la[i] += la[i + 1];
        tot[w * 64 + lane] = la[0];
    }
    __syncthreads();
    float off = 0.f;
#pragma unroll
    for (int w2 = 0; w2 < 8; ++w2) { const float t = tot[w2 * 64 + lane]; off += ((dir == 0) ? (w2 < w) : (w2 > w)) ? t : 0.f; }
#pragma unroll
    for (int i = 0; i < 8; ++i) cum[(w * 8 + i) * 65 + lane] = la[i] + off;
    __syncthreads();
}
DI void gla_load_vt(LAS unsigned char* lds, const bf16* P, size_t row0, int h, int tid) {
    LAS unsigned short* vT = (LAS unsigned short*)(lds + L_VT);
    const int c = tid >> 3, dg = tid & 7;
    const bf16* vp = P + (row0 + c) * LDP0 + C_BV + h * 128 + dg * 16;
    const bf16x8 v0 = *(const bf16x8*)vp, v1 = *(const bf16x8*)(vp + 8);
#pragma unroll
    for (int e = 0; e < 8; ++e) { vT[(dg * 16 + e) * 72 + c] = (unsigned short)v0[e]; vT[(dg * 16 + 8 + e) * 72 + c] = (unsigned short)v1[e]; }
}
DI void gla_g1_unit(const Args& a, LAS unsigned char* lds, int unit, int tid, int lane, int wave) {
    const bf16* P = (const bf16*)(a.ws + WS_P);
    const int n = unit % NCHUNK, seq = unit / NCHUNK, dir = seq & 1, h = (seq >> 1) & 3, b = seq >> 3;
    const size_t row0 = chunk_row0(b, n);
    gla_cum(a, lds, P, row0, h, dir, tid);
    LAS float* cum = (LAS float*)(lds + L_CUM); LAS unsigned short* kdT = (LAS unsigned short*)(lds + L_A); LAS unsigned short* vT = (LAS unsigned short*)(lds + L_VT);
    const int cend = dir ? 0 : 63;
    { const int c = tid >> 3, dg = tid & 7; float kk[8]; unpack8(*(const bf16x8*)(P + (row0 + c) * LDP0 + C_BK + h * 64 + dg * 8), kk);
#pragma unroll
      for (int dd = 0; dd < 8; ++dd) { const int d = dg * 8 + dd; const float v = kk[dd] * __expf(cum[cend * 65 + d] - cum[c * 65 + d]); kdT[d * 72 + c] = (unsigned short)(pk2(v, 0.f) & 0xffffu); } }
    gla_load_vt(lds, P, row0, h, tid);
    if (tid < 64) ((float*)(a.ws + WS_DEC))[(size_t)(seq * NCHUNK + n) * 64 + tid] = __expf(cum[cend * 65 + tid]);
    __syncthreads();
    const int fr = lane & 15, fq = lane >> 4;
    bf16x8 av[2];
#pragma unroll
    for (int ks = 0; ks < 2; ++ks) av[ks] = *(const LAS bf16x8*)(vT + (wave * 16 + fr) * 72 + ks * 32 + fq * 8);
    float* st = st_ptr(a, seq, n);
#pragma unroll
    for (int nt = 0; nt < 4; ++nt) { f32x4 acc = {0.f, 0.f, 0.f, 0.f};
#pragma unroll
        for (int ks = 0; ks < 2; ++ks) { const bf16x8 bk = *(const LAS bf16x8*)(kdT + (nt * 16 + fr) * 72 + ks * 32 + fq * 8); acc = MFMA16(av[ks], bk, acc); }
#pragma unroll
        for (int r = 0; r < 4; ++r) st[(wave * 16 + fq * 4 + r) * 64 + nt * 16 + fr] = acc[r]; }
    __syncthreads();
}
DI void gla_scan(const Args& a, int tid) {
    const float* DEC = (const float*)(a.ws + WS_DEC);
    for (int e = blockIdx.x * NTHR + tid; e < 32 * 8192; e += gridDim.x * NTHR) {
        const int seq = e >> 13, el = e & 8191, dk = el & 63, dir = seq & 1;
        float S = 0.f;
        for (int s4 = 0; s4 < NCHUNK; s4 += 4) {
            float* p[4]; float t[4], dc[4];
#pragma unroll
            for (int i = 0; i < 4; ++i) { const int step = s4 + i; const int n = dir == 0 ? (step < 4 ? 64 + step : step - 4) : (step < 4 ? 67 - step : 67 - step);
                p[i] = st_ptr(a, seq, n) + el; t[i] = *p[i]; dc[i] = DEC[(size_t)(seq * NCHUNK + n) * 64 + dk]; }
#pragma unroll
            for (int i = 0; i < 4; ++i) { *p[i] = S; S = dc[i] * S + t[i]; }
        }
    }
}
DI void gla_g3_unit(const Args& a, LAS unsigned char* lds, int unit, int tid, int lane, int wave) {
    const bf16* P = (const bf16*)(a.ws + WS_P); bf16* O = (bf16*)(a.ws + WS_HO);
    const int n = unit % NCHUNK, bh = unit / NCHUNK, h = bh & 3, b = bh >> 2;
    const size_t row0 = chunk_row0(b, n);
    LAS float* cum = (LAS float*)(lds + L_CUM); LAS unsigned short* qg = (LAS unsigned short*)(lds + L_A); LAS unsigned short* kg = (LAS unsigned short*)(lds + L_B);
    LAS unsigned short* att = (LAS unsigned short*)(lds + L_ATT); LAS unsigned short* vT = (LAS unsigned short*)(lds + L_VT); LAS float* ssq = (LAS float*)(lds + L_SSQ);
    const int fr = lane & 15, fq = lane >> 4, ct = wave & 3, dvh = wave >> 2;
    gla_load_vt(lds, P, row0, h, tid);
    f32x4 acc[4];
#pragma unroll
    for (int nt = 0; nt < 4; ++nt) acc[nt] = (f32x4){0.f, 0.f, 0.f, 0.f};
    for (int dir = 0; dir < 2; ++dir) {
        gla_cum(a, lds, P, row0, h, dir, tid);
        { const int c = tid >> 3, dg = tid & 7; float qq[8], kk[8], oq[8], ok[8];
          unpack8(*(const bf16x8*)(P + (row0 + c) * LDP0 + C_BQ + h * 64 + dg * 8), qq); unpack8(*(const bf16x8*)(P + (row0 + c) * LDP0 + C_BK + h * 64 + dg * 8), kk);
#pragma unroll
          for (int dd = 0; dd < 8; ++dd) { const float cu = cum[c * 65 + dg * 8 + dd]; oq[dd] = qq[dd] * 0.125f * __expf(cu); ok[dd] = kk[dd] * __expf(-cu); }
          *(LAS bf16x8*)(qg + c * 72 + dg * 8) = pack8(oq); *(LAS bf16x8*)(kg + c * 72 + dg * 8) = pack8(ok); }
        __syncthreads();
        bf16x8 bq[2];
#pragma unroll
        for (int ks = 0; ks < 2; ++ks) bq[ks] = *(const LAS bf16x8*)(qg + (ct * 16 + fr) * 72 + ks * 32 + fq * 8);
#pragma unroll
        for (int si = 0; si < 2; ++si) { const int st = dvh * 2 + si; f32x4 s = {0.f, 0.f, 0.f, 0.f};
#pragma unroll
            for (int ks = 0; ks < 2; ++ks) { const bf16x8 ak = *(const LAS bf16x8*)(kg + (st * 16 + fr) * 72 + ks * 32 + fq * 8); s = MFMA16(ak, bq[ks], s); }
            const int cpos = ct * 16 + fr; float pv[4];
#pragma unroll
            for (int r = 0; r < 4; ++r) { const int spos = st * 16 + fq * 4 + r; const bool keep = dir == 0 ? (spos <= cpos) : (spos >= cpos); pv[r] = keep ? s[r] : 0.f; }
            u32x2 w; w.x = pk2(pv[0], pv[1]); w.y = pk2(pv[2], pv[3]);
            *(LAS u32x2*)(att + cpos * 72 + st * 16 + fq * 4) = w; }
        __syncthreads();
        bf16x8 ba[2];
#pragma unroll
        for (int ks = 0; ks < 2; ++ks) ba[ks] = *(const LAS bf16x8*)(att + (ct * 16 + fr) * 72 + ks * 32 + fq * 8);
        const float* st = st_ptr(a, (bh * 2 + dir), n);
#pragma unroll
        for (int nt = 0; nt < 4; ++nt) { const int dvt = dvh * 4 + nt;
#pragma unroll
            for (int ks = 0; ks < 2; ++ks) {
                const bf16x8 av = *(const LAS bf16x8*)(vT + (dvt * 16 + fr) * 72 + ks * 32 + fq * 8);
                acc[nt] = MFMA16(av, ba[ks], acc[nt]);
                const f32x4 s0 = *(const f32x4*)(st + (dvt * 16 + fr) * 64 + ks * 32 + fq * 8), s1 = *(const f32x4*)(st + (dvt * 16 + fr) * 64 + ks * 32 + fq * 8 + 4);
                const float sf[8] = {s0[0], s0[1], s0[2], s0[3], s1[0], s1[1], s1[2], s1[3]};
                acc[nt] = MFMA16(pack8(sf), bq[ks], acc[nt]); } }
        __syncthreads();
    }
    float sq = 0.f;
#pragma unroll
    for (int nt = 0; nt < 4; ++nt) sq += (acc[nt][0] * acc[nt][0] + acc[nt][1] * acc[nt][1]) + (acc[nt][2] * acc[nt][2] + acc[nt][3] * acc[nt][3]);
    sq += __shfl_xor(sq, 16); sq += __shfl_xor(sq, 32);
    if (fq == 0) ssq[wave * 16 + fr] = sq;
    __syncthreads();
    const float tot = ssq[wave * 16 + fr] + ssq[(wave ^ 4) * 16 + fr];
    const float rstd = __builtin_amdgcn_rsqf(tot * (1.0f / 128.0f) + EPS);
    const size_t row = row0 + ct * 16 + fr;
#pragma unroll
    for (int nt = 0; nt < 4; ++nt) { const int dv0 = (dvh * 4 + nt) * 16 + fq * 4;
        const f32x4 g4 = *(const f32x4*)(a.in[I_GNORM] + h * 128 + dv0);
        const u32x2 bw = *(const u32x2*)(P + row * LDP0 + C_BO + h * 128 + dv0);
        const float g0 = __uint_as_float(bw.x << 16), g1 = __uint_as_float(bw.x & 0xffff0000u), g2 = __uint_as_float(bw.y << 16), g3 = __uint_as_float(bw.y & 0xffff0000u);
        u32x2 w; w.x = pk2(acc[nt][0] * rstd * g4[0] * silu_f(g0), acc[nt][1] * rstd * g4[1] * silu_f(g1));
        w.y = pk2(acc[nt][2] * rstd * g4[2] * silu_f(g2), acc[nt][3] * rstd * g4[3] * silu_f(g3));
        *(u32x2*)(O + row * D + 512 + h * 128 + dv0) = w; }
    __syncthreads();
}

DI void rope_row(bf16* prow, int t, int lane) {
    const int prow_pos = t >> 6, pcol_pos = t & 63;
#pragma unroll
    for (int i = 0; i < 5; ++i) { const int pi = lane + 64 * i, head = pi >> 5, rem = pi & 31, half = rem >> 4, j = rem & 15;
        const int c1 = head * 64 + half * 32 + j, pos = half ? pcol_pos : prow_pos;
        const float cs = ROPE_COS[pos * 16 + j], sn = ROPE_SIN[pos * 16 + j];
        const float u1 = bf2f(prow[c1]), u2 = bf2f(prow[c1 + 16]);
        prow[c1] = (unsigned short)(pk2(u1 * cs - u2 * sn, 0.f) & 0xffffu); prow[c1 + 16] = (unsigned short)(pk2(u2 * cs + u1 * sn, 0.f) & 0xffffu); }
}

constexpr int NPHASE = 19;
#ifndef NA_NR
#define NA_NR 2
#endif
#ifndef PROBE_MASK
#define PROBE_MASK 0u
#endif
#define REPS(k) (((PROBE_MASK >> (k)) & 1u) ? 2 : 1)
__global__ void __launch_bounds__(NTHR, 2) fwd_kernel(Args a) {
    extern __shared__ __attribute__((aligned(16))) unsigned char lds_raw[];
    LAS unsigned char* lds = (LAS unsigned char*)lds_raw;
    const int tid = threadIdx.x, lane = tid & 63, wave = __builtin_amdgcn_readfirstlane(tid >> 6);
    const int G = gridDim.x, gw = blockIdx.x * NWAVES + wave, NGW = G * NWAVES;
    unsigned char* ws = a.ws;
    const int lo = a.ph_lo, hi = a.ph_hi;
#define IN(k) (lo <= (k) && (k) < hi)
#ifndef PROBE_SYNC
#define PROBE_SYNC 1
#endif
    volatile LAS unsigned* MISC = (volatile LAS unsigned*)(lds + 131072 + 320);
    if (tid < 32) MISC[tid] = 0u;
    __syncthreads();
    unsigned* barw = (unsigned*)(ws + WS_CTL);
    XcdBarrier xbar; xbar.bar = barw; xbar.x = 0; xbar.st = MISC + 8;
#define SEAM(k) do { if (IN(k) && IN((k) + 1)) { for (int sr_ = 0; sr_ < PROBE_SYNC; ++sr_) { if ((k) == 0) { cg::this_grid().sync(); if (sr_ == 0) xbar = xcd_barrier_post(barw, MISC + 8); } else xcd_barrier(xbar); } } } while (0)
    bf16* H = (bf16*)(ws + WS_HO); bf16* YF = (bf16*)(ws + WS_YF); bf16* P = (bf16*)(ws + WS_P);

    if (IN(0)) { if (blockIdx.x == 0) { for (int i = tid; i < XCD_BAR_WORDS; i += NTHR) barw[i] = 0u; }
        for (int rep = 0; rep < REPS(0); ++rep) { phase_prologue(a, lds, tid, lane, wave); __syncthreads(); } } SEAM(0);
    if (IN(1)) { for (int rep = 0; rep < REPS(1); ++rep) phase_rows(a, 0, 0, lane, wave); } SEAM(1);
    if (IN(2)) { pg8::Gemm g{H, (const bf16*)(ws + WS_WABI), MT, LDP0, D}; pg8::StaticOrder S; S.init(MT, LDP0, G, (int)blockIdx.x);
        EpiStore E{P, LDP0}; pg8::gemm_phase<EpiStore, pg8::StaticOrder, true, true>(lds, g, S, E); if (REPS(2) > 1) { pg8::gemm_phase<EpiStore, pg8::StaticOrder, true, true>(lds, g, S, E); } } SEAM(2);
    if (IN(3)) {
        for (int rep = 0; rep < REPS(3); ++rep) for (int u = blockIdx.x; u < 32 * NCHUNK; u += G) gla_g1_unit(a, lds, u, tid, lane, wave);
        __syncthreads();
        for (int m = gw; m < NLAT; m += NGW) rope_row(P + (size_t)m * LDP0, m & 4095, lane);
        for (int u = gw; u < NBATCH * 2 * 68; u += NGW) vt_unit(P, LDP0, C_AV, 2, YF, u, lds + wave * 16384, lane);
    } SEAM(3);
    if (IN(4)) {
        for (int rep = 0; rep < REPS(4); ++rep) for (int wt = gw; wt < 2176; wt += NGW) window_attn_tile(a, wt, lane);
        gla_scan(a, tid);
    } SEAM(4);
    if (IN(5)) { for (int rep = 0; rep < REPS(5); ++rep) for (int u = blockIdx.x; u < 16 * NCHUNK; u += G) gla_g3_unit(a, lds, u, tid, lane, wave); } SEAM(5);
    if (IN(6)) { pg8::Gemm g{H, (const bf16*)(ws + WS_WABO), MT, D, D}; pg8::StaticOrder S; S.init(MT, D, G, (int)blockIdx.x);
        EpiStore E{YF, D}; pg8::gemm_phase<EpiStore, pg8::StaticOrder, true, true>(lds, g, S, E); if (REPS(6) > 1) { pg8::gemm_phase<EpiStore, pg8::StaticOrder, true, true>(lds, g, S, E); } } SEAM(6);
    if (IN(7)) { for (int rep = 0; rep < REPS(7); ++rep) phase_rows(a, 1, 0, lane, wave); } SEAM(7);
    if (IN(8)) { pg8::Gemm g{H, (const bf16*)(ws + WS_WFI), MT, 2 * FF, D}; pg8::StaticOrder S; S.init(MT, 2 * FF, G, (int)blockIdx.x);
        EpiSwiglu E{P, FF}; pg8::gemm_phase<EpiSwiglu, pg8::StaticOrder, true, true>(lds, g, S, E); if (REPS(8) > 1) { pg8::gemm_phase<EpiSwiglu, pg8::StaticOrder, true, true>(lds, g, S, E); } } SEAM(8);
    if (IN(9)) { pg8::Gemm g{P, (const bf16*)(ws + WS_WFO), MT, D, FF}; pg8::StaticOrder S; S.init(MT, D, G, (int)blockIdx.x);
        EpiStore E{YF, D}; pg8::gemm_phase<EpiStore, pg8::StaticOrder, true, true>(lds, g, S, E); if (REPS(9) > 1) { pg8::gemm_phase<EpiStore, pg8::StaticOrder, true, true>(lds, g, S, E); } } SEAM(9);
    if (IN(10)) { phase_rows(a, 2, 0, lane, wave); } SEAM(10);
    if (IN(11)) { pg8::Gemm g{H, (const bf16*)(ws + WS_WNI), MT, LDP1, D}; pg8::StaticOrder S; S.init(MT, LDP1, G, (int)blockIdx.x);
        EpiStore E{P, LDP1}; pg8::gemm_phase<EpiStore, pg8::StaticOrder, true, true>(lds, g, S, E); if (REPS(11) > 1) { pg8::gemm_phase<EpiStore, pg8::StaticOrder, true, true>(lds, g, S, E); } } SEAM(11);
    if (IN(12)) { for (int rep = 0; rep < REPS(12); ++rep) for (int u = gw; u < NBATCH * 16 * 68; u += NGW) vt_unit(P, LDP1, 2048, 16, YF, u, lds + wave * 16384, lane); } SEAM(12);
    if (IN(13)) { for (int rep = 0; rep < REPS(13); ++rep) for (int gid = gw; gid < 16384 / NA_NR; gid += NGW) na_attn_group<NA_NR>(a, gid, lane, (LAS float*)(lds + wave * 16384)); } SEAM(13);
    if (IN(14)) { pg8::Gemm g{H, (const bf16*)(ws + WS_WNO), NLAT, D, D}; pg8::StaticOrder S; S.init(NLAT, D, G, (int)blockIdx.x);
        EpiStore E{YF, D}; pg8::gemm_phase<EpiStore, pg8::StaticOrder, true, true>(lds, g, S, E); if (REPS(14) > 1) { pg8::gemm_phase<EpiStore, pg8::StaticOrder, true, true>(lds, g, S, E); } } SEAM(14);
    if (IN(15)) { phase_rows(a, 1, 1, lane, wave); } SEAM(15);
    if (IN(16)) { pg8::Gemm g{H, (const bf16*)(ws + WS_WFI) + (size_t)5632 * 1024, NLAT, 2 * FF, D}; pg8::StaticOrder S; S.init(NLAT, 2 * FF, G, (int)blockIdx.x);
        EpiSwiglu E{P, FF}; pg8::gemm_phase<EpiSwiglu, pg8::StaticOrder, true, true>(lds, g, S, E); if (REPS(16) > 1) { pg8::gemm_phase<EpiSwiglu, pg8::StaticOrder, true, true>(lds, g, S, E); } } SEAM(16);
    if (IN(17)) { pg8::Gemm g{P, (const bf16*)(ws + WS_WFO) + (size_t)1024 * FF, NLAT, D, FF}; pg8::StaticOrder S; S.init(NLAT, D, G, (int)blockIdx.x);
        EpiStore E{YF, D}; pg8::gemm_phase<EpiStore, pg8::StaticOrder, true, true>(lds, g, S, E); if (REPS(17) > 1) { pg8::gemm_phase<EpiStore, pg8::StaticOrder, true, true>(lds, g, S, E); } } SEAM(17);
    if (IN(18)) { phase_rows(a, 2, 1, lane, wave); }
#undef IN
#undef SEAM
}

extern "C" void kernel_launch(void* const* d_in, const int* in_sizes, int n_in, void* d_out, int out_size, void* d_ws, size_t ws_size, hipStream_t stream) {
    static int grid = 0;
    if (grid == 0) {
        if (n_in != 23 || out_size != NLAT * D || ws_size < WS_END) { fprintf(stderr, "kernel_launch: unexpected problem shape (n_in %d, out %d, ws %zu)\n", n_in, out_size, ws_size); grid = -1; return; }
        int dev = 0, cus = 0, per_cu = 0;
        (void)hipGetDevice(&dev); (void)hipDeviceGetAttribute(&cus, hipDeviceAttributeMultiprocessorCount, dev);
        if (hipFuncSetAttribute((const void*)fwd_kernel, hipFuncAttributeMaxDynamicSharedMemorySize, LDS_BYTES) != hipSuccess) { fprintf(stderr, "kernel_launch: hipFuncSetAttribute failed\n"); grid = -1; return; }
        (void)hipOccupancyMaxActiveBlocksPerMultiprocessor(&per_cu, (const void*)fwd_kernel, NTHR, LDS_BYTES);
        if (per_cu < 1) per_cu = 1;
        (void)hipGetLastError();
        grid = cus * per_cu;
    }
    if (grid < 0) return;
    Args a{};
    for (int i = 0; i < 23; ++i) a.in[i] = (const float*)d_in[i];
    a.out = (float*)d_out; a.ws = (unsigned char*)d_ws;
#if COOP
    a.ph_lo = 0; a.ph_hi = NPHASE;
    void* args[] = {&a};
    hipError_t e = hipLaunchCooperativeKernel((const void*)fwd_kernel, dim3(grid), dim3(NTHR), args, LDS_BYTES, stream);
    if (e != hipSuccess) fprintf(stderr, "cooperative launch failed: %s (grid %d)\n", hipGetErrorString(e), grid);
#else
    for (int p = 0; p < NPHASE; ++p) { a.ph_lo = p; a.ph_hi = p + 1; hipLaunchKernelGGL(fwd_kernel, dim3(grid), dim3(NTHR), LDS_BYTES, stream, a); }
#endif
}
```

```cpp
#include <hip/hip_runtime.h>
#include <hip/hip_cooperative_groups.h>
#include <cstdio>
#include <cstdint>
namespace cg = cooperative_groups;
namespace pg8 {
#define PG8_LAS __attribute__((address_space(3)))
typedef unsigned short bf16_t;
typedef short bf16x8 __attribute__((ext_vector_type(8)));
typedef float f32x4 __attribute__((ext_vector_type(4)));
typedef unsigned u32x4 __attribute__((ext_vector_type(4)));
constexpr int BM = 256, BK = 64, HALF = 128, HTB = HALF * BK * 2  , STAGE_BYTES = 8 * HTB, NXCD = 8, WGM = 8;

__host__ __device__ __forceinline__ int lds_byte(int r, int c) { const int st = (r >> 4) * 2 + (c >> 5), rr = r & 15, cc = c & 31, ob = rr * 64 + cc * 2; return st * 1024 + (ob ^ (((ob >> 9) & 1) << 5)); }
__host__ __device__ __forceinline__ void stage_rc(int b, int& R, int& C) { const int st = b / 1024, sb = b % 1024, swz = sb ^ (((sb >> 9) & 1) << 5); R = (st >> 1) * 16 + swz / 64; C = (st & 1) * 32 + (swz % 64) / 2; }
__host__ __device__ __forceinline__ int perm32(int rho) { const int n = rho >> 4, i = rho & 15; return 8 * (i >> 2) + 4 * n + (i & 3); }

struct Unit { int pm, pn; };
struct Gemm { const bf16_t* A; const bf16_t* Bt; int M, N, K; };

struct StaticOrder {
    int nM, nN, nwg, G, c;
    __host__ __device__ void init(int M, int N, int G_, int c_) { nM = M / BM; nN = N / BM; nwg = nM * nN; G = G_; c = c_; }
    __host__ __device__ bool next(int i, Unit& u) const {
        const long L = (long)i * G + c; if (L >= nwg) return false;
        int wgid = (int)L; { const int q = nwg / NXCD, r = nwg % NXCD, xcd = wgid % NXCD, off = wgid / NXCD; wgid = (xcd < r ? xcd * (q + 1) : r * (q + 1) + (xcd - r) * q) + off; }
        const int nig = WGM * nN, gid = wgid / nig, fm = gid * WGM, gsz = (nM - fm) < WGM ? (nM - fm) : WGM;
        u.pm = fm + ((wgid % nig) % gsz); u.pn = (wgid % nig) / gsz; return true;
    }
    __device__ __forceinline__ void a_ready(const Unit&) const {}
    __device__ __forceinline__ void done(const Unit&) const {}
};

__device__ __forceinline__ unsigned cvt_pk_bf16(float lo, float hi) { unsigned r; asm volatile("v_cvt_pk_bf16_f32 %0, %1, %2" : "=v"(r) : "v"(lo), "v"(hi)); return r; }
template <class Epi, class Sched, bool ALIGN_EPI = false, bool SP2 = false>
__device__ __forceinline__ void gemm_phase(PG8_LAS unsigned char* lds, const Gemm g, const Sched& S, const Epi& E) {
    const int tid = threadIdx.x, wid = __builtin_amdgcn_readfirstlane(tid >> 6), lane = tid & 63, wr = wid >> 2, wc = wid & 3, fr = lane & 15, fq = lane >> 4;
    const int K = g.K, nt = K / BK;
    unsigned voffA[2], voffB[2];
#pragma unroll
    for (int i = 0; i < 2; ++i) { int R, C; stage_rc(tid * 16 + i * 8192, R, C); const int Rb = Epi::PERM ? ((R & ~31) + perm32(R & 31)) : R;
        voffA[i] = (unsigned)(R * K + C) * 2u; voffB[i] = (unsigned)(Rb * K + C) * 2u; }
    const size_t kstep = (size_t)(BK * 2);
    const size_t hstep = (size_t)HALF * K * 2;
    const size_t tstep = 2 * hstep;
    const unsigned ldsw = (unsigned)wid * 1024u;
    const int aoff = lds_byte(wr * 64 + fr, fq * 8), boff = lds_byte(wc * 32 + fr, fq * 8);
#define PG8_SA(b, h) (((b) * 2 + (h)) * HTB)
#define PG8_SB(b, h) ((4 + (b) * 2 + (h)) * HTB)
#define PG8_STAGE(bufoff, gbase, voff) do { _Pragma("unroll") for (int _i = 0; _i < 2; ++_i) \
        __builtin_amdgcn_global_load_lds((const unsigned*)((const char*)(gbase) + (voff)[_i]), (PG8_LAS unsigned*)(lds + (bufoff) + ldsw + _i * 8192), 16, 0, 0); } while (0)
#define PG8_LDA(dst, b, h) do { _Pragma("unroll") for (int m = 0; m < 4; ++m) _Pragma("unroll") for (int k = 0; k < 2; ++k) dst[m][k] = *(const PG8_LAS bf16x8*)(lds + PG8_SA(b, h) + aoff + m * 2048 + k * 1024); } while (0)
#define PG8_LDB(dst, b, h) do { _Pragma("unroll") for (int n = 0; n < 2; ++n) _Pragma("unroll") for (int k = 0; k < 2; ++k) dst[n][k] = *(const PG8_LAS bf16x8*)(lds + PG8_SB(b, h) + boff + n * 2048 + k * 1024); } while (0)
#define PG8_MMA(ai, bj, At, Bt) do { __builtin_amdgcn_s_setprio(1); _Pragma("unroll") for (int m = 0; m < 4; ++m) _Pragma("unroll") for (int n = 0; n < 2; ++n) _Pragma("unroll") for (int k = 0; k < 2; ++k) \
        acc[ai][bj][m][n] = __builtin_amdgcn_mfma_f32_16x16x32_bf16(Bt[n][k], At[m][k], acc[ai][bj][m][n], 0, 0, 0); __builtin_amdgcn_s_setprio(0); } while (0)
#define PG8_WAIT_V(n) asm volatile("s_waitcnt vmcnt(" #n ")" ::: "memory")
#define PG8_WAIT_L(n) asm volatile("s_waitcnt lgkmcnt(" #n ")" ::: "memory")
#define PG8_BAR __builtin_amdgcn_s_barrier()
#define PG8_SCHED __builtin_amdgcn_sched_barrier(0)
    Unit cur, nxt; int ui = 0;
    if (!S.next(0, cur)) return;
    f32x4 acc[2][2][4][2];
#pragma unroll
    for (int a = 0; a < 2; ++a)
#pragma unroll
        for (int b = 0; b < 2; ++b)
#pragma unroll
            for (int m = 0; m < 4; ++m)
#pragma unroll
                for (int n = 0; n < 2; ++n) acc[a][b][m][n] = (f32x4){0.f, 0.f, 0.f, 0.f};
    bf16x8 At[4][2], B0[2][2], B1[2][2];
    const char* cA = (const char*)g.A + (size_t)cur.pm * tstep; const char* cB = (const char*)g.Bt + (size_t)cur.pn * tstep;
    S.a_ready(cur);
    if constexpr (SP2) {
        PG8_STAGE(PG8_SB(0, 0), cB, voffB); PG8_STAGE(PG8_SB(0, 1), cB + hstep, voffB); PG8_STAGE(PG8_SA(0, 0), cA, voffA); PG8_STAGE(PG8_SA(0, 1), cA + hstep, voffA);
        if (wr == 1) PG8_BAR;
        PG8_WAIT_V(2); PG8_BAR;
        PG8_STAGE(PG8_SB(1, 0), cB + kstep, voffB); PG8_STAGE(PG8_SA(1, 0), cA + kstep, voffA); PG8_STAGE(PG8_SB(1, 1), cB + hstep + kstep, voffB);
        PG8_WAIT_V(6); PG8_BAR;
    } else {
        PG8_STAGE(PG8_SB(0, 0), cB, voffB); PG8_STAGE(PG8_SA(0, 0), cA, voffA); PG8_STAGE(PG8_SB(0, 1), cB + hstep, voffB); PG8_STAGE(PG8_SA(0, 1), cA + hstep, voffA);
        if (wr == 1) PG8_BAR;
        PG8_WAIT_V(4); PG8_BAR;
        PG8_STAGE(PG8_SB(1, 0), cB + kstep, voffB); PG8_STAGE(PG8_SA(1, 0), cA + kstep, voffA); PG8_STAGE(PG8_SB(1, 1), cB + hstep + kstep, voffB);
        PG8_WAIT_V(6); PG8_BAR;
    }
    for (;;) {
        const bool has_next = S.next(ui + 1, nxt);
        const char* nA = has_next ? (const char*)g.A + (size_t)nxt.pm * tstep : cA; const char* nB = has_next ? (const char*)g.Bt + (size_t)nxt.pn * tstep : cB;
        for (int t = 0; t < nt; t += 2) {
            const bool last = (t == nt - 2);
            const char* a1 = cA + (size_t)(t + 1) * kstep;
            const char* a2 = last ? nA : cA + (size_t)(t + 2) * kstep; const char* b2 = last ? nB : cB + (size_t)(t + 2) * kstep;
            const char* a3 = a2 + kstep; const char* b3 = b2 + kstep;
            if (last && has_next) S.a_ready(nxt);
            if constexpr (SP2) {
            PG8_LDB(B0, 0, 0); PG8_LDB(B1, 0, 1); PG8_SCHED; PG8_LDA(At, 0, 0); PG8_STAGE(PG8_SA(1, 1), a1 + hstep, voffA);
            PG8_WAIT_V(8); PG8_WAIT_L(0); PG8_BAR; PG8_MMA(0, 0, At, B0); PG8_MMA(0, 1, At, B1); PG8_BAR; PG8_SCHED;
            PG8_LDA(At, 0, 1); PG8_STAGE(PG8_SB(0, 0), b2, voffB); PG8_STAGE(PG8_SB(0, 1), b2 + hstep, voffB); PG8_STAGE(PG8_SA(0, 0), a2, voffA);
            PG8_WAIT_V(8); PG8_WAIT_L(0); PG8_BAR; PG8_MMA(1, 0, At, B0); PG8_MMA(1, 1, At, B1); PG8_BAR; PG8_SCHED;
            PG8_LDB(B0, 1, 0); PG8_LDB(B1, 1, 1); PG8_SCHED; PG8_LDA(At, 1, 0); PG8_STAGE(PG8_SA(0, 1), a2 + hstep, voffA);
            PG8_WAIT_V(8); PG8_WAIT_L(0); PG8_BAR; PG8_MMA(0, 0, At, B0); PG8_MMA(0, 1, At, B1); PG8_BAR; PG8_SCHED;
            PG8_LDA(At, 1, 1); PG8_STAGE(PG8_SB(1, 0), b3, voffB); PG8_STAGE(PG8_SB(1, 1), b3 + hstep, voffB); PG8_STAGE(PG8_SA(1, 0), a3, voffA);
            PG8_WAIT_V(8); PG8_WAIT_L(0); PG8_BAR; PG8_MMA(1, 0, At, B0); PG8_MMA(1, 1, At, B1); PG8_BAR; PG8_SCHED;
            } else {
            PG8_LDB(B0, 0, 0); PG8_SCHED; PG8_LDA(At, 0, 0); PG8_STAGE(PG8_SA(1, 1), a1 + hstep, voffA);
            PG8_WAIT_L(8); PG8_BAR; PG8_WAIT_L(0); PG8_MMA(0, 0, At, B0); PG8_BAR; PG8_SCHED;
            PG8_LDB(B1, 0, 1); PG8_STAGE(PG8_SB(0, 0), b2, voffB);
            PG8_BAR; PG8_WAIT_L(0); PG8_MMA(0, 1, At, B1); PG8_BAR;
            PG8_LDA(At, 0, 1); PG8_STAGE(PG8_SA(0, 0), a2, voffA);
            PG8_BAR; PG8_WAIT_L(0); PG8_MMA(1, 0, At, B0); PG8_BAR; PG8_SCHED;
            PG8_STAGE(PG8_SB(0, 1), b2 + hstep, voffB);
            PG8_WAIT_V(6); PG8_BAR; PG8_MMA(1, 1, At, B1); PG8_BAR;
            PG8_LDB(B0, 1, 0); PG8_SCHED; PG8_LDA(At, 1, 0); PG8_STAGE(PG8_SA(0, 1), a2 + hstep, voffA);
            PG8_WAIT_L(8); PG8_BAR; PG8_WAIT_L(0); PG8_MMA(0, 0, At, B0); PG8_BAR; PG8_SCHED;
            PG8_LDB(B1, 1, 1); PG8_STAGE(PG8_SB(1, 0), b3, voffB);
            PG8_BAR; PG8_WAIT_L(0); PG8_MMA(0, 1, At, B1); PG8_BAR;
            PG8_LDA(At, 1, 1); PG8_STAGE(PG8_SA(1, 0), a3, voffA);
            PG8_BAR; PG8_WAIT_L(0); PG8_MMA(1, 0, At, B0); PG8_BAR; PG8_SCHED;
            PG8_STAGE(PG8_SB(1, 1), b3 + hstep, voffB);
            PG8_WAIT_V(6); PG8_BAR; PG8_MMA(1, 1, At, B1); PG8_BAR;
            }
        }
        if constexpr (ALIGN_EPI) { if (wr == 0) PG8_BAR; }
        if constexpr (!Epi::AFTER_DRAIN) { E(acc, cur, wr, wc, fr, fq); S.done(cur); }
        if (!has_next) break;
#pragma unroll
        for (int a = 0; a < 2; ++a)
#pragma unroll
            for (int b = 0; b < 2; ++b)
#pragma unroll
                for (int m = 0; m < 4; ++m)
#pragma unroll
                    for (int n = 0; n < 2; ++n) acc[a][b][m][n] = (f32x4){0.f, 0.f, 0.f, 0.f};
        cur = nxt; cA = nA; cB = nB; ++ui;
        if constexpr (ALIGN_EPI) { if (wr == 1) PG8_BAR; }
    }
    PG8_WAIT_V(0);
    if constexpr (!ALIGN_EPI) { if (wr == 0) PG8_BAR; }
    PG8_BAR;
    if constexpr (Epi::AFTER_DRAIN) { E.fused(acc, cur, wr, wc, fr, fq, lds, wid, lane); S.done(cur); }
#undef PG8_SA
#undef PG8_SB
#undef PG8_STAGE
#undef PG8_LDA
#undef PG8_LDB
#undef PG8_MMA
#undef PG8_WAIT_V
#undef PG8_WAIT_L
#undef PG8_BAR
#undef PG8_SCHED
}
}
__device__ const float ROPE_COS[1024] = {1.f,1.f,1.f,1.f,1.f,1.f,1.f,1.f,1.f,1.f,1.f,1.f,1.f,1.f,1.f,1.f,0.540302277f,0.846009135f,0.950415254f,0.98423022f,0.995004177f,0.998419285f,0.999500036f,0.999841869f,0.999949992f,0.999984205f,0.999994993f,0.999998391f,0.999999523f,0.999999821f,0.99999994f,1.f,-0.416146845f,0.431462824f,0.806578398f,0.937418282f,0.980066597f,0.993682086f,0.998000681f,0.999367595f,0.999800026f,0.999936759f,0.999979973f,0.999993682f,0.999997973f,0.999999344f,0.999999821f,0.99999994f,-0.989992499f,-0.115966164f,0.582753658f,0.861040652f,0.955336511f,0.985803485f,0.995503366f,0.998577297f,0.999550045f,0.999857724f,0.999954998f,0.999985754f,0.99999553f,0.999998569f,0.999999523f,0.999999881f,-0.653643608f,-0.627679706f,0.301137477f,0.757506192f,0.921060979f,0.974808276f,0.992010653f,0.997471273f,0.999200106f,0.999747038f,0.999920011f,0.999974728f,0.999992013f,0.999997497f,0.999999225f,0.999999762f,0.2836622f,-0.946079254f,-0.0103423381f,0.630080283f,0.87758255f,0.960731268f,0.987526f,0.996049762f,0.998750269f,0.999604762f,0.999875009f,0.999960482f,0.999987483f,0.999996066f,0.999998748f,0.999999583f,0.960170269f,-0.973103702f,-0.3207964f,0.482782036f,0.825335622f,0.943616986f,0.982053936f,0.9943133f,0.998200536f,0.999430835f,0.999819994f,0.999943078f,0.999981999f,0.999994338f,0.999998212f,0.999999404f,0.753902256f,-0.700429797f,-0.599437475f,0.320257008f,0.764842212f,0.923519433f,0.975599885f,0.992262423f,0.997551024f,0.999225318f,0.999755025f,0.999922514f,0.999975502f,0.999992251f,0.999997556f,0.999999225f,-0.145500034f,-0.212036446f,-0.818632424f,0.147631213f,0.696706712f,0.900502324f,0.968170285f,0.989897788f,0.996801734f,0.998988271f,0.999680042f,0.999898791f,0.999967992f,0.999989867f,0.999996781f,0.999998987f,-0.91113025f,0.341660261f,-0.956644177f,-0.0296507962f,0.621609926f,0.874638259f,0.959772646f,0.987220109f,0.995952725f,0.998719573f,0.999595046f,0.99987191f,0.999959528f,0.999987185f,0.999995947f,0.999998748f,-0.839071512f,0.790131867f,-0.999786079f,-0.205997631f,0.540302277f,0.846009135f,0.950415313f,0.98423022f,0.995004177f,0.998419285f,0.999500036f,0.999841869f,0.999949992f,0.999984205f,0.999994993f,0.999998391f,0.00442569796f,0.995257378f,-0.943779767f,-0.375847399f,0.453596085f,0.814705312f,0.940107584f,0.980929136f,0.993956089f,0.998087406f,0.999395072f,0.999808669f,0.999939501f,0.999980867f,0.99999392f,0.999998093f,0.843853951f,0.893861592f,-0.79417938f,-0.53384304f,0.362357706f,0.780825913f,0.92885989f,0.97731787f,0.99280864f,0.997723997f,0.999280095f,0.99977231f,0.999927998f,0.999977231f,0.999992788f,0.999997735f,0.907446802f,0.517172873f,-0.565820515f,-0.675001681f,0.267498761f,0.744477987f,0.916683376f,0.973397553f,0.99156189f,0.997329056f,0.999155104f,0.999732792f,0.999915481f,0.999973297f,0.999991536f,0.999997318f,0.136737213f,-0.0187961515f,-0.28134948f,-0.794870913f,0.16996716f,0.705776393f,0.903590262f,0.969169438f,0.990216017f,0.996902585f,0.999020159f,0.999690115f,0.99990201f,0.999969006f,0.999990225f,0.999996901f,-0.759687901f,-0.548975468f,0.0310223512f,-0.889670432f,0.070737198f,0.6648435f,0.889593601f,0.964634836f,0.988771081f,0.996444523f,0.998875201f,0.999644279f,0.999887526f,0.999964416f,0.999988735f,0.999996424f,-0.957659483f,-0.910081089f,0.340318173f,-0.95641005f,-0.0291995462f,0.621808827f,0.87470746f,0.959795177f,0.987227261f,0.99595499f,0.998720288f,0.999595284f,0.999872029f,0.999959528f,0.999987185f,0.999995947f,-0.275163352f,-0.990897954f,0.615864813f,-0.99298501f,-0.128844544f,0.576808274f,0.858946681f,0.954652011f,0.985584795f,0.995433986f,0.998555362f,0.999543071f,0.999855518f,0.999954283f,0.999985576f,0.99999541f,0.660316706f,-0.766536534f,0.830336154f,-0.998241663f,-0.227202162f,0.529984176f,0.842327058f,0.949207008f,0.983843684f,0.994881511f,0.998380423f,0.999487758f,0.999837995f,0.9999488f,0.999983788f,0.999994874f,0.988704622f,-0.306095392f,0.962463796f,-0.972014248f,-0.323289543f,0.481484592f,0.824865162f,0.943461835f,0.982004225f,0.994297504f,0.998195529f,0.999429286f,0.999819517f,0.999942899f,0.99998194f,0.999994278f,0.408082068f,0.248616725f,0.999144375f,-0.91512996f,-0.416146845f,0.431462824f,0.806578457f,0.937418282f,0.980066597f,0.993682086f,0.998000681f,0.999367595f,0.999800026f,0.999936759f,0.999979973f,0.999993682f,-0.547729254f,0.726760268f,0.936740458f,-0.829382956f,-0.504846215f,0.380077004f,0.787485182f,0.931078374f,0.97803092f,0.993035257f,0.99779582f,0.999302804f,0.999779522f,0.999930263f,0.999977946f,0.999993026f,-0.99996084f,0.981074572f,0.781440377f,-0.717477441f,-0.588501155f,0.327489585f,0.767604589f,0.92444396f,0.975897431f,0.992357016f,0.997581005f,0.999234855f,0.999758005f,0.999923468f,0.999975801f,0.999992371f,-0.53283304f,0.933235765f,0.548645258f,-0.582943261f,-0.666275978f,0.273866832f,0.746956408f,0.917517304f,0.97366637f,0.991647422f,0.997356176f,0.999163687f,0.999735534f,0.999916375f,0.999973536f,0.999991655f,0.424179018f,0.597977161f,0.261441678f,-0.430023283f,-0.737393796f,0.219378278f,0.725561321f,0.910300434f,0.971337974f,0.990906477f,0.997121394f,0.99908942f,0.99971199f,0.999908924f,0.999971211f,0.99999088f,0.991202831f,0.078552261f,-0.0516893305f,-0.263540596f,-0.801143587f,0.164196163f,0.703440726f,0.902795732f,0.968912423f,0.99013412f,0.996876657f,0.999011934f,0.999687493f,0.999901175f,0.999968767f,0.999990106f,0.64691931f,-0.465064496f,-0.359694332f,-0.0887455046f,-0.856888831f,0.108494945f,0.680616796f,0.895005584f,0.966389954f,0.98933053f,0.996621907f,0.998931348f,0.999662042f,0.999893129f,0.999966204f,0.999989331f,-0.292138815f,-0.865450621f,-0.632028639f,0.088848114f,-0.904072165f,0.0524506159f,0.6571123f,0.886932373f,0.963770926f,0.988495648f,0.996357203f,0.998847544f,0.999635518f,0.999884725f,0.999963522f,0.999988496f,-0.962605894f,-0.999293387f,-0.841684937f,0.26363951f,-0.942222297f,-0.00375941908f,0.632950664f,0.878578722f,0.961055458f,0.987629473f,0.996082544f,0.998760641f,0.99960804f,0.999876022f,0.99996078f,0.999987602f,-0.748057544f,-0.825371623f,-0.967871487f,0.430115849f,-0.970958173f,-0.0599575676f,0.608156204f,0.869947195f,0.958243906f,0.986732066f,0.995797932f,0.998670578f,0.999579549f,0.999867022f,0.999957979f,0.999986708f,0.154251456f,-0.397251874f,-0.998075247f,0.583026946f,-0.989992499f,-0.115966164f,0.582753658f,0.861040652f,0.955336511f,0.985803485f,0.995503366f,0.998577297f,0.999550045f,0.999857724f,0.999954998f,0.999985754f,0.914742351f,0.153215483f,-0.929300308f,0.717549205f,-0.999135137f,-0.171608135f,0.556768358f,0.851861775f,0.95233357f,0.984843671f,0.995198846f,0.998480916f,0.999519527f,0.999848068f,0.999951959f,0.999984801f,0.83422339f,0.656495154f,-0.768367112f,0.829440355f,-0.998294771f,-0.226707578f,0.53022635f,0.842413545f,0.949235439f,0.983852804f,0.994884372f,0.998381376f,0.999488056f,0.999838114f,0.9999488f,0.999983788f,-0.0132767474f,0.95758605f,-0.531235278f,0.915171385f,-0.987479806f,-0.281090319f,0.503154159f,0.832698941f,0.946042359f,0.982830763f,0.994559944f,0.998278618f,0.999455571f,0.999827802f,0.999945521f,0.999982774f,-0.848570287f,0.963757515f,-0.241421118f,0.972038329f,-0.966798186f,-0.334584385f,0.475578904f,0.822721004f,0.942754686f,0.981777668f,0.994225562f,0.99817276f,0.999422073f,0.999817252f,0.999942183f,0.999981701f,-0.903692186f,0.673110247f,0.0723346695f,0.998247743f,-0.93645668f,-0.387020677f,0.447528064f,0.812482953f,0.939372718f,0.980693519f,0.993881226f,0.998063743f,0.999387562f,0.999806345f,0.999938726f,0.999980628f,-0.127963692f,0.175156534f,0.378916174f,0.992972851f,-0.896758378f,-0.438233554f,0.419029742f,0.801987886f,0.935896814f,0.979578316f,0.993526995f,0.997951567f,0.999352098f,0.999795079f,0.99993521f,0.999979496f,0.765414059f,-0.376742303f,0.647921681f,0.95638001f,-0.848100007f,-0.488060862f,0.39011243f,0.791239262f,0.93232733f,0.978432178f,0.993162811f,0.997836173f,0.99931556f,0.999783576f,0.999931574f,0.999978364f,0.955073655f,-0.812611222f,0.852673113f,0.889623463f,-0.790967762f,-0.536345184f,0.360805035f,0.780240417f,0.928664625f,0.977255106f,0.992788672f,0.997717679f,0.999278069f,0.999771714f,0.999927819f,0.999977171f,0.266642928f,-0.998210371f,0.972865343f,0.794808388f,-0.72593224f,-0.582933903f,0.331136853f,0.768994927f,0.924909055f,0.976047099f,0.99240464f,0.997596025f,0.999239624f,0.999759495f,0.999923944f,0.999975979f,-0.666938066f,-0.87637943f,0.996578991f,0.674925625f,-0.653643608f,-0.627679706f,0.301137596f,0.757506192f,0.921060979f,0.974808276f,0.992010653f,0.997471273f,0.999200106f,0.999747038f,0.999920011f,0.999974728f,-0.987339258f,-0.484639406f,0.921462357f,0.533756077f,-0.574824035f,-0.670441091f,0.270837069f,0.745777905f,0.917120814f,0.973538578f,0.991606772f,0.997343302f,0.999159634f,0.999734223f,0.999915957f,0.999973416f,-0.399985313f,0.0563609414f,0.754965365f,0.375752151f,-0.490260571f,-0.711082935f,0.240265876f,0.733813822f,0.913088918f,0.972238123f,0.991192937f,0.997212172f,0.999118149f,0.99972111f,0.999911785f,0.999972105f,0.555113316f,0.580003142f,0.513598442f,0.205897167f,-0.400799006f,-0.749476731f,0.209454417f,0.721617639f,0.908965766f,0.970906913f,0.990769207f,0.997077882f,0.999075651f,0.999707639f,0.999907553f,0.999970794f,0.999843299f,0.925014675f,0.221298173f,0.0295478199f,-0.307332784f,-0.785501122f,0.178433523f,0.709193349f,0.904751658f,0.969545007f,0.990335584f,0.996940494f,0.99903214f,0.99969393f,0.999903202f,0.999969363f,0.52532196f,0.985138178f,-0.0929481089f,-0.147732988f,-0.210795805f,-0.819042206f,0.147234216f,0.696544766f,0.90044713f,0.968152404f,0.989892066f,0.996799886f,0.998987675f,0.999679863f,0.999898732f,0.999967992f,-0.432177931f,0.741858006f,-0.397976756f,-0.320354372f,-0.112152621f,-0.849993885f,0.115887694f,0.683675885f,0.89605248f,0.966729224f,0.989438653f,0.996656179f,0.998942196f,0.999665439f,0.999894202f,0.999966562f,-0.992335498f,0.270098448f,-0.663538277f,-0.48287195f,-0.0123883775f,-0.878258407f,0.0844252855f,0.670590878f,0.891568303f,0.965275466f,0.988975346f,0.996509314f,0.998895705f,0.999650776f,0.999889553f,0.999965072f,-0.640144348f,-0.284846604f,-0.863296509f,-0.630159974f,0.0874991715f,-0.903746367f,0.0528784581f,0.657293737f,0.886994898f,0.963791192f,0.988502085f,0.996359289f,0.9988482f,0.999635756f,0.999884784f,0.999963582f,0.300592542f,-0.75206399f,-0.977442741f,-0.757573068f,0.18651247f,-0.926377118f,0.0212787576f,0.643788815f,0.882332861f,0.962276459f,0.98801899f,0.996206105f,0.998799741f,0.999620378f,0.999879956f,0.999962032f,0.964965999f,-0.987659097f,-0.994656444f,-0.861092687f,0.2836622f,-0.946079254f,-0.0103422189f,0.630080283f,0.87758255f,0.960731268f,0.987526f,0.996049762f,0.998750269f,0.999604762f,0.999875009f,0.999960482f,0.742154181f,-0.919073522f,-0.913230121f,-0.937454224f,0.377977669f,-0.96279037f,-0.0419528559f,0.616172493f,0.872744501f,0.959155679f,0.987023175f,0.99589026f,0.998699784f,0.999588788f,0.999869943f,0.999958873f,-0.162990779f,-0.567430019f,-0.741239965f,-0.984248459f,0.468516916f,-0.976457715f,-0.0735215396f,0.602069914f,0.86781919f,0.95754981f,0.986510456f,0.995727658f,0.998648286f,0.999572515f,0.999864817f,0.999957263f,-0.918282807f,-0.0410281904f,-0.495741814f,-1.f,0.554374516f,-0.987038016f,-0.105016708f,0.587776959f,0.862807095f,0.955913603f,0.985987842f,0.995561838f,0.998595834f,0.999555886f,0.999859571f,0.999955595f,-0.829309821f,0.498009592f,-0.201079622f,-0.984212041f,0.634692967f,-0.994497895f,-0.136406869f,0.573298037f,0.857708693f,0.954247177f,0.985455394f,0.995392919f,0.998542368f,0.999538958f,0.999854207f,0.999953866f,0.0221267566f,0.883669317f,0.113521777f,-0.937382519f,0.708669782f,-0.998813629f,-0.167660639f,0.558637917f,0.852524519f,0.95255059f,0.984913111f,0.99522084f,0.99848789f,0.999521732f,0.999848783f,0.999952197f,0.853220105f,0.997174621f,0.416867077f,-0.860988438f,0.775565803f,-0.999971747f,-0.198746875f,0.543801069f,0.847255111f,0.950823903f,0.984360933f,0.995045662f,0.998432398f,0.999504209f,0.99984318f,0.999950409f,0.899866819f,0.803569078f,0.678870201f,-0.757439196f,0.834712923f,-0.997968495f,-0.22963427f,0.528792322f,0.841901004f,0.949067116f,0.983798921f,0.994867265f,0.998375952f,0.999486327f,0.999837577f,0.999948621f,0.119180135f,0.362476677f,0.873550534f,-0.63000071f,0.885519624f,-0.99281019f,-0.260292053f,0.513616323f,0.836462677f,0.947280347f,0.983227074f,0.994685769f,0.998318493f,0.999468148f,0.999831796f,0.999946833f,-0.771080196f,-0.1902491f,0.981602073f,-0.482692331f,0.927478492f,-0.984513164f,-0.290689558f,0.498277903f,0.830940723f,0.945463598f,0.982645452f,0.994501114f,0.998260021f,0.99944967f,0.999825954f,0.999944985f,-0.952412963f,-0.684381902f,0.992308319f,-0.320159167f,0.960170269f,-0.973103702f,-0.3207964f,0.482782036f,0.825335622f,0.943616986f,0.982053936f,0.9943133f,0.998200536f,0.999430835f,0.999819994f,0.999943078f,-0.258101642f,-0.967739642f,0.904607594f,-0.1475292f,0.98326844f,-0.958617806f,-0.350582451f,0.467133403f,0.819648027f,0.941740453f,0.981452644f,0.994122326f,0.998140097f,0.999411702f,0.999813974f,0.99994117f,0.673507154f,-0.953050017f,0.727198064f,0.0297537707f,0.996542096f,-0.941101313f,-0.380017966f,0.451337039f,0.813878477f,0.939834237f,0.980841517f,0.993928254f,0.998078644f,0.999392271f,0.999807835f,0.999939203f,0.985896587f,-0.644837022f,0.477671444f,0.206098333f,0.999858618f,-0.920609534f,-0.409073502f,0.435397953f,0.808027506f,0.937898219f,0.980220556f,0.993731022f,0.998016179f,0.999372482f,0.999801576f,0.999937236f};
__device__ const float ROPE_SIN[1024] = {0.f,0.f,0.f,0.f,0.f,0.f,0.f,0.f,0.f,0.f,0.f,0.f,0.f,0.f,0.f,0.f,0.841470957f,0.533168435f,0.310983598f,0.176892191f,0.0998334214f,0.0562044978f,0.0316175036f,0.0177818574f,0.00999983307f,0.00562338345f,0.00316227227f,0.0017782785f,0.000999999931f,0.000562341243f,0.000316227757f,0.00017782794f,0.909297407f,0.902130723f,0.591127098f,0.348205268f,0.198669329f,0.112231314f,0.0632033944f,0.0355580896f,0.0199986659f,0.011246589f,0.00632451288f,0.00355655141f,0.0019999987f,0.00112468237f,0.000632455456f,0.00035565588f,0.141120002f,0.993253171f,0.812648892f,0.5085361f,0.295520216f,0.167903304f,0.0947260857f,0.0533230826f,0.0299954992f,0.0168694388f,0.00948669016f,0.00533481315f,0.0029999956f,0.00168702309f,0.000948683126f,0.000533483806f,-0.756802499f,0.778471708f,0.953580737f,0.652827978f,0.389418334f,0.223044485f,0.126154065f,0.0710712075f,0.0399893336f,0.0224917568f,0.0126487734f,0.00711305765f,0.00399998948f,0.00224936334f,0.00126491068f,0.000711311703f,-0.958924294f,0.32393527f,0.999946535f,0.776529968f,0.47942555f,0.277480543f,0.157455876f,0.0887968615f,0.0499791652f,0.0281133614f,0.0158107281f,0.00889127981f,0.0049999794f,0.0028117029f,0.00158113812f,0.000889139599f,-0.279415488f,-0.230367512f,0.947148204f,0.875740528f,0.564642489f,0.33103931f,0.188600272f,0.106494442f,0.0599640049f,0.0337340795f,0.0189725272f,0.0106694745f,0.0059999642f,0.00337404152f,0.00189736532f,0.00106696738f,0.656986594f,-0.713721275f,0.800421596f,0.947330713f,0.64421767f,0.383551568f,0.219556093f,0.124158338f,0.0699428469f,0.0393537246f,0.0221341345f,0.0124476347f,0.00699994294f,0.00393637875f,0.00221359241f,0.00124479528f,0.989358246f,-0.977261782f,0.574317753f,0.989042461f,0.717356086f,0.434851229f,0.250292331f,0.141782969f,0.0799146891f,0.0449721329f,0.0252955221f,0.0142257558f,0.0079999147f,0.00449871505f,0.00252981926f,0.00142262306f,0.412118495f,-0.939823508f,0.291259229f,0.999560297f,0.783326924f,0.484776139f,0.280778319f,0.159362778f,0.0898785442f,0.0505891182f,0.0284566563f,0.0160038304f,0.00899987947f,0.00506105041f,0.00284604589f,0.00160045072f,-0.54402113f,-0.612936914f,-0.0206835698f,0.978552461f,0.841470957f,0.533168435f,0.310983568f,0.176892191f,0.099833414f,0.0562044978f,0.0316175036f,0.0177818574f,0.009999834f,0.00562338345f,0.00316227227f,0.0017782785f,-0.999990225f,-0.0972764567f,-0.33057496f,0.926681578f,0.891207397f,0.579875171f,0.340877861f,0.19436565f,0.1097783f,0.0618181042f,0.0347780399f,0.0195598267f,0.0109997792f,0.00618571462f,0.00347849843f,0.00195610616f,-0.536572933f,0.448342979f,-0.60768342f,0.845583618f,0.932039082f,0.624748647f,0.370431304f,0.211777672f,0.119712204f,0.0674297586f,0.0379382223f,0.0213377345f,0.0119997123f,0.0067480444f,0.00379472389f,0.00213393359f,0.420167029f,0.855880976f,-0.824528456f,0.737816215f,0.963558197f,0.667647004f,0.399614304f,0.229122713f,0.129634142f,0.0730392784f,0.0410980321f,0.0231155735f,0.0129996343f,0.00731037185f,0.00411094911f,0.00231176103f,0.990607381f,0.999823332f,-0.959605396f,0.606778562f,0.985449731f,0.708434701f,0.428397775f,0.246395305f,0.139543116f,0.078646481f,0.0442574248f,0.0248933397f,0.0139995432f,0.00787269697f,0.00442717411f,0.00248958869f,0.650287867f,0.835838437f,-0.999518692f,0.456603259f,0.997494996f,0.746982634f,0.456752867f,0.263589978f,0.149438128f,0.0842512026f,0.0474163815f,0.0266710296f,0.0149994381f,0.00843502022f,0.00474339863f,0.00266741589f,-0.287903309f,0.414430231f,-0.940310359f,0.292027086f,0.999573588f,0.783169091f,0.484651238f,0.280701309f,0.159318209f,0.0898532644f,0.0505748577f,0.028448632f,0.015999319f,0.00899733976f,0.00505962269f,0.00284524332f,-0.961397469f,-0.134615138f,-0.78785187f,0.11824052f,0.991664827f,0.81687957f,0.512064993f,0.29772386f,0.169182345f,0.09545248f,0.0537328273f,0.0302261449f,0.0169991814f,0.00955965649f,0.00537584582f,0.00302307028f,-0.750987232f,-0.642200708f,-0.557262897f,-0.0592755191f,0.973847628f,0.84800756f,0.538966715f,0.314652264f,0.179029569f,0.101048686f,0.0568902642f,0.0320035629f,0.0179990288f,0.0101219704f,0.00569206895f,0.00320089748f,0.149877205f,-0.952000856f,-0.271410108f,-0.234921798f,0.946300089f,0.876454532f,0.565329552f,0.331481189f,0.188858896f,0.10664168f,0.060047131f,0.0337808803f,0.0189988576f,0.0106842816f,0.00600829115f,0.00337872445f,0.912945271f,-0.968601942f,0.0413582884f,-0.403158993f,0.909297407f,0.902130723f,0.591127038f,0.348205268f,0.198669314f,0.112231314f,0.0632033944f,0.0355580896f,0.0199986678f,0.011246589f,0.00632451288f,0.00355655141f,0.836655617f,-0.686891198f,0.35002476f,-0.558680534f,0.863209307f,0.924954832f,0.616333544f,0.364819258f,0.208459899f,0.117817394f,0.0663590282f,0.0373351872f,0.0209984574f,0.0118088927f,0.00664073415f,0.00373437814f,-0.00885130931f,-0.193630233f,0.623979926f,-0.696581721f,0.808496356f,0.944854796f,0.640923738f,0.381317884f,0.218229622f,0.123399742f,0.0695140064f,0.0391121693f,0.0219982266f,0.0123711927f,0.00695695449f,0.00391220488f,-0.846220434f,0.359264523f,0.836055279f,-0.812512875f,0.745705247f,0.961767614f,0.664873064f,0.397695929f,0.227977514f,0.128978193f,0.0726682767f,0.0408890247f,0.0229979735f,0.0129334899f,0.00727317436f,0.00409003161f,-0.905578375f,0.801513135f,0.965219259f,-0.902817786f,0.67546314f,0.97563988f,0.688157499f,0.413948208f,0.237702623f,0.134552568f,0.0758218244f,0.0426657498f,0.0239976961f,0.0134957815f,0.0075893933f,0.00426785741f,-0.132351756f,0.996909976f,0.998663187f,-0.964648306f,0.598472118f,0.986427724f,0.710753918f,0.430069596f,0.247403964f,0.140122697f,0.0789746121f,0.0444423407f,0.0249973964f,0.0140580693f,0.00790561177f,0.00444568414f,0.76255846f,0.885276794f,0.933070183f,-0.996054351f,0.515501261f,0.994096994f,0.732639611f,0.446054995f,0.257080555f,0.145688385f,0.0821266174f,0.0462187938f,0.0259970706f,0.0146203535f,0.00822182931f,0.00462350994f,0.956375957f,0.500994205f,0.774945021f,-0.996045172f,0.427379847f,0.99862349f,0.753792703f,0.46189931f,0.266731411f,0.151249468f,0.0852777958f,0.0479951017f,0.0269967206f,0.015182632f,0.00853804592f,0.00480133574f,0.270905793f,-0.0375856608f,0.539968967f,-0.964621305f,0.334988207f,0.999992907f,0.774192095f,0.477597594f,0.276355654f,0.156805754f,0.0884281173f,0.049771253f,0.0279963426f,0.0157449059f,0.0088542616f,0.00497916201f,-0.663633883f,-0.564589798f,0.251445323f,-0.902773678f,0.239249229f,0.998200953f,0.793817401f,0.49314484f,0.28595221f,0.162357092f,0.0915775672f,0.0515472479f,0.0289959367f,0.0163071752f,0.00917047635f,0.00515698735f,-0.988031626f,-0.917709649f,-0.0620148405f,-0.812452853f,0.141120002f,0.993253171f,0.812648892f,0.5085361f,0.295520186f,0.167903304f,0.0947260931f,0.0533230826f,0.029995501f,0.0168694388f,0.00948669016f,0.00533481315f,-0.404037654f,-0.988192797f,-0.369325012f,-0.696507812f,0.0415805206f,0.985165298f,0.830667794f,0.523766637f,0.305058628f,0.173444211f,0.0978736654f,0.055098746f,0.0309950355f,0.0174316969f,0.00980290305f,0.00551263802f,0.551426709f,-0.754330218f,-0.640009403f,-0.5585953f,-0.0583741926f,0.973962843f,0.847856104f,0.538831532f,0.314566553f,0.17897962f,0.101020269f,0.0568742342f,0.0319945402f,0.0179939512f,0.0101191159f,0.00569046335f,0.999911845f,-0.28814739f,-0.847224355f,-0.403064936f,-0.157745644f,0.959681332f,0.864196658f,0.553726017f,0.324043006f,0.184509367f,0.10416586f,0.0586495437f,0.0329940096f,0.0185561981f,0.010435327f,0.00586828869f,0.529082716f,0.266779721f,-0.97042042f,-0.234822124f,-0.255541205f,0.942365825f,0.879673064f,0.568445385f,0.333487093f,0.190033287f,0.107310407f,0.0604246669f,0.0339934528f,0.0191184394f,0.010751537f,0.00604611309f,-0.428182662f,0.739542127f,-0.997380435f,-0.0591726787f,-0.350783229f,0.92207104f,0.894269884f,0.582984984f,0.342897803f,0.195551202f,0.110453881f,0.0621996038f,0.034992855f,0.0196806751f,0.0110677453f,0.00622393796f,-0.991778851f,0.984540582f,-0.925431013f,0.118342586f,-0.442520559f,0.89886117f,0.907972515f,0.597340286f,0.352274209f,0.201062918f,0.113596253f,0.0639743358f,0.0359922275f,0.0202429052f,0.0113839535f,0.0064017619f,-0.643538117f,0.926318109f,-0.761706948f,0.292125374f,-0.529836178f,0.872809589f,0.920767248f,0.611506701f,0.361615449f,0.206568271f,0.116737492f,0.0657488778f,0.036991559f,0.0208051261f,0.0117001599f,0.0065795863f,0.296368569f,0.58280617f,-0.522444785f,0.456694692f,-0.611857831f,0.84399873f,0.932641268f,0.625479698f,0.370920479f,0.212067112f,0.119877554f,0.0675232038f,0.0379908569f,0.0213673431f,0.0120163653f,0.00675741071f,0.963795364f,0.0598003156f,-0.231372014f,0.606860459f,-0.687766254f,0.81251961f,0.943582714f,0.639254928f,0.380188406f,0.217559248f,0.123016424f,0.0692973137f,0.0389901139f,0.0219295528f,0.0123325698f,0.00693523418f,0.745113134f,-0.481621295f,0.0826458037f,0.737885714f,-0.756802499f,0.778471708f,0.953580678f,0.652827978f,0.389418334f,0.223044485f,0.126154065f,0.0710712075f,0.0399893373f,0.0224917568f,0.0126487734f,0.00711305765f,-0.158622667f,-0.874714017f,0.388467699f,0.845638454f,-0.818277061f,0.74196279f,0.962625206f,0.666194677f,0.39860931f,0.228522688f,0.129290432f,0.0728448778f,0.0409885161f,0.0230539497f,0.0129649751f,0.00729088066f,-0.916521549f,-0.998410463f,0.655764699f,0.926720202f,-0.871575892f,0.703108132f,0.970707119f,0.679350674f,0.407760441f,0.233993664f,0.132425532f,0.0746183172f,0.0419876575f,0.0236161388f,0.0132811759f,0.00746870413f,-0.831774771f,-0.814614236f,0.858030677f,0.97857362f,-0.916166008f,0.662030637f,0.977818429f,0.692291796f,0.416870773f,0.23945722f,0.135559291f,0.0763915181f,0.0429867506f,0.0241783205f,0.0135973748f,0.00764652714f,0.0177019257f,-0.37993139f,0.975206196f,0.999563396f,-0.951602101f,0.618860185f,0.983951986f,0.70501405f,0.425939471f,0.244913206f,0.138691694f,0.0781644881f,0.0439858064f,0.0247404929f,0.0139135728f,0.00782434922f,0.850903511f,0.171763569f,0.995670974f,0.989027262f,-0.977530122f,0.57373327f,0.989101648f,0.717513323f,0.434965521f,0.250361472f,0.141822711f,0.0799371973f,0.0449848175f,0.0253026579f,0.0142297689f,0.00800217129f,0.901788354f,0.670557022f,0.917395473f,0.947297752f,-0.993690968f,0.526792526f,0.993262351f,0.72978574f,0.44394809f,0.255801797f,0.144952312f,0.0817096606f,0.0459837839f,0.0258648153f,0.0145459641f,0.0081799943f,0.123573124f,0.962832689f,0.748142362f,0.875690997f,-0.999923289f,0.478186339f,0.996429801f,0.741827428f,0.452886283f,0.261234075f,0.148080453f,0.0834818557f,0.0469827019f,0.0264269635f,0.0148621574f,0.00835781638f,-0.768254638f,0.958573103f,0.504697084f,0.776465356f,-0.99616462f,0.428068399f,0.99860096f,0.753634512f,0.461779177f,0.266658038f,0.151207119f,0.0852537975f,0.0479815714f,0.0269891042f,0.0151783489f,0.00853563752f,-0.953752637f,0.659090102f,0.211200655f,0.652750373f,-0.982452571f,0.376597136f,0.999773562f,0.765203178f,0.470625877f,0.272073567f,0.15433228f,0.087025471f,0.0489803962f,0.0275512375f,0.0154945394f,0.0087134596f,-0.262374848f,0.156619072f,-0.10324046f,0.508447945f,-0.958924294f,0.32393527f,0.999946535f,0.776529968f,0.47942555f,0.277480543f,0.157455891f,0.0887968615f,0.0499791689f,0.0281133596f,0.0158107281f,0.00889127981f,0.670229197f,-0.394086063f,-0.407444149f,0.3481085f,-0.925814748f,0.270249337f,0.99911958f,0.787611187f,0.48817724f,0.282878697f,0.160577938f,0.0905679762f,0.0509778969f,0.0286754742f,0.0161269177f,0.00906910095f,0.986627579f,-0.823421597f,-0.671240151f,0.176790684f,-0.883454502f,0.215709001f,0.997293651f,0.798443377f,0.496880114f,0.28826794f,0.163698375f,0.0923388004f,0.051976569f,0.0292375814f,0.0164431017f,0.00924692024f,0.395925164f,-0.999157965f,-0.868469954f,-0.000103020677f,-0.832267344f,0.160486728f,0.994470477f,0.809023023f,0.505533338f,0.293648034f,0.166817173f,0.0941093415f,0.0529751927f,0.0297996756f,0.0167592876f,0.00942474138f,-0.558789074f,-0.867171526f,-0.979574919f,-0.176993474f,-0.772764444f,0.104756832f,0.990652919f,0.819346905f,0.514135957f,0.29901889f,0.169934288f,0.0958795771f,0.0539737605f,0.0303617641f,0.0170754679f,0.00960256159f,-0.999755144f,-0.468111664f,-0.993535519f,-0.348301649f,-0.705540299f,0.0486960001f,0.985844791f,0.829411685f,0.522687256f,0.304380238f,0.173049718f,0.0976495072f,0.0549722798f,0.0309238415f,0.01739165f,0.00978038087f,-0.521551013f,0.0751182064f,-0.908967435f,-0.508624554f,-0.631266713f,-0.00751878507f,0.980050862f,0.839214146f,0.531186223f,0.30973196f,0.17616342f,0.0994191393f,0.0559707358f,0.0314859077f,0.0177078284f,0.00995820016f,0.436164767f,0.595211506f,-0.734258294f,-0.652905703f,-0.550685287f,-0.0637097955f,0.973276973f,0.848751247f,0.539632022f,0.315073937f,0.179275364f,0.101188451f,0.0569691435f,0.0320479684f,0.0180240069f,0.0101360194f,0.992872655f,0.931992829f,-0.486733496f,-0.776594579f,-0.464602023f,-0.119699396f,0.965529919f,0.858020008f,0.548023939f,0.3204059f,0.182385504f,0.102957435f,0.0579674877f,0.0326100141f,0.0183401816f,0.0103138378f,0.636738002f,0.981735826f,-0.190938011f,-0.87579f,-0.373876572f,-0.175310582f,0.956817448f,0.867017388f,0.55636102f,0.325727791f,0.185493827f,0.104726106f,0.0589657798f,0.0331720486f,0.0186563563f,0.0104916561f,-0.304810613f,0.729123712f,0.12379095f,-0.947363734f,-0.279415488f,-0.230367512f,0.947148204f,0.875740528f,0.564642429f,0.33103931f,0.188600287f,0.106494442f,0.0599640086f,0.0337340795f,0.0189725272f,0.0106694745f,-0.966117799f,0.251952261f,0.426245421f,-0.98905772f,-0.182162598f,-0.284696162f,0.936531842f,0.884186864f,0.572867453f,0.336340427f,0.191704854f,0.108262435f,0.0609621815f,0.0342960916f,0.0192886982f,0.0108472919f,-0.739180684f,-0.302812874f,0.686427653f,-0.999557257f,-0.0830891207f,-0.338124752f,0.924979091f,0.892353535f,0.581035137f,0.341630876f,0.194807529f,0.110030092f,0.0619602874f,0.0348580964f,0.0196048655f,0.0110251084f,0.167355701f,-0.764320076f,0.878538549f,-0.978531301f,0.0168140903f,-0.390484393f,0.912501454f,0.900238097f,0.589144766f,0.346910536f,0.197908238f,0.111797392f,0.0629583374f,0.0354200937f,0.0199210308f,0.0112029258f};
#define LAS __attribute__((address_space(3)))
#define XB_TMO      128
#define XB_XCNT(j)  (256  + 64 * (j))
#define XB_XSUB(j)  (1280 + 64 * (j))
#define XB_XGEN(j)  (2304 + 64 * (j))
#define XB_TOP      3328
#define XB_TOPGEN   3392
#define XCD_BAR_WORDS 3456
#define XB_SPIN_CAP (1u << 18)

__device__ __forceinline__ unsigned xb_ld(unsigned* p)              { return __hip_atomic_load(p, __ATOMIC_RELAXED, __HIP_MEMORY_SCOPE_AGENT); }
__device__ __forceinline__ unsigned xb_add(unsigned* p, unsigned v) { return __hip_atomic_fetch_add(p, v, __ATOMIC_RELAXED, __HIP_MEMORY_SCOPE_AGENT); }
__device__ __forceinline__ unsigned xb_xcc_id() { return (unsigned)__builtin_amdgcn_s_getreg((3 << 11) | 20) & 0xFu; }
#define XB_SPIN(cond, bar) do { unsigned _sp = 0; while (cond) { __builtin_amdgcn_s_sleep(1); \
    if ((++_sp & 255u) == 0u) { if (xb_ld(&(bar)[XB_TMO])) break; if (_sp > XB_SPIN_CAP) { atomicAdd(&(bar)[XB_TMO], 1u); break; } } } } while (0)

struct XcdBarrier {
    unsigned* bar; unsigned x;
    volatile LAS unsigned* st;
};

__device__ __forceinline__ XcdBarrier xcd_barrier_post(unsigned* bar, volatile LAS unsigned* st) {
    XcdBarrier b; b.bar = bar; b.x = xb_xcc_id(); b.st = st;
    if (threadIdx.x == 0) (void)xb_add(&bar[XB_XCNT(b.x)], 1u);
    return b;
}
__device__ __forceinline__ void xcd_barrier_complete(unsigned* bar, unsigned x, unsigned& nloc, unsigned& nx) {
    const unsigned G = gridDim.x * gridDim.y * gridDim.z;
    unsigned sum, cnt, mine, sp = 0u;
    for (;;) {
        sum = 0u; cnt = 0u; mine = 0u;
#pragma unroll
        for (unsigned j = 0; j < 16; ++j) { const unsigned c = xb_ld(&bar[XB_XCNT(j)]); sum += c; cnt += (c > 0u) ? 1u : 0u; mine = (j == x) ? c : mine; }
        if (sum == G) break;
        __builtin_amdgcn_s_sleep(1);
        if ((++sp & 255u) == 0u) { if (xb_ld(&bar[XB_TMO])) break; if (sp > XB_SPIN_CAP) { atomicAdd(&bar[XB_TMO], 1u); break; } }
    }
    nloc = mine > 0u ? mine : 1u; nx = cnt > 0u ? cnt : 1u;
}

__device__ __forceinline__ void xcd_barrier(const XcdBarrier& b) {
    asm volatile("s_waitcnt vmcnt(0)" ::: "memory");
    __syncthreads();
    if (threadIdx.x == 0) {
        unsigned* bar = b.bar;
        __builtin_amdgcn_s_waitcnt(0);
        unsigned nloc = b.st[0], nx = b.st[1];
        if (nloc == 0u) { xcd_barrier_complete(bar, b.x, nloc, nx); b.st[0] = nloc; b.st[1] = nx; }
        const unsigned old = xb_add(&bar[XB_XSUB(b.x)], 1u);
        const unsigned gen = old / nloc;
        if (old + 1u == (gen + 1u) * nloc) {
            __builtin_amdgcn_fence(__ATOMIC_RELEASE, "agent");
            asm volatile("s_waitcnt vmcnt(0)" ::: "memory");
            const unsigned og = xb_add(&bar[XB_TOP], 1u);
            const unsigned tg = og / nx;
            if (og + 1u == (tg + 1u) * nx) xb_add(&bar[XB_TOPGEN], 1u);
            else XB_SPIN(xb_ld(&bar[XB_TOPGEN]) == tg, bar);
            __builtin_amdgcn_fence(__ATOMIC_ACQUIRE, "agent");
            xb_add(&bar[XB_XGEN(b.x)], 1u);
            asm volatile("s_waitcnt vmcnt(0)" ::: "memory");
        } else {
            XB_SPIN(xb_ld(&bar[XB_XGEN(b.x)]) == gen, bar);
            __builtin_amdgcn_fence(__ATOMIC_ACQUIRE, "agent");
            asm volatile("s_waitcnt vmcnt(0)" ::: "memory");
        }
    }
    __syncthreads();
}

#define DI __device__ __forceinline__
#define LAS __attribute__((address_space(3)))
typedef unsigned short bf16;
typedef short bf16x8 __attribute__((ext_vector_type(8)));
typedef float f32x4 __attribute__((ext_vector_type(4)));
typedef unsigned u32x4 __attribute__((ext_vector_type(4)));
typedef unsigned u32x2 __attribute__((ext_vector_type(2)));

#ifndef COOP
#define COOP 1
#endif

constexpr int D = 1024, NBATCH = 4, SEQ = 4096, CTXL = 256, NLAT = NBATCH * SEQ, NCTX = NBATCH * CTXL, MT = NLAT + NCTX;
constexpr int FF = 2816, KEYS = SEQ + CTXL;
constexpr int LDP0 = 2560, LDP1 = 3072;
constexpr int C_AQ = 0, C_AK = 512, C_AV = 640, C_BQ = 768, C_BK = 1024, C_BV = 1280, C_BO = 1792, C_RF = 2304, C_RB = 2320;
constexpr float LOG2E = 1.4426950408889634f, EPS = 1e-6f;
constexpr int NCHUNK = 68;

constexpr size_t MiB = 1u << 20;
constexpr size_t WS_CTL = 0, WS_MOD = 1 * MiB, WS_XC = 2 * MiB, WS_WABI = 6 * MiB, WS_WABO = 11 * MiB, WS_WFI = 13 * MiB, WS_WFO = 35 * MiB, WS_WNI = 46 * MiB, WS_WNO = 52 * MiB;
constexpr size_t WS_HO = 54 * MiB, WS_YF = 88 * MiB, WS_P = 122 * MiB, WS_STC = 224 * MiB, WS_DEC = 228 * MiB, WS_END = 229 * MiB;
constexpr int LDS_BYTES = 147456;
constexpr int NWAVES = 8, NTHR = 512;

DI float bf2f(unsigned short h) { return __uint_as_float(((unsigned)h) << 16); }
DI unsigned pk2(float lo, float hi) { return pg8::cvt_pk_bf16(lo, hi); }
DI float wave_sum(float v) {
#pragma unroll
    for (int o = 1; o < 64; o <<= 1) v += __shfl_xor(v, o);
    return v;
}
DI float fast_exp2(float x) { return __builtin_amdgcn_exp2f(x); }
DI float silu_f(float g) { return g * __builtin_amdgcn_rcpf(1.0f + __expf(-g)); }
DI void unpack8(const bf16x8 v, float (&o)[8]) {
#pragma unroll
    for (int i = 0; i < 8; ++i) o[i] = bf2f((unsigned short)v[i]);
}
DI bf16x8 pack8(const float (&p)[8]) {
    u32x4 w; w.x = pk2(p[0], p[1]); w.y = pk2(p[2], p[3]); w.z = pk2(p[4], p[5]); w.w = pk2(p[6], p[7]);
    return __builtin_bit_cast(bf16x8, w);
}
#define MFMA16(a, b, c) __builtin_amdgcn_mfma_f32_16x16x32_bf16((a), (b), (c), 0, 0, 0)

struct EpiStore {
    static constexpr bool PERM = true, AFTER_DRAIN = false;
    bf16* O; int ldc;
    DI void operator()(const pg8::f32x4 (&acc)[2][2][4][2], const pg8::Unit& u, int wr, int wc, int fr, int fq) const {
        const int row0 = u.pm * 256 + wr * 64 + fr, col0 = u.pn * 256 + wc * 32 + 8 * fq;
#pragma unroll
        for (int ai = 0; ai < 2; ++ai)
#pragma unroll
            for (int m = 0; m < 4; ++m) { bf16* rowp = O + (size_t)(row0 + ai * 128 + m * 16) * ldc + col0;
#pragma unroll
                for (int bj = 0; bj < 2; ++bj) { const pg8::f32x4 v0 = acc[ai][bj][m][0], v1 = acc[ai][bj][m][1];
                    u32x4 w; w.x = pk2(v0[0], v0[1]); w.y = pk2(v0[2], v0[3]); w.z = pk2(v1[0], v1[1]); w.w = pk2(v1[2], v1[3]);
                    *(u32x4*)(rowp + bj * 128) = w; } }
    }
};
struct EpiSwiglu {
    static constexpr bool PERM = true, AFTER_DRAIN = false;
    bf16* O; int ldc;
    DI void operator()(const pg8::f32x4 (&acc)[2][2][4][2], const pg8::Unit& u, int wr, int wc, int fr, int fq) const {
        const int row0 = u.pm * 256 + wr * 64 + fr, col0 = u.pn * 128 + wc * 32 + 8 * fq;
#pragma unroll
        for (int ai = 0; ai < 2; ++ai)
#pragma unroll
            for (int m = 0; m < 4; ++m) { bf16* rowp = O + (size_t)(row0 + ai * 128 + m * 16) * ldc + col0;
                const pg8::f32x4 g0 = acc[ai][0][m][0], g1 = acc[ai][0][m][1], u0 = acc[ai][1][m][0], u1 = acc[ai][1][m][1];
                u32x4 w; w.x = pk2(silu_f(g0[0]) * u0[0], silu_f(g0[1]) * u0[1]); w.y = pk2(silu_f(g0[2]) * u0[2], silu_f(g0[3]) * u0[3]);
                w.z = pk2(silu_f(g1[0]) * u1[0], silu_f(g1[1]) * u1[1]); w.w = pk2(silu_f(g1[2]) * u1[2], silu_f(g1[3]) * u1[3]);
                *(u32x4*)rowp = w; }
    }
};

struct Args { const float* in[23]; float* out; unsigned char* ws; int ph_lo, ph_hi; };
enum { I_X = 0, I_C, I_CTX, I_CCTX, I_WMOD, I_BMOD, I_GMPRE, I_GMPOST, I_GFPRE, I_GFPOST, I_WFI, I_WFO, I_ABWI, I_ABWO, I_SINK, I_GFW, I_GFB, I_GBW, I_GBB, I_GNORM, I_NAWI, I_NAWO, I_RELB };

DI void transpose_item(const float* W, int K, int N, bf16* WT, int k0, int n0, int drow0, LAS float* scr, int lane) {
#pragma unroll 8
    for (int i = 0; i < 32; ++i) { const int kk = 2 * i + (lane >> 5); scr[kk * 33 + (lane & 31)] = W[(size_t)(k0 + kk) * N + n0 + (lane & 31)]; }
    asm volatile("s_waitcnt lgkmcnt(0)" ::: "memory");
    const int c = lane & 7;
#pragma unroll
    for (int j = 0; j < 4; ++j) { const int n = (lane >> 3) + 8 * j; const LAS float* s = scr + (8 * c) * 33 + n;
        u32x4 o; o.x = pk2(s[0 * 33], s[1 * 33]); o.y = pk2(s[2 * 33], s[3 * 33]); o.z = pk2(s[4 * 33], s[5 * 33]); o.w = pk2(s[6 * 33], s[7 * 33]);
        *(u32x4*)(WT + (size_t)(drow0 + n) * K + k0 + 8 * c) = o; }
    asm volatile("s_waitcnt lgkmcnt(0)" ::: "memory");
}
DI void xpose_plain(const float* W, int K, int N, bf16* WT, int item, LAS float* scr, int lane) {
    const int nblk = N / 32, kb = item / nblk, nb = item % nblk;
    transpose_item(W, K, N, WT, 64 * kb, 32 * nb, 32 * nb, scr, lane);
}
DI void xpose_ffnin(const float* W, bf16* WT, int item, LAS float* scr, int lane) {
    const int nblk = 5632 / 32, kb = item / nblk, nb = item % nblk, n0 = 32 * nb;
    const int bj = n0 >= FF ? 1 : 0, cc = n0 - bj * FF, drow0 = 256 * (cc >> 7) + 128 * bj + (cc & 127);
    transpose_item(W, 1024, 5632, WT, 64 * kb, n0, drow0, scr, lane);
}

DI void phase_prologue(const Args& a, LAS unsigned char* lds, int tid, int lane, int wave) {
    unsigned char* ws = a.ws;
    {
        LAS float* sl = (LAS float*)lds;
        LAS float* red = (LAS float*)(lds + 32768);
        for (int i = tid; i < 5 * 1024; i += NTHR) { const int s = i >> 10, k = i & 1023; const float v = s < 4 ? a.in[I_C][s * 1024 + k] : a.in[I_CCTX][k]; sl[i] = v / (1.0f + __expf(-v)); }
        __syncthreads();
        for (int u = blockIdx.x; u < 192; u += gridDim.x) {
            const int layer = u / 96, col = (u % 96) * 64 + lane;
            const float* W = a.in[I_WMOD] + (size_t)layer * 1024 * 6144 + col;
            float acc[5] = {0.f, 0.f, 0.f, 0.f, 0.f};
            const int kb = wave * 128;
#pragma unroll 8
            for (int k = 0; k < 128; ++k) { const float w = W[(size_t)(kb + k) * 6144];
#pragma unroll
                for (int s = 0; s < 5; ++s) acc[s] += sl[s * 1024 + kb + k] * w; }
#pragma unroll
            for (int s = 0; s < 5; ++s) red[(wave * 5 + s) * 64 + lane] = acc[s];
            __syncthreads();
            if (tid < 320) { const int s = tid >> 6, l = tid & 63; float t = 0.f;
#pragma unroll
                for (int w = 0; w < 8; ++w) t += red[(w * 5 + s) * 64 + l];
                const int c2 = (u % 96) * 64 + l;
                ((float*)(ws + WS_MOD))[(size_t)(layer * 5 + s) * 6144 + c2] = t + a.in[I_BMOD][layer * 6144 + c2]; }
            __syncthreads();
        }
        __syncthreads();
    }
    LAS float* scr = (LAS float*)(lds + wave * 16384);
    const int gw = blockIdx.x * NWAVES + wave, NGW = gridDim.x * NWAVES;
    constexpr int I_1 = 16 * 73, I_2 = 16 * 32, I_3 = 16 * 176, I_4 = 44 * 32, I_5 = 16 * 96, I_6 = 16 * 32;
    constexpr int NITEMS = I_1 + I_2 + 2 * I_3 + 2 * I_4 + I_5 + I_6;
    for (int it = gw; it < NITEMS; it += NGW) {
        int r = it;
        if (r < I_1) { xpose_plain(a.in[I_ABWI], 1024, 2336, (bf16*)(ws + WS_WABI), r, scr, lane); continue; } r -= I_1;
        if (r < I_2) { xpose_plain(a.in[I_ABWO], 1024, 1024, (bf16*)(ws + WS_WABO), r, scr, lane); continue; } r -= I_2;
        if (r < I_3) { xpose_ffnin(a.in[I_WFI], (bf16*)(ws + WS_WFI), r, scr, lane); continue; } r -= I_3;
        if (r < I_3) { xpose_ffnin(a.in[I_WFI] + (size_t)1024 * 5632, (bf16*)(ws + WS_WFI) + (size_t)5632 * 1024, r, scr, lane); continue; } r -= I_3;
        if (r < I_4) { xpose_plain(a.in[I_WFO], FF, 1024, (bf16*)(ws + WS_WFO), r, scr, lane); continue; } r -= I_4;
        if (r < I_4) { xpose_plain(a.in[I_WFO] + (size_t)FF * 1024, FF, 1024, (bf16*)(ws + WS_WFO) + (size_t)1024 * FF, r, scr, lane); continue; } r -= I_4;
        if (r < I_5) { xpose_plain(a.in[I_NAWI], 1024, 3072, (bf16*)(ws + WS_WNI), r, scr, lane); continue; } r -= I_5;
        xpose_plain(a.in[I_NAWO], 1024, 1024, (bf16*)(ws + WS_WNO), r, scr, lane);
    }
    { u32x4* z = (u32x4*)((bf16*)(ws + WS_WABI) + (size_t)2336 * 1024); const u32x4 zero = {0u, 0u, 0u, 0u};
      for (int i = blockIdx.x * NTHR + tid; i < 224 * 128; i += gridDim.x * NTHR) z[i] = zero; }
}

DI void row_op(const float* xsrc, const bf16* y, const float* gpost, const float* gate, float* xdst,
               const float* gpre, const float* shift, const float* scale, bf16* hdst, int lane) {
    f32x4 v[4];
#pragma unroll
    for (int j = 0; j < 4; ++j) v[j] = *((const f32x4*)xsrc + lane + 64 * j);
    if (y) {
        f32x4 yv[4]; float s = 0.f;
#pragma unroll
        for (int j = 0; j < 4; ++j) { const u32x2 w = *((const u32x2*)y + lane + 64 * j);
            yv[j] = (f32x4){__uint_as_float(w.x << 16), __uint_as_float(w.x & 0xffff0000u), __uint_as_float(w.y << 16), __uint_as_float(w.y & 0xffff0000u)};
            s += (yv[j].x * yv[j].x + yv[j].y * yv[j].y) + (yv[j].z * yv[j].z + yv[j].w * yv[j].w); }
        const float rstd = __builtin_amdgcn_rsqf(wave_sum(s) * (1.0f / D) + EPS);
#pragma unroll
        for (int j = 0; j < 4; ++j) { const f32x4 gp = *((const f32x4*)gpost + lane + 64 * j), gt = *((const f32x4*)gate + lane + 64 * j);
            v[j] = v[j] + gt * (yv[j] * rstd * gp); }
    }
    if (xdst) {
#pragma unroll
        for (int j = 0; j < 4; ++j) *((f32x4*)xdst + lane + 64 * j) = v[j];
    }
    if (hdst) {
        float s = 0.f;
#pragma unroll
        for (int j = 0; j < 4; ++j) s += (v[j].x * v[j].x + v[j].y * v[j].y) + (v[j].z * v[j].z + v[j].w * v[j].w);
        const float rstd = __builtin_amdgcn_rsqf(wave_sum(s) * (1.0f / D) + EPS);
#pragma unroll
        for (int j = 0; j < 4; ++j) { const f32x4 gp = *((const f32x4*)gpre + lane + 64 * j), sh = *((const f32x4*)shift + lane + 64 * j), sc = *((const f32x4*)scale + lane + 64 * j);
            const f32x4 h = v[j] * rstd * gp * (sc + 1.0f) + sh;
            u32x2 w; w.x = pk2(h.x, h.y); w.y = pk2(h.z, h.w);
            *((u32x2*)hdst + lane + 64 * j) = w; }
    }
}
DI void phase_rows(const Args& a, int mode, int layer, int lane, int wave) {
    unsigned char* ws = a.ws;
    const float* MOD = (const float*)(ws + WS_MOD);
    bf16* H = (bf16*)(ws + WS_HO); const bf16* YF = (const bf16*)(ws + WS_YF); float* XC = (float*)(ws + WS_XC);
    const int gw = blockIdx.x * NWAVES + wave, NGW = gridDim.x * NWAVES;
    const int nrows = (layer == 0) ? MT : NLAT;
    for (int m = gw; m < nrows; m += NGW) {
        const bool lat = m < NLAT; const int s = lat ? (m >> 12) : 4;
        const float* mod = MOD + (size_t)(layer * 5 + s) * 6144;
        float* xcur = lat ? a.out + (size_t)m * D : XC + (size_t)(m - NLAT) * D;
        if (mode == 0) {
            const float* xin = lat ? a.in[I_X] + (size_t)m * D : a.in[I_CTX] + (size_t)(m - NLAT) * D;
            row_op(xin, nullptr, nullptr, nullptr, nullptr, a.in[I_GMPRE], mod, mod + 1024, H + (size_t)m * D, lane);
        } else if (mode == 1) {
            const float* xin = (layer == 0) ? (lat ? a.in[I_X] + (size_t)m * D : a.in[I_CTX] + (size_t)(m - NLAT) * D) : xcur;
            row_op(xin, YF + (size_t)m * D, a.in[I_GMPOST] + layer * D, mod + 2048, xcur, a.in[I_GFPRE] + layer * D, mod + 3072, mod + 4096, H + (size_t)m * D, lane);
        } else {
            if (layer == 0) { const float* mod1 = MOD + (size_t)(5 + s) * 6144;
                row_op(xcur, YF + (size_t)m * D, a.in[I_GFPOST], mod + 5120, xcur, a.in[I_GMPRE] + D, mod1, mod1 + 1024, H + (size_t)m * D, lane); }
            else row_op(xcur, YF + (size_t)m * D, a.in[I_GFPOST] + D, mod + 5120, xcur, nullptr, nullptr, nullptr, nullptr, lane);
        }
    }
}

DI float xmax_quads(float x) {
    unsigned u = __float_as_uint(x);
    auto r = __builtin_amdgcn_permlane16_swap(u, u, false, false);
    u = __float_as_uint(fmaxf(__uint_as_float(r[0]), __uint_as_float(r[1])));
    auto r2 = __builtin_amdgcn_permlane32_swap(u, u, false, false);
    return fmaxf(__uint_as_float(r2[0]), __uint_as_float(r2[1]));
}
DI float xsum_quads(float x) {
    unsigned u = __float_as_uint(x);
    auto r = __builtin_amdgcn_permlane16_swap(u, u, false, false);
    u = __float_as_uint(__uint_as_float(r[0]) + __uint_as_float(r[1]));
    auto r2 = __builtin_amdgcn_permlane32_swap(u, u, false, false);
    return __uint_as_float(r2[0]) + __uint_as_float(r2[1]);
}
struct KVFrag { bf16x8 kf[2][2]; bf16x8 vf[4]; };
DI void kv_load(KVFrag& f, const bf16* kp, int kld, const bf16* vp, int vld, int fr, int fq) {
#pragma unroll
    for (int h = 0; h < 2; ++h)
#pragma unroll
        for (int ks = 0; ks < 2; ++ks) f.kf[h][ks] = *(const bf16x8*)(kp + (size_t)((fr >> 2) * 8 + h * 4 + (fr & 3)) * kld + ks * 32 + fq * 8);
#pragma unroll
    for (int nt = 0; nt < 4; ++nt) f.vf[nt] = *(const bf16x8*)(vp + (size_t)(nt * 16 + fr) * vld + fq * 8);
}
template <int MODE>
DI void attn_one(f32x4 (&o)[4], float& mrun, float& lrun, const bf16x8 (&qf)[2], const KVFrag& f, float sc2, int d0, unsigned okmask, const float (&bias)[8]) {
    f32x4 s0 = {0.f, 0.f, 0.f, 0.f}, s1 = {0.f, 0.f, 0.f, 0.f};
    s0 = MFMA16(f.kf[0][0], qf[0], s0); s0 = MFMA16(f.kf[0][1], qf[1], s0);
    s1 = MFMA16(f.kf[1][0], qf[0], s1); s1 = MFMA16(f.kf[1][1], qf[1], s1);
    float sv[8] = {s0[0], s0[1], s0[2], s0[3], s1[0], s1[1], s1[2], s1[3]};
    float mx = -1e30f;
#pragma unroll
    for (int i = 0; i < 8; ++i) {
        float t = sv[i] * sc2;
        if (MODE == 1) { const int dd = d0 - i; t = (dd >= -128 && dd <= 128) ? t : -1e30f; }
        if (MODE == 2) { t = ((okmask >> i) & 1u) ? t + bias[i] : -1e30f; }
        sv[i] = t; mx = fmaxf(mx, t);
    }
    mx = xmax_quads(mx);
    if (__builtin_amdgcn_ballot_w64(mx > mrun) != 0ull) {
        const float mn = fmaxf(mrun, mx), alpha = fast_exp2(mrun - mn);
        lrun *= alpha; mrun = mn;
#pragma unroll
        for (int nt = 0; nt < 4; ++nt) o[nt] = o[nt] * alpha;
    }
    float p[8], ps = 0.f;
#pragma unroll
    for (int i = 0; i < 8; ++i) { p[i] = fast_exp2(sv[i] - mrun); ps += p[i]; }
    lrun += xsum_quads(ps);
    const bf16x8 pf = pack8(p);
#pragma unroll
    for (int nt = 0; nt < 4; ++nt) o[nt] = MFMA16(f.vf[nt], pf, o[nt]);
}
DI void attn_store1(const f32x4 (&o)[4], float lrun, bf16* op, int fq) {
    const float inv = 1.0f / lrun;
#pragma unroll
    for (int nt = 0; nt < 4; ++nt) { u32x2 w; w.x = pk2(o[nt][0] * inv, o[nt][1] * inv); w.y = pk2(o[nt][2] * inv, o[nt][3] * inv);
        *(u32x2*)(op + nt * 16 + fq * 4) = w; }
}

DI void window_attn_tile(const Args& a, int wt, int lane) {
    const bf16* P = (const bf16*)(a.ws + WS_P); const bf16* VtA = (const bf16*)(a.ws + WS_YF); bf16* O = (bf16*)(a.ws + WS_HO);
    const int fr = lane & 15, fq = lane >> 4;
    const bool isctx = wt >= 2048;
    int b, kvh, q0; size_t qrow;
    if (!isctx) { b = wt >> 9; kvh = (wt >> 8) & 1; q0 = (wt & 255) * 16; qrow = (size_t)b * SEQ + q0 + fr; }
    else { const int ct = wt - 2048; b = ct >> 5; kvh = (ct >> 4) & 1; q0 = (ct & 15) * 16; qrow = (size_t)NLAT + b * CTXL + q0 + fr; }
    bf16x8 qf[4][2]; f32x4 o[4][4]; float mrun[4], lrun[4];
#pragma unroll
    for (int g = 0; g < 4; ++g) {
#pragma unroll
        for (int ks = 0; ks < 2; ++ks) qf[g][ks] = *(const bf16x8*)(P + qrow * LDP0 + C_AQ + (kvh * 4 + g) * 64 + ks * 32 + fq * 8);
#pragma unroll
        for (int nt = 0; nt < 4; ++nt) o[g][nt] = (f32x4){0.f, 0.f, 0.f, 0.f};
        mrun[g] = a.in[I_SINK][kvh * 4 + g] * LOG2E; lrun[g] = 1.0f;
    }
    const float sc2 = 0.125f * LOG2E;
    const float nob[8] = {0.f, 0.f, 0.f, 0.f, 0.f, 0.f, 0.f, 0.f};
    const bf16* vbase = VtA + (size_t)((b * 2 + kvh) * 64) * KEYS;
    const bf16* kctx = P + (size_t)(NLAT + b * CTXL) * LDP0 + C_AK + kvh * 64;
    const bf16* kloc = P + (size_t)(b * SEQ) * LDP0 + C_AK + kvh * 64;
    const int tlo = (q0 - 128 > 0 ? q0 - 128 : 0) & ~31, thi = (q0 + 16 + 128 < SEQ) ? q0 + 16 + 128 : SEQ;
    const int ntile = isctx ? 8 : 8 + (thi - tlo + 31) / 32;
#define WIN_LOAD(F, t) do { const int t_ = (t); const int k0_ = t_ < 8 ? t_ * 32 : tlo + (t_ - 8) * 32; \
        kv_load(F, (t_ < 8 ? kctx : kloc) + (size_t)k0_ * LDP0, LDP0, vbase + (t_ < 8 ? SEQ : 0) + k0_, KEYS, fr, fq); } while (0)
#define WIN_PROC(F, t) do { const int t_ = (t); const int d0_ = t_ < 8 ? 0 : q0 + fr - (tlo + (t_ - 8) * 32) - fq * 8; \
        _Pragma("unroll") for (int g = 0; g < 4; ++g) attn_one<1>(o[g], mrun[g], lrun[g], qf[g], F, sc2, d0_, 0u, nob); } while (0)
    KVFrag A, B;
    WIN_LOAD(A, 0);
    for (int t = 0; t < ntile; t += 2) {
        WIN_LOAD(B, (t + 1 < ntile ? t + 1 : ntile - 1));
        WIN_PROC(A, t);
        WIN_LOAD(A, (t + 2 < ntile ? t + 2 : ntile - 1));
        if (t + 1 < ntile) WIN_PROC(B, t + 1);
    }
#undef WIN_LOAD
#undef WIN_PROC
#pragma unroll
    for (int g = 0; g < 4; ++g) attn_store1(o[g], lrun[g], O + qrow * D + (kvh * 4 + g) * 64, fq);
}

template <int NR>
DI void na_attn_group(const Args& a, int gid, int lane, LAS float* btab  ) {
    const bf16* P = (const bf16*)(a.ws + WS_P); const bf16* VtC = (const bf16*)(a.ws + WS_YF); bf16* O = (bf16*)(a.ws + WS_HO);
    const int fr = lane & 15, fq = lane >> 4;
    constexpr int NRG = 64 / NR; const int j = gid & 3, r0 = ((gid >> 2) % NRG) * NR, h = ((gid >> 2) / NRG) & 15, b = (gid >> 2) / (NRG * 16);
    { const float* relb = a.in[I_RELB] + h * 465;
      for (int i = lane; i < 465; i += 64) btab[i] = relb[i] * LOG2E;
      asm volatile("s_waitcnt vmcnt(0) lgkmcnt(0)" ::: "memory"); }
    bf16x8 qf[NR][2]; f32x4 o[NR][4]; float mrun[NR], lrun[NR];
#pragma unroll
    for (int qi = 0; qi < NR; ++qi) { const size_t qrow = (size_t)b * SEQ + (r0 + qi) * 64 + j * 16 + fr;
#pragma unroll
        for (int ks = 0; ks < 2; ++ks) qf[qi][ks] = *(const bf16x8*)(P + qrow * LDP1 + h * 64 + ks * 32 + fq * 8);
#pragma unroll
        for (int nt = 0; nt < 4; ++nt) o[qi][nt] = (f32x4){0.f, 0.f, 0.f, 0.f};
        mrun[qi] = -1e30f; lrun[qi] = 0.f; }
    const float sc2 = 0.125f * LOG2E;
    const float nob[8] = {0.f, 0.f, 0.f, 0.f, 0.f, 0.f, 0.f, 0.f};
    const bf16* vbase = VtC + (size_t)((b * 16 + h) * 64) * KEYS;
    const bf16* kctx = P + (size_t)(NLAT + b * CTXL) * LDP1 + 1024 + h * 64;
    const bf16* kloc = P + (size_t)(b * SEQ) * LDP1 + 1024 + h * 64;
    const int seg_start = j == 0 ? 0 : (j == 1 ? 8 : (j == 2 ? 24 : 32));
    const int qcol = j * 16 + fr; const int cs = qcol - 8 < 0 ? 0 : (qcol - 8 > 48 ? 48 : qcol - 8);
    unsigned okmask = 0u; int coloff[8];
#pragma unroll
    for (int i = 0; i < 8; ++i) { const int keycol = seg_start + fq * 8 + i; if (keycol >= cs && keycol < cs + 16) okmask |= 1u << i;
        int co = keycol - qcol + 15; co = co < 0 ? 0 : (co > 30 ? 30 : co); coloff[i] = co; }
    const int rsa = r0 - 4 < 0 ? 0 : (r0 - 4 > 56 ? 56 : r0 - 4);
    const int rsb = r0 + NR - 1 - 4 < 0 ? 0 : (r0 + NR - 1 - 4 > 56 ? 56 : r0 + NR - 1 - 4);
    const int nloc = rsb + 8 - rsa, ntile = 8 + nloc;
#define NA_LOAD(F, t) do { const int t_ = (t); const int k0_ = t_ < 8 ? t_ * 32 : (rsa + t_ - 8) * 64 + seg_start; \
        kv_load(F, (t_ < 8 ? kctx : kloc) + (size_t)k0_ * LDP1, LDP1, vbase + (t_ < 8 ? SEQ : 0) + k0_, KEYS, fr, fq); } while (0)
#define NA_PROC(F, t) do { const int t_ = (t); \
        if (t_ < 8) { _Pragma("unroll") for (int qi = 0; qi < NR; ++qi) attn_one<0>(o[qi], mrun[qi], lrun[qi], qf[qi], F, sc2, 0, 0u, nob); } \
        else { const int R_ = rsa + t_ - 8; \
            _Pragma("unroll") for (int qi = 0; qi < NR; ++qi) { const int r_ = r0 + qi; const int rs_ = r_ - 4 < 0 ? 0 : (r_ - 4 > 56 ? 56 : r_ - 4); \
                if (R_ >= rs_ && R_ < rs_ + 8) { const LAS float* rb_ = btab + (R_ - r_ + 7) * 31; float bias_[8]; \
                    _Pragma("unroll") for (int e = 0; e < 8; ++e) bias_[e] = rb_[coloff[e]]; \
                    attn_one<2>(o[qi], mrun[qi], lrun[qi], qf[qi], F, sc2, 0, okmask, bias_); } } } } while (0)
    KVFrag A, B;
    NA_LOAD(A, 0);
    for (int t = 0; t < ntile; t += 2) {
        NA_LOAD(B, (t + 1 < ntile ? t + 1 : ntile - 1));
        NA_PROC(A, t);
        NA_LOAD(A, (t + 2 < ntile ? t + 2 : ntile - 1));
        if (t + 1 < ntile) NA_PROC(B, t + 1);
    }
#undef NA_LOAD
#undef NA_PROC
#pragma unroll
    for (int qi = 0; qi < NR; ++qi) attn_store1(o[qi], lrun[qi], O + ((size_t)b * SEQ + (r0 + qi) * 64 + j * 16 + fr) * D + h * 64, fq);
}

DI void vt_unit(const bf16* P, int ldp, int vcol, int nh, bf16* Vt, int unit, LAS unsigned char* scr, int lane) {
    const int kb = unit % 68, bh = unit / 68, h = bh % nh, b = bh / nh;
    const size_t row0 = kb < 64 ? (size_t)b * SEQ + kb * 64 : (size_t)NLAT + b * CTXL + (kb - 64) * 64;
    LAS unsigned short* t = (LAS unsigned short*)scr;
#pragma unroll
    for (int i = 0; i < 8; ++i) { const int key = (lane >> 3) + 8 * i, ch = lane & 7;
        const u32x4 v = *(const u32x4*)(P + (row0 + key) * ldp + vcol + h * 64 + ch * 8);
        *(LAS u32x4*)(t + key * 72 + ch * 8) = v; }
    asm volatile("s_waitcnt lgkmcnt(0)" ::: "memory");
    bf16* dst = Vt + (size_t)(bh * 64 + lane) * KEYS + kb * 64;
#pragma unroll
    for (int g8 = 0; g8 < 8; ++g8) { unsigned short e[8];
#pragma unroll
        for (int i = 0; i < 8; ++i) e[i] = t[(g8 * 8 + i) * 72 + lane];
        u32x4 w; w.x = e[0] | ((unsigned)e[1] << 16); w.y = e[2] | ((unsigned)e[3] << 16); w.z = e[4] | ((unsigned)e[5] << 16); w.w = e[6] | ((unsigned)e[7] << 16);
        *(u32x4*)(dst + g8 * 8) = w; }
    asm volatile("s_waitcnt lgkmcnt(0)" ::: "memory");
}

constexpr int L_GW = 0, L_CUM = 4608, L_A = 21248, L_B = 30464, L_ATT = 39680, L_VT = 48896, L_SSQ = 67328, L_TOT = 67840;
DI size_t chunk_row0(int b, int n) { return n < 64 ? (size_t)b * SEQ + n * 64 : (size_t)NLAT + b * CTXL + (n - 64) * 64; }
DI float* st_ptr(const Args& a, int seq, int n) { return n < 64 ? a.out + (size_t)(seq * 64 + n) * 8192 : (float*)(a.ws + WS_STC) + (size_t)(seq * 4 + (n - 64)) * 8192; }

DI void gla_cum(const Args& a, LAS unsigned char* lds, const bf16* P, size_t row0, int h, int dir, int tid) {
    LAS float* rfl = (LAS float*)(lds + L_GW); LAS float* tot = (LAS float*)(lds + L_TOT); LAS float* cum = (LAS float*)(lds + L_CUM);
    const float* gw = a.in[dir ? I_GBW : I_GFW]; const float* gb = a.in[dir ? I_GBB : I_GFB];
    const int lane = tid & 63, w = tid >> 6;
    { const int c = tid >> 3, r2 = (tid & 7) * 2; const unsigned v = *(const unsigned*)(P + (row0 + c) * LDP0 + (dir ? C_RB : C_RF) + r2);
      rfl[c * 16 + r2] = __uint_as_float(v << 16); rfl[c * 16 + r2 + 1] = __uint_as_float(v & 0xffff0000u); }
    float gwr[16];
#pragma unroll
    for (int r = 0; r < 16; ++r) gwr[r] = gw[r * 256 + h * 64 + lane];
    const float gbv = gb[h * 64 + lane];
    __syncthreads();
    float la[8];
#pragma unroll
    for (int i = 0; i < 8; ++i) { const int c = w * 8 + i; float x = gbv;
#pragma unroll
        for (int r = 0; r < 16; ++r) x += rfl[c * 16 + r] * gwr[r];
        la[i] = (fminf(x, 0.f) - __logf(1.0f + __expf(-fabsf(x)))) * (1.0f / 16.0f); }
    if (dir == 0) {
#pragma unroll
        for (int i = 1; i < 8; ++i) la[i] += la[i - 1];
        tot[w * 64 + lane] = la[7];
    } else {
#pragma unroll
        for (int i = 6; i >= 0; --i) la[i] += la[i + 1];
        tot[w * 64 + lane] = la[0];
    }
    __syncthreads();
    float off = 0.f;
#pragma unroll
    for (int w2 = 0; w2 < 8; ++w2) { const float t = tot[w2 * 64 + lane]; off += ((dir == 0) ? (w2 < w) : (w2 > w)) ? t : 0.f; }
#pragma unroll
    for (int i = 0; i < 8; ++i) cum[(w * 8 + i) * 65 + lane] = la[i] + off;
    __syncthreads();
}
DI void gla_load_vt(LAS unsigned char* lds, const bf16* P, size_t row0, int h, int tid) {
    LAS unsigned short* vT = (LAS unsigned short*)(lds + L_VT);
    const int c = tid >> 3, dg = tid & 7;
    const bf16* vp = P + (row0 + c) * LDP0 + C_BV + h * 128 + dg * 16;
    const bf16x8 v0 = *(const bf16x8*)vp, v1 = *(const bf16x8*)(vp + 8);
#pragma unroll
    for (int e = 0; e < 8; ++e) { vT[(dg * 16 + e) * 72 + c] = (unsigned short)v0[e]; vT[(dg * 16 + 8 + e) * 72 + c] = (unsigned short)v1[e]; }
}
DI void gla_g1_unit(const Args& a, LAS unsigned char* lds, int unit, int tid, int lane, int wave) {
    const bf16* P = (const bf16*)(a.ws + WS_P);
    const int n = unit % NCHUNK, seq = unit / NCHUNK, dir = seq & 1, h = (seq >> 1) & 3, b = seq >> 3;
    const size_t row0 = chunk_row0(b, n);
    const bf16x8 kraw = *(const bf16x8*)(P + (row0 + (tid >> 3)) * LDP0 + C_BK + h * 64 + (tid & 7) * 8);
    gla_load_vt(lds, P, row0, h, tid);
    gla_cum(a, lds, P, row0, h, dir, tid);
    LAS float* cum = (LAS float*)(lds + L_CUM); LAS unsigned short* kdT = (LAS unsigned short*)(lds + L_A); LAS unsigned short* vT = (LAS unsigned short*)(lds + L_VT);
    const int cend = dir ? 0 : 63;
    { const int c = tid >> 3, dg = tid & 7; float kk[8]; unpack8(kraw, kk);
#pragma unroll
      for (int dd = 0; dd < 8; ++dd) { const int d = dg * 8 + dd; const float v = kk[dd] * __expf(cum[cend * 65 + d] - cum[c * 65 + d]); kdT[d * 72 + c] = (unsigned short)(pk2(v, 0.f) & 0xffffu); } }
    if (tid < 64) ((float*)(a.ws + WS_DEC))[(size_t)(seq * NCHUNK + n) * 64 + tid] = __expf(cum[cend * 65 + tid]);
    __syncthreads();
    const int fr = lane & 15, fq = lane >> 4;
    bf16x8 av[2];
#pragma unroll
    for (int ks = 0; ks < 2; ++ks) av[ks] = *(const LAS bf16x8*)(vT + (wave * 16 + fr) * 72 + ks * 32 + fq * 8);
    float* st = st_ptr(a, seq, n);
#pragma unroll
    for (int nt = 0; nt < 4; ++nt) { f32x4 acc = {0.f, 0.f, 0.f, 0.f};
#pragma unroll
        for (int ks = 0; ks < 2; ++ks) { const bf16x8 bk = *(const LAS bf16x8*)(kdT + (nt * 16 + fr) * 72 + ks * 32 + fq * 8); acc = MFMA16(av[ks], bk, acc); }
#pragma unroll
        for (int r = 0; r < 4; ++r) st[(wave * 16 + fq * 4 + r) * 64 + nt * 16 + fr] = acc[r]; }
    __syncthreads();
}
DI void gla_scan(const Args& a, int tid) {
    const float* DEC = (const float*)(a.ws + WS_DEC);
    for (int e = blockIdx.x * NTHR + tid; e < 32 * 8192; e += gridDim.x * NTHR) {
        const int seq = e >> 13, el = e & 8191, dk = el & 63, dir = seq & 1;
        float S = 0.f;
        for (int s4 = 0; s4 < NCHUNK; s4 += 4) {
            float* p[4]; float t[4], dc[4];
#pragma unroll
            for (int i = 0; i < 4; ++i) { const int step = s4 + i; const int n = dir == 0 ? (step < 4 ? 64 + step : step - 4) : (step < 4 ? 67 - step : 67 - step);
                p[i] = st_ptr(a, seq, n) + el; t[i] = *p[i]; dc[i] = DEC[(size_t)(seq * NCHUNK + n) * 64 + dk]; }
#pragma unroll
            for (int i = 0; i < 4; ++i) { *p[i] = S; S = dc[i] * S + t[i]; }
        }
    }
}
DI void gla_g3_unit(const Args& a, LAS unsigned char* lds, int unit, int tid, int lane, int wave) {
    const bf16* P = (const bf16*)(a.ws + WS_P); bf16* O = (bf16*)(a.ws + WS_HO);
    const int n = unit % NCHUNK, bh = unit / NCHUNK, h = bh & 3, b = bh >> 2;
    const size_t row0 = chunk_row0(b, n);
    LAS float* cum = (LAS float*)(lds + L_CUM); LAS unsigned short* qg = (LAS unsigned short*)(lds + L_A); LAS unsigned short* kg = (LAS unsigned short*)(lds + L_B);
    LAS unsigned short* att = (LAS unsigned short*)(lds + L_ATT); LAS unsigned short* vT = (LAS unsigned short*)(lds + L_VT); LAS float* ssq = (LAS float*)(lds + L_SSQ);
    const int fr = lane & 15, fq = lane >> 4, ct = wave & 3, dvh = wave >> 2;
    gla_load_vt(lds, P, row0, h, tid);
    f32x4 acc[4];
#pragma unroll
    for (int nt = 0; nt < 4; ++nt) acc[nt] = (f32x4){0.f, 0.f, 0.f, 0.f};
    const bf16x8 qraw = *(const bf16x8*)(P + (row0 + (tid >> 3)) * LDP0 + C_BQ + h * 64 + (tid & 7) * 8), kraw = *(const bf16x8*)(P + (row0 + (tid >> 3)) * LDP0 + C_BK + h * 64 + (tid & 7) * 8);
    for (int dir = 0; dir < 2; ++dir) {
        const float* st = st_ptr(a, (bh * 2 + dir), n);
        f32x4 sraw[4][2][2];
#pragma unroll
        for (int nt = 0; nt < 4; ++nt)
#pragma unroll
            for (int ks = 0; ks < 2; ++ks) { const float* sp = st + ((dvh * 4 + nt) * 16 + fr) * 64 + ks * 32 + fq * 8; sraw[nt][ks][0] = *(const f32x4*)sp; sraw[nt][ks][1] = *(const f32x4*)(sp + 4); }
        gla_cum(a, lds, P, row0, h, dir, tid);
        { const int c = tid >> 3, dg = tid & 7; float qq[8], kk[8], oq[8], ok[8];
          unpack8(qraw, qq); unpack8(kraw, kk);
#pragma unroll
          for (int dd = 0; dd < 8; ++dd) { const float cu = cum[c * 65 + dg * 8 + dd]; oq[dd] = qq[dd] * 0.125f * __expf(cu); ok[dd] = kk[dd] * __expf(-cu); }
          *(LAS bf16x8*)(qg + c * 72 + dg * 8) = pack8(oq); *(LAS bf16x8*)(kg + c * 72 + dg * 8) = pack8(ok); }
        __syncthreads();
        bf16x8 bq[2];
#pragma unroll
        for (int ks = 0; ks < 2; ++ks) bq[ks] = *(const LAS bf16x8*)(qg + (ct * 16 + fr) * 72 + ks * 32 + fq * 8);
#pragma unroll
        for (int si = 0; si < 2; ++si) { const int st = dvh * 2 + si; f32x4 s = {0.f, 0.f, 0.f, 0.f};
#pragma unroll
            for (int ks = 0; ks < 2; ++ks) { const bf16x8 ak = *(const LAS bf16x8*)(kg + (st * 16 + fr) * 72 + ks * 32 + fq * 8); s = MFMA16(ak, bq[ks], s); }
            const int cpos = ct * 16 + fr; float pv[4];
#pragma unroll
            for (int r = 0; r < 4; ++r) { const int spos = st * 16 + fq * 4 + r; const bool keep = dir == 0 ? (spos <= cpos) : (spos >= cpos); pv[r] = keep ? s[r] : 0.f; }
            u32x2 w; w.x = pk2(pv[0], pv[1]); w.y = pk2(pv[2], pv[3]);
            *(LAS u32x2*)(att + cpos * 72 + st * 16 + fq * 4) = w; }
        __syncthreads();
        bf16x8 ba[2];
#pragma unroll
        for (int ks = 0; ks < 2; ++ks) ba[ks] = *(const LAS bf16x8*)(att + (ct * 16 + fr) * 72 + ks * 32 + fq * 8);
#pragma unroll
        for (int nt = 0; nt < 4; ++nt) { const int dvt = dvh * 4 + nt;
#pragma unroll
            for (int ks = 0; ks < 2; ++ks) {
                const bf16x8 av = *(const LAS bf16x8*)(vT + (dvt * 16 + fr) * 72 + ks * 32 + fq * 8);
                acc[nt] = MFMA16(av, ba[ks], acc[nt]);
                const f32x4 s0 = sraw[nt][ks][0], s1 = sraw[nt][ks][1];
                const float sf[8] = {s0[0], s0[1], s0[2], s0[3], s1[0], s1[1], s1[2], s1[3]};
                acc[nt] = MFMA16(pack8(sf), bq[ks], acc[nt]); } }
        __syncthreads();
    }
    float sq = 0.f;
#pragma unroll
    for (int nt = 0; nt < 4; ++nt) sq += (acc[nt][0] * acc[nt][0] + acc[nt][1] * acc[nt][1]) + (acc[nt][2] * acc[nt][2] + acc[nt][3] * acc[nt][3]);
    sq += __shfl_xor(sq, 16); sq += __shfl_xor(sq, 32);
    if (fq == 0) ssq[wave * 16 + fr] = sq;
    __syncthreads();
    const float tot = ssq[wave * 16 + fr] + ssq[(wave ^ 4) * 16 + fr];
    const float rstd = __builtin_amdgcn_rsqf(tot * (1.0f / 128.0f) + EPS);
    const size_t row = row0 + ct * 16 + fr;
#pragma unroll
    for (int nt = 0; nt < 4; ++nt) { const int dv0 = (dvh * 4 + nt) * 16 + fq * 4;
        const f32x4 g4 = *(const f32x4*)(a.in[I_GNORM] + h * 128 + dv0);
        const u32x2 bw = *(const u32x2*)(P + row * LDP0 + C_BO + h * 128 + dv0);
        const float g0 = __uint_as_float(bw.x << 16), g1 = __uint_as_float(bw.x & 0xffff0000u), g2 = __uint_as_float(bw.y << 16), g3 = __uint_as_float(bw.y & 0xffff0000u);
        u32x2 w; w.x = pk2(acc[nt][0] * rstd * g4[0] * silu_f(g0), acc[nt][1] * rstd * g4[1] * silu_f(g1));
        w.y = pk2(acc[nt][2] * rstd * g4[2] * silu_f(g2), acc[nt][3] * rstd * g4[3] * silu_f(g3));
        *(u32x2*)(O + row * D + 512 + h * 128 + dv0) = w; }
    __syncthreads();
}

DI void rope_row(bf16* prow, int t, int lane) {
    const int prow_pos = t >> 6, pcol_pos = t & 63;
#pragma unroll
    for (int i = 0; i < 5; ++i) { const int pi = lane + 64 * i, head = pi >> 5, rem = pi & 31, half = rem >> 4, j = rem & 15;
        const int c1 = head * 64 + half * 32 + j, pos = half ? pcol_pos : prow_pos;
        const float cs = ROPE_COS[pos * 16 + j], sn = ROPE_SIN[pos * 16 + j];
        const float u1 = bf2f(prow[c1]), u2 = bf2f(prow[c1 + 16]);
        prow[c1] = (unsigned short)(pk2(u1 * cs - u2 * sn, 0.f) & 0xffffu); prow[c1 + 16] = (unsigned short)(pk2(u2 * cs + u1 * sn, 0.f) & 0xffffu); }
}

constexpr int NPHASE = 19;
#ifndef NA_NR
#define NA_NR 2
#endif
#ifndef PROBE_MASK
#define PROBE_MASK 0u
#endif
#define REPS(k) (((PROBE_MASK >> (k)) & 1u) ? 2 : 1)
__global__ void __launch_bounds__(NTHR, 2) fwd_kernel(Args a) {
    extern __shared__ __attribute__((aligned(16))) unsigned char lds_raw[];
    LAS unsigned char* lds = (LAS unsigned char*)lds_raw;
    const int tid = threadIdx.x, lane = tid & 63, wave = __builtin_amdgcn_readfirstlane(tid >> 6);
    const int G = gridDim.x, gw = blockIdx.x * NWAVES + wave, NGW = G * NWAVES;
    unsigned char* ws = a.ws;
    const int lo = a.ph_lo, hi = a.ph_hi;
#define IN(k) (lo <= (k) && (k) < hi)
#ifndef PROBE_SYNC
#define PROBE_SYNC 1
#endif
    volatile LAS unsigned* MISC = (volatile LAS unsigned*)(lds + 131072 + 320);
    if (tid < 32) MISC[tid] = 0u;
    __syncthreads();
    unsigned* barw = (unsigned*)(ws + WS_CTL);
    XcdBarrier xbar; xbar.bar = barw; xbar.x = 0; xbar.st = MISC + 8;
#define SEAM(k) do { if (IN(k) && IN((k) + 1)) { for (int sr_ = 0; sr_ < PROBE_SYNC; ++sr_) { if ((k) == 0) { cg::this_grid().sync(); if (sr_ == 0) xbar = xcd_barrier_post(barw, MISC + 8); } else xcd_barrier(xbar); } } } while (0)
    bf16* H = (bf16*)(ws + WS_HO); bf16* YF = (bf16*)(ws + WS_YF); bf16* P = (bf16*)(ws + WS_P);

    if (IN(0)) { if (blockIdx.x == 0) { for (int i = tid; i < XCD_BAR_WORDS; i += NTHR) barw[i] = 0u; }
        for (int rep = 0; rep < REPS(0); ++rep) { phase_prologue(a, lds, tid, lane, wave); __syncthreads(); } } SEAM(0);
    if (IN(1)) { for (int rep = 0; rep < REPS(1); ++rep) phase_rows(a, 0, 0, lane, wave); } SEAM(1);
    if (IN(2)) { pg8::Gemm g{H, (const bf16*)(ws + WS_WABI), MT, LDP0, D}; pg8::StaticOrder S; S.init(MT, LDP0, G, (int)blockIdx.x);
        EpiStore E{P, LDP0}; pg8::gemm_phase<EpiStore, pg8::StaticOrder, true, true>(lds, g, S, E); if (REPS(2) > 1) { pg8::gemm_phase<EpiStore, pg8::StaticOrder, true, true>(lds, g, S, E); } } SEAM(2);
    if (IN(3)) {
        for (int rep = 0; rep < REPS(3); ++rep) for (int u = blockIdx.x; u < 32 * NCHUNK; u += G) gla_g1_unit(a, lds, u, tid, lane, wave);
        __syncthreads();
        for (int m = gw; m < NLAT; m += NGW) rope_row(P + (size_t)m * LDP0, m & 4095, lane);
        for (int u = gw; u < NBATCH * 2 * 68; u += NGW) vt_unit(P, LDP0, C_AV, 2, YF, u, lds + wave * 16384, lane);
    } SEAM(3);
    if (IN(4)) {
        for (int rep = 0; rep < REPS(4); ++rep) for (int wt = gw; wt < 2176; wt += NGW) window_attn_tile(a, wt, lane);
        gla_scan(a, tid);
    } SEAM(4);
    if (IN(5)) { for (int rep = 0; rep < REPS(5); ++rep) for (int u = blockIdx.x; u < 16 * NCHUNK; u += G) gla_g3_unit(a, lds, u, tid, lane, wave); } SEAM(5);
    if (IN(6)) { pg8::Gemm g{H, (const bf16*)(ws + WS_WABO), MT, D, D}; pg8::StaticOrder S; S.init(MT, D, G, (int)blockIdx.x);
        EpiStore E{YF, D}; pg8::gemm_phase<EpiStore, pg8::StaticOrder, true, true>(lds, g, S, E); if (REPS(6) > 1) { pg8::gemm_phase<EpiStore, pg8::StaticOrder, true, true>(lds, g, S, E); } } SEAM(6);
    if (IN(7)) { for (int rep = 0; rep < REPS(7); ++rep) phase_rows(a, 1, 0, lane, wave); } SEAM(7);
    if (IN(8)) { pg8::Gemm g{H, (const bf16*)(ws + WS_WFI), MT, 2 * FF, D}; pg8::StaticOrder S; S.init(MT, 2 * FF, G, (int)blockIdx.x);
        EpiSwiglu E{P, FF}; pg8::gemm_phase<EpiSwiglu, pg8::StaticOrder, true, true>(lds, g, S, E); if (REPS(8) > 1) { pg8::gemm_phase<EpiSwiglu, pg8::StaticOrder, true, true>(lds, g, S, E); } } SEAM(8);
    if (IN(9)) { pg8::Gemm g{P, (const bf16*)(ws + WS_WFO), MT, D, FF}; pg8::StaticOrder S; S.init(MT, D, G, (int)blockIdx.x);
        EpiStore E{YF, D}; pg8::gemm_phase<EpiStore, pg8::StaticOrder, true, true>(lds, g, S, E); if (REPS(9) > 1) { pg8::gemm_phase<EpiStore, pg8::StaticOrder, true, true>(lds, g, S, E); } } SEAM(9);
    if (IN(10)) { phase_rows(a, 2, 0, lane, wave); } SEAM(10);
    if (IN(11)) { pg8::Gemm g{H, (const bf16*)(ws + WS_WNI), MT, LDP1, D}; pg8::StaticOrder S; S.init(MT, LDP1, G, (int)blockIdx.x);
        EpiStore E{P, LDP1}; pg8::gemm_phase<EpiStore, pg8::StaticOrder, true, true>(lds, g, S, E); if (REPS(11) > 1) { pg8::gemm_phase<EpiStore, pg8::StaticOrder, true, true>(lds, g, S, E); } } SEAM(11);
    if (IN(12)) { for (int rep = 0; rep < REPS(12); ++rep) for (int u = gw; u < NBATCH * 16 * 68; u += NGW) vt_unit(P, LDP1, 2048, 16, YF, u, lds + wave * 16384, lane); } SEAM(12);
    if (IN(13)) { for (int rep = 0; rep < REPS(13); ++rep) for (int gid = gw; gid < 16384 / NA_NR; gid += NGW) na_attn_group<NA_NR>(a, gid, lane, (LAS float*)(lds + wave * 16384)); } SEAM(13);
    if (IN(14)) { pg8::Gemm g{H, (const bf16*)(ws + WS_WNO), NLAT, D, D}; pg8::StaticOrder S; S.init(NLAT, D, G, (int)blockIdx.x);
        EpiStore E{YF, D}; pg8::gemm_phase<EpiStore, pg8::StaticOrder, true, true>(lds, g, S, E); if (REPS(14) > 1) { pg8::gemm_phase<EpiStore, pg8::StaticOrder, true, true>(lds, g, S, E); } } SEAM(14);
    if (IN(15)) { phase_rows(a, 1, 1, lane, wave); } SEAM(15);
    if (IN(16)) { pg8::Gemm g{H, (const bf16*)(ws + WS_WFI) + (size_t)5632 * 1024, NLAT, 2 * FF, D}; pg8::StaticOrder S; S.init(NLAT, 2 * FF, G, (int)blockIdx.x);
        EpiSwiglu E{P, FF}; pg8::gemm_phase<EpiSwiglu, pg8::StaticOrder, true, true>(lds, g, S, E); if (REPS(16) > 1) { pg8::gemm_phase<EpiSwiglu, pg8::StaticOrder, true, true>(lds, g, S, E); } } SEAM(16);
    if (IN(17)) { pg8::Gemm g{P, (const bf16*)(ws + WS_WFO) + (size_t)1024 * FF, NLAT, D, FF}; pg8::StaticOrder S; S.init(NLAT, D, G, (int)blockIdx.x);
        EpiStore E{YF, D}; pg8::gemm_phase<EpiStore, pg8::StaticOrder, true, true>(lds, g, S, E); if (REPS(17) > 1) { pg8::gemm_phase<EpiStore, pg8::StaticOrder, true, true>(lds, g, S, E); } } SEAM(17);
    if (IN(18)) { phase_rows(a, 2, 1, lane, wave); }
#undef IN
#undef SEAM
}

extern "C" void kernel_launch(void* const* d_in, const int* in_sizes, int n_in, void* d_out, int out_size, void* d_ws, size_t ws_size, hipStream_t stream) {
    static int grid = 0;
    if (grid == 0) {
        if (n_in != 23 || out_size != NLAT * D || ws_size < WS_END) { fprintf(stderr, "kernel_launch: unexpected problem shape (n_in %d, out %d, ws %zu)\n", n_in, out_size, ws_size); grid = -1; return; }
        int dev = 0, cus = 0, per_cu = 0;
        (void)hipGetDevice(&dev); (void)hipDeviceGetAttribute(&cus, hipDeviceAttributeMultiprocessorCount, dev);
        if (hipFuncSetAttribute((const void*)fwd_kernel, hipFuncAttributeMaxDynamicSharedMemorySize, LDS_BYTES) != hipSuccess) { fprintf(stderr, "kernel_launch: hipFuncSetAttribute failed\n"); grid = -1; return; }
        (void)hipOccupancyMaxActiveBlocksPerMultiprocessor(&per_cu, (const void*)fwd_kernel, NTHR, LDS_BYTES);
        if (per_cu < 1) per_cu = 1;
        (void)hipGetLastError();
        grid = cus * per_cu;
    }
    if (grid < 0) return;
    Args a{};
    for (int i = 0; i < 23; ++i) a.in[i] = (const float*)d_in[i];
    a.out = (float*)d_out; a.ws = (unsigned char*)d_ws;
#if COOP
    a.ph_lo = 0; a.ph_hi = NPHASE;
    void* args[] = {&a};
    hipError_t e = hipLaunchCooperativeKernel((const void*)fwd_kernel, dim3(grid), dim3(NTHR), args, LDS_BYTES, stream);
    if (e != hipSuccess) fprintf(stderr, "cooperative launch failed: %s (grid %d)\n", hipGetErrorString(e), grid);
#else
    for (int p = 0; p < NPHASE; ++p) { a.ph_lo = p; a.ph_hi = p + 1; hipLaunchKernelGGL(fwd_kernel, dim3(grid), dim3(NTHR), LDS_BYTES, stream, a); }
#endif
}
```

```cpp
#include <hip/hip_runtime.h>
#include <hip/hip_cooperative_groups.h>
#include <cstdio>
#include <cstdint>
namespace cg = cooperative_groups;
namespace pg8 {
#define PG8_LAS __attribute__((address_space(3)))
typedef unsigned short bf16_t;
typedef short bf16x8 __attribute__((ext_vector_type(8)));
typedef float f32x4 __attribute__((ext_vector_type(4)));
typedef unsigned u32x4 __attribute__((ext_vector_type(4)));
constexpr int BM = 256, BK = 64, HALF = 128, HTB = HALF * BK * 2  , STAGE_BYTES = 8 * HTB, NXCD = 8, WGM = 8;

__host__ __device__ __forceinline__ int lds_byte(int r, int c) { const int st = (r >> 4) * 2 + (c >> 5), rr = r & 15, cc = c & 31, ob = rr * 64 + cc * 2; return st * 1024 + (ob ^ (((ob >> 9) & 1) << 5)); }
__host__ __device__ __forceinline__ void stage_rc(int b, int& R, int& C) { const int st = b / 1024, sb = b % 1024, swz = sb ^ (((sb >> 9) & 1) << 5); R = (st >> 1) * 16 + swz / 64; C = (st & 1) * 32 + (swz % 64) / 2; }
__host__ __device__ __forceinline__ int perm32(int rho) { const int n = rho >> 4, i = rho & 15; return 8 * (i >> 2) + 4 * n + (i & 3); }

struct Unit { int pm, pn; };
struct Gemm { const bf16_t* A; const bf16_t* Bt; int M, N, K, Kext; };

struct StaticOrder {
    int nM, nN, nwg, G, c;
    __host__ __device__ void init(int M, int N, int G_, int c_) { nM = M / BM; nN = N / BM; nwg = nM * nN; G = G_; c = c_; }
    __host__ __device__ bool next(int i, Unit& u) const {
        const long L = (long)i * G + c; if (L >= nwg) return false;
        int wgid = (int)L; { const int q = nwg / NXCD, r = nwg % NXCD, xcd = wgid % NXCD, off = wgid / NXCD; wgid = (xcd < r ? xcd * (q + 1) : r * (q + 1) + (xcd - r) * q) + off; }
        const int nig = WGM * nN, gid = wgid / nig, fm = gid * WGM, gsz = (nM - fm) < WGM ? (nM - fm) : WGM;
        u.pm = fm + ((wgid % nig) % gsz); u.pn = (wgid % nig) / gsz; return true;
    }
    __device__ __forceinline__ void a_ready(const Unit&) const {}
    __device__ __forceinline__ void done(const Unit&) const {}
};

__device__ __forceinline__ unsigned cvt_pk_bf16(float lo, float hi) { unsigned r; asm volatile("v_cvt_pk_bf16_f32 %0, %1, %2" : "=v"(r) : "v"(lo), "v"(hi)); return r; }
template <class Epi, class Sched, bool ALIGN_EPI = false, bool SP2 = false>
__device__ __forceinline__ void gemm_phase(PG8_LAS unsigned char* lds, const Gemm g, const Sched& S, const Epi& E) {
    const int tid = threadIdx.x, wid = __builtin_amdgcn_readfirstlane(tid >> 6), lane = tid & 63, wr = wid >> 2, wc = wid & 3, fr = lane & 15, fq = lane >> 4;
    const int K = g.K, nt = g.Kext / BK;
    unsigned voffA[2], voffB[2];
#pragma unroll
    for (int i = 0; i < 2; ++i) { int R, C; stage_rc(tid * 16 + i * 8192, R, C); const int Rb = Epi::PERM ? ((R & ~31) + perm32(R & 31)) : R;
        voffA[i] = (unsigned)(R * K + C) * 2u; voffB[i] = (unsigned)(Rb * K + C) * 2u; }
    const size_t kstep = (size_t)(BK * 2);
    const size_t hstep = (size_t)HALF * K * 2;
    const size_t tstep = 2 * hstep;
    const unsigned ldsw = (unsigned)wid * 1024u;
    const int aoff = lds_byte(wr * 64 + fr, fq * 8), boff = lds_byte(wc * 32 + fr, fq * 8);
#define PG8_SA(b, h) (((b) * 2 + (h)) * HTB)
#define PG8_SB(b, h) ((4 + (b) * 2 + (h)) * HTB)
#define PG8_STAGE(bufoff, gbase, voff) do { _Pragma("unroll") for (int _i = 0; _i < 2; ++_i) \
        __builtin_amdgcn_global_load_lds((const unsigned*)((const char*)(gbase) + (voff)[_i]), (PG8_LAS unsigned*)(lds + (bufoff) + ldsw + _i * 8192), 16, 0, 0); } while (0)
#define PG8_LDA(dst, b, h) do { _Pragma("unroll") for (int m = 0; m < 4; ++m) _Pragma("unroll") for (int k = 0; k < 2; ++k) dst[m][k] = *(const PG8_LAS bf16x8*)(lds + PG8_SA(b, h) + aoff + m * 2048 + k * 1024); } while (0)
#define PG8_LDB(dst, b, h) do { _Pragma("unroll") for (int n = 0; n < 2; ++n) _Pragma("unroll") for (int k = 0; k < 2; ++k) dst[n][k] = *(const PG8_LAS bf16x8*)(lds + PG8_SB(b, h) + boff + n * 2048 + k * 1024); } while (0)
#define PG8_MMA(ai, bj, At, Bt) do { __builtin_amdgcn_s_setprio(1); _Pragma("unroll") for (int m = 0; m < 4; ++m) _Pragma("unroll") for (int n = 0; n < 2; ++n) _Pragma("unroll") for (int k = 0; k < 2; ++k) \
        acc[ai][bj][m][n] = __builtin_amdgcn_mfma_f32_16x16x32_bf16(Bt[n][k], At[m][k], acc[ai][bj][m][n], 0, 0, 0); __builtin_amdgcn_s_setprio(0); } while (0)
#define PG8_WAIT_V(n) asm volatile("s_waitcnt vmcnt(" #n ")" ::: "memory")
#define PG8_WAIT_L(n) asm volatile("s_waitcnt lgkmcnt(" #n ")" ::: "memory")
#define PG8_BAR __builtin_amdgcn_s_barrier()
#define PG8_SCHED __builtin_amdgcn_sched_barrier(0)
    Unit cur, nxt; int ui = 0;
    if (!S.next(0, cur)) return;
    f32x4 acc[2][2][4][2];
#pragma unroll
    for (int a = 0; a < 2; ++a)
#pragma unroll
        for (int b = 0; b < 2; ++b)
#pragma unroll
            for (int m = 0; m < 4; ++m)
#pragma unroll
                for (int n = 0; n < 2; ++n) acc[a][b][m][n] = (f32x4){0.f, 0.f, 0.f, 0.f};
    bf16x8 At[4][2], B0[2][2], B1[2][2];
    const char* cA = (const char*)g.A + (size_t)cur.pm * tstep; const char* cB = (const char*)g.Bt + (size_t)cur.pn * tstep;
    S.a_ready(cur);
    if constexpr (SP2) {
        PG8_STAGE(PG8_SB(0, 0), cB, voffB); PG8_STAGE(PG8_SB(0, 1), cB + hstep, voffB); PG8_STAGE(PG8_SA(0, 0), cA, voffA); PG8_STAGE(PG8_SA(0, 1), cA + hstep, voffA);
        if (wr == 1) PG8_BAR;
        PG8_WAIT_V(2); PG8_BAR;
        PG8_STAGE(PG8_SB(1, 0), cB + kstep, voffB); PG8_STAGE(PG8_SA(1, 0), cA + kstep, voffA); PG8_STAGE(PG8_SB(1, 1), cB + hstep + kstep, voffB);
        PG8_WAIT_V(6); PG8_BAR;
    } else {
        PG8_STAGE(PG8_SB(0, 0), cB, voffB); PG8_STAGE(PG8_SA(0, 0), cA, voffA); PG8_STAGE(PG8_SB(0, 1), cB + hstep, voffB); PG8_STAGE(PG8_SA(0, 1), cA + hstep, voffA);
        if (wr == 1) PG8_BAR;
        PG8_WAIT_V(4); PG8_BAR;
        PG8_STAGE(PG8_SB(1, 0), cB + kstep, voffB); PG8_STAGE(PG8_SA(1, 0), cA + kstep, voffA); PG8_STAGE(PG8_SB(1, 1), cB + hstep + kstep, voffB);
        PG8_WAIT_V(6); PG8_BAR;
    }
    for (;;) {
        const bool has_next = S.next(ui + 1, nxt);
        const char* nA = has_next ? (const char*)g.A + (size_t)nxt.pm * tstep : cA; const char* nB = has_next ? (const char*)g.Bt + (size_t)nxt.pn * tstep : cB;
        for (int t = 0; t < nt; t += 2) {
            const bool last = (t == nt - 2);
            const char* a1 = cA + (size_t)(t + 1) * kstep;
            const char* a2 = last ? nA : cA + (size_t)(t + 2) * kstep; const char* b2 = last ? nB : cB + (size_t)(t + 2) * kstep;
            const char* a3 = a2 + kstep; const char* b3 = b2 + kstep;
            if (last && has_next) S.a_ready(nxt);
            if constexpr (SP2) {
            PG8_LDB(B0, 0, 0); PG8_LDB(B1, 0, 1); PG8_SCHED; PG8_LDA(At, 0, 0); PG8_STAGE(PG8_SA(1, 1), a1 + hstep, voffA);
            PG8_WAIT_V(8); PG8_WAIT_L(0); PG8_BAR; PG8_MMA(0, 0, At, B0); PG8_MMA(0, 1, At, B1); PG8_BAR; PG8_SCHED;
            PG8_LDA(At, 0, 1); PG8_STAGE(PG8_SB(0, 0), b2, voffB); PG8_STAGE(PG8_SB(0, 1), b2 + hstep, voffB); PG8_STAGE(PG8_SA(0, 0), a2, voffA);
            PG8_WAIT_V(8); PG8_WAIT_L(0); PG8_BAR; PG8_MMA(1, 0, At, B0); PG8_MMA(1, 1, At, B1); PG8_BAR; PG8_SCHED;
            PG8_LDB(B0, 1, 0); PG8_LDB(B1, 1, 1); PG8_SCHED; PG8_LDA(At, 1, 0); PG8_STAGE(PG8_SA(0, 1), a2 + hstep, voffA);
            PG8_WAIT_V(8); PG8_WAIT_L(0); PG8_BAR; PG8_MMA(0, 0, At, B0); PG8_MMA(0, 1, At, B1); PG8_BAR; PG8_SCHED;
            PG8_LDA(At, 1, 1); PG8_STAGE(PG8_SB(1, 0), b3, voffB); PG8_STAGE(PG8_SB(1, 1), b3 + hstep, voffB); PG8_STAGE(PG8_SA(1, 0), a3, voffA);
            PG8_WAIT_V(8); PG8_WAIT_L(0); PG8_BAR; PG8_MMA(1, 0, At, B0); PG8_MMA(1, 1, At, B1); PG8_BAR; PG8_SCHED;
            } else {
            PG8_LDB(B0, 0, 0); PG8_SCHED; PG8_LDA(At, 0, 0); PG8_STAGE(PG8_SA(1, 1), a1 + hstep, voffA);
            PG8_WAIT_L(8); PG8_BAR; PG8_WAIT_L(0); PG8_MMA(0, 0, At, B0); PG8_BAR; PG8_SCHED;
            PG8_LDB(B1, 0, 1); PG8_STAGE(PG8_SB(0, 0), b2, voffB);
            PG8_BAR; PG8_WAIT_L(0); PG8_MMA(0, 1, At, B1); PG8_BAR;
            PG8_LDA(At, 0, 1); PG8_STAGE(PG8_SA(0, 0), a2, voffA);
            PG8_BAR; PG8_WAIT_L(0); PG8_MMA(1, 0, At, B0); PG8_BAR; PG8_SCHED;
            PG8_STAGE(PG8_SB(0, 1), b2 + hstep, voffB);
            PG8_WAIT_V(6); PG8_BAR; PG8_MMA(1, 1, At, B1); PG8_BAR;
            PG8_LDB(B0, 1, 0); PG8_SCHED; PG8_LDA(At, 1, 0); PG8_STAGE(PG8_SA(0, 1), a2 + hstep, voffA);
            PG8_WAIT_L(8); PG8_BAR; PG8_WAIT_L(0); PG8_MMA(0, 0, At, B0); PG8_BAR; PG8_SCHED;
            PG8_LDB(B1, 1, 1); PG8_STAGE(PG8_SB(1, 0), b3, voffB);
            PG8_BAR; PG8_WAIT_L(0); PG8_MMA(0, 1, At, B1); PG8_BAR;
            PG8_LDA(At, 1, 1); PG8_STAGE(PG8_SA(1, 0), a3, voffA);
            PG8_BAR; PG8_WAIT_L(0); PG8_MMA(1, 0, At, B0); PG8_BAR; PG8_SCHED;
            PG8_STAGE(PG8_SB(1, 1), b3 + hstep, voffB);
            PG8_WAIT_V(6); PG8_BAR; PG8_MMA(1, 1, At, B1); PG8_BAR;
            }
        }
        if constexpr (ALIGN_EPI) { if (wr == 0) PG8_BAR; }
        if constexpr (!Epi::AFTER_DRAIN) { E(acc, cur, wr, wc, fr, fq); S.done(cur); }
        if (!has_next) break;
#pragma unroll
        for (int a = 0; a < 2; ++a)
#pragma unroll
            for (int b = 0; b < 2; ++b)
#pragma unroll
                for (int m = 0; m < 4; ++m)
#pragma unroll
                    for (int n = 0; n < 2; ++n) acc[a][b][m][n] = (f32x4){0.f, 0.f, 0.f, 0.f};
        cur = nxt; cA = nA; cB = nB; ++ui;
        if constexpr (ALIGN_EPI) { if (wr == 1) PG8_BAR; }
    }
    PG8_WAIT_V(0);
    if constexpr (!ALIGN_EPI) { if (wr == 0) PG8_BAR; }
    PG8_BAR;
    if constexpr (Epi::AFTER_DRAIN) { E.fused(acc, cur, wr, wc, fr, fq, lds, wid, lane); S.done(cur); }
#undef PG8_SA
#undef PG8_SB
#undef PG8_STAGE
#undef PG8_LDA
#undef PG8_LDB
#undef PG8_MMA
#undef PG8_WAIT_V
#undef PG8_WAIT_L
#undef PG8_BAR
#undef PG8_SCHED
}
}
__device__ const float ROPE_COS[1024] = {1.f,1.f,1.f,1.f,1.f,1.f,1.f,1.f,1.f,1.f,1.f,1.f,1.f,1.f,1.f,1.f,0.540302277f,0.846009135f,0.950415254f,0.98423022f,0.995004177f,0.998419285f,0.999500036f,0.999841869f,0.999949992f,0.999984205f,0.999994993f,0.999998391f,0.999999523f,0.999999821f,0.99999994f,1.f,-0.416146845f,0.431462824f,0.806578398f,0.937418282f,0.980066597f,0.993682086f,0.998000681f,0.999367595f,0.999800026f,0.999936759f,0.999979973f,0.999993682f,0.999997973f,0.999999344f,0.999999821f,0.99999994f,-0.989992499f,-0.115966164f,0.582753658f,0.861040652f,0.955336511f,0.985803485f,0.995503366f,0.998577297f,0.999550045f,0.999857724f,0.999954998f,0.999985754f,0.99999553f,0.999998569f,0.999999523f,0.999999881f,-0.653643608f,-0.627679706f,0.301137477f,0.757506192f,0.921060979f,0.974808276f,0.992010653f,0.997471273f,0.999200106f,0.999747038f,0.999920011f,0.999974728f,0.999992013f,0.999997497f,0.999999225f,0.999999762f,0.2836622f,-0.946079254f,-0.0103423381f,0.630080283f,0.87758255f,0.960731268f,0.987526f,0.996049762f,0.998750269f,0.999604762f,0.999875009f,0.999960482f,0.999987483f,0.999996066f,0.999998748f,0.999999583f,0.960170269f,-0.973103702f,-0.3207964f,0.482782036f,0.825335622f,0.943616986f,0.982053936f,0.9943133f,0.998200536f,0.999430835f,0.999819994f,0.999943078f,0.999981999f,0.999994338f,0.999998212f,0.999999404f,0.753902256f,-0.700429797f,-0.599437475f,0.320257008f,0.764842212f,0.923519433f,0.975599885f,0.992262423f,0.997551024f,0.999225318f,0.999755025f,0.999922514f,0.999975502f,0.999992251f,0.999997556f,0.999999225f,-0.145500034f,-0.212036446f,-0.818632424f,0.147631213f,0.696706712f,0.900502324f,0.968170285f,0.989897788f,0.996801734f,0.998988271f,0.999680042f,0.999898791f,0.999967992f,0.999989867f,0.999996781f,0.999998987f,-0.91113025f,0.341660261f,-0.956644177f,-0.0296507962f,0.621609926f,0.874638259f,0.959772646f,0.987220109f,0.995952725f,0.998719573f,0.999595046f,0.99987191f,0.999959528f,0.999987185f,0.999995947f,0.999998748f,-0.839071512f,0.790131867f,-0.999786079f,-0.205997631f,0.540302277f,0.846009135f,0.950415313f,0.98423022f,0.995004177f,0.998419285f,0.999500036f,0.999841869f,0.999949992f,0.999984205f,0.999994993f,0.999998391f,0.00442569796f,0.995257378f,-0.943779767f,-0.375847399f,0.453596085f,0.814705312f,0.940107584f,0.980929136f,0.993956089f,0.998087406f,0.999395072f,0.999808669f,0.999939501f,0.999980867f,0.99999392f,0.999998093f,0.843853951f,0.893861592f,-0.79417938f,-0.53384304f,0.362357706f,0.780825913f,0.92885989f,0.97731787f,0.99280864f,0.997723997f,0.999280095f,0.99977231f,0.999927998f,0.999977231f,0.999992788f,0.999997735f,0.907446802f,0.517172873f,-0.565820515f,-0.675001681f,0.267498761f,0.744477987f,0.916683376f,0.973397553f,0.99156189f,0.997329056f,0.999155104f,0.999732792f,0.999915481f,0.999973297f,0.999991536f,0.999997318f,0.136737213f,-0.0187961515f,-0.28134948f,-0.794870913f,0.16996716f,0.705776393f,0.903590262f,0.969169438f,0.990216017f,0.996902585f,0.999020159f,0.999690115f,0.99990201f,0.999969006f,0.999990225f,0.999996901f,-0.759687901f,-0.548975468f,0.0310223512f,-0.889670432f,0.070737198f,0.6648435f,0.889593601f,0.964634836f,0.988771081f,0.996444523f,0.998875201f,0.999644279f,0.999887526f,0.999964416f,0.999988735f,0.999996424f,-0.957659483f,-0.910081089f,0.340318173f,-0.95641005f,-0.0291995462f,0.621808827f,0.87470746f,0.959795177f,0.987227261f,0.99595499f,0.998720288f,0.999595284f,0.999872029f,0.999959528f,0.999987185f,0.999995947f,-0.275163352f,-0.990897954f,0.615864813f,-0.99298501f,-0.128844544f,0.576808274f,0.858946681f,0.954652011f,0.985584795f,0.995433986f,0.998555362f,0.999543071f,0.999855518f,0.999954283f,0.999985576f,0.99999541f,0.660316706f,-0.766536534f,0.830336154f,-0.998241663f,-0.227202162f,0.529984176f,0.842327058f,0.949207008f,0.983843684f,0.994881511f,0.998380423f,0.999487758f,0.999837995f,0.9999488f,0.999983788f,0.999994874f,0.988704622f,-0.306095392f,0.962463796f,-0.972014248f,-0.323289543f,0.481484592f,0.824865162f,0.943461835f,0.982004225f,0.994297504f,0.998195529f,0.999429286f,0.999819517f,0.999942899f,0.99998194f,0.999994278f,0.408082068f,0.248616725f,0.999144375f,-0.91512996f,-0.416146845f,0.431462824f,0.806578457f,0.937418282f,0.980066597f,0.993682086f,0.998000681f,0.999367595f,0.999800026f,0.999936759f,0.999979973f,0.999993682f,-0.547729254f,0.726760268f,0.936740458f,-0.829382956f,-0.504846215f,0.380077004f,0.787485182f,0.931078374f,0.97803092f,0.993035257f,0.99779582f,0.999302804f,0.999779522f,0.999930263f,0.999977946f,0.999993026f,-0.99996084f,0.981074572f,0.781440377f,-0.717477441f,-0.588501155f,0.327489585f,0.767604589f,0.92444396f,0.975897431f,0.992357016f,0.997581005f,0.999234855f,0.999758005f,0.999923468f,0.999975801f,0.999992371f,-0.53283304f,0.933235765f,0.548645258f,-0.582943261f,-0.666275978f,0.273866832f,0.746956408f,0.917517304f,0.97366637f,0.991647422f,0.997356176f,0.999163687f,0.999735534f,0.999916375f,0.999973536f,0.999991655f,0.424179018f,0.597977161f,0.261441678f,-0.430023283f,-0.737393796f,0.219378278f,0.725561321f,0.910300434f,0.971337974f,0.990906477f,0.997121394f,0.99908942f,0.99971199f,0.999908924f,0.999971211f,0.99999088f,0.991202831f,0.078552261f,-0.0516893305f,-0.263540596f,-0.801143587f,0.164196163f,0.703440726f,0.902795732f,0.968912423f,0.99013412f,0.996876657f,0.999011934f,0.999687493f,0.999901175f,0.999968767f,0.999990106f,0.64691931f,-0.465064496f,-0.359694332f,-0.0887455046f,-0.856888831f,0.108494945f,0.680616796f,0.895005584f,0.966389954f,0.98933053f,0.996621907f,0.998931348f,0.999662042f,0.999893129f,0.999966204f,0.999989331f,-0.292138815f,-0.865450621f,-0.632028639f,0.088848114f,-0.904072165f,0.0524506159f,0.6571123f,0.886932373f,0.963770926f,0.988495648f,0.996357203f,0.998847544f,0.999635518f,0.999884725f,0.999963522f,0.999988496f,-0.962605894f,-0.999293387f,-0.841684937f,0.26363951f,-0.942222297f,-0.00375941908f,0.632950664f,0.878578722f,0.961055458f,0.987629473f,0.996082544f,0.998760641f,0.99960804f,0.999876022f,0.99996078f,0.999987602f,-0.748057544f,-0.825371623f,-0.967871487f,0.430115849f,-0.970958173f,-0.0599575676f,0.608156204f,0.869947195f,0.958243906f,0.986732066f,0.995797932f,0.998670578f,0.999579549f,0.999867022f,0.999957979f,0.999986708f,0.154251456f,-0.397251874f,-0.998075247f,0.583026946f,-0.989992499f,-0.115966164f,0.582753658f,0.861040652f,0.955336511f,0.985803485f,0.995503366f,0.998577297f,0.999550045f,0.999857724f,0.999954998f,0.999985754f,0.914742351f,0.153215483f,-0.929300308f,0.717549205f,-0.999135137f,-0.171608135f,0.556768358f,0.851861775f,0.95233357f,0.984843671f,0.995198846f,0.998480916f,0.999519527f,0.999848068f,0.999951959f,0.999984801f,0.83422339f,0.656495154f,-0.768367112f,0.829440355f,-0.998294771f,-0.226707578f,0.53022635f,0.842413545f,0.949235439f,0.983852804f,0.994884372f,0.998381376f,0.999488056f,0.999838114f,0.9999488f,0.999983788f,-0.0132767474f,0.95758605f,-0.531235278f,0.915171385f,-0.987479806f,-0.281090319f,0.503154159f,0.832698941f,0.946042359f,0.982830763f,0.994559944f,0.998278618f,0.999455571f,0.999827802f,0.999945521f,0.999982774f,-0.848570287f,0.963757515f,-0.241421118f,0.972038329f,-0.966798186f,-0.334584385f,0.475578904f,0.822721004f,0.942754686f,0.981777668f,0.994225562f,0.99817276f,0.999422073f,0.999817252f,0.999942183f,0.999981701f,-0.903692186f,0.673110247f,0.0723346695f,0.998247743f,-0.93645668f,-0.387020677f,0.447528064f,0.812482953f,0.939372718f,0.980693519f,0.993881226f,0.998063743f,0.999387562f,0.999806345f,0.999938726f,0.999980628f,-0.127963692f,0.175156534f,0.378916174f,0.992972851f,-0.896758378f,-0.438233554f,0.419029742f,0.801987886f,0.935896814f,0.979578316f,0.993526995f,0.997951567f,0.999352098f,0.999795079f,0.99993521f,0.999979496f,0.765414059f,-0.376742303f,0.647921681f,0.95638001f,-0.848100007f,-0.488060862f,0.39011243f,0.791239262f,0.93232733f,0.978432178f,0.993162811f,0.997836173f,0.99931556f,0.999783576f,0.999931574f,0.999978364f,0.955073655f,-0.812611222f,0.852673113f,0.889623463f,-0.790967762f,-0.536345184f,0.360805035f,0.780240417f,0.928664625f,0.977255106f,0.992788672f,0.997717679f,0.999278069f,0.999771714f,0.999927819f,0.999977171f,0.266642928f,-0.998210371f,0.972865343f,0.794808388f,-0.72593224f,-0.582933903f,0.331136853f,0.768994927f,0.924909055f,0.976047099f,0.99240464f,0.997596025f,0.999239624f,0.999759495f,0.999923944f,0.999975979f,-0.666938066f,-0.87637943f,0.996578991f,0.674925625f,-0.653643608f,-0.627679706f,0.301137596f,0.757506192f,0.921060979f,0.974808276f,0.992010653f,0.997471273f,0.999200106f,0.999747038f,0.999920011f,0.999974728f,-0.987339258f,-0.484639406f,0.921462357f,0.533756077f,-0.574824035f,-0.670441091f,0.270837069f,0.745777905f,0.917120814f,0.973538578f,0.991606772f,0.997343302f,0.999159634f,0.999734223f,0.999915957f,0.999973416f,-0.399985313f,0.0563609414f,0.754965365f,0.375752151f,-0.490260571f,-0.711082935f,0.240265876f,0.733813822f,0.913088918f,0.972238123f,0.991192937f,0.997212172f,0.999118149f,0.99972111f,0.999911785f,0.999972105f,0.555113316f,0.580003142f,0.513598442f,0.205897167f,-0.400799006f,-0.749476731f,0.209454417f,0.721617639f,0.908965766f,0.970906913f,0.990769207f,0.997077882f,0.999075651f,0.999707639f,0.999907553f,0.999970794f,0.999843299f,0.925014675f,0.221298173f,0.0295478199f,-0.307332784f,-0.785501122f,0.178433523f,0.709193349f,0.904751658f,0.969545007f,0.990335584f,0.996940494f,0.99903214f,0.99969393f,0.999903202f,0.999969363f,0.52532196f,0.985138178f,-0.0929481089f,-0.147732988f,-0.210795805f,-0.819042206f,0.147234216f,0.696544766f,0.90044713f,0.968152404f,0.989892066f,0.996799886f,0.998987675f,0.999679863f,0.999898732f,0.999967992f,-0.432177931f,0.741858006f,-0.397976756f,-0.320354372f,-0.112152621f,-0.849993885f,0.115887694f,0.683675885f,0.89605248f,0.966729224f,0.989438653f,0.996656179f,0.998942196f,0.999665439f,0.999894202f,0.999966562f,-0.992335498f,0.270098448f,-0.663538277f,-0.48287195f,-0.0123883775f,-0.878258407f,0.0844252855f,0.670590878f,0.891568303f,0.965275466f,0.988975346f,0.996509314f,0.998895705f,0.999650776f,0.999889553f,0.999965072f,-0.640144348f,-0.284846604f,-0.863296509f,-0.630159974f,0.0874991715f,-0.903746367f,0.0528784581f,0.657293737f,0.886994898f,0.963791192f,0.988502085f,0.996359289f,0.9988482f,0.999635756f,0.999884784f,0.999963582f,0.300592542f,-0.75206399f,-0.977442741f,-0.757573068f,0.18651247f,-0.926377118f,0.0212787576f,0.643788815f,0.882332861f,0.962276459f,0.98801899f,0.996206105f,0.998799741f,0.999620378f,0.999879956f,0.999962032f,0.964965999f,-0.987659097f,-0.994656444f,-0.861092687f,0.2836622f,-0.946079254f,-0.0103422189f,0.630080283f,0.87758255f,0.960731268f,0.987526f,0.996049762f,0.998750269f,0.999604762f,0.999875009f,0.999960482f,0.742154181f,-0.919073522f,-0.913230121f,-0.937454224f,0.377977669f,-0.96279037f,-0.0419528559f,0.616172493f,0.872744501f,0.959155679f,0.987023175f,0.99589026f,0.998699784f,0.999588788f,0.999869943f,0.999958873f,-0.162990779f,-0.567430019f,-0.741239965f,-0.984248459f,0.468516916f,-0.976457715f,-0.0735215396f,0.602069914f,0.86781919f,0.95754981f,0.986510456f,0.995727658f,0.998648286f,0.999572515f,0.999864817f,0.999957263f,-0.918282807f,-0.0410281904f,-0.495741814f,-1.f,0.554374516f,-0.987038016f,-0.105016708f,0.587776959f,0.862807095f,0.955913603f,0.985987842f,0.995561838f,0.998595834f,0.999555886f,0.999859571f,0.999955595f,-0.829309821f,0.498009592f,-0.201079622f,-0.984212041f,0.634692967f,-0.994497895f,-0.136406869f,0.573298037f,0.857708693f,0.954247177f,0.985455394f,0.995392919f,0.998542368f,0.999538958f,0.999854207f,0.999953866f,0.0221267566f,0.883669317f,0.113521777f,-0.937382519f,0.708669782f,-0.998813629f,-0.167660639f,0.558637917f,0.852524519f,0.95255059f,0.984913111f,0.99522084f,0.99848789f,0.999521732f,0.999848783f,0.999952197f,0.853220105f,0.997174621f,0.416867077f,-0.860988438f,0.775565803f,-0.999971747f,-0.198746875f,0.543801069f,0.847255111f,0.950823903f,0.984360933f,0.995045662f,0.998432398f,0.999504209f,0.99984318f,0.999950409f,0.899866819f,0.803569078f,0.678870201f,-0.757439196f,0.834712923f,-0.997968495f,-0.22963427f,0.528792322f,0.841901004f,0.949067116f,0.983798921f,0.994867265f,0.998375952f,0.999486327f,0.999837577f,0.999948621f,0.119180135f,0.362476677f,0.873550534f,-0.63000071f,0.885519624f,-0.99281019f,-0.260292053f,0.513616323f,0.836462677f,0.947280347f,0.983227074f,0.994685769f,0.998318493f,0.999468148f,0.999831796f,0.999946833f,-0.771080196f,-0.1902491f,0.981602073f,-0.482692331f,0.927478492f,-0.984513164f,-0.290689558f,0.498277903f,0.830940723f,0.945463598f,0.982645452f,0.994501114f,0.998260021f,0.99944967f,0.999825954f,0.999944985f,-0.952412963f,-0.684381902f,0.992308319f,-0.320159167f,0.960170269f,-0.973103702f,-0.3207964f,0.482782036f,0.825335622f,0.943616986f,0.982053936f,0.9943133f,0.998200536f,0.999430835f,0.999819994f,0.999943078f,-0.258101642f,-0.967739642f,0.904607594f,-0.1475292f,0.98326844f,-0.958617806f,-0.350582451f,0.467133403f,0.819648027f,0.941740453f,0.981452644f,0.994122326f,0.998140097f,0.999411702f,0.999813974f,0.99994117f,0.673507154f,-0.953050017f,0.727198064f,0.0297537707f,0.996542096f,-0.941101313f,-0.380017966f,0.451337039f,0.813878477f,0.939834237f,0.980841517f,0.993928254f,0.998078644f,0.999392271f,0.999807835f,0.999939203f,0.985896587f,-0.644837022f,0.477671444f,0.206098333f,0.999858618f,-0.920609534f,-0.409073502f,0.435397953f,0.808027506f,0.937898219f,0.980220556f,0.993731022f,0.998016179f,0.999372482f,0.999801576f,0.999937236f};
__device__ const float ROPE_SIN[1024] = {0.f,0.f,0.f,0.f,0.f,0.f,0.f,0.f,0.f,0.f,0.f,0.f,0.f,0.f,0.f,0.f,0.841470957f,0.533168435f,0.310983598f,0.176892191f,0.0998334214f,0.0562044978f,0.0316175036f,0.0177818574f,0.00999983307f,0.00562338345f,0.00316227227f,0.0017782785f,0.000999999931f,0.000562341243f,0.000316227757f,0.00017782794f,0.909297407f,0.902130723f,0.591127098f,0.348205268f,0.198669329f,0.112231314f,0.0632033944f,0.0355580896f,0.0199986659f,0.011246589f,0.00632451288f,0.00355655141f,0.0019999987f,0.00112468237f,0.000632455456f,0.00035565588f,0.141120002f,0.993253171f,0.812648892f,0.5085361f,0.295520216f,0.167903304f,0.0947260857f,0.0533230826f,0.0299954992f,0.0168694388f,0.00948669016f,0.00533481315f,0.0029999956f,0.00168702309f,0.000948683126f,0.000533483806f,-0.756802499f,0.778471708f,0.953580737f,0.652827978f,0.389418334f,0.223044485f,0.126154065f,0.0710712075f,0.0399893336f,0.0224917568f,0.0126487734f,0.00711305765f,0.00399998948f,0.00224936334f,0.00126491068f,0.000711311703f,-0.958924294f,0.32393527f,0.999946535f,0.776529968f,0.47942555f,0.277480543f,0.157455876f,0.0887968615f,0.0499791652f,0.0281133614f,0.0158107281f,0.00889127981f,0.0049999794f,0.0028117029f,0.00158113812f,0.000889139599f,-0.279415488f,-0.230367512f,0.947148204f,0.875740528f,0.564642489f,0.33103931f,0.188600272f,0.106494442f,0.0599640049f,0.0337340795f,0.0189725272f,0.0106694745f,0.0059999642f,0.00337404152f,0.00189736532f,0.00106696738f,0.656986594f,-0.713721275f,0.800421596f,0.947330713f,0.64421767f,0.383551568f,0.219556093f,0.124158338f,0.0699428469f,0.0393537246f,0.0221341345f,0.0124476347f,0.00699994294f,0.00393637875f,0.00221359241f,0.00124479528f,0.989358246f,-0.977261782f,0.574317753f,0.989042461f,0.717356086f,0.434851229f,0.250292331f,0.141782969f,0.0799146891f,0.0449721329f,0.0252955221f,0.0142257558f,0.0079999147f,0.00449871505f,0.00252981926f,0.00142262306f,0.412118495f,-0.939823508f,0.291259229f,0.999560297f,0.783326924f,0.484776139f,0.280778319f,0.159362778f,0.0898785442f,0.0505891182f,0.0284566563f,0.0160038304f,0.00899987947f,0.00506105041f,0.00284604589f,0.00160045072f,-0.54402113f,-0.612936914f,-0.0206835698f,0.978552461f,0.841470957f,0.533168435f,0.310983568f,0.176892191f,0.099833414f,0.0562044978f,0.0316175036f,0.0177818574f,0.009999834f,0.00562338345f,0.00316227227f,0.0017782785f,-0.999990225f,-0.0972764567f,-0.33057496f,0.926681578f,0.891207397f,0.579875171f,0.340877861f,0.19436565f,0.1097783f,0.0618181042f,0.0347780399f,0.0195598267f,0.0109997792f,0.00618571462f,0.00347849843f,0.00195610616f,-0.536572933f,0.448342979f,-0.60768342f,0.845583618f,0.932039082f,0.624748647f,0.370431304f,0.211777672f,0.119712204f,0.0674297586f,0.0379382223f,0.0213377345f,0.0119997123f,0.0067480444f,0.00379472389f,0.00213393359f,0.420167029f,0.855880976f,-0.824528456f,0.737816215f,0.963558197f,0.667647004f,0.399614304f,0.229122713f,0.129634142f,0.0730392784f,0.0410980321f,0.0231155735f,0.0129996343f,0.00731037185f,0.00411094911f,0.00231176103f,0.990607381f,0.999823332f,-0.959605396f,0.606778562f,0.985449731f,0.708434701f,0.428397775f,0.246395305f,0.139543116f,0.078646481f,0.0442574248f,0.0248933397f,0.0139995432f,0.00787269697f,0.00442717411f,0.00248958869f,0.650287867f,0.835838437f,-0.999518692f,0.456603259f,0.997494996f,0.746982634f,0.456752867f,0.263589978f,0.149438128f,0.0842512026f,0.0474163815f,0.0266710296f,0.0149994381f,0.00843502022f,0.00474339863f,0.00266741589f,-0.287903309f,0.414430231f,-0.940310359f,0.292027086f,0.999573588f,0.783169091f,0.484651238f,0.280701309f,0.159318209f,0.0898532644f,0.0505748577f,0.028448632f,0.015999319f,0.00899733976f,0.00505962269f,0.00284524332f,-0.961397469f,-0.134615138f,-0.78785187f,0.11824052f,0.991664827f,0.81687957f,0.512064993f,0.29772386f,0.169182345f,0.09545248f,0.0537328273f,0.0302261449f,0.0169991814f,0.00955965649f,0.00537584582f,0.00302307028f,-0.750987232f,-0.642200708f,-0.557262897f,-0.0592755191f,0.973847628f,0.84800756f,0.538966715f,0.314652264f,0.179029569f,0.101048686f,0.0568902642f,0.0320035629f,0.0179990288f,0.0101219704f,0.00569206895f,0.00320089748f,0.149877205f,-0.952000856f,-0.271410108f,-0.234921798f,0.946300089f,0.876454532f,0.565329552f,0.331481189f,0.188858896f,0.10664168f,0.060047131f,0.0337808803f,0.0189988576f,0.0106842816f,0.00600829115f,0.00337872445f,0.912945271f,-0.968601942f,0.0413582884f,-0.403158993f,0.909297407f,0.902130723f,0.591127038f,0.348205268f,0.198669314f,0.112231314f,0.0632033944f,0.0355580896f,0.0199986678f,0.011246589f,0.00632451288f,0.00355655141f,0.836655617f,-0.686891198f,0.35002476f,-0.558680534f,0.863209307f,0.924954832f,0.616333544f,0.364819258f,0.208459899f,0.117817394f,0.0663590282f,0.0373351872f,0.0209984574f,0.0118088927f,0.00664073415f,0.00373437814f,-0.00885130931f,-0.193630233f,0.623979926f,-0.696581721f,0.808496356f,0.944854796f,0.640923738f,0.381317884f,0.218229622f,0.123399742f,0.0695140064f,0.0391121693f,0.0219982266f,0.0123711927f,0.00695695449f,0.00391220488f,-0.846220434f,0.359264523f,0.836055279f,-0.812512875f,0.745705247f,0.961767614f,0.664873064f,0.397695929f,0.227977514f,0.128978193f,0.0726682767f,0.0408890247f,0.0229979735f,0.0129334899f,0.00727317436f,0.00409003161f,-0.905578375f,0.801513135f,0.965219259f,-0.902817786f,0.67546314f,0.97563988f,0.688157499f,0.413948208f,0.237702623f,0.134552568f,0.0758218244f,0.0426657498f,0.0239976961f,0.0134957815f,0.0075893933f,0.00426785741f,-0.132351756f,0.996909976f,0.998663187f,-0.964648306f,0.598472118f,0.986427724f,0.710753918f,0.430069596f,0.247403964f,0.140122697f,0.0789746121f,0.0444423407f,0.0249973964f,0.0140580693f,0.00790561177f,0.00444568414f,0.76255846f,0.885276794f,0.933070183f,-0.996054351f,0.515501261f,0.994096994f,0.732639611f,0.446054995f,0.257080555f,0.145688385f,0.0821266174f,0.0462187938f,0.0259970706f,0.0146203535f,0.00822182931f,0.00462350994f,0.956375957f,0.500994205f,0.774945021f,-0.996045172f,0.427379847f,0.99862349f,0.753792703f,0.46189931f,0.266731411f,0.151249468f,0.0852777958f,0.0479951017f,0.0269967206f,0.015182632f,0.00853804592f,0.00480133574f,0.270905793f,-0.0375856608f,0.539968967f,-0.964621305f,0.334988207f,0.999992907f,0.774192095f,0.477597594f,0.276355654f,0.156805754f,0.0884281173f,0.049771253f,0.0279963426f,0.0157449059f,0.0088542616f,0.00497916201f,-0.663633883f,-0.564589798f,0.251445323f,-0.902773678f,0.239249229f,0.998200953f,0.793817401f,0.49314484f,0.28595221f,0.162357092f,0.0915775672f,0.0515472479f,0.0289959367f,0.0163071752f,0.00917047635f,0.00515698735f,-0.988031626f,-0.917709649f,-0.0620148405f,-0.812452853f,0.141120002f,0.993253171f,0.812648892f,0.5085361f,0.295520186f,0.167903304f,0.0947260931f,0.0533230826f,0.029995501f,0.0168694388f,0.00948669016f,0.00533481315f,-0.404037654f,-0.988192797f,-0.369325012f,-0.696507812f,0.0415805206f,0.985165298f,0.830667794f,0.523766637f,0.305058628f,0.173444211f,0.0978736654f,0.055098746f,0.0309950355f,0.0174316969f,0.00980290305f,0.00551263802f,0.551426709f,-0.754330218f,-0.640009403f,-0.5585953f,-0.0583741926f,0.973962843f,0.847856104f,0.538831532f,0.314566553f,0.17897962f,0.101020269f,0.0568742342f,0.0319945402f,0.0179939512f,0.0101191159f,0.00569046335f,0.999911845f,-0.28814739f,-0.847224355f,-0.403064936f,-0.157745644f,0.959681332f,0.864196658f,0.553726017f,0.324043006f,0.184509367f,0.10416586f,0.0586495437f,0.0329940096f,0.0185561981f,0.010435327f,0.00586828869f,0.529082716f,0.266779721f,-0.97042042f,-0.234822124f,-0.255541205f,0.942365825f,0.879673064f,0.568445385f,0.333487093f,0.190033287f,0.107310407f,0.0604246669f,0.0339934528f,0.0191184394f,0.010751537f,0.00604611309f,-0.428182662f,0.739542127f,-0.997380435f,-0.0591726787f,-0.350783229f,0.92207104f,0.894269884f,0.582984984f,0.342897803f,0.195551202f,0.110453881f,0.0621996038f,0.034992855f,0.0196806751f,0.0110677453f,0.00622393796f,-0.991778851f,0.984540582f,-0.925431013f,0.118342586f,-0.442520559f,0.89886117f,0.907972515f,0.597340286f,0.352274209f,0.201062918f,0.113596253f,0.0639743358f,0.0359922275f,0.0202429052f,0.0113839535f,0.0064017619f,-0.643538117f,0.926318109f,-0.761706948f,0.292125374f,-0.529836178f,0.872809589f,0.920767248f,0.611506701f,0.361615449f,0.206568271f,0.116737492f,0.0657488778f,0.036991559f,0.0208051261f,0.0117001599f,0.0065795863f,0.296368569f,0.58280617f,-0.522444785f,0.456694692f,-0.611857831f,0.84399873f,0.932641268f,0.625479698f,0.370920479f,0.212067112f,0.119877554f,0.0675232038f,0.0379908569f,0.0213673431f,0.0120163653f,0.00675741071f,0.963795364f,0.0598003156f,-0.231372014f,0.606860459f,-0.687766254f,0.81251961f,0.943582714f,0.639254928f,0.380188406f,0.217559248f,0.123016424f,0.0692973137f,0.0389901139f,0.0219295528f,0.0123325698f,0.00693523418f,0.745113134f,-0.481621295f,0.0826458037f,0.737885714f,-0.756802499f,0.778471708f,0.953580678f,0.652827978f,0.389418334f,0.223044485f,0.126154065f,0.0710712075f,0.0399893373f,0.0224917568f,0.0126487734f,0.00711305765f,-0.158622667f,-0.874714017f,0.388467699f,0.845638454f,-0.818277061f,0.74196279f,0.962625206f,0.666194677f,0.39860931f,0.228522688f,0.129290432f,0.0728448778f,0.0409885161f,0.0230539497f,0.0129649751f,0.00729088066f,-0.916521549f,-0.998410463f,0.655764699f,0.926720202f,-0.871575892f,0.703108132f,0.970707119f,0.679350674f,0.407760441f,0.233993664f,0.132425532f,0.0746183172f,0.0419876575f,0.0236161388f,0.0132811759f,0.00746870413f,-0.831774771f,-0.814614236f,0.858030677f,0.97857362f,-0.916166008f,0.662030637f,0.977818429f,0.692291796f,0.416870773f,0.23945722f,0.135559291f,0.0763915181f,0.0429867506f,0.0241783205f,0.0135973748f,0.00764652714f,0.0177019257f,-0.37993139f,0.975206196f,0.999563396f,-0.951602101f,0.618860185f,0.983951986f,0.70501405f,0.425939471f,0.244913206f,0.138691694f,0.0781644881f,0.0439858064f,0.0247404929f,0.0139135728f,0.00782434922f,0.850903511f,0.171763569f,0.995670974f,0.989027262f,-0.977530122f,0.57373327f,0.989101648f,0.717513323f,0.434965521f,0.250361472f,0.141822711f,0.0799371973f,0.0449848175f,0.0253026579f,0.0142297689f,0.00800217129f,0.901788354f,0.670557022f,0.917395473f,0.947297752f,-0.993690968f,0.526792526f,0.993262351f,0.72978574f,0.44394809f,0.255801797f,0.144952312f,0.0817096606f,0.0459837839f,0.0258648153f,0.0145459641f,0.0081799943f,0.123573124f,0.962832689f,0.748142362f,0.875690997f,-0.999923289f,0.478186339f,0.996429801f,0.741827428f,0.452886283f,0.261234075f,0.148080453f,0.0834818557f,0.0469827019f,0.0264269635f,0.0148621574f,0.00835781638f,-0.768254638f,0.958573103f,0.504697084f,0.776465356f,-0.99616462f,0.428068399f,0.99860096f,0.753634512f,0.461779177f,0.266658038f,0.151207119f,0.0852537975f,0.0479815714f,0.0269891042f,0.0151783489f,0.00853563752f,-0.953752637f,0.659090102f,0.211200655f,0.652750373f,-0.982452571f,0.376597136f,0.999773562f,0.765203178f,0.470625877f,0.272073567f,0.15433228f,0.087025471f,0.0489803962f,0.0275512375f,0.0154945394f,0.0087134596f,-0.262374848f,0.156619072f,-0.10324046f,0.508447945f,-0.958924294f,0.32393527f,0.999946535f,0.776529968f,0.47942555f,0.277480543f,0.157455891f,0.0887968615f,0.0499791689f,0.0281133596f,0.0158107281f,0.00889127981f,0.670229197f,-0.394086063f,-0.407444149f,0.3481085f,-0.925814748f,0.270249337f,0.99911958f,0.787611187f,0.48817724f,0.282878697f,0.160577938f,0.0905679762f,0.0509778969f,0.0286754742f,0.0161269177f,0.00906910095f,0.986627579f,-0.823421597f,-0.671240151f,0.176790684f,-0.883454502f,0.215709001f,0.997293651f,0.798443377f,0.496880114f,0.28826794f,0.163698375f,0.0923388004f,0.051976569f,0.0292375814f,0.0164431017f,0.00924692024f,0.395925164f,-0.999157965f,-0.868469954f,-0.000103020677f,-0.832267344f,0.160486728f,0.994470477f,0.809023023f,0.505533338f,0.293648034f,0.166817173f,0.0941093415f,0.0529751927f,0.0297996756f,0.0167592876f,0.00942474138f,-0.558789074f,-0.867171526f,-0.979574919f,-0.176993474f,-0.772764444f,0.104756832f,0.990652919f,0.819346905f,0.514135957f,0.29901889f,0.169934288f,0.0958795771f,0.0539737605f,0.0303617641f,0.0170754679f,0.00960256159f,-0.999755144f,-0.468111664f,-0.993535519f,-0.348301649f,-0.705540299f,0.0486960001f,0.985844791f,0.829411685f,0.522687256f,0.304380238f,0.173049718f,0.0976495072f,0.0549722798f,0.0309238415f,0.01739165f,0.00978038087f,-0.521551013f,0.0751182064f,-0.908967435f,-0.508624554f,-0.631266713f,-0.00751878507f,0.980050862f,0.839214146f,0.531186223f,0.30973196f,0.17616342f,0.0994191393f,0.0559707358f,0.0314859077f,0.0177078284f,0.00995820016f,0.436164767f,0.595211506f,-0.734258294f,-0.652905703f,-0.550685287f,-0.0637097955f,0.973276973f,0.848751247f,0.539632022f,0.315073937f,0.179275364f,0.101188451f,0.0569691435f,0.0320479684f,0.0180240069f,0.0101360194f,0.992872655f,0.931992829f,-0.486733496f,-0.776594579f,-0.464602023f,-0.119699396f,0.965529919f,0.858020008f,0.548023939f,0.3204059f,0.182385504f,0.102957435f,0.0579674877f,0.0326100141f,0.0183401816f,0.0103138378f,0.636738002f,0.981735826f,-0.190938011f,-0.87579f,-0.373876572f,-0.175310582f,0.956817448f,0.867017388f,0.55636102f,0.325727791f,0.185493827f,0.104726106f,0.0589657798f,0.0331720486f,0.0186563563f,0.0104916561f,-0.304810613f,0.729123712f,0.12379095f,-0.947363734f,-0.279415488f,-0.230367512f,0.947148204f,0.875740528f,0.564642429f,0.33103931f,0.188600287f,0.106494442f,0.0599640086f,0.0337340795f,0.0189725272f,0.0106694745f,-0.966117799f,0.251952261f,0.426245421f,-0.98905772f,-0.182162598f,-0.284696162f,0.936531842f,0.884186864f,0.572867453f,0.336340427f,0.191704854f,0.108262435f,0.0609621815f,0.0342960916f,0.0192886982f,0.0108472919f,-0.739180684f,-0.302812874f,0.686427653f,-0.999557257f,-0.0830891207f,-0.338124752f,0.924979091f,0.892353535f,0.581035137f,0.341630876f,0.194807529f,0.110030092f,0.0619602874f,0.0348580964f,0.0196048655f,0.0110251084f,0.167355701f,-0.764320076f,0.878538549f,-0.978531301f,0.0168140903f,-0.390484393f,0.912501454f,0.900238097f,0.589144766f,0.346910536f,0.197908238f,0.111797392f,0.0629583374f,0.0354200937f,0.0199210308f,0.0112029258f};
#define LAS __attribute__((address_space(3)))
#define XB_TMO      128
#define XB_XCNT(j)  (256  + 64 * (j))
#define XB_XSUB(j)  (1280 + 64 * (j))
#define XB_XGEN(j)  (2304 + 64 * (j))
#define XB_TOP      3328
#define XB_TOPGEN   3392
#define XCD_BAR_WORDS 3456
#define XB_SPIN_CAP (1u << 18)

__device__ __forceinline__ unsigned xb_ld(unsigned* p)              { return __hip_atomic_load(p, __ATOMIC_RELAXED, __HIP_MEMORY_SCOPE_AGENT); }
__device__ __forceinline__ unsigned xb_add(unsigned* p, unsigned v) { return __hip_atomic_fetch_add(p, v, __ATOMIC_RELAXED, __HIP_MEMORY_SCOPE_AGENT); }
__device__ __forceinline__ unsigned xb_xcc_id() { return (unsigned)__builtin_amdgcn_s_getreg((3 << 11) | 20) & 0xFu; }
#define XB_SPIN(cond, bar) do { unsigned _sp = 0; while (cond) { __builtin_amdgcn_s_sleep(1); \
    if ((++_sp & 255u) == 0u) { if (xb_ld(&(bar)[XB_TMO])) break; if (_sp > XB_SPIN_CAP) { atomicAdd(&(bar)[XB_TMO], 1u); break; } } } } while (0)

struct XcdBarrier {
    unsigned* bar; unsigned x;
    volatile LAS unsigned* st;
};

__device__ __forceinline__ XcdBarrier xcd_barrier_post(unsigned* bar, volatile LAS unsigned* st) {
    XcdBarrier b; b.bar = bar; b.x = xb_xcc_id(); b.st = st;
    if (threadIdx.x == 0) (void)xb_add(&bar[XB_XCNT(b.x)], 1u);
    return b;
}
__device__ __forceinline__ void xcd_barrier_complete(unsigned* bar, unsigned x, unsigned& nloc, unsigned& nx) {
    const unsigned G = gridDim.x * gridDim.y * gridDim.z;
    unsigned sum, cnt, mine, sp = 0u;
    for (;;) {
        sum = 0u; cnt = 0u; mine = 0u;
#pragma unroll
        for (unsigned j = 0; j < 16; ++j) { const unsigned c = xb_ld(&bar[XB_XCNT(j)]); sum += c; cnt += (c > 0u) ? 1u : 0u; mine = (j == x) ? c : mine; }
        if (sum == G) break;
        __builtin_amdgcn_s_sleep(1);
        if ((++sp & 255u) == 0u) { if (xb_ld(&bar[XB_TMO])) break; if (sp > XB_SPIN_CAP) { atomicAdd(&bar[XB_TMO], 1u); break; } }
    }
    nloc = mine > 0u ? mine : 1u; nx = cnt > 0u ? cnt : 1u;
}

__device__ __forceinline__ void xcd_barrier(const XcdBarrier& b) {
    asm volatile("s_waitcnt vmcnt(0)" ::: "memory");
    __syncthreads();
    if (threadIdx.x == 0) {
        unsigned* bar = b.bar;
        __builtin_amdgcn_s_waitcnt(0);
        unsigned nloc = b.st[0], nx = b.st[1];
        if (nloc == 0u) { xcd_barrier_complete(bar, b.x, nloc, nx); b.st[0] = nloc; b.st[1] = nx; }
        const unsigned old = xb_add(&bar[XB_XSUB(b.x)], 1u);
        const unsigned gen = old / nloc;
        if (old + 1u == (gen + 1u) * nloc) {
            __builtin_amdgcn_fence(__ATOMIC_RELEASE, "agent");
            asm volatile("s_waitcnt vmcnt(0)" ::: "memory");
            const unsigned og = xb_add(&bar[XB_TOP], 1u);
            const unsigned tg = og / nx;
            if (og + 1u == (tg + 1u) * nx) xb_add(&bar[XB_TOPGEN], 1u);
            else XB_SPIN(xb_ld(&bar[XB_TOPGEN]) == tg, bar);
            __builtin_amdgcn_fence(__ATOMIC_ACQUIRE, "agent");
            xb_add(&bar[XB_XGEN(b.x)], 1u);
            asm volatile("s_waitcnt vmcnt(0)" ::: "memory");
        } else {
            XB_SPIN(xb_ld(&bar[XB_XGEN(b.x)]) == gen, bar);
            __builtin_amdgcn_fence(__ATOMIC_ACQUIRE, "agent");
            asm volatile("s_waitcnt vmcnt(0)" ::: "memory");
        }
    }
    __syncthreads();
}

#define DI __device__ __forceinline__
#define LAS __attribute__((address_space(3)))
typedef unsigned short bf16;
typedef short bf16x8 __attribute__((ext_vector_type(8)));
typedef float f32x4 __attribute__((ext_vector_type(4)));
typedef unsigned u32x4 __attribute__((ext_vector_type(4)));
typedef unsigned u32x2 __attribute__((ext_vector_type(2)));

#ifndef COOP
#define COOP 1
#endif

constexpr int D = 1024, NBATCH = 4, SEQ = 4096, CTXL = 256, NLAT = NBATCH * SEQ, NCTX = NBATCH * CTXL, MT = NLAT + NCTX;
constexpr int FF = 2816, KEYS = SEQ + CTXL;
constexpr int LDP0 = 2560, LDP1 = 3072;
constexpr int C_AQ = 0, C_AK = 512, C_AV = 640, C_BQ = 768, C_BK = 1024, C_BV = 1280, C_BO = 1792, C_RF = 2304, C_RB = 2320;
constexpr float LOG2E = 1.4426950408889634f, EPS = 1e-6f;
constexpr int NCHUNK = 68;

constexpr size_t MiB = 1u << 20;
constexpr size_t WS_CTL = 0, WS_MOD = 1 * MiB, WS_XC = 2 * MiB, WS_WABI = 6 * MiB, WS_WABO = 11 * MiB, WS_WFI = 13 * MiB, WS_WFO = 35 * MiB, WS_WNI = 46 * MiB, WS_WNO = 52 * MiB;
constexpr size_t WS_HO = 54 * MiB, WS_YF = 88 * MiB, WS_P = 122 * MiB, WS_STC = 224 * MiB, WS_DEC = 228 * MiB, WS_END = 246 * MiB;
constexpr size_t WS_PART = 224 * MiB;
constexpr int LDS_BYTES = 147456;
constexpr int NWAVES = 8, NTHR = 512;

DI float bf2f(unsigned short h) { return __uint_as_float(((unsigned)h) << 16); }
DI unsigned pk2(float lo, float hi) { return pg8::cvt_pk_bf16(lo, hi); }
DI float wave_sum(float v) {
#pragma unroll
    for (int o = 1; o < 64; o <<= 1) v += __shfl_xor(v, o);
    return v;
}
DI float fast_exp2(float x) { return __builtin_amdgcn_exp2f(x); }
DI float silu_f(float g) { return g * __builtin_amdgcn_rcpf(1.0f + __expf(-g)); }
DI void unpack8(const bf16x8 v, float (&o)[8]) {
#pragma unroll
    for (int i = 0; i < 8; ++i) o[i] = bf2f((unsigned short)v[i]);
}
DI bf16x8 pack8(const float (&p)[8]) {
    u32x4 w; w.x = pk2(p[0], p[1]); w.y = pk2(p[2], p[3]); w.z = pk2(p[4], p[5]); w.w = pk2(p[6], p[7]);
    return __builtin_bit_cast(bf16x8, w);
}
#define MFMA16(a, b, c) __builtin_amdgcn_mfma_f32_16x16x32_bf16((a), (b), (c), 0, 0, 0)

struct EpiStore {
    static constexpr bool PERM = true, AFTER_DRAIN = false;
    bf16* O; int ldc;
    DI void operator()(const pg8::f32x4 (&acc)[2][2][4][2], const pg8::Unit& u, int wr, int wc, int fr, int fq) const {
        const int row0 = u.pm * 256 + wr * 64 + fr, col0 = u.pn * 256 + wc * 32 + 8 * fq;
#pragma unroll
        for (int ai = 0; ai < 2; ++ai)
#pragma unroll
            for (int m = 0; m < 4; ++m) { bf16* rowp = O + (size_t)(row0 + ai * 128 + m * 16) * ldc + col0;
#pragma unroll
                for (int bj = 0; bj < 2; ++bj) { const pg8::f32x4 v0 = acc[ai][bj][m][0], v1 = acc[ai][bj][m][1];
                    u32x4 w; w.x = pk2(v0[0], v0[1]); w.y = pk2(v0[2], v0[3]); w.z = pk2(v1[0], v1[1]); w.w = pk2(v1[2], v1[3]);
                    *(u32x4*)(rowp + bj * 128) = w; } }
    }
};
struct EpiSwiglu {
    static constexpr bool PERM = true, AFTER_DRAIN = false;
    bf16* O; int ldc;
    DI void operator()(const pg8::f32x4 (&acc)[2][2][4][2], const pg8::Unit& u, int wr, int wc, int fr, int fq) const {
        const int row0 = u.pm * 256 + wr * 64 + fr, col0 = u.pn * 128 + wc * 32 + 8 * fq;
#pragma unroll
        for (int ai = 0; ai < 2; ++ai)
#pragma unroll
            for (int m = 0; m < 4; ++m) { bf16* rowp = O + (size_t)(row0 + ai * 128 + m * 16) * ldc + col0;
                const pg8::f32x4 g0 = acc[ai][0][m][0], g1 = acc[ai][0][m][1], u0 = acc[ai][1][m][0], u1 = acc[ai][1][m][1];
                u32x4 w; w.x = pk2(silu_f(g0[0]) * u0[0], silu_f(g0[1]) * u0[1]); w.y = pk2(silu_f(g0[2]) * u0[2], silu_f(g0[3]) * u0[3]);
                w.z = pk2(silu_f(g1[0]) * u1[0], silu_f(g1[1]) * u1[1]); w.w = pk2(silu_f(g1[2]) * u1[2], silu_f(g1[3]) * u1[3]);
                *(u32x4*)rowp = w; }
    }
};

struct OneUnit {
    int pm, pn; bool has;
    DI bool next(int i, pg8::Unit& u) const { if (i != 0 || !has) return false; u.pm = pm; u.pn = pn; return true; }
    DI void a_ready(const pg8::Unit&) const {}
    DI void done(const pg8::Unit&) const {}
};

struct Args { const float* in[23]; float* out; unsigned char* ws; int ph_lo, ph_hi; };
enum { I_X = 0, I_C, I_CTX, I_CCTX, I_WMOD, I_BMOD, I_GMPRE, I_GMPOST, I_GFPRE, I_GFPOST, I_WFI, I_WFO, I_ABWI, I_ABWO, I_SINK, I_GFW, I_GFB, I_GBW, I_GBB, I_GNORM, I_NAWI, I_NAWO, I_RELB };

DI void transpose_item(const float* W, int K, int N, bf16* WT, int k0, int n0, int drow0, LAS float* scr, int lane) {
#pragma unroll 8
    for (int i = 0; i < 32; ++i) { const int kk = 2 * i + (lane >> 5); scr[kk * 33 + (lane & 31)] = W[(size_t)(k0 + kk) * N + n0 + (lane & 31)]; }
    asm volatile("s_waitcnt lgkmcnt(0)" ::: "memory");
    const int c = lane & 7;
#pragma unroll
    for (int j = 0; j < 4; ++j) { const int n = (lane >> 3) + 8 * j; const LAS float* s = scr + (8 * c) * 33 + n;
        u32x4 o; o.x = pk2(s[0 * 33], s[1 * 33]); o.y = pk2(s[2 * 33], s[3 * 33]); o.z = pk2(s[4 * 33], s[5 * 33]); o.w = pk2(s[6 * 33], s[7 * 33]);
        *(u32x4*)(WT + (size_t)(drow0 + n) * K + k0 + 8 * c) = o; }
    asm volatile("s_waitcnt lgkmcnt(0)" ::: "memory");
}
DI void xpose_plain(const float* W, int K, int N, bf16* WT, int item, LAS float* scr, int lane) {
    const int nblk = N / 32, kb = item / nblk, nb = item % nblk;
    transpose_item(W, K, N, WT, 64 * kb, 32 * nb, 32 * nb, scr, lane);
}
DI void xpose_ffnin(const float* W, bf16* WT, int item, LAS float* scr, int lane) {
    const int nblk = 5632 / 32, kb = item / nblk, nb = item % nblk, n0 = 32 * nb;
    const int bj = n0 >= FF ? 1 : 0, cc = n0 - bj * FF, drow0 = 256 * (cc >> 7) + 128 * bj + (cc & 127);
    transpose_item(W, 1024, 5632, WT, 64 * kb, n0, drow0, scr, lane);
}

DI void phase_prologue(const Args& a, LAS unsigned char* lds, int tid, int lane, int wave) {
    unsigned char* ws = a.ws;
    {
        LAS float* sl = (LAS float*)lds;
        LAS float* red = (LAS float*)(lds + 32768);
        for (int i = tid; i < 5 * 1024; i += NTHR) { const int s = i >> 10, k = i & 1023; const float v = s < 4 ? a.in[I_C][s * 1024 + k] : a.in[I_CCTX][k]; sl[i] = v / (1.0f + __expf(-v)); }
        __syncthreads();
        for (int u = blockIdx.x; u < 192; u += gridDim.x) {
            const int layer = u / 96, col = (u % 96) * 64 + lane;
            const float* W = a.in[I_WMOD] + (size_t)layer * 1024 * 6144 + col;
            float acc[5] = {0.f, 0.f, 0.f, 0.f, 0.f};
            const int kb = wave * 128;
#pragma unroll 8
            for (int k = 0; k < 128; ++k) { const float w = W[(size_t)(kb + k) * 6144];
#pragma unroll
                for (int s = 0; s < 5; ++s) acc[s] += sl[s * 1024 + kb + k] * w; }
#pragma unroll
            for (int s = 0; s < 5; ++s) red[(wave * 5 + s) * 64 + lane] = acc[s];
            __syncthreads();
            if (tid < 320) { const int s = tid >> 6, l = tid & 63; float t = 0.f;
#pragma unroll
                for (int w = 0; w < 8; ++w) t += red[(w * 5 + s) * 64 + l];
                const int c2 = (u % 96) * 64 + l;
                ((float*)(ws + WS_MOD))[(size_t)(layer * 5 + s) * 6144 + c2] = t + a.in[I_BMOD][layer * 6144 + c2]; }
            __syncthreads();
        }
        __syncthreads();
    }
    LAS float* scr = (LAS float*)(lds + wave * 16384);
    const int gw = blockIdx.x * NWAVES + wave, NGW = gridDim.x * NWAVES;
    constexpr int I_1 = 16 * 73, I_2 = 16 * 32, I_3 = 16 * 176, I_4 = 44 * 32, I_5 = 16 * 96, I_6 = 16 * 32;
    constexpr int NITEMS = I_1 + I_2 + 2 * I_3 + 2 * I_4 + I_5 + I_6;
    for (int it = gw; it < NITEMS; it += NGW) {
        int r = it;
        if (r < I_1) { xpose_plain(a.in[I_ABWI], 1024, 2336, (bf16*)(ws + WS_WABI), r, scr, lane); continue; } r -= I_1;
        if (r < I_2) { xpose_plain(a.in[I_ABWO], 1024, 1024, (bf16*)(ws + WS_WABO), r, scr, lane); continue; } r -= I_2;
        if (r < I_3) { xpose_ffnin(a.in[I_WFI], (bf16*)(ws + WS_WFI), r, scr, lane); continue; } r -= I_3;
        if (r < I_3) { xpose_ffnin(a.in[I_WFI] + (size_t)1024 * 5632, (bf16*)(ws + WS_WFI) + (size_t)5632 * 1024, r, scr, lane); continue; } r -= I_3;
        if (r < I_4) { xpose_plain(a.in[I_WFO], FF, 1024, (bf16*)(ws + WS_WFO), r, scr, lane); continue; } r -= I_4;
        if (r < I_4) { xpose_plain(a.in[I_WFO] + (size_t)FF * 1024, FF, 1024, (bf16*)(ws + WS_WFO) + (size_t)1024 * FF, r, scr, lane); continue; } r -= I_4;
        if (r < I_5) { xpose_plain(a.in[I_NAWI], 1024, 3072, (bf16*)(ws + WS_WNI), r, scr, lane); continue; } r -= I_5;
        xpose_plain(a.in[I_NAWO], 1024, 1024, (bf16*)(ws + WS_WNO), r, scr, lane);
    }
    { u32x4* z = (u32x4*)((bf16*)(ws + WS_WABI) + (size_t)2336 * 1024); const u32x4 zero = {0u, 0u, 0u, 0u};
      for (int i = blockIdx.x * NTHR + tid; i < 224 * 128; i += gridDim.x * NTHR) z[i] = zero; }
}

DI void row_op(const float* xsrc, const bf16* y, int nslice, const float* gpost, const float* gate, float* xdst,
               const float* gpre, const float* shift, const float* scale, bf16* hdst, int lane) {
    f32x4 v[4];
#pragma unroll
    for (int j = 0; j < 4; ++j) v[j] = *((const f32x4*)xsrc + lane + 64 * j);
    if (y) {
        f32x4 yv[4]; float s = 0.f;
#pragma unroll
        for (int j = 0; j < 4; ++j) yv[j] = (f32x4){0.f, 0.f, 0.f, 0.f};
        for (int sl = 0; sl < nslice; ++sl) {
#pragma unroll
            for (int j = 0; j < 4; ++j) { const u32x2 w = *((const u32x2*)(y + (size_t)sl * NCTX * D) + lane + 64 * j);
                yv[j] = yv[j] + (f32x4){__uint_as_float(w.x << 16), __uint_as_float(w.x & 0xffff0000u), __uint_as_float(w.y << 16), __uint_as_float(w.y & 0xffff0000u)}; } }
#pragma unroll
        for (int j = 0; j < 4; ++j) s += (yv[j].x * yv[j].x + yv[j].y * yv[j].y) + (yv[j].z * yv[j].z + yv[j].w * yv[j].w);
        const float rstd = __builtin_amdgcn_rsqf(wave_sum(s) * (1.0f / D) + EPS);
#pragma unroll
        for (int j = 0; j < 4; ++j) { const f32x4 gp = *((const f32x4*)gpost + lane + 64 * j), gt = *((const f32x4*)gate + lane + 64 * j);
            v[j] = v[j] + gt * (yv[j] * rstd * gp); }
    }
    if (xdst) {
#pragma unroll
        for (int j = 0; j < 4; ++j) *((f32x4*)xdst + lane + 64 * j) = v[j];
    }
    if (hdst) {
        float s = 0.f;
#pragma unroll
        for (int j = 0; j < 4; ++j) s += (v[j].x * v[j].x + v[j].y * v[j].y) + (v[j].z * v[j].z + v[j].w * v[j].w);
        const float rstd = __builtin_amdgcn_rsqf(wave_sum(s) * (1.0f / D) + EPS);
#pragma unroll
        for (int j = 0; j < 4; ++j) { const f32x4 gp = *((const f32x4*)gpre + lane + 64 * j), sh = *((const f32x4*)shift + lane + 64 * j), sc = *((const f32x4*)scale + lane + 64 * j);
            const f32x4 h = v[j] * rstd * gp * (sc + 1.0f) + sh;
            u32x2 w; w.x = pk2(h.x, h.y); w.y = pk2(h.z, h.w);
            *((u32x2*)hdst + lane + 64 * j) = w; }
    }
}
DI void phase_rows(const Args& a, int mode, int layer, int lane, int wave) {
    unsigned char* ws = a.ws;
    const float* MOD = (const float*)(ws + WS_MOD);
    bf16* H = (bf16*)(ws + WS_HO); const bf16* YF = (const bf16*)(ws + WS_YF); const bf16* PART = (const bf16*)(ws + WS_PART); float* XC = (float*)(ws + WS_XC);
    const int gw = blockIdx.x * NWAVES + wave, NGW = gridDim.x * NWAVES;
    const int nrows = (layer == 0) ? MT : NLAT;
    for (int m = gw; m < nrows; m += NGW) {
        const bool lat = m < NLAT; const int s = lat ? (m >> 12) : 4;
        const float* mod = MOD + (size_t)(layer * 5 + s) * 6144;
        float* xcur = lat ? a.out + (size_t)m * D : XC + (size_t)(m - NLAT) * D;
        if (mode == 0) {
            const float* xin = lat ? a.in[I_X] + (size_t)m * D : a.in[I_CTX] + (size_t)(m - NLAT) * D;
            row_op(xin, nullptr, 0, nullptr, nullptr, nullptr, a.in[I_GMPRE], mod, mod + 1024, H + (size_t)m * D, lane);
        } else if (mode == 1) {
            const float* xin = (layer == 0) ? (lat ? a.in[I_X] + (size_t)m * D : a.in[I_CTX] + (size_t)(m - NLAT) * D) : xcur;
            row_op(xin, (layer == 0 && !lat) ? PART + (size_t)(m - NLAT) * D : YF + (size_t)m * D, (layer == 0 && !lat) ? 4 : 1, a.in[I_GMPOST] + layer * D, mod + 2048, xcur, a.in[I_GFPRE] + layer * D, mod + 3072, mod + 4096, H + (size_t)m * D, lane);
        } else {
            if (layer == 0) { const float* mod1 = MOD + (size_t)(5 + s) * 6144;
                row_op(xcur, lat ? YF + (size_t)m * D : PART + (size_t)(m - NLAT) * D, lat ? 1 : 11, a.in[I_GFPOST], mod + 5120, xcur, a.in[I_GMPRE] + D, mod1, mod1 + 1024, H + (size_t)m * D, lane); }
            else row_op(xcur, YF + (size_t)m * D, 1, a.in[I_GFPOST] + D, mod + 5120, xcur, nullptr, nullptr, nullptr, nullptr, lane);
        }
    }
}

DI float xmax_quads(float x) {
    unsigned u = __float_as_uint(x);
    auto r = __builtin_amdgcn_permlane16_swap(u, u, false, false);
    u = __float_as_uint(fmaxf(__uint_as_float(r[0]), __uint_as_float(r[1])));
    auto r2 = __builtin_amdgcn_permlane32_swap(u, u, false, false);
    return fmaxf(__uint_as_float(r2[0]), __uint_as_float(r2[1]));
}
DI float xsum_quads(float x) {
    unsigned u = __float_as_uint(x);
    auto r = __builtin_amdgcn_permlane16_swap(u, u, false, false);
    u = __float_as_uint(__uint_as_float(r[0]) + __uint_as_float(r[1]));
    auto r2 = __builtin_amdgcn_permlane32_swap(u, u, false, false);
    return __uint_as_float(r2[0]) + __uint_as_float(r2[1]);
}
struct KVFrag { bf16x8 kf[2][2]; bf16x8 vf[4]; };
DI void kv_load(KVFrag& f, const bf16* kp, int kld, const bf16* vp, int vld, int fr, int fq) {
#pragma unroll
    for (int h = 0; h < 2; ++h)
#pragma unroll
        for (int ks = 0; ks < 2; ++ks) f.kf[h][ks] = *(const bf16x8*)(kp + (size_t)((fr >> 2) * 8 + h * 4 + (fr & 3)) * kld + ks * 32 + fq * 8);
#pragma unroll
    for (int nt = 0; nt < 4; ++nt) f.vf[nt] = *(const bf16x8*)(vp + (size_t)(nt * 16 + fr) * vld + fq * 8);
}
template <int MODE>
DI void attn_one(f32x4 (&o)[4], float& mrun, float& lrun, const bf16x8 (&qf)[2], const KVFrag& f, float sc2, int d0, unsigned okmask, const float (&bias)[8]) {
    f32x4 s0 = {0.f, 0.f, 0.f, 0.f}, s1 = {0.f, 0.f, 0.f, 0.f};
    s0 = MFMA16(f.kf[0][0], qf[0], s0); s0 = MFMA16(f.kf[0][1], qf[1], s0);
    s1 = MFMA16(f.kf[1][0], qf[0], s1); s1 = MFMA16(f.kf[1][1], qf[1], s1);
    float sv[8] = {s0[0], s0[1], s0[2], s0[3], s1[0], s1[1], s1[2], s1[3]};
    float mx = -1e30f;
#pragma unroll
    for (int i = 0; i < 8; ++i) {
        float t = sv[i] * sc2;
        if (MODE == 1) { const int dd = d0 - i; t = (dd >= -128 && dd <= 128) ? t : -1e30f; }
        if (MODE == 2) { t = ((okmask >> i) & 1u) ? t + bias[i] : -1e30f; }
        sv[i] = t; mx = fmaxf(mx, t);
    }
    mx = xmax_quads(mx);
    if (__builtin_amdgcn_ballot_w64(mx > mrun) != 0ull) {
        const float mn = fmaxf(mrun, mx), alpha = fast_exp2(mrun - mn);
        lrun *= alpha; mrun = mn;
#pragma unroll
        for (int nt = 0; nt < 4; ++nt) o[nt] = o[nt] * alpha;
    }
    float p[8], ps = 0.f;
#pragma unroll
    for (int i = 0; i < 8; ++i) { p[i] = fast_exp2(sv[i] - mrun); ps += p[i]; }
    lrun += xsum_quads(ps);
    const bf16x8 pf = pack8(p);
#pragma unroll
    for (int nt = 0; nt < 4; ++nt) o[nt] = MFMA16(f.vf[nt], pf, o[nt]);
}
DI void attn_store1(const f32x4 (&o)[4], float lrun, bf16* op, int fq) {
    const float inv = 1.0f / lrun;
#pragma unroll
    for (int nt = 0; nt < 4; ++nt) { u32x2 w; w.x = pk2(o[nt][0] * inv, o[nt][1] * inv); w.y = pk2(o[nt][2] * inv, o[nt][3] * inv);
        *(u32x2*)(op + nt * 16 + fq * 4) = w; }
}

DI void window_attn_tile(const Args& a, int wt, int lane) {
    const bf16* P = (const bf16*)(a.ws + WS_P); const bf16* VtA = (const bf16*)(a.ws + WS_YF); bf16* O = (bf16*)(a.ws + WS_HO);
    const int fr = lane & 15, fq = lane >> 4;
    const bool isctx = wt >= 2048;
    int b, kvh, q0; size_t qrow;
    if (!isctx) { b = wt >> 9; kvh = (wt >> 8) & 1; q0 = (wt & 255) * 16; qrow = (size_t)b * SEQ + q0 + fr; }
    else { const int ct = wt - 2048; b = ct >> 5; kvh = (ct >> 4) & 1; q0 = (ct & 15) * 16; qrow = (size_t)NLAT + b * CTXL + q0 + fr; }
    bf16x8 qf[4][2]; f32x4 o[4][4]; float mrun[4], lrun[4];
#pragma unroll
    for (int g = 0; g < 4; ++g) {
#pragma unroll
        for (int ks = 0; ks < 2; ++ks) qf[g][ks] = *(const bf16x8*)(P + qrow * LDP0 + C_AQ + (kvh * 4 + g) * 64 + ks * 32 + fq * 8);
#pragma unroll
        for (int nt = 0; nt < 4; ++nt) o[g][nt] = (f32x4){0.f, 0.f, 0.f, 0.f};
        mrun[g] = a.in[I_SINK][kvh * 4 + g] * LOG2E; lrun[g] = 1.0f;
    }
    const float sc2 = 0.125f * LOG2E;
    const float nob[8] = {0.f, 0.f, 0.f, 0.f, 0.f, 0.f, 0.f, 0.f};
    const bf16* vbase = VtA + (size_t)((b * 2 + kvh) * 64) * KEYS;
    const bf16* kctx = P + (size_t)(NLAT + b * CTXL) * LDP0 + C_AK + kvh * 64;
    const bf16* kloc = P + (size_t)(b * SEQ) * LDP0 + C_AK + kvh * 64;
    const int tlo = (q0 - 128 > 0 ? q0 - 128 : 0) & ~31, thi = (q0 + 16 + 128 < SEQ) ? q0 + 16 + 128 : SEQ;
    const int ntile = isctx ? 8 : 8 + (thi - tlo + 31) / 32;
#define WIN_LOAD(F, t) do { const int t_ = (t); const int k0_ = t_ < 8 ? t_ * 32 : tlo + (t_ - 8) * 32; \
        kv_load(F, (t_ < 8 ? kctx : kloc) + (size_t)k0_ * LDP0, LDP0, vbase + (t_ < 8 ? SEQ : 0) + k0_, KEYS, fr, fq); } while (0)
#define WIN_PROC(F, t) do { const int t_ = (t); const int d0_ = t_ < 8 ? 0 : q0 + fr - (tlo + (t_ - 8) * 32) - fq * 8; \
        _Pragma("unroll") for (int g = 0; g < 4; ++g) attn_one<1>(o[g], mrun[g], lrun[g], qf[g], F, sc2, d0_, 0u, nob); } while (0)
    KVFrag A, B;
    WIN_LOAD(A, 0);
    for (int t = 0; t < ntile; t += 2) {
        WIN_LOAD(B, (t + 1 < ntile ? t + 1 : ntile - 1));
        WIN_PROC(A, t);
        WIN_LOAD(A, (t + 2 < ntile ? t + 2 : ntile - 1));
        if (t + 1 < ntile) WIN_PROC(B, t + 1);
    }
#undef WIN_LOAD
#undef WIN_PROC
#pragma unroll
    for (int g = 0; g < 4; ++g) attn_store1(o[g], lrun[g], O + qrow * D + (kvh * 4 + g) * 64, fq);
}

template <int NR>
DI void na_attn_group(const Args& a, int gid, int lane, LAS float* btab  ) {
    const bf16* P = (const bf16*)(a.ws + WS_P); const bf16* VtC = (const bf16*)(a.ws + WS_YF); bf16* O = (bf16*)(a.ws + WS_HO);
    const int fr = lane & 15, fq = lane >> 4;
    constexpr int NRG = 64 / NR; const int j = gid & 3, r0 = ((gid >> 2) % NRG) * NR, h = ((gid >> 2) / NRG) & 15, b = (gid >> 2) / (NRG * 16);
    { const float* relb = a.in[I_RELB] + h * 465;
      for (int i = lane; i < 465; i += 64) btab[i] = relb[i] * LOG2E;
      asm volatile("s_waitcnt vmcnt(0) lgkmcnt(0)" ::: "memory"); }
    bf16x8 qf[NR][2]; f32x4 o[NR][4]; float mrun[NR], lrun[NR];
#pragma unroll
    for (int qi = 0; qi < NR; ++qi) { const size_t qrow = (size_t)b * SEQ + (r0 + qi) * 64 + j * 16 + fr;
#pragma unroll
        for (int ks = 0; ks < 2; ++ks) qf[qi][ks] = *(const bf16x8*)(P + qrow * LDP1 + h * 64 + ks * 32 + fq * 8);
#pragma unroll
        for (int nt = 0; nt < 4; ++nt) o[qi][nt] = (f32x4){0.f, 0.f, 0.f, 0.f};
        mrun[qi] = -1e30f; lrun[qi] = 0.f; }
    const float sc2 = 0.125f * LOG2E;
    const float nob[8] = {0.f, 0.f, 0.f, 0.f, 0.f, 0.f, 0.f, 0.f};
    const bf16* vbase = VtC + (size_t)((b * 16 + h) * 64) * KEYS;
    const bf16* kctx = P + (size_t)(NLAT + b * CTXL) * LDP1 + 1024 + h * 64;
    const bf16* kloc = P + (size_t)(b * SEQ) * LDP1 + 1024 + h * 64;
    const int seg_start = j == 0 ? 0 : (j == 1 ? 8 : (j == 2 ? 24 : 32));
    const int qcol = j * 16 + fr; const int cs = qcol - 8 < 0 ? 0 : (qcol - 8 > 48 ? 48 : qcol - 8);
    unsigned okmask = 0u; int coloff[8];
#pragma unroll
    for (int i = 0; i < 8; ++i) { const int keycol = seg_start + fq * 8 + i; if (keycol >= cs && keycol < cs + 16) okmask |= 1u << i;
        int co = keycol - qcol + 15; co = co < 0 ? 0 : (co > 30 ? 30 : co); coloff[i] = co; }
    const int rsa = r0 - 4 < 0 ? 0 : (r0 - 4 > 56 ? 56 : r0 - 4);
    const int rsb = r0 + NR - 1 - 4 < 0 ? 0 : (r0 + NR - 1 - 4 > 56 ? 56 : r0 + NR - 1 - 4);
    const int nloc = rsb + 8 - rsa, ntile = 8 + nloc;
#define NA_LOAD(F, t) do { const int t_ = (t); const int k0_ = t_ < 8 ? t_ * 32 : (rsa + t_ - 8) * 64 + seg_start; \
        kv_load(F, (t_ < 8 ? kctx : kloc) + (size_t)k0_ * LDP1, LDP1, vbase + (t_ < 8 ? SEQ : 0) + k0_, KEYS, fr, fq); } while (0)
#define NA_PROC(F, t) do { const int t_ = (t); \
        if (t_ < 8) { _Pragma("unroll") for (int qi = 0; qi < NR; ++qi) attn_one<0>(o[qi], mrun[qi], lrun[qi], qf[qi], F, sc2, 0, 0u, nob); } \
        else { const int R_ = rsa + t_ - 8; \
            _Pragma("unroll") for (int qi = 0; qi < NR; ++qi) { const int r_ = r0 + qi; const int rs_ = r_ - 4 < 0 ? 0 : (r_ - 4 > 56 ? 56 : r_ - 4); \
                if (R_ >= rs_ && R_ < rs_ + 8) { const LAS float* rb_ = btab + (R_ - r_ + 7) * 31; float bias_[8]; \
                    _Pragma("unroll") for (int e = 0; e < 8; ++e) bias_[e] = rb_[coloff[e]]; \
                    attn_one<2>(o[qi], mrun[qi], lrun[qi], qf[qi], F, sc2, 0, okmask, bias_); } } } } while (0)
    KVFrag A, B;
    NA_LOAD(A, 0);
    for (int t = 0; t < ntile; t += 2) {
        NA_LOAD(B, (t + 1 < ntile ? t + 1 : ntile - 1));
        NA_PROC(A, t);
        NA_LOAD(A, (t + 2 < ntile ? t + 2 : ntile - 1));
        if (t + 1 < ntile) NA_PROC(B, t + 1);
    }
#undef NA_LOAD
#undef NA_PROC
#pragma unroll
    for (int qi = 0; qi < NR; ++qi) attn_store1(o[qi], lrun[qi], O + ((size_t)b * SEQ + (r0 + qi) * 64 + j * 16 + fr) * D + h * 64, fq);
}

DI void vt_unit(const bf16* P, int ldp, int vcol, int nh, bf16* Vt, int unit, LAS unsigned char* scr, int lane) {
    const int kb = unit % 68, bh = unit / 68, h = bh % nh, b = bh / nh;
    const size_t row0 = kb < 64 ? (size_t)b * SEQ + kb * 64 : (size_t)NLAT + b * CTXL + (kb - 64) * 64;
    LAS unsigned short* t = (LAS unsigned short*)scr;
#pragma unroll
    for (int i = 0; i < 8; ++i) { const int key = (lane >> 3) + 8 * i, ch = lane & 7;
        const u32x4 v = *(const u32x4*)(P + (row0 + key) * ldp + vcol + h * 64 + ch * 8);
        *(LAS u32x4*)(t + key * 72 + ch * 8) = v; }
    asm volatile("s_waitcnt lgkmcnt(0)" ::: "memory");
    bf16* dst = Vt + (size_t)(bh * 64 + lane) * KEYS + kb * 64;
#pragma unroll
    for (int g8 = 0; g8 < 8; ++g8) { unsigned short e[8];
#pragma unroll
        for (int i = 0; i < 8; ++i) e[i] = t[(g8 * 8 + i) * 72 + lane];
        u32x4 w; w.x = e[0] | ((unsigned)e[1] << 16); w.y = e[2] | ((unsigned)e[3] << 16); w.z = e[4] | ((unsigned)e[5] << 16); w.w = e[6] | ((unsigned)e[7] << 16);
        *(u32x4*)(dst + g8 * 8) = w; }
    asm volatile("s_waitcnt lgkmcnt(0)" ::: "memory");
}

constexpr int L_GW = 0, L_CUM = 4608, L_A = 21248, L_B = 30464, L_ATT = 39680, L_VT = 48896, L_SSQ = 67328, L_TOT = 67840;
DI size_t chunk_row0(int b, int n) { return n < 64 ? (size_t)b * SEQ + n * 64 : (size_t)NLAT + b * CTXL + (n - 64) * 64; }
DI float* st_ptr(const Args& a, int seq, int n) { return n < 64 ? a.out + (size_t)(seq * 64 + n) * 8192 : (float*)(a.ws + WS_STC) + (size_t)(seq * 4 + (n - 64)) * 8192; }

DI void gla_cum(const Args& a, LAS unsigned char* lds, const bf16* P, size_t row0, int h, int dir, int tid) {
    LAS float* rfl = (LAS float*)(lds + L_GW); LAS float* tot = (LAS float*)(lds + L_TOT); LAS float* cum = (LAS float*)(lds + L_CUM);
    const float* gw = a.in[dir ? I_GBW : I_GFW]; const float* gb = a.in[dir ? I_GBB : I_GFB];
    const int lane = tid & 63, w = tid >> 6;
    { const int c = tid >> 3, r2 = (tid & 7) * 2; const unsigned v = *(const unsigned*)(P + (row0 + c) * LDP0 + (dir ? C_RB : C_RF) + r2);
      rfl[c * 16 + r2] = __uint_as_float(v << 16); rfl[c * 16 + r2 + 1] = __uint_as_float(v & 0xffff0000u); }
    float gwr[16];
#pragma unroll
    for (int r = 0; r < 16; ++r) gwr[r] = gw[r * 256 + h * 64 + lane];
    const float gbv = gb[h * 64 + lane];
    __syncthreads();
    float la[8];
#pragma unroll
    for (int i = 0; i < 8; ++i) { const int c = w * 8 + i; float x = gbv;
#pragma unroll
        for (int r = 0; r < 16; ++r) x += rfl[c * 16 + r] * gwr[r];
        la[i] = (fminf(x, 0.f) - __logf(1.0f + __expf(-fabsf(x)))) * (1.0f / 16.0f); }
    if (dir == 0) {
#pragma unroll
        for (int i = 1; i < 8; ++i) la[i] += la[i - 1];
        tot[w * 64 + lane] = la[7];
    } else {
#pragma unroll
        for (int i = 6; i >= 0; --i) la[i] += la[i + 1];
        tot[w * 64 + lane] = la[0];
    }
    __syncthreads();
    float off = 0.f;
#pragma unroll
    for (int w2 = 0; w2 < 8; ++w2) { const float t = tot[w2 * 64 + lane]; off += ((dir == 0) ? (w2 < w) : (w2 > w)) ? t : 0.f; }
#pragma unroll
    for (int i = 0; i < 8; ++i) cum[(w * 8 + i) * 65 + lane] = la[i] + off;
    __syncthreads();
}
DI void gla_load_vt(LAS unsigned char* lds, const bf16* P, size_t row0, int h, int tid) {
    LAS unsigned short* vT = (LAS unsigned short*)(lds + L_VT);
    const int c = tid >> 3, dg = tid & 7;
    const bf16* vp = P + (row0 + c) * LDP0 + C_BV + h * 128 + dg * 16;
    const bf16x8 v0 = *(const bf16x8*)vp, v1 = *(const bf16x8*)(vp + 8);
#pragma unroll
    for (int e = 0; e < 8; ++e) { vT[(dg * 16 + e) * 72 + c] = (unsigned short)v0[e]; vT[(dg * 16 + 8 + e) * 72 + c] = (unsigned short)v1[e]; }
}
DI void gla_g1_unit(const Args& a, LAS unsigned char* lds, int unit, int tid, int lane, int wave) {
    const bf16* P = (const bf16*)(a.ws + WS_P);
    const int n = unit % NCHUNK, seq = unit / NCHUNK, dir = seq & 1, h = (seq >> 1) & 3, b = seq >> 3;
    const size_t row0 = chunk_row0(b, n);
    const bf16x8 kraw = *(const bf16x8*)(P + (row0 + (tid >> 3)) * LDP0 + C_BK + h * 64 + (tid & 7) * 8);
    gla_load_vt(lds, P, row0, h, tid);
    gla_cum(a, lds, P, row0, h, dir, tid);
    LAS float* cum = (LAS float*)(lds + L_CUM); LAS unsigned short* kdT = (LAS unsigned short*)(lds + L_A); LAS unsigned short* vT = (LAS unsigned short*)(lds + L_VT);
    const int cend = dir ? 0 : 63;
    { const int c = tid >> 3, dg = tid & 7; float kk[8]; unpack8(kraw, kk);
#pragma unroll
      for (int dd = 0; dd < 8; ++dd) { const int d = dg * 8 + dd; const float v = kk[dd] * __expf(cum[cend * 65 + d] - cum[c * 65 + d]); kdT[d * 72 + c] = (unsigned short)(pk2(v, 0.f) & 0xffffu); } }
    if (tid < 64) ((float*)(a.ws + WS_DEC))[(size_t)(seq * NCHUNK + n) * 64 + tid] = __expf(cum[cend * 65 + tid]);
    __syncthreads();
    const int fr = lane & 15, fq = lane >> 4;
    bf16x8 av[2];
#pragma unroll
    for (int ks = 0; ks < 2; ++ks) av[ks] = *(const LAS bf16x8*)(vT + (wave * 16 + fr) * 72 + ks * 32 + fq * 8);
    float* st = st_ptr(a, seq, n);
#pragma unroll
    for (int nt = 0; nt < 4; ++nt) { f32x4 acc = {0.f, 0.f, 0.f, 0.f};
#pragma unroll
        for (int ks = 0; ks < 2; ++ks) { const bf16x8 bk = *(const LAS bf16x8*)(kdT + (nt * 16 + fr) * 72 + ks * 32 + fq * 8); acc = MFMA16(av[ks], bk, acc); }
#pragma unroll
        for (int r = 0; r < 4; ++r) st[(wave * 16 + fq * 4 + r) * 64 + nt * 16 + fr] = acc[r]; }
    __syncthreads();
}
DI void gla_scan(const Args& a, int tid) {
    const float* DEC = (const float*)(a.ws + WS_DEC);
    for (int e = blockIdx.x * NTHR + tid; e < 32 * 8192; e += gridDim.x * NTHR) {
        const int seq = e >> 13, el = e & 8191, dk = el & 63, dir = seq & 1;
        float S = 0.f;
        for (int s4 = 0; s4 < NCHUNK; s4 += 4) {
            float* p[4]; float t[4], dc[4];
#pragma unroll
            for (int i = 0; i < 4; ++i) { const int step = s4 + i; const int n = dir == 0 ? (step < 4 ? 64 + step : step - 4) : (step < 4 ? 67 - step : 67 - step);
                p[i] = st_ptr(a, seq, n) + el; t[i] = *p[i]; dc[i] = DEC[(size_t)(seq * NCHUNK + n) * 64 + dk]; }
#pragma unroll
            for (int i = 0; i < 4; ++i) { *p[i] = S; S = dc[i] * S + t[i]; }
        }
    }
}
DI void gla_g3_unit(const Args& a, LAS unsigned char* lds, int unit, int tid, int lane, int wave) {
    const bf16* P = (const bf16*)(a.ws + WS_P); bf16* O = (bf16*)(a.ws + WS_HO);
    const int n = unit % NCHUNK, bh = unit / NCHUNK, h = bh & 3, b = bh >> 2;
    const size_t row0 = chunk_row0(b, n);
    LAS float* cum = (LAS float*)(lds + L_CUM); LAS unsigned short* qg = (LAS unsigned short*)(lds + L_A); LAS unsigned short* kg = (LAS unsigned short*)(lds + L_B);
    LAS unsigned short* att = (LAS unsigned short*)(lds + L_ATT); LAS unsigned short* vT = (LAS unsigned short*)(lds + L_VT); LAS float* ssq = (LAS float*)(lds + L_SSQ);
    const int fr = lane & 15, fq = lane >> 4, ct = wave & 3, dvh = wave >> 2;
    gla_load_vt(lds, P, row0, h, tid);
    f32x4 acc[4];
#pragma unroll
    for (int nt = 0; nt < 4; ++nt) acc[nt] = (f32x4){0.f, 0.f, 0.f, 0.f};
    const bf16x8 qraw = *(const bf16x8*)(P + (row0 + (tid >> 3)) * LDP0 + C_BQ + h * 64 + (tid & 7) * 8), kraw = *(const bf16x8*)(P + (row0 + (tid >> 3)) * LDP0 + C_BK + h * 64 + (tid & 7) * 8);
    for (int dir = 0; dir < 2; ++dir) {
        const float* st = st_ptr(a, (bh * 2 + dir), n);
        f32x4 sraw[4][2][2];
#pragma unroll
        for (int nt = 0; nt < 4; ++nt)
#pragma unroll
            for (int ks = 0; ks < 2; ++ks) { const float* sp = st + ((dvh * 4 + nt) * 16 + fr) * 64 + ks * 32 + fq * 8; sraw[nt][ks][0] = *(const f32x4*)sp; sraw[nt][ks][1] = *(const f32x4*)(sp + 4); }
        gla_cum(a, lds, P, row0, h, dir, tid);
        { const int c = tid >> 3, dg = tid & 7; float qq[8], kk[8], oq[8], ok[8];
          unpack8(qraw, qq); unpack8(kraw, kk);
#pragma unroll
          for (int dd = 0; dd < 8; ++dd) { const float cu = cum[c * 65 + dg * 8 + dd]; oq[dd] = qq[dd] * 0.125f * __expf(cu); ok[dd] = kk[dd] * __expf(-cu); }
          *(LAS bf16x8*)(qg + c * 72 + dg * 8) = pack8(oq); *(LAS bf16x8*)(kg + c * 72 + dg * 8) = pack8(ok); }
        __syncthreads();
        bf16x8 bq[2];
#pragma unroll
        for (int ks = 0; ks < 2; ++ks) bq[ks] = *(const LAS bf16x8*)(qg + (ct * 16 + fr) * 72 + ks * 32 + fq * 8);
#pragma unroll
        for (int si = 0; si < 2; ++si) { const int st = dvh * 2 + si; f32x4 s = {0.f, 0.f, 0.f, 0.f};
#pragma unroll
            for (int ks = 0; ks < 2; ++ks) { const bf16x8 ak = *(const LAS bf16x8*)(kg + (st * 16 + fr) * 72 + ks * 32 + fq * 8); s = MFMA16(ak, bq[ks], s); }
            const int cpos = ct * 16 + fr; float pv[4];
#pragma unroll
            for (int r = 0; r < 4; ++r) { const int spos = st * 16 + fq * 4 + r; const bool keep = dir == 0 ? (spos <= cpos) : (spos >= cpos); pv[r] = keep ? s[r] : 0.f; }
            u32x2 w; w.x = pk2(pv[0], pv[1]); w.y = pk2(pv[2], pv[3]);
            *(LAS u32x2*)(att + cpos * 72 + st * 16 + fq * 4) = w; }
        __syncthreads();
        bf16x8 ba[2];
#pragma unroll
        for (int ks = 0; ks < 2; ++ks) ba[ks] = *(const LAS bf16x8*)(att + (ct * 16 + fr) * 72 + ks * 32 + fq * 8);
#pragma unroll
        for (int nt = 0; nt < 4; ++nt) { const int dvt = dvh * 4 + nt;
#pragma unroll
            for (int ks = 0; ks < 2; ++ks) {
                const bf16x8 av = *(const LAS bf16x8*)(vT + (dvt * 16 + fr) * 72 + ks * 32 + fq * 8);
                acc[nt] = MFMA16(av, ba[ks], acc[nt]);
                const f32x4 s0 = sraw[nt][ks][0], s1 = sraw[nt][ks][1];
                const float sf[8] = {s0[0], s0[1], s0[2], s0[3], s1[0], s1[1], s1[2], s1[3]};
                acc[nt] = MFMA16(pack8(sf), bq[ks], acc[nt]); } }
        __syncthreads();
    }
    float sq = 0.f;
#pragma unroll
    for (int nt = 0; nt < 4; ++nt) sq += (acc[nt][0] * acc[nt][0] + acc[nt][1] * acc[nt][1]) + (acc[nt][2] * acc[nt][2] + acc[nt][3] * acc[nt][3]);
    sq += __shfl_xor(sq, 16); sq += __shfl_xor(sq, 32);
    if (fq == 0) ssq[wave * 16 + fr] = sq;
    __syncthreads();
    const float tot = ssq[wave * 16 + fr] + ssq[(wave ^ 4) * 16 + fr];
    const float rstd = __builtin_amdgcn_rsqf(tot * (1.0f / 128.0f) + EPS);
    const size_t row = row0 + ct * 16 + fr;
#pragma unroll
    for (int nt = 0; nt < 4; ++nt) { const int dv0 = (dvh * 4 + nt) * 16 + fq * 4;
        const f32x4 g4 = *(const f32x4*)(a.in[I_GNORM] + h * 128 + dv0);
        const u32x2 bw = *(const u32x2*)(P + row * LDP0 + C_BO + h * 128 + dv0);
        const float g0 = __uint_as_float(bw.x << 16), g1 = __uint_as_float(bw.x & 0xffff0000u), g2 = __uint_as_float(bw.y << 16), g3 = __uint_as_float(bw.y & 0xffff0000u);
        u32x2 w; w.x = pk2(acc[nt][0] * rstd * g4[0] * silu_f(g0), acc[nt][1] * rstd * g4[1] * silu_f(g1));
        w.y = pk2(acc[nt][2] * rstd * g4[2] * silu_f(g2), acc[nt][3] * rstd * g4[3] * silu_f(g3));
        *(u32x2*)(O + row * D + 512 + h * 128 + dv0) = w; }
    __syncthreads();
}

DI void rope_row(bf16* prow, int t, int lane) {
    const int prow_pos = t >> 6, pcol_pos = t & 63;
#pragma unroll
    for (int i = 0; i < 5; ++i) { const int pi = lane + 64 * i, head = pi >> 5, rem = pi & 31, half = rem >> 4, j = rem & 15;
        const int c1 = head * 64 + half * 32 + j, pos = half ? pcol_pos : prow_pos;
        const float cs = ROPE_COS[pos * 16 + j], sn = ROPE_SIN[pos * 16 + j];
        const float u1 = bf2f(prow[c1]), u2 = bf2f(prow[c1 + 16]);
        prow[c1] = (unsigned short)(pk2(u1 * cs - u2 * sn, 0.f) & 0xffffu); prow[c1 + 16] = (unsigned short)(pk2(u2 * cs + u1 * sn, 0.f) & 0xffffu); }
}

constexpr int NPHASE = 19;
#ifndef NA_NR
#define NA_NR 2
#endif
#ifndef PROBE_MASK
#define PROBE_MASK 0u
#endif
#define REPS(k) (((PROBE_MASK >> (k)) & 1u) ? 2 : 1)
__global__ void __launch_bounds__(NTHR, 2) fwd_kernel(Args a) {
    extern __shared__ __attribute__((aligned(16))) unsigned char lds_raw[];
    LAS unsigned char* lds = (LAS unsigned char*)lds_raw;
    const int tid = threadIdx.x, lane = tid & 63, wave = __builtin_amdgcn_readfirstlane(tid >> 6);
    const int G = gridDim.x, gw = blockIdx.x * NWAVES + wave, NGW = G * NWAVES;
    unsigned char* ws = a.ws;
    const int lo = a.ph_lo, hi = a.ph_hi;
#define IN(k) (lo <= (k) && (k) < hi)
#ifndef PROBE_SYNC
#define PROBE_SYNC 1
#endif
    volatile LAS unsigned* MISC = (volatile LAS unsigned*)(lds + 131072 + 320);
    if (tid < 32) MISC[tid] = 0u;
    __syncthreads();
    unsigned* barw = (unsigned*)(ws + WS_CTL);
    XcdBarrier xbar; xbar.bar = barw; xbar.x = 0; xbar.st = MISC + 8;
    if (hi - lo > 1) {
        if (blockIdx.x == 0) { for (int i = tid; i < XCD_BAR_WORDS; i += NTHR) barw[i] = 0u; }
        cg::this_grid().sync();
        xbar = xcd_barrier_post(barw, MISC + 8);
    }
#define SEAM(k) do { if (IN(k) && IN((k) + 1)) { for (int sr_ = 0; sr_ < PROBE_SYNC; ++sr_) xcd_barrier(xbar); } } while (0)
    bf16* H = (bf16*)(ws + WS_HO); bf16* YF = (bf16*)(ws + WS_YF); bf16* P = (bf16*)(ws + WS_P);

    if (IN(0)) { for (int rep = 0; rep < REPS(0); ++rep) { phase_prologue(a, lds, tid, lane, wave); __syncthreads(); } } SEAM(0);
    if (IN(1)) { for (int rep = 0; rep < REPS(1); ++rep) phase_rows(a, 0, 0, lane, wave); } SEAM(1);
    if (IN(2)) { pg8::Gemm g{H, (const bf16*)(ws + WS_WABI), MT, LDP0, D, D}; pg8::StaticOrder S; S.init(MT, LDP0, G, (int)blockIdx.x);
        EpiStore E{P, LDP0}; pg8::gemm_phase<EpiStore, pg8::StaticOrder, true, true>(lds, g, S, E); if (REPS(2) > 1) { pg8::gemm_phase<EpiStore, pg8::StaticOrder, true, true>(lds, g, S, E); } } SEAM(2);
    if (IN(3)) {
        for (int rep = 0; rep < REPS(3); ++rep) for (int u = blockIdx.x; u < 32 * NCHUNK; u += G) gla_g1_unit(a, lds, u, tid, lane, wave);
        __syncthreads();
        for (int m = gw; m < NLAT; m += NGW) rope_row(P + (size_t)m * LDP0, m & 4095, lane);
        for (int u = gw; u < NBATCH * 2 * 68; u += NGW) vt_unit(P, LDP0, C_AV, 2, YF, u, lds + wave * 16384, lane);
    } SEAM(3);
    if (IN(4)) {
        for (int rep = 0; rep < REPS(4); ++rep) for (int wt = gw; wt < 2176; wt += NGW) window_attn_tile(a, wt, lane);
        gla_scan(a, tid);
    } SEAM(4);
    if (IN(5)) { for (int rep = 0; rep < REPS(5); ++rep) for (int u = blockIdx.x; u < 16 * NCHUNK; u += G) gla_g3_unit(a, lds, u, tid, lane, wave); } SEAM(5);
    if (IN(6)) { pg8::Gemm g{H, (const bf16*)(ws + WS_WABO), NLAT, D, D, D}; pg8::StaticOrder S; S.init(NLAT, D, G, (int)blockIdx.x);
        EpiStore E{YF, D}; pg8::gemm_phase<EpiStore, pg8::StaticOrder, true, true>(lds, g, S, E); if (REPS(6) > 1) { pg8::gemm_phase<EpiStore, pg8::StaticOrder, true, true>(lds, g, S, E); }
        { const int bx = (int)blockIdx.x, kc = bx >> 4, uu = bx & 15; OneUnit S1{uu >> 2, uu & 3, bx < 64};
          pg8::Gemm g1{H + (size_t)NLAT * D + kc * 256, (const bf16*)(ws + WS_WABO) + kc * 256, NCTX, D, D, 256};
          EpiStore E1{(bf16*)(ws + WS_PART) + (size_t)kc * NCTX * D, D}; pg8::gemm_phase<EpiStore, OneUnit, true, true>(lds, g1, S1, E1); } } SEAM(6);
    if (IN(7)) { for (int rep = 0; rep < REPS(7); ++rep) phase_rows(a, 1, 0, lane, wave); } SEAM(7);
    if (IN(8)) { pg8::Gemm g{H, (const bf16*)(ws + WS_WFI), MT, 2 * FF, D, D}; pg8::StaticOrder S; S.init(MT, 2 * FF, G, (int)blockIdx.x);
        EpiSwiglu E{P, FF}; pg8::gemm_phase<EpiSwiglu, pg8::StaticOrder, true, true>(lds, g, S, E); if (REPS(8) > 1) { pg8::gemm_phase<EpiSwiglu, pg8::StaticOrder, true, true>(lds, g, S, E); } } SEAM(8);
    if (IN(9)) { pg8::Gemm g{P, (const bf16*)(ws + WS_WFO), NLAT, D, FF, FF}; pg8::StaticOrder S; S.init(NLAT, D, G, (int)blockIdx.x);
        EpiStore E{YF, D}; pg8::gemm_phase<EpiStore, pg8::StaticOrder, true, true>(lds, g, S, E); if (REPS(9) > 1) { pg8::gemm_phase<EpiStore, pg8::StaticOrder, true, true>(lds, g, S, E); }
        { const int bx = (int)blockIdx.x, kc = bx >> 4, uu = bx & 15; OneUnit S1{uu >> 2, uu & 3, bx < 176};
          pg8::Gemm g1{P + (size_t)NLAT * FF + kc * 256, (const bf16*)(ws + WS_WFO) + kc * 256, NCTX, D, FF, 256};
          EpiStore E1{(bf16*)(ws + WS_PART) + (size_t)kc * NCTX * D, D}; pg8::gemm_phase<EpiStore, OneUnit, true, true>(lds, g1, S1, E1); } } SEAM(9);
    if (IN(10)) { phase_rows(a, 2, 0, lane, wave); } SEAM(10);
    if (IN(11)) { pg8::Gemm g{H, (const bf16*)(ws + WS_WNI), MT, LDP1, D, D}; pg8::StaticOrder S; S.init(MT, LDP1, G, (int)blockIdx.x);
        EpiStore E{P, LDP1}; pg8::gemm_phase<EpiStore, pg8::StaticOrder, true, true>(lds, g, S, E); if (REPS(11) > 1) { pg8::gemm_phase<EpiStore, pg8::StaticOrder, true, true>(lds, g, S, E); } } SEAM(11);
    if (IN(12)) { for (int rep = 0; rep < REPS(12); ++rep) for (int u = gw; u < NBATCH * 16 * 68; u += NGW) vt_unit(P, LDP1, 2048, 16, YF, u, lds + wave * 16384, lane); } SEAM(12);
    if (IN(13)) { for (int rep = 0; rep < REPS(13); ++rep) for (int gid = gw; gid < 16384 / NA_NR; gid += NGW) na_attn_group<NA_NR>(a, gid, lane, (LAS float*)(lds + wave * 16384)); } SEAM(13);
    if (IN(14)) { pg8::Gemm g{H, (const bf16*)(ws + WS_WNO), NLAT, D, D, D}; pg8::StaticOrder S; S.init(NLAT, D, G, (int)blockIdx.x);
        EpiStore E{YF, D}; pg8::gemm_phase<EpiStore, pg8::StaticOrder, true, true>(lds, g, S, E); if (REPS(14) > 1) { pg8::gemm_phase<EpiStore, pg8::StaticOrder, true, true>(lds, g, S, E); } } SEAM(14);
    if (IN(15)) { phase_rows(a, 1, 1, lane, wave); } SEAM(15);
    if (IN(16)) { pg8::Gemm g{H, (const bf16*)(ws + WS_WFI) + (size_t)5632 * 1024, NLAT, 2 * FF, D, D}; pg8::StaticOrder S; S.init(NLAT, 2 * FF, G, (int)blockIdx.x);
        EpiSwiglu E{P, FF}; pg8::gemm_phase<EpiSwiglu, pg8::StaticOrder, true, true>(lds, g, S, E); if (REPS(16) > 1) { pg8::gemm_phase<EpiSwiglu, pg8::StaticOrder, true, true>(lds, g, S, E); } } SEAM(16);
    if (IN(17)) { pg8::Gemm g{P, (const bf16*)(ws + WS_WFO) + (size_t)1024 * FF, NLAT, D, FF, FF}; pg8::StaticOrder S; S.init(NLAT, D, G, (int)blockIdx.x);
        EpiStore E{YF, D}; pg8::gemm_phase<EpiStore, pg8::StaticOrder, true, true>(lds, g, S, E); if (REPS(17) > 1) { pg8::gemm_phase<EpiStore, pg8::StaticOrder, true, true>(lds, g, S, E); } } SEAM(17);
    if (IN(18)) { phase_rows(a, 2, 1, lane, wave); }
#undef IN
#undef SEAM
}

extern "C" void kernel_launch(void* const* d_in, const int* in_sizes, int n_in, void* d_out, int out_size, void* d_ws, size_t ws_size, hipStream_t stream) {
    static int grid = 0;
    if (grid == 0) {
        if (n_in != 23 || out_size != NLAT * D || ws_size < WS_END) { fprintf(stderr, "kernel_launch: unexpected problem shape (n_in %d, out %d, ws %zu)\n", n_in, out_size, ws_size); grid = -1; return; }
        int dev = 0, cus = 0, per_cu = 0;
        (void)hipGetDevice(&dev); (void)hipDeviceGetAttribute(&cus, hipDeviceAttributeMultiprocessorCount, dev);
        if (hipFuncSetAttribute((const void*)fwd_kernel, hipFuncAttributeMaxDynamicSharedMemorySize, LDS_BYTES) != hipSuccess) { fprintf(stderr, "kernel_launch: hipFuncSetAttribute failed\n"); grid = -1; return; }
        (void)hipOccupancyMaxActiveBlocksPerMultiprocessor(&per_cu, (const void*)fwd_kernel, NTHR, LDS_BYTES);
        if (per_cu < 1) per_cu = 1;
        (void)hipGetLastError();
        grid = cus * per_cu;
    }
    if (grid < 0) return;
    Args a{};
    for (int i = 0; i < 23; ++i) a.in[i] = (const float*)d_in[i];
    a.out = (float*)d_out; a.ws = (unsigned char*)d_ws;
#if COOP
    a.ph_lo = 0; a.ph_hi = NPHASE;
    void* args[] = {&a};
    hipError_t e = hipLaunchCooperativeKernel((const void*)fwd_kernel, dim3(grid), dim3(NTHR), args, LDS_BYTES, stream);
    if (e != hipSuccess) fprintf(stderr, "cooperative launch failed: %s (grid %d)\n", hipGetErrorString(e), grid);
#else
    for (int p = 0; p < NPHASE; ++p) { a.ph_lo = p; a.ph_hi = p + 1; hipLaunchKernelGGL(fwd_kernel, dim3(grid), dim3(NTHR), LDS_BYTES, stream, a); }
#endif
}
```

```cpp
#include <hip/hip_runtime.h>
#include <hip/hip_cooperative_groups.h>
#include <cstdio>
#include <cstdint>
namespace cg = cooperative_groups;
namespace pg8 {
#define PG8_LAS __attribute__((address_space(3)))
typedef unsigned short bf16_t;
typedef short bf16x8 __attribute__((ext_vector_type(8)));
typedef float f32x4 __attribute__((ext_vector_type(4)));
typedef unsigned u32x4 __attribute__((ext_vector_type(4)));
constexpr int BM = 256, BK = 64, HALF = 128, HTB = HALF * BK * 2  , STAGE_BYTES = 8 * HTB, NXCD = 8, WGM = 8;

__host__ __device__ __forceinline__ int lds_byte(int r, int c) { const int st = (r >> 4) * 2 + (c >> 5), rr = r & 15, cc = c & 31, ob = rr * 64 + cc * 2; return st * 1024 + (ob ^ (((ob >> 9) & 1) << 5)); }
__host__ __device__ __forceinline__ void stage_rc(int b, int& R, int& C) { const int st = b / 1024, sb = b % 1024, swz = sb ^ (((sb >> 9) & 1) << 5); R = (st >> 1) * 16 + swz / 64; C = (st & 1) * 32 + (swz % 64) / 2; }
__host__ __device__ __forceinline__ int perm32(int rho) { const int n = rho >> 4, i = rho & 15; return 8 * (i >> 2) + 4 * n + (i & 3); }

struct Unit { int pm, pn; };
struct Gemm { const bf16_t* A; const bf16_t* Bt; int M, N, K, Kext; };

struct StaticOrder {
    int nM, nN, nwg, G, c;
    __host__ __device__ void init(int M, int N, int G_, int c_) { nM = M / BM; nN = N / BM; nwg = nM * nN; G = G_; c = c_; }
    __host__ __device__ bool next(int i, Unit& u) const {
        const long L = (long)i * G + c; if (L >= nwg) return false;
        int wgid = (int)L; { const int q = nwg / NXCD, r = nwg % NXCD, xcd = wgid % NXCD, off = wgid / NXCD; wgid = (xcd < r ? xcd * (q + 1) : r * (q + 1) + (xcd - r) * q) + off; }
        const int nig = WGM * nN, gid = wgid / nig, fm = gid * WGM, gsz = (nM - fm) < WGM ? (nM - fm) : WGM;
        u.pm = fm + ((wgid % nig) % gsz); u.pn = (wgid % nig) / gsz; return true;
    }
    __device__ __forceinline__ void a_ready(const Unit&) const {}
    __device__ __forceinline__ void done(const Unit&) const {}
};

__device__ __forceinline__ unsigned cvt_pk_bf16(float lo, float hi) { unsigned r; asm volatile("v_cvt_pk_bf16_f32 %0, %1, %2" : "=v"(r) : "v"(lo), "v"(hi)); return r; }
template <class Epi, class Sched, bool ALIGN_EPI = false, bool SP2 = false>
__device__ __forceinline__ void gemm_phase(PG8_LAS unsigned char* lds, const Gemm g, const Sched& S, const Epi& E) {
    const int tid = threadIdx.x, wid = __builtin_amdgcn_readfirstlane(tid >> 6), lane = tid & 63, wr = wid >> 2, wc = wid & 3, fr = lane & 15, fq = lane >> 4;
    const int K = g.K, nt = g.Kext / BK;
    unsigned voffA[2], voffB[2];
#pragma unroll
    for (int i = 0; i < 2; ++i) { int R, C; stage_rc(tid * 16 + i * 8192, R, C); const int Rb = Epi::PERM ? ((R & ~31) + perm32(R & 31)) : R;
        voffA[i] = (unsigned)(R * K + C) * 2u; voffB[i] = (unsigned)(Rb * K + C) * 2u; }
    const size_t kstep = (size_t)(BK * 2);
    const size_t hstep = (size_t)HALF * K * 2;
    const size_t tstep = 2 * hstep;
    const unsigned ldsw = (unsigned)wid * 1024u;
    const int aoff = lds_byte(wr * 64 + fr, fq * 8), boff = lds_byte(wc * 32 + fr, fq * 8);
#define PG8_SA(b, h) (((b) * 2 + (h)) * HTB)
#define PG8_SB(b, h) ((4 + (b) * 2 + (h)) * HTB)
#define PG8_STAGE(bufoff, gbase, voff) do { _Pragma("unroll") for (int _i = 0; _i < 2; ++_i) \
        __builtin_amdgcn_global_load_lds((const unsigned*)((const char*)(gbase) + (voff)[_i]), (PG8_LAS unsigned*)(lds + (bufoff) + ldsw + _i * 8192), 16, 0, 0); } while (0)
#define PG8_LDA(dst, b, h) do { _Pragma("unroll") for (int m = 0; m < 4; ++m) _Pragma("unroll") for (int k = 0; k < 2; ++k) dst[m][k] = *(const PG8_LAS bf16x8*)(lds + PG8_SA(b, h) + aoff + m * 2048 + k * 1024); } while (0)
#define PG8_LDB(dst, b, h) do { _Pragma("unroll") for (int n = 0; n < 2; ++n) _Pragma("unroll") for (int k = 0; k < 2; ++k) dst[n][k] = *(const PG8_LAS bf16x8*)(lds + PG8_SB(b, h) + boff + n * 2048 + k * 1024); } while (0)
#define PG8_MMA(ai, bj, At, Bt) do { __builtin_amdgcn_s_setprio(1); _Pragma("unroll") for (int m = 0; m < 4; ++m) _Pragma("unroll") for (int n = 0; n < 2; ++n) _Pragma("unroll") for (int k = 0; k < 2; ++k) \
        acc[ai][bj][m][n] = __builtin_amdgcn_mfma_f32_16x16x32_bf16(Bt[n][k], At[m][k], acc[ai][bj][m][n], 0, 0, 0); __builtin_amdgcn_s_setprio(0); } while (0)
#define PG8_WAIT_V(n) asm volatile("s_waitcnt vmcnt(" #n ")" ::: "memory")
#define PG8_WAIT_L(n) asm volatile("s_waitcnt lgkmcnt(" #n ")" ::: "memory")
#define PG8_BAR __builtin_amdgcn_s_barrier()
#define PG8_SCHED __builtin_amdgcn_sched_barrier(0)
    Unit cur, nxt; int ui = 0;
    if (!S.next(0, cur)) return;
    f32x4 acc[2][2][4][2];
#pragma unroll
    for (int a = 0; a < 2; ++a)
#pragma unroll
        for (int b = 0; b < 2; ++b)
#pragma unroll
            for (int m = 0; m < 4; ++m)
#pragma unroll
                for (int n = 0; n < 2; ++n) acc[a][b][m][n] = (f32x4){0.f, 0.f, 0.f, 0.f};
    bf16x8 At[4][2], B0[2][2], B1[2][2];
    const char* cA = (const char*)g.A + (size_t)cur.pm * tstep; const char* cB = (const char*)g.Bt + (size_t)cur.pn * tstep;
    S.a_ready(cur);
    if constexpr (SP2) {
        PG8_STAGE(PG8_SB(0, 0), cB, voffB); PG8_STAGE(PG8_SB(0, 1), cB + hstep, voffB); PG8_STAGE(PG8_SA(0, 0), cA, voffA); PG8_STAGE(PG8_SA(0, 1), cA + hstep, voffA);
        if (wr == 1) PG8_BAR;
        PG8_WAIT_V(2); PG8_BAR;
        PG8_STAGE(PG8_SB(1, 0), cB + kstep, voffB); PG8_STAGE(PG8_SA(1, 0), cA + kstep, voffA); PG8_STAGE(PG8_SB(1, 1), cB + hstep + kstep, voffB);
        PG8_WAIT_V(6); PG8_BAR;
    } else {
        PG8_STAGE(PG8_SB(0, 0), cB, voffB); PG8_STAGE(PG8_SA(0, 0), cA, voffA); PG8_STAGE(PG8_SB(0, 1), cB + hstep, voffB); PG8_STAGE(PG8_SA(0, 1), cA + hstep, voffA);
        if (wr == 1) PG8_BAR;
        PG8_WAIT_V(4); PG8_BAR;
        PG8_STAGE(PG8_SB(1, 0), cB + kstep, voffB); PG8_STAGE(PG8_SA(1, 0), cA + kstep, voffA); PG8_STAGE(PG8_SB(1, 1), cB + hstep + kstep, voffB);
        PG8_WAIT_V(6); PG8_BAR;
    }
    for (;;) {
        const bool has_next = S.next(ui + 1, nxt);
        const char* nA = has_next ? (const char*)g.A + (size_t)nxt.pm * tstep : cA; const char* nB = has_next ? (const char*)g.Bt + (size_t)nxt.pn * tstep : cB;
        for (int t = 0; t < nt; t += 2) {
            const bool last = (t == nt - 2);
            const char* a1 = cA + (size_t)(t + 1) * kstep;
            const char* a2 = last ? nA : cA + (size_t)(t + 2) * kstep; const char* b2 = last ? nB : cB + (size_t)(t + 2) * kstep;
            const char* a3 = a2 + kstep; const char* b3 = b2 + kstep;
            if (last && has_next) S.a_ready(nxt);
            if constexpr (SP2) {
            PG8_LDB(B0, 0, 0); PG8_LDB(B1, 0, 1); PG8_SCHED; PG8_LDA(At, 0, 0); PG8_STAGE(PG8_SA(1, 1), a1 + hstep, voffA);
            PG8_WAIT_V(8); PG8_WAIT_L(0); PG8_BAR; PG8_MMA(0, 0, At, B0); PG8_MMA(0, 1, At, B1); PG8_BAR; PG8_SCHED;
            PG8_LDA(At, 0, 1); PG8_STAGE(PG8_SB(0, 0), b2, voffB); PG8_STAGE(PG8_SB(0, 1), b2 + hstep, voffB); PG8_STAGE(PG8_SA(0, 0), a2, voffA);
            PG8_WAIT_V(8); PG8_WAIT_L(0); PG8_BAR; PG8_MMA(1, 0, At, B0); PG8_MMA(1, 1, At, B1); PG8_BAR; PG8_SCHED;
            PG8_LDB(B0, 1, 0); PG8_LDB(B1, 1, 1); PG8_SCHED; PG8_LDA(At, 1, 0); PG8_STAGE(PG8_SA(0, 1), a2 + hstep, voffA);
            PG8_WAIT_V(8); PG8_WAIT_L(0); PG8_BAR; PG8_MMA(0, 0, At, B0); PG8_MMA(0, 1, At, B1); PG8_BAR; PG8_SCHED;
            PG8_LDA(At, 1, 1); PG8_STAGE(PG8_SB(1, 0), b3, voffB); PG8_STAGE(PG8_SB(1, 1), b3 + hstep, voffB); PG8_STAGE(PG8_SA(1, 0), a3, voffA);
            PG8_WAIT_V(8); PG8_WAIT_L(0); PG8_BAR; PG8_MMA(1, 0, At, B0); PG8_MMA(1, 1, At, B1); PG8_BAR; PG8_SCHED;
            } else {
            PG8_LDB(B0, 0, 0); PG8_SCHED; PG8_LDA(At, 0, 0); PG8_STAGE(PG8_SA(1, 1), a1 + hstep, voffA);
            PG8_WAIT_L(8); PG8_BAR; PG8_WAIT_L(0); PG8_MMA(0, 0, At, B0); PG8_BAR; PG8_SCHED;
            PG8_LDB(B1, 0, 1); PG8_STAGE(PG8_SB(0, 0), b2, voffB);
            PG8_BAR; PG8_WAIT_L(0); PG8_MMA(0, 1, At, B1); PG8_BAR;
            PG8_LDA(At, 0, 1); PG8_STAGE(PG8_SA(0, 0), a2, voffA);
            PG8_BAR; PG8_WAIT_L(0); PG8_MMA(1, 0, At, B0); PG8_BAR; PG8_SCHED;
            PG8_STAGE(PG8_SB(0, 1), b2 + hstep, voffB);
            PG8_WAIT_V(6); PG8_BAR; PG8_MMA(1, 1, At, B1); PG8_BAR;
            PG8_LDB(B0, 1, 0); PG8_SCHED; PG8_LDA(At, 1, 0); PG8_STAGE(PG8_SA(0, 1), a2 + hstep, voffA);
            PG8_WAIT_L(8); PG8_BAR; PG8_WAIT_L(0); PG8_MMA(0, 0, At, B0); PG8_BAR; PG8_SCHED;
            PG8_LDB(B1, 1, 1); PG8_STAGE(PG8_SB(1, 0), b3, voffB);
            PG8_BAR; PG8_WAIT_L(0); PG8_MMA(0, 1, At, B1); PG8_BAR;
            PG8_LDA(At, 1, 1); PG8_STAGE(PG8_SA(1, 0), a3, voffA);
            PG8_BAR; PG8_WAIT_L(0); PG8_MMA(1, 0, At, B0); PG8_BAR; PG8_SCHED;
            PG8_STAGE(PG8_SB(1, 1), b3 + hstep, voffB);
            PG8_WAIT_V(6); PG8_BAR; PG8_MMA(1, 1, At, B1); PG8_BAR;
            }
        }
        if constexpr (ALIGN_EPI) { if (wr == 0) PG8_BAR; }
        if constexpr (!Epi::AFTER_DRAIN) { E(acc, cur, wr, wc, fr, fq); S.done(cur); }
        if (!has_next) break;
#pragma unroll
        for (int a = 0; a < 2; ++a)
#pragma unroll
            for (int b = 0; b < 2; ++b)
#pragma unroll
                for (int m = 0; m < 4; ++m)
#pragma unroll
                    for (int n = 0; n < 2; ++n) acc[a][b][m][n] = (f32x4){0.f, 0.f, 0.f, 0.f};
        cur = nxt; cA = nA; cB = nB; ++ui;
        if constexpr (ALIGN_EPI) { if (wr == 1) PG8_BAR; }
    }
    PG8_WAIT_V(0);
    if constexpr (!ALIGN_EPI) { if (wr == 0) PG8_BAR; }
    PG8_BAR;
    if constexpr (Epi::AFTER_DRAIN) { E.fused(acc, cur, wr, wc, fr, fq, lds, wid, lane); S.done(cur); }
#undef PG8_SA
#undef PG8_SB
#undef PG8_STAGE
#undef PG8_LDA
#undef PG8_LDB
#undef PG8_MMA
#undef PG8_WAIT_V
#undef PG8_WAIT_L
#undef PG8_BAR
#undef PG8_SCHED
}
}
__device__ const float ROPE_COS[1024] = {1.f,1.f,1.f,1.f,1.f,1.f,1.f,1.f,1.f,1.f,1.f,1.f,1.f,1.f,1.f,1.f,0.540302277f,0.846009135f,0.950415254f,0.98423022f,0.995004177f,0.998419285f,0.999500036f,0.999841869f,0.999949992f,0.999984205f,0.999994993f,0.999998391f,0.999999523f,0.999999821f,0.99999994f,1.f,-0.416146845f,0.431462824f,0.806578398f,0.937418282f,0.980066597f,0.993682086f,0.998000681f,0.999367595f,0.999800026f,0.999936759f,0.999979973f,0.999993682f,0.999997973f,0.999999344f,0.999999821f,0.99999994f,-0.989992499f,-0.115966164f,0.582753658f,0.861040652f,0.955336511f,0.985803485f,0.995503366f,0.998577297f,0.999550045f,0.999857724f,0.999954998f,0.999985754f,0.99999553f,0.999998569f,0.999999523f,0.999999881f,-0.653643608f,-0.627679706f,0.301137477f,0.757506192f,0.921060979f,0.974808276f,0.992010653f,0.997471273f,0.999200106f,0.999747038f,0.999920011f,0.999974728f,0.999992013f,0.999997497f,0.999999225f,0.999999762f,0.2836622f,-0.946079254f,-0.0103423381f,0.630080283f,0.87758255f,0.960731268f,0.987526f,0.996049762f,0.998750269f,0.999604762f,0.999875009f,0.999960482f,0.999987483f,0.999996066f,0.999998748f,0.999999583f,0.960170269f,-0.973103702f,-0.3207964f,0.482782036f,0.825335622f,0.943616986f,0.982053936f,0.9943133f,0.998200536f,0.999430835f,0.999819994f,0.999943078f,0.999981999f,0.999994338f,0.999998212f,0.999999404f,0.753902256f,-0.700429797f,-0.599437475f,0.320257008f,0.764842212f,0.923519433f,0.975599885f,0.992262423f,0.997551024f,0.999225318f,0.999755025f,0.999922514f,0.999975502f,0.999992251f,0.999997556f,0.999999225f,-0.145500034f,-0.212036446f,-0.818632424f,0.147631213f,0.696706712f,0.900502324f,0.968170285f,0.989897788f,0.996801734f,0.998988271f,0.999680042f,0.999898791f,0.999967992f,0.999989867f,0.999996781f,0.999998987f,-0.91113025f,0.341660261f,-0.956644177f,-0.0296507962f,0.621609926f,0.874638259f,0.959772646f,0.987220109f,0.995952725f,0.998719573f,0.999595046f,0.99987191f,0.999959528f,0.999987185f,0.999995947f,0.999998748f,-0.839071512f,0.790131867f,-0.999786079f,-0.205997631f,0.540302277f,0.846009135f,0.950415313f,0.98423022f,0.995004177f,0.998419285f,0.999500036f,0.999841869f,0.999949992f,0.999984205f,0.999994993f,0.999998391f,0.00442569796f,0.995257378f,-0.943779767f,-0.375847399f,0.453596085f,0.814705312f,0.940107584f,0.980929136f,0.993956089f,0.998087406f,0.999395072f,0.999808669f,0.999939501f,0.999980867f,0.99999392f,0.999998093f,0.843853951f,0.893861592f,-0.79417938f,-0.53384304f,0.362357706f,0.780825913f,0.92885989f,0.97731787f,0.99280864f,0.997723997f,0.999280095f,0.99977231f,0.999927998f,0.999977231f,0.999992788f,0.999997735f,0.907446802f,0.517172873f,-0.565820515f,-0.675001681f,0.267498761f,0.744477987f,0.916683376f,0.973397553f,0.99156189f,0.997329056f,0.999155104f,0.999732792f,0.999915481f,0.999973297f,0.999991536f,0.999997318f,0.136737213f,-0.0187961515f,-0.28134948f,-0.794870913f,0.16996716f,0.705776393f,0.903590262f,0.969169438f,0.990216017f,0.996902585f,0.999020159f,0.999690115f,0.99990201f,0.999969006f,0.999990225f,0.999996901f,-0.759687901f,-0.548975468f,0.0310223512f,-0.889670432f,0.070737198f,0.6648435f,0.889593601f,0.964634836f,0.988771081f,0.996444523f,0.998875201f,0.999644279f,0.999887526f,0.999964416f,0.999988735f,0.999996424f,-0.957659483f,-0.910081089f,0.340318173f,-0.95641005f,-0.0291995462f,0.621808827f,0.87470746f,0.959795177f,0.987227261f,0.99595499f,0.998720288f,0.999595284f,0.999872029f,0.999959528f,0.999987185f,0.999995947f,-0.275163352f,-0.990897954f,0.615864813f,-0.99298501f,-0.128844544f,0.576808274f,0.858946681f,0.954652011f,0.985584795f,0.995433986f,0.998555362f,0.999543071f,0.999855518f,0.999954283f,0.999985576f,0.99999541f,0.660316706f,-0.766536534f,0.830336154f,-0.998241663f,-0.227202162f,0.529984176f,0.842327058f,0.949207008f,0.983843684f,0.994881511f,0.998380423f,0.999487758f,0.999837995f,0.9999488f,0.999983788f,0.999994874f,0.988704622f,-0.306095392f,0.962463796f,-0.972014248f,-0.323289543f,0.481484592f,0.824865162f,0.943461835f,0.982004225f,0.994297504f,0.998195529f,0.999429286f,0.999819517f,0.999942899f,0.99998194f,0.999994278f,0.408082068f,0.248616725f,0.999144375f,-0.91512996f,-0.416146845f,0.431462824f,0.806578457f,0.937418282f,0.980066597f,0.993682086f,0.998000681f,0.999367595f,0.999800026f,0.999936759f,0.999979973f,0.999993682f,-0.547729254f,0.726760268f,0.936740458f,-0.829382956f,-0.504846215f,0.380077004f,0.787485182f,0.931078374f,0.97803092f,0.993035257f,0.99779582f,0.999302804f,0.999779522f,0.999930263f,0.999977946f,0.999993026f,-0.99996084f,0.981074572f,0.781440377f,-0.717477441f,-0.588501155f,0.327489585f,0.767604589f,0.92444396f,0.975897431f,0.992357016f,0.997581005f,0.999234855f,0.999758005f,0.999923468f,0.999975801f,0.999992371f,-0.53283304f,0.933235765f,0.548645258f,-0.582943261f,-0.666275978f,0.273866832f,0.746956408f,0.917517304f,0.97366637f,0.991647422f,0.997356176f,0.999163687f,0.999735534f,0.999916375f,0.999973536f,0.999991655f,0.424179018f,0.597977161f,0.261441678f,-0.430023283f,-0.737393796f,0.219378278f,0.725561321f,0.910300434f,0.971337974f,0.990906477f,0.997121394f,0.99908942f,0.99971199f,0.999908924f,0.999971211f,0.99999088f,0.991202831f,0.078552261f,-0.0516893305f,-0.263540596f,-0.801143587f,0.164196163f,0.703440726f,0.902795732f,0.968912423f,0.99013412f,0.996876657f,0.999011934f,0.999687493f,0.999901175f,0.999968767f,0.999990106f,0.64691931f,-0.465064496f,-0.359694332f,-0.0887455046f,-0.856888831f,0.108494945f,0.680616796f,0.895005584f,0.966389954f,0.98933053f,0.996621907f,0.998931348f,0.999662042f,0.999893129f,0.999966204f,0.999989331f,-0.292138815f,-0.865450621f,-0.632028639f,0.088848114f,-0.904072165f,0.0524506159f,0.6571123f,0.886932373f,0.963770926f,0.988495648f,0.996357203f,0.998847544f,0.999635518f,0.999884725f,0.999963522f,0.999988496f,-0.962605894f,-0.999293387f,-0.841684937f,0.26363951f,-0.942222297f,-0.00375941908f,0.632950664f,0.878578722f,0.961055458f,0.987629473f,0.996082544f,0.998760641f,0.99960804f,0.999876022f,0.99996078f,0.999987602f,-0.748057544f,-0.825371623f,-0.967871487f,0.430115849f,-0.970958173f,-0.0599575676f,0.608156204f,0.869947195f,0.958243906f,0.986732066f,0.995797932f,0.998670578f,0.999579549f,0.999867022f,0.999957979f,0.999986708f,0.154251456f,-0.397251874f,-0.998075247f,0.583026946f,-0.989992499f,-0.115966164f,0.582753658f,0.861040652f,0.955336511f,0.985803485f,0.995503366f,0.998577297f,0.999550045f,0.999857724f,0.999954998f,0.999985754f,0.914742351f,0.153215483f,-0.929300308f,0.717549205f,-0.999135137f,-0.171608135f,0.556768358f,0.851861775f,0.95233357f,0.984843671f,0.995198846f,0.998480916f,0.999519527f,0.999848068f,0.999951959f,0.999984801f,0.83422339f,0.656495154f,-0.768367112f,0.829440355f,-0.998294771f,-0.226707578f,0.53022635f,0.842413545f,0.949235439f,0.983852804f,0.994884372f,0.998381376f,0.999488056f,0.999838114f,0.9999488f,0.999983788f,-0.0132767474f,0.95758605f,-0.531235278f,0.915171385f,-0.987479806f,-0.281090319f,0.503154159f,0.832698941f,0.946042359f,0.982830763f,0.994559944f,0.998278618f,0.999455571f,0.999827802f,0.999945521f,0.999982774f,-0.848570287f,0.963757515f,-0.241421118f,0.972038329f,-0.966798186f,-0.334584385f,0.475578904f,0.822721004f,0.942754686f,0.981777668f,0.994225562f,0.99817276f,0.999422073f,0.999817252f,0.999942183f,0.999981701f,-0.903692186f,0.673110247f,0.0723346695f,0.998247743f,-0.93645668f,-0.387020677f,0.447528064f,0.812482953f,0.939372718f,0.980693519f,0.993881226f,0.998063743f,0.999387562f,0.999806345f,0.999938726f,0.999980628f,-0.127963692f,0.175156534f,0.378916174f,0.992972851f,-0.896758378f,-0.438233554f,0.419029742f,0.801987886f,0.935896814f,0.979578316f,0.993526995f,0.997951567f,0.999352098f,0.999795079f,0.99993521f,0.999979496f,0.765414059f,-0.376742303f,0.647921681f,0.95638001f,-0.848100007f,-0.488060862f,0.39011243f,0.791239262f,0.93232733f,0.978432178f,0.993162811f,0.997836173f,0.99931556f,0.999783576f,0.999931574f,0.999978364f,0.955073655f,-0.812611222f,0.852673113f,0.889623463f,-0.790967762f,-0.536345184f,0.360805035f,0.780240417f,0.928664625f,0.977255106f,0.992788672f,0.997717679f,0.999278069f,0.999771714f,0.999927819f,0.999977171f,0.266642928f,-0.998210371f,0.972865343f,0.794808388f,-0.72593224f,-0.582933903f,0.331136853f,0.768994927f,0.924909055f,0.976047099f,0.99240464f,0.997596025f,0.999239624f,0.999759495f,0.999923944f,0.999975979f,-0.666938066f,-0.87637943f,0.996578991f,0.674925625f,-0.653643608f,-0.627679706f,0.301137596f,0.757506192f,0.921060979f,0.974808276f,0.992010653f,0.997471273f,0.999200106f,0.999747038f,0.999920011f,0.999974728f,-0.987339258f,-0.484639406f,0.921462357f,0.533756077f,-0.574824035f,-0.670441091f,0.270837069f,0.745777905f,0.917120814f,0.973538578f,0.991606772f,0.997343302f,0.999159634f,0.999734223f,0.999915957f,0.999973416f,-0.399985313f,0.0563609414f,0.754965365f,0.375752151f,-0.490260571f,-0.711082935f,0.240265876f,0.733813822f,0.913088918f,0.972238123f,0.991192937f,0.997212172f,0.999118149f,0.99972111f,0.999911785f,0.999972105f,0.555113316f,0.580003142f,0.513598442f,0.205897167f,-0.400799006f,-0.749476731f,0.209454417f,0.721617639f,0.908965766f,0.970906913f,0.990769207f,0.997077882f,0.999075651f,0.999707639f,0.999907553f,0.999970794f,0.999843299f,0.925014675f,0.221298173f,0.0295478199f,-0.307332784f,-0.785501122f,0.178433523f,0.709193349f,0.904751658f,0.969545007f,0.990335584f,0.996940494f,0.99903214f,0.99969393f,0.999903202f,0.999969363f,0.52532196f,0.985138178f,-0.0929481089f,-0.147732988f,-0.210795805f,-0.819042206f,0.147234216f,0.696544766f,0.90044713f,0.968152404f,0.989892066f,0.996799886f,0.998987675f,0.999679863f,0.999898732f,0.999967992f,-0.432177931f,0.741858006f,-0.397976756f,-0.320354372f,-0.112152621f,-0.849993885f,0.115887694f,0.683675885f,0.89605248f,0.966729224f,0.989438653f,0.996656179f,0.998942196f,0.999665439f,0.999894202f,0.999966562f,-0.992335498f,0.270098448f,-0.663538277f,-0.48287195f,-0.0123883775f,-0.878258407f,0.0844252855f,0.670590878f,0.891568303f,0.965275466f,0.988975346f,0.996509314f,0.998895705f,0.999650776f,0.999889553f,0.999965072f,-0.640144348f,-0.284846604f,-0.863296509f,-0.630159974f,0.0874991715f,-0.903746367f,0.0528784581f,0.657293737f,0.886994898f,0.963791192f,0.988502085f,0.996359289f,0.9988482f,0.999635756f,0.999884784f,0.999963582f,0.300592542f,-0.75206399f,-0.977442741f,-0.757573068f,0.18651247f,-0.926377118f,0.0212787576f,0.643788815f,0.882332861f,0.962276459f,0.98801899f,0.996206105f,0.998799741f,0.999620378f,0.999879956f,0.999962032f,0.964965999f,-0.987659097f,-0.994656444f,-0.861092687f,0.2836622f,-0.946079254f,-0.0103422189f,0.630080283f,0.87758255f,0.960731268f,0.987526f,0.996049762f,0.998750269f,0.999604762f,0.999875009f,0.999960482f,0.742154181f,-0.919073522f,-0.913230121f,-0.937454224f,0.377977669f,-0.96279037f,-0.0419528559f,0.616172493f,0.872744501f,0.959155679f,0.987023175f,0.99589026f,0.998699784f,0.999588788f,0.999869943f,0.999958873f,-0.162990779f,-0.567430019f,-0.741239965f,-0.984248459f,0.468516916f,-0.976457715f,-0.0735215396f,0.602069914f,0.86781919f,0.95754981f,0.986510456f,0.995727658f,0.998648286f,0.999572515f,0.999864817f,0.999957263f,-0.918282807f,-0.0410281904f,-0.495741814f,-1.f,0.554374516f,-0.987038016f,-0.105016708f,0.587776959f,0.862807095f,0.955913603f,0.985987842f,0.995561838f,0.998595834f,0.999555886f,0.999859571f,0.999955595f,-0.829309821f,0.498009592f,-0.201079622f,-0.984212041f,0.634692967f,-0.994497895f,-0.136406869f,0.573298037f,0.857708693f,0.954247177f,0.985455394f,0.995392919f,0.998542368f,0.999538958f,0.999854207f,0.999953866f,0.0221267566f,0.883669317f,0.113521777f,-0.937382519f,0.708669782f,-0.998813629f,-0.167660639f,0.558637917f,0.852524519f,0.95255059f,0.984913111f,0.99522084f,0.99848789f,0.999521732f,0.999848783f,0.999952197f,0.853220105f,0.997174621f,0.416867077f,-0.860988438f,0.775565803f,-0.999971747f,-0.198746875f,0.543801069f,0.847255111f,0.950823903f,0.984360933f,0.995045662f,0.998432398f,0.999504209f,0.99984318f,0.999950409f,0.899866819f,0.803569078f,0.678870201f,-0.757439196f,0.834712923f,-0.997968495f,-0.22963427f,0.528792322f,0.841901004f,0.949067116f,0.983798921f,0.994867265f,0.998375952f,0.999486327f,0.999837577f,0.999948621f,0.119180135f,0.362476677f,0.873550534f,-0.63000071f,0.885519624f,-0.99281019f,-0.260292053f,0.513616323f,0.836462677f,0.947280347f,0.983227074f,0.994685769f,0.998318493f,0.999468148f,0.999831796f,0.999946833f,-0.771080196f,-0.1902491f,0.981602073f,-0.482692331f,0.927478492f,-0.984513164f,-0.290689558f,0.498277903f,0.830940723f,0.945463598f,0.982645452f,0.994501114f,0.998260021f,0.99944967f,0.999825954f,0.999944985f,-0.952412963f,-0.684381902f,0.992308319f,-0.320159167f,0.960170269f,-0.973103702f,-0.3207964f,0.482782036f,0.825335622f,0.943616986f,0.982053936f,0.9943133f,0.998200536f,0.999430835f,0.999819994f,0.999943078f,-0.258101642f,-0.967739642f,0.904607594f,-0.1475292f,0.98326844f,-0.958617806f,-0.350582451f,0.467133403f,0.819648027f,0.941740453f,0.981452644f,0.994122326f,0.998140097f,0.999411702f,0.999813974f,0.99994117f,0.673507154f,-0.953050017f,0.727198064f,0.0297537707f,0.996542096f,-0.941101313f,-0.380017966f,0.451337039f,0.813878477f,0.939834237f,0.980841517f,0.993928254f,0.998078644f,0.999392271f,0.999807835f,0.999939203f,0.985896587f,-0.644837022f,0.477671444f,0.206098333f,0.999858618f,-0.920609534f,-0.409073502f,0.435397953f,0.808027506f,0.937898219f,0.980220556f,0.993731022f,0.998016179f,0.999372482f,0.999801576f,0.999937236f};
__device__ const float ROPE_SIN[1024] = {0.f,0.f,0.f,0.f,0.f,0.f,0.f,0.f,0.f,0.f,0.f,0.f,0.f,0.f,0.f,0.f,0.841470957f,0.533168435f,0.310983598f,0.176892191f,0.0998334214f,0.0562044978f,0.0316175036f,0.0177818574f,0.00999983307f,0.00562338345f,0.00316227227f,0.0017782785f,0.000999999931f,0.000562341243f,0.000316227757f,0.00017782794f,0.909297407f,0.902130723f,0.591127098f,0.348205268f,0.198669329f,0.112231314f,0.0632033944f,0.0355580896f,0.0199986659f,0.011246589f,0.00632451288f,0.00355655141f,0.0019999987f,0.00112468237f,0.000632455456f,0.00035565588f,0.141120002f,0.993253171f,0.812648892f,0.5085361f,0.295520216f,0.167903304f,0.0947260857f,0.0533230826f,0.0299954992f,0.0168694388f,0.00948669016f,0.00533481315f,0.0029999956f,0.00168702309f,0.000948683126f,0.000533483806f,-0.756802499f,0.778471708f,0.953580737f,0.652827978f,0.389418334f,0.223044485f,0.126154065f,0.0710712075f,0.0399893336f,0.0224917568f,0.0126487734f,0.00711305765f,0.00399998948f,0.00224936334f,0.00126491068f,0.000711311703f,-0.958924294f,0.32393527f,0.999946535f,0.776529968f,0.47942555f,0.277480543f,0.157455876f,0.0887968615f,0.0499791652f,0.0281133614f,0.0158107281f,0.00889127981f,0.0049999794f,0.0028117029f,0.00158113812f,0.000889139599f,-0.279415488f,-0.230367512f,0.947148204f,0.875740528f,0.564642489f,0.33103931f,0.188600272f,0.106494442f,0.0599640049f,0.0337340795f,0.0189725272f,0.0106694745f,0.0059999642f,0.00337404152f,0.00189736532f,0.00106696738f,0.656986594f,-0.713721275f,0.800421596f,0.947330713f,0.64421767f,0.383551568f,0.219556093f,0.124158338f,0.0699428469f,0.0393537246f,0.0221341345f,0.0124476347f,0.00699994294f,0.00393637875f,0.00221359241f,0.00124479528f,0.989358246f,-0.977261782f,0.574317753f,0.989042461f,0.717356086f,0.434851229f,0.250292331f,0.141782969f,0.0799146891f,0.0449721329f,0.0252955221f,0.0142257558f,0.0079999147f,0.00449871505f,0.00252981926f,0.00142262306f,0.412118495f,-0.939823508f,0.291259229f,0.999560297f,0.783326924f,0.484776139f,0.280778319f,0.159362778f,0.0898785442f,0.0505891182f,0.0284566563f,0.0160038304f,0.00899987947f,0.00506105041f,0.00284604589f,0.00160045072f,-0.54402113f,-0.612936914f,-0.0206835698f,0.978552461f,0.841470957f,0.533168435f,0.310983568f,0.176892191f,0.099833414f,0.0562044978f,0.0316175036f,0.0177818574f,0.009999834f,0.00562338345f,0.00316227227f,0.0017782785f,-0.999990225f,-0.0972764567f,-0.33057496f,0.926681578f,0.891207397f,0.579875171f,0.340877861f,0.19436565f,0.1097783f,0.0618181042f,0.0347780399f,0.0195598267f,0.0109997792f,0.00618571462f,0.00347849843f,0.00195610616f,-0.536572933f,0.448342979f,-0.60768342f,0.845583618f,0.932039082f,0.624748647f,0.370431304f,0.211777672f,0.119712204f,0.0674297586f,0.0379382223f,0.0213377345f,0.0119997123f,0.0067480444f,0.00379472389f,0.00213393359f,0.420167029f,0.855880976f,-0.824528456f,0.737816215f,0.963558197f,0.667647004f,0.399614304f,0.229122713f,0.129634142f,0.0730392784f,0.0410980321f,0.0231155735f,0.0129996343f,0.00731037185f,0.00411094911f,0.00231176103f,0.990607381f,0.999823332f,-0.959605396f,0.606778562f,0.985449731f,0.708434701f,0.428397775f,0.246395305f,0.139543116f,0.078646481f,0.0442574248f,0.0248933397f,0.0139995432f,0.00787269697f,0.00442717411f,0.00248958869f,0.650287867f,0.835838437f,-0.999518692f,0.456603259f,0.997494996f,0.746982634f,0.456752867f,0.263589978f,0.149438128f,0.0842512026f,0.0474163815f,0.0266710296f,0.0149994381f,0.00843502022f,0.00474339863f,0.00266741589f,-0.287903309f,0.414430231f,-0.940310359f,0.292027086f,0.999573588f,0.783169091f,0.484651238f,0.280701309f,0.159318209f,0.0898532644f,0.0505748577f,0.028448632f,0.015999319f,0.00899733976f,0.00505962269f,0.00284524332f,-0.961397469f,-0.134615138f,-0.78785187f,0.11824052f,0.991664827f,0.81687957f,0.512064993f,0.29772386f,0.169182345f,0.09545248f,0.0537328273f,0.0302261449f,0.0169991814f,0.00955965649f,0.00537584582f,0.00302307028f,-0.750987232f,-0.642200708f,-0.557262897f,-0.0592755191f,0.973847628f,0.84800756f,0.538966715f,0.314652264f,0.179029569f,0.101048686f,0.0568902642f,0.0320035629f,0.0179990288f,0.0101219704f,0.00569206895f,0.00320089748f,0.149877205f,-0.952000856f,-0.271410108f,-0.234921798f,0.946300089f,0.876454532f,0.565329552f,0.331481189f,0.188858896f,0.10664168f,0.060047131f,0.0337808803f,0.0189988576f,0.0106842816f,0.00600829115f,0.00337872445f,0.912945271f,-0.968601942f,0.0413582884f,-0.403158993f,0.909297407f,0.902130723f,0.591127038f,0.348205268f,0.198669314f,0.112231314f,0.0632033944f,0.0355580896f,0.0199986678f,0.011246589f,0.00632451288f,0.00355655141f,0.836655617f,-0.686891198f,0.35002476f,-0.558680534f,0.863209307f,0.924954832f,0.616333544f,0.364819258f,0.208459899f,0.117817394f,0.0663590282f,0.0373351872f,0.0209984574f,0.0118088927f,0.00664073415f,0.00373437814f,-0.00885130931f,-0.193630233f,0.623979926f,-0.696581721f,0.808496356f,0.944854796f,0.640923738f,0.381317884f,0.218229622f,0.123399742f,0.0695140064f,0.0391121693f,0.0219982266f,0.0123711927f,0.00695695449f,0.00391220488f,-0.846220434f,0.359264523f,0.836055279f,-0.812512875f,0.745705247f,0.961767614f,0.664873064f,0.397695929f,0.227977514f,0.128978193f,0.0726682767f,0.0408890247f,0.0229979735f,0.0129334899f,0.00727317436f,0.00409003161f,-0.905578375f,0.801513135f,0.965219259f,-0.902817786f,0.67546314f,0.97563988f,0.688157499f,0.413948208f,0.237702623f,0.134552568f,0.0758218244f,0.0426657498f,0.0239976961f,0.0134957815f,0.0075893933f,0.00426785741f,-0.132351756f,0.996909976f,0.998663187f,-0.964648306f,0.598472118f,0.986427724f,0.710753918f,0.430069596f,0.247403964f,0.140122697f,0.0789746121f,0.0444423407f,0.0249973964f,0.0140580693f,0.00790561177f,0.00444568414f,0.76255846f,0.885276794f,0.933070183f,-0.996054351f,0.515501261f,0.994096994f,0.732639611f,0.446054995f,0.257080555f,0.145688385f,0.0821266174f,0.0462187938f,0.0259970706f,0.0146203535f,0.00822182931f,0.00462350994f,0.956375957f,0.500994205f,0.774945021f,-0.996045172f,0.427379847f,0.99862349f,0.753792703f,0.46189931f,0.266731411f,0.151249468f,0.0852777958f,0.0479951017f,0.0269967206f,0.015182632f,0.00853804592f,0.00480133574f,0.270905793f,-0.0375856608f,0.539968967f,-0.964621305f,0.334988207f,0.999992907f,0.774192095f,0.477597594f,0.276355654f,0.156805754f,0.0884281173f,0.049771253f,0.0279963426f,0.0157449059f,0.0088542616f,0.00497916201f,-0.663633883f,-0.564589798f,0.251445323f,-0.902773678f,0.239249229f,0.998200953f,0.793817401f,0.49314484f,0.28595221f,0.162357092f,0.0915775672f,0.0515472479f,0.0289959367f,0.0163071752f,0.00917047635f,0.00515698735f,-0.988031626f,-0.917709649f,-0.0620148405f,-0.812452853f,0.141120002f,0.993253171f,0.812648892f,0.5085361f,0.295520186f,0.167903304f,0.0947260931f,0.0533230826f,0.029995501f,0.0168694388f,0.00948669016f,0.00533481315f,-0.404037654f,-0.988192797f,-0.369325012f,-0.696507812f,0.0415805206f,0.985165298f,0.830667794f,0.523766637f,0.305058628f,0.173444211f,0.0978736654f,0.055098746f,0.0309950355f,0.0174316969f,0.00980290305f,0.00551263802f,0.551426709f,-0.754330218f,-0.640009403f,-0.5585953f,-0.0583741926f,0.973962843f,0.847856104f,0.538831532f,0.314566553f,0.17897962f,0.101020269f,0.0568742342f,0.0319945402f,0.0179939512f,0.0101191159f,0.00569046335f,0.999911845f,-0.28814739f,-0.847224355f,-0.403064936f,-0.157745644f,0.959681332f,0.864196658f,0.553726017f,0.324043006f,0.184509367f,0.10416586f,0.0586495437f,0.0329940096f,0.0185561981f,0.010435327f,0.00586828869f,0.529082716f,0.266779721f,-0.97042042f,-0.234822124f,-0.255541205f,0.942365825f,0.879673064f,0.568445385f,0.333487093f,0.190033287f,0.107310407f,0.0604246669f,0.0339934528f,0.0191184394f,0.010751537f,0.00604611309f,-0.428182662f,0.739542127f,-0.997380435f,-0.0591726787f,-0.350783229f,0.92207104f,0.894269884f,0.582984984f,0.342897803f,0.195551202f,0.110453881f,0.0621996038f,0.034992855f,0.0196806751f,0.0110677453f,0.00622393796f,-0.991778851f,0.984540582f,-0.925431013f,0.118342586f,-0.442520559f,0.89886117f,0.907972515f,0.597340286f,0.352274209f,0.201062918f,0.113596253f,0.0639743358f,0.0359922275f,0.0202429052f,0.0113839535f,0.0064017619f,-0.643538117f,0.926318109f,-0.761706948f,0.292125374f,-0.529836178f,0.872809589f,0.920767248f,0.611506701f,0.361615449f,0.206568271f,0.116737492f,0.0657488778f,0.036991559f,0.0208051261f,0.0117001599f,0.0065795863f,0.296368569f,0.58280617f,-0.522444785f,0.456694692f,-0.611857831f,0.84399873f,0.932641268f,0.625479698f,0.370920479f,0.212067112f,0.119877554f,0.0675232038f,0.0379908569f,0.0213673431f,0.0120163653f,0.00675741071f,0.963795364f,0.0598003156f,-0.231372014f,0.606860459f,-0.687766254f,0.81251961f,0.943582714f,0.639254928f,0.380188406f,0.217559248f,0.123016424f,0.0692973137f,0.0389901139f,0.0219295528f,0.0123325698f,0.00693523418f,0.745113134f,-0.481621295f,0.0826458037f,0.737885714f,-0.756802499f,0.778471708f,0.953580678f,0.652827978f,0.389418334f,0.223044485f,0.126154065f,0.0710712075f,0.0399893373f,0.0224917568f,0.0126487734f,0.00711305765f,-0.158622667f,-0.874714017f,0.388467699f,0.845638454f,-0.818277061f,0.74196279f,0.962625206f,0.666194677f,0.39860931f,0.228522688f,0.129290432f,0.0728448778f,0.0409885161f,0.0230539497f,0.0129649751f,0.00729088066f,-0.916521549f,-0.998410463f,0.655764699f,0.926720202f,-0.871575892f,0.703108132f,0.970707119f,0.679350674f,0.407760441f,0.233993664f,0.132425532f,0.0746183172f,0.0419876575f,0.0236161388f,0.0132811759f,0.00746870413f,-0.831774771f,-0.814614236f,0.858030677f,0.97857362f,-0.916166008f,0.662030637f,0.977818429f,0.692291796f,0.416870773f,0.23945722f,0.135559291f,0.0763915181f,0.0429867506f,0.0241783205f,0.0135973748f,0.00764652714f,0.0177019257f,-0.37993139f,0.975206196f,0.999563396f,-0.951602101f,0.618860185f,0.983951986f,0.70501405f,0.425939471f,0.244913206f,0.138691694f,0.0781644881f,0.0439858064f,0.0247404929f,0.0139135728f,0.00782434922f,0.850903511f,0.171763569f,0.995670974f,0.989027262f,-0.977530122f,0.57373327f,0.989101648f,0.717513323f,0.434965521f,0.250361472f,0.141822711f,0.0799371973f,0.0449848175f,0.0253026579f,0.0142297689f,0.00800217129f,0.901788354f,0.670557022f,0.917395473f,0.947297752f,-0.993690968f,0.526792526f,0.993262351f,0.72978574f,0.44394809f,0.255801797f,0.144952312f,0.0817096606f,0.0459837839f,0.0258648153f,0.0145459641f,0.0081799943f,0.123573124f,0.962832689f,0.748142362f,0.875690997f,-0.999923289f,0.478186339f,0.996429801f,0.741827428f,0.452886283f,0.261234075f,0.148080453f,0.0834818557f,0.0469827019f,0.0264269635f,0.0148621574f,0.00835781638f,-0.768254638f,0.958573103f,0.504697084f,0.776465356f,-0.99616462f,0.428068399f,0.99860096f,0.753634512f,0.461779177f,0.266658038f,0.151207119f,0.0852537975f,0.0479815714f,0.0269891042f,0.0151783489f,0.00853563752f,-0.953752637f,0.659090102f,0.211200655f,0.652750373f,-0.982452571f,0.376597136f,0.999773562f,0.765203178f,0.470625877f,0.272073567f,0.15433228f,0.087025471f,0.0489803962f,0.0275512375f,0.0154945394f,0.0087134596f,-0.262374848f,0.156619072f,-0.10324046f,0.508447945f,-0.958924294f,0.32393527f,0.999946535f,0.776529968f,0.47942555f,0.277480543f,0.157455891f,0.0887968615f,0.0499791689f,0.0281133596f,0.0158107281f,0.00889127981f,0.670229197f,-0.394086063f,-0.407444149f,0.3481085f,-0.925814748f,0.270249337f,0.99911958f,0.787611187f,0.48817724f,0.282878697f,0.160577938f,0.0905679762f,0.0509778969f,0.0286754742f,0.0161269177f,0.00906910095f,0.986627579f,-0.823421597f,-0.671240151f,0.176790684f,-0.883454502f,0.215709001f,0.997293651f,0.798443377f,0.496880114f,0.28826794f,0.163698375f,0.0923388004f,0.051976569f,0.0292375814f,0.0164431017f,0.00924692024f,0.395925164f,-0.999157965f,-0.868469954f,-0.000103020677f,-0.832267344f,0.160486728f,0.994470477f,0.809023023f,0.505533338f,0.293648034f,0.166817173f,0.0941093415f,0.0529751927f,0.0297996756f,0.0167592876f,0.00942474138f,-0.558789074f,-0.867171526f,-0.979574919f,-0.176993474f,-0.772764444f,0.104756832f,0.990652919f,0.819346905f,0.514135957f,0.29901889f,0.169934288f,0.0958795771f,0.0539737605f,0.0303617641f,0.0170754679f,0.00960256159f,-0.999755144f,-0.468111664f,-0.993535519f,-0.348301649f,-0.705540299f,0.0486960001f,0.985844791f,0.829411685f,0.522687256f,0.304380238f,0.173049718f,0.0976495072f,0.0549722798f,0.0309238415f,0.01739165f,0.00978038087f,-0.521551013f,0.0751182064f,-0.908967435f,-0.508624554f,-0.631266713f,-0.00751878507f,0.980050862f,0.839214146f,0.531186223f,0.30973196f,0.17616342f,0.0994191393f,0.0559707358f,0.0314859077f,0.0177078284f,0.00995820016f,0.436164767f,0.595211506f,-0.734258294f,-0.652905703f,-0.550685287f,-0.0637097955f,0.973276973f,0.848751247f,0.539632022f,0.315073937f,0.179275364f,0.101188451f,0.0569691435f,0.0320479684f,0.0180240069f,0.0101360194f,0.992872655f,0.931992829f,-0.486733496f,-0.776594579f,-0.464602023f,-0.119699396f,0.965529919f,0.858020008f,0.548023939f,0.3204059f,0.182385504f,0.102957435f,0.0579674877f,0.0326100141f,0.0183401816f,0.0103138378f,0.636738002f,0.981735826f,-0.190938011f,-0.87579f,-0.373876572f,-0.175310582f,0.956817448f,0.867017388f,0.55636102f,0.325727791f,0.185493827f,0.104726106f,0.0589657798f,0.0331720486f,0.0186563563f,0.0104916561f,-0.304810613f,0.729123712f,0.12379095f,-0.947363734f,-0.279415488f,-0.230367512f,0.947148204f,0.875740528f,0.564642429f,0.33103931f,0.188600287f,0.106494442f,0.0599640086f,0.0337340795f,0.0189725272f,0.0106694745f,-0.966117799f,0.251952261f,0.426245421f,-0.98905772f,-0.182162598f,-0.284696162f,0.936531842f,0.884186864f,0.572867453f,0.336340427f,0.191704854f,0.108262435f,0.0609621815f,0.0342960916f,0.0192886982f,0.0108472919f,-0.739180684f,-0.302812874f,0.686427653f,-0.999557257f,-0.0830891207f,-0.338124752f,0.924979091f,0.892353535f,0.581035137f,0.341630876f,0.194807529f,0.110030092f,0.0619602874f,0.0348580964f,0.0196048655f,0.0110251084f,0.167355701f,-0.764320076f,0.878538549f,-0.978531301f,0.0168140903f,-0.390484393f,0.912501454f,0.900238097f,0.589144766f,0.346910536f,0.197908238f,0.111797392f,0.0629583374f,0.0354200937f,0.0199210308f,0.0112029258f};
#define LAS __attribute__((address_space(3)))
#define XB_TMO      128
#define XB_XCNT(j)  (256  + 64 * (j))
#define XB_XSUB(j)  (1280 + 64 * (j))
#define XB_XGEN(j)  (2304 + 64 * (j))
#define XB_TOP      3328
#define XB_TOPGEN   3392
#define XCD_BAR_WORDS 3456
#define XB_SPIN_CAP (1u << 18)

__device__ __forceinline__ unsigned xb_ld(unsigned* p)              { return __hip_atomic_load(p, __ATOMIC_RELAXED, __HIP_MEMORY_SCOPE_AGENT); }
__device__ __forceinline__ unsigned xb_add(unsigned* p, unsigned v) { return __hip_atomic_fetch_add(p, v, __ATOMIC_RELAXED, __HIP_MEMORY_SCOPE_AGENT); }
__device__ __forceinline__ unsigned xb_xcc_id() { return (unsigned)__builtin_amdgcn_s_getreg((3 << 11) | 20) & 0xFu; }
#define XB_SPIN(cond, bar) do { unsigned _sp = 0; while (cond) { __builtin_amdgcn_s_sleep(1); \
    if ((++_sp & 255u) == 0u) { if (xb_ld(&(bar)[XB_TMO])) break; if (_sp > XB_SPIN_CAP) { atomicAdd(&(bar)[XB_TMO], 1u); break; } } } } while (0)

struct XcdBarrier {
    unsigned* bar; unsigned x;
    volatile LAS unsigned* st;
};

__device__ __forceinline__ XcdBarrier xcd_barrier_post(unsigned* bar, volatile LAS unsigned* st) {
    XcdBarrier b; b.bar = bar; b.x = xb_xcc_id(); b.st = st;
    if (threadIdx.x == 0) (void)xb_add(&bar[XB_XCNT(b.x)], 1u);
    return b;
}
__device__ __forceinline__ void xcd_barrier_complete(unsigned* bar, unsigned x, unsigned& nloc, unsigned& nx) {
    const unsigned G = gridDim.x * gridDim.y * gridDim.z;
    unsigned sum, cnt, mine, sp = 0u;
    for (;;) {
        sum = 0u; cnt = 0u; mine = 0u;
#pragma unroll
        for (unsigned j = 0; j < 16; ++j) { const unsigned c = xb_ld(&bar[XB_XCNT(j)]); sum += c; cnt += (c > 0u) ? 1u : 0u; mine = (j == x) ? c : mine; }
        if (sum == G) break;
        __builtin_amdgcn_s_sleep(1);
        if ((++sp & 255u) == 0u) { if (xb_ld(&bar[XB_TMO])) break; if (sp > XB_SPIN_CAP) { atomicAdd(&bar[XB_TMO], 1u); break; } }
    }
    nloc = mine > 0u ? mine : 1u; nx = cnt > 0u ? cnt : 1u;
}

__device__ __forceinline__ void xcd_barrier(const XcdBarrier& b) {
    asm volatile("s_waitcnt vmcnt(0)" ::: "memory");
    __syncthreads();
    if (threadIdx.x == 0) {
        unsigned* bar = b.bar;
        __builtin_amdgcn_s_waitcnt(0);
        unsigned nloc = b.st[0], nx = b.st[1];
        if (nloc == 0u) { xcd_barrier_complete(bar, b.x, nloc, nx); b.st[0] = nloc; b.st[1] = nx; }
        const unsigned old = xb_add(&bar[XB_XSUB(b.x)], 1u);
        const unsigned gen = old / nloc;
        if (old + 1u == (gen + 1u) * nloc) {
            __builtin_amdgcn_fence(__ATOMIC_RELEASE, "agent");
            asm volatile("s_waitcnt vmcnt(0)" ::: "memory");
            const unsigned og = xb_add(&bar[XB_TOP], 1u);
            const unsigned tg = og / nx;
            if (og + 1u == (tg + 1u) * nx) xb_add(&bar[XB_TOPGEN], 1u);
            else XB_SPIN(xb_ld(&bar[XB_TOPGEN]) == tg, bar);
            __builtin_amdgcn_fence(__ATOMIC_ACQUIRE, "agent");
            xb_add(&bar[XB_XGEN(b.x)], 1u);
            asm volatile("s_waitcnt vmcnt(0)" ::: "memory");
        } else {
            XB_SPIN(xb_ld(&bar[XB_XGEN(b.x)]) == gen, bar);
            __builtin_amdgcn_fence(__ATOMIC_ACQUIRE, "agent");
            asm volatile("s_waitcnt vmcnt(0)" ::: "memory");
        }
    }
    __syncthreads();
}

#define DI __device__ __forceinline__
#define LAS __attribute__((address_space(3)))
typedef unsigned short bf16;
typedef short bf16x8 __attribute__((ext_vector_type(8)));
typedef float f32x4 __attribute__((ext_vector_type(4)));
typedef unsigned u32x4 __attribute__((ext_vector_type(4)));
typedef unsigned u32x2 __attribute__((ext_vector_type(2)));

#ifndef COOP
#define COOP 1
#endif

constexpr int D = 1024, NBATCH = 4, SEQ = 4096, CTXL = 256, NLAT = NBATCH * SEQ, NCTX = NBATCH * CTXL, MT = NLAT + NCTX;
constexpr int FF = 2816, KEYS = SEQ + CTXL;
constexpr int LDP0 = 2560, LDP1 = 3072;
constexpr int C_AQ = 0, C_AK = 512, C_AV = 640, C_BQ = 768, C_BK = 1024, C_BV = 1280, C_BO = 1792, C_RF = 2304, C_RB = 2320;
constexpr float LOG2E = 1.4426950408889634f, EPS = 1e-6f;
constexpr int NCHUNK = 68;

constexpr size_t MiB = 1u << 20;
constexpr size_t WS_CTL = 0, WS_MOD = 1 * MiB, WS_XC = 2 * MiB, WS_WABI = 6 * MiB, WS_WABO = 11 * MiB, WS_WFI = 13 * MiB, WS_WFO = 35 * MiB, WS_WNI = 46 * MiB, WS_WNO = 52 * MiB;
constexpr size_t WS_HO = 54 * MiB, WS_YF = 88 * MiB, WS_P = 122 * MiB, WS_STC = 224 * MiB, WS_DEC = 228 * MiB, WS_END = 246 * MiB;
constexpr size_t WS_PART = 224 * MiB;
constexpr int LDS_BYTES = 147456;
constexpr int NWAVES = 8, NTHR = 512;

DI float bf2f(unsigned short h) { return __uint_as_float(((unsigned)h) << 16); }
DI unsigned pk2(float lo, float hi) { return pg8::cvt_pk_bf16(lo, hi); }
DI float wave_sum(float v) {
#pragma unroll
    for (int o = 1; o < 64; o <<= 1) v += __shfl_xor(v, o);
    return v;
}
DI float fast_exp2(float x) { return __builtin_amdgcn_exp2f(x); }
DI float silu_f(float g) { return g * __builtin_amdgcn_rcpf(1.0f + __expf(-g)); }
DI void unpack8(const bf16x8 v, float (&o)[8]) {
#pragma unroll
    for (int i = 0; i < 8; ++i) o[i] = bf2f((unsigned short)v[i]);
}
DI bf16x8 pack8(const float (&p)[8]) {
    u32x4 w; w.x = pk2(p[0], p[1]); w.y = pk2(p[2], p[3]); w.z = pk2(p[4], p[5]); w.w = pk2(p[6], p[7]);
    return __builtin_bit_cast(bf16x8, w);
}
#define MFMA16(a, b, c) __builtin_amdgcn_mfma_f32_16x16x32_bf16((a), (b), (c), 0, 0, 0)

struct EpiStore {
    static constexpr bool PERM = true, AFTER_DRAIN = false;
    bf16* O; int ldc;
    DI void operator()(const pg8::f32x4 (&acc)[2][2][4][2], const pg8::Unit& u, int wr, int wc, int fr, int fq) const {
        const int row0 = u.pm * 256 + wr * 64 + fr, col0 = u.pn * 256 + wc * 32 + 8 * fq;
#pragma unroll
        for (int ai = 0; ai < 2; ++ai)
#pragma unroll
            for (int m = 0; m < 4; ++m) { bf16* rowp = O + (size_t)(row0 + ai * 128 + m * 16) * ldc + col0;
#pragma unroll
                for (int bj = 0; bj < 2; ++bj) { const pg8::f32x4 v0 = acc[ai][bj][m][0], v1 = acc[ai][bj][m][1];
                    u32x4 w; w.x = pk2(v0[0], v0[1]); w.y = pk2(v0[2], v0[3]); w.z = pk2(v1[0], v1[1]); w.w = pk2(v1[2], v1[3]);
                    *(u32x4*)(rowp + bj * 128) = w; } }
    }
};
struct EpiSwiglu {
    static constexpr bool PERM = true, AFTER_DRAIN = false;
    bf16* O; int ldc;
    DI void operator()(const pg8::f32x4 (&acc)[2][2][4][2], const pg8::Unit& u, int wr, int wc, int fr, int fq) const {
        const int row0 = u.pm * 256 + wr * 64 + fr, col0 = u.pn * 128 + wc * 32 + 8 * fq;
#pragma unroll
        for (int ai = 0; ai < 2; ++ai)
#pragma unroll
            for (int m = 0; m < 4; ++m) { bf16* rowp = O + (size_t)(row0 + ai * 128 + m * 16) * ldc + col0;
                const pg8::f32x4 g0 = acc[ai][0][m][0], g1 = acc[ai][0][m][1], u0 = acc[ai][1][m][0], u1 = acc[ai][1][m][1];
                u32x4 w; w.x = pk2(silu_f(g0[0]) * u0[0], silu_f(g0[1]) * u0[1]); w.y = pk2(silu_f(g0[2]) * u0[2], silu_f(g0[3]) * u0[3]);
                w.z = pk2(silu_f(g1[0]) * u1[0], silu_f(g1[1]) * u1[1]); w.w = pk2(silu_f(g1[2]) * u1[2], silu_f(g1[3]) * u1[3]);
                *(u32x4*)rowp = w; }
    }
};

struct OneUnit {
    int pm, pn; bool has;
    DI bool next(int i, pg8::Unit& u) const { if (i != 0 || !has) return false; u.pm = pm; u.pn = pn; return true; }
    DI void a_ready(const pg8::Unit&) const {}
    DI void done(const pg8::Unit&) const {}
};

struct Args { const float* in[23]; float* out; unsigned char* ws; int ph_lo, ph_hi; };
enum { I_X = 0, I_C, I_CTX, I_CCTX, I_WMOD, I_BMOD, I_GMPRE, I_GMPOST, I_GFPRE, I_GFPOST, I_WFI, I_WFO, I_ABWI, I_ABWO, I_SINK, I_GFW, I_GFB, I_GBW, I_GBB, I_GNORM, I_NAWI, I_NAWO, I_RELB };

DI void transpose_item(const float* W, int K, int N, bf16* WT, int k0, int n0, int drow0, LAS float* scr, int lane) {
#pragma unroll 8
    for (int i = 0; i < 32; ++i) { const int kk = 2 * i + (lane >> 5); scr[kk * 33 + (lane & 31)] = W[(size_t)(k0 + kk) * N + n0 + (lane & 31)]; }
    asm volatile("s_waitcnt lgkmcnt(0)" ::: "memory");
    const int c = lane & 7;
#pragma unroll
    for (int j = 0; j < 4; ++j) { const int n = (lane >> 3) + 8 * j; const LAS float* s = scr + (8 * c) * 33 + n;
        u32x4 o; o.x = pk2(s[0 * 33], s[1 * 33]); o.y = pk2(s[2 * 33], s[3 * 33]); o.z = pk2(s[4 * 33], s[5 * 33]); o.w = pk2(s[6 * 33], s[7 * 33]);
        *(u32x4*)(WT + (size_t)(drow0 + n) * K + k0 + 8 * c) = o; }
    asm volatile("s_waitcnt lgkmcnt(0)" ::: "memory");
}
DI void xpose_plain(const float* W, int K, int N, bf16* WT, int item, LAS float* scr, int lane) {
    const int nblk = N / 32, kb = item / nblk, nb = item % nblk;
    transpose_item(W, K, N, WT, 64 * kb, 32 * nb, 32 * nb, scr, lane);
}
DI void xpose_ffnin(const float* W, bf16* WT, int item, LAS float* scr, int lane) {
    const int nblk = 5632 / 32, kb = item / nblk, nb = item % nblk, n0 = 32 * nb;
    const int bj = n0 >= FF ? 1 : 0, cc = n0 - bj * FF, drow0 = 256 * (cc >> 7) + 128 * bj + (cc & 127);
    transpose_item(W, 1024, 5632, WT, 64 * kb, n0, drow0, scr, lane);
}

DI void phase_prologue(const Args& a, LAS unsigned char* lds, int tid, int lane, int wave) {
    unsigned char* ws = a.ws;
    {
        LAS float* sl = (LAS float*)lds;
        LAS float* red = (LAS float*)(lds + 32768);
        for (int i = tid; i < 5 * 1024; i += NTHR) { const int s = i >> 10, k = i & 1023; const float v = s < 4 ? a.in[I_C][s * 1024 + k] : a.in[I_CCTX][k]; sl[i] = v / (1.0f + __expf(-v)); }
        __syncthreads();
        for (int u = blockIdx.x; u < 192; u += gridDim.x) {
            const int layer = u / 96, col = (u % 96) * 64 + lane;
            const float* W = a.in[I_WMOD] + (size_t)layer * 1024 * 6144 + col;
            float acc[5] = {0.f, 0.f, 0.f, 0.f, 0.f};
            const int kb = wave * 128;
#pragma unroll 8
            for (int k = 0; k < 128; ++k) { const float w = W[(size_t)(kb + k) * 6144];
#pragma unroll
                for (int s = 0; s < 5; ++s) acc[s] += sl[s * 1024 + kb + k] * w; }
#pragma unroll
            for (int s = 0; s < 5; ++s) red[(wave * 5 + s) * 64 + lane] = acc[s];
            __syncthreads();
            if (tid < 320) { const int s = tid >> 6, l = tid & 63; float t = 0.f;
#pragma unroll
                for (int w = 0; w < 8; ++w) t += red[(w * 5 + s) * 64 + l];
                const int c2 = (u % 96) * 64 + l;
                ((float*)(ws + WS_MOD))[(size_t)(layer * 5 + s) * 6144 + c2] = t + a.in[I_BMOD][layer * 6144 + c2]; }
            __syncthreads();
        }
        __syncthreads();
    }
    LAS float* scr = (LAS float*)(lds + wave * 16384);
    const int gw = blockIdx.x * NWAVES + wave, NGW = gridDim.x * NWAVES;
    constexpr int I_1 = 16 * 73, I_2 = 16 * 32, I_3 = 16 * 176, I_4 = 44 * 32, I_5 = 16 * 96, I_6 = 16 * 32;
    constexpr int NITEMS = I_1 + I_2 + 2 * I_3 + 2 * I_4 + I_5 + I_6;
    for (int it = gw; it < NITEMS; it += NGW) {
        int r = it;
        if (r < I_1) { xpose_plain(a.in[I_ABWI], 1024, 2336, (bf16*)(ws + WS_WABI), r, scr, lane); continue; } r -= I_1;
        if (r < I_2) { xpose_plain(a.in[I_ABWO], 1024, 1024, (bf16*)(ws + WS_WABO), r, scr, lane); continue; } r -= I_2;
        if (r < I_3) { xpose_ffnin(a.in[I_WFI], (bf16*)(ws + WS_WFI), r, scr, lane); continue; } r -= I_3;
        if (r < I_3) { xpose_ffnin(a.in[I_WFI] + (size_t)1024 * 5632, (bf16*)(ws + WS_WFI) + (size_t)5632 * 1024, r, scr, lane); continue; } r -= I_3;
        if (r < I_4) { xpose_plain(a.in[I_WFO], FF, 1024, (bf16*)(ws + WS_WFO), r, scr, lane); continue; } r -= I_4;
        if (r < I_4) { xpose_plain(a.in[I_WFO] + (size_t)FF * 1024, FF, 1024, (bf16*)(ws + WS_WFO) + (size_t)1024 * FF, r, scr, lane); continue; } r -= I_4;
        if (r < I_5) { xpose_plain(a.in[I_NAWI], 1024, 3072, (bf16*)(ws + WS_WNI), r, scr, lane); continue; } r -= I_5;
        xpose_plain(a.in[I_NAWO], 1024, 1024, (bf16*)(ws + WS_WNO), r, scr, lane);
    }
    { u32x4* z = (u32x4*)((bf16*)(ws + WS_WABI) + (size_t)2336 * 1024); const u32x4 zero = {0u, 0u, 0u, 0u};
      for (int i = blockIdx.x * NTHR + tid; i < 224 * 128; i += gridDim.x * NTHR) z[i] = zero; }
}

DI void row_op(const float* xsrc, const bf16* y, int nslice, const float* gpost, const float* gate, float* xdst,
               const float* gpre, const float* shift, const float* scale, bf16* hdst, int lane) {
    f32x4 v[4];
#pragma unroll
    for (int j = 0; j < 4; ++j) v[j] = *((const f32x4*)xsrc + lane + 64 * j);
    if (y) {
        f32x4 yv[4]; float s = 0.f;
#pragma unroll
        for (int j = 0; j < 4; ++j) yv[j] = (f32x4){0.f, 0.f, 0.f, 0.f};
        for (int sl = 0; sl < nslice; ++sl) {
#pragma unroll
            for (int j = 0; j < 4; ++j) { const u32x2 w = *((const u32x2*)(y + (size_t)sl * NCTX * D) + lane + 64 * j);
                yv[j] = yv[j] + (f32x4){__uint_as_float(w.x << 16), __uint_as_float(w.x & 0xffff0000u), __uint_as_float(w.y << 16), __uint_as_float(w.y & 0xffff0000u)}; } }
#pragma unroll
        for (int j = 0; j < 4; ++j) s += (yv[j].x * yv[j].x + yv[j].y * yv[j].y) + (yv[j].z * yv[j].z + yv[j].w * yv[j].w);
        const float rstd = __builtin_amdgcn_rsqf(wave_sum(s) * (1.0f / D) + EPS);
#pragma unroll
        for (int j = 0; j < 4; ++j) { const f32x4 gp = *((const f32x4*)gpost + lane + 64 * j), gt = *((const f32x4*)gate + lane + 64 * j);
            v[j] = v[j] + gt * (yv[j] * rstd * gp); }
    }
    if (xdst) {
#pragma unroll
        for (int j = 0; j < 4; ++j) *((f32x4*)xdst + lane + 64 * j) = v[j];
    }
    if (hdst) {
        float s = 0.f;
#pragma unroll
        for (int j = 0; j < 4; ++j) s += (v[j].x * v[j].x + v[j].y * v[j].y) + (v[j].z * v[j].z + v[j].w * v[j].w);
        const float rstd = __builtin_amdgcn_rsqf(wave_sum(s) * (1.0f / D) + EPS);
#pragma unroll
        for (int j = 0; j < 4; ++j) { const f32x4 gp = *((const f32x4*)gpre + lane + 64 * j), sh = *((const f32x4*)shift + lane + 64 * j), sc = *((const f32x4*)scale + lane + 64 * j);
            const f32x4 h = v[j] * rstd * gp * (sc + 1.0f) + sh;
            u32x2 w; w.x = pk2(h.x, h.y); w.y = pk2(h.z, h.w);
            *((u32x2*)hdst + lane + 64 * j) = w; }
    }
}
DI void phase_rows(const Args& a, int mode, int layer, int lane, int wave) {
    unsigned char* ws = a.ws;
    const float* MOD = (const float*)(ws + WS_MOD);
    bf16* H = (bf16*)(ws + WS_HO); const bf16* YF = (const bf16*)(ws + WS_YF); const bf16* PART = (const bf16*)(ws + WS_PART); float* XC = (float*)(ws + WS_XC);
    const int gw = blockIdx.x * NWAVES + wave, NGW = gridDim.x * NWAVES;
    const int nrows = (layer == 0) ? MT : NLAT;
    for (int m = gw; m < nrows; m += NGW) {
        const bool lat = m < NLAT; const int s = lat ? (m >> 12) : 4;
        const float* mod = MOD + (size_t)(layer * 5 + s) * 6144;
        float* xcur = lat ? a.out + (size_t)m * D : XC + (size_t)(m - NLAT) * D;
        if (mode == 0) {
            const float* xin = lat ? a.in[I_X] + (size_t)m * D : a.in[I_CTX] + (size_t)(m - NLAT) * D;
            row_op(xin, nullptr, 0, nullptr, nullptr, nullptr, a.in[I_GMPRE], mod, mod + 1024, H + (size_t)m * D, lane);
        } else if (mode == 1) {
            const float* xin = (layer == 0) ? (lat ? a.in[I_X] + (size_t)m * D : a.in[I_CTX] + (size_t)(m - NLAT) * D) : xcur;
            row_op(xin, (layer == 0 && !lat) ? PART + (size_t)(m - NLAT) * D : YF + (size_t)m * D, (layer == 0 && !lat) ? 4 : 1, a.in[I_GMPOST] + layer * D, mod + 2048, xcur, a.in[I_GFPRE] + layer * D, mod + 3072, mod + 4096, H + (size_t)m * D, lane);
        } else {
            if (layer == 0) { const float* mod1 = MOD + (size_t)(5 + s) * 6144;
                row_op(xcur, lat ? YF + (size_t)m * D : PART + (size_t)(m - NLAT) * D, lat ? 1 : 11, a.in[I_GFPOST], mod + 5120, xcur, a.in[I_GMPRE] + D, mod1, mod1 + 1024, H + (size_t)m * D, lane); }
            else row_op(xcur, YF + (size_t)m * D, 1, a.in[I_GFPOST] + D, mod + 5120, xcur, nullptr, nullptr, nullptr, nullptr, lane);
        }
    }
}

DI float xmax_quads(float x) {
    unsigned u = __float_as_uint(x);
    auto r = __builtin_amdgcn_permlane16_swap(u, u, false, false);
    u = __float_as_uint(fmaxf(__uint_as_float(r[0]), __uint_as_float(r[1])));
    auto r2 = __builtin_amdgcn_permlane32_swap(u, u, false, false);
    return fmaxf(__uint_as_float(r2[0]), __uint_as_float(r2[1]));
}
DI float xsum_quads(float x) {
    unsigned u = __float_as_uint(x);
    auto r = __builtin_amdgcn_permlane16_swap(u, u, false, false);
    u = __float_as_uint(__uint_as_float(r[0]) + __uint_as_float(r[1]));
    auto r2 = __builtin_amdgcn_permlane32_swap(u, u, false, false);
    return __uint_as_float(r2[0]) + __uint_as_float(r2[1]);
}
struct KVFrag { bf16x8 kf[2][2]; bf16x8 vf[4]; };
DI void kv_load(KVFrag& f, const bf16* kp, int kld, const bf16* vp, int vld, int fr, int fq) {
#pragma unroll
    for (int h = 0; h < 2; ++h)
#pragma unroll
        for (int ks = 0; ks < 2; ++ks) f.kf[h][ks] = *(const bf16x8*)(kp + (size_t)((fr >> 2) * 8 + h * 4 + (fr & 3)) * kld + ks * 32 + fq * 8);
#pragma unroll
    for (int nt = 0; nt < 4; ++nt) f.vf[nt] = *(const bf16x8*)(vp + (size_t)(nt * 16 + fr) * vld + fq * 8);
}
template <int MODE>
DI void attn_one(f32x4 (&o)[4], float& mrun, float& lrun, const bf16x8 (&qf)[2], const KVFrag& f, float sc2, int d0, unsigned okmask, const float (&bias)[8]) {
    f32x4 s0 = {0.f, 0.f, 0.f, 0.f}, s1 = {0.f, 0.f, 0.f, 0.f};
    s0 = MFMA16(f.kf[0][0], qf[0], s0); s0 = MFMA16(f.kf[0][1], qf[1], s0);
    s1 = MFMA16(f.kf[1][0], qf[0], s1); s1 = MFMA16(f.kf[1][1], qf[1], s1);
    float sv[8] = {s0[0], s0[1], s0[2], s0[3], s1[0], s1[1], s1[2], s1[3]};
    float mx = -1e30f;
#pragma unroll
    for (int i = 0; i < 8; ++i) {
        float t = sv[i] * sc2;
        if (MODE == 1) { const int dd = d0 - i; t = (dd >= -128 && dd <= 128) ? t : -1e30f; }
        if (MODE == 2) { t = ((okmask >> i) & 1u) ? t + bias[i] : -1e30f; }
        sv[i] = t; mx = fmaxf(mx, t);
    }
    mx = xmax_quads(mx);
    {
        const float mn = fmaxf(mrun, mx), alpha = fast_exp2(mrun - mn);
        lrun *= alpha; mrun = mn;
#pragma unroll
        for (int nt = 0; nt < 4; ++nt) o[nt] = o[nt] * alpha;
    }
    float p[8], ps = 0.f;
#pragma unroll
    for (int i = 0; i < 8; ++i) { p[i] = fast_exp2(sv[i] - mrun); ps += p[i]; }
    lrun += xsum_quads(ps);
    const bf16x8 pf = pack8(p);
#pragma unroll
    for (int nt = 0; nt < 4; ++nt) o[nt] = MFMA16(f.vf[nt], pf, o[nt]);
}
DI void attn_store1(const f32x4 (&o)[4], float lrun, bf16* op, int fq) {
    const float inv = 1.0f / lrun;
#pragma unroll
    for (int nt = 0; nt < 4; ++nt) { u32x2 w; w.x = pk2(o[nt][0] * inv, o[nt][1] * inv); w.y = pk2(o[nt][2] * inv, o[nt][3] * inv);
        *(u32x2*)(op + nt * 16 + fq * 4) = w; }
}

DI void window_attn_tile(const Args& a, int wt, int lane) {
    const bf16* P = (const bf16*)(a.ws + WS_P); const bf16* VtA = (const bf16*)(a.ws + WS_YF); bf16* O = (bf16*)(a.ws + WS_HO);
    const int fr = lane & 15, fq = lane >> 4;
    const bool isctx = wt >= 2048;
    int b, kvh, q0; size_t qrow;
    if (!isctx) { b = wt >> 9; kvh = (wt >> 8) & 1; q0 = (wt & 255) * 16; qrow = (size_t)b * SEQ + q0 + fr; }
    else { const int ct = wt - 2048; b = ct >> 5; kvh = (ct >> 4) & 1; q0 = (ct & 15) * 16; qrow = (size_t)NLAT + b * CTXL + q0 + fr; }
    bf16x8 qf[4][2]; f32x4 o[4][4]; float mrun[4], lrun[4];
#pragma unroll
    for (int g = 0; g < 4; ++g) {
#pragma unroll
        for (int ks = 0; ks < 2; ++ks) qf[g][ks] = *(const bf16x8*)(P + qrow * LDP0 + C_AQ + (kvh * 4 + g) * 64 + ks * 32 + fq * 8);
#pragma unroll
        for (int nt = 0; nt < 4; ++nt) o[g][nt] = (f32x4){0.f, 0.f, 0.f, 0.f};
        mrun[g] = a.in[I_SINK][kvh * 4 + g] * LOG2E; lrun[g] = 1.0f;
    }
    const float sc2 = 0.125f * LOG2E;
    const float nob[8] = {0.f, 0.f, 0.f, 0.f, 0.f, 0.f, 0.f, 0.f};
    const bf16* vbase = VtA + (size_t)((b * 2 + kvh) * 64) * KEYS;
    const bf16* kctx = P + (size_t)(NLAT + b * CTXL) * LDP0 + C_AK + kvh * 64;
    const bf16* kloc = P + (size_t)(b * SEQ) * LDP0 + C_AK + kvh * 64;
    const int tlo = (q0 - 128 > 0 ? q0 - 128 : 0) & ~31, thi = (q0 + 16 + 128 < SEQ) ? q0 + 16 + 128 : SEQ;
    const int ntile = isctx ? 8 : 8 + (thi - tlo + 31) / 32;
#define WIN_LOAD(F, t) do { const int t_ = (t); const int k0_ = t_ < 8 ? t_ * 32 : tlo + (t_ - 8) * 32; \
        kv_load(F, (t_ < 8 ? kctx : kloc) + (size_t)k0_ * LDP0, LDP0, vbase + (t_ < 8 ? SEQ : 0) + k0_, KEYS, fr, fq); } while (0)
#define WIN_PROC(F, t) do { const int t_ = (t); const int d0_ = t_ < 8 ? 0 : q0 + fr - (tlo + (t_ - 8) * 32) - fq * 8; \
        _Pragma("unroll") for (int g = 0; g < 4; ++g) attn_one<1>(o[g], mrun[g], lrun[g], qf[g], F, sc2, d0_, 0u, nob); } while (0)
    KVFrag A, B;
    WIN_LOAD(A, 0);
    for (int t = 0; t < ntile; t += 2) {
        WIN_LOAD(B, (t + 1 < ntile ? t + 1 : ntile - 1));
        WIN_PROC(A, t);
        WIN_LOAD(A, (t + 2 < ntile ? t + 2 : ntile - 1));
        if (t + 1 < ntile) WIN_PROC(B, t + 1);
    }
#undef WIN_LOAD
#undef WIN_PROC
#pragma unroll
    for (int g = 0; g < 4; ++g) attn_store1(o[g], lrun[g], O + qrow * D + (kvh * 4 + g) * 64, fq);
}

template <int NR>
DI void na_attn_group(const Args& a, int gid, int lane, LAS float* btab  ) {
    const bf16* P = (const bf16*)(a.ws + WS_P); const bf16* VtC = (const bf16*)(a.ws + WS_YF); bf16* O = (bf16*)(a.ws + WS_HO);
    const int fr = lane & 15, fq = lane >> 4;
    constexpr int NRG = 64 / NR; const int j = gid & 3, r0 = ((gid >> 2) % NRG) * NR, h = ((gid >> 2) / NRG) & 15, b = (gid >> 2) / (NRG * 16);
    { const float* relb = a.in[I_RELB] + h * 465;
      for (int i = lane; i < 465; i += 64) btab[i] = relb[i] * LOG2E;
      asm volatile("s_waitcnt vmcnt(0) lgkmcnt(0)" ::: "memory"); }
    bf16x8 qf[NR][2]; f32x4 o[NR][4]; float mrun[NR], lrun[NR];
#pragma unroll
    for (int qi = 0; qi < NR; ++qi) { const size_t qrow = (size_t)b * SEQ + (r0 + qi) * 64 + j * 16 + fr;
#pragma unroll
        for (int ks = 0; ks < 2; ++ks) qf[qi][ks] = *(const bf16x8*)(P + qrow * LDP1 + h * 64 + ks * 32 + fq * 8);
#pragma unroll
        for (int nt = 0; nt < 4; ++nt) o[qi][nt] = (f32x4){0.f, 0.f, 0.f, 0.f};
        mrun[qi] = -1e30f; lrun[qi] = 0.f; }
    const float sc2 = 0.125f * LOG2E;
    const float nob[8] = {0.f, 0.f, 0.f, 0.f, 0.f, 0.f, 0.f, 0.f};
    const bf16* vbase = VtC + (size_t)((b * 16 + h) * 64) * KEYS;
    const bf16* kctx = P + (size_t)(NLAT + b * CTXL) * LDP1 + 1024 + h * 64;
    const bf16* kloc = P + (size_t)(b * SEQ) * LDP1 + 1024 + h * 64;
    const int seg_start = j == 0 ? 0 : (j == 1 ? 8 : (j == 2 ? 24 : 32));
    const int qcol = j * 16 + fr; const int cs = qcol - 8 < 0 ? 0 : (qcol - 8 > 48 ? 48 : qcol - 8);
    unsigned okmask = 0u; int coloff[8];
#pragma unroll
    for (int i = 0; i < 8; ++i) { const int keycol = seg_start + fq * 8 + i; if (keycol >= cs && keycol < cs + 16) okmask |= 1u << i;
        int co = keycol - qcol + 15; co = co < 0 ? 0 : (co > 30 ? 30 : co); coloff[i] = co; }
    const int rsa = r0 - 4 < 0 ? 0 : (r0 - 4 > 56 ? 56 : r0 - 4);
    const int rsb = r0 + NR - 1 - 4 < 0 ? 0 : (r0 + NR - 1 - 4 > 56 ? 56 : r0 + NR - 1 - 4);
    const int nloc = rsb + 8 - rsa, ntile = 8 + nloc;
#define NA_LOAD(F, t) do { const int t_ = (t); const int k0_ = t_ < 8 ? t_ * 32 : (rsa + t_ - 8) * 64 + seg_start; \
        kv_load(F, (t_ < 8 ? kctx : kloc) + (size_t)k0_ * LDP1, LDP1, vbase + (t_ < 8 ? SEQ : 0) + k0_, KEYS, fr, fq); } while (0)
#define NA_PROC(F, t) do { const int t_ = (t); \
        if (t_ < 8) { _Pragma("unroll") for (int qi = 0; qi < NR; ++qi) attn_one<0>(o[qi], mrun[qi], lrun[qi], qf[qi], F, sc2, 0, 0u, nob); } \
        else { const int R_ = rsa + t_ - 8; \
            _Pragma("unroll") for (int qi = 0; qi < NR; ++qi) { const int r_ = r0 + qi; const int rs_ = r_ - 4 < 0 ? 0 : (r_ - 4 > 56 ? 56 : r_ - 4); \
                if (R_ >= rs_ && R_ < rs_ + 8) { const LAS float* rb_ = btab + (R_ - r_ + 7) * 31; float bias_[8]; \
                    _Pragma("unroll") for (int e = 0; e < 8; ++e) bias_[e] = rb_[coloff[e]]; \
                    attn_one<2>(o[qi], mrun[qi], lrun[qi], qf[qi], F, sc2, 0, okmask, bias_); } } } } while (0)
    if (NR <= 2) {
        KVFrag A, B;
        NA_LOAD(A, 0);
        for (int t = 0; t < ntile; t += 2) {
            NA_LOAD(B, (t + 1 < ntile ? t + 1 : ntile - 1));
            NA_PROC(A, t);
            NA_LOAD(A, (t + 2 < ntile ? t + 2 : ntile - 1));
            if (t + 1 < ntile) NA_PROC(B, t + 1);
        }
    } else {
        KVFrag A;
        for (int t = 0; t < ntile; ++t) { NA_LOAD(A, t); NA_PROC(A, t); }
    }
#undef NA_LOAD
#undef NA_PROC
#pragma unroll
    for (int qi = 0; qi < NR; ++qi) attn_store1(o[qi], lrun[qi], O + ((size_t)b * SEQ + (r0 + qi) * 64 + j * 16 + fr) * D + h * 64, fq);
}

constexpr int NA_KC = 0, NA_VC = 36864, NA_KR = 70656, NA_VR = 89088, NA_BT = 107520;
DI void kv_load_lds(KVFrag& f, const LAS unsigned short* kimg, const LAS unsigned short* vimg, int vpitch, int fr, int fq) {
#pragma unroll
    for (int h = 0; h < 2; ++h)
#pragma unroll
        for (int ks = 0; ks < 2; ++ks) f.kf[h][ks] = *(const LAS bf16x8*)(kimg + ((fr >> 2) * 8 + h * 4 + (fr & 3)) * 72 + ks * 32 + fq * 8);
#pragma unroll
    for (int nt = 0; nt < 4; ++nt) f.vf[nt] = *(const LAS bf16x8*)(vimg + (nt * 16 + fr) * vpitch + fq * 8);
}
DI void na_attn_unit(const Args& a, LAS unsigned char* lds, int unit, int tid, int lane, int wave) {
    const bf16* P = (const bf16*)(a.ws + WS_P); const bf16* VtC = (const bf16*)(a.ws + WS_YF); bf16* O = (bf16*)(a.ws + WS_HO);
    LAS unsigned short* KC = (LAS unsigned short*)(lds + NA_KC); LAS unsigned short* VC = (LAS unsigned short*)(lds + NA_VC);
    LAS unsigned short* KR = (LAS unsigned short*)(lds + NA_KR); LAS unsigned short* VR = (LAS unsigned short*)(lds + NA_VR); LAS float* bt = (LAS float*)(lds + NA_BT);
    const int fr = lane & 15, fq = lane >> 4;
    const int r0 = (unit & 15) * 4, h = (unit >> 4) & 15, b = unit >> 8;
    const int qr = r0 + (wave >> 1), jb = (wave & 1) * 2;
    const bf16* vglob = VtC + (size_t)((b * 16 + h) * 64) * KEYS;
    const bf16* kglob = P + (size_t)(b * SEQ) * LDP1 + 1024 + h * 64;
    const int rsa = r0 - 4 < 0 ? 0 : (r0 - 4 > 56 ? 56 : r0 - 4);
    const int rsb = r0 + 3 - 4 < 0 ? 0 : (r0 + 3 - 4 > 56 ? 56 : r0 + 3 - 4);
    const int nloc = rsb + 8 - rsa;
    for (int i = tid; i < 465; i += NTHR) bt[i] = a.in[I_RELB][h * 465 + i] * LOG2E;
    { const int row = tid >> 1, half = tid & 1; const bf16* src = P + (size_t)(NLAT + b * CTXL + row) * LDP1 + 1024 + h * 64 + half * 32;
#pragma unroll
      for (int i = 0; i < 4; ++i) *(LAS u32x4*)(KC + row * 72 + half * 32 + i * 8) = *(const u32x4*)(src + i * 8); }
    { const int d = tid >> 3, ch = tid & 7; const bf16* src = vglob + (size_t)d * KEYS + SEQ + ch * 32;
#pragma unroll
      for (int i = 0; i < 4; ++i) *(LAS u32x4*)(VC + d * 264 + ch * 32 + i * 8) = *(const u32x4*)(src + i * 8); }
    const int srow = tid >> 3, sch = (tid & 7) * 8;
    { const u32x4 kreg = *(const u32x4*)(kglob + (size_t)(rsa * 64 + srow) * LDP1 + sch), vreg = *(const u32x4*)(vglob + (size_t)srow * KEYS + rsa * 64 + sch);
      *(LAS u32x4*)(KR + srow * 72 + sch) = kreg; *(LAS u32x4*)(VR + srow * 72 + sch) = vreg; }
    bf16x8 qf[2][2]; f32x4 o[2][4]; float mrun[2], lrun[2];
#pragma unroll
    for (int qi = 0; qi < 2; ++qi) { const size_t qrow = (size_t)b * SEQ + qr * 64 + (jb + qi) * 16 + fr;
#pragma unroll
        for (int ks = 0; ks < 2; ++ks) qf[qi][ks] = *(const bf16x8*)(P + qrow * LDP1 + h * 64 + ks * 32 + fq * 8);
#pragma unroll
        for (int nt = 0; nt < 4; ++nt) o[qi][nt] = (f32x4){0.f, 0.f, 0.f, 0.f};
        mrun[qi] = -1e30f; lrun[qi] = 0.f; }
    const float sc2 = 0.125f * LOG2E;
    const float nob[8] = {0.f, 0.f, 0.f, 0.f, 0.f, 0.f, 0.f, 0.f};
    __syncthreads();
    for (int t8 = 0; t8 < 8; ++t8) { KVFrag F; kv_load_lds(F, KC + t8 * 32 * 72, VC + t8 * 32, 264, fr, fq);
#pragma unroll
        for (int qi = 0; qi < 2; ++qi) attn_one<0>(o[qi], mrun[qi], lrun[qi], qf[qi], F, sc2, 0, 0u, nob); }
    int seg_start[2], cbase[2]; unsigned okmask[2];
#pragma unroll
    for (int qi = 0; qi < 2; ++qi) { const int j = jb + qi; seg_start[qi] = j == 0 ? 0 : (j == 1 ? 8 : (j == 2 ? 24 : 32));
        const int qcol = j * 16 + fr; const int cs = qcol - 8 < 0 ? 0 : (qcol - 8 > 48 ? 48 : qcol - 8);
        unsigned m = 0u;
#pragma unroll
        for (int i = 0; i < 8; ++i) { const int keycol = seg_start[qi] + fq * 8 + i; if (keycol >= cs && keycol < cs + 16) m |= 1u << i; }
        okmask[qi] = m; cbase[qi] = seg_start[qi] + fq * 8 - qcol + 15; }
    const int rsq = qr - 4 < 0 ? 0 : (qr - 4 > 56 ? 56 : qr - 4);
    for (int t = 0; t < nloc; ++t) {
        const int R = rsa + t, cur = t & 1;
        u32x4 kreg = {0u, 0u, 0u, 0u}, vreg = {0u, 0u, 0u, 0u};
        if (t + 1 < nloc) { kreg = *(const u32x4*)(kglob + (size_t)((R + 1) * 64 + srow) * LDP1 + sch); vreg = *(const u32x4*)(vglob + (size_t)srow * KEYS + (R + 1) * 64 + sch); }
        if (R >= rsq && R < rsq + 8) {
            const LAS float* rb = bt + (R - qr + 7) * 31;
#pragma unroll
            for (int qi = 0; qi < 2; ++qi) { KVFrag F; kv_load_lds(F, KR + cur * 4608 + seg_start[qi] * 72, VR + cur * 4608 + seg_start[qi], 72, fr, fq);
                float bias[8];
#pragma unroll
                for (int e = 0; e < 8; ++e) { int co = cbase[qi] + e; co = co < 0 ? 0 : (co > 30 ? 30 : co); bias[e] = rb[co]; }
                attn_one<2>(o[qi], mrun[qi], lrun[qi], qf[qi], F, sc2, 0, okmask[qi], bias); }
        }
        if (t + 1 < nloc) { *(LAS u32x4*)(KR + (cur ^ 1) * 4608 + srow * 72 + sch) = kreg; *(LAS u32x4*)(VR + (cur ^ 1) * 4608 + srow * 72 + sch) = vreg; }
        __syncthreads();
    }
#pragma unroll
    for (int qi = 0; qi < 2; ++qi) attn_store1(o[qi], lrun[qi], O + ((size_t)b * SEQ + qr * 64 + (jb + qi) * 16 + fr) * D + h * 64, fq);
}

DI void vt_unit(const bf16* P, int ldp, int vcol, int nh, bf16* Vt, int unit, LAS unsigned char* scr, int lane) {
    const int kb = unit % 68, bh = unit / 68, h = bh % nh, b = bh / nh;
    const size_t row0 = kb < 64 ? (size_t)b * SEQ + kb * 64 : (size_t)NLAT + b * CTXL + (kb - 64) * 64;
    LAS unsigned short* t = (LAS unsigned short*)scr;
#pragma unroll
    for (int i = 0; i < 8; ++i) { const int key = (lane >> 3) + 8 * i, ch = lane & 7;
        const u32x4 v = *(const u32x4*)(P + (row0 + key) * ldp + vcol + h * 64 + ch * 8);
        *(LAS u32x4*)(t + key * 72 + ch * 8) = v; }
    asm volatile("s_waitcnt lgkmcnt(0)" ::: "memory");
    bf16* dst = Vt + (size_t)(bh * 64 + lane) * KEYS + kb * 64;
#pragma unroll
    for (int g8 = 0; g8 < 8; ++g8) { unsigned short e[8];
#pragma unroll
        for (int i = 0; i < 8; ++i) e[i] = t[(g8 * 8 + i) * 72 + lane];
        u32x4 w; w.x = e[0] | ((unsigned)e[1] << 16); w.y = e[2] | ((unsigned)e[3] << 16); w.z = e[4] | ((unsigned)e[5] << 16); w.w = e[6] | ((unsigned)e[7] << 16);
        *(u32x4*)(dst + g8 * 8) = w; }
    asm volatile("s_waitcnt lgkmcnt(0)" ::: "memory");
}

constexpr int L_GW = 0, L_CUM = 4608, L_A = 21248, L_B = 30464, L_ATT = 39680, L_VT = 48896, L_SSQ = 67328, L_TOT = 67840;
DI size_t chunk_row0(int b, int n) { return n < 64 ? (size_t)b * SEQ + n * 64 : (size_t)NLAT + b * CTXL + (n - 64) * 64; }
DI float* st_ptr(const Args& a, int seq, int n) { return n < 64 ? a.out + (size_t)(seq * 64 + n) * 8192 : (float*)(a.ws + WS_STC) + (size_t)(seq * 4 + (n - 64)) * 8192; }

DI void gla_cum(const Args& a, LAS unsigned char* lds, const bf16* P, size_t row0, int h, int dir, int tid) {
    LAS float* rfl = (LAS float*)(lds + L_GW); LAS float* tot = (LAS float*)(lds + L_TOT); LAS float* cum = (LAS float*)(lds + L_CUM);
    const float* gw = a.in[dir ? I_GBW : I_GFW]; const float* gb = a.in[dir ? I_GBB : I_GFB];
    const int lane = tid & 63, w = tid >> 6;
    { const int c = tid >> 3, r2 = (tid & 7) * 2; const unsigned v = *(const unsigned*)(P + (row0 + c) * LDP0 + (dir ? C_RB : C_RF) + r2);
      rfl[c * 16 + r2] = __uint_as_float(v << 16); rfl[c * 16 + r2 + 1] = __uint_as_float(v & 0xffff0000u); }
    float gwr[16];
#pragma unroll
    for (int r = 0; r < 16; ++r) gwr[r] = gw[r * 256 + h * 64 + lane];
    const float gbv = gb[h * 64 + lane];
    __syncthreads();
    float la[8];
#pragma unroll
    for (int i = 0; i < 8; ++i) { const int c = w * 8 + i; float x = gbv;
#pragma unroll
        for (int r = 0; r < 16; ++r) x += rfl[c * 16 + r] * gwr[r];
        la[i] = (fminf(x, 0.f) - __logf(1.0f + __expf(-fabsf(x)))) * (1.0f / 16.0f); }
    if (dir == 0) {
#pragma unroll
        for (int i = 1; i < 8; ++i) la[i] += la[i - 1];
        tot[w * 64 + lane] = la[7];
    } else {
#pragma unroll
        for (int i = 6; i >= 0; --i) la[i] += la[i + 1];
        tot[w * 64 + lane] = la[0];
    }
    __syncthreads();
    float off = 0.f;
#pragma unroll
    for (int w2 = 0; w2 < 8; ++w2) { const float t = tot[w2 * 64 + lane]; off += ((dir == 0) ? (w2 < w) : (w2 > w)) ? t : 0.f; }
#pragma unroll
    for (int i = 0; i < 8; ++i) cum[(w * 8 + i) * 65 + lane] = la[i] + off;
    __syncthreads();
}
DI void gla_load_vt(LAS unsigned char* lds, const bf16* P, size_t row0, int h, int tid) {
    LAS unsigned short* vT = (LAS unsigned short*)(lds + L_VT);
    const int c = tid >> 3, dg = tid & 7;
    const bf16* vp = P + (row0 + c) * LDP0 + C_BV + h * 128 + dg * 16;
    const bf16x8 v0 = *(const bf16x8*)vp, v1 = *(const bf16x8*)(vp + 8);
#pragma unroll
    for (int e = 0; e < 8; ++e) { vT[(dg * 16 + e) * 72 + c] = (unsigned short)v0[e]; vT[(dg * 16 + 8 + e) * 72 + c] = (unsigned short)v1[e]; }
}
DI void gla_g1_unit(const Args& a, LAS unsigned char* lds, int unit, int tid, int lane, int wave) {
    const bf16* P = (const bf16*)(a.ws + WS_P);
    const int n = unit % NCHUNK, seq = unit / NCHUNK, dir = seq & 1, h = (seq >> 1) & 3, b = seq >> 3;
    const size_t row0 = chunk_row0(b, n);
    const bf16x8 kraw = *(const bf16x8*)(P + (row0 + (tid >> 3)) * LDP0 + C_BK + h * 64 + (tid & 7) * 8);
    gla_load_vt(lds, P, row0, h, tid);
    gla_cum(a, lds, P, row0, h, dir, tid);
    LAS float* cum = (LAS float*)(lds + L_CUM); LAS unsigned short* kdT = (LAS unsigned short*)(lds + L_A); LAS unsigned short* vT = (LAS unsigned short*)(lds + L_VT);
    const int cend = dir ? 0 : 63;
    { const int c = tid >> 3, dg = tid & 7; float kk[8]; unpack8(kraw, kk);
#pragma unroll
      for (int dd = 0; dd < 8; ++dd) { const int d = dg * 8 + dd; const float v = kk[dd] * __expf(cum[cend * 65 + d] - cum[c * 65 + d]); kdT[d * 72 + c] = (unsigned short)(pk2(v, 0.f) & 0xffffu); } }
    if (tid < 64) ((float*)(a.ws + WS_DEC))[(size_t)(seq * NCHUNK + n) * 64 + tid] = __expf(cum[cend * 65 + tid]);
    __syncthreads();
    const int fr = lane & 15, fq = lane >> 4;
    bf16x8 av[2];
#pragma unroll
    for (int ks = 0; ks < 2; ++ks) av[ks] = *(const LAS bf16x8*)(vT + (wave * 16 + fr) * 72 + ks * 32 + fq * 8);
    float* st = st_ptr(a, seq, n);
#pragma unroll
    for (int nt = 0; nt < 4; ++nt) { f32x4 acc = {0.f, 0.f, 0.f, 0.f};
#pragma unroll
        for (int ks = 0; ks < 2; ++ks) { const bf16x8 bk = *(const LAS bf16x8*)(kdT + (nt * 16 + fr) * 72 + ks * 32 + fq * 8); acc = MFMA16(av[ks], bk, acc); }
#pragma unroll
        for (int r = 0; r < 4; ++r) st[(wave * 16 + fq * 4 + r) * 64 + nt * 16 + fr] = acc[r]; }
    __syncthreads();
}
DI void gla_scan(const Args& a, int tid) {
    const float* DEC = (const float*)(a.ws + WS_DEC);
    for (int e = blockIdx.x * NTHR + tid; e < 32 * 8192; e += gridDim.x * NTHR) {
        const int seq = e >> 13, el = e & 8191, dk = el & 63, dir = seq & 1;
        float S = 0.f;
        for (int s4 = 0; s4 < NCHUNK; s4 += 4) {
            float* p[4]; float t[4], dc[4];
#pragma unroll
            for (int i = 0; i < 4; ++i) { const int step = s4 + i; const int n = dir == 0 ? (step < 4 ? 64 + step : step - 4) : (step < 4 ? 67 - step : 67 - step);
                p[i] = st_ptr(a, seq, n) + el; t[i] = *p[i]; dc[i] = DEC[(size_t)(seq * NCHUNK + n) * 64 + dk]; }
#pragma unroll
            for (int i = 0; i < 4; ++i) { *p[i] = S; S = dc[i] * S + t[i]; }
        }
    }
}
DI void gla_g3_unit(const Args& a, LAS unsigned char* lds, int unit, int tid, int lane, int wave) {
    const bf16* P = (const bf16*)(a.ws + WS_P); bf16* O = (bf16*)(a.ws + WS_HO);
    const int n = unit % NCHUNK, bh = unit / NCHUNK, h = bh & 3, b = bh >> 2;
    const size_t row0 = chunk_row0(b, n);
    LAS float* cum = (LAS float*)(lds + L_CUM); LAS unsigned short* qg = (LAS unsigned short*)(lds + L_A); LAS unsigned short* kg = (LAS unsigned short*)(lds + L_B);
    LAS unsigned short* att = (LAS unsigned short*)(lds + L_ATT); LAS unsigned short* vT = (LAS unsigned short*)(lds + L_VT); LAS float* ssq = (LAS float*)(lds + L_SSQ);
    const int fr = lane & 15, fq = lane >> 4, ct = wave & 3, dvh = wave >> 2;
    gla_load_vt(lds, P, row0, h, tid);
    f32x4 acc[4];
#pragma unroll
    for (int nt = 0; nt < 4; ++nt) acc[nt] = (f32x4){0.f, 0.f, 0.f, 0.f};
    const bf16x8 qraw = *(const bf16x8*)(P + (row0 + (tid >> 3)) * LDP0 + C_BQ + h * 64 + (tid & 7) * 8), kraw = *(const bf16x8*)(P + (row0 + (tid >> 3)) * LDP0 + C_BK + h * 64 + (tid & 7) * 8);
    for (int dir = 0; dir < 2; ++dir) {
        const float* st = st_ptr(a, (bh * 2 + dir), n);
        f32x4 sraw[4][2][2];
#pragma unroll
        for (int nt = 0; nt < 4; ++nt)
#pragma unroll
            for (int ks = 0; ks < 2; ++ks) { const float* sp = st + ((dvh * 4 + nt) * 16 + fr) * 64 + ks * 32 + fq * 8; sraw[nt][ks][0] = *(const f32x4*)sp; sraw[nt][ks][1] = *(const f32x4*)(sp + 4); }
        gla_cum(a, lds, P, row0, h, dir, tid);
        { const int c = tid >> 3, dg = tid & 7; float qq[8], kk[8], oq[8], ok[8];
          unpack8(qraw, qq); unpack8(kraw, kk);
#pragma unroll
          for (int dd = 0; dd < 8; ++dd) { const float cu = cum[c * 65 + dg * 8 + dd]; oq[dd] = qq[dd] * 0.125f * __expf(cu); ok[dd] = kk[dd] * __expf(-cu); }
          *(LAS bf16x8*)(qg + c * 72 + dg * 8) = pack8(oq); *(LAS bf16x8*)(kg + c * 72 + dg * 8) = pack8(ok); }
        __syncthreads();
        bf16x8 bq[2];
#pragma unroll
        for (int ks = 0; ks < 2; ++ks) bq[ks] = *(const LAS bf16x8*)(qg + (ct * 16 + fr) * 72 + ks * 32 + fq * 8);
#pragma unroll
        for (int si = 0; si < 2; ++si) { const int st = dvh * 2 + si; f32x4 s = {0.f, 0.f, 0.f, 0.f};
#pragma unroll
            for (int ks = 0; ks < 2; ++ks) { const bf16x8 ak = *(const LAS bf16x8*)(kg + (st * 16 + fr) * 72 + ks * 32 + fq * 8); s = MFMA16(ak, bq[ks], s); }
            const int cpos = ct * 16 + fr; float pv[4];
#pragma unroll
            for (int r = 0; r < 4; ++r) { const int spos = st * 16 + fq * 4 + r; const bool keep = dir == 0 ? (spos <= cpos) : (spos >= cpos); pv[r] = keep ? s[r] : 0.f; }
            u32x2 w; w.x = pk2(pv[0], pv[1]); w.y = pk2(pv[2], pv[3]);
            *(LAS u32x2*)(att + cpos * 72 + st * 16 + fq * 4) = w; }
        __syncthreads();
        bf16x8 ba[2];
#pragma unroll
        for (int ks = 0; ks < 2; ++ks) ba[ks] = *(const LAS bf16x8*)(att + (ct * 16 + fr) * 72 + ks * 32 + fq * 8);
#pragma unroll
        for (int nt = 0; nt < 4; ++nt) { const int dvt = dvh * 4 + nt;
#pragma unroll
            for (int ks = 0; ks < 2; ++ks) {
                const bf16x8 av = *(const LAS bf16x8*)(vT + (dvt * 16 + fr) * 72 + ks * 32 + fq * 8);
                acc[nt] = MFMA16(av, ba[ks], acc[nt]);
                const f32x4 s0 = sraw[nt][ks][0], s1 = sraw[nt][ks][1];
                const float sf[8] = {s0[0], s0[1], s0[2], s0[3], s1[0], s1[1], s1[2], s1[3]};
                acc[nt] = MFMA16(pack8(sf), bq[ks], acc[nt]); } }
        __syncthreads();
    }
    float sq = 0.f;
#pragma unroll
    for (int nt = 0; nt < 4; ++nt) sq += (acc[nt][0] * acc[nt][0] + acc[nt][1] * acc[nt][1]) + (acc[nt][2] * acc[nt][2] + acc[nt][3] * acc[nt][3]);
    sq += __shfl_xor(sq, 16); sq += __shfl_xor(sq, 32);
    if (fq == 0) ssq[wave * 16 + fr] = sq;
    __syncthreads();
    const float tot = ssq[wave * 16 + fr] + ssq[(wave ^ 4) * 16 + fr];
    const float rstd = __builtin_amdgcn_rsqf(tot * (1.0f / 128.0f) + EPS);
    const size_t row = row0 + ct * 16 + fr;
#pragma unroll
    for (int nt = 0; nt < 4; ++nt) { const int dv0 = (dvh * 4 + nt) * 16 + fq * 4;
        const f32x4 g4 = *(const f32x4*)(a.in[I_GNORM] + h * 128 + dv0);
        const u32x2 bw = *(const u32x2*)(P + row * LDP0 + C_BO + h * 128 + dv0);
        const float g0 = __uint_as_float(bw.x << 16), g1 = __uint_as_float(bw.x & 0xffff0000u), g2 = __uint_as_float(bw.y << 16), g3 = __uint_as_float(bw.y & 0xffff0000u);
        u32x2 w; w.x = pk2(acc[nt][0] * rstd * g4[0] * silu_f(g0), acc[nt][1] * rstd * g4[1] * silu_f(g1));
        w.y = pk2(acc[nt][2] * rstd * g4[2] * silu_f(g2), acc[nt][3] * rstd * g4[3] * silu_f(g3));
        *(u32x2*)(O + row * D + 512 + h * 128 + dv0) = w; }
    __syncthreads();
}

DI void rope_row(bf16* prow, int t, int lane) {
    const int prow_pos = t >> 6, pcol_pos = t & 63;
#pragma unroll
    for (int i = 0; i < 5; ++i) { const int pi = lane + 64 * i, head = pi >> 5, rem = pi & 31, half = rem >> 4, j = rem & 15;
        const int c1 = head * 64 + half * 32 + j, pos = half ? pcol_pos : prow_pos;
        const float cs = ROPE_COS[pos * 16 + j], sn = ROPE_SIN[pos * 16 + j];
        const float u1 = bf2f(prow[c1]), u2 = bf2f(prow[c1 + 16]);
        prow[c1] = (unsigned short)(pk2(u1 * cs - u2 * sn, 0.f) & 0xffffu); prow[c1 + 16] = (unsigned short)(pk2(u2 * cs + u1 * sn, 0.f) & 0xffffu); }
}

constexpr int NPHASE = 19;
#ifndef NA_NR
#define NA_NR 2
#endif
#ifndef PROBE_MASK
#define PROBE_MASK 0u
#endif
#define REPS(k) (((PROBE_MASK >> (k)) & 1u) ? 2 : 1)
__global__ void __launch_bounds__(NTHR, 2) fwd_kernel(Args a) {
    extern __shared__ __attribute__((aligned(16))) unsigned char lds_raw[];
    LAS unsigned char* lds = (LAS unsigned char*)lds_raw;
    const int tid = threadIdx.x, lane = tid & 63, wave = __builtin_amdgcn_readfirstlane(tid >> 6);
    const int G = gridDim.x, gw = blockIdx.x * NWAVES + wave, NGW = G * NWAVES;
    unsigned char* ws = a.ws;
    const int lo = a.ph_lo, hi = a.ph_hi;
#define IN(k) (lo <= (k) && (k) < hi)
#ifndef PROBE_SYNC
#define PROBE_SYNC 1
#endif
    volatile LAS unsigned* MISC = (volatile LAS unsigned*)(lds + 131072 + 320);
    if (tid < 32) MISC[tid] = 0u;
    __syncthreads();
    unsigned* barw = (unsigned*)(ws + WS_CTL);
    XcdBarrier xbar; xbar.bar = barw; xbar.x = 0; xbar.st = MISC + 8;
    if (hi - lo > 1) {
        if (blockIdx.x == 0) { for (int i = tid; i < XCD_BAR_WORDS; i += NTHR) barw[i] = 0u; }
        cg::this_grid().sync();
        xbar = xcd_barrier_post(barw, MISC + 8);
    }
#define SEAM(k) do { if (IN(k) && IN((k) + 1)) { for (int sr_ = 0; sr_ < PROBE_SYNC; ++sr_) xcd_barrier(xbar); } } while (0)
    bf16* H = (bf16*)(ws + WS_HO); bf16* YF = (bf16*)(ws + WS_YF); bf16* P = (bf16*)(ws + WS_P);

    if (IN(0)) { for (int rep = 0; rep < REPS(0); ++rep) { phase_prologue(a, lds, tid, lane, wave); __syncthreads(); } } SEAM(0);
    if (IN(1)) { for (int rep = 0; rep < REPS(1); ++rep) phase_rows(a, 0, 0, lane, wave); } SEAM(1);
    if (IN(2)) { pg8::Gemm g{H, (const bf16*)(ws + WS_WABI), MT, LDP0, D, D}; pg8::StaticOrder S; S.init(MT, LDP0, G, (int)blockIdx.x);
        EpiStore E{P, LDP0}; pg8::gemm_phase<EpiStore, pg8::StaticOrder, true, true>(lds, g, S, E); if (REPS(2) > 1) { pg8::gemm_phase<EpiStore, pg8::StaticOrder, true, true>(lds, g, S, E); } } SEAM(2);
    if (IN(3)) {
        for (int rep = 0; rep < REPS(3); ++rep) for (int u = blockIdx.x; u < 32 * NCHUNK; u += G) gla_g1_unit(a, lds, u, tid, lane, wave);
        __syncthreads();
        for (int m = gw; m < NLAT; m += NGW) rope_row(P + (size_t)m * LDP0, m & 4095, lane);
        for (int u = gw; u < NBATCH * 2 * 68; u += NGW) vt_unit(P, LDP0, C_AV, 2, YF, u, lds + wave * 16384, lane);
    } SEAM(3);
    if (IN(4)) {
        for (int rep = 0; rep < REPS(4); ++rep) for (int wt = gw; wt < 2176; wt += NGW) window_attn_tile(a, wt, lane);
        gla_scan(a, tid);
    } SEAM(4);
    if (IN(5)) { for (int rep = 0; rep < REPS(5); ++rep) for (int u = blockIdx.x; u < 16 * NCHUNK; u += G) gla_g3_unit(a, lds, u, tid, lane, wave); } SEAM(5);
    if (IN(6)) { pg8::Gemm g{H, (const bf16*)(ws + WS_WABO), NLAT, D, D, D}; pg8::StaticOrder S; S.init(NLAT, D, G, (int)blockIdx.x);
        EpiStore E{YF, D}; pg8::gemm_phase<EpiStore, pg8::StaticOrder, true, true>(lds, g, S, E); if (REPS(6) > 1) { pg8::gemm_phase<EpiStore, pg8::StaticOrder, true, true>(lds, g, S, E); }
        { const int bx = (int)blockIdx.x, kc = bx >> 4, uu = bx & 15; OneUnit S1{uu >> 2, uu & 3, bx < 64};
          pg8::Gemm g1{H + (size_t)NLAT * D + kc * 256, (const bf16*)(ws + WS_WABO) + kc * 256, NCTX, D, D, 256};
          EpiStore E1{(bf16*)(ws + WS_PART) + (size_t)kc * NCTX * D, D}; pg8::gemm_phase<EpiStore, OneUnit, true, true>(lds, g1, S1, E1); } } SEAM(6);
    if (IN(7)) { for (int rep = 0; rep < REPS(7); ++rep) phase_rows(a, 1, 0, lane, wave); } SEAM(7);
    if (IN(8)) { pg8::Gemm g{H, (const bf16*)(ws + WS_WFI), MT, 2 * FF, D, D}; pg8::StaticOrder S; S.init(MT, 2 * FF, G, (int)blockIdx.x);
        EpiSwiglu E{P, FF}; pg8::gemm_phase<EpiSwiglu, pg8::StaticOrder, true, true>(lds, g, S, E); if (REPS(8) > 1) { pg8::gemm_phase<EpiSwiglu, pg8::StaticOrder, true, true>(lds, g, S, E); } } SEAM(8);
    if (IN(9)) { pg8::Gemm g{P, (const bf16*)(ws + WS_WFO), NLAT, D, FF, FF}; pg8::StaticOrder S; S.init(NLAT, D, G, (int)blockIdx.x);
        EpiStore E{YF, D}; pg8::gemm_phase<EpiStore, pg8::StaticOrder, true, true>(lds, g, S, E); if (REPS(9) > 1) { pg8::gemm_phase<EpiStore, pg8::StaticOrder, true, true>(lds, g, S, E); }
        { const int bx = (int)blockIdx.x, kc = bx >> 4, uu = bx & 15; OneUnit S1{uu >> 2, uu & 3, bx < 176};
          pg8::Gemm g1{P + (size_t)NLAT * FF + kc * 256, (const bf16*)(ws + WS_WFO) + kc * 256, NCTX, D, FF, 256};
          EpiStore E1{(bf16*)(ws + WS_PART) + (size_t)kc * NCTX * D, D}; pg8::gemm_phase<EpiStore, OneUnit, true, true>(lds, g1, S1, E1); } } SEAM(9);
    if (IN(10)) { phase_rows(a, 2, 0, lane, wave); } SEAM(10);
    if (IN(11)) { pg8::Gemm g{H, (const bf16*)(ws + WS_WNI), MT, LDP1, D, D}; pg8::StaticOrder S; S.init(MT, LDP1, G, (int)blockIdx.x);
        EpiStore E{P, LDP1}; pg8::gemm_phase<EpiStore, pg8::StaticOrder, true, true>(lds, g, S, E); if (REPS(11) > 1) { pg8::gemm_phase<EpiStore, pg8::StaticOrder, true, true>(lds, g, S, E); } } SEAM(11);
    if (IN(12)) { for (int rep = 0; rep < REPS(12); ++rep) for (int u = gw; u < NBATCH * 16 * 68; u += NGW) vt_unit(P, LDP1, 2048, 16, YF, u, lds + wave * 16384, lane); } SEAM(12);
    if (IN(13)) { for (int rep = 0; rep < REPS(13); ++rep) for (int u = blockIdx.x; u < 1024; u += G) na_attn_unit(a, lds, u, tid, lane, wave); } SEAM(13);
    if (IN(14)) { pg8::Gemm g{H, (const bf16*)(ws + WS_WNO), NLAT, D, D, D}; pg8::StaticOrder S; S.init(NLAT, D, G, (int)blockIdx.x);
        EpiStore E{YF, D}; pg8::gemm_phase<EpiStore, pg8::StaticOrder, true, true>(lds, g, S, E); if (REPS(14) > 1) { pg8::gemm_phase<EpiStore, pg8::StaticOrder, true, true>(lds, g, S, E); } } SEAM(14);
    if (IN(15)) { phase_rows(a, 1, 1, lane, wave); } SEAM(15);
    if (IN(16)) { pg8::Gemm g{H, (const bf16*)(ws + WS_WFI) + (size_t)5632 * 1024, NLAT, 2 * FF, D, D}; pg8::StaticOrder S; S.init(NLAT, 2 * FF, G, (int)blockIdx.x);
        EpiSwiglu E{P, FF}; pg8::gemm_phase<EpiSwiglu, pg8::StaticOrder, true, true>(lds, g, S, E); if (REPS(16) > 1) { pg8::gemm_phase<EpiSwiglu, pg8::StaticOrder, true, true>(lds, g, S, E); } } SEAM(16);
    if (IN(17)) { pg8::Gemm g{P, (const bf16*)(ws + WS_WFO) + (size_t)1024 * FF, NLAT, D, FF, FF}; pg8::StaticOrder S; S.init(NLAT, D, G, (int)blockIdx.x);
        EpiStore E{YF, D}; pg8::gemm_phase<EpiStore, pg8::StaticOrder, true, true>(lds, g, S, E); if (REPS(17) > 1) { pg8::gemm_phase<EpiStore, pg8::StaticOrder, true, true>(lds, g, S, E); } } SEAM(17);
    if (IN(18)) { phase_rows(a, 2, 1, lane, wave); }
#undef IN
#undef SEAM
}

extern "C" void kernel_launch(void* const* d_in, const int* in_sizes, int n_in, void* d_out, int out_size, void* d_ws, size_t ws_size, hipStream_t stream) {
    static int grid = 0;
    if (grid == 0) {
        if (n_in != 23 || out_size != NLAT * D || ws_size < WS_END) { fprintf(stderr, "kernel_launch: unexpected problem shape (n_in %d, out %d, ws %zu)\n", n_in, out_size, ws_size); grid = -1; return; }
        int dev = 0, cus = 0, per_cu = 0;
        (void)hipGetDevice(&dev); (void)hipDeviceGetAttribute(&cus, hipDeviceAttributeMultiprocessorCount, dev);
        if (hipFuncSetAttribute((const void*)fwd_kernel, hipFuncAttributeMaxDynamicSharedMemorySize, LDS_BYTES) != hipSuccess) { fprintf(stderr, "kernel_launch: hipFuncSetAttribute failed\n"); grid = -1; return; }
        (void)hipOccupancyMaxActiveBlocksPerMultiprocessor(&per_cu, (const void*)fwd_kernel, NTHR, LDS_BYTES);
        if (per_cu < 1) per_cu = 1;
        (void)hipGetLastError();
        grid = cus * per_cu;
    }
    if (grid < 0) return;
    Args a{};
    for (int i = 0; i < 23; ++i) a.in[i] = (const float*)d_in[i];
    a.out = (float*)d_out; a.ws = (unsigned char*)d_ws;
#if COOP
    a.ph_lo = 0; a.ph_hi = NPHASE;
    void* args[] = {&a};
    hipError_t e = hipLaunchCooperativeKernel((const void*)fwd_kernel, dim3(grid), dim3(NTHR), args, LDS_BYTES, stream);
    if (e != hipSuccess) fprintf(stderr, "cooperative launch failed: %s (grid %d)\n", hipGetErrorString(e), grid);
#else
    for (int p = 0; p < NPHASE; ++p) { a.ph_lo = p; a.ph_hi = p + 1; hipLaunchKernelGGL(fwd_kernel, dim3(grid), dim3(NTHR), LDS_BYTES, stream, a); }
#endif
}
```

```cpp
#include <hip/hip_runtime.h>
#include <hip/hip_cooperative_groups.h>
#include <cstdio>
#include <cstdint>
namespace cg = cooperative_groups;
namespace pg8 {
#define PG8_LAS __attribute__((address_space(3)))
typedef unsigned short bf16_t;
typedef short bf16x8 __attribute__((ext_vector_type(8)));
typedef float f32x4 __attribute__((ext_vector_type(4)));
typedef unsigned u32x4 __attribute__((ext_vector_type(4)));
constexpr int BM = 256, BK = 64, HALF = 128, HTB = HALF * BK * 2  , STAGE_BYTES = 8 * HTB, NXCD = 8, WGM = 8;

__host__ __device__ __forceinline__ int lds_byte(int r, int c) { const int st = (r >> 4) * 2 + (c >> 5), rr = r & 15, cc = c & 31, ob = rr * 64 + cc * 2; return st * 1024 + (ob ^ (((ob >> 9) & 1) << 5)); }
__host__ __device__ __forceinline__ void stage_rc(int b, int& R, int& C) { const int st = b / 1024, sb = b % 1024, swz = sb ^ (((sb >> 9) & 1) << 5); R = (st >> 1) * 16 + swz / 64; C = (st & 1) * 32 + (swz % 64) / 2; }
__host__ __device__ __forceinline__ int perm32(int rho) { const int n = rho >> 4, i = rho & 15; return 8 * (i >> 2) + 4 * n + (i & 3); }

struct Unit { int pm, pn; };
struct Gemm { const bf16_t* A; const bf16_t* Bt; int M, N, K, Kext; };

struct StaticOrder {
    int nM, nN, nwg, G, c;
    __host__ __device__ void init(int M, int N, int G_, int c_) { nM = M / BM; nN = N / BM; nwg = nM * nN; G = G_; c = c_; }
    __host__ __device__ bool next(int i, Unit& u) const {
        const long L = (long)i * G + c; if (L >= nwg) return false;
        int wgid = (int)L; { const int q = nwg / NXCD, r = nwg % NXCD, xcd = wgid % NXCD, off = wgid / NXCD; wgid = (xcd < r ? xcd * (q + 1) : r * (q + 1) + (xcd - r) * q) + off; }
        const int nig = WGM * nN, gid = wgid / nig, fm = gid * WGM, gsz = (nM - fm) < WGM ? (nM - fm) : WGM;
        u.pm = fm + ((wgid % nig) % gsz); u.pn = (wgid % nig) / gsz; return true;
    }
    __device__ __forceinline__ void a_ready(const Unit&) const {}
    __device__ __forceinline__ void done(const Unit&) const {}
};

__device__ __forceinline__ unsigned cvt_pk_bf16(float lo, float hi) { unsigned r; asm volatile("v_cvt_pk_bf16_f32 %0, %1, %2" : "=v"(r) : "v"(lo), "v"(hi)); return r; }
template <class Epi, class Sched, bool ALIGN_EPI = false, bool SP2 = false>
__device__ __forceinline__ void gemm_phase(PG8_LAS unsigned char* lds, const Gemm g, const Sched& S, const Epi& E) {
    const int tid = threadIdx.x, wid = __builtin_amdgcn_readfirstlane(tid >> 6), lane = tid & 63, wr = wid >> 2, wc = wid & 3, fr = lane & 15, fq = lane >> 4;
    const int K = g.K, nt = g.Kext / BK;
    unsigned voffA[2], voffB[2];
#pragma unroll
    for (int i = 0; i < 2; ++i) { int R, C; stage_rc(tid * 16 + i * 8192, R, C); const int Rb = Epi::PERM ? ((R & ~31) + perm32(R & 31)) : R;
        voffA[i] = (unsigned)(R * K + C) * 2u; voffB[i] = (unsigned)(Rb * K + C) * 2u; }
    const size_t kstep = (size_t)(BK * 2);
    const size_t hstep = (size_t)HALF * K * 2;
    const size_t tstep = 2 * hstep;
    const unsigned ldsw = (unsigned)wid * 1024u;
    const int aoff = lds_byte(wr * 64 + fr, fq * 8), boff = lds_byte(wc * 32 + fr, fq * 8);
#define PG8_SA(b, h) (((b) * 2 + (h)) * HTB)
#define PG8_SB(b, h) ((4 + (b) * 2 + (h)) * HTB)
#define PG8_STAGE(bufoff, gbase, voff) do { _Pragma("unroll") for (int _i = 0; _i < 2; ++_i) \
        __builtin_amdgcn_global_load_lds((const unsigned*)((const char*)(gbase) + (voff)[_i]), (PG8_LAS unsigned*)(lds + (bufoff) + ldsw + _i * 8192), 16, 0, 0); } while (0)
#define PG8_LDA(dst, b, h) do { _Pragma("unroll") for (int m = 0; m < 4; ++m) _Pragma("unroll") for (int k = 0; k < 2; ++k) dst[m][k] = *(const PG8_LAS bf16x8*)(lds + PG8_SA(b, h) + aoff + m * 2048 + k * 1024); } while (0)
#define PG8_LDB(dst, b, h) do { _Pragma("unroll") for (int n = 0; n < 2; ++n) _Pragma("unroll") for (int k = 0; k < 2; ++k) dst[n][k] = *(const PG8_LAS bf16x8*)(lds + PG8_SB(b, h) + boff + n * 2048 + k * 1024); } while (0)
#define PG8_MMA(ai, bj, At, Bt) do { __builtin_amdgcn_s_setprio(1); _Pragma("unroll") for (int m = 0; m < 4; ++m) _Pragma("unroll") for (int n = 0; n < 2; ++n) _Pragma("unroll") for (int k = 0; k < 2; ++k) \
        acc[ai][bj][m][n] = __builtin_amdgcn_mfma_f32_16x16x32_bf16(Bt[n][k], At[m][k], acc[ai][bj][m][n], 0, 0, 0); __builtin_amdgcn_s_setprio(0); } while (0)
#define PG8_WAIT_V(n) asm volatile("s_waitcnt vmcnt(" #n ")" ::: "memory")
#define PG8_WAIT_L(n) asm volatile("s_waitcnt lgkmcnt(" #n ")" ::: "memory")
#define PG8_BAR __builtin_amdgcn_s_barrier()
#define PG8_SCHED __builtin_amdgcn_sched_barrier(0)
    Unit cur, nxt; int ui = 0;
    if (!S.next(0, cur)) return;
    f32x4 acc[2][2][4][2];
#pragma unroll
    for (int a = 0; a < 2; ++a)
#pragma unroll
        for (int b = 0; b < 2; ++b)
#pragma unroll
            for (int m = 0; m < 4; ++m)
#pragma unroll
                for (int n = 0; n < 2; ++n) acc[a][b][m][n] = (f32x4){0.f, 0.f, 0.f, 0.f};
    bf16x8 At[4][2], B0[2][2], B1[2][2];
    const char* cA = (const char*)g.A + (size_t)cur.pm * tstep; const char* cB = (const char*)g.Bt + (size_t)cur.pn * tstep;
    S.a_ready(cur);
    if constexpr (SP2) {
        PG8_STAGE(PG8_SB(0, 0), cB, voffB); PG8_STAGE(PG8_SB(0, 1), cB + hstep, voffB); PG8_STAGE(PG8_SA(0, 0), cA, voffA); PG8_STAGE(PG8_SA(0, 1), cA + hstep, voffA);
        if (wr == 1) PG8_BAR;
        PG8_WAIT_V(2); PG8_BAR;
        PG8_STAGE(PG8_SB(1, 0), cB + kstep, voffB); PG8_STAGE(PG8_SA(1, 0), cA + kstep, voffA); PG8_STAGE(PG8_SB(1, 1), cB + hstep + kstep, voffB);
        PG8_WAIT_V(6); PG8_BAR;
    } else {
        PG8_STAGE(PG8_SB(0, 0), cB, voffB); PG8_STAGE(PG8_SA(0, 0), cA, voffA); PG8_STAGE(PG8_SB(0, 1), cB + hstep, voffB); PG8_STAGE(PG8_SA(0, 1), cA + hstep, voffA);
        if (wr == 1) PG8_BAR;
        PG8_WAIT_V(4); PG8_BAR;
        PG8_STAGE(PG8_SB(1, 0), cB + kstep, voffB); PG8_STAGE(PG8_SA(1, 0), cA + kstep, voffA); PG8_STAGE(PG8_SB(1, 1), cB + hstep + kstep, voffB);
        PG8_WAIT_V(6); PG8_BAR;
    }
    for (;;) {
        const bool has_next = S.next(ui + 1, nxt);
        const char* nA = has_next ? (const char*)g.A + (size_t)nxt.pm * tstep : cA; const char* nB = has_next ? (const char*)g.Bt + (size_t)nxt.pn * tstep : cB;
        for (int t = 0; t < nt; t += 2) {
            const bool last = (t == nt - 2);
            const char* a1 = cA + (size_t)(t + 1) * kstep;
            const char* a2 = last ? nA : cA + (size_t)(t + 2) * kstep; const char* b2 = last ? nB : cB + (size_t)(t + 2) * kstep;
            const char* a3 = a2 + kstep; const char* b3 = b2 + kstep;
            if (last && has_next) S.a_ready(nxt);
            if constexpr (SP2) {
            PG8_LDB(B0, 0, 0); PG8_LDB(B1, 0, 1); PG8_SCHED; PG8_LDA(At, 0, 0); PG8_STAGE(PG8_SA(1, 1), a1 + hstep, voffA);
            PG8_WAIT_V(8); PG8_WAIT_L(0); PG8_BAR; PG8_MMA(0, 0, At, B0); PG8_MMA(0, 1, At, B1); PG8_BAR; PG8_SCHED;
            PG8_LDA(At, 0, 1); PG8_STAGE(PG8_SB(0, 0), b2, voffB); PG8_STAGE(PG8_SB(0, 1), b2 + hstep, voffB); PG8_STAGE(PG8_SA(0, 0), a2, voffA);
            PG8_WAIT_V(8); PG8_WAIT_L(0); PG8_BAR; PG8_MMA(1, 0, At, B0); PG8_MMA(1, 1, At, B1); PG8_BAR; PG8_SCHED;
            PG8_LDB(B0, 1, 0); PG8_LDB(B1, 1, 1); PG8_SCHED; PG8_LDA(At, 1, 0); PG8_STAGE(PG8_SA(0, 1), a2 + hstep, voffA);
            PG8_WAIT_V(8); PG8_WAIT_L(0); PG8_BAR; PG8_MMA(0, 0, At, B0); PG8_MMA(0, 1, At, B1); PG8_BAR; PG8_SCHED;
            PG8_LDA(At, 1, 1); PG8_STAGE(PG8_SB(1, 0), b3, voffB); PG8_STAGE(PG8_SB(1, 1), b3 + hstep, voffB); PG8_STAGE(PG8_SA(1, 0), a3, voffA);
            PG8_WAIT_V(8); PG8_WAIT_L(0); PG8_BAR; PG8_MMA(1, 0, At, B0); PG8_MMA(1, 1, At, B1); PG8_BAR; PG8_SCHED;
            } else {
            PG8_LDB(B0, 0, 0); PG8_SCHED; PG8_LDA(At, 0, 0); PG8_STAGE(PG8_SA(1, 1), a1 + hstep, voffA);
            PG8_WAIT_L(8); PG8_BAR; PG8_WAIT_L(0); PG8_MMA(0, 0, At, B0); PG8_BAR; PG8_SCHED;
            PG8_LDB(B1, 0, 1); PG8_STAGE(PG8_SB(0, 0), b2, voffB);
            PG8_BAR; PG8_WAIT_L(0); PG8_MMA(0, 1, At, B1); PG8_BAR;
            PG8_LDA(At, 0, 1); PG8_STAGE(PG8_SA(0, 0), a2, voffA);
            PG8_BAR; PG8_WAIT_L(0); PG8_MMA(1, 0, At, B0); PG8_BAR; PG8_SCHED;
            PG8_STAGE(PG8_SB(0, 1), b2 + hstep, voffB);
            PG8_WAIT_V(6); PG8_BAR; PG8_MMA(1, 1, At, B1); PG8_BAR;
            PG8_LDB(B0, 1, 0); PG8_SCHED; PG8_LDA(At, 1, 0); PG8_STAGE(PG8_SA(0, 1), a2 + hstep, voffA);
            PG8_WAIT_L(8); PG8_BAR; PG8_WAIT_L(0); PG8_MMA(0, 0, At, B0); PG8_BAR; PG8_SCHED;
            PG8_LDB(B1, 1, 1); PG8_STAGE(PG8_SB(1, 0), b3, voffB);
            PG8_BAR; PG8_WAIT_L(0); PG8_MMA(0, 1, At, B1); PG8_BAR;
            PG8_LDA(At, 1, 1); PG8_STAGE(PG8_SA(1, 0), a3, voffA);
            PG8_BAR; PG8_WAIT_L(0); PG8_MMA(1, 0, At, B0); PG8_BAR; PG8_SCHED;
            PG8_STAGE(PG8_SB(1, 1), b3 + hstep, voffB);
            PG8_WAIT_V(6); PG8_BAR; PG8_MMA(1, 1, At, B1); PG8_BAR;
            }
        }
        if constexpr (ALIGN_EPI) { if (wr == 0) PG8_BAR; }
        if constexpr (!Epi::AFTER_DRAIN) { E(acc, cur, wr, wc, fr, fq); S.done(cur); }
        if (!has_next) break;
#pragma unroll
        for (int a = 0; a < 2; ++a)
#pragma unroll
            for (int b = 0; b < 2; ++b)
#pragma unroll
                for (int m = 0; m < 4; ++m)
#pragma unroll
                    for (int n = 0; n < 2; ++n) acc[a][b][m][n] = (f32x4){0.f, 0.f, 0.f, 0.f};
        cur = nxt; cA = nA; cB = nB; ++ui;
        if constexpr (ALIGN_EPI) { if (wr == 1) PG8_BAR; }
    }
    PG8_WAIT_V(0);
    if constexpr (!ALIGN_EPI) { if (wr == 0) PG8_BAR; }
    PG8_BAR;
    if constexpr (Epi::AFTER_DRAIN) { E.fused(acc, cur, wr, wc, fr, fq, lds, wid, lane); S.done(cur); }
#undef PG8_SA
#undef PG8_SB
#undef PG8_STAGE
#undef PG8_LDA
#undef PG8_LDB
#undef PG8_MMA
#undef PG8_WAIT_V
#undef PG8_WAIT_L
#undef PG8_BAR
#undef PG8_SCHED
}
}
__device__ const float ROPE_COS[1024] = {1.f,1.f,1.f,1.f,1.f,1.f,1.f,1.f,1.f,1.f,1.f,1.f,1.f,1.f,1.f,1.f,0.540302277f,0.846009135f,0.950415254f,0.98423022f,0.995004177f,0.998419285f,0.999500036f,0.999841869f,0.999949992f,0.999984205f,0.999994993f,0.999998391f,0.999999523f,0.999999821f,0.99999994f,1.f,-0.416146845f,0.431462824f,0.806578398f,0.937418282f,0.980066597f,0.993682086f,0.998000681f,0.999367595f,0.999800026f,0.999936759f,0.999979973f,0.999993682f,0.999997973f,0.999999344f,0.999999821f,0.99999994f,-0.989992499f,-0.115966164f,0.582753658f,0.861040652f,0.955336511f,0.985803485f,0.995503366f,0.998577297f,0.999550045f,0.999857724f,0.999954998f,0.999985754f,0.99999553f,0.999998569f,0.999999523f,0.999999881f,-0.653643608f,-0.627679706f,0.301137477f,0.757506192f,0.921060979f,0.974808276f,0.992010653f,0.997471273f,0.999200106f,0.999747038f,0.999920011f,0.999974728f,0.999992013f,0.999997497f,0.999999225f,0.999999762f,0.2836622f,-0.946079254f,-0.0103423381f,0.630080283f,0.87758255f,0.960731268f,0.987526f,0.996049762f,0.998750269f,0.999604762f,0.999875009f,0.999960482f,0.999987483f,0.999996066f,0.999998748f,0.999999583f,0.960170269f,-0.973103702f,-0.3207964f,0.482782036f,0.825335622f,0.943616986f,0.982053936f,0.9943133f,0.998200536f,0.999430835f,0.999819994f,0.999943078f,0.999981999f,0.999994338f,0.999998212f,0.999999404f,0.753902256f,-0.700429797f,-0.599437475f,0.320257008f,0.764842212f,0.923519433f,0.975599885f,0.992262423f,0.997551024f,0.999225318f,0.999755025f,0.999922514f,0.999975502f,0.999992251f,0.999997556f,0.999999225f,-0.145500034f,-0.212036446f,-0.818632424f,0.147631213f,0.696706712f,0.900502324f,0.968170285f,0.989897788f,0.996801734f,0.998988271f,0.999680042f,0.999898791f,0.999967992f,0.999989867f,0.999996781f,0.999998987f,-0.91113025f,0.341660261f,-0.956644177f,-0.0296507962f,0.621609926f,0.874638259f,0.959772646f,0.987220109f,0.995952725f,0.998719573f,0.999595046f,0.99987191f,0.999959528f,0.999987185f,0.999995947f,0.999998748f,-0.839071512f,0.790131867f,-0.999786079f,-0.205997631f,0.540302277f,0.846009135f,0.950415313f,0.98423022f,0.995004177f,0.998419285f,0.999500036f,0.999841869f,0.999949992f,0.999984205f,0.999994993f,0.999998391f,0.00442569796f,0.995257378f,-0.943779767f,-0.375847399f,0.453596085f,0.814705312f,0.940107584f,0.980929136f,0.993956089f,0.998087406f,0.999395072f,0.999808669f,0.999939501f,0.999980867f,0.99999392f,0.999998093f,0.843853951f,0.893861592f,-0.79417938f,-0.53384304f,0.362357706f,0.780825913f,0.92885989f,0.97731787f,0.99280864f,0.997723997f,0.999280095f,0.99977231f,0.999927998f,0.999977231f,0.999992788f,0.999997735f,0.907446802f,0.517172873f,-0.565820515f,-0.675001681f,0.267498761f,0.744477987f,0.916683376f,0.973397553f,0.99156189f,0.997329056f,0.999155104f,0.999732792f,0.999915481f,0.999973297f,0.999991536f,0.999997318f,0.136737213f,-0.0187961515f,-0.28134948f,-0.794870913f,0.16996716f,0.705776393f,0.903590262f,0.969169438f,0.990216017f,0.996902585f,0.999020159f,0.999690115f,0.99990201f,0.999969006f,0.999990225f,0.999996901f,-0.759687901f,-0.548975468f,0.0310223512f,-0.889670432f,0.070737198f,0.6648435f,0.889593601f,0.964634836f,0.988771081f,0.996444523f,0.998875201f,0.999644279f,0.999887526f,0.999964416f,0.999988735f,0.999996424f,-0.957659483f,-0.910081089f,0.340318173f,-0.95641005f,-0.0291995462f,0.621808827f,0.87470746f,0.959795177f,0.987227261f,0.99595499f,0.998720288f,0.999595284f,0.999872029f,0.999959528f,0.999987185f,0.999995947f,-0.275163352f,-0.990897954f,0.615864813f,-0.99298501f,-0.128844544f,0.576808274f,0.858946681f,0.954652011f,0.985584795f,0.995433986f,0.998555362f,0.999543071f,0.999855518f,0.999954283f,0.999985576f,0.99999541f,0.660316706f,-0.766536534f,0.830336154f,-0.998241663f,-0.227202162f,0.529984176f,0.842327058f,0.949207008f,0.983843684f,0.994881511f,0.998380423f,0.999487758f,0.999837995f,0.9999488f,0.999983788f,0.999994874f,0.988704622f,-0.306095392f,0.962463796f,-0.972014248f,-0.323289543f,0.481484592f,0.824865162f,0.943461835f,0.982004225f,0.994297504f,0.998195529f,0.999429286f,0.999819517f,0.999942899f,0.99998194f,0.999994278f,0.408082068f,0.248616725f,0.999144375f,-0.91512996f,-0.416146845f,0.431462824f,0.806578457f,0.937418282f,0.980066597f,0.993682086f,0.998000681f,0.999367595f,0.999800026f,0.999936759f,0.999979973f,0.999993682f,-0.547729254f,0.726760268f,0.936740458f,-0.829382956f,-0.504846215f,0.380077004f,0.787485182f,0.931078374f,0.97803092f,0.993035257f,0.99779582f,0.999302804f,0.999779522f,0.999930263f,0.999977946f,0.999993026f,-0.99996084f,0.981074572f,0.781440377f,-0.717477441f,-0.588501155f,0.327489585f,0.767604589f,0.92444396f,0.975897431f,0.992357016f,0.997581005f,0.999234855f,0.999758005f,0.999923468f,0.999975801f,0.999992371f,-0.53283304f,0.933235765f,0.548645258f,-0.582943261f,-0.666275978f,0.273866832f,0.746956408f,0.917517304f,0.97366637f,0.991647422f,0.997356176f,0.999163687f,0.999735534f,0.999916375f,0.999973536f,0.999991655f,0.424179018f,0.597977161f,0.261441678f,-0.430023283f,-0.737393796f,0.219378278f,0.725561321f,0.910300434f,0.971337974f,0.990906477f,0.997121394f,0.99908942f,0.99971199f,0.999908924f,0.999971211f,0.99999088f,0.991202831f,0.078552261f,-0.0516893305f,-0.263540596f,-0.801143587f,0.164196163f,0.703440726f,0.902795732f,0.968912423f,0.99013412f,0.996876657f,0.999011934f,0.999687493f,0.999901175f,0.999968767f,0.999990106f,0.64691931f,-0.465064496f,-0.359694332f,-0.0887455046f,-0.856888831f,0.108494945f,0.680616796f,0.895005584f,0.966389954f,0.98933053f,0.996621907f,0.998931348f,0.999662042f,0.999893129f,0.999966204f,0.999989331f,-0.292138815f,-0.865450621f,-0.632028639f,0.088848114f,-0.904072165f,0.0524506159f,0.6571123f,0.886932373f,0.963770926f,0.988495648f,0.996357203f,0.998847544f,0.999635518f,0.999884725f,0.999963522f,0.999988496f,-0.962605894f,-0.999293387f,-0.841684937f,0.26363951f,-0.942222297f,-0.00375941908f,0.632950664f,0.878578722f,0.961055458f,0.987629473f,0.996082544f,0.998760641f,0.99960804f,0.999876022f,0.99996078f,0.999987602f,-0.748057544f,-0.825371623f,-0.967871487f,0.430115849f,-0.970958173f,-0.0599575676f,0.608156204f,0.869947195f,0.958243906f,0.986732066f,0.995797932f,0.998670578f,0.999579549f,0.999867022f,0.999957979f,0.999986708f,0.154251456f,-0.397251874f,-0.998075247f,0.583026946f,-0.989992499f,-0.115966164f,0.582753658f,0.861040652f,0.955336511f,0.985803485f,0.995503366f,0.998577297f,0.999550045f,0.999857724f,0.999954998f,0.999985754f,0.914742351f,0.153215483f,-0.929300308f,0.717549205f,-0.999135137f,-0.171608135f,0.556768358f,0.851861775f,0.95233357f,0.984843671f,0.995198846f,0.998480916f,0.999519527f,0.999848068f,0.999951959f,0.999984801f,0.83422339f,0.656495154f,-0.768367112f,0.829440355f,-0.998294771f,-0.226707578f,0.53022635f,0.842413545f,0.949235439f,0.983852804f,0.994884372f,0.998381376f,0.999488056f,0.999838114f,0.9999488f,0.999983788f,-0.0132767474f,0.95758605f,-0.531235278f,0.915171385f,-0.987479806f,-0.281090319f,0.503154159f,0.832698941f,0.946042359f,0.982830763f,0.994559944f,0.998278618f,0.999455571f,0.999827802f,0.999945521f,0.999982774f,-0.848570287f,0.963757515f,-0.241421118f,0.972038329f,-0.966798186f,-0.334584385f,0.475578904f,0.822721004f,0.942754686f,0.981777668f,0.994225562f,0.99817276f,0.999422073f,0.999817252f,0.999942183f,0.999981701f,-0.903692186f,0.673110247f,0.0723346695f,0.998247743f,-0.93645668f,-0.387020677f,0.447528064f,0.812482953f,0.939372718f,0.980693519f,0.993881226f,0.998063743f,0.999387562f,0.999806345f,0.999938726f,0.999980628f,-0.127963692f,0.175156534f,0.378916174f,0.992972851f,-0.896758378f,-0.438233554f,0.419029742f,0.801987886f,0.935896814f,0.979578316f,0.993526995f,0.997951567f,0.999352098f,0.999795079f,0.99993521f,0.999979496f,0.765414059f,-0.376742303f,0.647921681f,0.95638001f,-0.848100007f,-0.488060862f,0.39011243f,0.791239262f,0.93232733f,0.978432178f,0.993162811f,0.997836173f,0.99931556f,0.999783576f,0.999931574f,0.999978364f,0.955073655f,-0.812611222f,0.852673113f,0.889623463f,-0.790967762f,-0.536345184f,0.360805035f,0.780240417f,0.928664625f,0.977255106f,0.992788672f,0.997717679f,0.999278069f,0.999771714f,0.999927819f,0.999977171f,0.266642928f,-0.998210371f,0.972865343f,0.794808388f,-0.72593224f,-0.582933903f,0.331136853f,0.768994927f,0.924909055f,0.976047099f,0.99240464f,0.997596025f,0.999239624f,0.999759495f,0.999923944f,0.999975979f,-0.666938066f,-0.87637943f,0.996578991f,0.674925625f,-0.653643608f,-0.627679706f,0.301137596f,0.757506192f,0.921060979f,0.974808276f,0.992010653f,0.997471273f,0.999200106f,0.999747038f,0.999920011f,0.999974728f,-0.987339258f,-0.484639406f,0.921462357f,0.533756077f,-0.574824035f,-0.670441091f,0.270837069f,0.745777905f,0.917120814f,0.973538578f,0.991606772f,0.997343302f,0.999159634f,0.999734223f,0.999915957f,0.999973416f,-0.399985313f,0.0563609414f,0.754965365f,0.375752151f,-0.490260571f,-0.711082935f,0.240265876f,0.733813822f,0.913088918f,0.972238123f,0.991192937f,0.997212172f,0.999118149f,0.99972111f,0.999911785f,0.999972105f,0.555113316f,0.580003142f,0.513598442f,0.205897167f,-0.400799006f,-0.749476731f,0.209454417f,0.721617639f,0.908965766f,0.970906913f,0.990769207f,0.997077882f,0.999075651f,0.999707639f,0.999907553f,0.999970794f,0.999843299f,0.925014675f,0.221298173f,0.0295478199f,-0.307332784f,-0.785501122f,0.178433523f,0.709193349f,0.904751658f,0.969545007f,0.990335584f,0.996940494f,0.99903214f,0.99969393f,0.999903202f,0.999969363f,0.52532196f,0.985138178f,-0.0929481089f,-0.147732988f,-0.210795805f,-0.819042206f,0.147234216f,0.696544766f,0.90044713f,0.968152404f,0.989892066f,0.996799886f,0.998987675f,0.999679863f,0.999898732f,0.999967992f,-0.432177931f,0.741858006f,-0.397976756f,-0.320354372f,-0.112152621f,-0.849993885f,0.115887694f,0.683675885f,0.89605248f,0.966729224f,0.989438653f,0.996656179f,0.998942196f,0.999665439f,0.999894202f,0.999966562f,-0.992335498f,0.270098448f,-0.663538277f,-0.48287195f,-0.0123883775f,-0.878258407f,0.0844252855f,0.670590878f,0.891568303f,0.965275466f,0.988975346f,0.996509314f,0.998895705f,0.999650776f,0.999889553f,0.999965072f,-0.640144348f,-0.284846604f,-0.863296509f,-0.630159974f,0.0874991715f,-0.903746367f,0.0528784581f,0.657293737f,0.886994898f,0.963791192f,0.988502085f,0.996359289f,0.9988482f,0.999635756f,0.999884784f,0.999963582f,0.300592542f,-0.75206399f,-0.977442741f,-0.757573068f,0.18651247f,-0.926377118f,0.0212787576f,0.643788815f,0.882332861f,0.962276459f,0.98801899f,0.996206105f,0.998799741f,0.999620378f,0.999879956f,0.999962032f,0.964965999f,-0.987659097f,-0.994656444f,-0.861092687f,0.2836622f,-0.946079254f,-0.0103422189f,0.630080283f,0.87758255f,0.960731268f,0.987526f,0.996049762f,0.998750269f,0.999604762f,0.999875009f,0.999960482f,0.742154181f,-0.919073522f,-0.913230121f,-0.937454224f,0.377977669f,-0.96279037f,-0.0419528559f,0.616172493f,0.872744501f,0.959155679f,0.987023175f,0.99589026f,0.998699784f,0.999588788f,0.999869943f,0.999958873f,-0.162990779f,-0.567430019f,-0.741239965f,-0.984248459f,0.468516916f,-0.976457715f,-0.0735215396f,0.602069914f,0.86781919f,0.95754981f,0.986510456f,0.995727658f,0.998648286f,0.999572515f,0.999864817f,0.999957263f,-0.918282807f,-0.0410281904f,-0.495741814f,-1.f,0.554374516f,-0.987038016f,-0.105016708f,0.587776959f,0.862807095f,0.955913603f,0.985987842f,0.995561838f,0.998595834f,0.999555886f,0.999859571f,0.999955595f,-0.829309821f,0.498009592f,-0.201079622f,-0.984212041f,0.634692967f,-0.994497895f,-0.136406869f,0.573298037f,0.857708693f,0.954247177f,0.985455394f,0.995392919f,0.998542368f,0.999538958f,0.999854207f,0.999953866f,0.0221267566f,0.883669317f,0.113521777f,-0.937382519f,0.708669782f,-0.998813629f,-0.167660639f,0.558637917f,0.852524519f,0.95255059f,0.984913111f,0.99522084f,0.99848789f,0.999521732f,0.999848783f,0.999952197f,0.853220105f,0.997174621f,0.416867077f,-0.860988438f,0.775565803f,-0.999971747f,-0.198746875f,0.543801069f,0.847255111f,0.950823903f,0.984360933f,0.995045662f,0.998432398f,0.999504209f,0.99984318f,0.999950409f,0.899866819f,0.803569078f,0.678870201f,-0.757439196f,0.834712923f,-0.997968495f,-0.22963427f,0.528792322f,0.841901004f,0.949067116f,0.983798921f,0.994867265f,0.998375952f,0.999486327f,0.999837577f,0.999948621f,0.119180135f,0.362476677f,0.873550534f,-0.63000071f,0.885519624f,-0.99281019f,-0.260292053f,0.513616323f,0.836462677f,0.947280347f,0.983227074f,0.994685769f,0.998318493f,0.999468148f,0.999831796f,0.999946833f,-0.771080196f,-0.1902491f,0.981602073f,-0.482692331f,0.927478492f,-0.984513164f,-0.290689558f,0.498277903f,0.830940723f,0.945463598f,0.982645452f,0.994501114f,0.998260021f,0.99944967f,0.999825954f,0.999944985f,-0.952412963f,-0.684381902f,0.992308319f,-0.320159167f,0.960170269f,-0.973103702f,-0.3207964f,0.482782036f,0.825335622f,0.943616986f,0.982053936f,0.9943133f,0.998200536f,0.999430835f,0.999819994f,0.999943078f,-0.258101642f,-0.967739642f,0.904607594f,-0.1475292f,0.98326844f,-0.958617806f,-0.350582451f,0.467133403f,0.819648027f,0.941740453f,0.981452644f,0.994122326f,0.998140097f,0.999411702f,0.999813974f,0.99994117f,0.673507154f,-0.953050017f,0.727198064f,0.0297537707f,0.996542096f,-0.941101313f,-0.380017966f,0.451337039f,0.813878477f,0.939834237f,0.980841517f,0.993928254f,0.998078644f,0.999392271f,0.999807835f,0.999939203f,0.985896587f,-0.644837022f,0.477671444f,0.206098333f,0.999858618f,-0.920609534f,-0.409073502f,0.435397953f,0.808027506f,0.937898219f,0.980220556f,0.993731022f,0.998016179f,0.999372482f,0.999801576f,0.999937236f};
__device__ const float ROPE_SIN[1024] = {0.f,0.f,0.f,0.f,0.f,0.f,0.f,0.f,0.f,0.f,0.f,0.f,0.f,0.f,0.f,0.f,0.841470957f,0.533168435f,0.310983598f,0.176892191f,0.0998334214f,0.0562044978f,0.0316175036f,0.0177818574f,0.00999983307f,0.00562338345f,0.00316227227f,0.0017782785f,0.000999999931f,0.000562341243f,0.000316227757f,0.00017782794f,0.909297407f,0.902130723f,0.591127098f,0.348205268f,0.198669329f,0.112231314f,0.0632033944f,0.0355580896f,0.0199986659f,0.011246589f,0.00632451288f,0.00355655141f,0.0019999987f,0.00112468237f,0.000632455456f,0.00035565588f,0.141120002f,0.993253171f,0.812648892f,0.5085361f,0.295520216f,0.167903304f,0.0947260857f,0.0533230826f,0.0299954992f,0.0168694388f,0.00948669016f,0.00533481315f,0.0029999956f,0.00168702309f,0.000948683126f,0.000533483806f,-0.756802499f,0.778471708f,0.953580737f,0.652827978f,0.389418334f,0.223044485f,0.126154065f,0.0710712075f,0.0399893336f,0.0224917568f,0.0126487734f,0.00711305765f,0.00399998948f,0.00224936334f,0.00126491068f,0.000711311703f,-0.958924294f,0.32393527f,0.999946535f,0.776529968f,0.47942555f,0.277480543f,0.157455876f,0.0887968615f,0.0499791652f,0.0281133614f,0.0158107281f,0.00889127981f,0.0049999794f,0.0028117029f,0.00158113812f,0.000889139599f,-0.279415488f,-0.230367512f,0.947148204f,0.875740528f,0.564642489f,0.33103931f,0.188600272f,0.106494442f,0.0599640049f,0.0337340795f,0.0189725272f,0.0106694745f,0.0059999642f,0.00337404152f,0.00189736532f,0.00106696738f,0.656986594f,-0.713721275f,0.800421596f,0.947330713f,0.64421767f,0.383551568f,0.219556093f,0.124158338f,0.0699428469f,0.0393537246f,0.0221341345f,0.0124476347f,0.00699994294f,0.00393637875f,0.00221359241f,0.00124479528f,0.989358246f,-0.977261782f,0.574317753f,0.989042461f,0.717356086f,0.434851229f,0.250292331f,0.141782969f,0.0799146891f,0.0449721329f,0.0252955221f,0.0142257558f,0.0079999147f,0.00449871505f,0.00252981926f,0.00142262306f,0.412118495f,-0.939823508f,0.291259229f,0.999560297f,0.783326924f,0.484776139f,0.280778319f,0.159362778f,0.0898785442f,0.0505891182f,0.0284566563f,0.0160038304f,0.00899987947f,0.00506105041f,0.00284604589f,0.00160045072f,-0.54402113f,-0.612936914f,-0.0206835698f,0.978552461f,0.841470957f,0.533168435f,0.310983568f,0.176892191f,0.099833414f,0.0562044978f,0.0316175036f,0.0177818574f,0.009999834f,0.00562338345f,0.00316227227f,0.0017782785f,-0.999990225f,-0.0972764567f,-0.33057496f,0.926681578f,0.891207397f,0.579875171f,0.340877861f,0.19436565f,0.1097783f,0.0618181042f,0.0347780399f,0.0195598267f,0.0109997792f,0.00618571462f,0.00347849843f,0.00195610616f,-0.536572933f,0.448342979f,-0.60768342f,0.845583618f,0.932039082f,0.624748647f,0.370431304f,0.211777672f,0.119712204f,0.0674297586f,0.0379382223f,0.0213377345f,0.0119997123f,0.0067480444f,0.00379472389f,0.00213393359f,0.420167029f,0.855880976f,-0.824528456f,0.737816215f,0.963558197f,0.667647004f,0.399614304f,0.229122713f,0.129634142f,0.0730392784f,0.0410980321f,0.0231155735f,0.0129996343f,0.00731037185f,0.00411094911f,0.00231176103f,0.990607381f,0.999823332f,-0.959605396f,0.606778562f,0.985449731f,0.708434701f,0.428397775f,0.246395305f,0.139543116f,0.078646481f,0.0442574248f,0.0248933397f,0.0139995432f,0.00787269697f,0.00442717411f,0.00248958869f,0.650287867f,0.835838437f,-0.999518692f,0.456603259f,0.997494996f,0.746982634f,0.456752867f,0.263589978f,0.149438128f,0.0842512026f,0.0474163815f,0.0266710296f,0.0149994381f,0.00843502022f,0.00474339863f,0.00266741589f,-0.287903309f,0.414430231f,-0.940310359f,0.292027086f,0.999573588f,0.783169091f,0.484651238f,0.280701309f,0.159318209f,0.0898532644f,0.0505748577f,0.028448632f,0.015999319f,0.00899733976f,0.00505962269f,0.00284524332f,-0.961397469f,-0.134615138f,-0.78785187f,0.11824052f,0.991664827f,0.81687957f,0.512064993f,0.29772386f,0.169182345f,0.09545248f,0.0537328273f,0.0302261449f,0.0169991814f,0.00955965649f,0.00537584582f,0.00302307028f,-0.750987232f,-0.642200708f,-0.557262897f,-0.0592755191f,0.973847628f,0.84800756f,0.538966715f,0.314652264f,0.179029569f,0.101048686f,0.0568902642f,0.0320035629f,0.0179990288f,0.0101219704f,0.00569206895f,0.00320089748f,0.149877205f,-0.952000856f,-0.271410108f,-0.234921798f,0.946300089f,0.876454532f,0.565329552f,0.331481189f,0.188858896f,0.10664168f,0.060047131f,0.0337808803f,0.0189988576f,0.0106842816f,0.00600829115f,0.00337872445f,0.912945271f,-0.968601942f,0.0413582884f,-0.403158993f,0.909297407f,0.902130723f,0.591127038f,0.348205268f,0.198669314f,0.112231314f,0.0632033944f,0.0355580896f,0.0199986678f,0.011246589f,0.00632451288f,0.00355655141f,0.836655617f,-0.686891198f,0.35002476f,-0.558680534f,0.863209307f,0.924954832f,0.616333544f,0.364819258f,0.208459899f,0.117817394f,0.0663590282f,0.0373351872f,0.0209984574f,0.0118088927f,0.00664073415f,0.00373437814f,-0.00885130931f,-0.193630233f,0.623979926f,-0.696581721f,0.808496356f,0.944854796f,0.640923738f,0.381317884f,0.218229622f,0.123399742f,0.0695140064f,0.0391121693f,0.0219982266f,0.0123711927f,0.00695695449f,0.00391220488f,-0.846220434f,0.359264523f,0.836055279f,-0.812512875f,0.745705247f,0.961767614f,0.664873064f,0.397695929f,0.227977514f,0.128978193f,0.0726682767f,0.0408890247f,0.0229979735f,0.0129334899f,0.00727317436f,0.00409003161f,-0.905578375f,0.801513135f,0.965219259f,-0.902817786f,0.67546314f,0.97563988f,0.688157499f,0.413948208f,0.237702623f,0.134552568f,0.0758218244f,0.0426657498f,0.0239976961f,0.0134957815f,0.0075893933f,0.00426785741f,-0.132351756f,0.996909976f,0.998663187f,-0.964648306f,0.598472118f,0.986427724f,0.710753918f,0.430069596f,0.247403964f,0.140122697f,0.0789746121f,0.0444423407f,0.0249973964f,0.0140580693f,0.00790561177f,0.00444568414f,0.76255846f,0.885276794f,0.933070183f,-0.996054351f,0.515501261f,0.994096994f,0.732639611f,0.446054995f,0.257080555f,0.145688385f,0.0821266174f,0.0462187938f,0.0259970706f,0.0146203535f,0.00822182931f,0.00462350994f,0.956375957f,0.500994205f,0.774945021f,-0.996045172f,0.427379847f,0.99862349f,0.753792703f,0.46189931f,0.266731411f,0.151249468f,0.0852777958f,0.0479951017f,0.0269967206f,0.015182632f,0.00853804592f,0.00480133574f,0.270905793f,-0.0375856608f,0.539968967f,-0.964621305f,0.334988207f,0.999992907f,0.774192095f,0.477597594f,0.276355654f,0.156805754f,0.0884281173f,0.049771253f,0.0279963426f,0.0157449059f,0.0088542616f,0.00497916201f,-0.663633883f,-0.564589798f,0.251445323f,-0.902773678f,0.239249229f,0.998200953f,0.793817401f,0.49314484f,0.28595221f,0.162357092f,0.0915775672f,0.0515472479f,0.0289959367f,0.0163071752f,0.00917047635f,0.00515698735f,-0.988031626f,-0.917709649f,-0.0620148405f,-0.812452853f,0.141120002f,0.993253171f,0.812648892f,0.5085361f,0.295520186f,0.167903304f,0.0947260931f,0.0533230826f,0.029995501f,0.0168694388f,0.00948669016f,0.00533481315f,-0.404037654f,-0.988192797f,-0.369325012f,-0.696507812f,0.0415805206f,0.985165298f,0.830667794f,0.523766637f,0.305058628f,0.173444211f,0.0978736654f,0.055098746f,0.0309950355f,0.0174316969f,0.00980290305f,0.00551263802f,0.551426709f,-0.754330218f,-0.640009403f,-0.5585953f,-0.0583741926f,0.973962843f,0.847856104f,0.538831532f,0.314566553f,0.17897962f,0.101020269f,0.0568742342f,0.0319945402f,0.0179939512f,0.0101191159f,0.00569046335f,0.999911845f,-0.28814739f,-0.847224355f,-0.403064936f,-0.157745644f,0.959681332f,0.864196658f,0.553726017f,0.324043006f,0.184509367f,0.10416586f,0.0586495437f,0.0329940096f,0.0185561981f,0.010435327f,0.00586828869f,0.529082716f,0.266779721f,-0.97042042f,-0.234822124f,-0.255541205f,0.942365825f,0.879673064f,0.568445385f,0.333487093f,0.190033287f,0.107310407f,0.0604246669f,0.0339934528f,0.0191184394f,0.010751537f,0.00604611309f,-0.428182662f,0.739542127f,-0.997380435f,-0.0591726787f,-0.350783229f,0.92207104f,0.894269884f,0.582984984f,0.342897803f,0.195551202f,0.110453881f,0.0621996038f,0.034992855f,0.0196806751f,0.0110677453f,0.00622393796f,-0.991778851f,0.984540582f,-0.925431013f,0.118342586f,-0.442520559f,0.89886117f,0.907972515f,0.597340286f,0.352274209f,0.201062918f,0.113596253f,0.0639743358f,0.0359922275f,0.0202429052f,0.0113839535f,0.0064017619f,-0.643538117f,0.926318109f,-0.761706948f,0.292125374f,-0.529836178f,0.872809589f,0.920767248f,0.611506701f,0.361615449f,0.206568271f,0.116737492f,0.0657488778f,0.036991559f,0.0208051261f,0.0117001599f,0.0065795863f,0.296368569f,0.58280617f,-0.522444785f,0.456694692f,-0.611857831f,0.84399873f,0.932641268f,0.625479698f,0.370920479f,0.212067112f,0.119877554f,0.0675232038f,0.0379908569f,0.0213673431f,0.0120163653f,0.00675741071f,0.963795364f,0.0598003156f,-0.231372014f,0.606860459f,-0.687766254f,0.81251961f,0.943582714f,0.639254928f,0.380188406f,0.217559248f,0.123016424f,0.0692973137f,0.0389901139f,0.0219295528f,0.0123325698f,0.00693523418f,0.745113134f,-0.481621295f,0.0826458037f,0.737885714f,-0.756802499f,0.778471708f,0.953580678f,0.652827978f,0.389418334f,0.223044485f,0.126154065f,0.0710712075f,0.0399893373f,0.0224917568f,0.0126487734f,0.00711305765f,-0.158622667f,-0.874714017f,0.388467699f,0.845638454f,-0.818277061f,0.74196279f,0.962625206f,0.666194677f,0.39860931f,0.228522688f,0.129290432f,0.0728448778f,0.0409885161f,0.0230539497f,0.0129649751f,0.00729088066f,-0.916521549f,-0.998410463f,0.655764699f,0.926720202f,-0.871575892f,0.703108132f,0.970707119f,0.679350674f,0.407760441f,0.233993664f,0.132425532f,0.0746183172f,0.0419876575f,0.0236161388f,0.0132811759f,0.00746870413f,-0.831774771f,-0.814614236f,0.858030677f,0.97857362f,-0.916166008f,0.662030637f,0.977818429f,0.692291796f,0.416870773f,0.23945722f,0.135559291f,0.0763915181f,0.0429867506f,0.0241783205f,0.0135973748f,0.00764652714f,0.0177019257f,-0.37993139f,0.975206196f,0.999563396f,-0.951602101f,0.618860185f,0.983951986f,0.70501405f,0.425939471f,0.244913206f,0.138691694f,0.0781644881f,0.0439858064f,0.0247404929f,0.0139135728f,0.00782434922f,0.850903511f,0.171763569f,0.995670974f,0.989027262f,-0.977530122f,0.57373327f,0.989101648f,0.717513323f,0.434965521f,0.250361472f,0.141822711f,0.0799371973f,0.0449848175f,0.0253026579f,0.0142297689f,0.00800217129f,0.901788354f,0.670557022f,0.917395473f,0.947297752f,-0.993690968f,0.526792526f,0.993262351f,0.72978574f,0.44394809f,0.255801797f,0.144952312f,0.0817096606f,0.0459837839f,0.0258648153f,0.0145459641f,0.0081799943f,0.123573124f,0.962832689f,0.748142362f,0.875690997f,-0.999923289f,0.478186339f,0.996429801f,0.741827428f,0.452886283f,0.261234075f,0.148080453f,0.0834818557f,0.0469827019f,0.0264269635f,0.0148621574f,0.00835781638f,-0.768254638f,0.958573103f,0.504697084f,0.776465356f,-0.99616462f,0.428068399f,0.99860096f,0.753634512f,0.461779177f,0.266658038f,0.151207119f,0.0852537975f,0.0479815714f,0.0269891042f,0.0151783489f,0.00853563752f,-0.953752637f,0.659090102f,0.211200655f,0.652750373f,-0.982452571f,0.376597136f,0.999773562f,0.765203178f,0.470625877f,0.272073567f,0.15433228f,0.087025471f,0.0489803962f,0.0275512375f,0.0154945394f,0.0087134596f,-0.262374848f,0.156619072f,-0.10324046f,0.508447945f,-0.958924294f,0.32393527f,0.999946535f,0.776529968f,0.47942555f,0.277480543f,0.157455891f,0.0887968615f,0.0499791689f,0.0281133596f,0.0158107281f,0.00889127981f,0.670229197f,-0.394086063f,-0.407444149f,0.3481085f,-0.925814748f,0.270249337f,0.99911958f,0.787611187f,0.48817724f,0.282878697f,0.160577938f,0.0905679762f,0.0509778969f,0.0286754742f,0.0161269177f,0.00906910095f,0.986627579f,-0.823421597f,-0.671240151f,0.176790684f,-0.883454502f,0.215709001f,0.997293651f,0.798443377f,0.496880114f,0.28826794f,0.163698375f,0.0923388004f,0.051976569f,0.0292375814f,0.0164431017f,0.00924692024f,0.395925164f,-0.999157965f,-0.868469954f,-0.000103020677f,-0.832267344f,0.160486728f,0.994470477f,0.809023023f,0.505533338f,0.293648034f,0.166817173f,0.0941093415f,0.0529751927f,0.0297996756f,0.0167592876f,0.00942474138f,-0.558789074f,-0.867171526f,-0.979574919f,-0.176993474f,-0.772764444f,0.104756832f,0.990652919f,0.819346905f,0.514135957f,0.29901889f,0.169934288f,0.0958795771f,0.0539737605f,0.0303617641f,0.0170754679f,0.00960256159f,-0.999755144f,-0.468111664f,-0.993535519f,-0.348301649f,-0.705540299f,0.0486960001f,0.985844791f,0.829411685f,0.522687256f,0.304380238f,0.173049718f,0.0976495072f,0.0549722798f,0.0309238415f,0.01739165f,0.00978038087f,-0.521551013f,0.0751182064f,-0.908967435f,-0.508624554f,-0.631266713f,-0.00751878507f,0.980050862f,0.839214146f,0.531186223f,0.30973196f,0.17616342f,0.0994191393f,0.0559707358f,0.0314859077f,0.0177078284f,0.00995820016f,0.436164767f,0.595211506f,-0.734258294f,-0.652905703f,-0.550685287f,-0.0637097955f,0.973276973f,0.848751247f,0.539632022f,0.315073937f,0.179275364f,0.101188451f,0.0569691435f,0.0320479684f,0.0180240069f,0.0101360194f,0.992872655f,0.931992829f,-0.486733496f,-0.776594579f,-0.464602023f,-0.119699396f,0.965529919f,0.858020008f,0.548023939f,0.3204059f,0.182385504f,0.102957435f,0.0579674877f,0.0326100141f,0.0183401816f,0.0103138378f,0.636738002f,0.981735826f,-0.190938011f,-0.87579f,-0.373876572f,-0.175310582f,0.956817448f,0.867017388f,0.55636102f,0.325727791f,0.185493827f,0.104726106f,0.0589657798f,0.0331720486f,0.0186563563f,0.0104916561f,-0.304810613f,0.729123712f,0.12379095f,-0.947363734f,-0.279415488f,-0.230367512f,0.947148204f,0.875740528f,0.564642429f,0.33103931f,0.188600287f,0.106494442f,0.0599640086f,0.0337340795f,0.0189725272f,0.0106694745f,-0.966117799f,0.251952261f,0.426245421f,-0.98905772f,-0.182162598f,-0.284696162f,0.936531842f,0.884186864f,0.572867453f,0.336340427f,0.191704854f,0.108262435f,0.0609621815f,0.0342960916f,0.0192886982f,0.0108472919f,-0.739180684f,-0.302812874f,0.686427653f,-0.999557257f,-0.0830891207f,-0.338124752f,0.924979091f,0.892353535f,0.581035137f,0.341630876f,0.194807529f,0.110030092f,0.0619602874f,0.0348580964f,0.0196048655f,0.0110251084f,0.167355701f,-0.764320076f,0.878538549f,-0.978531301f,0.0168140903f,-0.390484393f,0.912501454f,0.900238097f,0.589144766f,0.346910536f,0.197908238f,0.111797392f,0.0629583374f,0.0354200937f,0.0199210308f,0.0112029258f};
#define LAS __attribute__((address_space(3)))
#define XB_TMO      128
#define XB_XCNT(j)  (256  + 64 * (j))
#define XB_XSUB(j)  (1280 + 64 * (j))
#define XB_XGEN(j)  (2304 + 64 * (j))
#define XB_TOP      3328
#define XB_TOPGEN   3392
#define XCD_BAR_WORDS 3456
#define XB_SPIN_CAP (1u << 18)

__device__ __forceinline__ unsigned xb_ld(unsigned* p)              { return __hip_atomic_load(p, __ATOMIC_RELAXED, __HIP_MEMORY_SCOPE_AGENT); }
__device__ __forceinline__ unsigned xb_add(unsigned* p, unsigned v) { return __hip_atomic_fetch_add(p, v, __ATOMIC_RELAXED, __HIP_MEMORY_SCOPE_AGENT); }
__device__ __forceinline__ unsigned xb_xcc_id() { return (unsigned)__builtin_amdgcn_s_getreg((3 << 11) | 20) & 0xFu; }
#define XB_SPIN(cond, bar) do { unsigned _sp = 0; while (cond) { __builtin_amdgcn_s_sleep(1); \
    if ((++_sp & 255u) == 0u) { if (xb_ld(&(bar)[XB_TMO])) break; if (_sp > XB_SPIN_CAP) { atomicAdd(&(bar)[XB_TMO], 1u); break; } } } } while (0)

struct XcdBarrier {
    unsigned* bar; unsigned x;
    volatile LAS unsigned* st;
};

__device__ __forceinline__ XcdBarrier xcd_barrier_post(unsigned* bar, volatile LAS unsigned* st) {
    XcdBarrier b; b.bar = bar; b.x = xb_xcc_id(); b.st = st;
    if (threadIdx.x == 0) (void)xb_add(&bar[XB_XCNT(b.x)], 1u);
    return b;
}
__device__ __forceinline__ void xcd_barrier_complete(unsigned* bar, unsigned x, unsigned& nloc, unsigned& nx) {
    const unsigned G = gridDim.x * gridDim.y * gridDim.z;
    unsigned sum, cnt, mine, sp = 0u;
    for (;;) {
        sum = 0u; cnt = 0u; mine = 0u;
#pragma unroll
        for (unsigned j = 0; j < 16; ++j) { const unsigned c = xb_ld(&bar[XB_XCNT(j)]); sum += c; cnt += (c > 0u) ? 1u : 0u; mine = (j == x) ? c : mine; }
        if (sum == G) break;
        __builtin_amdgcn_s_sleep(1);
        if ((++sp & 255u) == 0u) { if (xb_ld(&bar[XB_TMO])) break; if (sp > XB_SPIN_CAP) { atomicAdd(&bar[XB_TMO], 1u); break; } }
    }
    nloc = mine > 0u ? mine : 1u; nx = cnt > 0u ? cnt : 1u;
}

__device__ __forceinline__ void xcd_barrier(const XcdBarrier& b) {
    asm volatile("s_waitcnt vmcnt(0)" ::: "memory");
    __syncthreads();
    if (threadIdx.x == 0) {
        unsigned* bar = b.bar;
        __builtin_amdgcn_s_waitcnt(0);
        unsigned nloc = b.st[0], nx = b.st[1];
        if (nloc == 0u) { xcd_barrier_complete(bar, b.x, nloc, nx); b.st[0] = nloc; b.st[1] = nx; }
        const unsigned old = xb_add(&bar[XB_XSUB(b.x)], 1u);
        const unsigned gen = old / nloc;
        if (old + 1u == (gen + 1u) * nloc) {
            __builtin_amdgcn_fence(__ATOMIC_RELEASE, "agent");
            asm volatile("s_waitcnt vmcnt(0)" ::: "memory");
            const unsigned og = xb_add(&bar[XB_TOP], 1u);
            const unsigned tg = og / nx;
            if (og + 1u == (tg + 1u) * nx) xb_add(&bar[XB_TOPGEN], 1u);
            else XB_SPIN(xb_ld(&bar[XB_TOPGEN]) == tg, bar);
            __builtin_amdgcn_fence(__ATOMIC_ACQUIRE, "agent");
            xb_add(&bar[XB_XGEN(b.x)], 1u);
            asm volatile("s_waitcnt vmcnt(0)" ::: "memory");
        } else {
            XB_SPIN(xb_ld(&bar[XB_XGEN(b.x)]) == gen, bar);
            __builtin_amdgcn_fence(__ATOMIC_ACQUIRE, "agent");
            asm volatile("s_waitcnt vmcnt(0)" ::: "memory");
        }
    }
    __syncthreads();
}

#define DI __device__ __forceinline__
#define LAS __attribute__((address_space(3)))
typedef unsigned short bf16;
typedef short bf16x8 __attribute__((ext_vector_type(8)));
typedef float f32x4 __attribute__((ext_vector_type(4)));
typedef unsigned u32x4 __attribute__((ext_vector_type(4)));
typedef unsigned u32x2 __attribute__((ext_vector_type(2)));

#ifndef COOP
#define COOP 1
#endif

constexpr int D = 1024, NBATCH = 4, SEQ = 4096, CTXL = 256, NLAT = NBATCH * SEQ, NCTX = NBATCH * CTXL, MT = NLAT + NCTX;
constexpr int FF = 2816, KEYS = SEQ + CTXL;
constexpr int LDP0 = 2560, LDP1 = 3072;
constexpr int C_AQ = 0, C_AK = 512, C_AV = 640, C_BQ = 768, C_BK = 1024, C_BV = 1280, C_BO = 1792, C_RF = 2304, C_RB = 2320;
constexpr float LOG2E = 1.4426950408889634f, EPS = 1e-6f;
constexpr int NCHUNK = 68;

constexpr size_t MiB = 1u << 20;
constexpr size_t WS_CTL = 0, WS_MOD = 1 * MiB, WS_XC = 2 * MiB, WS_WABI = 6 * MiB, WS_WABO = 11 * MiB, WS_WFI = 13 * MiB, WS_WFO = 35 * MiB, WS_WNI = 46 * MiB, WS_WNO = 52 * MiB;
constexpr size_t WS_HO = 54 * MiB, WS_YF = 88 * MiB, WS_P = 122 * MiB, WS_STC = 224 * MiB, WS_DEC = 228 * MiB, WS_END = 246 * MiB;
constexpr size_t WS_CUM0 = 207 * MiB, WS_CUM1 = 229 * MiB;
constexpr size_t WS_PART = 224 * MiB;
constexpr int LDS_BYTES = 147456;
constexpr int NWAVES = 8, NTHR = 512;

DI float bf2f(unsigned short h) { return __uint_as_float(((unsigned)h) << 16); }
DI unsigned pk2(float lo, float hi) { return pg8::cvt_pk_bf16(lo, hi); }
DI float wave_sum(float v) {
#pragma unroll
    for (int o = 1; o < 64; o <<= 1) v += __shfl_xor(v, o);
    return v;
}
DI float fast_exp2(float x) { return __builtin_amdgcn_exp2f(x); }
DI float silu_f(float g) { return g * __builtin_amdgcn_rcpf(1.0f + __expf(-g)); }
DI void unpack8(const bf16x8 v, float (&o)[8]) {
#pragma unroll
    for (int i = 0; i < 8; ++i) o[i] = bf2f((unsigned short)v[i]);
}
DI bf16x8 pack8(const float (&p)[8]) {
    u32x4 w; w.x = pk2(p[0], p[1]); w.y = pk2(p[2], p[3]); w.z = pk2(p[4], p[5]); w.w = pk2(p[6], p[7]);
    return __builtin_bit_cast(bf16x8, w);
}
#define MFMA16(a, b, c) __builtin_amdgcn_mfma_f32_16x16x32_bf16((a), (b), (c), 0, 0, 0)

struct EpiStore {
    static constexpr bool PERM = true, AFTER_DRAIN = false;
    bf16* O; int ldc;
    DI void operator()(const pg8::f32x4 (&acc)[2][2][4][2], const pg8::Unit& u, int wr, int wc, int fr, int fq) const {
        const int row0 = u.pm * 256 + wr * 64 + fr, col0 = u.pn * 256 + wc * 32 + 8 * fq;
#pragma unroll
        for (int ai = 0; ai < 2; ++ai)
#pragma unroll
            for (int m = 0; m < 4; ++m) { bf16* rowp = O + (size_t)(row0 + ai * 128 + m * 16) * ldc + col0;
#pragma unroll
                for (int bj = 0; bj < 2; ++bj) { const pg8::f32x4 v0 = acc[ai][bj][m][0], v1 = acc[ai][bj][m][1];
                    u32x4 w; w.x = pk2(v0[0], v0[1]); w.y = pk2(v0[2], v0[3]); w.z = pk2(v1[0], v1[1]); w.w = pk2(v1[2], v1[3]);
                    *(u32x4*)(rowp + bj * 128) = w; } }
    }
};
struct EpiSwiglu {
    static constexpr bool PERM = true, AFTER_DRAIN = false;
    bf16* O; int ldc;
    DI void operator()(const pg8::f32x4 (&acc)[2][2][4][2], const pg8::Unit& u, int wr, int wc, int fr, int fq) const {
        const int row0 = u.pm * 256 + wr * 64 + fr, col0 = u.pn * 128 + wc * 32 + 8 * fq;
#pragma unroll
        for (int ai = 0; ai < 2; ++ai)
#pragma unroll
            for (int m = 0; m < 4; ++m) { bf16* rowp = O + (size_t)(row0 + ai * 128 + m * 16) * ldc + col0;
                const pg8::f32x4 g0 = acc[ai][0][m][0], g1 = acc[ai][0][m][1], u0 = acc[ai][1][m][0], u1 = acc[ai][1][m][1];
                u32x4 w; w.x = pk2(silu_f(g0[0]) * u0[0], silu_f(g0[1]) * u0[1]); w.y = pk2(silu_f(g0[2]) * u0[2], silu_f(g0[3]) * u0[3]);
                w.z = pk2(silu_f(g1[0]) * u1[0], silu_f(g1[1]) * u1[1]); w.w = pk2(silu_f(g1[2]) * u1[2], silu_f(g1[3]) * u1[3]);
                *(u32x4*)rowp = w; }
    }
};

struct OneUnit {
    int pm, pn; bool has;
    DI bool next(int i, pg8::Unit& u) const { if (i != 0 || !has) return false; u.pm = pm; u.pn = pn; return true; }
    DI void a_ready(const pg8::Unit&) const {}
    DI void done(const pg8::Unit&) const {}
};

struct Args { const float* in[23]; float* out; unsigned char* ws; int ph_lo, ph_hi; };
enum { I_X = 0, I_C, I_CTX, I_CCTX, I_WMOD, I_BMOD, I_GMPRE, I_GMPOST, I_GFPRE, I_GFPOST, I_WFI, I_WFO, I_ABWI, I_ABWO, I_SINK, I_GFW, I_GFB, I_GBW, I_GBB, I_GNORM, I_NAWI, I_NAWO, I_RELB };

DI void transpose_item(const float* W, int K, int N, bf16* WT, int k0, int n0, int drow0, LAS float* scr, int lane) {
#pragma unroll 8
    for (int i = 0; i < 32; ++i) { const int kk = 2 * i + (lane >> 5); scr[kk * 33 + (lane & 31)] = W[(size_t)(k0 + kk) * N + n0 + (lane & 31)]; }
    asm volatile("s_waitcnt lgkmcnt(0)" ::: "memory");
    const int c = lane & 7;
#pragma unroll
    for (int j = 0; j < 4; ++j) { const int n = (lane >> 3) + 8 * j; const LAS float* s = scr + (8 * c) * 33 + n;
        u32x4 o; o.x = pk2(s[0 * 33], s[1 * 33]); o.y = pk2(s[2 * 33], s[3 * 33]); o.z = pk2(s[4 * 33], s[5 * 33]); o.w = pk2(s[6 * 33], s[7 * 33]);
        *(u32x4*)(WT + (size_t)(drow0 + n) * K + k0 + 8 * c) = o; }
    asm volatile("s_waitcnt lgkmcnt(0)" ::: "memory");
}
DI void xpose_plain(const float* W, int K, int N, bf16* WT, int item, LAS float* scr, int lane) {
    const int nblk = N / 32, kb = item / nblk, nb = item % nblk;
    transpose_item(W, K, N, WT, 64 * kb, 32 * nb, 32 * nb, scr, lane);
}
DI void xpose_ffnin(const float* W, bf16* WT, int item, LAS float* scr, int lane) {
    const int nblk = 5632 / 32, kb = item / nblk, nb = item % nblk, n0 = 32 * nb;
    const int bj = n0 >= FF ? 1 : 0, cc = n0 - bj * FF, drow0 = 256 * (cc >> 7) + 128 * bj + (cc & 127);
    transpose_item(W, 1024, 5632, WT, 64 * kb, n0, drow0, scr, lane);
}

DI void phase_prologue(const Args& a, LAS unsigned char* lds, int tid, int lane, int wave) {
    unsigned char* ws = a.ws;
    {
        LAS float* sl = (LAS float*)lds;
        LAS float* red = (LAS float*)(lds + 32768);
        for (int i = tid; i < 5 * 1024; i += NTHR) { const int s = i >> 10, k = i & 1023; const float v = s < 4 ? a.in[I_C][s * 1024 + k] : a.in[I_CCTX][k]; sl[i] = v / (1.0f + __expf(-v)); }
        __syncthreads();
        for (int u = blockIdx.x; u < 192; u += gridDim.x) {
            const int layer = u / 96, col = (u % 96) * 64 + lane;
            const float* W = a.in[I_WMOD] + (size_t)layer * 1024 * 6144 + col;
            float acc[5] = {0.f, 0.f, 0.f, 0.f, 0.f};
            const int kb = wave * 128;
#pragma unroll 8
            for (int k = 0; k < 128; ++k) { const float w = W[(size_t)(kb + k) * 6144];
#pragma unroll
                for (int s = 0; s < 5; ++s) acc[s] += sl[s * 1024 + kb + k] * w; }
#pragma unroll
            for (int s = 0; s < 5; ++s) red[(wave * 5 + s) * 64 + lane] = acc[s];
            __syncthreads();
            if (tid < 320) { const int s = tid >> 6, l = tid & 63; float t = 0.f;
#pragma unroll
                for (int w = 0; w < 8; ++w) t += red[(w * 5 + s) * 64 + l];
                const int c2 = (u % 96) * 64 + l;
                ((float*)(ws + WS_MOD))[(size_t)(layer * 5 + s) * 6144 + c2] = t + a.in[I_BMOD][layer * 6144 + c2]; }
            __syncthreads();
        }
        __syncthreads();
    }
    LAS float* scr = (LAS float*)(lds + wave * 16384);
    const int gw = blockIdx.x * NWAVES + wave, NGW = gridDim.x * NWAVES;
    constexpr int I_1 = 16 * 73, I_2 = 16 * 32, I_3 = 16 * 176, I_4 = 44 * 32, I_5 = 16 * 96, I_6 = 16 * 32;
    constexpr int NITEMS = I_1 + I_2 + 2 * I_3 + 2 * I_4 + I_5 + I_6;
    for (int it = gw; it < NITEMS; it += NGW) {
        int r = it;
        if (r < I_1) { xpose_plain(a.in[I_ABWI], 1024, 2336, (bf16*)(ws + WS_WABI), r, scr, lane); continue; } r -= I_1;
        if (r < I_2) { xpose_plain(a.in[I_ABWO], 1024, 1024, (bf16*)(ws + WS_WABO), r, scr, lane); continue; } r -= I_2;
        if (r < I_3) { xpose_ffnin(a.in[I_WFI], (bf16*)(ws + WS_WFI), r, scr, lane); continue; } r -= I_3;
        if (r < I_3) { xpose_ffnin(a.in[I_WFI] + (size_t)1024 * 5632, (bf16*)(ws + WS_WFI) + (size_t)5632 * 1024, r, scr, lane); continue; } r -= I_3;
        if (r < I_4) { xpose_plain(a.in[I_WFO], FF, 1024, (bf16*)(ws + WS_WFO), r, scr, lane); continue; } r -= I_4;
        if (r < I_4) { xpose_plain(a.in[I_WFO] + (size_t)FF * 1024, FF, 1024, (bf16*)(ws + WS_WFO) + (size_t)1024 * FF, r, scr, lane); continue; } r -= I_4;
        if (r < I_5) { xpose_plain(a.in[I_NAWI], 1024, 3072, (bf16*)(ws + WS_WNI), r, scr, lane); continue; } r -= I_5;
        xpose_plain(a.in[I_NAWO], 1024, 1024, (bf16*)(ws + WS_WNO), r, scr, lane);
    }
    { u32x4* z = (u32x4*)((bf16*)(ws + WS_WABI) + (size_t)2336 * 1024); const u32x4 zero = {0u, 0u, 0u, 0u};
      for (int i = blockIdx.x * NTHR + tid; i < 224 * 128; i += gridDim.x * NTHR) z[i] = zero; }
}

DI void row_op(const float* xsrc, const bf16* y, int nslice, const float* gpost, const float* gate, float* xdst,
               const float* gpre, const float* shift, const float* scale, bf16* hdst, int lane) {
    f32x4 v[4];
#pragma unroll
    for (int j = 0; j < 4; ++j) v[j] = *((const f32x4*)xsrc + lane + 64 * j);
    if (y) {
        f32x4 yv[4]; float s = 0.f;
#pragma unroll
        for (int j = 0; j < 4; ++j) yv[j] = (f32x4){0.f, 0.f, 0.f, 0.f};
        for (int sl = 0; sl < nslice; ++sl) {
#pragma unroll
            for (int j = 0; j < 4; ++j) { const u32x2 w = *((const u32x2*)(y + (size_t)sl * NCTX * D) + lane + 64 * j);
                yv[j] = yv[j] + (f32x4){__uint_as_float(w.x << 16), __uint_as_float(w.x & 0xffff0000u), __uint_as_float(w.y << 16), __uint_as_float(w.y & 0xffff0000u)}; } }
#pragma unroll
        for (int j = 0; j < 4; ++j) s += (yv[j].x * yv[j].x + yv[j].y * yv[j].y) + (yv[j].z * yv[j].z + yv[j].w * yv[j].w);
        const float rstd = __builtin_amdgcn_rsqf(wave_sum(s) * (1.0f / D) + EPS);
#pragma unroll
        for (int j = 0; j < 4; ++j) { const f32x4 gp = *((const f32x4*)gpost + lane + 64 * j), gt = *((const f32x4*)gate + lane + 64 * j);
            v[j] = v[j] + gt * (yv[j] * rstd * gp); }
    }
    if (xdst) {
#pragma unroll
        for (int j = 0; j < 4; ++j) *((f32x4*)xdst + lane + 64 * j) = v[j];
    }
    if (hdst) {
        float s = 0.f;
#pragma unroll
        for (int j = 0; j < 4; ++j) s += (v[j].x * v[j].x + v[j].y * v[j].y) + (v[j].z * v[j].z + v[j].w * v[j].w);
        const float rstd = __builtin_amdgcn_rsqf(wave_sum(s) * (1.0f / D) + EPS);
#pragma unroll
        for (int j = 0; j < 4; ++j) { const f32x4 gp = *((const f32x4*)gpre + lane + 64 * j), sh = *((const f32x4*)shift + lane + 64 * j), sc = *((const f32x4*)scale + lane + 64 * j);
            const f32x4 h = v[j] * rstd * gp * (sc + 1.0f) + sh;
            u32x2 w; w.x = pk2(h.x, h.y); w.y = pk2(h.z, h.w);
            *((u32x2*)hdst + lane + 64 * j) = w; }
    }
}
DI void phase_rows(const Args& a, int mode, int layer, int lane, int wave) {
    unsigned char* ws = a.ws;
    const float* MOD = (const float*)(ws + WS_MOD);
    bf16* H = (bf16*)(ws + WS_HO); const bf16* YF = (const bf16*)(ws + WS_YF); const bf16* PART = (const bf16*)(ws + WS_PART); float* XC = (float*)(ws + WS_XC);
    const int gw = blockIdx.x * NWAVES + wave, NGW = gridDim.x * NWAVES;
    const int nrows = (layer == 0) ? MT : NLAT;
    for (int m = gw; m < nrows; m += NGW) {
        const bool lat = m < NLAT; const int s = lat ? (m >> 12) : 4;
        const float* mod = MOD + (size_t)(layer * 5 + s) * 6144;
        float* xcur = lat ? a.out + (size_t)m * D : XC + (size_t)(m - NLAT) * D;
        if (mode == 0) {
            const float* xin = lat ? a.in[I_X] + (size_t)m * D : a.in[I_CTX] + (size_t)(m - NLAT) * D;
            row_op(xin, nullptr, 0, nullptr, nullptr, nullptr, a.in[I_GMPRE], mod, mod + 1024, H + (size_t)m * D, lane);
        } else if (mode == 1) {
            const float* xin = (layer == 0) ? (lat ? a.in[I_X] + (size_t)m * D : a.in[I_CTX] + (size_t)(m - NLAT) * D) : xcur;
            row_op(xin, (layer == 0 && !lat) ? PART + (size_t)(m - NLAT) * D : YF + (size_t)m * D, (layer == 0 && !lat) ? 4 : 1, a.in[I_GMPOST] + layer * D, mod + 2048, xcur, a.in[I_GFPRE] + layer * D, mod + 3072, mod + 4096, H + (size_t)m * D, lane);
        } else {
            if (layer == 0) { const float* mod1 = MOD + (size_t)(5 + s) * 6144;
                row_op(xcur, lat ? YF + (size_t)m * D : PART + (size_t)(m - NLAT) * D, lat ? 1 : 11, a.in[I_GFPOST], mod + 5120, xcur, a.in[I_GMPRE] + D, mod1, mod1 + 1024, H + (size_t)m * D, lane); }
            else row_op(xcur, YF + (size_t)m * D, 1, a.in[I_GFPOST] + D, mod + 5120, xcur, nullptr, nullptr, nullptr, nullptr, lane);
        }
    }
}

DI float xmax_quads(float x) {
    unsigned u = __float_as_uint(x);
    auto r = __builtin_amdgcn_permlane16_swap(u, u, false, false);
    u = __float_as_uint(fmaxf(__uint_as_float(r[0]), __uint_as_float(r[1])));
    auto r2 = __builtin_amdgcn_permlane32_swap(u, u, false, false);
    return fmaxf(__uint_as_float(r2[0]), __uint_as_float(r2[1]));
}
DI float xsum_quads(float x) {
    unsigned u = __float_as_uint(x);
    auto r = __builtin_amdgcn_permlane16_swap(u, u, false, false);
    u = __float_as_uint(__uint_as_float(r[0]) + __uint_as_float(r[1]));
    auto r2 = __builtin_amdgcn_permlane32_swap(u, u, false, false);
    return __uint_as_float(r2[0]) + __uint_as_float(r2[1]);
}
struct KVFrag { bf16x8 kf[2][2]; bf16x8 vf[4]; };
DI void kv_load(KVFrag& f, const bf16* kp, int kld, const bf16* vp, int vld, int fr, int fq) {
#pragma unroll
    for (int h = 0; h < 2; ++h)
#pragma unroll
        for (int ks = 0; ks < 2; ++ks) f.kf[h][ks] = *(const bf16x8*)(kp + (size_t)((fr >> 2) * 8 + h * 4 + (fr & 3)) * kld + ks * 32 + fq * 8);
#pragma unroll
    for (int nt = 0; nt < 4; ++nt) f.vf[nt] = *(const bf16x8*)(vp + (size_t)(nt * 16 + fr) * vld + fq * 8);
}
template <int MODE>
DI void attn_one(f32x4 (&o)[4], float& mrun, float& lrun, const bf16x8 (&qf)[2], const KVFrag& f, float sc2, int d0, unsigned okmask, const float (&bias)[8]) {
    f32x4 s0 = {0.f, 0.f, 0.f, 0.f}, s1 = {0.f, 0.f, 0.f, 0.f};
    s0 = MFMA16(f.kf[0][0], qf[0], s0); s0 = MFMA16(f.kf[0][1], qf[1], s0);
    s1 = MFMA16(f.kf[1][0], qf[0], s1); s1 = MFMA16(f.kf[1][1], qf[1], s1);
    float sv[8] = {s0[0], s0[1], s0[2], s0[3], s1[0], s1[1], s1[2], s1[3]};
    float mx = -1e30f;
#pragma unroll
    for (int i = 0; i < 8; ++i) {
        float t = sv[i] * sc2;
        if (MODE == 1) { const int dd = d0 - i; t = (dd >= -128 && dd <= 128) ? t : -1e30f; }
        if (MODE == 2) { t = ((okmask >> i) & 1u) ? t + bias[i] : -1e30f; }
        sv[i] = t; mx = fmaxf(mx, t);
    }
    mx = xmax_quads(mx);
    {
        const float mn = fmaxf(mrun, mx), alpha = fast_exp2(mrun - mn);
        lrun *= alpha; mrun = mn;
#pragma unroll
        for (int nt = 0; nt < 4; ++nt) o[nt] = o[nt] * alpha;
    }
    float p[8], ps = 0.f;
#pragma unroll
    for (int i = 0; i < 8; ++i) { p[i] = fast_exp2(sv[i] - mrun); ps += p[i]; }
    lrun += xsum_quads(ps);
    const bf16x8 pf = pack8(p);
#pragma unroll
    for (int nt = 0; nt < 4; ++nt) o[nt] = MFMA16(f.vf[nt], pf, o[nt]);
}
DI void attn_store1(const f32x4 (&o)[4], float lrun, bf16* op, int fq) {
    const float inv = 1.0f / lrun;
#pragma unroll
    for (int nt = 0; nt < 4; ++nt) { u32x2 w; w.x = pk2(o[nt][0] * inv, o[nt][1] * inv); w.y = pk2(o[nt][2] * inv, o[nt][3] * inv);
        *(u32x2*)(op + nt * 16 + fq * 4) = w; }
}

DI void window_attn_tile(const Args& a, int wt, int lane) {
    const bf16* P = (const bf16*)(a.ws + WS_P); const bf16* VtA = (const bf16*)(a.ws + WS_YF); bf16* O = (bf16*)(a.ws + WS_HO);
    const int fr = lane & 15, fq = lane >> 4;
    const bool isctx = wt >= 2048;
    int b, kvh, q0; size_t qrow;
    if (!isctx) { b = wt >> 9; kvh = (wt >> 8) & 1; q0 = (wt & 255) * 16; qrow = (size_t)b * SEQ + q0 + fr; }
    else { const int ct = wt - 2048; b = ct >> 5; kvh = (ct >> 4) & 1; q0 = (ct & 15) * 16; qrow = (size_t)NLAT + b * CTXL + q0 + fr; }
    bf16x8 qf[4][2]; f32x4 o[4][4]; float mrun[4], lrun[4];
#pragma unroll
    for (int g = 0; g < 4; ++g) {
#pragma unroll
        for (int ks = 0; ks < 2; ++ks) qf[g][ks] = *(const bf16x8*)(P + qrow * LDP0 + C_AQ + (kvh * 4 + g) * 64 + ks * 32 + fq * 8);
#pragma unroll
        for (int nt = 0; nt < 4; ++nt) o[g][nt] = (f32x4){0.f, 0.f, 0.f, 0.f};
        mrun[g] = a.in[I_SINK][kvh * 4 + g] * LOG2E; lrun[g] = 1.0f;
    }
    const float sc2 = 0.125f * LOG2E;
    const float nob[8] = {0.f, 0.f, 0.f, 0.f, 0.f, 0.f, 0.f, 0.f};
    const bf16* vbase = VtA + (size_t)((b * 2 + kvh) * 64) * KEYS;
    const bf16* kctx = P + (size_t)(NLAT + b * CTXL) * LDP0 + C_AK + kvh * 64;
    const bf16* kloc = P + (size_t)(b * SEQ) * LDP0 + C_AK + kvh * 64;
    const int tlo = (q0 - 128 > 0 ? q0 - 128 : 0) & ~31, thi = (q0 + 16 + 128 < SEQ) ? q0 + 16 + 128 : SEQ;
    const int ntile = isctx ? 8 : 8 + (thi - tlo + 31) / 32;
#define WIN_LOAD(F, t) do { const int t_ = (t); const int k0_ = t_ < 8 ? t_ * 32 : tlo + (t_ - 8) * 32; \
        kv_load(F, (t_ < 8 ? kctx : kloc) + (size_t)k0_ * LDP0, LDP0, vbase + (t_ < 8 ? SEQ : 0) + k0_, KEYS, fr, fq); } while (0)
#define WIN_PROC(F, t) do { const int t_ = (t); const int d0_ = t_ < 8 ? 0 : q0 + fr - (tlo + (t_ - 8) * 32) - fq * 8; \
        _Pragma("unroll") for (int g = 0; g < 4; ++g) attn_one<1>(o[g], mrun[g], lrun[g], qf[g], F, sc2, d0_, 0u, nob); } while (0)
    KVFrag A, B;
    WIN_LOAD(A, 0);
    for (int t = 0; t < ntile; t += 2) {
        WIN_LOAD(B, (t + 1 < ntile ? t + 1 : ntile - 1));
        WIN_PROC(A, t);
        WIN_LOAD(A, (t + 2 < ntile ? t + 2 : ntile - 1));
        if (t + 1 < ntile) WIN_PROC(B, t + 1);
    }
#undef WIN_LOAD
#undef WIN_PROC
#pragma unroll
    for (int g = 0; g < 4; ++g) attn_store1(o[g], lrun[g], O + qrow * D + (kvh * 4 + g) * 64, fq);
}

template <int NR>
DI void na_attn_group(const Args& a, int gid, int lane, LAS float* btab  ) {
    const bf16* P = (const bf16*)(a.ws + WS_P); const bf16* VtC = (const bf16*)(a.ws + WS_YF); bf16* O = (bf16*)(a.ws + WS_HO);
    const int fr = lane & 15, fq = lane >> 4;
    constexpr int NRG = 64 / NR; const int j = gid & 3, r0 = ((gid >> 2) % NRG) * NR, h = ((gid >> 2) / NRG) & 15, b = (gid >> 2) / (NRG * 16);
    { const float* relb = a.in[I_RELB] + h * 465;
      for (int i = lane; i < 465; i += 64) btab[i] = relb[i] * LOG2E;
      asm volatile("s_waitcnt vmcnt(0) lgkmcnt(0)" ::: "memory"); }
    bf16x8 qf[NR][2]; f32x4 o[NR][4]; float mrun[NR], lrun[NR];
#pragma unroll
    for (int qi = 0; qi < NR; ++qi) { const size_t qrow = (size_t)b * SEQ + (r0 + qi) * 64 + j * 16 + fr;
#pragma unroll
        for (int ks = 0; ks < 2; ++ks) qf[qi][ks] = *(const bf16x8*)(P + qrow * LDP1 + h * 64 + ks * 32 + fq * 8);
#pragma unroll
        for (int nt = 0; nt < 4; ++nt) o[qi][nt] = (f32x4){0.f, 0.f, 0.f, 0.f};
        mrun[qi] = -1e30f; lrun[qi] = 0.f; }
    const float sc2 = 0.125f * LOG2E;
    const float nob[8] = {0.f, 0.f, 0.f, 0.f, 0.f, 0.f, 0.f, 0.f};
    const bf16* vbase = VtC + (size_t)((b * 16 + h) * 64) * KEYS;
    const bf16* kctx = P + (size_t)(NLAT + b * CTXL) * LDP1 + 1024 + h * 64;
    const bf16* kloc = P + (size_t)(b * SEQ) * LDP1 + 1024 + h * 64;
    const int seg_start = j == 0 ? 0 : (j == 1 ? 8 : (j == 2 ? 24 : 32));
    const int qcol = j * 16 + fr; const int cs = qcol - 8 < 0 ? 0 : (qcol - 8 > 48 ? 48 : qcol - 8);
    unsigned okmask = 0u; int coloff[8];
#pragma unroll
    for (int i = 0; i < 8; ++i) { const int keycol = seg_start + fq * 8 + i; if (keycol >= cs && keycol < cs + 16) okmask |= 1u << i;
        int co = keycol - qcol + 15; co = co < 0 ? 0 : (co > 30 ? 30 : co); coloff[i] = co; }
    const int rsa = r0 - 4 < 0 ? 0 : (r0 - 4 > 56 ? 56 : r0 - 4);
    const int rsb = r0 + NR - 1 - 4 < 0 ? 0 : (r0 + NR - 1 - 4 > 56 ? 56 : r0 + NR - 1 - 4);
    const int nloc = rsb + 8 - rsa, ntile = 8 + nloc;
#define NA_LOAD(F, t) do { const int t_ = (t); const int k0_ = t_ < 8 ? t_ * 32 : (rsa + t_ - 8) * 64 + seg_start; \
        kv_load(F, (t_ < 8 ? kctx : kloc) + (size_t)k0_ * LDP1, LDP1, vbase + (t_ < 8 ? SEQ : 0) + k0_, KEYS, fr, fq); } while (0)
#define NA_PROC(F, t) do { const int t_ = (t); \
        if (t_ < 8) { _Pragma("unroll") for (int qi = 0; qi < NR; ++qi) attn_one<0>(o[qi], mrun[qi], lrun[qi], qf[qi], F, sc2, 0, 0u, nob); } \
        else { const int R_ = rsa + t_ - 8; \
            _Pragma("unroll") for (int qi = 0; qi < NR; ++qi) { const int r_ = r0 + qi; const int rs_ = r_ - 4 < 0 ? 0 : (r_ - 4 > 56 ? 56 : r_ - 4); \
                if (R_ >= rs_ && R_ < rs_ + 8) { const LAS float* rb_ = btab + (R_ - r_ + 7) * 31; float bias_[8]; \
                    _Pragma("unroll") for (int e = 0; e < 8; ++e) bias_[e] = rb_[coloff[e]]; \
                    attn_one<2>(o[qi], mrun[qi], lrun[qi], qf[qi], F, sc2, 0, okmask, bias_); } } } } while (0)
    if (NR <= 2) {
        KVFrag A, B;
        NA_LOAD(A, 0);
        for (int t = 0; t < ntile; t += 2) {
            NA_LOAD(B, (t + 1 < ntile ? t + 1 : ntile - 1));
            NA_PROC(A, t);
            NA_LOAD(A, (t + 2 < ntile ? t + 2 : ntile - 1));
            if (t + 1 < ntile) NA_PROC(B, t + 1);
        }
    } else {
        KVFrag A;
        for (int t = 0; t < ntile; ++t) { NA_LOAD(A, t); NA_PROC(A, t); }
    }
#undef NA_LOAD
#undef NA_PROC
#pragma unroll
    for (int qi = 0; qi < NR; ++qi) attn_store1(o[qi], lrun[qi], O + ((size_t)b * SEQ + (r0 + qi) * 64 + j * 16 + fr) * D + h * 64, fq);
}

constexpr int NA_KC = 0, NA_VC = 36864, NA_KR = 70656, NA_VR = 89088, NA_BT = 107520;
DI void kv_load_lds(KVFrag& f, const LAS unsigned short* kimg, const LAS unsigned short* vimg, int vpitch, int fr, int fq) {
#pragma unroll
    for (int h = 0; h < 2; ++h)
#pragma unroll
        for (int ks = 0; ks < 2; ++ks) f.kf[h][ks] = *(const LAS bf16x8*)(kimg + ((fr >> 2) * 8 + h * 4 + (fr & 3)) * 72 + ks * 32 + fq * 8);
#pragma unroll
    for (int nt = 0; nt < 4; ++nt) f.vf[nt] = *(const LAS bf16x8*)(vimg + (nt * 16 + fr) * vpitch + fq * 8);
}
DI void na_attn_unit(const Args& a, LAS unsigned char* lds, int unit, int tid, int lane, int wave) {
    const bf16* P = (const bf16*)(a.ws + WS_P); const bf16* VtC = (const bf16*)(a.ws + WS_YF); bf16* O = (bf16*)(a.ws + WS_HO);
    LAS unsigned short* KC = (LAS unsigned short*)(lds + NA_KC); LAS unsigned short* VC = (LAS unsigned short*)(lds + NA_VC);
    LAS unsigned short* KR = (LAS unsigned short*)(lds + NA_KR); LAS unsigned short* VR = (LAS unsigned short*)(lds + NA_VR); LAS float* bt = (LAS float*)(lds + NA_BT);
    const int fr = lane & 15, fq = lane >> 4;
    const int r0 = (unit & 15) * 4, h = (unit >> 4) & 15, b = unit >> 8;
    const int qr = r0 + (wave >> 1), jb = (wave & 1) * 2;
    const bf16* vglob = VtC + (size_t)((b * 16 + h) * 64) * KEYS;
    const bf16* kglob = P + (size_t)(b * SEQ) * LDP1 + 1024 + h * 64;
    const int rsa = r0 - 4 < 0 ? 0 : (r0 - 4 > 56 ? 56 : r0 - 4);
    const int rsb = r0 + 3 - 4 < 0 ? 0 : (r0 + 3 - 4 > 56 ? 56 : r0 + 3 - 4);
    const int nloc = rsb + 8 - rsa;
    for (int i = tid; i < 465; i += NTHR) bt[i] = a.in[I_RELB][h * 465 + i] * LOG2E;
    { const int row = tid >> 1, half = tid & 1; const bf16* src = P + (size_t)(NLAT + b * CTXL + row) * LDP1 + 1024 + h * 64 + half * 32;
#pragma unroll
      for (int i = 0; i < 4; ++i) *(LAS u32x4*)(KC + row * 72 + half * 32 + i * 8) = *(const u32x4*)(src + i * 8); }
    { const int d = tid >> 3, ch = tid & 7; const bf16* src = vglob + (size_t)d * KEYS + SEQ + ch * 32;
#pragma unroll
      for (int i = 0; i < 4; ++i) *(LAS u32x4*)(VC + d * 264 + ch * 32 + i * 8) = *(const u32x4*)(src + i * 8); }
    const int srow = tid >> 3, sch = (tid & 7) * 8;
    { const u32x4 kreg = *(const u32x4*)(kglob + (size_t)(rsa * 64 + srow) * LDP1 + sch), vreg = *(const u32x4*)(vglob + (size_t)srow * KEYS + rsa * 64 + sch);
      *(LAS u32x4*)(KR + srow * 72 + sch) = kreg; *(LAS u32x4*)(VR + srow * 72 + sch) = vreg; }
    bf16x8 qf[2][2]; f32x4 o[2][4]; float mrun[2], lrun[2];
#pragma unroll
    for (int qi = 0; qi < 2; ++qi) { const size_t qrow = (size_t)b * SEQ + qr * 64 + (jb + qi) * 16 + fr;
#pragma unroll
        for (int ks = 0; ks < 2; ++ks) qf[qi][ks] = *(const bf16x8*)(P + qrow * LDP1 + h * 64 + ks * 32 + fq * 8);
#pragma unroll
        for (int nt = 0; nt < 4; ++nt) o[qi][nt] = (f32x4){0.f, 0.f, 0.f, 0.f};
        mrun[qi] = -1e30f; lrun[qi] = 0.f; }
    const float sc2 = 0.125f * LOG2E;
    const float nob[8] = {0.f, 0.f, 0.f, 0.f, 0.f, 0.f, 0.f, 0.f};
    __syncthreads();
    for (int t8 = 0; t8 < 8; ++t8) { KVFrag F; kv_load_lds(F, KC + t8 * 32 * 72, VC + t8 * 32, 264, fr, fq);
#pragma unroll
        for (int qi = 0; qi < 2; ++qi) attn_one<0>(o[qi], mrun[qi], lrun[qi], qf[qi], F, sc2, 0, 0u, nob); }
    int seg_start[2], cbase[2]; unsigned okmask[2];
#pragma unroll
    for (int qi = 0; qi < 2; ++qi) { const int j = jb + qi; seg_start[qi] = j == 0 ? 0 : (j == 1 ? 8 : (j == 2 ? 24 : 32));
        const int qcol = j * 16 + fr; const int cs = qcol - 8 < 0 ? 0 : (qcol - 8 > 48 ? 48 : qcol - 8);
        unsigned m = 0u;
#pragma unroll
        for (int i = 0; i < 8; ++i) { const int keycol = seg_start[qi] + fq * 8 + i; if (keycol >= cs && keycol < cs + 16) m |= 1u << i; }
        okmask[qi] = m; cbase[qi] = seg_start[qi] + fq * 8 - qcol + 15; }
    const int rsq = qr - 4 < 0 ? 0 : (qr - 4 > 56 ? 56 : qr - 4);
    for (int t = 0; t < nloc; ++t) {
        const int R = rsa + t, cur = t & 1;
        u32x4 kreg = {0u, 0u, 0u, 0u}, vreg = {0u, 0u, 0u, 0u};
        if (t + 1 < nloc) { kreg = *(const u32x4*)(kglob + (size_t)((R + 1) * 64 + srow) * LDP1 + sch); vreg = *(const u32x4*)(vglob + (size_t)srow * KEYS + (R + 1) * 64 + sch); }
        if (R >= rsq && R < rsq + 8) {
            const LAS float* rb = bt + (R - qr + 7) * 31;
#pragma unroll
            for (int qi = 0; qi < 2; ++qi) { KVFrag F; kv_load_lds(F, KR + cur * 4608 + seg_start[qi] * 72, VR + cur * 4608 + seg_start[qi], 72, fr, fq);
                float bias[8];
#pragma unroll
                for (int e = 0; e < 8; ++e) { int co = cbase[qi] + e; co = co < 0 ? 0 : (co > 30 ? 30 : co); bias[e] = rb[co]; }
                attn_one<2>(o[qi], mrun[qi], lrun[qi], qf[qi], F, sc2, 0, okmask[qi], bias); }
        }
        if (t + 1 < nloc) { *(LAS u32x4*)(KR + (cur ^ 1) * 4608 + srow * 72 + sch) = kreg; *(LAS u32x4*)(VR + (cur ^ 1) * 4608 + srow * 72 + sch) = vreg; }
        __syncthreads();
    }
#pragma unroll
    for (int qi = 0; qi < 2; ++qi) attn_store1(o[qi], lrun[qi], O + ((size_t)b * SEQ + qr * 64 + (jb + qi) * 16 + fr) * D + h * 64, fq);
}

DI void vt_unit(const bf16* P, int ldp, int vcol, int nh, bf16* Vt, int unit, LAS unsigned char* scr, int lane) {
    const int kb = unit % 68, bh = unit / 68, h = bh % nh, b = bh / nh;
    const size_t row0 = kb < 64 ? (size_t)b * SEQ + kb * 64 : (size_t)NLAT + b * CTXL + (kb - 64) * 64;
    LAS unsigned short* t = (LAS unsigned short*)scr;
#pragma unroll
    for (int i = 0; i < 8; ++i) { const int key = (lane >> 3) + 8 * i, ch = lane & 7;
        const u32x4 v = *(const u32x4*)(P + (row0 + key) * ldp + vcol + h * 64 + ch * 8);
        *(LAS u32x4*)(t + key * 72 + ch * 8) = v; }
    asm volatile("s_waitcnt lgkmcnt(0)" ::: "memory");
    bf16* dst = Vt + (size_t)(bh * 64 + lane) * KEYS + kb * 64;
#pragma unroll
    for (int g8 = 0; g8 < 8; ++g8) { unsigned short e[8];
#pragma unroll
        for (int i = 0; i < 8; ++i) e[i] = t[(g8 * 8 + i) * 72 + lane];
        u32x4 w; w.x = e[0] | ((unsigned)e[1] << 16); w.y = e[2] | ((unsigned)e[3] << 16); w.z = e[4] | ((unsigned)e[5] << 16); w.w = e[6] | ((unsigned)e[7] << 16);
        *(u32x4*)(dst + g8 * 8) = w; }
    asm volatile("s_waitcnt lgkmcnt(0)" ::: "memory");
}

constexpr int L_GW = 0, L_CUM = 4608, L_A = 21248, L_B = 30464, L_ATT = 39680, L_VT = 48896, L_SSQ = 67328, L_TOT = 67840;
DI size_t chunk_row0(int b, int n) { return n < 64 ? (size_t)b * SEQ + n * 64 : (size_t)NLAT + b * CTXL + (n - 64) * 64; }
DI float* cum_ptr(const Args& a, int dir, int bh, int n) { return (float*)(a.ws + (dir ? WS_CUM1 : WS_CUM0)) + (size_t)(bh * NCHUNK + n) * 4096; }
DI float* st_ptr(const Args& a, int seq, int n) { return n < 64 ? a.out + (size_t)(seq * 64 + n) * 8192 : (float*)(a.ws + WS_STC) + (size_t)(seq * 4 + (n - 64)) * 8192; }

DI void gla_cum(const Args& a, LAS unsigned char* lds, const bf16* P, size_t row0, int h, int dir, int tid) {
    LAS float* rfl = (LAS float*)(lds + L_GW); LAS float* tot = (LAS float*)(lds + L_TOT); LAS float* cum = (LAS float*)(lds + L_CUM);
    const float* gw = a.in[dir ? I_GBW : I_GFW]; const float* gb = a.in[dir ? I_GBB : I_GFB];
    const int lane = tid & 63, w = tid >> 6;
    { const int c = tid >> 3, r2 = (tid & 7) * 2; const unsigned v = *(const unsigned*)(P + (row0 + c) * LDP0 + (dir ? C_RB : C_RF) + r2);
      rfl[c * 16 + r2] = __uint_as_float(v << 16); rfl[c * 16 + r2 + 1] = __uint_as_float(v & 0xffff0000u); }
    float gwr[16];
#pragma unroll
    for (int r = 0; r < 16; ++r) gwr[r] = gw[r * 256 + h * 64 + lane];
    const float gbv = gb[h * 64 + lane];
    __syncthreads();
    float la[8];
#pragma unroll
    for (int i = 0; i < 8; ++i) { const int c = w * 8 + i; float x = gbv;
#pragma unroll
        for (int r = 0; r < 16; ++r) x += rfl[c * 16 + r] * gwr[r];
        la[i] = (fminf(x, 0.f) - __logf(1.0f + __expf(-fabsf(x)))) * (1.0f / 16.0f); }
    if (dir == 0) {
#pragma unroll
        for (int i = 1; i < 8; ++i) la[i] += la[i - 1];
        tot[w * 64 + lane] = la[7];
    } else {
#pragma unroll
        for (int i = 6; i >= 0; --i) la[i] += la[i + 1];
        tot[w * 64 + lane] = la[0];
    }
    __syncthreads();
    float off = 0.f;
#pragma unroll
    for (int w2 = 0; w2 < 8; ++w2) { const float t = tot[w2 * 64 + lane]; off += ((dir == 0) ? (w2 < w) : (w2 > w)) ? t : 0.f; }
#pragma unroll
    for (int i = 0; i < 8; ++i) cum[(w * 8 + i) * 65 + lane] = la[i] + off;
    __syncthreads();
}
DI void gla_load_vt(LAS unsigned char* lds, const bf16* P, size_t row0, int h, int tid) {
    LAS unsigned short* vT = (LAS unsigned short*)(lds + L_VT);
    const int c = tid >> 3, dg = tid & 7;
    const bf16* vp = P + (row0 + c) * LDP0 + C_BV + h * 128 + dg * 16;
    const bf16x8 v0 = *(const bf16x8*)vp, v1 = *(const bf16x8*)(vp + 8);
#pragma unroll
    for (int e = 0; e < 8; ++e) { vT[(dg * 16 + e) * 72 + c] = (unsigned short)v0[e]; vT[(dg * 16 + 8 + e) * 72 + c] = (unsigned short)v1[e]; }
}
DI void gla_g1_unit(const Args& a, LAS unsigned char* lds, int unit, int tid, int lane, int wave) {
    const bf16* P = (const bf16*)(a.ws + WS_P);
    const int n = unit % NCHUNK, seq = unit / NCHUNK, dir = seq & 1, h = (seq >> 1) & 3, b = seq >> 3;
    const size_t row0 = chunk_row0(b, n);
    const bf16x8 kraw = *(const bf16x8*)(P + (row0 + (tid >> 3)) * LDP0 + C_BK + h * 64 + (tid & 7) * 8);
    gla_load_vt(lds, P, row0, h, tid);
    gla_cum(a, lds, P, row0, h, dir, tid);
    LAS float* cum = (LAS float*)(lds + L_CUM); LAS unsigned short* kdT = (LAS unsigned short*)(lds + L_A); LAS unsigned short* vT = (LAS unsigned short*)(lds + L_VT);
    const int cend = dir ? 0 : 63;
    { const int c = tid >> 3, dg = tid & 7; float kk[8]; unpack8(kraw, kk);
#pragma unroll
      for (int dd = 0; dd < 8; ++dd) { const int d = dg * 8 + dd; const float v = kk[dd] * __expf(cum[cend * 65 + d] - cum[c * 65 + d]); kdT[d * 72 + c] = (unsigned short)(pk2(v, 0.f) & 0xffffu); } }
    { const int c = tid >> 3, dg = tid & 7; float* cp = cum_ptr(a, dir, seq >> 1, n) + c * 64 + dg * 8;
      *(f32x4*)cp = (f32x4){cum[c * 65 + dg * 8], cum[c * 65 + dg * 8 + 1], cum[c * 65 + dg * 8 + 2], cum[c * 65 + dg * 8 + 3]};
      *(f32x4*)(cp + 4) = (f32x4){cum[c * 65 + dg * 8 + 4], cum[c * 65 + dg * 8 + 5], cum[c * 65 + dg * 8 + 6], cum[c * 65 + dg * 8 + 7]}; }
    if (tid < 64) ((float*)(a.ws + WS_DEC))[(size_t)(seq * NCHUNK + n) * 64 + tid] = __expf(cum[cend * 65 + tid]);
    __syncthreads();
    const int fr = lane & 15, fq = lane >> 4;
    bf16x8 av[2];
#pragma unroll
    for (int ks = 0; ks < 2; ++ks) av[ks] = *(const LAS bf16x8*)(vT + (wave * 16 + fr) * 72 + ks * 32 + fq * 8);
    float* st = st_ptr(a, seq, n);
#pragma unroll
    for (int nt = 0; nt < 4; ++nt) { f32x4 acc = {0.f, 0.f, 0.f, 0.f};
#pragma unroll
        for (int ks = 0; ks < 2; ++ks) { const bf16x8 bk = *(const LAS bf16x8*)(kdT + (nt * 16 + fr) * 72 + ks * 32 + fq * 8); acc = MFMA16(av[ks], bk, acc); }
#pragma unroll
        for (int r = 0; r < 4; ++r) st[(wave * 16 + fq * 4 + r) * 64 + nt * 16 + fr] = acc[r]; }
    __syncthreads();
}
DI void gla_scan(const Args& a, int tid) {
    const float* DEC = (const float*)(a.ws + WS_DEC);
    for (int e = blockIdx.x * NTHR + tid; e < 32 * 8192; e += gridDim.x * NTHR) {
        const int seq = e >> 13, el = e & 8191, dk = el & 63, dir = seq & 1;
        float S = 0.f;
        for (int s4 = 0; s4 < NCHUNK; s4 += 4) {
            float* p[4]; float t[4], dc[4];
#pragma unroll
            for (int i = 0; i < 4; ++i) { const int step = s4 + i; const int n = dir == 0 ? (step < 4 ? 64 + step : step - 4) : (step < 4 ? 67 - step : 67 - step);
                p[i] = st_ptr(a, seq, n) + el; t[i] = *p[i]; dc[i] = DEC[(size_t)(seq * NCHUNK + n) * 64 + dk]; }
#pragma unroll
            for (int i = 0; i < 4; ++i) { *p[i] = S; S = dc[i] * S + t[i]; }
        }
    }
}
DI void gla_g3_unit(const Args& a, LAS unsigned char* lds, int unit, int tid, int lane, int wave) {
    const bf16* P = (const bf16*)(a.ws + WS_P); bf16* O = (bf16*)(a.ws + WS_HO);
    const int n = unit % NCHUNK, bh = unit / NCHUNK, h = bh & 3, b = bh >> 2;
    const size_t row0 = chunk_row0(b, n);
    LAS float* cum = (LAS float*)(lds + L_CUM); LAS unsigned short* qg = (LAS unsigned short*)(lds + L_A); LAS unsigned short* kg = (LAS unsigned short*)(lds + L_B);
    LAS unsigned short* att = (LAS unsigned short*)(lds + L_ATT); LAS unsigned short* vT = (LAS unsigned short*)(lds + L_VT); LAS float* ssq = (LAS float*)(lds + L_SSQ);
    const int fr = lane & 15, fq = lane >> 4, ct = wave & 3, dvh = wave >> 2;
    gla_load_vt(lds, P, row0, h, tid);
    f32x4 acc[4];
#pragma unroll
    for (int nt = 0; nt < 4; ++nt) acc[nt] = (f32x4){0.f, 0.f, 0.f, 0.f};
    const bf16x8 qraw = *(const bf16x8*)(P + (row0 + (tid >> 3)) * LDP0 + C_BQ + h * 64 + (tid & 7) * 8), kraw = *(const bf16x8*)(P + (row0 + (tid >> 3)) * LDP0 + C_BK + h * 64 + (tid & 7) * 8);
    for (int dir = 0; dir < 2; ++dir) {
        const float* cp = cum_ptr(a, dir, bh, n) + (tid >> 3) * 64 + (tid & 7) * 8;
        const f32x4 c0 = *(const f32x4*)cp, c1 = *(const f32x4*)(cp + 4);
        const float* st = st_ptr(a, (bh * 2 + dir), n);
        f32x4 sraw[4][2][2];
#pragma unroll
        for (int nt = 0; nt < 4; ++nt)
#pragma unroll
            for (int ks = 0; ks < 2; ++ks) { const float* sp = st + ((dvh * 4 + nt) * 16 + fr) * 64 + ks * 32 + fq * 8; sraw[nt][ks][0] = *(const f32x4*)sp; sraw[nt][ks][1] = *(const f32x4*)(sp + 4); }
        { const int c = tid >> 3, dg = tid & 7; float qq[8], kk[8], oq[8], ok[8];
          const float cu8[8] = {c0[0], c0[1], c0[2], c0[3], c1[0], c1[1], c1[2], c1[3]};
          unpack8(qraw, qq); unpack8(kraw, kk);
#pragma unroll
          for (int dd = 0; dd < 8; ++dd) { const float cu = cu8[dd]; oq[dd] = qq[dd] * 0.125f * __expf(cu); ok[dd] = kk[dd] * __expf(-cu); }
          *(LAS bf16x8*)(qg + c * 72 + dg * 8) = pack8(oq); *(LAS bf16x8*)(kg + c * 72 + dg * 8) = pack8(ok); }
        __syncthreads();
        bf16x8 bq[2];
#pragma unroll
        for (int ks = 0; ks < 2; ++ks) bq[ks] = *(const LAS bf16x8*)(qg + (ct * 16 + fr) * 72 + ks * 32 + fq * 8);
#pragma unroll
        for (int si = 0; si < 2; ++si) { const int st = dvh * 2 + si; f32x4 s = {0.f, 0.f, 0.f, 0.f};
#pragma unroll
            for (int ks = 0; ks < 2; ++ks) { const bf16x8 ak = *(const LAS bf16x8*)(kg + (st * 16 + fr) * 72 + ks * 32 + fq * 8); s = MFMA16(ak, bq[ks], s); }
            const int cpos = ct * 16 + fr; float pv[4];
#pragma unroll
            for (int r = 0; r < 4; ++r) { const int spos = st * 16 + fq * 4 + r; const bool keep = dir == 0 ? (spos <= cpos) : (spos >= cpos); pv[r] = keep ? s[r] : 0.f; }
            u32x2 w; w.x = pk2(pv[0], pv[1]); w.y = pk2(pv[2], pv[3]);
            *(LAS u32x2*)(att + cpos * 72 + st * 16 + fq * 4) = w; }
        __syncthreads();
        bf16x8 ba[2];
#pragma unroll
        for (int ks = 0; ks < 2; ++ks) ba[ks] = *(const LAS bf16x8*)(att + (ct * 16 + fr) * 72 + ks * 32 + fq * 8);
#pragma unroll
        for (int nt = 0; nt < 4; ++nt) { const int dvt = dvh * 4 + nt;
#pragma unroll
            for (int ks = 0; ks < 2; ++ks) {
                const bf16x8 av = *(const LAS bf16x8*)(vT + (dvt * 16 + fr) * 72 + ks * 32 + fq * 8);
                acc[nt] = MFMA16(av, ba[ks], acc[nt]);
                const f32x4 s0 = sraw[nt][ks][0], s1 = sraw[nt][ks][1];
                const float sf[8] = {s0[0], s0[1], s0[2], s0[3], s1[0], s1[1], s1[2], s1[3]};
                acc[nt] = MFMA16(pack8(sf), bq[ks], acc[nt]); } }
        __syncthreads();
    }
    float sq = 0.f;
#pragma unroll
    for (int nt = 0; nt < 4; ++nt) sq += (acc[nt][0] * acc[nt][0] + acc[nt][1] * acc[nt][1]) + (acc[nt][2] * acc[nt][2] + acc[nt][3] * acc[nt][3]);
    sq += __shfl_xor(sq, 16); sq += __shfl_xor(sq, 32);
    if (fq == 0) ssq[wave * 16 + fr] = sq;
    __syncthreads();
    const float tot = ssq[wave * 16 + fr] + ssq[(wave ^ 4) * 16 + fr];
    const float rstd = __builtin_amdgcn_rsqf(tot * (1.0f / 128.0f) + EPS);
    const size_t row = row0 + ct * 16 + fr;
#pragma unroll
    for (int nt = 0; nt < 4; ++nt) { const int dv0 = (dvh * 4 + nt) * 16 + fq * 4;
        const f32x4 g4 = *(const f32x4*)(a.in[I_GNORM] + h * 128 + dv0);
        const u32x2 bw = *(const u32x2*)(P + row * LDP0 + C_BO + h * 128 + dv0);
        const float g0 = __uint_as_float(bw.x << 16), g1 = __uint_as_float(bw.x & 0xffff0000u), g2 = __uint_as_float(bw.y << 16), g3 = __uint_as_float(bw.y & 0xffff0000u);
        u32x2 w; w.x = pk2(acc[nt][0] * rstd * g4[0] * silu_f(g0), acc[nt][1] * rstd * g4[1] * silu_f(g1));
        w.y = pk2(acc[nt][2] * rstd * g4[2] * silu_f(g2), acc[nt][3] * rstd * g4[3] * silu_f(g3));
        *(u32x2*)(O + row * D + 512 + h * 128 + dv0) = w; }
    __syncthreads();
}

DI void rope_row(bf16* prow, int t, int lane) {
    const int prow_pos = t >> 6, pcol_pos = t & 63;
#pragma unroll
    for (int i = 0; i < 5; ++i) { const int pi = lane + 64 * i, head = pi >> 5, rem = pi & 31, half = rem >> 4, j = rem & 15;
        const int c1 = head * 64 + half * 32 + j, pos = half ? pcol_pos : prow_pos;
        const float cs = ROPE_COS[pos * 16 + j], sn = ROPE_SIN[pos * 16 + j];
        const float u1 = bf2f(prow[c1]), u2 = bf2f(prow[c1 + 16]);
        prow[c1] = (unsigned short)(pk2(u1 * cs - u2 * sn, 0.f) & 0xffffu); prow[c1 + 16] = (unsigned short)(pk2(u2 * cs + u1 * sn, 0.f) & 0xffffu); }
}

constexpr int NPHASE = 19;
#ifndef NA_NR
#define NA_NR 2
#endif
#ifndef PROBE_MASK
#define PROBE_MASK 0u
#endif
#define REPS(k) (((PROBE_MASK >> (k)) & 1u) ? 2 : 1)
__global__ void __launch_bounds__(NTHR, 2) fwd_kernel(Args a) {
    extern __shared__ __attribute__((aligned(16))) unsigned char lds_raw[];
    LAS unsigned char* lds = (LAS unsigned char*)lds_raw;
    const int tid = threadIdx.x, lane = tid & 63, wave = __builtin_amdgcn_readfirstlane(tid >> 6);
    const int G = gridDim.x, gw = blockIdx.x * NWAVES + wave, NGW = G * NWAVES;
    unsigned char* ws = a.ws;
    const int lo = a.ph_lo, hi = a.ph_hi;
#define IN(k) (lo <= (k) && (k) < hi)
#ifndef PROBE_SYNC
#define PROBE_SYNC 1
#endif
    volatile LAS unsigned* MISC = (volatile LAS unsigned*)(lds + 131072 + 320);
    if (tid < 32) MISC[tid] = 0u;
    __syncthreads();
    unsigned* barw = (unsigned*)(ws + WS_CTL);
    XcdBarrier xbar; xbar.bar = barw; xbar.x = 0; xbar.st = MISC + 8;
    if (hi - lo > 1) {
        if (blockIdx.x == 0) { for (int i = tid; i < XCD_BAR_WORDS; i += NTHR) barw[i] = 0u; }
        cg::this_grid().sync();
        xbar = xcd_barrier_post(barw, MISC + 8);
    }
#define SEAM(k) do { if (IN(k) && IN((k) + 1)) { for (int sr_ = 0; sr_ < PROBE_SYNC; ++sr_) xcd_barrier(xbar); } } while (0)
    bf16* H = (bf16*)(ws + WS_HO); bf16* YF = (bf16*)(ws + WS_YF); bf16* P = (bf16*)(ws + WS_P);

    if (IN(0)) { for (int rep = 0; rep < REPS(0); ++rep) { phase_prologue(a, lds, tid, lane, wave); __syncthreads(); } } SEAM(0);
    if (IN(1)) { for (int rep = 0; rep < REPS(1); ++rep) phase_rows(a, 0, 0, lane, wave); } SEAM(1);
    if (IN(2)) { pg8::Gemm g{H, (const bf16*)(ws + WS_WABI), MT, LDP0, D, D}; pg8::StaticOrder S; S.init(MT, LDP0, G, (int)blockIdx.x);
        EpiStore E{P, LDP0}; pg8::gemm_phase<EpiStore, pg8::StaticOrder, true, true>(lds, g, S, E); if (REPS(2) > 1) { pg8::gemm_phase<EpiStore, pg8::StaticOrder, true, true>(lds, g, S, E); } } SEAM(2);
    if (IN(3)) {
        for (int rep = 0; rep < REPS(3); ++rep) for (int u = blockIdx.x; u < 32 * NCHUNK; u += G) gla_g1_unit(a, lds, u, tid, lane, wave);
        __syncthreads();
        for (int m = gw; m < NLAT; m += NGW) rope_row(P + (size_t)m * LDP0, m & 4095, lane);
        for (int u = gw; u < NBATCH * 2 * 68; u += NGW) vt_unit(P, LDP0, C_AV, 2, YF, u, lds + wave * 16384, lane);
    } SEAM(3);
    if (IN(4)) {
        for (int rep = 0; rep < REPS(4); ++rep) for (int wt = gw; wt < 2176; wt += NGW) window_attn_tile(a, wt, lane);
        gla_scan(a, tid);
    } SEAM(4);
    if (IN(5)) { for (int rep = 0; rep < REPS(5); ++rep) for (int u = blockIdx.x; u < 16 * NCHUNK; u += G) gla_g3_unit(a, lds, u, tid, lane, wave); } SEAM(5);
    if (IN(6)) { pg8::Gemm g{H, (const bf16*)(ws + WS_WABO), NLAT, D, D, D}; pg8::StaticOrder S; S.init(NLAT, D, G, (int)blockIdx.x);
        EpiStore E{YF, D}; pg8::gemm_phase<EpiStore, pg8::StaticOrder, true, true>(lds, g, S, E); if (REPS(6) > 1) { pg8::gemm_phase<EpiStore, pg8::StaticOrder, true, true>(lds, g, S, E); }
        { const int bx = (int)blockIdx.x, kc = bx >> 4, uu = bx & 15; OneUnit S1{uu >> 2, uu & 3, bx < 64};
          pg8::Gemm g1{H + (size_t)NLAT * D + kc * 256, (const bf16*)(ws + WS_WABO) + kc * 256, NCTX, D, D, 256};
          EpiStore E1{(bf16*)(ws + WS_PART) + (size_t)kc * NCTX * D, D}; pg8::gemm_phase<EpiStore, OneUnit, true, true>(lds, g1, S1, E1); } } SEAM(6);
    if (IN(7)) { for (int rep = 0; rep < REPS(7); ++rep) phase_rows(a, 1, 0, lane, wave); } SEAM(7);
    if (IN(8)) { pg8::Gemm g{H, (const bf16*)(ws + WS_WFI), MT, 2 * FF, D, D}; pg8::StaticOrder S; S.init(MT, 2 * FF, G, (int)blockIdx.x);
        EpiSwiglu E{P, FF}; pg8::gemm_phase<EpiSwiglu, pg8::StaticOrder, true, true>(lds, g, S, E); if (REPS(8) > 1) { pg8::gemm_phase<EpiSwiglu, pg8::StaticOrder, true, true>(lds, g, S, E); } } SEAM(8);
    if (IN(9)) { pg8::Gemm g{P, (const bf16*)(ws + WS_WFO), NLAT, D, FF, FF}; pg8::StaticOrder S; S.init(NLAT, D, G, (int)blockIdx.x);
        EpiStore E{YF, D}; pg8::gemm_phase<EpiStore, pg8::StaticOrder, true, true>(lds, g, S, E); if (REPS(9) > 1) { pg8::gemm_phase<EpiStore, pg8::StaticOrder, true, true>(lds, g, S, E); }
        { const int bx = (int)blockIdx.x, kc = bx >> 4, uu = bx & 15; OneUnit S1{uu >> 2, uu & 3, bx < 176};
          pg8::Gemm g1{P + (size_t)NLAT * FF + kc * 256, (const bf16*)(ws + WS_WFO) + kc * 256, NCTX, D, FF, 256};
          EpiStore E1{(bf16*)(ws + WS_PART) + (size_t)kc * NCTX * D, D}; pg8::gemm_phase<EpiStore, OneUnit, true, true>(lds, g1, S1, E1); } } SEAM(9);
    if (IN(10)) { phase_rows(a, 2, 0, lane, wave); } SEAM(10);
    if (IN(11)) { pg8::Gemm g{H, (const bf16*)(ws + WS_WNI), MT, LDP1, D, D}; pg8::StaticOrder S; S.init(MT, LDP1, G, (int)blockIdx.x);
        EpiStore E{P, LDP1}; pg8::gemm_phase<EpiStore, pg8::StaticOrder, true, true>(lds, g, S, E); if (REPS(11) > 1) { pg8::gemm_phase<EpiStore, pg8::StaticOrder, true, true>(lds, g, S, E); } } SEAM(11);
    if (IN(12)) { for (int rep = 0; rep < REPS(12); ++rep) for (int u = gw; u < NBATCH * 16 * 68; u += NGW) vt_unit(P, LDP1, 2048, 16, YF, u, lds + wave * 16384, lane); } SEAM(12);
    if (IN(13)) { for (int rep = 0; rep < REPS(13); ++rep) for (int u = blockIdx.x; u < 1024; u += G) na_attn_unit(a, lds, u, tid, lane, wave); } SEAM(13);
    if (IN(14)) { pg8::Gemm g{H, (const bf16*)(ws + WS_WNO), NLAT, D, D, D}; pg8::StaticOrder S; S.init(NLAT, D, G, (int)blockIdx.x);
        EpiStore E{YF, D}; pg8::gemm_phase<EpiStore, pg8::StaticOrder, true, true>(lds, g, S, E); if (REPS(14) > 1) { pg8::gemm_phase<EpiStore, pg8::StaticOrder, true, true>(lds, g, S, E); } } SEAM(14);
    if (IN(15)) { phase_rows(a, 1, 1, lane, wave); } SEAM(15);
    if (IN(16)) { pg8::Gemm g{H, (const bf16*)(ws + WS_WFI) + (size_t)5632 * 1024, NLAT, 2 * FF, D, D}; pg8::StaticOrder S; S.init(NLAT, 2 * FF, G, (int)blockIdx.x);
        EpiSwiglu E{P, FF}; pg8::gemm_phase<EpiSwiglu, pg8::StaticOrder, true, true>(lds, g, S, E); if (REPS(16) > 1) { pg8::gemm_phase<EpiSwiglu, pg8::StaticOrder, true, true>(lds, g, S, E); } } SEAM(16);
    if (IN(17)) { pg8::Gemm g{P, (const bf16*)(ws + WS_WFO) + (size_t)1024 * FF, NLAT, D, FF, FF}; pg8::StaticOrder S; S.init(NLAT, D, G, (int)blockIdx.x);
        EpiStore E{YF, D}; pg8::gemm_phase<EpiStore, pg8::StaticOrder, true, true>(lds, g, S, E); if (REPS(17) > 1) { pg8::gemm_phase<EpiStore, pg8::StaticOrder, true, true>(lds, g, S, E); } } SEAM(17);
    if (IN(18)) { phase_rows(a, 2, 1, lane, wave); }
#undef IN
#undef SEAM
}

extern "C" void kernel_launch(void* const* d_in, const int* in_sizes, int n_in, void* d_out, int out_size, void* d_ws, size_t ws_size, hipStream_t stream) {
    static int grid = 0;
    if (grid == 0) {
        if (n_in != 23 || out_size != NLAT * D || ws_size < WS_END) { fprintf(stderr, "kernel_launch: unexpected problem shape (n_in %d, out %d, ws %zu)\n", n_in, out_size, ws_size); grid = -1; return; }
        int dev = 0, cus = 0, per_cu = 0;
        (void)hipGetDevice(&dev); (void)hipDeviceGetAttribute(&cus, hipDeviceAttributeMultiprocessorCount, dev);
        if (hipFuncSetAttribute((const void*)fwd_kernel, hipFuncAttributeMaxDynamicSharedMemorySize, LDS_BYTES) != hipSuccess) { fprintf(stderr, "kernel_launch: hipFuncSetAttribute failed\n"); grid = -1; return; }
        (void)hipOccupancyMaxActiveBlocksPerMultiprocessor(&per_cu, (const void*)fwd_kernel, NTHR, LDS_BYTES);
        if (per_cu < 1) per_cu = 1;
        (void)hipGetLastError();
        grid = cus * per_cu;
    }
    if (grid < 0) return;
    Args a{};
    for (int i = 0; i < 23; ++i) a.in[i] = (const float*)d_in[i];
    a.out = (float*)d_out; a.ws = (unsigned char*)d_ws;
#if COOP
    a.ph_lo = 0; a.ph_hi = NPHASE;
    void* args[] = {&a};
    hipError_t e = hipLaunchCooperativeKernel((const void*)fwd_kernel, dim3(grid), dim3(NTHR), args, LDS_BYTES, stream);
    if (e != hipSuccess) fprintf(stderr, "cooperative launch failed: %s (grid %d)\n", hipGetErrorString(e), grid);
#else
    for (int p = 0; p < NPHASE; ++p) { a.ph_lo = p; a.ph_hi = p + 1; hipLaunchKernelGGL(fwd_kernel, dim3(grid), dim3(NTHR), LDS_BYTES, stream, a); }
#endif
}
```

```cpp
#include <hip/hip_runtime.h>
#include <hip/hip_cooperative_groups.h>
#include <cstdio>
#include <cstdint>
namespace cg = cooperative_groups;
namespace pg8 {
#define PG8_LAS __attribute__((address_space(3)))
typedef unsigned short bf16_t;
typedef short bf16x8 __attribute__((ext_vector_type(8)));
typedef float f32x4 __attribute__((ext_vector_type(4)));
typedef unsigned u32x4 __attribute__((ext_vector_type(4)));
constexpr int BM = 256, BK = 64, HALF = 128, HTB = HALF * BK * 2  , STAGE_BYTES = 8 * HTB, NXCD = 8, WGM = 8;

__host__ __device__ __forceinline__ int lds_byte(int r, int c) { const int st = (r >> 4) * 2 + (c >> 5), rr = r & 15, cc = c & 31, ob = rr * 64 + cc * 2; return st * 1024 + (ob ^ (((ob >> 9) & 1) << 5)); }
__host__ __device__ __forceinline__ void stage_rc(int b, int& R, int& C) { const int st = b / 1024, sb = b % 1024, swz = sb ^ (((sb >> 9) & 1) << 5); R = (st >> 1) * 16 + swz / 64; C = (st & 1) * 32 + (swz % 64) / 2; }
__host__ __device__ __forceinline__ int perm32(int rho) { const int n = rho >> 4, i = rho & 15; return 8 * (i >> 2) + 4 * n + (i & 3); }

struct Unit { int pm, pn; };
struct Gemm { const bf16_t* A; const bf16_t* Bt; int M, N, K, Kext; };

struct StaticOrder {
    int nM, nN, nwg, G, c;
    __host__ __device__ void init(int M, int N, int G_, int c_) { nM = M / BM; nN = N / BM; nwg = nM * nN; G = G_; c = c_; }
    __host__ __device__ bool next(int i, Unit& u) const {
        const long L = (long)i * G + c; if (L >= nwg) return false;
        int wgid = (int)L; { const int q = nwg / NXCD, r = nwg % NXCD, xcd = wgid % NXCD, off = wgid / NXCD; wgid = (xcd < r ? xcd * (q + 1) : r * (q + 1) + (xcd - r) * q) + off; }
        const int nig = WGM * nN, gid = wgid / nig, fm = gid * WGM, gsz = (nM - fm) < WGM ? (nM - fm) : WGM;
        u.pm = fm + ((wgid % nig) % gsz); u.pn = (wgid % nig) / gsz; return true;
    }
    __device__ __forceinline__ void a_ready(const Unit&) const {}
    __device__ __forceinline__ void done(const Unit&) const {}
};

__device__ __forceinline__ unsigned cvt_pk_bf16(float lo, float hi) { unsigned r; asm volatile("v_cvt_pk_bf16_f32 %0, %1, %2" : "=v"(r) : "v"(lo), "v"(hi)); return r; }
template <class Epi, class Sched, bool ALIGN_EPI = false, bool SP2 = false>
__device__ __forceinline__ void gemm_phase(PG8_LAS unsigned char* lds, const Gemm g, const Sched& S, const Epi& E) {
    const int tid = threadIdx.x, wid = __builtin_amdgcn_readfirstlane(tid >> 6), lane = tid & 63, wr = wid >> 2, wc = wid & 3, fr = lane & 15, fq = lane >> 4;
    const int K = g.K, nt = g.Kext / BK;
    unsigned voffA[2], voffB[2];
#pragma unroll
    for (int i = 0; i < 2; ++i) { int R, C; stage_rc(tid * 16 + i * 8192, R, C); const int Rb = Epi::PERM ? ((R & ~31) + perm32(R & 31)) : R;
        voffA[i] = (unsigned)(R * K + C) * 2u; voffB[i] = (unsigned)(Rb * K + C) * 2u; }
    const size_t kstep = (size_t)(BK * 2);
    const size_t hstep = (size_t)HALF * K * 2;
    const size_t tstep = 2 * hstep;
    const unsigned ldsw = (unsigned)wid * 1024u;
    const int aoff = lds_byte(wr * 64 + fr, fq * 8), boff = lds_byte(wc * 32 + fr, fq * 8);
#define PG8_SA(b, h) (((b) * 2 + (h)) * HTB)
#define PG8_SB(b, h) ((4 + (b) * 2 + (h)) * HTB)
#define PG8_STAGE(bufoff, gbase, voff) do { _Pragma("unroll") for (int _i = 0; _i < 2; ++_i) \
        __builtin_amdgcn_global_load_lds((const unsigned*)((const char*)(gbase) + (voff)[_i]), (PG8_LAS unsigned*)(lds + (bufoff) + ldsw + _i * 8192), 16, 0, 0); } while (0)
#define PG8_LDA(dst, b, h) do { _Pragma("unroll") for (int m = 0; m < 4; ++m) _Pragma("unroll") for (int k = 0; k < 2; ++k) dst[m][k] = *(const PG8_LAS bf16x8*)(lds + PG8_SA(b, h) + aoff + m * 2048 + k * 1024); } while (0)
#define PG8_LDB(dst, b, h) do { _Pragma("unroll") for (int n = 0; n < 2; ++n) _Pragma("unroll") for (int k = 0; k < 2; ++k) dst[n][k] = *(const PG8_LAS bf16x8*)(lds + PG8_SB(b, h) + boff + n * 2048 + k * 1024); } while (0)
#define PG8_MMA(ai, bj, At, Bt) do { __builtin_amdgcn_s_setprio(1); _Pragma("unroll") for (int m = 0; m < 4; ++m) _Pragma("unroll") for (int n = 0; n < 2; ++n) _Pragma("unroll") for (int k = 0; k < 2; ++k) \
        acc[ai][bj][m][n] = __builtin_amdgcn_mfma_f32_16x16x32_bf16(Bt[n][k], At[m][k], acc[ai][bj][m][n], 0, 0, 0); __builtin_amdgcn_s_setprio(0); } while (0)
#define PG8_WAIT_V(n) asm volatile("s_waitcnt vmcnt(" #n ")" ::: "memory")
#define PG8_WAIT_L(n) asm volatile("s_waitcnt lgkmcnt(" #n ")" ::: "memory")
#define PG8_BAR __builtin_amdgcn_s_barrier()
#define PG8_SCHED __builtin_amdgcn_sched_barrier(0)
    Unit cur, nxt; int ui = 0;
    if (!S.next(0, cur)) return;
    f32x4 acc[2][2][4][2];
#pragma unroll
    for (int a = 0; a < 2; ++a)
#pragma unroll
        for (int b = 0; b < 2; ++b)
#pragma unroll
            for (int m = 0; m < 4; ++m)
#pragma unroll
                for (int n = 0; n < 2; ++n) acc[a][b][m][n] = (f32x4){0.f, 0.f, 0.f, 0.f};
    bf16x8 At[4][2], B0[2][2], B1[2][2];
    const char* cA = (const char*)g.A + (size_t)cur.pm * tstep; const char* cB = (const char*)g.Bt + (size_t)cur.pn * tstep;
    S.a_ready(cur);
    if constexpr (SP2) {
        PG8_STAGE(PG8_SB(0, 0), cB, voffB); PG8_STAGE(PG8_SB(0, 1), cB + hstep, voffB); PG8_STAGE(PG8_SA(0, 0), cA, voffA); PG8_STAGE(PG8_SA(0, 1), cA + hstep, voffA);
        if (wr == 1) PG8_BAR;
        PG8_WAIT_V(2); PG8_BAR;
        PG8_STAGE(PG8_SB(1, 0), cB + kstep, voffB); PG8_STAGE(PG8_SA(1, 0), cA + kstep, voffA); PG8_STAGE(PG8_SB(1, 1), cB + hstep + kstep, voffB);
        PG8_WAIT_V(6); PG8_BAR;
    } else {
        PG8_STAGE(PG8_SB(0, 0), cB, voffB); PG8_STAGE(PG8_SA(0, 0), cA, voffA); PG8_STAGE(PG8_SB(0, 1), cB + hstep, voffB); PG8_STAGE(PG8_SA(0, 1), cA + hstep, voffA);
        if (wr == 1) PG8_BAR;
        PG8_WAIT_V(4); PG8_BAR;
        PG8_STAGE(PG8_SB(1, 0), cB + kstep, voffB); PG8_STAGE(PG8_SA(1, 0), cA + kstep, voffA); PG8_STAGE(PG8_SB(1, 1), cB + hstep + kstep, voffB);
        PG8_WAIT_V(6); PG8_BAR;
    }
    for (;;) {
        const bool has_next = S.next(ui + 1, nxt);
        const char* nA = has_next ? (const char*)g.A + (size_t)nxt.pm * tstep : cA; const char* nB = has_next ? (const char*)g.Bt + (size_t)nxt.pn * tstep : cB;
        for (int t = 0; t < nt; t += 2) {
            const bool last = (t == nt - 2);
            const char* a1 = cA + (size_t)(t + 1) * kstep;
            const char* a2 = last ? nA : cA + (size_t)(t + 2) * kstep; const char* b2 = last ? nB : cB + (size_t)(t + 2) * kstep;
            const char* a3 = a2 + kstep; const char* b3 = b2 + kstep;
            if (last && has_next) S.a_ready(nxt);
            if constexpr (SP2) {
            PG8_LDB(B0, 0, 0); PG8_LDB(B1, 0, 1); PG8_SCHED; PG8_LDA(At, 0, 0); PG8_STAGE(PG8_SA(1, 1), a1 + hstep, voffA);
            PG8_WAIT_V(8); PG8_WAIT_L(0); PG8_BAR; PG8_MMA(0, 0, At, B0); PG8_MMA(0, 1, At, B1); PG8_BAR; PG8_SCHED;
            PG8_LDA(At, 0, 1); PG8_STAGE(PG8_SB(0, 0), b2, voffB); PG8_STAGE(PG8_SB(0, 1), b2 + hstep, voffB); PG8_STAGE(PG8_SA(0, 0), a2, voffA);
            PG8_WAIT_V(8); PG8_WAIT_L(0); PG8_BAR; PG8_MMA(1, 0, At, B0); PG8_MMA(1, 1, At, B1); PG8_BAR; PG8_SCHED;
            PG8_LDB(B0, 1, 0); PG8_LDB(B1, 1, 1); PG8_SCHED; PG8_LDA(At, 1, 0); PG8_STAGE(PG8_SA(0, 1), a2 + hstep, voffA);
            PG8_WAIT_V(8); PG8_WAIT_L(0); PG8_BAR; PG8_MMA(0, 0, At, B0); PG8_MMA(0, 1, At, B1); PG8_BAR; PG8_SCHED;
            PG8_LDA(At, 1, 1); PG8_STAGE(PG8_SB(1, 0), b3, voffB); PG8_STAGE(PG8_SB(1, 1), b3 + hstep, voffB); PG8_STAGE(PG8_SA(1, 0), a3, voffA);
            PG8_WAIT_V(8); PG8_WAIT_L(0); PG8_BAR; PG8_MMA(1, 0, At, B0); PG8_MMA(1, 1, At, B1); PG8_BAR; PG8_SCHED;
            } else {
            PG8_LDB(B0, 0, 0); PG8_SCHED; PG8_LDA(At, 0, 0); PG8_STAGE(PG8_SA(1, 1), a1 + hstep, voffA);
            PG8_WAIT_L(8); PG8_BAR; PG8_WAIT_L(0); PG8_MMA(0, 0, At, B0); PG8_BAR; PG8_SCHED;
            PG8_LDB(B1, 0, 1); PG8_STAGE(PG8_SB(0, 0), b2, voffB);
            PG8_BAR; PG8_WAIT_L(0); PG8_MMA(0, 1, At, B1); PG8_BAR;
            PG8_LDA(At, 0, 1); PG8_STAGE(PG8_SA(0, 0), a2, voffA);
            PG8_BAR; PG8_WAIT_L(0); PG8_MMA(1, 0, At, B0); PG8_BAR; PG8_SCHED;
            PG8_STAGE(PG8_SB(0, 1), b2 + hstep, voffB);
            PG8_WAIT_V(6); PG8_BAR; PG8_MMA(1, 1, At, B1); PG8_BAR;
            PG8_LDB(B0, 1, 0); PG8_SCHED; PG8_LDA(At, 1, 0); PG8_STAGE(PG8_SA(0, 1), a2 + hstep, voffA);
            PG8_WAIT_L(8); PG8_BAR; PG8_WAIT_L(0); PG8_MMA(0, 0, At, B0); PG8_BAR; PG8_SCHED;
            PG8_LDB(B1, 1, 1); PG8_STAGE(PG8_SB(1, 0), b3, voffB);
            PG8_BAR; PG8_WAIT_L(0); PG8_MMA(0, 1, At, B1); PG8_BAR;
            PG8_LDA(At, 1, 1); PG8_STAGE(PG8_SA(1, 0), a3, voffA);
            PG8_BAR; PG8_WAIT_L(0); PG8_MMA(1, 0, At, B0); PG8_BAR; PG8_SCHED;
            PG8_STAGE(PG8_SB(1, 1), b3 + hstep, voffB);
            PG8_WAIT_V(6); PG8_BAR; PG8_MMA(1, 1, At, B1); PG8_BAR;
            }
        }
        if constexpr (ALIGN_EPI) { if (wr == 0) PG8_BAR; }
        if constexpr (!Epi::AFTER_DRAIN) { E(acc, cur, wr, wc, fr, fq); S.done(cur); }
        if (!has_next) break;
#pragma unroll
        for (int a = 0; a < 2; ++a)
#pragma unroll
            for (int b = 0; b < 2; ++b)
#pragma unroll
                for (int m = 0; m < 4; ++m)
#pragma unroll
                    for (int n = 0; n < 2; ++n) acc[a][b][m][n] = (f32x4){0.f, 0.f, 0.f, 0.f};
        cur = nxt; cA = nA; cB = nB; ++ui;
        if constexpr (ALIGN_EPI) { if (wr == 1) PG8_BAR; }
    }
    PG8_WAIT_V(0);
    if constexpr (!ALIGN_EPI) { if (wr == 0) PG8_BAR; }
    PG8_BAR;
    if constexpr (Epi::AFTER_DRAIN) { E.fused(acc, cur, wr, wc, fr, fq, lds, wid, lane); S.done(cur); }
#undef PG8_SA
#undef PG8_SB
#undef PG8_STAGE
#undef PG8_LDA
#undef PG8_LDB
#undef PG8_MMA
#undef PG8_WAIT_V
#undef PG8_WAIT_L
#undef PG8_BAR
#undef PG8_SCHED
}
}
__device__ const float ROPE_COS[1024] = {1.f,1.f,1.f,1.f,1.f,1.f,1.f,1.f,1.f,1.f,1.f,1.f,1.f,1.f,1.f,1.f,0.540302277f,0.846009135f,0.950415254f,0.98423022f,0.995004177f,0.998419285f,0.999500036f,0.999841869f,0.999949992f,0.999984205f,0.999994993f,0.999998391f,0.999999523f,0.999999821f,0.99999994f,1.f,-0.416146845f,0.431462824f,0.806578398f,0.937418282f,0.980066597f,0.993682086f,0.998000681f,0.999367595f,0.999800026f,0.999936759f,0.999979973f,0.999993682f,0.999997973f,0.999999344f,0.999999821f,0.99999994f,-0.989992499f,-0.115966164f,0.582753658f,0.861040652f,0.955336511f,0.985803485f,0.995503366f,0.998577297f,0.999550045f,0.999857724f,0.999954998f,0.999985754f,0.99999553f,0.999998569f,0.999999523f,0.999999881f,-0.653643608f,-0.627679706f,0.301137477f,0.757506192f,0.921060979f,0.974808276f,0.992010653f,0.997471273f,0.999200106f,0.999747038f,0.999920011f,0.999974728f,0.999992013f,0.999997497f,0.999999225f,0.999999762f,0.2836622f,-0.946079254f,-0.0103423381f,0.630080283f,0.87758255f,0.960731268f,0.987526f,0.996049762f,0.998750269f,0.999604762f,0.999875009f,0.999960482f,0.999987483f,0.999996066f,0.999998748f,0.999999583f,0.960170269f,-0.973103702f,-0.3207964f,0.482782036f,0.825335622f,0.943616986f,0.982053936f,0.9943133f,0.998200536f,0.999430835f,0.999819994f,0.999943078f,0.999981999f,0.999994338f,0.999998212f,0.999999404f,0.753902256f,-0.700429797f,-0.599437475f,0.320257008f,0.764842212f,0.923519433f,0.975599885f,0.992262423f,0.997551024f,0.999225318f,0.999755025f,0.999922514f,0.999975502f,0.999992251f,0.999997556f,0.999999225f,-0.145500034f,-0.212036446f,-0.818632424f,0.147631213f,0.696706712f,0.900502324f,0.968170285f,0.989897788f,0.996801734f,0.998988271f,0.999680042f,0.999898791f,0.999967992f,0.999989867f,0.999996781f,0.999998987f,-0.91113025f,0.341660261f,-0.956644177f,-0.0296507962f,0.621609926f,0.874638259f,0.959772646f,0.987220109f,0.995952725f,0.998719573f,0.999595046f,0.99987191f,0.999959528f,0.999987185f,0.999995947f,0.999998748f,-0.839071512f,0.790131867f,-0.999786079f,-0.205997631f,0.540302277f,0.846009135f,0.950415313f,0.98423022f,0.995004177f,0.998419285f,0.999500036f,0.999841869f,0.999949992f,0.999984205f,0.999994993f,0.999998391f,0.00442569796f,0.995257378f,-0.943779767f,-0.375847399f,0.453596085f,0.814705312f,0.940107584f,0.980929136f,0.993956089f,0.998087406f,0.999395072f,0.999808669f,0.999939501f,0.999980867f,0.99999392f,0.999998093f,0.843853951f,0.893861592f,-0.79417938f,-0.53384304f,0.362357706f,0.780825913f,0.92885989f,0.97731787f,0.99280864f,0.997723997f,0.999280095f,0.99977231f,0.999927998f,0.999977231f,0.999992788f,0.999997735f,0.907446802f,0.517172873f,-0.565820515f,-0.675001681f,0.267498761f,0.744477987f,0.916683376f,0.973397553f,0.99156189f,0.997329056f,0.999155104f,0.999732792f,0.999915481f,0.999973297f,0.999991536f,0.999997318f,0.136737213f,-0.0187961515f,-0.28134948f,-0.794870913f,0.16996716f,0.705776393f,0.903590262f,0.969169438f,0.990216017f,0.996902585f,0.999020159f,0.999690115f,0.99990201f,0.999969006f,0.999990225f,0.999996901f,-0.759687901f,-0.548975468f,0.0310223512f,-0.889670432f,0.070737198f,0.6648435f,0.889593601f,0.964634836f,0.988771081f,0.996444523f,0.998875201f,0.999644279f,0.999887526f,0.999964416f,0.999988735f,0.999996424f,-0.957659483f,-0.910081089f,0.340318173f,-0.95641005f,-0.0291995462f,0.621808827f,0.87470746f,0.959795177f,0.987227261f,0.99595499f,0.998720288f,0.999595284f,0.999872029f,0.999959528f,0.999987185f,0.999995947f,-0.275163352f,-0.990897954f,0.615864813f,-0.99298501f,-0.128844544f,0.576808274f,0.858946681f,0.954652011f,0.985584795f,0.995433986f,0.998555362f,0.999543071f,0.999855518f,0.999954283f,0.999985576f,0.99999541f,0.660316706f,-0.766536534f,0.830336154f,-0.998241663f,-0.227202162f,0.529984176f,0.842327058f,0.949207008f,0.983843684f,0.994881511f,0.998380423f,0.999487758f,0.999837995f,0.9999488f,0.999983788f,0.999994874f,0.988704622f,-0.306095392f,0.962463796f,-0.972014248f,-0.323289543f,0.481484592f,0.824865162f,0.943461835f,0.982004225f,0.994297504f,0.998195529f,0.999429286f,0.999819517f,0.999942899f,0.99998194f,0.999994278f,0.408082068f,0.248616725f,0.999144375f,-0.91512996f,-0.416146845f,0.431462824f,0.806578457f,0.937418282f,0.980066597f,0.993682086f,0.998000681f,0.999367595f,0.999800026f,0.999936759f,0.999979973f,0.999993682f,-0.547729254f,0.726760268f,0.936740458f,-0.829382956f,-0.504846215f,0.380077004f,0.787485182f,0.931078374f,0.97803092f,0.993035257f,0.99779582f,0.999302804f,0.999779522f,0.999930263f,0.999977946f,0.999993026f,-0.99996084f,0.981074572f,0.781440377f,-0.717477441f,-0.588501155f,0.327489585f,0.767604589f,0.92444396f,0.975897431f,0.992357016f,0.997581005f,0.999234855f,0.999758005f,0.999923468f,0.999975801f,0.999992371f,-0.53283304f,0.933235765f,0.548645258f,-0.582943261f,-0.666275978f,0.273866832f,0.746956408f,0.917517304f,0.97366637f,0.991647422f,0.997356176f,0.999163687f,0.999735534f,0.999916375f,0.999973536f,0.999991655f,0.424179018f,0.597977161f,0.261441678f,-0.430023283f,-0.737393796f,0.219378278f,0.725561321f,0.910300434f,0.971337974f,0.990906477f,0.997121394f,0.99908942f,0.99971199f,0.999908924f,0.999971211f,0.99999088f,0.991202831f,0.078552261f,-0.0516893305f,-0.263540596f,-0.801143587f,0.164196163f,0.703440726f,0.902795732f,0.968912423f,0.99013412f,0.996876657f,0.999011934f,0.999687493f,0.999901175f,0.999968767f,0.999990106f,0.64691931f,-0.465064496f,-0.359694332f,-0.0887455046f,-0.856888831f,0.108494945f,0.680616796f,0.895005584f,0.966389954f,0.98933053f,0.996621907f,0.998931348f,0.999662042f,0.999893129f,0.999966204f,0.999989331f,-0.292138815f,-0.865450621f,-0.632028639f,0.088848114f,-0.904072165f,0.0524506159f,0.6571123f,0.886932373f,0.963770926f,0.988495648f,0.996357203f,0.998847544f,0.999635518f,0.999884725f,0.999963522f,0.999988496f,-0.962605894f,-0.999293387f,-0.841684937f,0.26363951f,-0.942222297f,-0.00375941908f,0.632950664f,0.878578722f,0.961055458f,0.987629473f,0.996082544f,0.998760641f,0.99960804f,0.999876022f,0.99996078f,0.999987602f,-0.748057544f,-0.825371623f,-0.967871487f,0.430115849f,-0.970958173f,-0.0599575676f,0.608156204f,0.869947195f,0.958243906f,0.986732066f,0.995797932f,0.998670578f,0.999579549f,0.999867022f,0.999957979f,0.999986708f,0.154251456f,-0.397251874f,-0.998075247f,0.583026946f,-0.989992499f,-0.115966164f,0.582753658f,0.861040652f,0.955336511f,0.985803485f,0.995503366f,0.998577297f,0.999550045f,0.999857724f,0.999954998f,0.999985754f,0.914742351f,0.153215483f,-0.929300308f,0.717549205f,-0.999135137f,-0.171608135f,0.556768358f,0.851861775f,0.95233357f,0.984843671f,0.995198846f,0.998480916f,0.999519527f,0.999848068f,0.999951959f,0.999984801f,0.83422339f,0.656495154f,-0.768367112f,0.829440355f,-0.998294771f,-0.226707578f,0.53022635f,0.842413545f,0.949235439f,0.983852804f,0.994884372f,0.998381376f,0.999488056f,0.999838114f,0.9999488f,0.999983788f,-0.0132767474f,0.95758605f,-0.531235278f,0.915171385f,-0.987479806f,-0.281090319f,0.503154159f,0.832698941f,0.946042359f,0.982830763f,0.994559944f,0.998278618f,0.999455571f,0.999827802f,0.999945521f,0.999982774f,-0.848570287f,0.963757515f,-0.241421118f,0.972038329f,-0.966798186f,-0.334584385f,0.475578904f,0.822721004f,0.942754686f,0.981777668f,0.994225562f,0.99817276f,0.999422073f,0.999817252f,0.999942183f,0.999981701f,-0.903692186f,0.673110247f,0.0723346695f,0.998247743f,-0.93645668f,-0.387020677f,0.447528064f,0.812482953f,0.939372718f,0.980693519f,0.993881226f,0.998063743f,0.999387562f,0.999806345f,0.999938726f,0.999980628f,-0.127963692f,0.175156534f,0.378916174f,0.992972851f,-0.896758378f,-0.438233554f,0.419029742f,0.801987886f,0.935896814f,0.979578316f,0.993526995f,0.997951567f,0.999352098f,0.999795079f,0.99993521f,0.999979496f,0.765414059f,-0.376742303f,0.647921681f,0.95638001f,-0.848100007f,-0.488060862f,0.39011243f,0.791239262f,0.93232733f,0.978432178f,0.993162811f,0.997836173f,0.99931556f,0.999783576f,0.999931574f,0.999978364f,0.955073655f,-0.812611222f,0.852673113f,0.889623463f,-0.790967762f,-0.536345184f,0.360805035f,0.780240417f,0.928664625f,0.977255106f,0.992788672f,0.997717679f,0.999278069f,0.999771714f,0.999927819f,0.999977171f,0.266642928f,-0.998210371f,0.972865343f,0.794808388f,-0.72593224f,-0.582933903f,0.331136853f,0.768994927f,0.924909055f,0.976047099f,0.99240464f,0.997596025f,0.999239624f,0.999759495f,0.999923944f,0.999975979f,-0.666938066f,-0.87637943f,0.996578991f,0.674925625f,-0.653643608f,-0.627679706f,0.301137596f,0.757506192f,0.921060979f,0.974808276f,0.992010653f,0.997471273f,0.999200106f,0.999747038f,0.999920011f,0.999974728f,-0.987339258f,-0.484639406f,0.921462357f,0.533756077f,-0.574824035f,-0.670441091f,0.270837069f,0.745777905f,0.917120814f,0.973538578f,0.991606772f,0.997343302f,0.999159634f,0.999734223f,0.999915957f,0.999973416f,-0.399985313f,0.0563609414f,0.754965365f,0.375752151f,-0.490260571f,-0.711082935f,0.240265876f,0.733813822f,0.913088918f,0.972238123f,0.991192937f,0.997212172f,0.999118149f,0.99972111f,0.999911785f,0.999972105f,0.555113316f,0.580003142f,0.513598442f,0.205897167f,-0.400799006f,-0.749476731f,0.209454417f,0.721617639f,0.908965766f,0.970906913f,0.990769207f,0.997077882f,0.999075651f,0.999707639f,0.999907553f,0.999970794f,0.999843299f,0.925014675f,0.221298173f,0.0295478199f,-0.307332784f,-0.785501122f,0.178433523f,0.709193349f,0.904751658f,0.969545007f,0.990335584f,0.996940494f,0.99903214f,0.99969393f,0.999903202f,0.999969363f,0.52532196f,0.985138178f,-0.0929481089f,-0.147732988f,-0.210795805f,-0.819042206f,0.147234216f,0.696544766f,0.90044713f,0.968152404f,0.989892066f,0.996799886f,0.998987675f,0.999679863f,0.999898732f,0.999967992f,-0.432177931f,0.741858006f,-0.397976756f,-0.320354372f,-0.112152621f,-0.849993885f,0.115887694f,0.683675885f,0.89605248f,0.966729224f,0.989438653f,0.996656179f,0.998942196f,0.999665439f,0.999894202f,0.999966562f,-0.992335498f,0.270098448f,-0.663538277f,-0.48287195f,-0.0123883775f,-0.878258407f,0.0844252855f,0.670590878f,0.891568303f,0.965275466f,0.988975346f,0.996509314f,0.998895705f,0.999650776f,0.999889553f,0.999965072f,-0.640144348f,-0.284846604f,-0.863296509f,-0.630159974f,0.0874991715f,-0.903746367f,0.0528784581f,0.657293737f,0.886994898f,0.963791192f,0.988502085f,0.996359289f,0.9988482f,0.999635756f,0.999884784f,0.999963582f,0.300592542f,-0.75206399f,-0.977442741f,-0.757573068f,0.18651247f,-0.926377118f,0.0212787576f,0.643788815f,0.882332861f,0.962276459f,0.98801899f,0.996206105f,0.998799741f,0.999620378f,0.999879956f,0.999962032f,0.964965999f,-0.987659097f,-0.994656444f,-0.861092687f,0.2836622f,-0.946079254f,-0.0103422189f,0.630080283f,0.87758255f,0.960731268f,0.987526f,0.996049762f,0.998750269f,0.999604762f,0.999875009f,0.999960482f,0.742154181f,-0.919073522f,-0.913230121f,-0.937454224f,0.377977669f,-0.96279037f,-0.0419528559f,0.616172493f,0.872744501f,0.959155679f,0.987023175f,0.99589026f,0.998699784f,0.999588788f,0.999869943f,0.999958873f,-0.162990779f,-0.567430019f,-0.741239965f,-0.984248459f,0.468516916f,-0.976457715f,-0.0735215396f,0.602069914f,0.86781919f,0.95754981f,0.986510456f,0.995727658f,0.998648286f,0.999572515f,0.999864817f,0.999957263f,-0.918282807f,-0.0410281904f,-0.495741814f,-1.f,0.554374516f,-0.987038016f,-0.105016708f,0.587776959f,0.862807095f,0.955913603f,0.985987842f,0.995561838f,0.998595834f,0.999555886f,0.999859571f,0.999955595f,-0.829309821f,0.498009592f,-0.201079622f,-0.984212041f,0.634692967f,-0.994497895f,-0.136406869f,0.573298037f,0.857708693f,0.954247177f,0.985455394f,0.995392919f,0.998542368f,0.999538958f,0.999854207f,0.999953866f,0.0221267566f,0.883669317f,0.113521777f,-0.937382519f,0.708669782f,-0.998813629f,-0.167660639f,0.558637917f,0.852524519f,0.95255059f,0.984913111f,0.99522084f,0.99848789f,0.999521732f,0.999848783f,0.999952197f,0.853220105f,0.997174621f,0.416867077f,-0.860988438f,0.775565803f,-0.999971747f,-0.198746875f,0.543801069f,0.847255111f,0.950823903f,0.984360933f,0.995045662f,0.998432398f,0.999504209f,0.99984318f,0.999950409f,0.899866819f,0.803569078f,0.678870201f,-0.757439196f,0.834712923f,-0.997968495f,-0.22963427f,0.528792322f,0.841901004f,0.949067116f,0.983798921f,0.994867265f,0.998375952f,0.999486327f,0.999837577f,0.999948621f,0.119180135f,0.362476677f,0.873550534f,-0.63000071f,0.885519624f,-0.99281019f,-0.260292053f,0.513616323f,0.836462677f,0.947280347f,0.983227074f,0.994685769f,0.998318493f,0.999468148f,0.999831796f,0.999946833f,-0.771080196f,-0.1902491f,0.981602073f,-0.482692331f,0.927478492f,-0.984513164f,-0.290689558f,0.498277903f,0.830940723f,0.945463598f,0.982645452f,0.994501114f,0.998260021f,0.99944967f,0.999825954f,0.999944985f,-0.952412963f,-0.684381902f,0.992308319f,-0.320159167f,0.960170269f,-0.973103702f,-0.3207964f,0.482782036f,0.825335622f,0.943616986f,0.982053936f,0.9943133f,0.998200536f,0.999430835f,0.999819994f,0.999943078f,-0.258101642f,-0.967739642f,0.904607594f,-0.1475292f,0.98326844f,-0.958617806f,-0.350582451f,0.467133403f,0.819648027f,0.941740453f,0.981452644f,0.994122326f,0.998140097f,0.999411702f,0.999813974f,0.99994117f,0.673507154f,-0.953050017f,0.727198064f,0.0297537707f,0.996542096f,-0.941101313f,-0.380017966f,0.451337039f,0.813878477f,0.939834237f,0.980841517f,0.993928254f,0.998078644f,0.999392271f,0.999807835f,0.999939203f,0.985896587f,-0.644837022f,0.477671444f,0.206098333f,0.999858618f,-0.920609534f,-0.409073502f,0.435397953f,0.808027506f,0.937898219f,0.980220556f,0.993731022f,0.998016179f,0.999372482f,0.999801576f,0.999937236f};
__device__ const float ROPE_SIN[1024] = {0.f,0.f,0.f,0.f,0.f,0.f,0.f,0.f,0.f,0.f,0.f,0.f,0.f,0.f,0.f,0.f,0.841470957f,0.533168435f,0.310983598f,0.176892191f,0.0998334214f,0.0562044978f,0.0316175036f,0.0177818574f,0.00999983307f,0.00562338345f,0.00316227227f,0.0017782785f,0.000999999931f,0.000562341243f,0.000316227757f,0.00017782794f,0.909297407f,0.902130723f,0.591127098f,0.348205268f,0.198669329f,0.112231314f,0.0632033944f,0.0355580896f,0.0199986659f,0.011246589f,0.00632451288f,0.00355655141f,0.0019999987f,0.00112468237f,0.000632455456f,0.00035565588f,0.141120002f,0.993253171f,0.812648892f,0.5085361f,0.295520216f,0.167903304f,0.0947260857f,0.0533230826f,0.0299954992f,0.0168694388f,0.00948669016f,0.00533481315f,0.0029999956f,0.00168702309f,0.000948683126f,0.000533483806f,-0.756802499f,0.778471708f,0.953580737f,0.652827978f,0.389418334f,0.223044485f,0.126154065f,0.0710712075f,0.0399893336f,0.0224917568f,0.0126487734f,0.00711305765f,0.00399998948f,0.00224936334f,0.00126491068f,0.000711311703f,-0.958924294f,0.32393527f,0.999946535f,0.776529968f,0.47942555f,0.277480543f,0.157455876f,0.0887968615f,0.0499791652f,0.0281133614f,0.0158107281f,0.00889127981f,0.0049999794f,0.0028117029f,0.00158113812f,0.000889139599f,-0.279415488f,-0.230367512f,0.947148204f,0.875740528f,0.564642489f,0.33103931f,0.188600272f,0.106494442f,0.0599640049f,0.0337340795f,0.0189725272f,0.0106694745f,0.0059999642f,0.00337404152f,0.00189736532f,0.00106696738f,0.656986594f,-0.713721275f,0.800421596f,0.947330713f,0.64421767f,0.383551568f,0.219556093f,0.124158338f,0.0699428469f,0.0393537246f,0.0221341345f,0.0124476347f,0.00699994294f,0.00393637875f,0.00221359241f,0.00124479528f,0.989358246f,-0.977261782f,0.574317753f,0.989042461f,0.717356086f,0.434851229f,0.250292331f,0.141782969f,0.0799146891f,0.0449721329f,0.0252955221f,0.0142257558f,0.0079999147f,0.00449871505f,0.00252981926f,0.00142262306f,0.412118495f,-0.939823508f,0.291259229f,0.999560297f,0.783326924f,0.484776139f,0.280778319f,0.159362778f,0.0898785442f,0.0505891182f,0.0284566563f,0.0160038304f,0.00899987947f,0.00506105041f,0.00284604589f,0.00160045072f,-0.54402113f,-0.612936914f,-0.0206835698f,0.978552461f,0.841470957f,0.533168435f,0.310983568f,0.176892191f,0.099833414f,0.0562044978f,0.0316175036f,0.0177818574f,0.009999834f,0.00562338345f,0.00316227227f,0.0017782785f,-0.999990225f,-0.0972764567f,-0.33057496f,0.926681578f,0.891207397f,0.579875171f,0.340877861f,0.19436565f,0.1097783f,0.0618181042f,0.0347780399f,0.0195598267f,0.0109997792f,0.00618571462f,0.00347849843f,0.00195610616f,-0.536572933f,0.448342979f,-0.60768342f,0.845583618f,0.932039082f,0.624748647f,0.370431304f,0.211777672f,0.119712204f,0.0674297586f,0.0379382223f,0.0213377345f,0.0119997123f,0.0067480444f,0.00379472389f,0.00213393359f,0.420167029f,0.855880976f,-0.824528456f,0.737816215f,0.963558197f,0.667647004f,0.399614304f,0.229122713f,0.129634142f,0.0730392784f,0.0410980321f,0.0231155735f,0.0129996343f,0.00731037185f,0.00411094911f,0.00231176103f,0.990607381f,0.999823332f,-0.959605396f,0.606778562f,0.985449731f,0.708434701f,0.428397775f,0.246395305f,0.139543116f,0.078646481f,0.0442574248f,0.0248933397f,0.0139995432f,0.00787269697f,0.00442717411f,0.00248958869f,0.650287867f,0.835838437f,-0.999518692f,0.456603259f,0.997494996f,0.746982634f,0.456752867f,0.263589978f,0.149438128f,0.0842512026f,0.0474163815f,0.0266710296f,0.0149994381f,0.00843502022f,0.00474339863f,0.00266741589f,-0.287903309f,0.414430231f,-0.940310359f,0.292027086f,0.999573588f,0.783169091f,0.484651238f,0.280701309f,0.159318209f,0.0898532644f,0.0505748577f,0.028448632f,0.015999319f,0.00899733976f,0.00505962269f,0.00284524332f,-0.961397469f,-0.134615138f,-0.78785187f,0.11824052f,0.991664827f,0.81687957f,0.512064993f,0.29772386f,0.169182345f,0.09545248f,0.0537328273f,0.0302261449f,0.0169991814f,0.00955965649f,0.00537584582f,0.00302307028f,-0.750987232f,-0.642200708f,-0.557262897f,-0.0592755191f,0.973847628f,0.84800756f,0.538966715f,0.314652264f,0.179029569f,0.101048686f,0.0568902642f,0.0320035629f,0.0179990288f,0.0101219704f,0.00569206895f,0.00320089748f,0.149877205f,-0.952000856f,-0.271410108f,-0.234921798f,0.946300089f,0.876454532f,0.565329552f,0.331481189f,0.188858896f,0.10664168f,0.060047131f,0.0337808803f,0.0189988576f,0.0106842816f,0.00600829115f,0.00337872445f,0.912945271f,-0.968601942f,0.0413582884f,-0.403158993f,0.909297407f,0.902130723f,0.591127038f,0.348205268f,0.198669314f,0.112231314f,0.0632033944f,0.0355580896f,0.0199986678f,0.011246589f,0.00632451288f,0.00355655141f,0.836655617f,-0.686891198f,0.35002476f,-0.558680534f,0.863209307f,0.924954832f,0.616333544f,0.364819258f,0.208459899f,0.117817394f,0.0663590282f,0.0373351872f,0.0209984574f,0.0118088927f,0.00664073415f,0.00373437814f,-0.00885130931f,-0.193630233f,0.623979926f,-0.696581721f,0.808496356f,0.944854796f,0.640923738f,0.381317884f,0.218229622f,0.123399742f,0.0695140064f,0.0391121693f,0.0219982266f,0.0123711927f,0.00695695449f,0.00391220488f,-0.846220434f,0.359264523f,0.836055279f,-0.812512875f,0.745705247f,0.961767614f,0.664873064f,0.397695929f,0.227977514f,0.128978193f,0.0726682767f,0.0408890247f,0.0229979735f,0.0129334899f,0.00727317436f,0.00409003161f,-0.905578375f,0.801513135f,0.965219259f,-0.902817786f,0.67546314f,0.97563988f,0.688157499f,0.413948208f,0.237702623f,0.134552568f,0.0758218244f,0.0426657498f,0.0239976961f,0.0134957815f,0.0075893933f,0.00426785741f,-0.132351756f,0.996909976f,0.998663187f,-0.964648306f,0.598472118f,0.986427724f,0.710753918f,0.430069596f,0.247403964f,0.140122697f,0.0789746121f,0.0444423407f,0.0249973964f,0.0140580693f,0.00790561177f,0.00444568414f,0.76255846f,0.885276794f,0.933070183f,-0.996054351f,0.515501261f,0.994096994f,0.732639611f,0.446054995f,0.257080555f,0.145688385f,0.0821266174f,0.0462187938f,0.0259970706f,0.0146203535f,0.00822182931f,0.00462350994f,0.956375957f,0.500994205f,0.774945021f,-0.996045172f,0.427379847f,0.99862349f,0.753792703f,0.46189931f,0.266731411f,0.151249468f,0.0852777958f,0.0479951017f,0.0269967206f,0.015182632f,0.00853804592f,0.00480133574f,0.270905793f,-0.0375856608f,0.539968967f,-0.964621305f,0.334988207f,0.999992907f,0.774192095f,0.477597594f,0.276355654f,0.156805754f,0.0884281173f,0.049771253f,0.0279963426f,0.0157449059f,0.0088542616f,0.00497916201f,-0.663633883f,-0.564589798f,0.251445323f,-0.902773678f,0.239249229f,0.998200953f,0.793817401f,0.49314484f,0.28595221f,0.162357092f,0.0915775672f,0.0515472479f,0.0289959367f,0.0163071752f,0.00917047635f,0.00515698735f,-0.988031626f,-0.917709649f,-0.0620148405f,-0.812452853f,0.141120002f,0.993253171f,0.812648892f,0.5085361f,0.295520186f,0.167903304f,0.0947260931f,0.0533230826f,0.029995501f,0.0168694388f,0.00948669016f,0.00533481315f,-0.404037654f,-0.988192797f,-0.369325012f,-0.696507812f,0.0415805206f,0.985165298f,0.830667794f,0.523766637f,0.305058628f,0.173444211f,0.0978736654f,0.055098746f,0.0309950355f,0.0174316969f,0.00980290305f,0.00551263802f,0.551426709f,-0.754330218f,-0.640009403f,-0.5585953f,-0.0583741926f,0.973962843f,0.847856104f,0.538831532f,0.314566553f,0.17897962f,0.101020269f,0.0568742342f,0.0319945402f,0.0179939512f,0.0101191159f,0.00569046335f,0.999911845f,-0.28814739f,-0.847224355f,-0.403064936f,-0.157745644f,0.959681332f,0.864196658f,0.553726017f,0.324043006f,0.184509367f,0.10416586f,0.0586495437f,0.0329940096f,0.0185561981f,0.010435327f,0.00586828869f,0.529082716f,0.266779721f,-0.97042042f,-0.234822124f,-0.255541205f,0.942365825f,0.879673064f,0.568445385f,0.333487093f,0.190033287f,0.107310407f,0.0604246669f,0.0339934528f,0.0191184394f,0.010751537f,0.00604611309f,-0.428182662f,0.739542127f,-0.997380435f,-0.0591726787f,-0.350783229f,0.92207104f,0.894269884f,0.582984984f,0.342897803f,0.195551202f,0.110453881f,0.0621996038f,0.034992855f,0.0196806751f,0.0110677453f,0.00622393796f,-0.991778851f,0.984540582f,-0.925431013f,0.118342586f,-0.442520559f,0.89886117f,0.907972515f,0.597340286f,0.352274209f,0.201062918f,0.113596253f,0.0639743358f,0.0359922275f,0.0202429052f,0.0113839535f,0.0064017619f,-0.643538117f,0.926318109f,-0.761706948f,0.292125374f,-0.529836178f,0.872809589f,0.920767248f,0.611506701f,0.361615449f,0.206568271f,0.116737492f,0.0657488778f,0.036991559f,0.0208051261f,0.0117001599f,0.0065795863f,0.296368569f,0.58280617f,-0.522444785f,0.456694692f,-0.611857831f,0.84399873f,0.932641268f,0.625479698f,0.370920479f,0.212067112f,0.119877554f,0.0675232038f,0.0379908569f,0.0213673431f,0.0120163653f,0.00675741071f,0.963795364f,0.0598003156f,-0.231372014f,0.606860459f,-0.687766254f,0.81251961f,0.943582714f,0.639254928f,0.380188406f,0.217559248f,0.123016424f,0.0692973137f,0.0389901139f,0.0219295528f,0.0123325698f,0.00693523418f,0.745113134f,-0.481621295f,0.0826458037f,0.737885714f,-0.756802499f,0.778471708f,0.953580678f,0.652827978f,0.389418334f,0.223044485f,0.126154065f,0.0710712075f,0.0399893373f,0.0224917568f,0.0126487734f,0.00711305765f,-0.158622667f,-0.874714017f,0.388467699f,0.845638454f,-0.818277061f,0.74196279f,0.962625206f,0.666194677f,0.39860931f,0.228522688f,0.129290432f,0.0728448778f,0.0409885161f,0.0230539497f,0.0129649751f,0.00729088066f,-0.916521549f,-0.998410463f,0.655764699f,0.926720202f,-0.871575892f,0.703108132f,0.970707119f,0.679350674f,0.407760441f,0.233993664f,0.132425532f,0.0746183172f,0.0419876575f,0.0236161388f,0.0132811759f,0.00746870413f,-0.831774771f,-0.814614236f,0.858030677f,0.97857362f,-0.916166008f,0.662030637f,0.977818429f,0.692291796f,0.416870773f,0.23945722f,0.135559291f,0.0763915181f,0.0429867506f,0.0241783205f,0.0135973748f,0.00764652714f,0.0177019257f,-0.37993139f,0.975206196f,0.999563396f,-0.951602101f,0.618860185f,0.983951986f,0.70501405f,0.425939471f,0.244913206f,0.138691694f,0.0781644881f,0.0439858064f,0.0247404929f,0.0139135728f,0.00782434922f,0.850903511f,0.171763569f,0.995670974f,0.989027262f,-0.977530122f,0.57373327f,0.989101648f,0.717513323f,0.434965521f,0.250361472f,0.141822711f,0.0799371973f,0.0449848175f,0.0253026579f,0.0142297689f,0.00800217129f,0.901788354f,0.670557022f,0.917395473f,0.947297752f,-0.993690968f,0.526792526f,0.993262351f,0.72978574f,0.44394809f,0.255801797f,0.144952312f,0.0817096606f,0.0459837839f,0.0258648153f,0.0145459641f,0.0081799943f,0.123573124f,0.962832689f,0.748142362f,0.875690997f,-0.999923289f,0.478186339f,0.996429801f,0.741827428f,0.452886283f,0.261234075f,0.148080453f,0.0834818557f,0.0469827019f,0.0264269635f,0.0148621574f,0.00835781638f,-0.768254638f,0.958573103f,0.504697084f,0.776465356f,-0.99616462f,0.428068399f,0.99860096f,0.753634512f,0.461779177f,0.266658038f,0.151207119f,0.0852537975f,0.0479815714f,0.0269891042f,0.0151783489f,0.00853563752f,-0.953752637f,0.659090102f,0.211200655f,0.652750373f,-0.982452571f,0.376597136f,0.999773562f,0.765203178f,0.470625877f,0.272073567f,0.15433228f,0.087025471f,0.0489803962f,0.0275512375f,0.0154945394f,0.0087134596f,-0.262374848f,0.156619072f,-0.10324046f,0.508447945f,-0.958924294f,0.32393527f,0.999946535f,0.776529968f,0.47942555f,0.277480543f,0.157455891f,0.0887968615f,0.0499791689f,0.0281133596f,0.0158107281f,0.00889127981f,0.670229197f,-0.394086063f,-0.407444149f,0.3481085f,-0.925814748f,0.270249337f,0.99911958f,0.787611187f,0.48817724f,0.282878697f,0.160577938f,0.0905679762f,0.0509778969f,0.0286754742f,0.0161269177f,0.00906910095f,0.986627579f,-0.823421597f,-0.671240151f,0.176790684f,-0.883454502f,0.215709001f,0.997293651f,0.798443377f,0.496880114f,0.28826794f,0.163698375f,0.0923388004f,0.051976569f,0.0292375814f,0.0164431017f,0.00924692024f,0.395925164f,-0.999157965f,-0.868469954f,-0.000103020677f,-0.832267344f,0.160486728f,0.994470477f,0.809023023f,0.505533338f,0.293648034f,0.166817173f,0.0941093415f,0.0529751927f,0.0297996756f,0.0167592876f,0.00942474138f,-0.558789074f,-0.867171526f,-0.979574919f,-0.176993474f,-0.772764444f,0.104756832f,0.990652919f,0.819346905f,0.514135957f,0.29901889f,0.169934288f,0.0958795771f,0.0539737605f,0.0303617641f,0.0170754679f,0.00960256159f,-0.999755144f,-0.468111664f,-0.993535519f,-0.348301649f,-0.705540299f,0.0486960001f,0.985844791f,0.829411685f,0.522687256f,0.304380238f,0.173049718f,0.0976495072f,0.0549722798f,0.0309238415f,0.01739165f,0.00978038087f,-0.521551013f,0.0751182064f,-0.908967435f,-0.508624554f,-0.631266713f,-0.00751878507f,0.980050862f,0.839214146f,0.531186223f,0.30973196f,0.17616342f,0.0994191393f,0.0559707358f,0.0314859077f,0.0177078284f,0.00995820016f,0.436164767f,0.595211506f,-0.734258294f,-0.652905703f,-0.550685287f,-0.0637097955f,0.973276973f,0.848751247f,0.539632022f,0.315073937f,0.179275364f,0.101188451f,0.0569691435f,0.0320479684f,0.0180240069f,0.0101360194f,0.992872655f,0.931992829f,-0.486733496f,-0.776594579f,-0.464602023f,-0.119699396f,0.965529919f,0.858020008f,0.548023939f,0.3204059f,0.182385504f,0.102957435f,0.0579674877f,0.0326100141f,0.0183401816f,0.0103138378f,0.636738002f,0.981735826f,-0.190938011f,-0.87579f,-0.373876572f,-0.175310582f,0.956817448f,0.867017388f,0.55636102f,0.325727791f,0.185493827f,0.104726106f,0.0589657798f,0.0331720486f,0.0186563563f,0.0104916561f,-0.304810613f,0.729123712f,0.12379095f,-0.947363734f,-0.279415488f,-0.230367512f,0.947148204f,0.875740528f,0.564642429f,0.33103931f,0.188600287f,0.106494442f,0.0599640086f,0.0337340795f,0.0189725272f,0.0106694745f,-0.966117799f,0.251952261f,0.426245421f,-0.98905772f,-0.182162598f,-0.284696162f,0.936531842f,0.884186864f,0.572867453f,0.336340427f,0.191704854f,0.108262435f,0.0609621815f,0.0342960916f,0.0192886982f,0.0108472919f,-0.739180684f,-0.302812874f,0.686427653f,-0.999557257f,-0.0830891207f,-0.338124752f,0.924979091f,0.892353535f,0.581035137f,0.341630876f,0.194807529f,0.110030092f,0.0619602874f,0.0348580964f,0.0196048655f,0.0110251084f,0.167355701f,-0.764320076f,0.878538549f,-0.978531301f,0.0168140903f,-0.390484393f,0.912501454f,0.900238097f,0.589144766f,0.346910536f,0.197908238f,0.111797392f,0.0629583374f,0.0354200937f,0.0199210308f,0.0112029258f};
#define LAS __attribute__((address_space(3)))
#define XB_TMO      128
#define XB_XCNT(j)  (256  + 64 * (j))
#define XB_XSUB(j)  (1280 + 64 * (j))
#define XB_XGEN(j)  (2304 + 64 * (j))
#define XB_TOP      3328
#define XB_TOPGEN   3392
#define XCD_BAR_WORDS 3456
#define XB_SPIN_CAP (1u << 18)

__device__ __forceinline__ unsigned xb_ld(unsigned* p)              { return __hip_atomic_load(p, __ATOMIC_RELAXED, __HIP_MEMORY_SCOPE_AGENT); }
__device__ __forceinline__ unsigned xb_add(unsigned* p, unsigned v) { return __hip_atomic_fetch_add(p, v, __ATOMIC_RELAXED, __HIP_MEMORY_SCOPE_AGENT); }
__device__ __forceinline__ unsigned xb_xcc_id() { return (unsigned)__builtin_amdgcn_s_getreg((3 << 11) | 20) & 0xFu; }
#define XB_SPIN(cond, bar) do { unsigned _sp = 0; while (cond) { __builtin_amdgcn_s_sleep(1); \
    if ((++_sp & 255u) == 0u) { if (xb_ld(&(bar)[XB_TMO])) break; if (_sp > XB_SPIN_CAP) { atomicAdd(&(bar)[XB_TMO], 1u); break; } } } } while (0)

struct XcdBarrier {
    unsigned* bar; unsigned x;
    volatile LAS unsigned* st;
};

__device__ __forceinline__ XcdBarrier xcd_barrier_post(unsigned* bar, volatile LAS unsigned* st) {
    XcdBarrier b; b.bar = bar; b.x = xb_xcc_id(); b.st = st;
    if (threadIdx.x == 0) (void)xb_add(&bar[XB_XCNT(b.x)], 1u);
    return b;
}
__device__ __forceinline__ void xcd_barrier_complete(unsigned* bar, unsigned x, unsigned& nloc, unsigned& nx) {
    const unsigned G = gridDim.x * gridDim.y * gridDim.z;
    unsigned sum, cnt, mine, sp = 0u;
    for (;;) {
        sum = 0u; cnt = 0u; mine = 0u;
#pragma unroll
        for (unsigned j = 0; j < 16; ++j) { const unsigned c = xb_ld(&bar[XB_XCNT(j)]); sum += c; cnt += (c > 0u) ? 1u : 0u; mine = (j == x) ? c : mine; }
        if (sum == G) break;
        __builtin_amdgcn_s_sleep(1);
        if ((++sp & 255u) == 0u) { if (xb_ld(&bar[XB_TMO])) break; if (sp > XB_SPIN_CAP) { atomicAdd(&bar[XB_TMO], 1u); break; } }
    }
    nloc = mine > 0u ? mine : 1u; nx = cnt > 0u ? cnt : 1u;
}

__device__ __forceinline__ void xcd_barrier(const XcdBarrier& b) {
    asm volatile("s_waitcnt vmcnt(0)" ::: "memory");
    __syncthreads();
    if (threadIdx.x == 0) {
        unsigned* bar = b.bar;
        __builtin_amdgcn_s_waitcnt(0);
        unsigned nloc = b.st[0], nx = b.st[1];
        if (nloc == 0u) { xcd_barrier_complete(bar, b.x, nloc, nx); b.st[0] = nloc; b.st[1] = nx; }
        const unsigned old = xb_add(&bar[XB_XSUB(b.x)], 1u);
        const unsigned gen = old / nloc;
        if (old + 1u == (gen + 1u) * nloc) {
            __builtin_amdgcn_fence(__ATOMIC_RELEASE, "agent");
            asm volatile("s_waitcnt vmcnt(0)" ::: "memory");
            const unsigned og = xb_add(&bar[XB_TOP], 1u);
            const unsigned tg = og / nx;
            if (og + 1u == (tg + 1u) * nx) xb_add(&bar[XB_TOPGEN], 1u);
            else XB_SPIN(xb_ld(&bar[XB_TOPGEN]) == tg, bar);
            __builtin_amdgcn_fence(__ATOMIC_ACQUIRE, "agent");
            xb_add(&bar[XB_XGEN(b.x)], 1u);
            asm volatile("s_waitcnt vmcnt(0)" ::: "memory");
        } else {
            XB_SPIN(xb_ld(&bar[XB_XGEN(b.x)]) == gen, bar);
            __builtin_amdgcn_fence(__ATOMIC_ACQUIRE, "agent");
            asm volatile("s_waitcnt vmcnt(0)" ::: "memory");
        }
    }
    __syncthreads();
}

#define DI __device__ __forceinline__
#define LAS __attribute__((address_space(3)))
typedef unsigned short bf16;
typedef short bf16x8 __attribute__((ext_vector_type(8)));
typedef float f32x4 __attribute__((ext_vector_type(4)));
typedef unsigned u32x4 __attribute__((ext_vector_type(4)));
typedef unsigned u32x2 __attribute__((ext_vector_type(2)));

#ifndef COOP
#define COOP 1
#endif

constexpr int D = 1024, NBATCH = 4, SEQ = 4096, CTXL = 256, NLAT = NBATCH * SEQ, NCTX = NBATCH * CTXL, MT = NLAT + NCTX;
constexpr int FF = 2816, KEYS = SEQ + CTXL;
constexpr int LDP0 = 2560, LDP1 = 3072;
constexpr int C_AQ = 0, C_AK = 512, C_AV = 640, C_BQ = 768, C_BK = 1024, C_BV = 1280, C_BO = 1792, C_RF = 2304, C_RB = 2320;
constexpr float LOG2E = 1.4426950408889634f, EPS = 1e-6f;
constexpr int NCHUNK = 68;

constexpr size_t MiB = 1u << 20;
constexpr size_t WS_CTL = 0, WS_MOD = 1 * MiB, WS_XC = 2 * MiB, WS_WABI = 6 * MiB, WS_WABO = 11 * MiB, WS_WFI = 13 * MiB, WS_WFO = 35 * MiB, WS_WNI = 46 * MiB, WS_WNO = 52 * MiB;
constexpr size_t WS_HO = 54 * MiB, WS_YF = 88 * MiB, WS_P = 122 * MiB, WS_STC = 224 * MiB, WS_DEC = 228 * MiB, WS_END = 246 * MiB;
constexpr size_t WS_CUM0 = 207 * MiB, WS_CUM1 = 229 * MiB;
constexpr size_t WS_PART = 224 * MiB;
constexpr int LDS_BYTES = 147456;
constexpr int NWAVES = 8, NTHR = 512;

DI float bf2f(unsigned short h) { return __uint_as_float(((unsigned)h) << 16); }
DI unsigned pk2(float lo, float hi) { return pg8::cvt_pk_bf16(lo, hi); }
DI float wave_sum(float v) {
#pragma unroll
    for (int o = 1; o < 64; o <<= 1) v += __shfl_xor(v, o);
    return v;
}
DI float fast_exp2(float x) { return __builtin_amdgcn_exp2f(x); }
DI float silu_f(float g) { return g * __builtin_amdgcn_rcpf(1.0f + __expf(-g)); }
DI void unpack8(const bf16x8 v, float (&o)[8]) {
#pragma unroll
    for (int i = 0; i < 8; ++i) o[i] = bf2f((unsigned short)v[i]);
}
DI bf16x8 pack8(const float (&p)[8]) {
    u32x4 w; w.x = pk2(p[0], p[1]); w.y = pk2(p[2], p[3]); w.z = pk2(p[4], p[5]); w.w = pk2(p[6], p[7]);
    return __builtin_bit_cast(bf16x8, w);
}
#define MFMA16(a, b, c) __builtin_amdgcn_mfma_f32_16x16x32_bf16((a), (b), (c), 0, 0, 0)

struct EpiStore {
    static constexpr bool PERM = true, AFTER_DRAIN = false;
    bf16* O; int ldc;
    DI void operator()(const pg8::f32x4 (&acc)[2][2][4][2], const pg8::Unit& u, int wr, int wc, int fr, int fq) const {
        const int row0 = u.pm * 256 + wr * 64 + fr, col0 = u.pn * 256 + wc * 32 + 8 * fq;
#pragma unroll
        for (int ai = 0; ai < 2; ++ai)
#pragma unroll
            for (int m = 0; m < 4; ++m) { bf16* rowp = O + (size_t)(row0 + ai * 128 + m * 16) * ldc + col0;
#pragma unroll
                for (int bj = 0; bj < 2; ++bj) { const pg8::f32x4 v0 = acc[ai][bj][m][0], v1 = acc[ai][bj][m][1];
                    u32x4 w; w.x = pk2(v0[0], v0[1]); w.y = pk2(v0[2], v0[3]); w.z = pk2(v1[0], v1[1]); w.w = pk2(v1[2], v1[3]);
                    *(u32x4*)(rowp + bj * 128) = w; } }
    }
};
struct EpiSwiglu {
    static constexpr bool PERM = true, AFTER_DRAIN = false;
    bf16* O; int ldc;
    DI void operator()(const pg8::f32x4 (&acc)[2][2][4][2], const pg8::Unit& u, int wr, int wc, int fr, int fq) const {
        const int row0 = u.pm * 256 + wr * 64 + fr, col0 = u.pn * 128 + wc * 32 + 8 * fq;
#pragma unroll
        for (int ai = 0; ai < 2; ++ai)
#pragma unroll
            for (int m = 0; m < 4; ++m) { bf16* rowp = O + (size_t)(row0 + ai * 128 + m * 16) * ldc + col0;
                const pg8::f32x4 g0 = acc[ai][0][m][0], g1 = acc[ai][0][m][1], u0 = acc[ai][1][m][0], u1 = acc[ai][1][m][1];
                u32x4 w; w.x = pk2(silu_f(g0[0]) * u0[0], silu_f(g0[1]) * u0[1]); w.y = pk2(silu_f(g0[2]) * u0[2], silu_f(g0[3]) * u0[3]);
                w.z = pk2(silu_f(g1[0]) * u1[0], silu_f(g1[1]) * u1[1]); w.w = pk2(silu_f(g1[2]) * u1[2], silu_f(g1[3]) * u1[3]);
                *(u32x4*)rowp = w; }
    }
};

struct OneUnit {
    int pm, pn; bool has;
    DI bool next(int i, pg8::Unit& u) const { if (i != 0 || !has) return false; u.pm = pm; u.pn = pn; return true; }
    DI void a_ready(const pg8::Unit&) const {}
    DI void done(const pg8::Unit&) const {}
};

struct Args { const float* in[23]; float* out; unsigned char* ws; int ph_lo, ph_hi; };
enum { I_X = 0, I_C, I_CTX, I_CCTX, I_WMOD, I_BMOD, I_GMPRE, I_GMPOST, I_GFPRE, I_GFPOST, I_WFI, I_WFO, I_ABWI, I_ABWO, I_SINK, I_GFW, I_GFB, I_GBW, I_GBB, I_GNORM, I_NAWI, I_NAWO, I_RELB };

DI void transpose_item(const float* W, int K, int N, bf16* WT, int k0, int n0, int drow0, LAS float* scr, int lane) {
#pragma unroll 8
    for (int i = 0; i < 32; ++i) { const int kk = 2 * i + (lane >> 5); scr[kk * 33 + (lane & 31)] = W[(size_t)(k0 + kk) * N + n0 + (lane & 31)]; }
    asm volatile("s_waitcnt lgkmcnt(0)" ::: "memory");
    const int c = lane & 7;
#pragma unroll
    for (int j = 0; j < 4; ++j) { const int n = (lane >> 3) + 8 * j; const LAS float* s = scr + (8 * c) * 33 + n;
        u32x4 o; o.x = pk2(s[0 * 33], s[1 * 33]); o.y = pk2(s[2 * 33], s[3 * 33]); o.z = pk2(s[4 * 33], s[5 * 33]); o.w = pk2(s[6 * 33], s[7 * 33]);
        *(u32x4*)(WT + (size_t)(drow0 + n) * K + k0 + 8 * c) = o; }
    asm volatile("s_waitcnt lgkmcnt(0)" ::: "memory");
}
DI void xpose_plain(const float* W, int K, int N, bf16* WT, int item, LAS float* scr, int lane) {
    const int nblk = N / 32, kb = item / nblk, nb = item % nblk;
    transpose_item(W, K, N, WT, 64 * kb, 32 * nb, 32 * nb, scr, lane);
}
DI void xpose_ffnin(const float* W, bf16* WT, int item, LAS float* scr, int lane) {
    const int nblk = 5632 / 32, kb = item / nblk, nb = item % nblk, n0 = 32 * nb;
    const int bj = n0 >= FF ? 1 : 0, cc = n0 - bj * FF, drow0 = 256 * (cc >> 7) + 128 * bj + (cc & 127);
    transpose_item(W, 1024, 5632, WT, 64 * kb, n0, drow0, scr, lane);
}

DI void phase_prologue(const Args& a, LAS unsigned char* lds, int tid, int lane, int wave) {
    unsigned char* ws = a.ws;
    {
        LAS float* sl = (LAS float*)lds;
        LAS float* red = (LAS float*)(lds + 32768);
        for (int i = tid; i < 5 * 1024; i += NTHR) { const int s = i >> 10, k = i & 1023; const float v = s < 4 ? a.in[I_C][s * 1024 + k] : a.in[I_CCTX][k]; sl[i] = v / (1.0f + __expf(-v)); }
        __syncthreads();
        for (int u = blockIdx.x; u < 192; u += gridDim.x) {
            const int layer = u / 96, col = (u % 96) * 64 + lane;
            const float* W = a.in[I_WMOD] + (size_t)layer * 1024 * 6144 + col;
            float acc[5] = {0.f, 0.f, 0.f, 0.f, 0.f};
            const int kb = wave * 128;
#pragma unroll 8
            for (int k = 0; k < 128; ++k) { const float w = W[(size_t)(kb + k) * 6144];
#pragma unroll
                for (int s = 0; s < 5; ++s) acc[s] += sl[s * 1024 + kb + k] * w; }
#pragma unroll
            for (int s = 0; s < 5; ++s) red[(wave * 5 + s) * 64 + lane] = acc[s];
            __syncthreads();
            if (tid < 320) { const int s = tid >> 6, l = tid & 63; float t = 0.f;
#pragma unroll
                for (int w = 0; w < 8; ++w) t += red[(w * 5 + s) * 64 + l];
                const int c2 = (u % 96) * 64 + l;
                ((float*)(ws + WS_MOD))[(size_t)(layer * 5 + s) * 6144 + c2] = t + a.in[I_BMOD][layer * 6144 + c2]; }
            __syncthreads();
        }
        __syncthreads();
    }
    LAS float* scr = (LAS float*)(lds + wave * 16384);
    const int gw = blockIdx.x * NWAVES + wave, NGW = gridDim.x * NWAVES;
    constexpr int I_1 = 16 * 73, I_2 = 16 * 32, I_3 = 16 * 176, I_4 = 44 * 32, I_5 = 16 * 96, I_6 = 16 * 32;
    constexpr int NITEMS = I_1 + I_2 + 2 * I_3 + 2 * I_4 + I_5 + I_6;
    for (int it = gw; it < NITEMS; it += NGW) {
        int r = it;
        if (r < I_1) { xpose_plain(a.in[I_ABWI], 1024, 2336, (bf16*)(ws + WS_WABI), r, scr, lane); continue; } r -= I_1;
        if (r < I_2) { xpose_plain(a.in[I_ABWO], 1024, 1024, (bf16*)(ws + WS_WABO), r, scr, lane); continue; } r -= I_2;
        if (r < I_3) { xpose_ffnin(a.in[I_WFI], (bf16*)(ws + WS_WFI), r, scr, lane); continue; } r -= I_3;
        if (r < I_3) { xpose_ffnin(a.in[I_WFI] + (size_t)1024 * 5632, (bf16*)(ws + WS_WFI) + (size_t)5632 * 1024, r, scr, lane); continue; } r -= I_3;
        if (r < I_4) { xpose_plain(a.in[I_WFO], FF, 1024, (bf16*)(ws + WS_WFO), r, scr, lane); continue; } r -= I_4;
        if (r < I_4) { xpose_plain(a.in[I_WFO] + (size_t)FF * 1024, FF, 1024, (bf16*)(ws + WS_WFO) + (size_t)1024 * FF, r, scr, lane); continue; } r -= I_4;
        if (r < I_5) { xpose_plain(a.in[I_NAWI], 1024, 3072, (bf16*)(ws + WS_WNI), r, scr, lane); continue; } r -= I_5;
        xpose_plain(a.in[I_NAWO], 1024, 1024, (bf16*)(ws + WS_WNO), r, scr, lane);
    }
    { u32x4* z = (u32x4*)((bf16*)(ws + WS_WABI) + (size_t)2336 * 1024); const u32x4 zero = {0u, 0u, 0u, 0u};
      for (int i = blockIdx.x * NTHR + tid; i < 224 * 128; i += gridDim.x * NTHR) z[i] = zero; }
}

DI void row_op(const float* xsrc, const bf16* y, int nslice, const float* gpost, const float* gate, float* xdst,
               const float* gpre, const float* shift, const float* scale, bf16* hdst, int lane) {
    f32x4 v[4];
#pragma unroll
    for (int j = 0; j < 4; ++j) v[j] = *((const f32x4*)xsrc + lane + 64 * j);
    if (y) {
        f32x4 yv[4]; float s = 0.f;
#pragma unroll
        for (int j = 0; j < 4; ++j) yv[j] = (f32x4){0.f, 0.f, 0.f, 0.f};
        for (int sl = 0; sl < nslice; ++sl) {
#pragma unroll
            for (int j = 0; j < 4; ++j) { const u32x2 w = *((const u32x2*)(y + (size_t)sl * NCTX * D) + lane + 64 * j);
                yv[j] = yv[j] + (f32x4){__uint_as_float(w.x << 16), __uint_as_float(w.x & 0xffff0000u), __uint_as_float(w.y << 16), __uint_as_float(w.y & 0xffff0000u)}; } }
#pragma unroll
        for (int j = 0; j < 4; ++j) s += (yv[j].x * yv[j].x + yv[j].y * yv[j].y) + (yv[j].z * yv[j].z + yv[j].w * yv[j].w);
        const float rstd = __builtin_amdgcn_rsqf(wave_sum(s) * (1.0f / D) + EPS);
#pragma unroll
        for (int j = 0; j < 4; ++j) { const f32x4 gp = *((const f32x4*)gpost + lane + 64 * j), gt = *((const f32x4*)gate + lane + 64 * j);
            v[j] = v[j] + gt * (yv[j] * rstd * gp); }
    }
    if (xdst) {
#pragma unroll
        for (int j = 0; j < 4; ++j) *((f32x4*)xdst + lane + 64 * j) = v[j];
    }
    if (hdst) {
        float s = 0.f;
#pragma unroll
        for (int j = 0; j < 4; ++j) s += (v[j].x * v[j].x + v[j].y * v[j].y) + (v[j].z * v[j].z + v[j].w * v[j].w);
        const float rstd = __builtin_amdgcn_rsqf(wave_sum(s) * (1.0f / D) + EPS);
#pragma unroll
        for (int j = 0; j < 4; ++j) { const f32x4 gp = *((const f32x4*)gpre + lane + 64 * j), sh = *((const f32x4*)shift + lane + 64 * j), sc = *((const f32x4*)scale + lane + 64 * j);
            const f32x4 h = v[j] * rstd * gp * (sc + 1.0f) + sh;
            u32x2 w; w.x = pk2(h.x, h.y); w.y = pk2(h.z, h.w);
            *((u32x2*)hdst + lane + 64 * j) = w; }
    }
}
DI void phase_rows(const Args& a, int mode, int layer, int lane, int wave) {
    unsigned char* ws = a.ws;
    const float* MOD = (const float*)(ws + WS_MOD);
    bf16* H = (bf16*)(ws + WS_HO); const bf16* YF = (const bf16*)(ws + WS_YF); const bf16* PART = (const bf16*)(ws + WS_PART); float* XC = (float*)(ws + WS_XC);
    const int gw = blockIdx.x * NWAVES + wave, NGW = gridDim.x * NWAVES;
    const int nrows = (layer == 0) ? MT : NLAT;
    for (int m = gw; m < nrows; m += NGW) {
        const bool lat = m < NLAT; const int s = lat ? (m >> 12) : 4;
        const float* mod = MOD + (size_t)(layer * 5 + s) * 6144;
        float* xcur = lat ? a.out + (size_t)m * D : XC + (size_t)(m - NLAT) * D;
        if (mode == 0) {
            const float* xin = lat ? a.in[I_X] + (size_t)m * D : a.in[I_CTX] + (size_t)(m - NLAT) * D;
            row_op(xin, nullptr, 0, nullptr, nullptr, nullptr, a.in[I_GMPRE], mod, mod + 1024, H + (size_t)m * D, lane);
        } else if (mode == 1) {
            const float* xin = (layer == 0) ? (lat ? a.in[I_X] + (size_t)m * D : a.in[I_CTX] + (size_t)(m - NLAT) * D) : xcur;
            row_op(xin, (layer == 0 && !lat) ? PART + (size_t)(m - NLAT) * D : YF + (size_t)m * D, (layer == 0 && !lat) ? 4 : 1, a.in[I_GMPOST] + layer * D, mod + 2048, xcur, a.in[I_GFPRE] + layer * D, mod + 3072, mod + 4096, H + (size_t)m * D, lane);
        } else {
            if (layer == 0) { const float* mod1 = MOD + (size_t)(5 + s) * 6144;
                row_op(xcur, lat ? YF + (size_t)m * D : PART + (size_t)(m - NLAT) * D, lat ? 1 : 11, a.in[I_GFPOST], mod + 5120, xcur, a.in[I_GMPRE] + D, mod1, mod1 + 1024, H + (size_t)m * D, lane); }
            else row_op(xcur, YF + (size_t)m * D, 1, a.in[I_GFPOST] + D, mod + 5120, xcur, nullptr, nullptr, nullptr, nullptr, lane);
        }
    }
}

DI float xmax_quads(float x) {
    unsigned u = __float_as_uint(x);
    auto r = __builtin_amdgcn_permlane16_swap(u, u, false, false);
    u = __float_as_uint(fmaxf(__uint_as_float(r[0]), __uint_as_float(r[1])));
    auto r2 = __builtin_amdgcn_permlane32_swap(u, u, false, false);
    return fmaxf(__uint_as_float(r2[0]), __uint_as_float(r2[1]));
}
DI float xsum_quads(float x) {
    unsigned u = __float_as_uint(x);
    auto r = __builtin_amdgcn_permlane16_swap(u, u, false, false);
    u = __float_as_uint(__uint_as_float(r[0]) + __uint_as_float(r[1]));
    auto r2 = __builtin_amdgcn_permlane32_swap(u, u, false, false);
    return __uint_as_float(r2[0]) + __uint_as_float(r2[1]);
}
struct KVFrag { bf16x8 kf[2][2]; bf16x8 vf[4]; };
DI void kv_load(KVFrag& f, const bf16* kp, int kld, const bf16* vp, int vld, int fr, int fq) {
#pragma unroll
    for (int h = 0; h < 2; ++h)
#pragma unroll
        for (int ks = 0; ks < 2; ++ks) f.kf[h][ks] = *(const bf16x8*)(kp + (size_t)((fr >> 2) * 8 + h * 4 + (fr & 3)) * kld + ks * 32 + fq * 8);
#pragma unroll
    for (int nt = 0; nt < 4; ++nt) f.vf[nt] = *(const bf16x8*)(vp + (size_t)(nt * 16 + fr) * vld + fq * 8);
}
template <int MODE>
DI void attn_one(f32x4 (&o)[4], float& mrun, float& lrun, const bf16x8 (&qf)[2], const KVFrag& f, float sc2, int d0, unsigned okmask, const float (&bias)[8]) {
    f32x4 s0 = {0.f, 0.f, 0.f, 0.f}, s1 = {0.f, 0.f, 0.f, 0.f};
    s0 = MFMA16(f.kf[0][0], qf[0], s0); s0 = MFMA16(f.kf[0][1], qf[1], s0);
    s1 = MFMA16(f.kf[1][0], qf[0], s1); s1 = MFMA16(f.kf[1][1], qf[1], s1);
    float sv[8] = {s0[0], s0[1], s0[2], s0[3], s1[0], s1[1], s1[2], s1[3]};
    float mx = -1e30f;
#pragma unroll
    for (int i = 0; i < 8; ++i) {
        float t = sv[i] * sc2;
        if (MODE == 1) { const int dd = d0 - i; t = (dd >= -128 && dd <= 128) ? t : -1e30f; }
        if (MODE == 2) { t = ((okmask >> i) & 1u) ? t + bias[i] : -1e30f; }
        sv[i] = t; mx = fmaxf(mx, t);
    }
    mx = xmax_quads(mx);
    {
        const float mn = fmaxf(mrun, mx), alpha = fast_exp2(mrun - mn);
        lrun *= alpha; mrun = mn;
#pragma unroll
        for (int nt = 0; nt < 4; ++nt) o[nt] = o[nt] * alpha;
    }
    float p[8], ps = 0.f;
#pragma unroll
    for (int i = 0; i < 8; ++i) { p[i] = fast_exp2(sv[i] - mrun); ps += p[i]; }
    lrun += xsum_quads(ps);
    const bf16x8 pf = pack8(p);
#pragma unroll
    for (int nt = 0; nt < 4; ++nt) o[nt] = MFMA16(f.vf[nt], pf, o[nt]);
}
DI void attn_store1(const f32x4 (&o)[4], float lrun, bf16* op, int fq) {
    const float inv = 1.0f / lrun;
#pragma unroll
    for (int nt = 0; nt < 4; ++nt) { u32x2 w; w.x = pk2(o[nt][0] * inv, o[nt][1] * inv); w.y = pk2(o[nt][2] * inv, o[nt][3] * inv);
        *(u32x2*)(op + nt * 16 + fq * 4) = w; }
}

DI void window_attn_tile(const Args& a, int wt, int lane) {
    const bf16* P = (const bf16*)(a.ws + WS_P); const bf16* VtA = (const bf16*)(a.ws + WS_YF); bf16* O = (bf16*)(a.ws + WS_HO);
    const int fr = lane & 15, fq = lane >> 4;
    const bool isctx = wt >= 2048;
    int b, kvh, q0; size_t qrow;
    if (!isctx) { b = wt >> 9; kvh = (wt >> 8) & 1; q0 = (wt & 255) * 16; qrow = (size_t)b * SEQ + q0 + fr; }
    else { const int ct = wt - 2048; b = ct >> 5; kvh = (ct >> 4) & 1; q0 = (ct & 15) * 16; qrow = (size_t)NLAT + b * CTXL + q0 + fr; }
    bf16x8 qf[4][2]; f32x4 o[4][4]; float mrun[4], lrun[4];
#pragma unroll
    for (int g = 0; g < 4; ++g) {
#pragma unroll
        for (int ks = 0; ks < 2; ++ks) qf[g][ks] = *(const bf16x8*)(P + qrow * LDP0 + C_AQ + (kvh * 4 + g) * 64 + ks * 32 + fq * 8);
#pragma unroll
        for (int nt = 0; nt < 4; ++nt) o[g][nt] = (f32x4){0.f, 0.f, 0.f, 0.f};
        mrun[g] = a.in[I_SINK][kvh * 4 + g] * LOG2E; lrun[g] = 1.0f;
    }
    const float sc2 = 0.125f * LOG2E;
    const float nob[8] = {0.f, 0.f, 0.f, 0.f, 0.f, 0.f, 0.f, 0.f};
    const bf16* vbase = VtA + (size_t)((b * 2 + kvh) * 64) * KEYS;
    const bf16* kctx = P + (size_t)(NLAT + b * CTXL) * LDP0 + C_AK + kvh * 64;
    const bf16* kloc = P + (size_t)(b * SEQ) * LDP0 + C_AK + kvh * 64;
    const int tlo = (q0 - 128 > 0 ? q0 - 128 : 0) & ~31, thi = (q0 + 16 + 128 < SEQ) ? q0 + 16 + 128 : SEQ;
    const int ntile = isctx ? 8 : 8 + (thi - tlo + 31) / 32;
#define WIN_LOAD(F, t) do { const int t_ = (t); const int k0_ = t_ < 8 ? t_ * 32 : tlo + (t_ - 8) * 32; \
        kv_load(F, (t_ < 8 ? kctx : kloc) + (size_t)k0_ * LDP0, LDP0, vbase + (t_ < 8 ? SEQ : 0) + k0_, KEYS, fr, fq); } while (0)
#define WIN_PROC(F, t) do { const int t_ = (t); const int d0_ = t_ < 8 ? 0 : q0 + fr - (tlo + (t_ - 8) * 32) - fq * 8; \
        _Pragma("unroll") for (int g = 0; g < 4; ++g) attn_one<1>(o[g], mrun[g], lrun[g], qf[g], F, sc2, d0_, 0u, nob); } while (0)
    KVFrag A, B;
    WIN_LOAD(A, 0);
    for (int t = 0; t < ntile; t += 2) {
        WIN_LOAD(B, (t + 1 < ntile ? t + 1 : ntile - 1));
        WIN_PROC(A, t);
        WIN_LOAD(A, (t + 2 < ntile ? t + 2 : ntile - 1));
        if (t + 1 < ntile) WIN_PROC(B, t + 1);
    }
#undef WIN_LOAD
#undef WIN_PROC
#pragma unroll
    for (int g = 0; g < 4; ++g) attn_store1(o[g], lrun[g], O + qrow * D + (kvh * 4 + g) * 64, fq);
}

template <int NR>
DI void na_attn_group(const Args& a, int gid, int lane, LAS float* btab  ) {
    const bf16* P = (const bf16*)(a.ws + WS_P); const bf16* VtC = (const bf16*)(a.ws + WS_YF); bf16* O = (bf16*)(a.ws + WS_HO);
    const int fr = lane & 15, fq = lane >> 4;
    constexpr int NRG = 64 / NR; const int j = gid & 3, r0 = ((gid >> 2) % NRG) * NR, h = ((gid >> 2) / NRG) & 15, b = (gid >> 2) / (NRG * 16);
    { const float* relb = a.in[I_RELB] + h * 465;
      for (int i = lane; i < 465; i += 64) btab[i] = relb[i] * LOG2E;
      asm volatile("s_waitcnt vmcnt(0) lgkmcnt(0)" ::: "memory"); }
    bf16x8 qf[NR][2]; f32x4 o[NR][4]; float mrun[NR], lrun[NR];
#pragma unroll
    for (int qi = 0; qi < NR; ++qi) { const size_t qrow = (size_t)b * SEQ + (r0 + qi) * 64 + j * 16 + fr;
#pragma unroll
        for (int ks = 0; ks < 2; ++ks) qf[qi][ks] = *(const bf16x8*)(P + qrow * LDP1 + h * 64 + ks * 32 + fq * 8);
#pragma unroll
        for (int nt = 0; nt < 4; ++nt) o[qi][nt] = (f32x4){0.f, 0.f, 0.f, 0.f};
        mrun[qi] = -1e30f; lrun[qi] = 0.f; }
    const float sc2 = 0.125f * LOG2E;
    const float nob[8] = {0.f, 0.f, 0.f, 0.f, 0.f, 0.f, 0.f, 0.f};
    const bf16* vbase = VtC + (size_t)((b * 16 + h) * 64) * KEYS;
    const bf16* kctx = P + (size_t)(NLAT + b * CTXL) * LDP1 + 1024 + h * 64;
    const bf16* kloc = P + (size_t)(b * SEQ) * LDP1 + 1024 + h * 64;
    const int seg_start = j == 0 ? 0 : (j == 1 ? 8 : (j == 2 ? 24 : 32));
    const int qcol = j * 16 + fr; const int cs = qcol - 8 < 0 ? 0 : (qcol - 8 > 48 ? 48 : qcol - 8);
    unsigned okmask = 0u; int coloff[8];
#pragma unroll
    for (int i = 0; i < 8; ++i) { const int keycol = seg_start + fq * 8 + i; if (keycol >= cs && keycol < cs + 16) okmask |= 1u << i;
        int co = keycol - qcol + 15; co = co < 0 ? 0 : (co > 30 ? 30 : co); coloff[i] = co; }
    const int rsa = r0 - 4 < 0 ? 0 : (r0 - 4 > 56 ? 56 : r0 - 4);
    const int rsb = r0 + NR - 1 - 4 < 0 ? 0 : (r0 + NR - 1 - 4 > 56 ? 56 : r0 + NR - 1 - 4);
    const int nloc = rsb + 8 - rsa, ntile = 8 + nloc;
#define NA_LOAD(F, t) do { const int t_ = (t); const int k0_ = t_ < 8 ? t_ * 32 : (rsa + t_ - 8) * 64 + seg_start; \
        kv_load(F, (t_ < 8 ? kctx : kloc) + (size_t)k0_ * LDP1, LDP1, vbase + (t_ < 8 ? SEQ : 0) + k0_, KEYS, fr, fq); } while (0)
#define NA_PROC(F, t) do { const int t_ = (t); \
        if (t_ < 8) { _Pragma("unroll") for (int qi = 0; qi < NR; ++qi) attn_one<0>(o[qi], mrun[qi], lrun[qi], qf[qi], F, sc2, 0, 0u, nob); } \
        else { const int R_ = rsa + t_ - 8; \
            _Pragma("unroll") for (int qi = 0; qi < NR; ++qi) { const int r_ = r0 + qi; const int rs_ = r_ - 4 < 0 ? 0 : (r_ - 4 > 56 ? 56 : r_ - 4); \
                if (R_ >= rs_ && R_ < rs_ + 8) { const LAS float* rb_ = btab + (R_ - r_ + 7) * 31; float bias_[8]; \
                    _Pragma("unroll") for (int e = 0; e < 8; ++e) bias_[e] = rb_[coloff[e]]; \
                    attn_one<2>(o[qi], mrun[qi], lrun[qi], qf[qi], F, sc2, 0, okmask, bias_); } } } } while (0)
    if (NR <= 2) {
        KVFrag A, B;
        NA_LOAD(A, 0);
        for (int t = 0; t < ntile; t += 2) {
            NA_LOAD(B, (t + 1 < ntile ? t + 1 : ntile - 1));
            NA_PROC(A, t);
            NA_LOAD(A, (t + 2 < ntile ? t + 2 : ntile - 1));
            if (t + 1 < ntile) NA_PROC(B, t + 1);
        }
    } else {
        KVFrag A;
        for (int t = 0; t < ntile; ++t) { NA_LOAD(A, t); NA_PROC(A, t); }
    }
#undef NA_LOAD
#undef NA_PROC
#pragma unroll
    for (int qi = 0; qi < NR; ++qi) attn_store1(o[qi], lrun[qi], O + ((size_t)b * SEQ + (r0 + qi) * 64 + j * 16 + fr) * D + h * 64, fq);
}

constexpr int NA_KC = 0, NA_VC = 36864, NA_KR = 73728, NA_VR = 92160, NA_BT = 110592;
typedef short s16x4 __attribute__((ext_vector_type(4)));
DI void kv_load_lds(KVFrag& f, const LAS unsigned short* kimg, const LAS unsigned short* vimg  , int fr, int fq) {
#pragma unroll
    for (int h = 0; h < 2; ++h)
#pragma unroll
        for (int ks = 0; ks < 2; ++ks) f.kf[h][ks] = *(const LAS bf16x8*)(kimg + ((fr >> 2) * 8 + h * 4 + (fr & 3)) * 72 + ks * 32 + fq * 8);
#ifdef NA_PLAIN_V
#pragma unroll
    for (int nt = 0; nt < 4; ++nt) { bf16x8 v;
#pragma unroll
        for (int j = 0; j < 8; ++j) v[j] = (short)vimg[(fq * 8 + j) * 72 + nt * 16 + fr];
        f.vf[nt] = v; }
    return;
#endif
    typedef LAS s16x4* trp_t;
    const LAS unsigned short* vb = vimg + (fq * 8 + (fr >> 2)) * 72 + (fr & 3) * 4;
    const s16x4 l0 = __builtin_amdgcn_ds_read_tr16_b64_v4i16((trp_t)(vb)),      h0 = __builtin_amdgcn_ds_read_tr16_b64_v4i16((trp_t)(vb + 288));
    const s16x4 l1 = __builtin_amdgcn_ds_read_tr16_b64_v4i16((trp_t)(vb + 16)), h1 = __builtin_amdgcn_ds_read_tr16_b64_v4i16((trp_t)(vb + 304));
    const s16x4 l2 = __builtin_amdgcn_ds_read_tr16_b64_v4i16((trp_t)(vb + 32)), h2 = __builtin_amdgcn_ds_read_tr16_b64_v4i16((trp_t)(vb + 320));
    const s16x4 l3 = __builtin_amdgcn_ds_read_tr16_b64_v4i16((trp_t)(vb + 48)), h3 = __builtin_amdgcn_ds_read_tr16_b64_v4i16((trp_t)(vb + 336));
    f.vf[0] = __builtin_shufflevector(l0, h0, 0, 1, 2, 3, 4, 5, 6, 7); f.vf[1] = __builtin_shufflevector(l1, h1, 0, 1, 2, 3, 4, 5, 6, 7);
    f.vf[2] = __builtin_shufflevector(l2, h2, 0, 1, 2, 3, 4, 5, 6, 7); f.vf[3] = __builtin_shufflevector(l3, h3, 0, 1, 2, 3, 4, 5, 6, 7);
}
DI void na_attn_unit(const Args& a, LAS unsigned char* lds, int unit, int tid, int lane, int wave) {
    const bf16* P = (const bf16*)(a.ws + WS_P); bf16* O = (bf16*)(a.ws + WS_HO);
    LAS unsigned short* KC = (LAS unsigned short*)(lds + NA_KC); LAS unsigned short* VC = (LAS unsigned short*)(lds + NA_VC);
    LAS unsigned short* KR = (LAS unsigned short*)(lds + NA_KR); LAS unsigned short* VR = (LAS unsigned short*)(lds + NA_VR); LAS float* bt = (LAS float*)(lds + NA_BT);
    const int fr = lane & 15, fq = lane >> 4;
    const int r0 = (unit & 15) * 4, h = (unit >> 4) & 15, b = unit >> 8;
    const int qr = r0 + (wave >> 1), jb = (wave & 1) * 2;
    const bf16* kglob = P + (size_t)(b * SEQ) * LDP1 + 1024 + h * 64;
    const bf16* vglob = P + (size_t)(b * SEQ) * LDP1 + 2048 + h * 64;
    const int rsa = r0 - 4 < 0 ? 0 : (r0 - 4 > 56 ? 56 : r0 - 4);
    const int rsb = r0 + 3 - 4 < 0 ? 0 : (r0 + 3 - 4 > 56 ? 56 : r0 + 3 - 4);
    const int nloc = rsb + 8 - rsa;
    for (int i = tid; i < 465; i += NTHR) bt[i] = a.in[I_RELB][h * 465 + i] * LOG2E;
    { const int row = tid >> 1, half = tid & 1; const bf16* src = P + (size_t)(NLAT + b * CTXL + row) * LDP1 + 1024 + h * 64 + half * 32;
#pragma unroll
      for (int i = 0; i < 4; ++i) { *(LAS u32x4*)(KC + row * 72 + half * 32 + i * 8) = *(const u32x4*)(src + i * 8); *(LAS u32x4*)(VC + row * 72 + half * 32 + i * 8) = *(const u32x4*)(src + 1024 + i * 8); } }
    const int srow = tid >> 3, sch = (tid & 7) * 8;
    { const u32x4 kreg = *(const u32x4*)(kglob + (size_t)(rsa * 64 + srow) * LDP1 + sch), vreg = *(const u32x4*)(vglob + (size_t)(rsa * 64 + srow) * LDP1 + sch);
      *(LAS u32x4*)(KR + srow * 72 + sch) = kreg; *(LAS u32x4*)(VR + srow * 72 + sch) = vreg; }
    bf16x8 qf[2][2]; f32x4 o[2][4]; float mrun[2], lrun[2];
#pragma unroll
    for (int qi = 0; qi < 2; ++qi) { const size_t qrow = (size_t)b * SEQ + qr * 64 + (jb + qi) * 16 + fr;
#pragma unroll
        for (int ks = 0; ks < 2; ++ks) qf[qi][ks] = *(const bf16x8*)(P + qrow * LDP1 + h * 64 + ks * 32 + fq * 8);
#pragma unroll
        for (int nt = 0; nt < 4; ++nt) o[qi][nt] = (f32x4){0.f, 0.f, 0.f, 0.f};
        mrun[qi] = -1e30f; lrun[qi] = 0.f; }
    const float sc2 = 0.125f * LOG2E;
    const float nob[8] = {0.f, 0.f, 0.f, 0.f, 0.f, 0.f, 0.f, 0.f};
    __syncthreads();
    for (int t8 = 0; t8 < 8; ++t8) { KVFrag F; kv_load_lds(F, KC + t8 * 32 * 72, VC + t8 * 32 * 72, fr, fq);
#pragma unroll
        for (int qi = 0; qi < 2; ++qi) attn_one<0>(o[qi], mrun[qi], lrun[qi], qf[qi], F, sc2, 0, 0u, nob); }
    int seg_start[2], cbase[2]; unsigned okmask[2];
#pragma unroll
    for (int qi = 0; qi < 2; ++qi) { const int j = jb + qi; seg_start[qi] = j == 0 ? 0 : (j == 1 ? 8 : (j == 2 ? 24 : 32));
        const int qcol = j * 16 + fr; const int cs = qcol - 8 < 0 ? 0 : (qcol - 8 > 48 ? 48 : qcol - 8);
        unsigned m = 0u;
#pragma unroll
        for (int i = 0; i < 8; ++i) { const int keycol = seg_start[qi] + fq * 8 + i; if (keycol >= cs && keycol < cs + 16) m |= 1u << i; }
        okmask[qi] = m; cbase[qi] = seg_start[qi] + fq * 8 - qcol + 15; }
    const int rsq = qr - 4 < 0 ? 0 : (qr - 4 > 56 ? 56 : qr - 4);
    for (int t = 0; t < nloc; ++t) {
        const int R = rsa + t, cur = t & 1;
        u32x4 kreg = {0u, 0u, 0u, 0u}, vreg = {0u, 0u, 0u, 0u};
        if (t + 1 < nloc) { kreg = *(const u32x4*)(kglob + (size_t)((R + 1) * 64 + srow) * LDP1 + sch); vreg = *(const u32x4*)(vglob + (size_t)((R + 1) * 64 + srow) * LDP1 + sch); }
        if (R >= rsq && R < rsq + 8) {
            const LAS float* rb = bt + (R - qr + 7) * 31;
#pragma unroll
            for (int qi = 0; qi < 2; ++qi) { KVFrag F; kv_load_lds(F, KR + cur * 4608 + seg_start[qi] * 72, VR + cur * 4608 + seg_start[qi] * 72, fr, fq);
                float bias[8];
#pragma unroll
                for (int e = 0; e < 8; ++e) { int co = cbase[qi] + e; co = co < 0 ? 0 : (co > 30 ? 30 : co); bias[e] = rb[co]; }
                attn_one<2>(o[qi], mrun[qi], lrun[qi], qf[qi], F, sc2, 0, okmask[qi], bias); }
        }
        if (t + 1 < nloc) { *(LAS u32x4*)(KR + (cur ^ 1) * 4608 + srow * 72 + sch) = kreg; *(LAS u32x4*)(VR + (cur ^ 1) * 4608 + srow * 72 + sch) = vreg; }
        __syncthreads();
    }
#pragma unroll
    for (int qi = 0; qi < 2; ++qi) attn_store1(o[qi], lrun[qi], O + ((size_t)b * SEQ + qr * 64 + (jb + qi) * 16 + fr) * D + h * 64, fq);
}

DI void vt_unit(const bf16* P, int ldp, int vcol, int nh, bf16* Vt, int unit, LAS unsigned char* scr, int lane) {
    const int kb = unit % 68, bh = unit / 68, h = bh % nh, b = bh / nh;
    const size_t row0 = kb < 64 ? (size_t)b * SEQ + kb * 64 : (size_t)NLAT + b * CTXL + (kb - 64) * 64;
    LAS unsigned short* t = (LAS unsigned short*)scr;
#pragma unroll
    for (int i = 0; i < 8; ++i) { const int key = (lane >> 3) + 8 * i, ch = lane & 7;
        const u32x4 v = *(const u32x4*)(P + (row0 + key) * ldp + vcol + h * 64 + ch * 8);
        *(LAS u32x4*)(t + key * 72 + ch * 8) = v; }
    asm volatile("s_waitcnt lgkmcnt(0)" ::: "memory");
    bf16* dst = Vt + (size_t)(bh * 64 + lane) * KEYS + kb * 64;
#pragma unroll
    for (int g8 = 0; g8 < 8; ++g8) { unsigned short e[8];
#pragma unroll
        for (int i = 0; i < 8; ++i) e[i] = t[(g8 * 8 + i) * 72 + lane];
        u32x4 w; w.x = e[0] | ((unsigned)e[1] << 16); w.y = e[2] | ((unsigned)e[3] << 16); w.z = e[4] | ((unsigned)e[5] << 16); w.w = e[6] | ((unsigned)e[7] << 16);
        *(u32x4*)(dst + g8 * 8) = w; }
    asm volatile("s_waitcnt lgkmcnt(0)" ::: "memory");
}

constexpr int L_GW = 0, L_CUM = 4608, L_A = 21248, L_B = 30464, L_ATT = 39680, L_VT = 48896, L_SSQ = 67328, L_TOT = 67840;
DI size_t chunk_row0(int b, int n) { return n < 64 ? (size_t)b * SEQ + n * 64 : (size_t)NLAT + b * CTXL + (n - 64) * 64; }
DI float* cum_ptr(const Args& a, int dir, int bh, int n) { return (float*)(a.ws + (dir ? WS_CUM1 : WS_CUM0)) + (size_t)(bh * NCHUNK + n) * 4096; }
DI float* st_ptr(const Args& a, int seq, int n) { return n < 64 ? a.out + (size_t)(seq * 64 + n) * 8192 : (float*)(a.ws + WS_STC) + (size_t)(seq * 4 + (n - 64)) * 8192; }

DI void gla_cum(const Args& a, LAS unsigned char* lds, const bf16* P, size_t row0, int h, int dir, int tid) {
    LAS float* rfl = (LAS float*)(lds + L_GW); LAS float* tot = (LAS float*)(lds + L_TOT); LAS float* cum = (LAS float*)(lds + L_CUM);
    const float* gw = a.in[dir ? I_GBW : I_GFW]; const float* gb = a.in[dir ? I_GBB : I_GFB];
    const int lane = tid & 63, w = tid >> 6;
    { const int c = tid >> 3, r2 = (tid & 7) * 2; const unsigned v = *(const unsigned*)(P + (row0 + c) * LDP0 + (dir ? C_RB : C_RF) + r2);
      rfl[c * 16 + r2] = __uint_as_float(v << 16); rfl[c * 16 + r2 + 1] = __uint_as_float(v & 0xffff0000u); }
    float gwr[16];
#pragma unroll
    for (int r = 0; r < 16; ++r) gwr[r] = gw[r * 256 + h * 64 + lane];
    const float gbv = gb[h * 64 + lane];
    __syncthreads();
    float la[8];
#pragma unroll
    for (int i = 0; i < 8; ++i) { const int c = w * 8 + i; float x = gbv;
#pragma unroll
        for (int r = 0; r < 16; ++r) x += rfl[c * 16 + r] * gwr[r];
        la[i] = (fminf(x, 0.f) - __logf(1.0f + __expf(-fabsf(x)))) * (1.0f / 16.0f); }
    if (dir == 0) {
#pragma unroll
        for (int i = 1; i < 8; ++i) la[i] += la[i - 1];
        tot[w * 64 + lane] = la[7];
    } else {
#pragma unroll
        for (int i = 6; i >= 0; --i) la[i] += la[i + 1];
        tot[w * 64 + lane] = la[0];
    }
    __syncthreads();
    float off = 0.f;
#pragma unroll
    for (int w2 = 0; w2 < 8; ++w2) { const float t = tot[w2 * 64 + lane]; off += ((dir == 0) ? (w2 < w) : (w2 > w)) ? t : 0.f; }
#pragma unroll
    for (int i = 0; i < 8; ++i) cum[(w * 8 + i) * 65 + lane] = la[i] + off;
    __syncthreads();
}
DI void gla_load_vt(LAS unsigned char* lds, const bf16* P, size_t row0, int h, int tid) {
    LAS unsigned short* vT = (LAS unsigned short*)(lds + L_VT);
    const int c = tid >> 3, dg = tid & 7;
    const bf16* vp = P + (row0 + c) * LDP0 + C_BV + h * 128 + dg * 16;
    const bf16x8 v0 = *(const bf16x8*)vp, v1 = *(const bf16x8*)(vp + 8);
#pragma unroll
    for (int e = 0; e < 8; ++e) { vT[(dg * 16 + e) * 72 + c] = (unsigned short)v0[e]; vT[(dg * 16 + 8 + e) * 72 + c] = (unsigned short)v1[e]; }
}
DI void gla_g1_unit(const Args& a, LAS unsigned char* lds, int unit, int tid, int lane, int wave) {
    const bf16* P = (const bf16*)(a.ws + WS_P);
    const int n = unit % NCHUNK, seq = unit / NCHUNK, dir = seq & 1, h = (seq >> 1) & 3, b = seq >> 3;
    const size_t row0 = chunk_row0(b, n);
    const bf16x8 kraw = *(const bf16x8*)(P + (row0 + (tid >> 3)) * LDP0 + C_BK + h * 64 + (tid & 7) * 8);
    gla_load_vt(lds, P, row0, h, tid);
    gla_cum(a, lds, P, row0, h, dir, tid);
    LAS float* cum = (LAS float*)(lds + L_CUM); LAS unsigned short* kdT = (LAS unsigned short*)(lds + L_A); LAS unsigned short* vT = (LAS unsigned short*)(lds + L_VT);
    const int cend = dir ? 0 : 63;
    { const int c = tid >> 3, dg = tid & 7; float kk[8]; unpack8(kraw, kk);
#pragma unroll
      for (int dd = 0; dd < 8; ++dd) { const int d = dg * 8 + dd; const float v = kk[dd] * __expf(cum[cend * 65 + d] - cum[c * 65 + d]); kdT[d * 72 + c] = (unsigned short)(pk2(v, 0.f) & 0xffffu); } }
    { const int c = tid >> 3, dg = tid & 7; float* cp = cum_ptr(a, dir, seq >> 1, n) + c * 64 + dg * 8;
      *(f32x4*)cp = (f32x4){cum[c * 65 + dg * 8], cum[c * 65 + dg * 8 + 1], cum[c * 65 + dg * 8 + 2], cum[c * 65 + dg * 8 + 3]};
      *(f32x4*)(cp + 4) = (f32x4){cum[c * 65 + dg * 8 + 4], cum[c * 65 + dg * 8 + 5], cum[c * 65 + dg * 8 + 6], cum[c * 65 + dg * 8 + 7]}; }
    if (tid < 64) ((float*)(a.ws + WS_DEC))[(size_t)(seq * NCHUNK + n) * 64 + tid] = __expf(cum[cend * 65 + tid]);
    __syncthreads();
    const int fr = lane & 15, fq = lane >> 4;
    bf16x8 av[2];
#pragma unroll
    for (int ks = 0; ks < 2; ++ks) av[ks] = *(const LAS bf16x8*)(vT + (wave * 16 + fr) * 72 + ks * 32 + fq * 8);
    float* st = st_ptr(a, seq, n);
#pragma unroll
    for (int nt = 0; nt < 4; ++nt) { f32x4 acc = {0.f, 0.f, 0.f, 0.f};
#pragma unroll
        for (int ks = 0; ks < 2; ++ks) { const bf16x8 bk = *(const LAS bf16x8*)(kdT + (nt * 16 + fr) * 72 + ks * 32 + fq * 8); acc = MFMA16(av[ks], bk, acc); }
#pragma unroll
        for (int r = 0; r < 4; ++r) st[(wave * 16 + fq * 4 + r) * 64 + nt * 16 + fr] = acc[r]; }
    __syncthreads();
}
DI void gla_scan(const Args& a, int tid) {
    const float* DEC = (const float*)(a.ws + WS_DEC);
    for (int e = blockIdx.x * NTHR + tid; e < 32 * 8192; e += gridDim.x * NTHR) {
        const int seq = e >> 13, el = e & 8191, dk = el & 63, dir = seq & 1;
        float S = 0.f;
        for (int s4 = 0; s4 < NCHUNK; s4 += 4) {
            float* p[4]; float t[4], dc[4];
#pragma unroll
            for (int i = 0; i < 4; ++i) { const int step = s4 + i; const int n = dir == 0 ? (step < 4 ? 64 + step : step - 4) : (step < 4 ? 67 - step : 67 - step);
                p[i] = st_ptr(a, seq, n) + el; t[i] = *p[i]; dc[i] = DEC[(size_t)(seq * NCHUNK + n) * 64 + dk]; }
#pragma unroll
            for (int i = 0; i < 4; ++i) { *p[i] = S; S = dc[i] * S + t[i]; }
        }
    }
}
DI void gla_g3_unit(const Args& a, LAS unsigned char* lds, int unit, int tid, int lane, int wave) {
    const bf16* P = (const bf16*)(a.ws + WS_P); bf16* O = (bf16*)(a.ws + WS_HO);
    const int n = unit % NCHUNK, bh = unit / NCHUNK, h = bh & 3, b = bh >> 2;
    const size_t row0 = chunk_row0(b, n);
    LAS float* cum = (LAS float*)(lds + L_CUM); LAS unsigned short* qg = (LAS unsigned short*)(lds + L_A); LAS unsigned short* kg = (LAS unsigned short*)(lds + L_B);
    LAS unsigned short* att = (LAS unsigned short*)(lds + L_ATT); LAS unsigned short* vT = (LAS unsigned short*)(lds + L_VT); LAS float* ssq = (LAS float*)(lds + L_SSQ);
    const int fr = lane & 15, fq = lane >> 4, ct = wave & 3, dvh = wave >> 2;
    gla_load_vt(lds, P, row0, h, tid);
    f32x4 acc[4];
#pragma unroll
    for (int nt = 0; nt < 4; ++nt) acc[nt] = (f32x4){0.f, 0.f, 0.f, 0.f};
    const bf16x8 qraw = *(const bf16x8*)(P + (row0 + (tid >> 3)) * LDP0 + C_BQ + h * 64 + (tid & 7) * 8), kraw = *(const bf16x8*)(P + (row0 + (tid >> 3)) * LDP0 + C_BK + h * 64 + (tid & 7) * 8);
    for (int dir = 0; dir < 2; ++dir) {
        const float* cp = cum_ptr(a, dir, bh, n) + (tid >> 3) * 64 + (tid & 7) * 8;
        const f32x4 c0 = *(const f32x4*)cp, c1 = *(const f32x4*)(cp + 4);
        const float* st = st_ptr(a, (bh * 2 + dir), n);
        f32x4 sraw[4][2][2];
#pragma unroll
        for (int nt = 0; nt < 4; ++nt)
#pragma unroll
            for (int ks = 0; ks < 2; ++ks) { const float* sp = st + ((dvh * 4 + nt) * 16 + fr) * 64 + ks * 32 + fq * 8; sraw[nt][ks][0] = *(const f32x4*)sp; sraw[nt][ks][1] = *(const f32x4*)(sp + 4); }
        { const int c = tid >> 3, dg = tid & 7; float qq[8], kk[8], oq[8], ok[8];
          const float cu8[8] = {c0[0], c0[1], c0[2], c0[3], c1[0], c1[1], c1[2], c1[3]};
          unpack8(qraw, qq); unpack8(kraw, kk);
#pragma unroll
          for (int dd = 0; dd < 8; ++dd) { const float cu = cu8[dd]; oq[dd] = qq[dd] * 0.125f * __expf(cu); ok[dd] = kk[dd] * __expf(-cu); }
          *(LAS bf16x8*)(qg + c * 72 + dg * 8) = pack8(oq); *(LAS bf16x8*)(kg + c * 72 + dg * 8) = pack8(ok); }
        __syncthreads();
        bf16x8 bq[2];
#pragma unroll
        for (int ks = 0; ks < 2; ++ks) bq[ks] = *(const LAS bf16x8*)(qg + (ct * 16 + fr) * 72 + ks * 32 + fq * 8);
#pragma unroll
        for (int si = 0; si < 2; ++si) { const int st = dvh * 2 + si; f32x4 s = {0.f, 0.f, 0.f, 0.f};
#pragma unroll
            for (int ks = 0; ks < 2; ++ks) { const bf16x8 ak = *(const LAS bf16x8*)(kg + (st * 16 + fr) * 72 + ks * 32 + fq * 8); s = MFMA16(ak, bq[ks], s); }
            const int cpos = ct * 16 + fr; float pv[4];
#pragma unroll
            for (int r = 0; r < 4; ++r) { const int spos = st * 16 + fq * 4 + r; const bool keep = dir == 0 ? (spos <= cpos) : (spos >= cpos); pv[r] = keep ? s[r] : 0.f; }
            u32x2 w; w.x = pk2(pv[0], pv[1]); w.y = pk2(pv[2], pv[3]);
            *(LAS u32x2*)(att + cpos * 72 + st * 16 + fq * 4) = w; }
        __syncthreads();
        bf16x8 ba[2];
#pragma unroll
        for (int ks = 0; ks < 2; ++ks) ba[ks] = *(const LAS bf16x8*)(att + (ct * 16 + fr) * 72 + ks * 32 + fq * 8);
#pragma unroll
        for (int nt = 0; nt < 4; ++nt) { const int dvt = dvh * 4 + nt;
#pragma unroll
            for (int ks = 0; ks < 2; ++ks) {
                const bf16x8 av = *(const LAS bf16x8*)(vT + (dvt * 16 + fr) * 72 + ks * 32 + fq * 8);
                acc[nt] = MFMA16(av, ba[ks], acc[nt]);
                const f32x4 s0 = sraw[nt][ks][0], s1 = sraw[nt][ks][1];
                const float sf[8] = {s0[0], s0[1], s0[2], s0[3], s1[0], s1[1], s1[2], s1[3]};
                acc[nt] = MFMA16(pack8(sf), bq[ks], acc[nt]); } }
        __syncthreads();
    }
    float sq = 0.f;
#pragma unroll
    for (int nt = 0; nt < 4; ++nt) sq += (acc[nt][0] * acc[nt][0] + acc[nt][1] * acc[nt][1]) + (acc[nt][2] * acc[nt][2] + acc[nt][3] * acc[nt][3]);
    sq += __shfl_xor(sq, 16); sq += __shfl_xor(sq, 32);
    if (fq == 0) ssq[wave * 16 + fr] = sq;
    __syncthreads();
    const float tot = ssq[wave * 16 + fr] + ssq[(wave ^ 4) * 16 + fr];
    const float rstd = __builtin_amdgcn_rsqf(tot * (1.0f / 128.0f) + EPS);
    const size_t row = row0 + ct * 16 + fr;
#pragma unroll
    for (int nt = 0; nt < 4; ++nt) { const int dv0 = (dvh * 4 + nt) * 16 + fq * 4;
        const f32x4 g4 = *(const f32x4*)(a.in[I_GNORM] + h * 128 + dv0);
        const u32x2 bw = *(const u32x2*)(P + row * LDP0 + C_BO + h * 128 + dv0);
        const float g0 = __uint_as_float(bw.x << 16), g1 = __uint_as_float(bw.x & 0xffff0000u), g2 = __uint_as_float(bw.y << 16), g3 = __uint_as_float(bw.y & 0xffff0000u);
        u32x2 w; w.x = pk2(acc[nt][0] * rstd * g4[0] * silu_f(g0), acc[nt][1] * rstd * g4[1] * silu_f(g1));
        w.y = pk2(acc[nt][2] * rstd * g4[2] * silu_f(g2), acc[nt][3] * rstd * g4[3] * silu_f(g3));
        *(u32x2*)(O + row * D + 512 + h * 128 + dv0) = w; }
    __syncthreads();
}

DI void rope_row(bf16* prow, int t, int lane) {
    const int prow_pos = t >> 6, pcol_pos = t & 63;
#pragma unroll
    for (int i = 0; i < 5; ++i) { const int pi = lane + 64 * i, head = pi >> 5, rem = pi & 31, half = rem >> 4, j = rem & 15;
        const int c1 = head * 64 + half * 32 + j, pos = half ? pcol_pos : prow_pos;
        const float cs = ROPE_COS[pos * 16 + j], sn = ROPE_SIN[pos * 16 + j];
        const float u1 = bf2f(prow[c1]), u2 = bf2f(prow[c1 + 16]);
        prow[c1] = (unsigned short)(pk2(u1 * cs - u2 * sn, 0.f) & 0xffffu); prow[c1 + 16] = (unsigned short)(pk2(u2 * cs + u1 * sn, 0.f) & 0xffffu); }
}

constexpr int NPHASE = 19;
#ifndef NA_NR
#define NA_NR 2
#endif
#ifndef PROBE_MASK
#define PROBE_MASK 0u
#endif
#define REPS(k) (((PROBE_MASK >> (k)) & 1u) ? 2 : 1)
__global__ void __launch_bounds__(NTHR, 2) fwd_kernel(Args a) {
    extern __shared__ __attribute__((aligned(16))) unsigned char lds_raw[];
    LAS unsigned char* lds = (LAS unsigned char*)lds_raw;
    const int tid = threadIdx.x, lane = tid & 63, wave = __builtin_amdgcn_readfirstlane(tid >> 6);
    const int G = gridDim.x, gw = blockIdx.x * NWAVES + wave, NGW = G * NWAVES;
    unsigned char* ws = a.ws;
    const int lo = a.ph_lo, hi = a.ph_hi;
#define IN(k) (lo <= (k) && (k) < hi)
#ifndef PROBE_SYNC
#define PROBE_SYNC 1
#endif
    volatile LAS unsigned* MISC = (volatile LAS unsigned*)(lds + 131072 + 320);
    if (tid < 32) MISC[tid] = 0u;
    __syncthreads();
    unsigned* barw = (unsigned*)(ws + WS_CTL);
    XcdBarrier xbar; xbar.bar = barw; xbar.x = 0; xbar.st = MISC + 8;
    if (hi - lo > 1) {
        if (blockIdx.x == 0) { for (int i = tid; i < XCD_BAR_WORDS; i += NTHR) barw[i] = 0u; }
        cg::this_grid().sync();
        xbar = xcd_barrier_post(barw, MISC + 8);
    }
#define SEAM(k) do { if (IN(k) && IN((k) + 1)) { for (int sr_ = 0; sr_ < PROBE_SYNC; ++sr_) xcd_barrier(xbar); } } while (0)
    bf16* H = (bf16*)(ws + WS_HO); bf16* YF = (bf16*)(ws + WS_YF); bf16* P = (bf16*)(ws + WS_P);

    if (IN(0)) { for (int rep = 0; rep < REPS(0); ++rep) { phase_prologue(a, lds, tid, lane, wave); __syncthreads(); } } SEAM(0);
    if (IN(1)) { for (int rep = 0; rep < REPS(1); ++rep) phase_rows(a, 0, 0, lane, wave); } SEAM(1);
    if (IN(2)) { pg8::Gemm g{H, (const bf16*)(ws + WS_WABI), MT, LDP0, D, D}; pg8::StaticOrder S; S.init(MT, LDP0, G, (int)blockIdx.x);
        EpiStore E{P, LDP0}; pg8::gemm_phase<EpiStore, pg8::StaticOrder, true, true>(lds, g, S, E); if (REPS(2) > 1) { pg8::gemm_phase<EpiStore, pg8::StaticOrder, true, true>(lds, g, S, E); } } SEAM(2);
    if (IN(3)) {
        for (int rep = 0; rep < REPS(3); ++rep) for (int u = blockIdx.x; u < 32 * NCHUNK; u += G) gla_g1_unit(a, lds, u, tid, lane, wave);
        __syncthreads();
        for (int m = gw; m < NLAT; m += NGW) rope_row(P + (size_t)m * LDP0, m & 4095, lane);
        for (int u = gw; u < NBATCH * 2 * 68; u += NGW) vt_unit(P, LDP0, C_AV, 2, YF, u, lds + wave * 16384, lane);
    } SEAM(3);
    if (IN(4)) {
        for (int rep = 0; rep < REPS(4); ++rep) for (int wt = gw; wt < 2176; wt += NGW) window_attn_tile(a, wt, lane);
        gla_scan(a, tid);
    } SEAM(4);
    if (IN(5)) { for (int rep = 0; rep < REPS(5); ++rep) for (int u = blockIdx.x; u < 16 * NCHUNK; u += G) gla_g3_unit(a, lds, u, tid, lane, wave); } SEAM(5);
    if (IN(6)) { pg8::Gemm g{H, (const bf16*)(ws + WS_WABO), NLAT, D, D, D}; pg8::StaticOrder S; S.init(NLAT, D, G, (int)blockIdx.x);
        EpiStore E{YF, D}; pg8::gemm_phase<EpiStore, pg8::StaticOrder, true, true>(lds, g, S, E); if (REPS(6) > 1) { pg8::gemm_phase<EpiStore, pg8::StaticOrder, true, true>(lds, g, S, E); }
        { const int bx = (int)blockIdx.x, kc = bx >> 4, uu = bx & 15; OneUnit S1{uu >> 2, uu & 3, bx < 64};
          pg8::Gemm g1{H + (size_t)NLAT * D + kc * 256, (const bf16*)(ws + WS_WABO) + kc * 256, NCTX, D, D, 256};
          EpiStore E1{(bf16*)(ws + WS_PART) + (size_t)kc * NCTX * D, D}; pg8::gemm_phase<EpiStore, OneUnit, true, true>(lds, g1, S1, E1); } } SEAM(6);
    if (IN(7)) { for (int rep = 0; rep < REPS(7); ++rep) phase_rows(a, 1, 0, lane, wave); } SEAM(7);
    if (IN(8)) { pg8::Gemm g{H, (const bf16*)(ws + WS_WFI), MT, 2 * FF, D, D}; pg8::StaticOrder S; S.init(MT, 2 * FF, G, (int)blockIdx.x);
        EpiSwiglu E{P, FF}; pg8::gemm_phase<EpiSwiglu, pg8::StaticOrder, true, true>(lds, g, S, E); if (REPS(8) > 1) { pg8::gemm_phase<EpiSwiglu, pg8::StaticOrder, true, true>(lds, g, S, E); } } SEAM(8);
    if (IN(9)) { pg8::Gemm g{P, (const bf16*)(ws + WS_WFO), NLAT, D, FF, FF}; pg8::StaticOrder S; S.init(NLAT, D, G, (int)blockIdx.x);
        EpiStore E{YF, D}; pg8::gemm_phase<EpiStore, pg8::StaticOrder, true, true>(lds, g, S, E); if (REPS(9) > 1) { pg8::gemm_phase<EpiStore, pg8::StaticOrder, true, true>(lds, g, S, E); }
        { const int bx = (int)blockIdx.x, kc = bx >> 4, uu = bx & 15; OneUnit S1{uu >> 2, uu & 3, bx < 176};
          pg8::Gemm g1{P + (size_t)NLAT * FF + kc * 256, (const bf16*)(ws + WS_WFO) + kc * 256, NCTX, D, FF, 256};
          EpiStore E1{(bf16*)(ws + WS_PART) + (size_t)kc * NCTX * D, D}; pg8::gemm_phase<EpiStore, OneUnit, true, true>(lds, g1, S1, E1); } } SEAM(9);
    if (IN(10)) { phase_rows(a, 2, 0, lane, wave); } SEAM(10);
    if (IN(11)) { pg8::Gemm g{H, (const bf16*)(ws + WS_WNI), MT, LDP1, D, D}; pg8::StaticOrder S; S.init(MT, LDP1, G, (int)blockIdx.x);
        EpiStore E{P, LDP1}; pg8::gemm_phase<EpiStore, pg8::StaticOrder, true, true>(lds, g, S, E); if (REPS(11) > 1) { pg8::gemm_phase<EpiStore, pg8::StaticOrder, true, true>(lds, g, S, E); } } SEAM(11);
    if (IN(13)) { for (int rep = 0; rep < REPS(13); ++rep) for (int u = blockIdx.x; u < 1024; u += G) na_attn_unit(a, lds, u, tid, lane, wave); } SEAM(13);
    if (IN(14)) { pg8::Gemm g{H, (const bf16*)(ws + WS_WNO), NLAT, D, D, D}; pg8::StaticOrder S; S.init(NLAT, D, G, (int)blockIdx.x);
        EpiStore E{YF, D}; pg8::gemm_phase<EpiStore, pg8::StaticOrder, true, true>(lds, g, S, E); if (REPS(14) > 1) { pg8::gemm_phase<EpiStore, pg8::StaticOrder, true, true>(lds, g, S, E); } } SEAM(14);
    if (IN(15)) { phase_rows(a, 1, 1, lane, wave); } SEAM(15);
    if (IN(16)) { pg8::Gemm g{H, (const bf16*)(ws + WS_WFI) + (size_t)5632 * 1024, NLAT, 2 * FF, D, D}; pg8::StaticOrder S; S.init(NLAT, 2 * FF, G, (int)blockIdx.x);
        EpiSwiglu E{P, FF}; pg8::gemm_phase<EpiSwiglu, pg8::StaticOrder, true, true>(lds, g, S, E); if (REPS(16) > 1) { pg8::gemm_phase<EpiSwiglu, pg8::StaticOrder, true, true>(lds, g, S, E); } } SEAM(16);
    if (IN(17)) { pg8::Gemm g{P, (const bf16*)(ws + WS_WFO) + (size_t)1024 * FF, NLAT, D, FF, FF}; pg8::StaticOrder S; S.init(NLAT, D, G, (int)blockIdx.x);
        EpiStore E{YF, D}; pg8::gemm_phase<EpiStore, pg8::StaticOrder, true, true>(lds, g, S, E); if (REPS(17) > 1) { pg8::gemm_phase<EpiStore, pg8::StaticOrder, true, true>(lds, g, S, E); } } SEAM(17);
    if (IN(18)) { phase_rows(a, 2, 1, lane, wave); }
#undef IN
#undef SEAM
}

extern "C" void kernel_launch(void* const* d_in, const int* in_sizes, int n_in, void* d_out, int out_size, void* d_ws, size_t ws_size, hipStream_t stream) {
    static int grid = 0;
    if (grid == 0) {
        if (n_in != 23 || out_size != NLAT * D || ws_size < WS_END) { fprintf(stderr, "kernel_launch: unexpected problem shape (n_in %d, out %d, ws %zu)\n", n_in, out_size, ws_size); grid = -1; return; }
        int dev = 0, cus = 0, per_cu = 0;
        (void)hipGetDevice(&dev); (void)hipDeviceGetAttribute(&cus, hipDeviceAttributeMultiprocessorCount, dev);
        if (hipFuncSetAttribute((const void*)fwd_kernel, hipFuncAttributeMaxDynamicSharedMemorySize, LDS_BYTES) != hipSuccess) { fprintf(stderr, "kernel_launch: hipFuncSetAttribute failed\n"); grid = -1; return; }
        (void)hipOccupancyMaxActiveBlocksPerMultiprocessor(&per_cu, (const void*)fwd_kernel, NTHR, LDS_BYTES);
        if (per_cu < 1) per_cu = 1;
        (void)hipGetLastError();
        grid = cus * per_cu;
    }
    if (grid < 0) return;
    Args a{};
    for (int i = 0; i < 23; ++i) a.in[i] = (const float*)d_in[i];
    a.out = (float*)d_out; a.ws = (unsigned char*)d_ws;
#if COOP
    a.ph_lo = 0; a.ph_hi = NPHASE;
    void* args[] = {&a};
    hipError_t e = hipLaunchCooperativeKernel((const void*)fwd_kernel, dim3(grid), dim3(NTHR), args, LDS_BYTES, stream);
    if (e != hipSuccess) fprintf(stderr, "cooperative launch failed: %s (grid %d)\n", hipGetErrorString(e), grid);
#else
    for (int p = 0; p < NPHASE; ++p) { a.ph_lo = p; a.ph_hi = p + 1; hipLaunchKernelGGL(fwd_kernel, dim3(grid), dim3(NTHR), LDS_BYTES, stream, a); }
#endif
}
```

```cpp
#include <hip/hip_runtime.h>
#include <hip/hip_cooperative_groups.h>
#include <cstdio>
#include <cstdint>
namespace cg = cooperative_groups;
namespace pg8 {
#define PG8_LAS __attribute__((address_space(3)))
typedef unsigned short bf16_t;
typedef short bf16x8 __attribute__((ext_vector_type(8)));
typedef float f32x4 __attribute__((ext_vector_type(4)));
typedef unsigned u32x4 __attribute__((ext_vector_type(4)));
constexpr int BM = 256, BK = 64, HALF = 128, HTB = HALF * BK * 2  , STAGE_BYTES = 8 * HTB, NXCD = 8, WGM = 8;

__host__ __device__ __forceinline__ int lds_byte(int r, int c) { const int st = (r >> 4) * 2 + (c >> 5), rr = r & 15, cc = c & 31, ob = rr * 64 + cc * 2; return st * 1024 + (ob ^ (((ob >> 9) & 1) << 5)); }
__host__ __device__ __forceinline__ void stage_rc(int b, int& R, int& C) { const int st = b / 1024, sb = b % 1024, swz = sb ^ (((sb >> 9) & 1) << 5); R = (st >> 1) * 16 + swz / 64; C = (st & 1) * 32 + (swz % 64) / 2; }
__host__ __device__ __forceinline__ int perm32(int rho) { const int n = rho >> 4, i = rho & 15; return 8 * (i >> 2) + 4 * n + (i & 3); }

struct Unit { int pm, pn; };
struct Gemm { const bf16_t* A; const bf16_t* Bt; int M, N, K, Kext; };

struct StaticOrder {
    int nM, nN, nwg, G, c;
    __host__ __device__ void init(int M, int N, int G_, int c_) { nM = M / BM; nN = N / BM; nwg = nM * nN; G = G_; c = c_; }
    __host__ __device__ bool next(int i, Unit& u) const {
        const long L = (long)i * G + c; if (L >= nwg) return false;
        int wgid = (int)L; { const int q = nwg / NXCD, r = nwg % NXCD, xcd = wgid % NXCD, off = wgid / NXCD; wgid = (xcd < r ? xcd * (q + 1) : r * (q + 1) + (xcd - r) * q) + off; }
        const int nig = WGM * nN, gid = wgid / nig, fm = gid * WGM, gsz = (nM - fm) < WGM ? (nM - fm) : WGM;
        u.pm = fm + ((wgid % nig) % gsz); u.pn = (wgid % nig) / gsz; return true;
    }
    __device__ __forceinline__ void a_ready(const Unit&) const {}
    __device__ __forceinline__ void done(const Unit&) const {}
};

__device__ __forceinline__ unsigned cvt_pk_bf16(float lo, float hi) { unsigned r; asm volatile("v_cvt_pk_bf16_f32 %0, %1, %2" : "=v"(r) : "v"(lo), "v"(hi)); return r; }
template <class Epi, class Sched, bool ALIGN_EPI = false, bool SP2 = false>
__device__ __forceinline__ void gemm_phase(PG8_LAS unsigned char* lds, const Gemm g, const Sched& S, const Epi& E) {
    const int tid = threadIdx.x, wid = __builtin_amdgcn_readfirstlane(tid >> 6), lane = tid & 63, wr = wid >> 2, wc = wid & 3, fr = lane & 15, fq = lane >> 4;
    const int K = g.K, nt = g.Kext / BK;
    unsigned voffA[2], voffB[2];
#pragma unroll
    for (int i = 0; i < 2; ++i) { int R, C; stage_rc(tid * 16 + i * 8192, R, C); const int Rb = Epi::PERM ? ((R & ~31) + perm32(R & 31)) : R;
        voffA[i] = (unsigned)(R * K + C) * 2u; voffB[i] = (unsigned)(Rb * K + C) * 2u; }
    const size_t kstep = (size_t)(BK * 2);
    const size_t hstep = (size_t)HALF * K * 2;
    const size_t tstep = 2 * hstep;
    const unsigned ldsw = (unsigned)wid * 1024u;
    const int aoff = lds_byte(wr * 64 + fr, fq * 8), boff = lds_byte(wc * 32 + fr, fq * 8);
#define PG8_SA(b, h) (((b) * 2 + (h)) * HTB)
#define PG8_SB(b, h) ((4 + (b) * 2 + (h)) * HTB)
#define PG8_STAGE(bufoff, gbase, voff) do { _Pragma("unroll") for (int _i = 0; _i < 2; ++_i) \
        __builtin_amdgcn_global_load_lds((const unsigned*)((const char*)(gbase) + (voff)[_i]), (PG8_LAS unsigned*)(lds + (bufoff) + ldsw + _i * 8192), 16, 0, 0); } while (0)
#define PG8_LDA(dst, b, h) do { _Pragma("unroll") for (int m = 0; m < 4; ++m) _Pragma("unroll") for (int k = 0; k < 2; ++k) dst[m][k] = *(const PG8_LAS bf16x8*)(lds + PG8_SA(b, h) + aoff + m * 2048 + k * 1024); } while (0)
#define PG8_LDB(dst, b, h) do { _Pragma("unroll") for (int n = 0; n < 2; ++n) _Pragma("unroll") for (int k = 0; k < 2; ++k) dst[n][k] = *(const PG8_LAS bf16x8*)(lds + PG8_SB(b, h) + boff + n * 2048 + k * 1024); } while (0)
#define PG8_MMA(ai, bj, At, Bt) do { __builtin_amdgcn_s_setprio(1); _Pragma("unroll") for (int m = 0; m < 4; ++m) _Pragma("unroll") for (int n = 0; n < 2; ++n) _Pragma("unroll") for (int k = 0; k < 2; ++k) \
        acc[ai][bj][m][n] = __builtin_amdgcn_mfma_f32_16x16x32_bf16(Bt[n][k], At[m][k], acc[ai][bj][m][n], 0, 0, 0); __builtin_amdgcn_s_setprio(0); } while (0)
#define PG8_WAIT_V(n) asm volatile("s_waitcnt vmcnt(" #n ")" ::: "memory")
#define PG8_WAIT_L(n) asm volatile("s_waitcnt lgkmcnt(" #n ")" ::: "memory")
#define PG8_BAR __builtin_amdgcn_s_barrier()
#define PG8_SCHED __builtin_amdgcn_sched_barrier(0)
    Unit cur, nxt; int ui = 0;
    if (!S.next(0, cur)) return;
    f32x4 acc[2][2][4][2];
#pragma unroll
    for (int a = 0; a < 2; ++a)
#pragma unroll
        for (int b = 0; b < 2; ++b)
#pragma unroll
            for (int m = 0; m < 4; ++m)
#pragma unroll
                for (int n = 0; n < 2; ++n) acc[a][b][m][n] = (f32x4){0.f, 0.f, 0.f, 0.f};
    bf16x8 At[4][2], B0[2][2], B1[2][2];
    const char* cA = (const char*)g.A + (size_t)cur.pm * tstep; const char* cB = (const char*)g.Bt + (size_t)cur.pn * tstep;
    S.a_ready(cur);
    if constexpr (SP2) {
        PG8_STAGE(PG8_SB(0, 0), cB, voffB); PG8_STAGE(PG8_SB(0, 1), cB + hstep, voffB); PG8_STAGE(PG8_SA(0, 0), cA, voffA); PG8_STAGE(PG8_SA(0, 1), cA + hstep, voffA);
        if (wr == 1) PG8_BAR;
        PG8_WAIT_V(2); PG8_BAR;
        PG8_STAGE(PG8_SB(1, 0), cB + kstep, voffB); PG8_STAGE(PG8_SA(1, 0), cA + kstep, voffA); PG8_STAGE(PG8_SB(1, 1), cB + hstep + kstep, voffB);
        PG8_WAIT_V(6); PG8_BAR;
    } else {
        PG8_STAGE(PG8_SB(0, 0), cB, voffB); PG8_STAGE(PG8_SA(0, 0), cA, voffA); PG8_STAGE(PG8_SB(0, 1), cB + hstep, voffB); PG8_STAGE(PG8_SA(0, 1), cA + hstep, voffA);
        if (wr == 1) PG8_BAR;
        PG8_WAIT_V(4); PG8_BAR;
        PG8_STAGE(PG8_SB(1, 0), cB + kstep, voffB); PG8_STAGE(PG8_SA(1, 0), cA + kstep, voffA); PG8_STAGE(PG8_SB(1, 1), cB + hstep + kstep, voffB);
        PG8_WAIT_V(6); PG8_BAR;
    }
    for (;;) {
        const bool has_next = S.next(ui + 1, nxt);
        const char* nA = has_next ? (const char*)g.A + (size_t)nxt.pm * tstep : cA; const char* nB = has_next ? (const char*)g.Bt + (size_t)nxt.pn * tstep : cB;
        for (int t = 0; t < nt; t += 2) {
            const bool last = (t == nt - 2);
            const char* a1 = cA + (size_t)(t + 1) * kstep;
            const char* a2 = last ? nA : cA + (size_t)(t + 2) * kstep; const char* b2 = last ? nB : cB + (size_t)(t + 2) * kstep;
            const char* a3 = a2 + kstep; const char* b3 = b2 + kstep;
            if (last && has_next) S.a_ready(nxt);
            if constexpr (SP2) {
            PG8_LDB(B0, 0, 0); PG8_LDB(B1, 0, 1); PG8_SCHED; PG8_LDA(At, 0, 0); PG8_STAGE(PG8_SA(1, 1), a1 + hstep, voffA);
            PG8_WAIT_V(8); PG8_WAIT_L(0); PG8_BAR; PG8_MMA(0, 0, At, B0); PG8_MMA(0, 1, At, B1); PG8_BAR; PG8_SCHED;
            PG8_LDA(At, 0, 1); PG8_STAGE(PG8_SB(0, 0), b2, voffB); PG8_STAGE(PG8_SB(0, 1), b2 + hstep, voffB); PG8_STAGE(PG8_SA(0, 0), a2, voffA);
            PG8_WAIT_V(8); PG8_WAIT_L(0); PG8_BAR; PG8_MMA(1, 0, At, B0); PG8_MMA(1, 1, At, B1); PG8_BAR; PG8_SCHED;
            PG8_LDB(B0, 1, 0); PG8_LDB(B1, 1, 1); PG8_SCHED; PG8_LDA(At, 1, 0); PG8_STAGE(PG8_SA(0, 1), a2 + hstep, voffA);
            PG8_WAIT_V(8); PG8_WAIT_L(0); PG8_BAR; PG8_MMA(0, 0, At, B0); PG8_MMA(0, 1, At, B1); PG8_BAR; PG8_SCHED;
            PG8_LDA(At, 1, 1); PG8_STAGE(PG8_SB(1, 0), b3, voffB); PG8_STAGE(PG8_SB(1, 1), b3 + hstep, voffB); PG8_STAGE(PG8_SA(1, 0), a3, voffA);
            PG8_WAIT_V(8); PG8_WAIT_L(0); PG8_BAR; PG8_MMA(1, 0, At, B0); PG8_MMA(1, 1, At, B1); PG8_BAR; PG8_SCHED;
            } else {
            PG8_LDB(B0, 0, 0); PG8_SCHED; PG8_LDA(At, 0, 0); PG8_STAGE(PG8_SA(1, 1), a1 + hstep, voffA);
            PG8_WAIT_L(8); PG8_BAR; PG8_WAIT_L(0); PG8_MMA(0, 0, At, B0); PG8_BAR; PG8_SCHED;
            PG8_LDB(B1, 0, 1); PG8_STAGE(PG8_SB(0, 0), b2, voffB);
            PG8_BAR; PG8_WAIT_L(0); PG8_MMA(0, 1, At, B1); PG8_BAR;
            PG8_LDA(At, 0, 1); PG8_STAGE(PG8_SA(0, 0), a2, voffA);
            PG8_BAR; PG8_WAIT_L(0); PG8_MMA(1, 0, At, B0); PG8_BAR; PG8_SCHED;
            PG8_STAGE(PG8_SB(0, 1), b2 + hstep, voffB);
            PG8_WAIT_V(6); PG8_BAR; PG8_MMA(1, 1, At, B1); PG8_BAR;
            PG8_LDB(B0, 1, 0); PG8_SCHED; PG8_LDA(At, 1, 0); PG8_STAGE(PG8_SA(0, 1), a2 + hstep, voffA);
            PG8_WAIT_L(8); PG8_BAR; PG8_WAIT_L(0); PG8_MMA(0, 0, At, B0); PG8_BAR; PG8_SCHED;
            PG8_LDB(B1, 1, 1); PG8_STAGE(PG8_SB(1, 0), b3, voffB);
            PG8_BAR; PG8_WAIT_L(0); PG8_MMA(0, 1, At, B1); PG8_BAR;
            PG8_LDA(At, 1, 1); PG8_STAGE(PG8_SA(1, 0), a3, voffA);
            PG8_BAR; PG8_WAIT_L(0); PG8_MMA(1, 0, At, B0); PG8_BAR; PG8_SCHED;
            PG8_STAGE(PG8_SB(1, 1), b3 + hstep, voffB);
            PG8_WAIT_V(6); PG8_BAR; PG8_MMA(1, 1, At, B1); PG8_BAR;
            }
        }
        if constexpr (ALIGN_EPI) { if (wr == 0) PG8_BAR; }
        if constexpr (!Epi::AFTER_DRAIN) { E(acc, cur, wr, wc, fr, fq); S.done(cur); }
        if (!has_next) break;
#pragma unroll
        for (int a = 0; a < 2; ++a)
#pragma unroll
            for (int b = 0; b < 2; ++b)
#pragma unroll
                for (int m = 0; m < 4; ++m)
#pragma unroll
                    for (int n = 0; n < 2; ++n) acc[a][b][m][n] = (f32x4){0.f, 0.f, 0.f, 0.f};
        cur = nxt; cA = nA; cB = nB; ++ui;
        if constexpr (ALIGN_EPI) { if (wr == 1) PG8_BAR; }
    }
    PG8_WAIT_V(0);
    if constexpr (!ALIGN_EPI) { if (wr == 0) PG8_BAR; }
    PG8_BAR;
    if constexpr (Epi::AFTER_DRAIN) { E.fused(acc, cur, wr, wc, fr, fq, lds, wid, lane); S.done(cur); }
#undef PG8_SA
#undef PG8_SB
#undef PG8_STAGE
#undef PG8_LDA
#undef PG8_LDB
#undef PG8_MMA
#undef PG8_WAIT_V
#undef PG8_WAIT_L
#undef PG8_BAR
#undef PG8_SCHED
}
}
__device__ const float ROPE_COS[1024] = {1.f,1.f,1.f,1.f,1.f,1.f,1.f,1.f,1.f,1.f,1.f,1.f,1.f,1.f,1.f,1.f,0.540302277f,0.846009135f,0.950415254f,0.98423022f,0.995004177f,0.998419285f,0.999500036f,0.999841869f,0.999949992f,0.999984205f,0.999994993f,0.999998391f,0.999999523f,0.999999821f,0.99999994f,1.f,-0.416146845f,0.431462824f,0.806578398f,0.937418282f,0.980066597f,0.993682086f,0.998000681f,0.999367595f,0.999800026f,0.999936759f,0.999979973f,0.999993682f,0.999997973f,0.999999344f,0.999999821f,0.99999994f,-0.989992499f,-0.115966164f,0.582753658f,0.861040652f,0.955336511f,0.985803485f,0.995503366f,0.998577297f,0.999550045f,0.999857724f,0.999954998f,0.999985754f,0.99999553f,0.999998569f,0.999999523f,0.999999881f,-0.653643608f,-0.627679706f,0.301137477f,0.757506192f,0.921060979f,0.974808276f,0.992010653f,0.997471273f,0.999200106f,0.999747038f,0.999920011f,0.999974728f,0.999992013f,0.999997497f,0.999999225f,0.999999762f,0.2836622f,-0.946079254f,-0.0103423381f,0.630080283f,0.87758255f,0.960731268f,0.987526f,0.996049762f,0.998750269f,0.999604762f,0.999875009f,0.999960482f,0.999987483f,0.999996066f,0.999998748f,0.999999583f,0.960170269f,-0.973103702f,-0.3207964f,0.482782036f,0.825335622f,0.943616986f,0.982053936f,0.9943133f,0.998200536f,0.999430835f,0.999819994f,0.999943078f,0.999981999f,0.999994338f,0.999998212f,0.999999404f,0.753902256f,-0.700429797f,-0.599437475f,0.320257008f,0.764842212f,0.923519433f,0.975599885f,0.992262423f,0.997551024f,0.999225318f,0.999755025f,0.999922514f,0.999975502f,0.999992251f,0.999997556f,0.999999225f,-0.145500034f,-0.212036446f,-0.818632424f,0.147631213f,0.696706712f,0.900502324f,0.968170285f,0.989897788f,0.996801734f,0.998988271f,0.999680042f,0.999898791f,0.999967992f,0.999989867f,0.999996781f,0.999998987f,-0.91113025f,0.341660261f,-0.956644177f,-0.0296507962f,0.621609926f,0.874638259f,0.959772646f,0.987220109f,0.995952725f,0.998719573f,0.999595046f,0.99987191f,0.999959528f,0.999987185f,0.999995947f,0.999998748f,-0.839071512f,0.790131867f,-0.999786079f,-0.205997631f,0.540302277f,0.846009135f,0.950415313f,0.98423022f,0.995004177f,0.998419285f,0.999500036f,0.999841869f,0.999949992f,0.999984205f,0.999994993f,0.999998391f,0.00442569796f,0.995257378f,-0.943779767f,-0.375847399f,0.453596085f,0.814705312f,0.940107584f,0.980929136f,0.993956089f,0.998087406f,0.999395072f,0.999808669f,0.999939501f,0.999980867f,0.99999392f,0.999998093f,0.843853951f,0.893861592f,-0.79417938f,-0.53384304f,0.362357706f,0.780825913f,0.92885989f,0.97731787f,0.99280864f,0.997723997f,0.999280095f,0.99977231f,0.999927998f,0.999977231f,0.999992788f,0.999997735f,0.907446802f,0.517172873f,-0.565820515f,-0.675001681f,0.267498761f,0.744477987f,0.916683376f,0.973397553f,0.99156189f,0.997329056f,0.999155104f,0.999732792f,0.999915481f,0.999973297f,0.999991536f,0.999997318f,0.136737213f,-0.0187961515f,-0.28134948f,-0.794870913f,0.16996716f,0.705776393f,0.903590262f,0.969169438f,0.990216017f,0.996902585f,0.999020159f,0.999690115f,0.99990201f,0.999969006f,0.999990225f,0.999996901f,-0.759687901f,-0.548975468f,0.0310223512f,-0.889670432f,0.070737198f,0.6648435f,0.889593601f,0.964634836f,0.988771081f,0.996444523f,0.998875201f,0.999644279f,0.999887526f,0.999964416f,0.999988735f,0.999996424f,-0.957659483f,-0.910081089f,0.340318173f,-0.95641005f,-0.0291995462f,0.621808827f,0.87470746f,0.959795177f,0.987227261f,0.99595499f,0.998720288f,0.999595284f,0.999872029f,0.999959528f,0.999987185f,0.999995947f,-0.275163352f,-0.990897954f,0.615864813f,-0.99298501f,-0.128844544f,0.576808274f,0.858946681f,0.954652011f,0.985584795f,0.995433986f,0.998555362f,0.999543071f,0.999855518f,0.999954283f,0.999985576f,0.99999541f,0.660316706f,-0.766536534f,0.830336154f,-0.998241663f,-0.227202162f,0.529984176f,0.842327058f,0.949207008f,0.983843684f,0.994881511f,0.998380423f,0.999487758f,0.999837995f,0.9999488f,0.999983788f,0.999994874f,0.988704622f,-0.306095392f,0.962463796f,-0.972014248f,-0.323289543f,0.481484592f,0.824865162f,0.943461835f,0.982004225f,0.994297504f,0.998195529f,0.999429286f,0.999819517f,0.999942899f,0.99998194f,0.999994278f,0.408082068f,0.248616725f,0.999144375f,-0.91512996f,-0.416146845f,0.431462824f,0.806578457f,0.937418282f,0.980066597f,0.993682086f,0.998000681f,0.999367595f,0.999800026f,0.999936759f,0.999979973f,0.999993682f,-0.547729254f,0.726760268f,0.936740458f,-0.829382956f,-0.504846215f,0.380077004f,0.787485182f,0.931078374f,0.97803092f,0.993035257f,0.99779582f,0.999302804f,0.999779522f,0.999930263f,0.999977946f,0.999993026f,-0.99996084f,0.981074572f,0.781440377f,-0.717477441f,-0.588501155f,0.327489585f,0.767604589f,0.92444396f,0.975897431f,0.992357016f,0.997581005f,0.999234855f,0.999758005f,0.999923468f,0.999975801f,0.999992371f,-0.53283304f,0.933235765f,0.548645258f,-0.582943261f,-0.666275978f,0.273866832f,0.746956408f,0.917517304f,0.97366637f,0.991647422f,0.997356176f,0.999163687f,0.999735534f,0.999916375f,0.999973536f,0.999991655f,0.424179018f,0.597977161f,0.261441678f,-0.430023283f,-0.737393796f,0.219378278f,0.725561321f,0.910300434f,0.971337974f,0.990906477f,0.997121394f,0.99908942f,0.99971199f,0.999908924f,0.999971211f,0.99999088f,0.991202831f,0.078552261f,-0.0516893305f,-0.263540596f,-0.801143587f,0.164196163f,0.703440726f,0.902795732f,0.968912423f,0.99013412f,0.996876657f,0.999011934f,0.999687493f,0.999901175f,0.999968767f,0.999990106f,0.64691931f,-0.465064496f,-0.359694332f,-0.0887455046f,-0.856888831f,0.108494945f,0.680616796f,0.895005584f,0.966389954f,0.98933053f,0.996621907f,0.998931348f,0.999662042f,0.999893129f,0.999966204f,0.999989331f,-0.292138815f,-0.865450621f,-0.632028639f,0.088848114f,-0.904072165f,0.0524506159f,0.6571123f,0.886932373f,0.963770926f,0.988495648f,0.996357203f,0.998847544f,0.999635518f,0.999884725f,0.999963522f,0.999988496f,-0.962605894f,-0.999293387f,-0.841684937f,0.26363951f,-0.942222297f,-0.00375941908f,0.632950664f,0.878578722f,0.961055458f,0.987629473f,0.996082544f,0.998760641f,0.99960804f,0.999876022f,0.99996078f,0.999987602f,-0.748057544f,-0.825371623f,-0.967871487f,0.430115849f,-0.970958173f,-0.0599575676f,0.608156204f,0.869947195f,0.958243906f,0.986732066f,0.995797932f,0.998670578f,0.999579549f,0.999867022f,0.999957979f,0.999986708f,0.154251456f,-0.397251874f,-0.998075247f,0.583026946f,-0.989992499f,-0.115966164f,0.582753658f,0.861040652f,0.955336511f,0.985803485f,0.995503366f,0.998577297f,0.999550045f,0.999857724f,0.999954998f,0.999985754f,0.914742351f,0.153215483f,-0.929300308f,0.717549205f,-0.999135137f,-0.171608135f,0.556768358f,0.851861775f,0.95233357f,0.984843671f,0.995198846f,0.998480916f,0.999519527f,0.999848068f,0.999951959f,0.999984801f,0.83422339f,0.656495154f,-0.768367112f,0.829440355f,-0.998294771f,-0.226707578f,0.53022635f,0.842413545f,0.949235439f,0.983852804f,0.994884372f,0.998381376f,0.999488056f,0.999838114f,0.9999488f,0.999983788f,-0.0132767474f,0.95758605f,-0.531235278f,0.915171385f,-0.987479806f,-0.281090319f,0.503154159f,0.832698941f,0.946042359f,0.982830763f,0.994559944f,0.998278618f,0.999455571f,0.999827802f,0.999945521f,0.999982774f,-0.848570287f,0.963757515f,-0.241421118f,0.972038329f,-0.966798186f,-0.334584385f,0.475578904f,0.822721004f,0.942754686f,0.981777668f,0.994225562f,0.99817276f,0.999422073f,0.999817252f,0.999942183f,0.999981701f,-0.903692186f,0.673110247f,0.0723346695f,0.998247743f,-0.93645668f,-0.387020677f,0.447528064f,0.812482953f,0.939372718f,0.980693519f,0.993881226f,0.998063743f,0.999387562f,0.999806345f,0.999938726f,0.999980628f,-0.127963692f,0.175156534f,0.378916174f,0.992972851f,-0.896758378f,-0.438233554f,0.419029742f,0.801987886f,0.935896814f,0.979578316f,0.993526995f,0.997951567f,0.999352098f,0.999795079f,0.99993521f,0.999979496f,0.765414059f,-0.376742303f,0.647921681f,0.95638001f,-0.848100007f,-0.488060862f,0.39011243f,0.791239262f,0.93232733f,0.978432178f,0.993162811f,0.997836173f,0.99931556f,0.999783576f,0.999931574f,0.999978364f,0.955073655f,-0.812611222f,0.852673113f,0.889623463f,-0.790967762f,-0.536345184f,0.360805035f,0.780240417f,0.928664625f,0.977255106f,0.992788672f,0.997717679f,0.999278069f,0.999771714f,0.999927819f,0.999977171f,0.266642928f,-0.998210371f,0.972865343f,0.794808388f,-0.72593224f,-0.582933903f,0.331136853f,0.768994927f,0.924909055f,0.976047099f,0.99240464f,0.997596025f,0.999239624f,0.999759495f,0.999923944f,0.999975979f,-0.666938066f,-0.87637943f,0.996578991f,0.674925625f,-0.653643608f,-0.627679706f,0.301137596f,0.757506192f,0.921060979f,0.974808276f,0.992010653f,0.997471273f,0.999200106f,0.999747038f,0.999920011f,0.999974728f,-0.987339258f,-0.484639406f,0.921462357f,0.533756077f,-0.574824035f,-0.670441091f,0.270837069f,0.745777905f,0.917120814f,0.973538578f,0.991606772f,0.997343302f,0.999159634f,0.999734223f,0.999915957f,0.999973416f,-0.399985313f,0.0563609414f,0.754965365f,0.375752151f,-0.490260571f,-0.711082935f,0.240265876f,0.733813822f,0.913088918f,0.972238123f,0.991192937f,0.997212172f,0.999118149f,0.99972111f,0.999911785f,0.999972105f,0.555113316f,0.580003142f,0.513598442f,0.205897167f,-0.400799006f,-0.749476731f,0.209454417f,0.721617639f,0.908965766f,0.970906913f,0.990769207f,0.997077882f,0.999075651f,0.999707639f,0.999907553f,0.999970794f,0.999843299f,0.925014675f,0.221298173f,0.0295478199f,-0.307332784f,-0.785501122f,0.178433523f,0.709193349f,0.904751658f,0.969545007f,0.990335584f,0.996940494f,0.99903214f,0.99969393f,0.999903202f,0.999969363f,0.52532196f,0.985138178f,-0.0929481089f,-0.147732988f,-0.210795805f,-0.819042206f,0.147234216f,0.696544766f,0.90044713f,0.968152404f,0.989892066f,0.996799886f,0.998987675f,0.999679863f,0.999898732f,0.999967992f,-0.432177931f,0.741858006f,-0.397976756f,-0.320354372f,-0.112152621f,-0.849993885f,0.115887694f,0.683675885f,0.89605248f,0.966729224f,0.989438653f,0.996656179f,0.998942196f,0.999665439f,0.999894202f,0.999966562f,-0.992335498f,0.270098448f,-0.663538277f,-0.48287195f,-0.0123883775f,-0.878258407f,0.0844252855f,0.670590878f,0.891568303f,0.965275466f,0.988975346f,0.996509314f,0.998895705f,0.999650776f,0.999889553f,0.999965072f,-0.640144348f,-0.284846604f,-0.863296509f,-0.630159974f,0.0874991715f,-0.903746367f,0.0528784581f,0.657293737f,0.886994898f,0.963791192f,0.988502085f,0.996359289f,0.9988482f,0.999635756f,0.999884784f,0.999963582f,0.300592542f,-0.75206399f,-0.977442741f,-0.757573068f,0.18651247f,-0.926377118f,0.0212787576f,0.643788815f,0.882332861f,0.962276459f,0.98801899f,0.996206105f,0.998799741f,0.999620378f,0.999879956f,0.999962032f,0.964965999f,-0.987659097f,-0.994656444f,-0.861092687f,0.2836622f,-0.946079254f,-0.0103422189f,0.630080283f,0.87758255f,0.960731268f,0.987526f,0.996049762f,0.998750269f,0.999604762f,0.999875009f,0.999960482f,0.742154181f,-0.919073522f,-0.913230121f,-0.937454224f,0.377977669f,-0.96279037f,-0.0419528559f,0.616172493f,0.872744501f,0.959155679f,0.987023175f,0.99589026f,0.998699784f,0.999588788f,0.999869943f,0.999958873f,-0.162990779f,-0.567430019f,-0.741239965f,-0.984248459f,0.468516916f,-0.976457715f,-0.0735215396f,0.602069914f,0.86781919f,0.95754981f,0.986510456f,0.995727658f,0.998648286f,0.999572515f,0.999864817f,0.999957263f,-0.918282807f,-0.0410281904f,-0.495741814f,-1.f,0.554374516f,-0.987038016f,-0.105016708f,0.587776959f,0.862807095f,0.955913603f,0.985987842f,0.995561838f,0.998595834f,0.999555886f,0.999859571f,0.999955595f,-0.829309821f,0.498009592f,-0.201079622f,-0.984212041f,0.634692967f,-0.994497895f,-0.136406869f,0.573298037f,0.857708693f,0.954247177f,0.985455394f,0.995392919f,0.998542368f,0.999538958f,0.999854207f,0.999953866f,0.0221267566f,0.883669317f,0.113521777f,-0.937382519f,0.708669782f,-0.998813629f,-0.167660639f,0.558637917f,0.852524519f,0.95255059f,0.984913111f,0.99522084f,0.99848789f,0.999521732f,0.999848783f,0.999952197f,0.853220105f,0.997174621f,0.416867077f,-0.860988438f,0.775565803f,-0.999971747f,-0.198746875f,0.543801069f,0.847255111f,0.950823903f,0.984360933f,0.995045662f,0.998432398f,0.999504209f,0.99984318f,0.999950409f,0.899866819f,0.803569078f,0.678870201f,-0.757439196f,0.834712923f,-0.997968495f,-0.22963427f,0.528792322f,0.841901004f,0.949067116f,0.983798921f,0.994867265f,0.998375952f,0.999486327f,0.999837577f,0.999948621f,0.119180135f,0.362476677f,0.873550534f,-0.63000071f,0.885519624f,-0.99281019f,-0.260292053f,0.513616323f,0.836462677f,0.947280347f,0.983227074f,0.994685769f,0.998318493f,0.999468148f,0.999831796f,0.999946833f,-0.771080196f,-0.1902491f,0.981602073f,-0.482692331f,0.927478492f,-0.984513164f,-0.290689558f,0.498277903f,0.830940723f,0.945463598f,0.982645452f,0.994501114f,0.998260021f,0.99944967f,0.999825954f,0.999944985f,-0.952412963f,-0.684381902f,0.992308319f,-0.320159167f,0.960170269f,-0.973103702f,-0.3207964f,0.482782036f,0.825335622f,0.943616986f,0.982053936f,0.9943133f,0.998200536f,0.999430835f,0.999819994f,0.999943078f,-0.258101642f,-0.967739642f,0.904607594f,-0.1475292f,0.98326844f,-0.958617806f,-0.350582451f,0.467133403f,0.819648027f,0.941740453f,0.981452644f,0.994122326f,0.998140097f,0.999411702f,0.999813974f,0.99994117f,0.673507154f,-0.953050017f,0.727198064f,0.0297537707f,0.996542096f,-0.941101313f,-0.380017966f,0.451337039f,0.813878477f,0.939834237f,0.980841517f,0.993928254f,0.998078644f,0.999392271f,0.999807835f,0.999939203f,0.985896587f,-0.644837022f,0.477671444f,0.206098333f,0.999858618f,-0.920609534f,-0.409073502f,0.435397953f,0.808027506f,0.937898219f,0.980220556f,0.993731022f,0.998016179f,0.999372482f,0.999801576f,0.999937236f};
__device__ const float ROPE_SIN[1024] = {0.f,0.f,0.f,0.f,0.f,0.f,0.f,0.f,0.f,0.f,0.f,0.f,0.f,0.f,0.f,0.f,0.841470957f,0.533168435f,0.310983598f,0.176892191f,0.0998334214f,0.0562044978f,0.0316175036f,0.0177818574f,0.00999983307f,0.00562338345f,0.00316227227f,0.0017782785f,0.000999999931f,0.000562341243f,0.000316227757f,0.00017782794f,0.909297407f,0.902130723f,0.591127098f,0.348205268f,0.198669329f,0.112231314f,0.0632033944f,0.0355580896f,0.0199986659f,0.011246589f,0.00632451288f,0.00355655141f,0.0019999987f,0.00112468237f,0.000632455456f,0.00035565588f,0.141120002f,0.993253171f,0.812648892f,0.5085361f,0.295520216f,0.167903304f,0.0947260857f,0.0533230826f,0.0299954992f,0.0168694388f,0.00948669016f,0.00533481315f,0.0029999956f,0.00168702309f,0.000948683126f,0.000533483806f,-0.756802499f,0.778471708f,0.953580737f,0.652827978f,0.389418334f,0.223044485f,0.126154065f,0.0710712075f,0.0399893336f,0.0224917568f,0.0126487734f,0.00711305765f,0.00399998948f,0.00224936334f,0.00126491068f,0.000711311703f,-0.958924294f,0.32393527f,0.999946535f,0.776529968f,0.47942555f,0.277480543f,0.157455876f,0.0887968615f,0.0499791652f,0.0281133614f,0.0158107281f,0.00889127981f,0.0049999794f,0.0028117029f,0.00158113812f,0.000889139599f,-0.279415488f,-0.230367512f,0.947148204f,0.875740528f,0.564642489f,0.33103931f,0.188600272f,0.106494442f,0.0599640049f,0.0337340795f,0.0189725272f,0.0106694745f,0.0059999642f,0.00337404152f,0.00189736532f,0.00106696738f,0.656986594f,-0.713721275f,0.800421596f,0.947330713f,0.64421767f,0.383551568f,0.219556093f,0.124158338f,0.0699428469f,0.0393537246f,0.0221341345f,0.0124476347f,0.00699994294f,0.00393637875f,0.00221359241f,0.00124479528f,0.989358246f,-0.977261782f,0.574317753f,0.989042461f,0.717356086f,0.434851229f,0.250292331f,0.141782969f,0.0799146891f,0.0449721329f,0.0252955221f,0.0142257558f,0.0079999147f,0.00449871505f,0.00252981926f,0.00142262306f,0.412118495f,-0.939823508f,0.291259229f,0.999560297f,0.783326924f,0.484776139f,0.280778319f,0.159362778f,0.0898785442f,0.0505891182f,0.0284566563f,0.0160038304f,0.00899987947f,0.00506105041f,0.00284604589f,0.00160045072f,-0.54402113f,-0.612936914f,-0.0206835698f,0.978552461f,0.841470957f,0.533168435f,0.310983568f,0.176892191f,0.099833414f,0.0562044978f,0.0316175036f,0.0177818574f,0.009999834f,0.00562338345f,0.00316227227f,0.0017782785f,-0.999990225f,-0.0972764567f,-0.33057496f,0.926681578f,0.891207397f,0.579875171f,0.340877861f,0.19436565f,0.1097783f,0.0618181042f,0.0347780399f,0.0195598267f,0.0109997792f,0.00618571462f,0.00347849843f,0.00195610616f,-0.536572933f,0.448342979f,-0.60768342f,0.845583618f,0.932039082f,0.624748647f,0.370431304f,0.211777672f,0.119712204f,0.0674297586f,0.0379382223f,0.0213377345f,0.0119997123f,0.0067480444f,0.00379472389f,0.00213393359f,0.420167029f,0.855880976f,-0.824528456f,0.737816215f,0.963558197f,0.667647004f,0.399614304f,0.229122713f,0.129634142f,0.0730392784f,0.0410980321f,0.0231155735f,0.0129996343f,0.00731037185f,0.00411094911f,0.00231176103f,0.990607381f,0.999823332f,-0.959605396f,0.606778562f,0.985449731f,0.708434701f,0.428397775f,0.246395305f,0.139543116f,0.078646481f,0.0442574248f,0.0248933397f,0.0139995432f,0.00787269697f,0.00442717411f,0.00248958869f,0.650287867f,0.835838437f,-0.999518692f,0.456603259f,0.997494996f,0.746982634f,0.456752867f,0.263589978f,0.149438128f,0.0842512026f,0.0474163815f,0.0266710296f,0.0149994381f,0.00843502022f,0.00474339863f,0.00266741589f,-0.287903309f,0.414430231f,-0.940310359f,0.292027086f,0.999573588f,0.783169091f,0.484651238f,0.280701309f,0.159318209f,0.0898532644f,0.0505748577f,0.028448632f,0.015999319f,0.00899733976f,0.00505962269f,0.00284524332f,-0.961397469f,-0.134615138f,-0.78785187f,0.11824052f,0.991664827f,0.81687957f,0.512064993f,0.29772386f,0.169182345f,0.09545248f,0.0537328273f,0.0302261449f,0.0169991814f,0.00955965649f,0.00537584582f,0.00302307028f,-0.750987232f,-0.642200708f,-0.557262897f,-0.0592755191f,0.973847628f,0.84800756f,0.538966715f,0.314652264f,0.179029569f,0.101048686f,0.0568902642f,0.0320035629f,0.0179990288f,0.0101219704f,0.00569206895f,0.00320089748f,0.149877205f,-0.952000856f,-0.271410108f,-0.234921798f,0.946300089f,0.876454532f,0.565329552f,0.331481189f,0.188858896f,0.10664168f,0.060047131f,0.0337808803f,0.0189988576f,0.0106842816f,0.00600829115f,0.00337872445f,0.912945271f,-0.968601942f,0.0413582884f,-0.403158993f,0.909297407f,0.902130723f,0.591127038f,0.348205268f,0.198669314f,0.112231314f,0.0632033944f,0.0355580896f,0.0199986678f,0.011246589f,0.00632451288f,0.00355655141f,0.836655617f,-0.686891198f,0.35002476f,-0.558680534f,0.863209307f,0.924954832f,0.616333544f,0.364819258f,0.208459899f,0.117817394f,0.0663590282f,0.0373351872f,0.0209984574f,0.0118088927f,0.00664073415f,0.00373437814f,-0.00885130931f,-0.193630233f,0.623979926f,-0.696581721f,0.808496356f,0.944854796f,0.640923738f,0.381317884f,0.218229622f,0.123399742f,0.0695140064f,0.0391121693f,0.0219982266f,0.0123711927f,0.00695695449f,0.00391220488f,-0.846220434f,0.359264523f,0.836055279f,-0.812512875f,0.745705247f,0.961767614f,0.664873064f,0.397695929f,0.227977514f,0.128978193f,0.0726682767f,0.0408890247f,0.0229979735f,0.0129334899f,0.00727317436f,0.00409003161f,-0.905578375f,0.801513135f,0.965219259f,-0.902817786f,0.67546314f,0.97563988f,0.688157499f,0.413948208f,0.237702623f,0.134552568f,0.0758218244f,0.0426657498f,0.0239976961f,0.0134957815f,0.0075893933f,0.00426785741f,-0.132351756f,0.996909976f,0.998663187f,-0.964648306f,0.598472118f,0.986427724f,0.710753918f,0.430069596f,0.247403964f,0.140122697f,0.0789746121f,0.0444423407f,0.0249973964f,0.0140580693f,0.00790561177f,0.00444568414f,0.76255846f,0.885276794f,0.933070183f,-0.996054351f,0.515501261f,0.994096994f,0.732639611f,0.446054995f,0.257080555f,0.145688385f,0.0821266174f,0.0462187938f,0.0259970706f,0.0146203535f,0.00822182931f,0.00462350994f,0.956375957f,0.500994205f,0.774945021f,-0.996045172f,0.427379847f,0.99862349f,0.753792703f,0.46189931f,0.266731411f,0.151249468f,0.0852777958f,0.0479951017f,0.0269967206f,0.015182632f,0.00853804592f,0.00480133574f,0.270905793f,-0.0375856608f,0.539968967f,-0.964621305f,0.334988207f,0.999992907f,0.774192095f,0.477597594f,0.276355654f,0.156805754f,0.0884281173f,0.049771253f,0.0279963426f,0.0157449059f,0.0088542616f,0.00497916201f,-0.663633883f,-0.564589798f,0.251445323f,-0.902773678f,0.239249229f,0.998200953f,0.793817401f,0.49314484f,0.28595221f,0.162357092f,0.0915775672f,0.0515472479f,0.0289959367f,0.0163071752f,0.00917047635f,0.00515698735f,-0.988031626f,-0.917709649f,-0.0620148405f,-0.812452853f,0.141120002f,0.993253171f,0.812648892f,0.5085361f,0.295520186f,0.167903304f,0.0947260931f,0.0533230826f,0.029995501f,0.0168694388f,0.00948669016f,0.00533481315f,-0.404037654f,-0.988192797f,-0.369325012f,-0.696507812f,0.0415805206f,0.985165298f,0.830667794f,0.523766637f,0.305058628f,0.173444211f,0.0978736654f,0.055098746f,0.0309950355f,0.0174316969f,0.00980290305f,0.00551263802f,0.551426709f,-0.754330218f,-0.640009403f,-0.5585953f,-0.0583741926f,0.973962843f,0.847856104f,0.538831532f,0.314566553f,0.17897962f,0.101020269f,0.0568742342f,0.0319945402f,0.0179939512f,0.0101191159f,0.00569046335f,0.999911845f,-0.28814739f,-0.847224355f,-0.403064936f,-0.157745644f,0.959681332f,0.864196658f,0.553726017f,0.324043006f,0.184509367f,0.10416586f,0.0586495437f,0.0329940096f,0.0185561981f,0.010435327f,0.00586828869f,0.529082716f,0.266779721f,-0.97042042f,-0.234822124f,-0.255541205f,0.942365825f,0.879673064f,0.568445385f,0.333487093f,0.190033287f,0.107310407f,0.0604246669f,0.0339934528f,0.0191184394f,0.010751537f,0.00604611309f,-0.428182662f,0.739542127f,-0.997380435f,-0.0591726787f,-0.350783229f,0.92207104f,0.894269884f,0.582984984f,0.342897803f,0.195551202f,0.110453881f,0.0621996038f,0.034992855f,0.0196806751f,0.0110677453f,0.00622393796f,-0.991778851f,0.984540582f,-0.925431013f,0.118342586f,-0.442520559f,0.89886117f,0.907972515f,0.597340286f,0.352274209f,0.201062918f,0.113596253f,0.0639743358f,0.0359922275f,0.0202429052f,0.0113839535f,0.0064017619f,-0.643538117f,0.926318109f,-0.761706948f,0.292125374f,-0.529836178f,0.872809589f,0.920767248f,0.611506701f,0.361615449f,0.206568271f,0.116737492f,0.0657488778f,0.036991559f,0.0208051261f,0.0117001599f,0.0065795863f,0.296368569f,0.58280617f,-0.522444785f,0.456694692f,-0.611857831f,0.84399873f,0.932641268f,0.625479698f,0.370920479f,0.212067112f,0.119877554f,0.0675232038f,0.0379908569f,0.0213673431f,0.0120163653f,0.00675741071f,0.963795364f,0.0598003156f,-0.231372014f,0.606860459f,-0.687766254f,0.81251961f,0.943582714f,0.639254928f,0.380188406f,0.217559248f,0.123016424f,0.0692973137f,0.0389901139f,0.0219295528f,0.0123325698f,0.00693523418f,0.745113134f,-0.481621295f,0.0826458037f,0.737885714f,-0.756802499f,0.778471708f,0.953580678f,0.652827978f,0.389418334f,0.223044485f,0.126154065f,0.0710712075f,0.0399893373f,0.0224917568f,0.0126487734f,0.00711305765f,-0.158622667f,-0.874714017f,0.388467699f,0.845638454f,-0.818277061f,0.74196279f,0.962625206f,0.666194677f,0.39860931f,0.228522688f,0.129290432f,0.0728448778f,0.0409885161f,0.0230539497f,0.0129649751f,0.00729088066f,-0.916521549f,-0.998410463f,0.655764699f,0.926720202f,-0.871575892f,0.703108132f,0.970707119f,0.679350674f,0.407760441f,0.233993664f,0.132425532f,0.0746183172f,0.0419876575f,0.0236161388f,0.0132811759f,0.00746870413f,-0.831774771f,-0.814614236f,0.858030677f,0.97857362f,-0.916166008f,0.662030637f,0.977818429f,0.692291796f,0.416870773f,0.23945722f,0.135559291f,0.0763915181f,0.0429867506f,0.0241783205f,0.0135973748f,0.00764652714f,0.0177019257f,-0.37993139f,0.975206196f,0.999563396f,-0.951602101f,0.618860185f,0.983951986f,0.70501405f,0.425939471f,0.244913206f,0.138691694f,0.0781644881f,0.0439858064f,0.0247404929f,0.0139135728f,0.00782434922f,0.850903511f,0.171763569f,0.995670974f,0.989027262f,-0.977530122f,0.57373327f,0.989101648f,0.717513323f,0.434965521f,0.250361472f,0.141822711f,0.0799371973f,0.0449848175f,0.0253026579f,0.0142297689f,0.00800217129f,0.901788354f,0.670557022f,0.917395473f,0.947297752f,-0.993690968f,0.526792526f,0.993262351f,0.72978574f,0.44394809f,0.255801797f,0.144952312f,0.0817096606f,0.0459837839f,0.0258648153f,0.0145459641f,0.0081799943f,0.123573124f,0.962832689f,0.748142362f,0.875690997f,-0.999923289f,0.478186339f,0.996429801f,0.741827428f,0.452886283f,0.261234075f,0.148080453f,0.0834818557f,0.0469827019f,0.0264269635f,0.0148621574f,0.00835781638f,-0.768254638f,0.958573103f,0.504697084f,0.776465356f,-0.99616462f,0.428068399f,0.99860096f,0.753634512f,0.461779177f,0.266658038f,0.151207119f,0.0852537975f,0.0479815714f,0.0269891042f,0.0151783489f,0.00853563752f,-0.953752637f,0.659090102f,0.211200655f,0.652750373f,-0.982452571f,0.376597136f,0.999773562f,0.765203178f,0.470625877f,0.272073567f,0.15433228f,0.087025471f,0.0489803962f,0.0275512375f,0.0154945394f,0.0087134596f,-0.262374848f,0.156619072f,-0.10324046f,0.508447945f,-0.958924294f,0.32393527f,0.999946535f,0.776529968f,0.47942555f,0.277480543f,0.157455891f,0.0887968615f,0.0499791689f,0.0281133596f,0.0158107281f,0.00889127981f,0.670229197f,-0.394086063f,-0.407444149f,0.3481085f,-0.925814748f,0.270249337f,0.99911958f,0.787611187f,0.48817724f,0.282878697f,0.160577938f,0.0905679762f,0.0509778969f,0.0286754742f,0.0161269177f,0.00906910095f,0.986627579f,-0.823421597f,-0.671240151f,0.176790684f,-0.883454502f,0.215709001f,0.997293651f,0.798443377f,0.496880114f,0.28826794f,0.163698375f,0.0923388004f,0.051976569f,0.0292375814f,0.0164431017f,0.00924692024f,0.395925164f,-0.999157965f,-0.868469954f,-0.000103020677f,-0.832267344f,0.160486728f,0.994470477f,0.809023023f,0.505533338f,0.293648034f,0.166817173f,0.0941093415f,0.0529751927f,0.0297996756f,0.0167592876f,0.00942474138f,-0.558789074f,-0.867171526f,-0.979574919f,-0.176993474f,-0.772764444f,0.104756832f,0.990652919f,0.819346905f,0.514135957f,0.29901889f,0.169934288f,0.0958795771f,0.0539737605f,0.0303617641f,0.0170754679f,0.00960256159f,-0.999755144f,-0.468111664f,-0.993535519f,-0.348301649f,-0.705540299f,0.0486960001f,0.985844791f,0.829411685f,0.522687256f,0.304380238f,0.173049718f,0.0976495072f,0.0549722798f,0.0309238415f,0.01739165f,0.00978038087f,-0.521551013f,0.0751182064f,-0.908967435f,-0.508624554f,-0.631266713f,-0.00751878507f,0.980050862f,0.839214146f,0.531186223f,0.30973196f,0.17616342f,0.0994191393f,0.0559707358f,0.0314859077f,0.0177078284f,0.00995820016f,0.436164767f,0.595211506f,-0.734258294f,-0.652905703f,-0.550685287f,-0.0637097955f,0.973276973f,0.848751247f,0.539632022f,0.315073937f,0.179275364f,0.101188451f,0.0569691435f,0.0320479684f,0.0180240069f,0.0101360194f,0.992872655f,0.931992829f,-0.486733496f,-0.776594579f,-0.464602023f,-0.119699396f,0.965529919f,0.858020008f,0.548023939f,0.3204059f,0.182385504f,0.102957435f,0.0579674877f,0.0326100141f,0.0183401816f,0.0103138378f,0.636738002f,0.981735826f,-0.190938011f,-0.87579f,-0.373876572f,-0.175310582f,0.956817448f,0.867017388f,0.55636102f,0.325727791f,0.185493827f,0.104726106f,0.0589657798f,0.0331720486f,0.0186563563f,0.0104916561f,-0.304810613f,0.729123712f,0.12379095f,-0.947363734f,-0.279415488f,-0.230367512f,0.947148204f,0.875740528f,0.564642429f,0.33103931f,0.188600287f,0.106494442f,0.0599640086f,0.0337340795f,0.0189725272f,0.0106694745f,-0.966117799f,0.251952261f,0.426245421f,-0.98905772f,-0.182162598f,-0.284696162f,0.936531842f,0.884186864f,0.572867453f,0.336340427f,0.191704854f,0.108262435f,0.0609621815f,0.0342960916f,0.0192886982f,0.0108472919f,-0.739180684f,-0.302812874f,0.686427653f,-0.999557257f,-0.0830891207f,-0.338124752f,0.924979091f,0.892353535f,0.581035137f,0.341630876f,0.194807529f,0.110030092f,0.0619602874f,0.0348580964f,0.0196048655f,0.0110251084f,0.167355701f,-0.764320076f,0.878538549f,-0.978531301f,0.0168140903f,-0.390484393f,0.912501454f,0.900238097f,0.589144766f,0.346910536f,0.197908238f,0.111797392f,0.0629583374f,0.0354200937f,0.0199210308f,0.0112029258f};
#define LAS __attribute__((address_space(3)))
#define XB_TMO      128
#define XB_XCNT(j)  (256  + 64 * (j))
#define XB_XSUB(j)  (1280 + 64 * (j))
#define XB_XGEN(j)  (2304 + 64 * (j))
#define XB_TOP      3328
#define XB_TOPGEN   3392
#define XCD_BAR_WORDS 3456
#define XB_SPIN_CAP (1u << 18)

__device__ __forceinline__ unsigned xb_ld(unsigned* p)              { return __hip_atomic_load(p, __ATOMIC_RELAXED, __HIP_MEMORY_SCOPE_AGENT); }
__device__ __forceinline__ unsigned xb_add(unsigned* p, unsigned v) { return __hip_atomic_fetch_add(p, v, __ATOMIC_RELAXED, __HIP_MEMORY_SCOPE_AGENT); }
__device__ __forceinline__ unsigned xb_xcc_id() { return (unsigned)__builtin_amdgcn_s_getreg((3 << 11) | 20) & 0xFu; }
#define XB_SPIN(cond, bar) do { unsigned _sp = 0; while (cond) { __builtin_amdgcn_s_sleep(1); \
    if ((++_sp & 255u) == 0u) { if (xb_ld(&(bar)[XB_TMO])) break; if (_sp > XB_SPIN_CAP) { atomicAdd(&(bar)[XB_TMO], 1u); break; } } } } while (0)

struct XcdBarrier {
    unsigned* bar; unsigned x;
    volatile LAS unsigned* st;
};

__device__ __forceinline__ XcdBarrier xcd_barrier_post(unsigned* bar, volatile LAS unsigned* st) {
    XcdBarrier b; b.bar = bar; b.x = xb_xcc_id(); b.st = st;
    if (threadIdx.x == 0) (void)xb_add(&bar[XB_XCNT(b.x)], 1u);
    return b;
}
__device__ __forceinline__ void xcd_barrier_complete(unsigned* bar, unsigned x, unsigned& nloc, unsigned& nx) {
    const unsigned G = gridDim.x * gridDim.y * gridDim.z;
    unsigned sum, cnt, mine, sp = 0u;
    for (;;) {
        sum = 0u; cnt = 0u; mine = 0u;
#pragma unroll
        for (unsigned j = 0; j < 16; ++j) { const unsigned c = xb_ld(&bar[XB_XCNT(j)]); sum += c; cnt += (c > 0u) ? 1u : 0u; mine = (j == x) ? c : mine; }
        if (sum == G) break;
        __builtin_amdgcn_s_sleep(1);
        if ((++sp & 255u) == 0u) { if (xb_ld(&bar[XB_TMO])) break; if (sp > XB_SPIN_CAP) { atomicAdd(&bar[XB_TMO], 1u); break; } }
    }
    nloc = mine > 0u ? mine : 1u; nx = cnt > 0u ? cnt : 1u;
}

__device__ __forceinline__ void xcd_barrier(const XcdBarrier& b) {
    asm volatile("s_waitcnt vmcnt(0)" ::: "memory");
    __syncthreads();
    if (threadIdx.x == 0) {
        unsigned* bar = b.bar;
        __builtin_amdgcn_s_waitcnt(0);
        unsigned nloc = b.st[0], nx = b.st[1];
        if (nloc == 0u) { xcd_barrier_complete(bar, b.x, nloc, nx); b.st[0] = nloc; b.st[1] = nx; }
        const unsigned old = xb_add(&bar[XB_XSUB(b.x)], 1u);
        const unsigned gen = old / nloc;
        if (old + 1u == (gen + 1u) * nloc) {
            __builtin_amdgcn_fence(__ATOMIC_RELEASE, "agent");
            asm volatile("s_waitcnt vmcnt(0)" ::: "memory");
            const unsigned og = xb_add(&bar[XB_TOP], 1u);
            const unsigned tg = og / nx;
            if (og + 1u == (tg + 1u) * nx) xb_add(&bar[XB_TOPGEN], 1u);
            else XB_SPIN(xb_ld(&bar[XB_TOPGEN]) == tg, bar);
            __builtin_amdgcn_fence(__ATOMIC_ACQUIRE, "agent");
            xb_add(&bar[XB_XGEN(b.x)], 1u);
            asm volatile("s_waitcnt vmcnt(0)" ::: "memory");
        } else {
            XB_SPIN(xb_ld(&bar[XB_XGEN(b.x)]) == gen, bar);
            __builtin_amdgcn_fence(__ATOMIC_ACQUIRE, "agent");
            asm volatile("s_waitcnt vmcnt(0)" ::: "memory");
        }
    }
    __syncthreads();
}

#define DI __device__ __forceinline__
#define LAS __attribute__((address_space(3)))
typedef unsigned short bf16;
typedef short bf16x8 __attribute__((ext_vector_type(8)));
typedef float f32x4 __attribute__((ext_vector_type(4)));
typedef unsigned u32x4 __attribute__((ext_vector_type(4)));
typedef unsigned u32x2 __attribute__((ext_vector_type(2)));

#ifndef COOP
#define COOP 1
#endif

constexpr int D = 1024, NBATCH = 4, SEQ = 4096, CTXL = 256, NLAT = NBATCH * SEQ, NCTX = NBATCH * CTXL, MT = NLAT + NCTX;
constexpr int FF = 2816, KEYS = SEQ + CTXL;
constexpr int LDP0 = 2560, LDP1 = 3072;
constexpr int C_AQ = 0, C_AK = 512, C_AV = 640, C_BQ = 768, C_BK = 1024, C_BV = 1280, C_BO = 1792, C_RF = 2304, C_RB = 2320;
constexpr float LOG2E = 1.4426950408889634f, EPS = 1e-6f;
constexpr int NCHUNK = 68;

constexpr size_t MiB = 1u << 20;
constexpr size_t WS_CTL = 0, WS_MOD = 1 * MiB, WS_XC = 2 * MiB, WS_WABI = 6 * MiB, WS_WABO = 11 * MiB, WS_WFI = 13 * MiB, WS_WFO = 35 * MiB, WS_WNI = 46 * MiB, WS_WNO = 52 * MiB;
constexpr size_t WS_HO = 54 * MiB, WS_YF = 88 * MiB, WS_P = 122 * MiB, WS_STC = 224 * MiB, WS_DEC = 228 * MiB, WS_END = 251 * MiB;
constexpr size_t WS_CUM0 = 207 * MiB, WS_CUM1 = 229 * MiB;
constexpr size_t WS_VTA = 246 * MiB;
constexpr size_t WS_PART = 224 * MiB;
constexpr int LDS_BYTES = 147456;
constexpr int NWAVES = 8, NTHR = 512;

DI float bf2f(unsigned short h) { return __uint_as_float(((unsigned)h) << 16); }
typedef float f32x2_t __attribute__((ext_vector_type(2)));
typedef __bf16 bf16x2_t __attribute__((ext_vector_type(2)));
DI unsigned pk2(float lo, float hi) { const f32x2_t v = {lo, hi}; const bf16x2_t b = __builtin_convertvector(v, bf16x2_t); return __builtin_bit_cast(unsigned, b); }
DI float wave_sum(float v) {
#pragma unroll
    for (int o = 1; o < 64; o <<= 1) v += __shfl_xor(v, o);
    return v;
}
DI float fast_exp2(float x) { return __builtin_amdgcn_exp2f(x); }
DI float silu_f(float g) { return g * __builtin_amdgcn_rcpf(1.0f + __expf(-g)); }
DI void unpack8(const bf16x8 v, float (&o)[8]) {
#pragma unroll
    for (int i = 0; i < 8; ++i) o[i] = bf2f((unsigned short)v[i]);
}
DI bf16x8 pack8(const float (&p)[8]) {
    u32x4 w; w.x = pk2(p[0], p[1]); w.y = pk2(p[2], p[3]); w.z = pk2(p[4], p[5]); w.w = pk2(p[6], p[7]);
    return __builtin_bit_cast(bf16x8, w);
}
#define MFMA16(a, b, c) __builtin_amdgcn_mfma_f32_16x16x32_bf16((a), (b), (c), 0, 0, 0)

struct EpiStore {
    static constexpr bool PERM = true, AFTER_DRAIN = false;
    bf16* O; int ldc;
    DI void operator()(const pg8::f32x4 (&acc)[2][2][4][2], const pg8::Unit& u, int wr, int wc, int fr, int fq) const {
        const int row0 = u.pm * 256 + wr * 64 + fr, col0 = u.pn * 256 + wc * 32 + 8 * fq;
#pragma unroll
        for (int ai = 0; ai < 2; ++ai)
#pragma unroll
            for (int m = 0; m < 4; ++m) { bf16* rowp = O + (size_t)(row0 + ai * 128 + m * 16) * ldc + col0;
#pragma unroll
                for (int bj = 0; bj < 2; ++bj) { const pg8::f32x4 v0 = acc[ai][bj][m][0], v1 = acc[ai][bj][m][1];
                    u32x4 w; w.x = pk2(v0[0], v0[1]); w.y = pk2(v0[2], v0[3]); w.z = pk2(v1[0], v1[1]); w.w = pk2(v1[2], v1[3]);
                    *(u32x4*)(rowp + bj * 128) = w; } }
    }
};
struct EpiSwiglu {
    static constexpr bool PERM = true, AFTER_DRAIN = false;
    bf16* O; int ldc;
    DI void operator()(const pg8::f32x4 (&acc)[2][2][4][2], const pg8::Unit& u, int wr, int wc, int fr, int fq) const {
        const int row0 = u.pm * 256 + wr * 64 + fr, col0 = u.pn * 128 + wc * 32 + 8 * fq;
#pragma unroll
        for (int ai = 0; ai < 2; ++ai)
#pragma unroll
            for (int m = 0; m < 4; ++m) { bf16* rowp = O + (size_t)(row0 + ai * 128 + m * 16) * ldc + col0;
                const pg8::f32x4 g0 = acc[ai][0][m][0], g1 = acc[ai][0][m][1], u0 = acc[ai][1][m][0], u1 = acc[ai][1][m][1];
                u32x4 w; w.x = pk2(silu_f(g0[0]) * u0[0], silu_f(g0[1]) * u0[1]); w.y = pk2(silu_f(g0[2]) * u0[2], silu_f(g0[3]) * u0[3]);
                w.z = pk2(silu_f(g1[0]) * u1[0], silu_f(g1[1]) * u1[1]); w.w = pk2(silu_f(g1[2]) * u1[2], silu_f(g1[3]) * u1[3]);
                *(u32x4*)rowp = w; }
    }
};

struct OneUnit {
    int pm, pn; bool has;
    DI bool next(int i, pg8::Unit& u) const { if (i != 0 || !has) return false; u.pm = pm; u.pn = pn; return true; }
    DI void a_ready(const pg8::Unit&) const {}
    DI void done(const pg8::Unit&) const {}
};

struct Args { const float* in[23]; float* out; unsigned char* ws; int ph_lo, ph_hi; };
enum { I_X = 0, I_C, I_CTX, I_CCTX, I_WMOD, I_BMOD, I_GMPRE, I_GMPOST, I_GFPRE, I_GFPOST, I_WFI, I_WFO, I_ABWI, I_ABWO, I_SINK, I_GFW, I_GFB, I_GBW, I_GBB, I_GNORM, I_NAWI, I_NAWO, I_RELB };

DI void transpose_item(const float* W, int K, int N, bf16* WT, int k0, int n0, int drow0, LAS float* scr, int lane) {
#pragma unroll 8
    for (int i = 0; i < 32; ++i) { const int kk = 2 * i + (lane >> 5); scr[kk * 33 + (lane & 31)] = W[(size_t)(k0 + kk) * N + n0 + (lane & 31)]; }
    asm volatile("s_waitcnt lgkmcnt(0)" ::: "memory");
    const int c = lane & 7;
#pragma unroll
    for (int j = 0; j < 4; ++j) { const int n = (lane >> 3) + 8 * j; const LAS float* s = scr + (8 * c) * 33 + n;
        u32x4 o; o.x = pk2(s[0 * 33], s[1 * 33]); o.y = pk2(s[2 * 33], s[3 * 33]); o.z = pk2(s[4 * 33], s[5 * 33]); o.w = pk2(s[6 * 33], s[7 * 33]);
        *(u32x4*)(WT + (size_t)(drow0 + n) * K + k0 + 8 * c) = o; }
    asm volatile("s_waitcnt lgkmcnt(0)" ::: "memory");
}
DI void xpose_plain(const float* W, int K, int N, bf16* WT, int item, LAS float* scr, int lane) {
    const int nblk = N / 32, kb = item / nblk, nb = item % nblk;
    transpose_item(W, K, N, WT, 64 * kb, 32 * nb, 32 * nb, scr, lane);
}
DI void xpose_ffnin(const float* W, bf16* WT, int item, LAS float* scr, int lane) {
    const int nblk = 5632 / 32, kb = item / nblk, nb = item % nblk, n0 = 32 * nb;
    const int bj = n0 >= FF ? 1 : 0, cc = n0 - bj * FF, drow0 = 256 * (cc >> 7) + 128 * bj + (cc & 127);
    transpose_item(W, 1024, 5632, WT, 64 * kb, n0, drow0, scr, lane);
}

DI void phase_prologue(const Args& a, LAS unsigned char* lds, int tid, int lane, int wave) {
    unsigned char* ws = a.ws;
    {
        LAS float* sl = (LAS float*)lds;
        LAS float* red = (LAS float*)(lds + 32768);
        for (int i = tid; i < 5 * 1024; i += NTHR) { const int s = i >> 10, k = i & 1023; const float v = s < 4 ? a.in[I_C][s * 1024 + k] : a.in[I_CCTX][k]; sl[i] = v / (1.0f + __expf(-v)); }
        __syncthreads();
        for (int u = blockIdx.x; u < 192; u += gridDim.x) {
            const int layer = u / 96, col = (u % 96) * 64 + lane;
            const float* W = a.in[I_WMOD] + (size_t)layer * 1024 * 6144 + col;
            float acc[5] = {0.f, 0.f, 0.f, 0.f, 0.f};
            const int kb = wave * 128;
#pragma unroll 8
            for (int k = 0; k < 128; ++k) { const float w = W[(size_t)(kb + k) * 6144];
#pragma unroll
                for (int s = 0; s < 5; ++s) acc[s] += sl[s * 1024 + kb + k] * w; }
#pragma unroll
            for (int s = 0; s < 5; ++s) red[(wave * 5 + s) * 64 + lane] = acc[s];
            __syncthreads();
            if (tid < 320) { const int s = tid >> 6, l = tid & 63; float t = 0.f;
#pragma unroll
                for (int w = 0; w < 8; ++w) t += red[(w * 5 + s) * 64 + l];
                const int c2 = (u % 96) * 64 + l;
                ((float*)(ws + WS_MOD))[(size_t)(layer * 5 + s) * 6144 + c2] = t + a.in[I_BMOD][layer * 6144 + c2]; }
            __syncthreads();
        }
        __syncthreads();
    }
    LAS float* scr = (LAS float*)(lds + wave * 16384);
    const int gw = blockIdx.x * NWAVES + wave, NGW = gridDim.x * NWAVES;
    constexpr int I_1 = 16 * 73, I_2 = 16 * 32, I_3 = 16 * 176, I_4 = 44 * 32, I_5 = 16 * 96, I_6 = 16 * 32;
    constexpr int NITEMS = I_1 + I_2 + 2 * I_3 + 2 * I_4 + I_5 + I_6;
    for (int it = gw; it < NITEMS; it += NGW) {
        int r = it;
        if (r < I_1) { xpose_plain(a.in[I_ABWI], 1024, 2336, (bf16*)(ws + WS_WABI), r, scr, lane); continue; } r -= I_1;
        if (r < I_2) { xpose_plain(a.in[I_ABWO], 1024, 1024, (bf16*)(ws + WS_WABO), r, scr, lane); continue; } r -= I_2;
        if (r < I_3) { xpose_ffnin(a.in[I_WFI], (bf16*)(ws + WS_WFI), r, scr, lane); continue; } r -= I_3;
        if (r < I_3) { xpose_ffnin(a.in[I_WFI] + (size_t)1024 * 5632, (bf16*)(ws + WS_WFI) + (size_t)5632 * 1024, r, scr, lane); continue; } r -= I_3;
        if (r < I_4) { xpose_plain(a.in[I_WFO], FF, 1024, (bf16*)(ws + WS_WFO), r, scr, lane); continue; } r -= I_4;
        if (r < I_4) { xpose_plain(a.in[I_WFO] + (size_t)FF * 1024, FF, 1024, (bf16*)(ws + WS_WFO) + (size_t)1024 * FF, r, scr, lane); continue; } r -= I_4;
        if (r < I_5) { xpose_plain(a.in[I_NAWI], 1024, 3072, (bf16*)(ws + WS_WNI), r, scr, lane); continue; } r -= I_5;
        xpose_plain(a.in[I_NAWO], 1024, 1024, (bf16*)(ws + WS_WNO), r, scr, lane);
    }
    { u32x4* z = (u32x4*)((bf16*)(ws + WS_WABI) + (size_t)2336 * 1024); const u32x4 zero = {0u, 0u, 0u, 0u};
      for (int i = blockIdx.x * NTHR + tid; i < 224 * 128; i += gridDim.x * NTHR) z[i] = zero; }
}

DI void row_op(const float* xsrc, const bf16* y, int nslice, const float* gpost, const float* gate, float* xdst,
               const float* gpre, const float* shift, const float* scale, bf16* hdst, int lane) {
    f32x4 v[4];
#pragma unroll
    for (int j = 0; j < 4; ++j) v[j] = *((const f32x4*)xsrc + lane + 64 * j);
    if (y) {
        f32x4 yv[4]; float s = 0.f;
#pragma unroll
        for (int j = 0; j < 4; ++j) yv[j] = (f32x4){0.f, 0.f, 0.f, 0.f};
        for (int sl = 0; sl < nslice; ++sl) {
#pragma unroll
            for (int j = 0; j < 4; ++j) { const u32x2 w = *((const u32x2*)(y + (size_t)sl * NCTX * D) + lane + 64 * j);
                yv[j] = yv[j] + (f32x4){__uint_as_float(w.x << 16), __uint_as_float(w.x & 0xffff0000u), __uint_as_float(w.y << 16), __uint_as_float(w.y & 0xffff0000u)}; } }
#pragma unroll
        for (int j = 0; j < 4; ++j) s += (yv[j].x * yv[j].x + yv[j].y * yv[j].y) + (yv[j].z * yv[j].z + yv[j].w * yv[j].w);
        const float rstd = __builtin_amdgcn_rsqf(wave_sum(s) * (1.0f / D) + EPS);
#pragma unroll
        for (int j = 0; j < 4; ++j) { const f32x4 gp = *((const f32x4*)gpost + lane + 64 * j), gt = *((const f32x4*)gate + lane + 64 * j);
            v[j] = v[j] + gt * (yv[j] * rstd * gp); }
    }
    if (xdst) {
#pragma unroll
        for (int j = 0; j < 4; ++j) *((f32x4*)xdst + lane + 64 * j) = v[j];
    }
    if (hdst) {
        float s = 0.f;
#pragma unroll
        for (int j = 0; j < 4; ++j) s += (v[j].x * v[j].x + v[j].y * v[j].y) + (v[j].z * v[j].z + v[j].w * v[j].w);
        const float rstd = __builtin_amdgcn_rsqf(wave_sum(s) * (1.0f / D) + EPS);
#pragma unroll
        for (int j = 0; j < 4; ++j) { const f32x4 gp = *((const f32x4*)gpre + lane + 64 * j), sh = *((const f32x4*)shift + lane + 64 * j), sc = *((const f32x4*)scale + lane + 64 * j);
            const f32x4 h = v[j] * rstd * gp * (sc + 1.0f) + sh;
            u32x2 w; w.x = pk2(h.x, h.y); w.y = pk2(h.z, h.w);
            *((u32x2*)hdst + lane + 64 * j) = w; }
    }
}
DI void phase_rows(const Args& a, int mode, int layer, int lane, int wave) {
    unsigned char* ws = a.ws;
    const float* MOD = (const float*)(ws + WS_MOD);
    bf16* H = (bf16*)(ws + WS_HO); const bf16* YF = (const bf16*)(ws + WS_YF); const bf16* PART = (const bf16*)(ws + WS_PART); float* XC = (float*)(ws + WS_XC);
    const int gw = blockIdx.x * NWAVES + wave, NGW = gridDim.x * NWAVES;
    const int nrows = (layer == 0) ? MT : NLAT;
    for (int m = gw; m < nrows; m += NGW) {
        const bool lat = m < NLAT; const int s = lat ? (m >> 12) : 4;
        const float* mod = MOD + (size_t)(layer * 5 + s) * 6144;
        float* xcur = lat ? a.out + (size_t)m * D : XC + (size_t)(m - NLAT) * D;
        if (mode == 0) {
            const float* xin = lat ? a.in[I_X] + (size_t)m * D : a.in[I_CTX] + (size_t)(m - NLAT) * D;
            row_op(xin, nullptr, 0, nullptr, nullptr, nullptr, a.in[I_GMPRE], mod, mod + 1024, H + (size_t)m * D, lane);
        } else if (mode == 1) {
            const float* xin = (layer == 0) ? (lat ? a.in[I_X] + (size_t)m * D : a.in[I_CTX] + (size_t)(m - NLAT) * D) : xcur;
            row_op(xin, (layer == 0 && !lat) ? PART + (size_t)(m - NLAT) * D : YF + (size_t)m * D, (layer == 0 && !lat) ? 4 : 1, a.in[I_GMPOST] + layer * D, mod + 2048, xcur, a.in[I_GFPRE] + layer * D, mod + 3072, mod + 4096, H + (size_t)m * D, lane);
        } else {
            if (layer == 0) { const float* mod1 = MOD + (size_t)(5 + s) * 6144;
                row_op(xcur, lat ? YF + (size_t)m * D : PART + (size_t)(m - NLAT) * D, lat ? 1 : 11, a.in[I_GFPOST], mod + 5120, xcur, a.in[I_GMPRE] + D, mod1, mod1 + 1024, H + (size_t)m * D, lane); }
            else row_op(xcur, YF + (size_t)m * D, 1, a.in[I_GFPOST] + D, mod + 5120, xcur, nullptr, nullptr, nullptr, nullptr, lane);
        }
    }
}

DI float xmax_quads(float x) {
    unsigned u = __float_as_uint(x);
    auto r = __builtin_amdgcn_permlane16_swap(u, u, false, false);
    u = __float_as_uint(fmaxf(__uint_as_float(r[0]), __uint_as_float(r[1])));
    auto r2 = __builtin_amdgcn_permlane32_swap(u, u, false, false);
    return fmaxf(__uint_as_float(r2[0]), __uint_as_float(r2[1]));
}
DI float xsum_quads(float x) {
    unsigned u = __float_as_uint(x);
    auto r = __builtin_amdgcn_permlane16_swap(u, u, false, false);
    u = __float_as_uint(__uint_as_float(r[0]) + __uint_as_float(r[1]));
    auto r2 = __builtin_amdgcn_permlane32_swap(u, u, false, false);
    return __uint_as_float(r2[0]) + __uint_as_float(r2[1]);
}
struct KVFrag { bf16x8 kf[2][2]; bf16x8 vf[4]; };
DI void kv_load(KVFrag& f, const bf16* kp, int kld, const bf16* vp, int vld, int fr, int fq) {
#pragma unroll
    for (int h = 0; h < 2; ++h)
#pragma unroll
        for (int ks = 0; ks < 2; ++ks) f.kf[h][ks] = *(const bf16x8*)(kp + (size_t)((fr >> 2) * 8 + h * 4 + (fr & 3)) * kld + ks * 32 + fq * 8);
#pragma unroll
    for (int nt = 0; nt < 4; ++nt) f.vf[nt] = *(const bf16x8*)(vp + (size_t)(nt * 16 + fr) * vld + fq * 8);
}
template <int MODE>
DI void attn_one(f32x4 (&o)[4], float& mrun, float& lrun, const bf16x8 (&qf)[2], const KVFrag& f, float sc2, int d0, unsigned okmask, const float (&bias)[8]) {
    f32x4 s0 = {0.f, 0.f, 0.f, 0.f}, s1 = {0.f, 0.f, 0.f, 0.f};
    s0 = MFMA16(f.kf[0][0], qf[0], s0); s0 = MFMA16(f.kf[0][1], qf[1], s0);
    s1 = MFMA16(f.kf[1][0], qf[0], s1); s1 = MFMA16(f.kf[1][1], qf[1], s1);
    float sv[8] = {s0[0], s0[1], s0[2], s0[3], s1[0], s1[1], s1[2], s1[3]};
    float mx = -1e30f;
#pragma unroll
    for (int i = 0; i < 8; ++i) {
        float t = sv[i] * sc2;
        if (MODE == 1) { const int dd = d0 - i; t = (dd >= -128 && dd <= 128) ? t : -1e30f; }
        if (MODE == 2) { t = ((okmask >> i) & 1u) ? t + bias[i] : -1e30f; }
        sv[i] = t; mx = fmaxf(mx, t);
    }
    mx = xmax_quads(mx);
    {
        const float mn = fmaxf(mrun, mx), alpha = fast_exp2(mrun - mn);
        lrun *= alpha; mrun = mn;
#pragma unroll
        for (int nt = 0; nt < 4; ++nt) o[nt] = o[nt] * alpha;
    }
    float p[8], ps = 0.f;
#pragma unroll
    for (int i = 0; i < 8; ++i) { p[i] = fast_exp2(sv[i] - mrun); ps += p[i]; }
    lrun += xsum_quads(ps);
    const bf16x8 pf = pack8(p);
#pragma unroll
    for (int nt = 0; nt < 4; ++nt) o[nt] = MFMA16(f.vf[nt], pf, o[nt]);
}
DI void attn_store1(const f32x4 (&o)[4], float lrun, bf16* op, int fq) {
    const float inv = 1.0f / lrun;
#pragma unroll
    for (int nt = 0; nt < 4; ++nt) { u32x2 w; w.x = pk2(o[nt][0] * inv, o[nt][1] * inv); w.y = pk2(o[nt][2] * inv, o[nt][3] * inv);
        *(u32x2*)(op + nt * 16 + fq * 4) = w; }
}

DI void window_attn_tile(const Args& a, int wt, int lane) {
    const bf16* P = (const bf16*)(a.ws + WS_P); const bf16* VtA = (const bf16*)(a.ws + WS_VTA); bf16* O = (bf16*)(a.ws + WS_HO);
    const int fr = lane & 15, fq = lane >> 4;
    const bool isctx = wt >= 2048;
    int b, kvh, q0; size_t qrow;
    if (!isctx) { b = wt >> 9; kvh = (wt >> 8) & 1; q0 = (wt & 255) * 16; qrow = (size_t)b * SEQ + q0 + fr; }
    else { const int ct = wt - 2048; b = ct >> 5; kvh = (ct >> 4) & 1; q0 = (ct & 15) * 16; qrow = (size_t)NLAT + b * CTXL + q0 + fr; }
    bf16x8 qf[4][2]; f32x4 o[4][4]; float mrun[4], lrun[4];
#pragma unroll
    for (int g = 0; g < 4; ++g) {
#pragma unroll
        for (int ks = 0; ks < 2; ++ks) qf[g][ks] = *(const bf16x8*)(P + qrow * LDP0 + C_AQ + (kvh * 4 + g) * 64 + ks * 32 + fq * 8);
#pragma unroll
        for (int nt = 0; nt < 4; ++nt) o[g][nt] = (f32x4){0.f, 0.f, 0.f, 0.f};
        mrun[g] = a.in[I_SINK][kvh * 4 + g] * LOG2E; lrun[g] = 1.0f;
    }
    const float sc2 = 0.125f * LOG2E;
    const float nob[8] = {0.f, 0.f, 0.f, 0.f, 0.f, 0.f, 0.f, 0.f};
    const bf16* vbase = VtA + (size_t)((b * 2 + kvh) * 64) * KEYS;
    const bf16* kctx = P + (size_t)(NLAT + b * CTXL) * LDP0 + C_AK + kvh * 64;
    const bf16* kloc = P + (size_t)(b * SEQ) * LDP0 + C_AK + kvh * 64;
    const int tlo = (q0 - 128 > 0 ? q0 - 128 : 0) & ~31, thi = (q0 + 16 + 128 < SEQ) ? q0 + 16 + 128 : SEQ;
    const int ntile = isctx ? 8 : 8 + (thi - tlo + 31) / 32;
#define WIN_LOAD(F, t) do { const int t_ = (t); const int k0_ = t_ < 8 ? t_ * 32 : tlo + (t_ - 8) * 32; \
        kv_load(F, (t_ < 8 ? kctx : kloc) + (size_t)k0_ * LDP0, LDP0, vbase + (t_ < 8 ? SEQ : 0) + k0_, KEYS, fr, fq); } while (0)
#define WIN_PROC(F, t) do { const int t_ = (t); const int d0_ = t_ < 8 ? 0 : q0 + fr - (tlo + (t_ - 8) * 32) - fq * 8; \
        _Pragma("unroll") for (int g = 0; g < 4; ++g) attn_one<1>(o[g], mrun[g], lrun[g], qf[g], F, sc2, d0_, 0u, nob); } while (0)
    KVFrag A, B;
    WIN_LOAD(A, 0);
    for (int t = 0; t < ntile; t += 2) {
        WIN_LOAD(B, (t + 1 < ntile ? t + 1 : ntile - 1));
        WIN_PROC(A, t);
        WIN_LOAD(A, (t + 2 < ntile ? t + 2 : ntile - 1));
        if (t + 1 < ntile) WIN_PROC(B, t + 1);
    }
#undef WIN_LOAD
#undef WIN_PROC
#pragma unroll
    for (int g = 0; g < 4; ++g) attn_store1(o[g], lrun[g], O + qrow * D + (kvh * 4 + g) * 64, fq);
}

template <int NR>
DI void na_attn_group(const Args& a, int gid, int lane, LAS float* btab  ) {
    const bf16* P = (const bf16*)(a.ws + WS_P); const bf16* VtC = (const bf16*)(a.ws + WS_YF); bf16* O = (bf16*)(a.ws + WS_HO);
    const int fr = lane & 15, fq = lane >> 4;
    constexpr int NRG = 64 / NR; const int j = gid & 3, r0 = ((gid >> 2) % NRG) * NR, h = ((gid >> 2) / NRG) & 15, b = (gid >> 2) / (NRG * 16);
    { const float* relb = a.in[I_RELB] + h * 465;
      for (int i = lane; i < 465; i += 64) btab[i] = relb[i] * LOG2E;
      asm volatile("s_waitcnt vmcnt(0) lgkmcnt(0)" ::: "memory"); }
    bf16x8 qf[NR][2]; f32x4 o[NR][4]; float mrun[NR], lrun[NR];
#pragma unroll
    for (int qi = 0; qi < NR; ++qi) { const size_t qrow = (size_t)b * SEQ + (r0 + qi) * 64 + j * 16 + fr;
#pragma unroll
        for (int ks = 0; ks < 2; ++ks) qf[qi][ks] = *(const bf16x8*)(P + qrow * LDP1 + h * 64 + ks * 32 + fq * 8);
#pragma unroll
        for (int nt = 0; nt < 4; ++nt) o[qi][nt] = (f32x4){0.f, 0.f, 0.f, 0.f};
        mrun[qi] = -1e30f; lrun[qi] = 0.f; }
    const float sc2 = 0.125f * LOG2E;
    const float nob[8] = {0.f, 0.f, 0.f, 0.f, 0.f, 0.f, 0.f, 0.f};
    const bf16* vbase = VtC + (size_t)((b * 16 + h) * 64) * KEYS;
    const bf16* kctx = P + (size_t)(NLAT + b * CTXL) * LDP1 + 1024 + h * 64;
    const bf16* kloc = P + (size_t)(b * SEQ) * LDP1 + 1024 + h * 64;
    const int seg_start = j == 0 ? 0 : (j == 1 ? 8 : (j == 2 ? 24 : 32));
    const int qcol = j * 16 + fr; const int cs = qcol - 8 < 0 ? 0 : (qcol - 8 > 48 ? 48 : qcol - 8);
    unsigned okmask = 0u; int coloff[8];
#pragma unroll
    for (int i = 0; i < 8; ++i) { const int keycol = seg_start + fq * 8 + i; if (keycol >= cs && keycol < cs + 16) okmask |= 1u << i;
        int co = keycol - qcol + 15; co = co < 0 ? 0 : (co > 30 ? 30 : co); coloff[i] = co; }
    const int rsa = r0 - 4 < 0 ? 0 : (r0 - 4 > 56 ? 56 : r0 - 4);
    const int rsb = r0 + NR - 1 - 4 < 0 ? 0 : (r0 + NR - 1 - 4 > 56 ? 56 : r0 + NR - 1 - 4);
    const int nloc = rsb + 8 - rsa, ntile = 8 + nloc;
#define NA_LOAD(F, t) do { const int t_ = (t); const int k0_ = t_ < 8 ? t_ * 32 : (rsa + t_ - 8) * 64 + seg_start; \
        kv_load(F, (t_ < 8 ? kctx : kloc) + (size_t)k0_ * LDP1, LDP1, vbase + (t_ < 8 ? SEQ : 0) + k0_, KEYS, fr, fq); } while (0)
#define NA_PROC(F, t) do { const int t_ = (t); \
        if (t_ < 8) { _Pragma("unroll") for (int qi = 0; qi < NR; ++qi) attn_one<0>(o[qi], mrun[qi], lrun[qi], qf[qi], F, sc2, 0, 0u, nob); } \
        else { const int R_ = rsa + t_ - 8; \
            _Pragma("unroll") for (int qi = 0; qi < NR; ++qi) { const int r_ = r0 + qi; const int rs_ = r_ - 4 < 0 ? 0 : (r_ - 4 > 56 ? 56 : r_ - 4); \
                if (R_ >= rs_ && R_ < rs_ + 8) { const LAS float* rb_ = btab + (R_ - r_ + 7) * 31; float bias_[8]; \
                    _Pragma("unroll") for (int e = 0; e < 8; ++e) bias_[e] = rb_[coloff[e]]; \
                    attn_one<2>(o[qi], mrun[qi], lrun[qi], qf[qi], F, sc2, 0, okmask, bias_); } } } } while (0)
    if (NR <= 2) {
        KVFrag A, B;
        NA_LOAD(A, 0);
        for (int t = 0; t < ntile; t += 2) {
            NA_LOAD(B, (t + 1 < ntile ? t + 1 : ntile - 1));
            NA_PROC(A, t);
            NA_LOAD(A, (t + 2 < ntile ? t + 2 : ntile - 1));
            if (t + 1 < ntile) NA_PROC(B, t + 1);
        }
    } else {
        KVFrag A;
        for (int t = 0; t < ntile; ++t) { NA_LOAD(A, t); NA_PROC(A, t); }
    }
#undef NA_LOAD
#undef NA_PROC
#pragma unroll
    for (int qi = 0; qi < NR; ++qi) attn_store1(o[qi], lrun[qi], O + ((size_t)b * SEQ + (r0 + qi) * 64 + j * 16 + fr) * D + h * 64, fq);
}

constexpr int NA_KC = 0, NA_VC = 36864, NA_KR = 73728, NA_VR = 92160, NA_BT = 110592;
typedef short s16x4 __attribute__((ext_vector_type(4)));
DI void kv_load_lds(KVFrag& f, const LAS unsigned short* kimg, const LAS unsigned short* vimg  , int fr, int fq) {
#pragma unroll
    for (int h = 0; h < 2; ++h)
#pragma unroll
        for (int ks = 0; ks < 2; ++ks) f.kf[h][ks] = *(const LAS bf16x8*)(kimg + ((fr >> 2) * 8 + h * 4 + (fr & 3)) * 72 + ks * 32 + fq * 8);
#ifdef NA_PLAIN_V
#pragma unroll
    for (int nt = 0; nt < 4; ++nt) { bf16x8 v;
#pragma unroll
        for (int j = 0; j < 8; ++j) v[j] = (short)vimg[(fq * 8 + j) * 72 + nt * 16 + fr];
        f.vf[nt] = v; }
    return;
#endif
    typedef LAS s16x4* trp_t;
    const LAS unsigned short* vb = vimg + (fq * 8 + (fr >> 2)) * 72 + (fr & 3) * 4;
    const s16x4 l0 = __builtin_amdgcn_ds_read_tr16_b64_v4i16((trp_t)(vb)),      h0 = __builtin_amdgcn_ds_read_tr16_b64_v4i16((trp_t)(vb + 288));
    const s16x4 l1 = __builtin_amdgcn_ds_read_tr16_b64_v4i16((trp_t)(vb + 16)), h1 = __builtin_amdgcn_ds_read_tr16_b64_v4i16((trp_t)(vb + 304));
    const s16x4 l2 = __builtin_amdgcn_ds_read_tr16_b64_v4i16((trp_t)(vb + 32)), h2 = __builtin_amdgcn_ds_read_tr16_b64_v4i16((trp_t)(vb + 320));
    const s16x4 l3 = __builtin_amdgcn_ds_read_tr16_b64_v4i16((trp_t)(vb + 48)), h3 = __builtin_amdgcn_ds_read_tr16_b64_v4i16((trp_t)(vb + 336));
    f.vf[0] = __builtin_shufflevector(l0, h0, 0, 1, 2, 3, 4, 5, 6, 7); f.vf[1] = __builtin_shufflevector(l1, h1, 0, 1, 2, 3, 4, 5, 6, 7);
    f.vf[2] = __builtin_shufflevector(l2, h2, 0, 1, 2, 3, 4, 5, 6, 7); f.vf[3] = __builtin_shufflevector(l3, h3, 0, 1, 2, 3, 4, 5, 6, 7);
}
DI void na_attn_unit(const Args& a, LAS unsigned char* lds, int unit, int tid, int lane, int wave) {
    const bf16* P = (const bf16*)(a.ws + WS_P); bf16* O = (bf16*)(a.ws + WS_HO);
    LAS unsigned short* KC = (LAS unsigned short*)(lds + NA_KC); LAS unsigned short* VC = (LAS unsigned short*)(lds + NA_VC);
    LAS unsigned short* KR = (LAS unsigned short*)(lds + NA_KR); LAS unsigned short* VR = (LAS unsigned short*)(lds + NA_VR); LAS float* bt = (LAS float*)(lds + NA_BT);
    const int fr = lane & 15, fq = lane >> 4;
    const int r0 = (unit & 15) * 4, h = (unit >> 4) & 15, b = unit >> 8;
    const int qr = r0 + (wave >> 1), jb = (wave & 1) * 2;
    const bf16* kglob = P + (size_t)(b * SEQ) * LDP1 + 1024 + h * 64;
    const bf16* vglob = P + (size_t)(b * SEQ) * LDP1 + 2048 + h * 64;
    const int rsa = r0 - 4 < 0 ? 0 : (r0 - 4 > 56 ? 56 : r0 - 4);
    const int rsb = r0 + 3 - 4 < 0 ? 0 : (r0 + 3 - 4 > 56 ? 56 : r0 + 3 - 4);
    const int nloc = rsb + 8 - rsa;
    for (int i = tid; i < 465; i += NTHR) bt[i] = a.in[I_RELB][h * 465 + i] * LOG2E;
    { const int row = tid >> 1, half = tid & 1; const bf16* src = P + (size_t)(NLAT + b * CTXL + row) * LDP1 + 1024 + h * 64 + half * 32;
#pragma unroll
      for (int i = 0; i < 4; ++i) { *(LAS u32x4*)(KC + row * 72 + half * 32 + i * 8) = *(const u32x4*)(src + i * 8); *(LAS u32x4*)(VC + row * 72 + half * 32 + i * 8) = *(const u32x4*)(src + 1024 + i * 8); } }
    const int srow = tid >> 3, sch = (tid & 7) * 8;
    { const u32x4 kreg = *(const u32x4*)(kglob + (size_t)(rsa * 64 + srow) * LDP1 + sch), vreg = *(const u32x4*)(vglob + (size_t)(rsa * 64 + srow) * LDP1 + sch);
      *(LAS u32x4*)(KR + srow * 72 + sch) = kreg; *(LAS u32x4*)(VR + srow * 72 + sch) = vreg; }
    bf16x8 qf[2][2]; f32x4 o[2][4]; float mrun[2], lrun[2];
#pragma unroll
    for (int qi = 0; qi < 2; ++qi) { const size_t qrow = (size_t)b * SEQ + qr * 64 + (jb + qi) * 16 + fr;
#pragma unroll
        for (int ks = 0; ks < 2; ++ks) qf[qi][ks] = *(const bf16x8*)(P + qrow * LDP1 + h * 64 + ks * 32 + fq * 8);
#pragma unroll
        for (int nt = 0; nt < 4; ++nt) o[qi][nt] = (f32x4){0.f, 0.f, 0.f, 0.f};
        mrun[qi] = -1e30f; lrun[qi] = 0.f; }
    const float sc2 = 0.125f * LOG2E;
    const float nob[8] = {0.f, 0.f, 0.f, 0.f, 0.f, 0.f, 0.f, 0.f};
    __syncthreads();
    for (int t8 = 0; t8 < 8; ++t8) { KVFrag F; kv_load_lds(F, KC + t8 * 32 * 72, VC + t8 * 32 * 72, fr, fq);
#pragma unroll
        for (int qi = 0; qi < 2; ++qi) attn_one<0>(o[qi], mrun[qi], lrun[qi], qf[qi], F, sc2, 0, 0u, nob); }
    int seg_start[2], cbase[2]; unsigned okmask[2];
#pragma unroll
    for (int qi = 0; qi < 2; ++qi) { const int j = jb + qi; seg_start[qi] = j == 0 ? 0 : (j == 1 ? 8 : (j == 2 ? 24 : 32));
        const int qcol = j * 16 + fr; const int cs = qcol - 8 < 0 ? 0 : (qcol - 8 > 48 ? 48 : qcol - 8);
        unsigned m = 0u;
#pragma unroll
        for (int i = 0; i < 8; ++i) { const int keycol = seg_start[qi] + fq * 8 + i; if (keycol >= cs && keycol < cs + 16) m |= 1u << i; }
        okmask[qi] = m; cbase[qi] = seg_start[qi] + fq * 8 - qcol + 15; }
    const int rsq = qr - 4 < 0 ? 0 : (qr - 4 > 56 ? 56 : qr - 4);
    for (int t = 0; t < nloc; ++t) {
        const int R = rsa + t, cur = t & 1;
        u32x4 kreg = {0u, 0u, 0u, 0u}, vreg = {0u, 0u, 0u, 0u};
        if (t + 1 < nloc) { kreg = *(const u32x4*)(kglob + (size_t)((R + 1) * 64 + srow) * LDP1 + sch); vreg = *(const u32x4*)(vglob + (size_t)((R + 1) * 64 + srow) * LDP1 + sch); }
        if (R >= rsq && R < rsq + 8) {
            const LAS float* rb = bt + (R - qr + 7) * 31;
#pragma unroll
            for (int qi = 0; qi < 2; ++qi) { KVFrag F; kv_load_lds(F, KR + cur * 4608 + seg_start[qi] * 72, VR + cur * 4608 + seg_start[qi] * 72, fr, fq);
                float bias[8];
#pragma unroll
                for (int e = 0; e < 8; ++e) { int co = cbase[qi] + e; co = co < 0 ? 0 : (co > 30 ? 30 : co); bias[e] = rb[co]; }
                attn_one<2>(o[qi], mrun[qi], lrun[qi], qf[qi], F, sc2, 0, okmask[qi], bias); }
        }
        if (t + 1 < nloc) { *(LAS u32x4*)(KR + (cur ^ 1) * 4608 + srow * 72 + sch) = kreg; *(LAS u32x4*)(VR + (cur ^ 1) * 4608 + srow * 72 + sch) = vreg; }
        __syncthreads();
    }
#pragma unroll
    for (int qi = 0; qi < 2; ++qi) attn_store1(o[qi], lrun[qi], O + ((size_t)b * SEQ + qr * 64 + (jb + qi) * 16 + fr) * D + h * 64, fq);
}

DI void vt_unit(const bf16* P, int ldp, int vcol, int nh, bf16* Vt, int unit, LAS unsigned char* scr, int lane) {
    const int kb = unit % 68, bh = unit / 68, h = bh % nh, b = bh / nh;
    const size_t row0 = kb < 64 ? (size_t)b * SEQ + kb * 64 : (size_t)NLAT + b * CTXL + (kb - 64) * 64;
    LAS unsigned short* t = (LAS unsigned short*)scr;
#pragma unroll
    for (int i = 0; i < 8; ++i) { const int key = (lane >> 3) + 8 * i, ch = lane & 7;
        const u32x4 v = *(const u32x4*)(P + (row0 + key) * ldp + vcol + h * 64 + ch * 8);
        *(LAS u32x4*)(t + key * 72 + ch * 8) = v; }
    asm volatile("s_waitcnt lgkmcnt(0)" ::: "memory");
    bf16* dst = Vt + (size_t)(bh * 64 + lane) * KEYS + kb * 64;
#pragma unroll
    for (int g8 = 0; g8 < 8; ++g8) { unsigned short e[8];
#pragma unroll
        for (int i = 0; i < 8; ++i) e[i] = t[(g8 * 8 + i) * 72 + lane];
        u32x4 w; w.x = e[0] | ((unsigned)e[1] << 16); w.y = e[2] | ((unsigned)e[3] << 16); w.z = e[4] | ((unsigned)e[5] << 16); w.w = e[6] | ((unsigned)e[7] << 16);
        *(u32x4*)(dst + g8 * 8) = w; }
    asm volatile("s_waitcnt lgkmcnt(0)" ::: "memory");
}

constexpr int L_GW = 0, L_CUM = 4608, L_A = 21248, L_B = 30464, L_ATT = 39680, L_VT = 48896, L_SSQ = 67328, L_TOT = 67840;
DI size_t chunk_row0(int b, int n) { return n < 64 ? (size_t)b * SEQ + n * 64 : (size_t)NLAT + b * CTXL + (n - 64) * 64; }
DI float* cum_ptr(const Args& a, int dir, int bh, int n) { return (float*)(a.ws + (dir ? WS_CUM1 : WS_CUM0)) + (size_t)(bh * NCHUNK + n) * 4096; }
DI bf16* st_ptr(const Args& a, int seq, int n) { return n < 64 ? (bf16*)(a.ws + WS_YF) + (size_t)(seq * 64 + n) * 8192 : (bf16*)(a.ws + WS_STC) + (size_t)(seq * 4 + (n - 64)) * 8192; }

DI void gla_cum(const Args& a, LAS unsigned char* lds, const bf16* P, size_t row0, int h, int dir, int tid) {
    LAS float* rfl = (LAS float*)(lds + L_GW); LAS float* tot = (LAS float*)(lds + L_TOT); LAS float* cum = (LAS float*)(lds + L_CUM);
    const float* gw = a.in[dir ? I_GBW : I_GFW]; const float* gb = a.in[dir ? I_GBB : I_GFB];
    const int lane = tid & 63, w = tid >> 6;
    { const int c = tid >> 3, r2 = (tid & 7) * 2; const unsigned v = *(const unsigned*)(P + (row0 + c) * LDP0 + (dir ? C_RB : C_RF) + r2);
      rfl[c * 16 + r2] = __uint_as_float(v << 16); rfl[c * 16 + r2 + 1] = __uint_as_float(v & 0xffff0000u); }
    float gwr[16];
#pragma unroll
    for (int r = 0; r < 16; ++r) gwr[r] = gw[r * 256 + h * 64 + lane];
    const float gbv = gb[h * 64 + lane];
    __syncthreads();
    float la[8];
#pragma unroll
    for (int i = 0; i < 8; ++i) { const int c = w * 8 + i; float x = gbv;
#pragma unroll
        for (int r = 0; r < 16; ++r) x += rfl[c * 16 + r] * gwr[r];
        la[i] = (fminf(x, 0.f) - __logf(1.0f + __expf(-fabsf(x)))) * (1.0f / 16.0f); }
    if (dir == 0) {
#pragma unroll
        for (int i = 1; i < 8; ++i) la[i] += la[i - 1];
        tot[w * 64 + lane] = la[7];
    } else {
#pragma unroll
        for (int i = 6; i >= 0; --i) la[i] += la[i + 1];
        tot[w * 64 + lane] = la[0];
    }
    __syncthreads();
    float off = 0.f;
#pragma unroll
    for (int w2 = 0; w2 < 8; ++w2) { const float t = tot[w2 * 64 + lane]; off += ((dir == 0) ? (w2 < w) : (w2 > w)) ? t : 0.f; }
#pragma unroll
    for (int i = 0; i < 8; ++i) cum[(w * 8 + i) * 65 + lane] = la[i] + off;
    __syncthreads();
}
DI void gla_load_vt(LAS unsigned char* lds, const bf16* P, size_t row0, int h, int tid) {
    LAS unsigned short* vT = (LAS unsigned short*)(lds + L_VT);
    const int c = tid >> 3, dg = tid & 7;
    const bf16* vp = P + (row0 + c) * LDP0 + C_BV + h * 128 + dg * 16;
    const bf16x8 v0 = *(const bf16x8*)vp, v1 = *(const bf16x8*)(vp + 8);
#pragma unroll
    for (int e = 0; e < 8; ++e) { vT[(dg * 16 + e) * 72 + c] = (unsigned short)v0[e]; vT[(dg * 16 + 8 + e) * 72 + c] = (unsigned short)v1[e]; }
}
DI void gla_g1_unit(const Args& a, LAS unsigned char* lds, int unit, int tid, int lane, int wave) {
    const bf16* P = (const bf16*)(a.ws + WS_P);
    const int n = unit % NCHUNK, seq = unit / NCHUNK, dir = seq & 1, h = (seq >> 1) & 3, b = seq >> 3;
    const size_t row0 = chunk_row0(b, n);
    const bf16x8 kraw = *(const bf16x8*)(P + (row0 + (tid >> 3)) * LDP0 + C_BK + h * 64 + (tid & 7) * 8);
    gla_load_vt(lds, P, row0, h, tid);
    gla_cum(a, lds, P, row0, h, dir, tid);
    LAS float* cum = (LAS float*)(lds + L_CUM); LAS unsigned short* kdT = (LAS unsigned short*)(lds + L_A); LAS unsigned short* vT = (LAS unsigned short*)(lds + L_VT);
    const int cend = dir ? 0 : 63;
    { const int c = tid >> 3, dg = tid & 7; float kk[8]; unpack8(kraw, kk);
#pragma unroll
      for (int dd = 0; dd < 8; ++dd) { const int d = dg * 8 + dd; const float v = kk[dd] * __expf(cum[cend * 65 + d] - cum[c * 65 + d]); kdT[d * 72 + c] = (unsigned short)(pk2(v, 0.f) & 0xffffu); } }
    { const int c = tid >> 3, dg = tid & 7; float* cp = cum_ptr(a, dir, seq >> 1, n) + c * 64 + dg * 8;
      *(f32x4*)cp = (f32x4){cum[c * 65 + dg * 8], cum[c * 65 + dg * 8 + 1], cum[c * 65 + dg * 8 + 2], cum[c * 65 + dg * 8 + 3]};
      *(f32x4*)(cp + 4) = (f32x4){cum[c * 65 + dg * 8 + 4], cum[c * 65 + dg * 8 + 5], cum[c * 65 + dg * 8 + 6], cum[c * 65 + dg * 8 + 7]}; }
    if (tid < 64) ((float*)(a.ws + WS_DEC))[(size_t)(seq * NCHUNK + n) * 64 + tid] = __expf(cum[cend * 65 + tid]);
    __syncthreads();
    const int fr = lane & 15, fq = lane >> 4;
    bf16x8 av[2];
#pragma unroll
    for (int ks = 0; ks < 2; ++ks) av[ks] = *(const LAS bf16x8*)(vT + (wave * 16 + fr) * 72 + ks * 32 + fq * 8);
    bf16* st = st_ptr(a, seq, n);
#pragma unroll
    for (int nt = 0; nt < 4; ++nt) { f32x4 acc = {0.f, 0.f, 0.f, 0.f};
#pragma unroll
        for (int ks = 0; ks < 2; ++ks) { const bf16x8 bk = *(const LAS bf16x8*)(kdT + (nt * 16 + fr) * 72 + ks * 32 + fq * 8); acc = MFMA16(bk, av[ks], acc); }
        u32x2 w; w.x = pk2(acc[0], acc[1]); w.y = pk2(acc[2], acc[3]);
        *(u32x2*)(st + (wave * 16 + fr) * 64 + nt * 16 + fq * 4) = w; }
    __syncthreads();
}
DI void gla_scan(const Args& a, int tid) {
    const float* DEC = (const float*)(a.ws + WS_DEC);
    for (int e2 = blockIdx.x * NTHR + tid; e2 < 32 * 4096; e2 += gridDim.x * NTHR) {
        const int seq = e2 >> 12, el = (e2 & 4095) * 2, dk = el & 63, dir = seq & 1;
        float S0 = 0.f, S1 = 0.f;
        for (int s4 = 0; s4 < NCHUNK; s4 += 4) {
            unsigned* p[4]; unsigned t[4]; float d0[4], d1[4];
#pragma unroll
            for (int i = 0; i < 4; ++i) { const int step = s4 + i; const int n = dir == 0 ? (step < 4 ? 64 + step : step - 4) : 67 - step;
                p[i] = (unsigned*)(st_ptr(a, seq, n) + el); t[i] = *p[i];
                const float* dp = DEC + (size_t)(seq * NCHUNK + n) * 64 + dk; d0[i] = dp[0]; d1[i] = dp[1]; }
#pragma unroll
            for (int i = 0; i < 4; ++i) { *p[i] = pk2(S0, S1); S0 = d0[i] * S0 + __uint_as_float(t[i] << 16); S1 = d1[i] * S1 + __uint_as_float(t[i] & 0xffff0000u); }
        }
    }
}
DI void gla_g3_unit(const Args& a, LAS unsigned char* lds, int unit, int tid, int lane, int wave) {
    const bf16* P = (const bf16*)(a.ws + WS_P); bf16* O = (bf16*)(a.ws + WS_HO);
    const int n = unit % NCHUNK, bh = unit / NCHUNK, h = bh & 3, b = bh >> 2;
    const size_t row0 = chunk_row0(b, n);
    LAS float* cum = (LAS float*)(lds + L_CUM); LAS unsigned short* qg = (LAS unsigned short*)(lds + L_A); LAS unsigned short* kg = (LAS unsigned short*)(lds + L_B);
    LAS unsigned short* att = (LAS unsigned short*)(lds + L_ATT); LAS unsigned short* vT = (LAS unsigned short*)(lds + L_VT); LAS float* ssq = (LAS float*)(lds + L_SSQ);
    const int fr = lane & 15, fq = lane >> 4, ct = wave & 3, dvh = wave >> 2;
    gla_load_vt(lds, P, row0, h, tid);
    f32x4 acc[4];
#pragma unroll
    for (int nt = 0; nt < 4; ++nt) acc[nt] = (f32x4){0.f, 0.f, 0.f, 0.f};
    const bf16x8 qraw = *(const bf16x8*)(P + (row0 + (tid >> 3)) * LDP0 + C_BQ + h * 64 + (tid & 7) * 8), kraw = *(const bf16x8*)(P + (row0 + (tid >> 3)) * LDP0 + C_BK + h * 64 + (tid & 7) * 8);
    for (int dir = 0; dir < 2; ++dir) {
        const float* cp = cum_ptr(a, dir, bh, n) + (tid >> 3) * 64 + (tid & 7) * 8;
        const f32x4 c0 = *(const f32x4*)cp, c1 = *(const f32x4*)(cp + 4);
        const bf16* st = st_ptr(a, (bh * 2 + dir), n);
        bf16x8 sraw[4][2];
#pragma unroll
        for (int nt = 0; nt < 4; ++nt)
#pragma unroll
            for (int ks = 0; ks < 2; ++ks) sraw[nt][ks] = *(const bf16x8*)(st + ((dvh * 4 + nt) * 16 + fr) * 64 + ks * 32 + fq * 8);
        { const int c = tid >> 3, dg = tid & 7; float qq[8], kk[8], oq[8], ok[8];
          const float cu8[8] = {c0[0], c0[1], c0[2], c0[3], c1[0], c1[1], c1[2], c1[3]};
          unpack8(qraw, qq); unpack8(kraw, kk);
#pragma unroll
          for (int dd = 0; dd < 8; ++dd) { const float cu = cu8[dd]; oq[dd] = qq[dd] * 0.125f * __expf(cu); ok[dd] = kk[dd] * __expf(-cu); }
          *(LAS bf16x8*)(qg + c * 72 + dg * 8) = pack8(oq); *(LAS bf16x8*)(kg + c * 72 + dg * 8) = pack8(ok); }
        __syncthreads();
        bf16x8 bq[2];
#pragma unroll
        for (int ks = 0; ks < 2; ++ks) bq[ks] = *(const LAS bf16x8*)(qg + (ct * 16 + fr) * 72 + ks * 32 + fq * 8);
#pragma unroll
        for (int si = 0; si < 2; ++si) { const int st = dvh * 2 + si; f32x4 s = {0.f, 0.f, 0.f, 0.f};
#pragma unroll
            for (int ks = 0; ks < 2; ++ks) { const bf16x8 ak = *(const LAS bf16x8*)(kg + (st * 16 + fr) * 72 + ks * 32 + fq * 8); s = MFMA16(ak, bq[ks], s); }
            const int cpos = ct * 16 + fr; float pv[4];
#pragma unroll
            for (int r = 0; r < 4; ++r) { const int spos = st * 16 + fq * 4 + r; const bool keep = dir == 0 ? (spos <= cpos) : (spos >= cpos); pv[r] = keep ? s[r] : 0.f; }
            u32x2 w; w.x = pk2(pv[0], pv[1]); w.y = pk2(pv[2], pv[3]);
            *(LAS u32x2*)(att + cpos * 72 + st * 16 + fq * 4) = w; }
        __syncthreads();
        bf16x8 ba[2];
#pragma unroll
        for (int ks = 0; ks < 2; ++ks) ba[ks] = *(const LAS bf16x8*)(att + (ct * 16 + fr) * 72 + ks * 32 + fq * 8);
#pragma unroll
        for (int nt = 0; nt < 4; ++nt) { const int dvt = dvh * 4 + nt;
#pragma unroll
            for (int ks = 0; ks < 2; ++ks) {
                const bf16x8 av = *(const LAS bf16x8*)(vT + (dvt * 16 + fr) * 72 + ks * 32 + fq * 8);
                acc[nt] = MFMA16(av, ba[ks], acc[nt]);
                acc[nt] = MFMA16(sraw[nt][ks], bq[ks], acc[nt]); } }
        __syncthreads();
    }
    float sq = 0.f;
#pragma unroll
    for (int nt = 0; nt < 4; ++nt) sq += (acc[nt][0] * acc[nt][0] + acc[nt][1] * acc[nt][1]) + (acc[nt][2] * acc[nt][2] + acc[nt][3] * acc[nt][3]);
    sq += __shfl_xor(sq, 16); sq += __shfl_xor(sq, 32);
    if (fq == 0) ssq[wave * 16 + fr] = sq;
    __syncthreads();
    const float tot = ssq[wave * 16 + fr] + ssq[(wave ^ 4) * 16 + fr];
    const float rstd = __builtin_amdgcn_rsqf(tot * (1.0f / 128.0f) + EPS);
    const size_t row = row0 + ct * 16 + fr;
#pragma unroll
    for (int nt = 0; nt < 4; ++nt) { const int dv0 = (dvh * 4 + nt) * 16 + fq * 4;
        const f32x4 g4 = *(const f32x4*)(a.in[I_GNORM] + h * 128 + dv0);
        const u32x2 bw = *(const u32x2*)(P + row * LDP0 + C_BO + h * 128 + dv0);
        const float g0 = __uint_as_float(bw.x << 16), g1 = __uint_as_float(bw.x & 0xffff0000u), g2 = __uint_as_float(bw.y << 16), g3 = __uint_as_float(bw.y & 0xffff0000u);
        u32x2 w; w.x = pk2(acc[nt][0] * rstd * g4[0] * silu_f(g0), acc[nt][1] * rstd * g4[1] * silu_f(g1));
        w.y = pk2(acc[nt][2] * rstd * g4[2] * silu_f(g2), acc[nt][3] * rstd * g4[3] * silu_f(g3));
        *(u32x2*)(O + row * D + 512 + h * 128 + dv0) = w; }
    __syncthreads();
}

DI void rope_row(bf16* prow, int t, int lane) {
    const int prow_pos = t >> 6, pcol_pos = t & 63;
#pragma unroll
    for (int i = 0; i < 5; ++i) { const int pi = lane + 64 * i, head = pi >> 5, rem = pi & 31, half = rem >> 4, j = rem & 15;
        const int c1 = head * 64 + half * 32 + j, pos = half ? pcol_pos : prow_pos;
        const float cs = ROPE_COS[pos * 16 + j], sn = ROPE_SIN[pos * 16 + j];
        const float u1 = bf2f(prow[c1]), u2 = bf2f(prow[c1 + 16]);
        prow[c1] = (unsigned short)(pk2(u1 * cs - u2 * sn, 0.f) & 0xffffu); prow[c1 + 16] = (unsigned short)(pk2(u2 * cs + u1 * sn, 0.f) & 0xffffu); }
}

constexpr int NPHASE = 19;
#ifndef NA_NR
#define NA_NR 2
#endif
#ifndef PROBE_MASK
#define PROBE_MASK 0u
#endif
#define REPS(k) (((PROBE_MASK >> (k)) & 1u) ? 2 : 1)
__global__ void __launch_bounds__(NTHR, 2) fwd_kernel(Args a) {
    extern __shared__ __attribute__((aligned(16))) unsigned char lds_raw[];
    LAS unsigned char* lds = (LAS unsigned char*)lds_raw;
    const int tid = threadIdx.x, lane = tid & 63, wave = __builtin_amdgcn_readfirstlane(tid >> 6);
    const int G = gridDim.x, gw = blockIdx.x * NWAVES + wave, NGW = G * NWAVES;
    unsigned char* ws = a.ws;
    const int lo = a.ph_lo, hi = a.ph_hi;
#define IN(k) (lo <= (k) && (k) < hi)
#ifndef PROBE_SYNC
#define PROBE_SYNC 1
#endif
    volatile LAS unsigned* MISC = (volatile LAS unsigned*)(lds + 131072 + 320);
    if (tid < 32) MISC[tid] = 0u;
    __syncthreads();
    unsigned* barw = (unsigned*)(ws + WS_CTL);
    XcdBarrier xbar; xbar.bar = barw; xbar.x = 0; xbar.st = MISC + 8;
    if (hi - lo > 1) {
        if (blockIdx.x == 0) { for (int i = tid; i < XCD_BAR_WORDS; i += NTHR) barw[i] = 0u; }
        cg::this_grid().sync();
        xbar = xcd_barrier_post(barw, MISC + 8);
    }
#define SEAM(k) do { if (IN(k) && IN((k) + 1)) { for (int sr_ = 0; sr_ < PROBE_SYNC; ++sr_) xcd_barrier(xbar); } } while (0)
    bf16* H = (bf16*)(ws + WS_HO); bf16* YF = (bf16*)(ws + WS_YF); bf16* P = (bf16*)(ws + WS_P);

    if (IN(0)) { for (int rep = 0; rep < REPS(0); ++rep) { phase_prologue(a, lds, tid, lane, wave); __syncthreads(); } } SEAM(0);
    if (IN(1)) { for (int rep = 0; rep < REPS(1); ++rep) phase_rows(a, 0, 0, lane, wave); } SEAM(1);
    if (IN(2)) { pg8::Gemm g{H, (const bf16*)(ws + WS_WABI), MT, LDP0, D, D}; pg8::StaticOrder S; S.init(MT, LDP0, G, (int)blockIdx.x);
        EpiStore E{P, LDP0}; pg8::gemm_phase<EpiStore, pg8::StaticOrder, true, true>(lds, g, S, E); if (REPS(2) > 1) { pg8::gemm_phase<EpiStore, pg8::StaticOrder, true, true>(lds, g, S, E); } } SEAM(2);
    if (IN(3)) {
        for (int rep = 0; rep < REPS(3); ++rep) for (int u = blockIdx.x; u < 32 * NCHUNK; u += G) gla_g1_unit(a, lds, u, tid, lane, wave);
        __syncthreads();
        for (int m = gw; m < NLAT; m += NGW) rope_row(P + (size_t)m * LDP0, m & 4095, lane);
        for (int u = gw; u < NBATCH * 2 * 68; u += NGW) vt_unit(P, LDP0, C_AV, 2, (bf16*)(ws + WS_VTA), u, lds + wave * 16384, lane);
    } SEAM(3);
    if (IN(4)) {
        for (int rep = 0; rep < REPS(4); ++rep) for (int wt = gw; wt < 2176; wt += NGW) window_attn_tile(a, wt, lane);
        gla_scan(a, tid);
    } SEAM(4);
    if (IN(5)) { for (int rep = 0; rep < REPS(5); ++rep) for (int u = blockIdx.x; u < 16 * NCHUNK; u += G) gla_g3_unit(a, lds, u, tid, lane, wave); } SEAM(5);
    if (IN(6)) { pg8::Gemm g{H, (const bf16*)(ws + WS_WABO), NLAT, D, D, D}; pg8::StaticOrder S; S.init(NLAT, D, G, (int)blockIdx.x);
        EpiStore E{YF, D}; pg8::gemm_phase<EpiStore, pg8::StaticOrder, true, true>(lds, g, S, E); if (REPS(6) > 1) { pg8::gemm_phase<EpiStore, pg8::StaticOrder, true, true>(lds, g, S, E); }
        { const int bx = (int)blockIdx.x, kc = bx >> 4, uu = bx & 15; OneUnit S1{uu >> 2, uu & 3, bx < 64};
          pg8::Gemm g1{H + (size_t)NLAT * D + kc * 256, (const bf16*)(ws + WS_WABO) + kc * 256, NCTX, D, D, 256};
          EpiStore E1{(bf16*)(ws + WS_PART) + (size_t)kc * NCTX * D, D}; pg8::gemm_phase<EpiStore, OneUnit, true, true>(lds, g1, S1, E1); } } SEAM(6);
    if (IN(7)) { for (int rep = 0; rep < REPS(7); ++rep) phase_rows(a, 1, 0, lane, wave); } SEAM(7);
    if (IN(8)) { pg8::Gemm g{H, (const bf16*)(ws + WS_WFI), MT, 2 * FF, D, D}; pg8::StaticOrder S; S.init(MT, 2 * FF, G, (int)blockIdx.x);
        EpiSwiglu E{P, FF}; pg8::gemm_phase<EpiSwiglu, pg8::StaticOrder, true, true>(lds, g, S, E); if (REPS(8) > 1) { pg8::gemm_phase<EpiSwiglu, pg8::StaticOrder, true, true>(lds, g, S, E); } } SEAM(8);
    if (IN(9)) { pg8::Gemm g{P, (const bf16*)(ws + WS_WFO), NLAT, D, FF, FF}; pg8::StaticOrder S; S.init(NLAT, D, G, (int)blockIdx.x);
        EpiStore E{YF, D}; pg8::gemm_phase<EpiStore, pg8::StaticOrder, true, true>(lds, g, S, E); if (REPS(9) > 1) { pg8::gemm_phase<EpiStore, pg8::StaticOrder, true, true>(lds, g, S, E); }
        { const int bx = (int)blockIdx.x, kc = bx >> 4, uu = bx & 15; OneUnit S1{uu >> 2, uu & 3, bx < 176};
          pg8::Gemm g1{P + (size_t)NLAT * FF + kc * 256, (const bf16*)(ws + WS_WFO) + kc * 256, NCTX, D, FF, 256};
          EpiStore E1{(bf16*)(ws + WS_PART) + (size_t)kc * NCTX * D, D}; pg8::gemm_phase<EpiStore, OneUnit, true, true>(lds, g1, S1, E1); } } SEAM(9);
    if (IN(10)) { phase_rows(a, 2, 0, lane, wave); } SEAM(10);
    if (IN(11)) { pg8::Gemm g{H, (const bf16*)(ws + WS_WNI), MT, LDP1, D, D}; pg8::StaticOrder S; S.init(MT, LDP1, G, (int)blockIdx.x);
        EpiStore E{P, LDP1}; pg8::gemm_phase<EpiStore, pg8::StaticOrder, true, true>(lds, g, S, E); if (REPS(11) > 1) { pg8::gemm_phase<EpiStore, pg8::StaticOrder, true, true>(lds, g, S, E); } } SEAM(11);
    if (IN(13)) { for (int rep = 0; rep < REPS(13); ++rep) for (int u = blockIdx.x; u < 1024; u += G) na_attn_unit(a, lds, u, tid, lane, wave); } SEAM(13);
    if (IN(14)) { pg8::Gemm g{H, (const bf16*)(ws + WS_WNO), NLAT, D, D, D}; pg8::StaticOrder S; S.init(NLAT, D, G, (int)blockIdx.x);
        EpiStore E{YF, D}; pg8::gemm_phase<EpiStore, pg8::StaticOrder, true, true>(lds, g, S, E); if (REPS(14) > 1) { pg8::gemm_phase<EpiStore, pg8::StaticOrder, true, true>(lds, g, S, E); } } SEAM(14);
    if (IN(15)) { phase_rows(a, 1, 1, lane, wave); } SEAM(15);
    if (IN(16)) { pg8::Gemm g{H, (const bf16*)(ws + WS_WFI) + (size_t)5632 * 1024, NLAT, 2 * FF, D, D}; pg8::StaticOrder S; S.init(NLAT, 2 * FF, G, (int)blockIdx.x);
        EpiSwiglu E{P, FF}; pg8::gemm_phase<EpiSwiglu, pg8::StaticOrder, true, true>(lds, g, S, E); if (REPS(16) > 1) { pg8::gemm_phase<EpiSwiglu, pg8::StaticOrder, true, true>(lds, g, S, E); } } SEAM(16);
    if (IN(17)) { pg8::Gemm g{P, (const bf16*)(ws + WS_WFO) + (size_t)1024 * FF, NLAT, D, FF, FF}; pg8::StaticOrder S; S.init(NLAT, D, G, (int)blockIdx.x);
        EpiStore E{YF, D}; pg8::gemm_phase<EpiStore, pg8::StaticOrder, true, true>(lds, g, S, E); if (REPS(17) > 1) { pg8::gemm_phase<EpiStore, pg8::StaticOrder, true, true>(lds, g, S, E); } } SEAM(17);
    if (IN(18)) { phase_rows(a, 2, 1, lane, wave); }
#undef IN
#undef SEAM
}

extern "C" void kernel_launch(void* const* d_in, const int* in_sizes, int n_in, void* d_out, int out_size, void* d_ws, size_t ws_size, hipStream_t stream) {
    static int grid = 0;
    if (grid == 0) {
        if (n_in != 23 || out_size != NLAT * D || ws_size < WS_END) { fprintf(stderr, "kernel_launch: unexpected problem shape (n_in %d, out %d, ws %zu)\n", n_in, out_size, ws_size); grid = -1; return; }
        int dev = 0, cus = 0, per_cu = 0;
        (void)hipGetDevice(&dev); (void)hipDeviceGetAttribute(&cus, hipDeviceAttributeMultiprocessorCount, dev);
        if (hipFuncSetAttribute((const void*)fwd_kernel, hipFuncAttributeMaxDynamicSharedMemorySize, LDS_BYTES) != hipSuccess) { fprintf(stderr, "kernel_launch: hipFuncSetAttribute failed\n"); grid = -1; return; }
        (void)hipOccupancyMaxActiveBlocksPerMultiprocessor(&per_cu, (const void*)fwd_kernel, NTHR, LDS_BYTES);
        if (per_cu < 1) per_cu = 1;
        (void)hipGetLastError();
        grid = cus * per_cu;
    }
    if (grid < 0) return;
    Args a{};
    for (int i = 0; i < 23; ++i) a.in[i] = (const float*)d_in[i];
    a.out = (float*)d_out; a.ws = (unsigned char*)d_ws;
#if COOP
    a.ph_lo = 0; a.ph_hi = NPHASE;
    void* args[] = {&a};
    hipError_t e = hipLaunchCooperativeKernel((const void*)fwd_kernel, dim3(grid), dim3(NTHR), args, LDS_BYTES, stream);
    if (e != hipSuccess) fprintf(stderr, "cooperative launch failed: %s (grid %d)\n", hipGetErrorString(e), grid);
#else
    for (int p = 0; p < NPHASE; ++p) { a.ph_lo = p; a.ph_hi = p + 1; hipLaunchKernelGGL(fwd_kernel, dim3(grid), dim3(NTHR), LDS_BYTES, stream, a); }
#endif
}
```

```cpp
#include <hip/hip_runtime.h>
#include <hip/hip_cooperative_groups.h>
#include <cstdio>
#include <cstdint>
namespace cg = cooperative_groups;
namespace pg8 {
#define PG8_LAS __attribute__((address_space(3)))
typedef unsigned short bf16_t;
typedef short bf16x8 __attribute__((ext_vector_type(8)));
typedef float f32x4 __attribute__((ext_vector_type(4)));
typedef unsigned u32x4 __attribute__((ext_vector_type(4)));
constexpr int BM = 256, BK = 64, HALF = 128, HTB = HALF * BK * 2  , STAGE_BYTES = 8 * HTB, NXCD = 8, WGM = 8;

__host__ __device__ __forceinline__ int lds_byte(int r, int c) { const int st = (r >> 4) * 2 + (c >> 5), rr = r & 15, cc = c & 31, ob = rr * 64 + cc * 2; return st * 1024 + (ob ^ (((ob >> 9) & 1) << 5)); }
__host__ __device__ __forceinline__ void stage_rc(int b, int& R, int& C) { const int st = b / 1024, sb = b % 1024, swz = sb ^ (((sb >> 9) & 1) << 5); R = (st >> 1) * 16 + swz / 64; C = (st & 1) * 32 + (swz % 64) / 2; }
__host__ __device__ __forceinline__ int perm32(int rho) { const int n = rho >> 4, i = rho & 15; return 8 * (i >> 2) + 4 * n + (i & 3); }

struct Unit { int pm, pn; };
struct Gemm { const bf16_t* A; const bf16_t* Bt; int M, N, K, Kext; };

struct StaticOrder {
    int nM, nN, nwg, G, c;
    __host__ __device__ void init(int M, int N, int G_, int c_) { nM = M / BM; nN = N / BM; nwg = nM * nN; G = G_; c = c_; }
    __host__ __device__ bool next(int i, Unit& u) const {
        const long L = (long)i * G + c; if (L >= nwg) return false;
        int wgid = (int)L; { const int q = nwg / NXCD, r = nwg % NXCD, xcd = wgid % NXCD, off = wgid / NXCD; wgid = (xcd < r ? xcd * (q + 1) : r * (q + 1) + (xcd - r) * q) + off; }
        const int nig = WGM * nN, gid = wgid / nig, fm = gid * WGM, gsz = (nM - fm) < WGM ? (nM - fm) : WGM;
        u.pm = fm + ((wgid % nig) % gsz); u.pn = (wgid % nig) / gsz; return true;
    }
    __device__ __forceinline__ void a_ready(const Unit&) const {}
    __device__ __forceinline__ void done(const Unit&) const {}
};

__device__ __forceinline__ unsigned cvt_pk_bf16(float lo, float hi) { unsigned r; asm volatile("v_cvt_pk_bf16_f32 %0, %1, %2" : "=v"(r) : "v"(lo), "v"(hi)); return r; }
template <class Epi, class Sched, bool ALIGN_EPI = false, bool SP2 = false>
__device__ __forceinline__ void gemm_phase(PG8_LAS unsigned char* lds, const Gemm g, const Sched& S, const Epi& E) {
    const int tid = threadIdx.x, wid = __builtin_amdgcn_readfirstlane(tid >> 6), lane = tid & 63, wr = wid >> 2, wc = wid & 3, fr = lane & 15, fq = lane >> 4;
    const int K = g.K, nt = g.Kext / BK;
    unsigned voffA[2], voffB[2];
#pragma unroll
    for (int i = 0; i < 2; ++i) { int R, C; stage_rc(tid * 16 + i * 8192, R, C); const int Rb = Epi::PERM ? ((R & ~31) + perm32(R & 31)) : R;
        voffA[i] = (unsigned)(R * K + C) * 2u; voffB[i] = (unsigned)(Rb * K + C) * 2u; }
    const size_t kstep = (size_t)(BK * 2);
    const size_t hstep = (size_t)HALF * K * 2;
    const size_t tstep = 2 * hstep;
    const unsigned ldsw = (unsigned)wid * 1024u;
    const int aoff = lds_byte(wr * 64 + fr, fq * 8), boff = lds_byte(wc * 32 + fr, fq * 8);
#define PG8_SA(b, h) (((b) * 2 + (h)) * HTB)
#define PG8_SB(b, h) ((4 + (b) * 2 + (h)) * HTB)
#define PG8_STAGE(bufoff, gbase, voff) do { _Pragma("unroll") for (int _i = 0; _i < 2; ++_i) \
        __builtin_amdgcn_global_load_lds((const unsigned*)((const char*)(gbase) + (voff)[_i]), (PG8_LAS unsigned*)(lds + (bufoff) + ldsw + _i * 8192), 16, 0, 0); } while (0)
#define PG8_LDA(dst, b, h) do { _Pragma("unroll") for (int m = 0; m < 4; ++m) _Pragma("unroll") for (int k = 0; k < 2; ++k) dst[m][k] = *(const PG8_LAS bf16x8*)(lds + PG8_SA(b, h) + aoff + m * 2048 + k * 1024); } while (0)
#define PG8_LDB(dst, b, h) do { _Pragma("unroll") for (int n = 0; n < 2; ++n) _Pragma("unroll") for (int k = 0; k < 2; ++k) dst[n][k] = *(const PG8_LAS bf16x8*)(lds + PG8_SB(b, h) + boff + n * 2048 + k * 1024); } while (0)
#define PG8_MMA(ai, bj, At, Bt) do { __builtin_amdgcn_s_setprio(1); _Pragma("unroll") for (int m = 0; m < 4; ++m) _Pragma("unroll") for (int n = 0; n < 2; ++n) _Pragma("unroll") for (int k = 0; k < 2; ++k) \
        acc[ai][bj][m][n] = __builtin_amdgcn_mfma_f32_16x16x32_bf16(Bt[n][k], At[m][k], acc[ai][bj][m][n], 0, 0, 0); __builtin_amdgcn_s_setprio(0); } while (0)
#define PG8_WAIT_V(n) asm volatile("s_waitcnt vmcnt(" #n ")" ::: "memory")
#define PG8_WAIT_L(n) asm volatile("s_waitcnt lgkmcnt(" #n ")" ::: "memory")
#define PG8_BAR __builtin_amdgcn_s_barrier()
#define PG8_SCHED __builtin_amdgcn_sched_barrier(0)
    Unit cur, nxt; int ui = 0;
    if (!S.next(0, cur)) return;
    f32x4 acc[2][2][4][2];
#pragma unroll
    for (int a = 0; a < 2; ++a)
#pragma unroll
        for (int b = 0; b < 2; ++b)
#pragma unroll
            for (int m = 0; m < 4; ++m)
#pragma unroll
                for (int n = 0; n < 2; ++n) acc[a][b][m][n] = (f32x4){0.f, 0.f, 0.f, 0.f};
    bf16x8 At[4][2], B0[2][2], B1[2][2];
    const char* cA = (const char*)g.A + (size_t)cur.pm * tstep; const char* cB = (const char*)g.Bt + (size_t)cur.pn * tstep;
    S.a_ready(cur);
    if constexpr (SP2) {
        PG8_STAGE(PG8_SB(0, 0), cB, voffB); PG8_STAGE(PG8_SB(0, 1), cB + hstep, voffB); PG8_STAGE(PG8_SA(0, 0), cA, voffA); PG8_STAGE(PG8_SA(0, 1), cA + hstep, voffA);
        if (wr == 1) PG8_BAR;
        PG8_WAIT_V(2); PG8_BAR;
        PG8_STAGE(PG8_SB(1, 0), cB + kstep, voffB); PG8_STAGE(PG8_SA(1, 0), cA + kstep, voffA); PG8_STAGE(PG8_SB(1, 1), cB + hstep + kstep, voffB);
        PG8_WAIT_V(6); PG8_BAR;
    } else {
        PG8_STAGE(PG8_SB(0, 0), cB, voffB); PG8_STAGE(PG8_SA(0, 0), cA, voffA); PG8_STAGE(PG8_SB(0, 1), cB + hstep, voffB); PG8_STAGE(PG8_SA(0, 1), cA + hstep, voffA);
        if (wr == 1) PG8_BAR;
        PG8_WAIT_V(4); PG8_BAR;
        PG8_STAGE(PG8_SB(1, 0), cB + kstep, voffB); PG8_STAGE(PG8_SA(1, 0), cA + kstep, voffA); PG8_STAGE(PG8_SB(1, 1), cB + hstep + kstep, voffB);
        PG8_WAIT_V(6); PG8_BAR;
    }
    for (;;) {
        const bool has_next = S.next(ui + 1, nxt);
        const char* nA = has_next ? (const char*)g.A + (size_t)nxt.pm * tstep : cA; const char* nB = has_next ? (const char*)g.Bt + (size_t)nxt.pn * tstep : cB;
        for (int t = 0; t < nt; t += 2) {
            const bool last = (t == nt - 2);
            const char* a1 = cA + (size_t)(t + 1) * kstep;
            const char* a2 = last ? nA : cA + (size_t)(t + 2) * kstep; const char* b2 = last ? nB : cB + (size_t)(t + 2) * kstep;
            const char* a3 = a2 + kstep; const char* b3 = b2 + kstep;
            if (last && has_next) S.a_ready(nxt);
            if constexpr (SP2) {
            PG8_LDB(B0, 0, 0); PG8_LDB(B1, 0, 1); PG8_SCHED; PG8_LDA(At, 0, 0); PG8_STAGE(PG8_SA(1, 1), a1 + hstep, voffA);
            PG8_WAIT_V(8); PG8_WAIT_L(0); PG8_BAR; PG8_MMA(0, 0, At, B0); PG8_MMA(0, 1, At, B1); PG8_BAR; PG8_SCHED;
            PG8_LDA(At, 0, 1); PG8_STAGE(PG8_SB(0, 0), b2, voffB); PG8_STAGE(PG8_SB(0, 1), b2 + hstep, voffB); PG8_STAGE(PG8_SA(0, 0), a2, voffA);
            PG8_WAIT_V(8); PG8_WAIT_L(0); PG8_BAR; PG8_MMA(1, 0, At, B0); PG8_MMA(1, 1, At, B1); PG8_BAR; PG8_SCHED;
            PG8_LDB(B0, 1, 0); PG8_LDB(B1, 1, 1); PG8_SCHED; PG8_LDA(At, 1, 0); PG8_STAGE(PG8_SA(0, 1), a2 + hstep, voffA);
            PG8_WAIT_V(8); PG8_WAIT_L(0); PG8_BAR; PG8_MMA(0, 0, At, B0); PG8_MMA(0, 1, At, B1); PG8_BAR; PG8_SCHED;
            PG8_LDA(At, 1, 1); PG8_STAGE(PG8_SB(1, 0), b3, voffB); PG8_STAGE(PG8_SB(1, 1), b3 + hstep, voffB); PG8_STAGE(PG8_SA(1, 0), a3, voffA);
            PG8_WAIT_V(8); PG8_WAIT_L(0); PG8_BAR; PG8_MMA(1, 0, At, B0); PG8_MMA(1, 1, At, B1); PG8_BAR; PG8_SCHED;
            } else {
            PG8_LDB(B0, 0, 0); PG8_SCHED; PG8_LDA(At, 0, 0); PG8_STAGE(PG8_SA(1, 1), a1 + hstep, voffA);
            PG8_WAIT_L(8); PG8_BAR; PG8_WAIT_L(0); PG8_MMA(0, 0, At, B0); PG8_BAR; PG8_SCHED;
            PG8_LDB(B1, 0, 1); PG8_STAGE(PG8_SB(0, 0), b2, voffB);
            PG8_BAR; PG8_WAIT_L(0); PG8_MMA(0, 1, At, B1); PG8_BAR;
            PG8_LDA(At, 0, 1); PG8_STAGE(PG8_SA(0, 0), a2, voffA);
            PG8_BAR; PG8_WAIT_L(0); PG8_MMA(1, 0, At, B0); PG8_BAR; PG8_SCHED;
            PG8_STAGE(PG8_SB(0, 1), b2 + hstep, voffB);
            PG8_WAIT_V(6); PG8_BAR; PG8_MMA(1, 1, At, B1); PG8_BAR;
            PG8_LDB(B0, 1, 0); PG8_SCHED; PG8_LDA(At, 1, 0); PG8_STAGE(PG8_SA(0, 1), a2 + hstep, voffA);
            PG8_WAIT_L(8); PG8_BAR; PG8_WAIT_L(0); PG8_MMA(0, 0, At, B0); PG8_BAR; PG8_SCHED;
            PG8_LDB(B1, 1, 1); PG8_STAGE(PG8_SB(1, 0), b3, voffB);
            PG8_BAR; PG8_WAIT_L(0); PG8_MMA(0, 1, At, B1); PG8_BAR;
            PG8_LDA(At, 1, 1); PG8_STAGE(PG8_SA(1, 0), a3, voffA);
            PG8_BAR; PG8_WAIT_L(0); PG8_MMA(1, 0, At, B0); PG8_BAR; PG8_SCHED;
            PG8_STAGE(PG8_SB(1, 1), b3 + hstep, voffB);
            PG8_WAIT_V(6); PG8_BAR; PG8_MMA(1, 1, At, B1); PG8_BAR;
            }
        }
        if constexpr (ALIGN_EPI) { if (wr == 0) PG8_BAR; }
        if constexpr (!Epi::AFTER_DRAIN) { E(acc, cur, wr, wc, fr, fq); S.done(cur); }
        if (!has_next) break;
#pragma unroll
        for (int a = 0; a < 2; ++a)
#pragma unroll
            for (int b = 0; b < 2; ++b)
#pragma unroll
                for (int m = 0; m < 4; ++m)
#pragma unroll
                    for (int n = 0; n < 2; ++n) acc[a][b][m][n] = (f32x4){0.f, 0.f, 0.f, 0.f};
        cur = nxt; cA = nA; cB = nB; ++ui;
        if constexpr (ALIGN_EPI) { if (wr == 1) PG8_BAR; }
    }
    PG8_WAIT_V(0);
    if constexpr (!ALIGN_EPI) { if (wr == 0) PG8_BAR; }
    PG8_BAR;
    if constexpr (Epi::AFTER_DRAIN) { E.fused(acc, cur, wr, wc, fr, fq, lds, wid, lane); S.done(cur); }
#undef PG8_SA
#undef PG8_SB
#undef PG8_STAGE
#undef PG8_LDA
#undef PG8_LDB
#undef PG8_MMA
#undef PG8_WAIT_V
#undef PG8_WAIT_L
#undef PG8_BAR
#undef PG8_SCHED
}
}
__device__ const float ROPE_COS[1024] = {1.f,1.f,1.f,1.f,1.f,1.f,1.f,1.f,1.f,1.f,1.f,1.f,1.f,1.f,1.f,1.f,0.540302277f,0.846009135f,0.950415254f,0.98423022f,0.995004177f,0.998419285f,0.999500036f,0.999841869f,0.999949992f,0.999984205f,0.999994993f,0.999998391f,0.999999523f,0.999999821f,0.99999994f,1.f,-0.416146845f,0.431462824f,0.806578398f,0.937418282f,0.980066597f,0.993682086f,0.998000681f,0.999367595f,0.999800026f,0.999936759f,0.999979973f,0.999993682f,0.999997973f,0.999999344f,0.999999821f,0.99999994f,-0.989992499f,-0.115966164f,0.582753658f,0.861040652f,0.955336511f,0.985803485f,0.995503366f,0.998577297f,0.999550045f,0.999857724f,0.999954998f,0.999985754f,0.99999553f,0.999998569f,0.999999523f,0.999999881f,-0.653643608f,-0.627679706f,0.301137477f,0.757506192f,0.921060979f,0.974808276f,0.992010653f,0.997471273f,0.999200106f,0.999747038f,0.999920011f,0.999974728f,0.999992013f,0.999997497f,0.999999225f,0.999999762f,0.2836622f,-0.946079254f,-0.0103423381f,0.630080283f,0.87758255f,0.960731268f,0.987526f,0.996049762f,0.998750269f,0.999604762f,0.999875009f,0.999960482f,0.999987483f,0.999996066f,0.999998748f,0.999999583f,0.960170269f,-0.973103702f,-0.3207964f,0.482782036f,0.825335622f,0.943616986f,0.982053936f,0.9943133f,0.998200536f,0.999430835f,0.999819994f,0.999943078f,0.999981999f,0.999994338f,0.999998212f,0.999999404f,0.753902256f,-0.700429797f,-0.599437475f,0.320257008f,0.764842212f,0.923519433f,0.975599885f,0.992262423f,0.997551024f,0.999225318f,0.999755025f,0.999922514f,0.999975502f,0.999992251f,0.999997556f,0.999999225f,-0.145500034f,-0.212036446f,-0.818632424f,0.147631213f,0.696706712f,0.900502324f,0.968170285f,0.989897788f,0.996801734f,0.998988271f,0.999680042f,0.999898791f,0.999967992f,0.999989867f,0.999996781f,0.999998987f,-0.91113025f,0.341660261f,-0.956644177f,-0.0296507962f,0.621609926f,0.874638259f,0.959772646f,0.987220109f,0.995952725f,0.998719573f,0.999595046f,0.99987191f,0.999959528f,0.999987185f,0.999995947f,0.999998748f,-0.839071512f,0.790131867f,-0.999786079f,-0.205997631f,0.540302277f,0.846009135f,0.950415313f,0.98423022f,0.995004177f,0.998419285f,0.999500036f,0.999841869f,0.999949992f,0.999984205f,0.999994993f,0.999998391f,0.00442569796f,0.995257378f,-0.943779767f,-0.375847399f,0.453596085f,0.814705312f,0.940107584f,0.980929136f,0.993956089f,0.998087406f,0.999395072f,0.999808669f,0.999939501f,0.999980867f,0.99999392f,0.999998093f,0.843853951f,0.893861592f,-0.79417938f,-0.53384304f,0.362357706f,0.780825913f,0.92885989f,0.97731787f,0.99280864f,0.997723997f,0.999280095f,0.99977231f,0.999927998f,0.999977231f,0.999992788f,0.999997735f,0.907446802f,0.517172873f,-0.565820515f,-0.675001681f,0.267498761f,0.744477987f,0.916683376f,0.973397553f,0.99156189f,0.997329056f,0.999155104f,0.999732792f,0.999915481f,0.999973297f,0.999991536f,0.999997318f,0.136737213f,-0.0187961515f,-0.28134948f,-0.794870913f,0.16996716f,0.705776393f,0.903590262f,0.969169438f,0.990216017f,0.996902585f,0.999020159f,0.999690115f,0.99990201f,0.999969006f,0.999990225f,0.999996901f,-0.759687901f,-0.548975468f,0.0310223512f,-0.889670432f,0.070737198f,0.6648435f,0.889593601f,0.964634836f,0.988771081f,0.996444523f,0.998875201f,0.999644279f,0.999887526f,0.999964416f,0.999988735f,0.999996424f,-0.957659483f,-0.910081089f,0.340318173f,-0.95641005f,-0.0291995462f,0.621808827f,0.87470746f,0.959795177f,0.987227261f,0.99595499f,0.998720288f,0.999595284f,0.999872029f,0.999959528f,0.999987185f,0.999995947f,-0.275163352f,-0.990897954f,0.615864813f,-0.99298501f,-0.128844544f,0.576808274f,0.858946681f,0.954652011f,0.985584795f,0.995433986f,0.998555362f,0.999543071f,0.999855518f,0.999954283f,0.999985576f,0.99999541f,0.660316706f,-0.766536534f,0.830336154f,-0.998241663f,-0.227202162f,0.529984176f,0.842327058f,0.949207008f,0.983843684f,0.994881511f,0.998380423f,0.999487758f,0.999837995f,0.9999488f,0.999983788f,0.999994874f,0.988704622f,-0.306095392f,0.962463796f,-0.972014248f,-0.323289543f,0.481484592f,0.824865162f,0.943461835f,0.982004225f,0.994297504f,0.998195529f,0.999429286f,0.999819517f,0.999942899f,0.99998194f,0.999994278f,0.408082068f,0.248616725f,0.999144375f,-0.91512996f,-0.416146845f,0.431462824f,0.806578457f,0.937418282f,0.980066597f,0.993682086f,0.998000681f,0.999367595f,0.999800026f,0.999936759f,0.999979973f,0.999993682f,-0.547729254f,0.726760268f,0.936740458f,-0.829382956f,-0.504846215f,0.380077004f,0.787485182f,0.931078374f,0.97803092f,0.993035257f,0.99779582f,0.999302804f,0.999779522f,0.999930263f,0.999977946f,0.999993026f,-0.99996084f,0.981074572f,0.781440377f,-0.717477441f,-0.588501155f,0.327489585f,0.767604589f,0.92444396f,0.975897431f,0.992357016f,0.997581005f,0.999234855f,0.999758005f,0.999923468f,0.999975801f,0.999992371f,-0.53283304f,0.933235765f,0.548645258f,-0.582943261f,-0.666275978f,0.273866832f,0.746956408f,0.917517304f,0.97366637f,0.991647422f,0.997356176f,0.999163687f,0.999735534f,0.999916375f,0.999973536f,0.999991655f,0.424179018f,0.597977161f,0.261441678f,-0.430023283f,-0.737393796f,0.219378278f,0.725561321f,0.910300434f,0.971337974f,0.990906477f,0.997121394f,0.99908942f,0.99971199f,0.999908924f,0.999971211f,0.99999088f,0.991202831f,0.078552261f,-0.0516893305f,-0.263540596f,-0.801143587f,0.164196163f,0.703440726f,0.902795732f,0.968912423f,0.99013412f,0.996876657f,0.999011934f,0.999687493f,0.999901175f,0.999968767f,0.999990106f,0.64691931f,-0.465064496f,-0.359694332f,-0.0887455046f,-0.856888831f,0.108494945f,0.680616796f,0.895005584f,0.966389954f,0.98933053f,0.996621907f,0.998931348f,0.999662042f,0.999893129f,0.999966204f,0.999989331f,-0.292138815f,-0.865450621f,-0.632028639f,0.088848114f,-0.904072165f,0.0524506159f,0.6571123f,0.886932373f,0.963770926f,0.988495648f,0.996357203f,0.998847544f,0.999635518f,0.999884725f,0.999963522f,0.999988496f,-0.962605894f,-0.999293387f,-0.841684937f,0.26363951f,-0.942222297f,-0.00375941908f,0.632950664f,0.878578722f,0.961055458f,0.987629473f,0.996082544f,0.998760641f,0.99960804f,0.999876022f,0.99996078f,0.999987602f,-0.748057544f,-0.825371623f,-0.967871487f,0.430115849f,-0.970958173f,-0.0599575676f,0.608156204f,0.869947195f,0.958243906f,0.986732066f,0.995797932f,0.998670578f,0.999579549f,0.999867022f,0.999957979f,0.999986708f,0.154251456f,-0.397251874f,-0.998075247f,0.583026946f,-0.989992499f,-0.115966164f,0.582753658f,0.861040652f,0.955336511f,0.985803485f,0.995503366f,0.998577297f,0.999550045f,0.999857724f,0.999954998f,0.999985754f,0.914742351f,0.153215483f,-0.929300308f,0.717549205f,-0.999135137f,-0.171608135f,0.556768358f,0.851861775f,0.95233357f,0.984843671f,0.995198846f,0.998480916f,0.999519527f,0.999848068f,0.999951959f,0.999984801f,0.83422339f,0.656495154f,-0.768367112f,0.829440355f,-0.998294771f,-0.226707578f,0.53022635f,0.842413545f,0.949235439f,0.983852804f,0.994884372f,0.998381376f,0.999488056f,0.999838114f,0.9999488f,0.999983788f,-0.0132767474f,0.95758605f,-0.531235278f,0.915171385f,-0.987479806f,-0.281090319f,0.503154159f,0.832698941f,0.946042359f,0.982830763f,0.994559944f,0.998278618f,0.999455571f,0.999827802f,0.999945521f,0.999982774f,-0.848570287f,0.963757515f,-0.241421118f,0.972038329f,-0.966798186f,-0.334584385f,0.475578904f,0.822721004f,0.942754686f,0.981777668f,0.994225562f,0.99817276f,0.999422073f,0.999817252f,0.999942183f,0.999981701f,-0.903692186f,0.673110247f,0.0723346695f,0.998247743f,-0.93645668f,-0.387020677f,0.447528064f,0.812482953f,0.939372718f,0.980693519f,0.993881226f,0.998063743f,0.999387562f,0.999806345f,0.999938726f,0.999980628f,-0.127963692f,0.175156534f,0.378916174f,0.992972851f,-0.896758378f,-0.438233554f,0.419029742f,0.801987886f,0.935896814f,0.979578316f,0.993526995f,0.997951567f,0.999352098f,0.999795079f,0.99993521f,0.999979496f,0.765414059f,-0.376742303f,0.647921681f,0.95638001f,-0.848100007f,-0.488060862f,0.39011243f,0.791239262f,0.93232733f,0.978432178f,0.993162811f,0.997836173f,0.99931556f,0.999783576f,0.999931574f,0.999978364f,0.955073655f,-0.812611222f,0.852673113f,0.889623463f,-0.790967762f,-0.536345184f,0.360805035f,0.780240417f,0.928664625f,0.977255106f,0.992788672f,0.997717679f,0.999278069f,0.999771714f,0.999927819f,0.999977171f,0.266642928f,-0.998210371f,0.972865343f,0.794808388f,-0.72593224f,-0.582933903f,0.331136853f,0.768994927f,0.924909055f,0.976047099f,0.99240464f,0.997596025f,0.999239624f,0.999759495f,0.999923944f,0.999975979f,-0.666938066f,-0.87637943f,0.996578991f,0.674925625f,-0.653643608f,-0.627679706f,0.301137596f,0.757506192f,0.921060979f,0.974808276f,0.992010653f,0.997471273f,0.999200106f,0.999747038f,0.999920011f,0.999974728f,-0.987339258f,-0.484639406f,0.921462357f,0.533756077f,-0.574824035f,-0.670441091f,0.270837069f,0.745777905f,0.917120814f,0.973538578f,0.991606772f,0.997343302f,0.999159634f,0.999734223f,0.999915957f,0.999973416f,-0.399985313f,0.0563609414f,0.754965365f,0.375752151f,-0.490260571f,-0.711082935f,0.240265876f,0.733813822f,0.913088918f,0.972238123f,0.991192937f,0.997212172f,0.999118149f,0.99972111f,0.999911785f,0.999972105f,0.555113316f,0.580003142f,0.513598442f,0.205897167f,-0.400799006f,-0.749476731f,0.209454417f,0.721617639f,0.908965766f,0.970906913f,0.990769207f,0.997077882f,0.999075651f,0.999707639f,0.999907553f,0.999970794f,0.999843299f,0.925014675f,0.221298173f,0.0295478199f,-0.307332784f,-0.785501122f,0.178433523f,0.709193349f,0.904751658f,0.969545007f,0.990335584f,0.996940494f,0.99903214f,0.99969393f,0.999903202f,0.999969363f,0.52532196f,0.985138178f,-0.0929481089f,-0.147732988f,-0.210795805f,-0.819042206f,0.147234216f,0.696544766f,0.90044713f,0.968152404f,0.989892066f,0.996799886f,0.998987675f,0.999679863f,0.999898732f,0.999967992f,-0.432177931f,0.741858006f,-0.397976756f,-0.320354372f,-0.112152621f,-0.849993885f,0.115887694f,0.683675885f,0.89605248f,0.966729224f,0.989438653f,0.996656179f,0.998942196f,0.999665439f,0.999894202f,0.999966562f,-0.992335498f,0.270098448f,-0.663538277f,-0.48287195f,-0.0123883775f,-0.878258407f,0.0844252855f,0.670590878f,0.891568303f,0.965275466f,0.988975346f,0.996509314f,0.998895705f,0.999650776f,0.999889553f,0.999965072f,-0.640144348f,-0.284846604f,-0.863296509f,-0.630159974f,0.0874991715f,-0.903746367f,0.0528784581f,0.657293737f,0.886994898f,0.963791192f,0.988502085f,0.996359289f,0.9988482f,0.999635756f,0.999884784f,0.999963582f,0.300592542f,-0.75206399f,-0.977442741f,-0.757573068f,0.18651247f,-0.926377118f,0.0212787576f,0.643788815f,0.882332861f,0.962276459f,0.98801899f,0.996206105f,0.998799741f,0.999620378f,0.999879956f,0.999962032f,0.964965999f,-0.987659097f,-0.994656444f,-0.861092687f,0.2836622f,-0.946079254f,-0.0103422189f,0.630080283f,0.87758255f,0.960731268f,0.987526f,0.996049762f,0.998750269f,0.999604762f,0.999875009f,0.999960482f,0.742154181f,-0.919073522f,-0.913230121f,-0.937454224f,0.377977669f,-0.96279037f,-0.0419528559f,0.616172493f,0.872744501f,0.959155679f,0.987023175f,0.99589026f,0.998699784f,0.999588788f,0.999869943f,0.999958873f,-0.162990779f,-0.567430019f,-0.741239965f,-0.984248459f,0.468516916f,-0.976457715f,-0.0735215396f,0.602069914f,0.86781919f,0.95754981f,0.986510456f,0.995727658f,0.998648286f,0.999572515f,0.999864817f,0.999957263f,-0.918282807f,-0.0410281904f,-0.495741814f,-1.f,0.554374516f,-0.987038016f,-0.105016708f,0.587776959f,0.862807095f,0.955913603f,0.985987842f,0.995561838f,0.998595834f,0.999555886f,0.999859571f,0.999955595f,-0.829309821f,0.498009592f,-0.201079622f,-0.984212041f,0.634692967f,-0.994497895f,-0.136406869f,0.573298037f,0.857708693f,0.954247177f,0.985455394f,0.995392919f,0.998542368f,0.999538958f,0.999854207f,0.999953866f,0.0221267566f,0.883669317f,0.113521777f,-0.937382519f,0.708669782f,-0.998813629f,-0.167660639f,0.558637917f,0.852524519f,0.95255059f,0.984913111f,0.99522084f,0.99848789f,0.999521732f,0.999848783f,0.999952197f,0.853220105f,0.997174621f,0.416867077f,-0.860988438f,0.775565803f,-0.999971747f,-0.198746875f,0.543801069f,0.847255111f,0.950823903f,0.984360933f,0.995045662f,0.998432398f,0.999504209f,0.99984318f,0.999950409f,0.899866819f,0.803569078f,0.678870201f,-0.757439196f,0.834712923f,-0.997968495f,-0.22963427f,0.528792322f,0.841901004f,0.949067116f,0.983798921f,0.994867265f,0.998375952f,0.999486327f,0.999837577f,0.999948621f,0.119180135f,0.362476677f,0.873550534f,-0.63000071f,0.885519624f,-0.99281019f,-0.260292053f,0.513616323f,0.836462677f,0.947280347f,0.983227074f,0.994685769f,0.998318493f,0.999468148f,0.999831796f,0.999946833f,-0.771080196f,-0.1902491f,0.981602073f,-0.482692331f,0.927478492f,-0.984513164f,-0.290689558f,0.498277903f,0.830940723f,0.945463598f,0.982645452f,0.994501114f,0.998260021f,0.99944967f,0.999825954f,0.999944985f,-0.952412963f,-0.684381902f,0.992308319f,-0.320159167f,0.960170269f,-0.973103702f,-0.3207964f,0.482782036f,0.825335622f,0.943616986f,0.982053936f,0.9943133f,0.998200536f,0.999430835f,0.999819994f,0.999943078f,-0.258101642f,-0.967739642f,0.904607594f,-0.1475292f,0.98326844f,-0.958617806f,-0.350582451f,0.467133403f,0.819648027f,0.941740453f,0.981452644f,0.994122326f,0.998140097f,0.999411702f,0.999813974f,0.99994117f,0.673507154f,-0.953050017f,0.727198064f,0.0297537707f,0.996542096f,-0.941101313f,-0.380017966f,0.451337039f,0.813878477f,0.939834237f,0.980841517f,0.993928254f,0.998078644f,0.999392271f,0.999807835f,0.999939203f,0.985896587f,-0.644837022f,0.477671444f,0.206098333f,0.999858618f,-0.920609534f,-0.409073502f,0.435397953f,0.808027506f,0.937898219f,0.980220556f,0.993731022f,0.998016179f,0.999372482f,0.999801576f,0.999937236f};
__device__ const float ROPE_SIN[1024] = {0.f,0.f,0.f,0.f,0.f,0.f,0.f,0.f,0.f,0.f,0.f,0.f,0.f,0.f,0.f,0.f,0.841470957f,0.533168435f,0.310983598f,0.176892191f,0.0998334214f,0.0562044978f,0.0316175036f,0.0177818574f,0.00999983307f,0.00562338345f,0.00316227227f,0.0017782785f,0.000999999931f,0.000562341243f,0.000316227757f,0.00017782794f,0.909297407f,0.902130723f,0.591127098f,0.348205268f,0.198669329f,0.112231314f,0.0632033944f,0.0355580896f,0.0199986659f,0.011246589f,0.00632451288f,0.00355655141f,0.0019999987f,0.00112468237f,0.000632455456f,0.00035565588f,0.141120002f,0.993253171f,0.812648892f,0.5085361f,0.295520216f,0.167903304f,0.0947260857f,0.0533230826f,0.0299954992f,0.0168694388f,0.00948669016f,0.00533481315f,0.0029999956f,0.00168702309f,0.000948683126f,0.000533483806f,-0.756802499f,0.778471708f,0.953580737f,0.652827978f,0.389418334f,0.223044485f,0.126154065f,0.0710712075f,0.0399893336f,0.0224917568f,0.0126487734f,0.00711305765f,0.00399998948f,0.00224936334f,0.00126491068f,0.000711311703f,-0.958924294f,0.32393527f,0.999946535f,0.776529968f,0.47942555f,0.277480543f,0.157455876f,0.0887968615f,0.0499791652f,0.0281133614f,0.0158107281f,0.00889127981f,0.0049999794f,0.0028117029f,0.00158113812f,0.000889139599f,-0.279415488f,-0.230367512f,0.947148204f,0.875740528f,0.564642489f,0.33103931f,0.188600272f,0.106494442f,0.0599640049f,0.0337340795f,0.0189725272f,0.0106694745f,0.0059999642f,0.00337404152f,0.00189736532f,0.00106696738f,0.656986594f,-0.713721275f,0.800421596f,0.947330713f,0.64421767f,0.383551568f,0.219556093f,0.124158338f,0.0699428469f,0.0393537246f,0.0221341345f,0.0124476347f,0.00699994294f,0.00393637875f,0.00221359241f,0.00124479528f,0.989358246f,-0.977261782f,0.574317753f,0.989042461f,0.717356086f,0.434851229f,0.250292331f,0.141782969f,0.0799146891f,0.0449721329f,0.0252955221f,0.0142257558f,0.0079999147f,0.00449871505f,0.00252981926f,0.00142262306f,0.412118495f,-0.939823508f,0.291259229f,0.999560297f,0.783326924f,0.484776139f,0.280778319f,0.159362778f,0.0898785442f,0.0505891182f,0.0284566563f,0.0160038304f,0.00899987947f,0.00506105041f,0.00284604589f,0.00160045072f,-0.54402113f,-0.612936914f,-0.0206835698f,0.978552461f,0.841470957f,0.533168435f,0.310983568f,0.176892191f,0.099833414f,0.0562044978f,0.0316175036f,0.0177818574f,0.009999834f,0.00562338345f,0.00316227227f,0.0017782785f,-0.999990225f,-0.0972764567f,-0.33057496f,0.926681578f,0.891207397f,0.579875171f,0.340877861f,0.19436565f,0.1097783f,0.0618181042f,0.0347780399f,0.0195598267f,0.0109997792f,0.00618571462f,0.00347849843f,0.00195610616f,-0.536572933f,0.448342979f,-0.60768342f,0.845583618f,0.932039082f,0.624748647f,0.370431304f,0.211777672f,0.119712204f,0.0674297586f,0.0379382223f,0.0213377345f,0.0119997123f,0.0067480444f,0.00379472389f,0.00213393359f,0.420167029f,0.855880976f,-0.824528456f,0.737816215f,0.963558197f,0.667647004f,0.399614304f,0.229122713f,0.129634142f,0.0730392784f,0.0410980321f,0.0231155735f,0.0129996343f,0.00731037185f,0.00411094911f,0.00231176103f,0.990607381f,0.999823332f,-0.959605396f,0.606778562f,0.985449731f,0.708434701f,0.428397775f,0.246395305f,0.139543116f,0.078646481f,0.0442574248f,0.0248933397f,0.0139995432f,0.00787269697f,0.00442717411f,0.00248958869f,0.650287867f,0.835838437f,-0.999518692f,0.456603259f,0.997494996f,0.746982634f,0.456752867f,0.263589978f,0.149438128f,0.0842512026f,0.0474163815f,0.0266710296f,0.0149994381f,0.00843502022f,0.00474339863f,0.00266741589f,-0.287903309f,0.414430231f,-0.940310359f,0.292027086f,0.999573588f,0.783169091f,0.484651238f,0.280701309f,0.159318209f,0.0898532644f,0.0505748577f,0.028448632f,0.015999319f,0.00899733976f,0.00505962269f,0.00284524332f,-0.961397469f,-0.134615138f,-0.78785187f,0.11824052f,0.991664827f,0.81687957f,0.512064993f,0.29772386f,0.169182345f,0.09545248f,0.0537328273f,0.0302261449f,0.0169991814f,0.00955965649f,0.00537584582f,0.00302307028f,-0.750987232f,-0.642200708f,-0.557262897f,-0.0592755191f,0.973847628f,0.84800756f,0.538966715f,0.314652264f,0.179029569f,0.101048686f,0.0568902642f,0.0320035629f,0.0179990288f,0.0101219704f,0.00569206895f,0.00320089748f,0.149877205f,-0.952000856f,-0.271410108f,-0.234921798f,0.946300089f,0.876454532f,0.565329552f,0.331481189f,0.188858896f,0.10664168f,0.060047131f,0.0337808803f,0.0189988576f,0.0106842816f,0.00600829115f,0.00337872445f,0.912945271f,-0.968601942f,0.0413582884f,-0.403158993f,0.909297407f,0.902130723f,0.591127038f,0.348205268f,0.198669314f,0.112231314f,0.0632033944f,0.0355580896f,0.0199986678f,0.011246589f,0.00632451288f,0.00355655141f,0.836655617f,-0.686891198f,0.35002476f,-0.558680534f,0.863209307f,0.924954832f,0.616333544f,0.364819258f,0.208459899f,0.117817394f,0.0663590282f,0.0373351872f,0.0209984574f,0.0118088927f,0.00664073415f,0.00373437814f,-0.00885130931f,-0.193630233f,0.623979926f,-0.696581721f,0.808496356f,0.944854796f,0.640923738f,0.381317884f,0.218229622f,0.123399742f,0.0695140064f,0.0391121693f,0.0219982266f,0.0123711927f,0.00695695449f,0.00391220488f,-0.846220434f,0.359264523f,0.836055279f,-0.812512875f,0.745705247f,0.961767614f,0.664873064f,0.397695929f,0.227977514f,0.128978193f,0.0726682767f,0.0408890247f,0.0229979735f,0.0129334899f,0.00727317436f,0.00409003161f,-0.905578375f,0.801513135f,0.965219259f,-0.902817786f,0.67546314f,0.97563988f,0.688157499f,0.413948208f,0.237702623f,0.134552568f,0.0758218244f,0.0426657498f,0.0239976961f,0.0134957815f,0.0075893933f,0.00426785741f,-0.132351756f,0.996909976f,0.998663187f,-0.964648306f,0.598472118f,0.986427724f,0.710753918f,0.430069596f,0.247403964f,0.140122697f,0.0789746121f,0.0444423407f,0.0249973964f,0.0140580693f,0.00790561177f,0.00444568414f,0.76255846f,0.885276794f,0.933070183f,-0.996054351f,0.515501261f,0.994096994f,0.732639611f,0.446054995f,0.257080555f,0.145688385f,0.0821266174f,0.0462187938f,0.0259970706f,0.0146203535f,0.00822182931f,0.00462350994f,0.956375957f,0.500994205f,0.774945021f,-0.996045172f,0.427379847f,0.99862349f,0.753792703f,0.46189931f,0.266731411f,0.151249468f,0.0852777958f,0.0479951017f,0.0269967206f,0.015182632f,0.00853804592f,0.00480133574f,0.270905793f,-0.0375856608f,0.539968967f,-0.964621305f,0.334988207f,0.999992907f,0.774192095f,0.477597594f,0.276355654f,0.156805754f,0.0884281173f,0.049771253f,0.0279963426f,0.0157449059f,0.0088542616f,0.00497916201f,-0.663633883f,-0.564589798f,0.251445323f,-0.902773678f,0.239249229f,0.998200953f,0.793817401f,0.49314484f,0.28595221f,0.162357092f,0.0915775672f,0.0515472479f,0.0289959367f,0.0163071752f,0.00917047635f,0.00515698735f,-0.988031626f,-0.917709649f,-0.0620148405f,-0.812452853f,0.141120002f,0.993253171f,0.812648892f,0.5085361f,0.295520186f,0.167903304f,0.0947260931f,0.0533230826f,0.029995501f,0.0168694388f,0.00948669016f,0.00533481315f,-0.404037654f,-0.988192797f,-0.369325012f,-0.696507812f,0.0415805206f,0.985165298f,0.830667794f,0.523766637f,0.305058628f,0.173444211f,0.0978736654f,0.055098746f,0.0309950355f,0.0174316969f,0.00980290305f,0.00551263802f,0.551426709f,-0.754330218f,-0.640009403f,-0.5585953f,-0.0583741926f,0.973962843f,0.847856104f,0.538831532f,0.314566553f,0.17897962f,0.101020269f,0.0568742342f,0.0319945402f,0.0179939512f,0.0101191159f,0.00569046335f,0.999911845f,-0.28814739f,-0.847224355f,-0.403064936f,-0.157745644f,0.959681332f,0.864196658f,0.553726017f,0.324043006f,0.184509367f,0.10416586f,0.0586495437f,0.0329940096f,0.0185561981f,0.010435327f,0.00586828869f,0.529082716f,0.266779721f,-0.97042042f,-0.234822124f,-0.255541205f,0.942365825f,0.879673064f,0.568445385f,0.333487093f,0.190033287f,0.107310407f,0.0604246669f,0.0339934528f,0.0191184394f,0.010751537f,0.00604611309f,-0.428182662f,0.739542127f,-0.997380435f,-0.0591726787f,-0.350783229f,0.92207104f,0.894269884f,0.582984984f,0.342897803f,0.195551202f,0.110453881f,0.0621996038f,0.034992855f,0.0196806751f,0.0110677453f,0.00622393796f,-0.991778851f,0.984540582f,-0.925431013f,0.118342586f,-0.442520559f,0.89886117f,0.907972515f,0.597340286f,0.352274209f,0.201062918f,0.113596253f,0.0639743358f,0.0359922275f,0.0202429052f,0.0113839535f,0.0064017619f,-0.643538117f,0.926318109f,-0.761706948f,0.292125374f,-0.529836178f,0.872809589f,0.920767248f,0.611506701f,0.361615449f,0.206568271f,0.116737492f,0.0657488778f,0.036991559f,0.0208051261f,0.0117001599f,0.0065795863f,0.296368569f,0.58280617f,-0.522444785f,0.456694692f,-0.611857831f,0.84399873f,0.932641268f,0.625479698f,0.370920479f,0.212067112f,0.119877554f,0.0675232038f,0.0379908569f,0.0213673431f,0.0120163653f,0.00675741071f,0.963795364f,0.0598003156f,-0.231372014f,0.606860459f,-0.687766254f,0.81251961f,0.943582714f,0.639254928f,0.380188406f,0.217559248f,0.123016424f,0.0692973137f,0.0389901139f,0.0219295528f,0.0123325698f,0.00693523418f,0.745113134f,-0.481621295f,0.0826458037f,0.737885714f,-0.756802499f,0.778471708f,0.953580678f,0.652827978f,0.389418334f,0.223044485f,0.126154065f,0.0710712075f,0.0399893373f,0.0224917568f,0.0126487734f,0.00711305765f,-0.158622667f,-0.874714017f,0.388467699f,0.845638454f,-0.818277061f,0.74196279f,0.962625206f,0.666194677f,0.39860931f,0.228522688f,0.129290432f,0.0728448778f,0.0409885161f,0.0230539497f,0.0129649751f,0.00729088066f,-0.916521549f,-0.998410463f,0.655764699f,0.926720202f,-0.871575892f,0.703108132f,0.970707119f,0.679350674f,0.407760441f,0.233993664f,0.132425532f,0.0746183172f,0.0419876575f,0.0236161388f,0.0132811759f,0.00746870413f,-0.831774771f,-0.814614236f,0.858030677f,0.97857362f,-0.916166008f,0.662030637f,0.977818429f,0.692291796f,0.416870773f,0.23945722f,0.135559291f,0.0763915181f,0.0429867506f,0.0241783205f,0.0135973748f,0.00764652714f,0.0177019257f,-0.37993139f,0.975206196f,0.999563396f,-0.951602101f,0.618860185f,0.983951986f,0.70501405f,0.425939471f,0.244913206f,0.138691694f,0.0781644881f,0.0439858064f,0.0247404929f,0.0139135728f,0.00782434922f,0.850903511f,0.171763569f,0.995670974f,0.989027262f,-0.977530122f,0.57373327f,0.989101648f,0.717513323f,0.434965521f,0.250361472f,0.141822711f,0.0799371973f,0.0449848175f,0.0253026579f,0.0142297689f,0.00800217129f,0.901788354f,0.670557022f,0.917395473f,0.947297752f,-0.993690968f,0.526792526f,0.993262351f,0.72978574f,0.44394809f,0.255801797f,0.144952312f,0.0817096606f,0.0459837839f,0.0258648153f,0.0145459641f,0.0081799943f,0.123573124f,0.962832689f,0.748142362f,0.875690997f,-0.999923289f,0.478186339f,0.996429801f,0.741827428f,0.452886283f,0.261234075f,0.148080453f,0.0834818557f,0.0469827019f,0.0264269635f,0.0148621574f,0.00835781638f,-0.768254638f,0.958573103f,0.504697084f,0.776465356f,-0.99616462f,0.428068399f,0.99860096f,0.753634512f,0.461779177f,0.266658038f,0.151207119f,0.0852537975f,0.0479815714f,0.0269891042f,0.0151783489f,0.00853563752f,-0.953752637f,0.659090102f,0.211200655f,0.652750373f,-0.982452571f,0.376597136f,0.999773562f,0.765203178f,0.470625877f,0.272073567f,0.15433228f,0.087025471f,0.0489803962f,0.0275512375f,0.0154945394f,0.0087134596f,-0.262374848f,0.156619072f,-0.10324046f,0.508447945f,-0.958924294f,0.32393527f,0.999946535f,0.776529968f,0.47942555f,0.277480543f,0.157455891f,0.0887968615f,0.0499791689f,0.0281133596f,0.0158107281f,0.00889127981f,0.670229197f,-0.394086063f,-0.407444149f,0.3481085f,-0.925814748f,0.270249337f,0.99911958f,0.787611187f,0.48817724f,0.282878697f,0.160577938f,0.0905679762f,0.0509778969f,0.0286754742f,0.0161269177f,0.00906910095f,0.986627579f,-0.823421597f,-0.671240151f,0.176790684f,-0.883454502f,0.215709001f,0.997293651f,0.798443377f,0.496880114f,0.28826794f,0.163698375f,0.0923388004f,0.051976569f,0.0292375814f,0.0164431017f,0.00924692024f,0.395925164f,-0.999157965f,-0.868469954f,-0.000103020677f,-0.832267344f,0.160486728f,0.994470477f,0.809023023f,0.505533338f,0.293648034f,0.166817173f,0.0941093415f,0.0529751927f,0.0297996756f,0.0167592876f,0.00942474138f,-0.558789074f,-0.867171526f,-0.979574919f,-0.176993474f,-0.772764444f,0.104756832f,0.990652919f,0.819346905f,0.514135957f,0.29901889f,0.169934288f,0.0958795771f,0.0539737605f,0.0303617641f,0.0170754679f,0.00960256159f,-0.999755144f,-0.468111664f,-0.993535519f,-0.348301649f,-0.705540299f,0.0486960001f,0.985844791f,0.829411685f,0.522687256f,0.304380238f,0.173049718f,0.0976495072f,0.0549722798f,0.0309238415f,0.01739165f,0.00978038087f,-0.521551013f,0.0751182064f,-0.908967435f,-0.508624554f,-0.631266713f,-0.00751878507f,0.980050862f,0.839214146f,0.531186223f,0.30973196f,0.17616342f,0.0994191393f,0.0559707358f,0.0314859077f,0.0177078284f,0.00995820016f,0.436164767f,0.595211506f,-0.734258294f,-0.652905703f,-0.550685287f,-0.0637097955f,0.973276973f,0.848751247f,0.539632022f,0.315073937f,0.179275364f,0.101188451f,0.0569691435f,0.0320479684f,0.0180240069f,0.0101360194f,0.992872655f,0.931992829f,-0.486733496f,-0.776594579f,-0.464602023f,-0.119699396f,0.965529919f,0.858020008f,0.548023939f,0.3204059f,0.182385504f,0.102957435f,0.0579674877f,0.0326100141f,0.0183401816f,0.0103138378f,0.636738002f,0.981735826f,-0.190938011f,-0.87579f,-0.373876572f,-0.175310582f,0.956817448f,0.867017388f,0.55636102f,0.325727791f,0.185493827f,0.104726106f,0.0589657798f,0.0331720486f,0.0186563563f,0.0104916561f,-0.304810613f,0.729123712f,0.12379095f,-0.947363734f,-0.279415488f,-0.230367512f,0.947148204f,0.875740528f,0.564642429f,0.33103931f,0.188600287f,0.106494442f,0.0599640086f,0.0337340795f,0.0189725272f,0.0106694745f,-0.966117799f,0.251952261f,0.426245421f,-0.98905772f,-0.182162598f,-0.284696162f,0.936531842f,0.884186864f,0.572867453f,0.336340427f,0.191704854f,0.108262435f,0.0609621815f,0.0342960916f,0.0192886982f,0.0108472919f,-0.739180684f,-0.302812874f,0.686427653f,-0.999557257f,-0.0830891207f,-0.338124752f,0.924979091f,0.892353535f,0.581035137f,0.341630876f,0.194807529f,0.110030092f,0.0619602874f,0.0348580964f,0.0196048655f,0.0110251084f,0.167355701f,-0.764320076f,0.878538549f,-0.978531301f,0.0168140903f,-0.390484393f,0.912501454f,0.900238097f,0.589144766f,0.346910536f,0.197908238f,0.111797392f,0.0629583374f,0.0354200937f,0.0199210308f,0.0112029258f};
#define LAS __attribute__((address_space(3)))
#define XB_TMO      128
#define XB_XCNT(j)  (256  + 64 * (j))
#define XB_XSUB(j)  (1280 + 64 * (j))
#define XB_XGEN(j)  (2304 + 64 * (j))
#define XB_TOP      3328
#define XB_TOPGEN   3392
#define XCD_BAR_WORDS 3456
#define XB_SPIN_CAP (1u << 18)

__device__ __forceinline__ unsigned xb_ld(unsigned* p)              { return __hip_atomic_load(p, __ATOMIC_RELAXED, __HIP_MEMORY_SCOPE_AGENT); }
__device__ __forceinline__ unsigned xb_add(unsigned* p, unsigned v) { return __hip_atomic_fetch_add(p, v, __ATOMIC_RELAXED, __HIP_MEMORY_SCOPE_AGENT); }
__device__ __forceinline__ unsigned xb_xcc_id() { return (unsigned)__builtin_amdgcn_s_getreg((3 << 11) | 20) & 0xFu; }
#define XB_SPIN(cond, bar) do { unsigned _sp = 0; while (cond) { __builtin_amdgcn_s_sleep(1); \
    if ((++_sp & 255u) == 0u) { if (xb_ld(&(bar)[XB_TMO])) break; if (_sp > XB_SPIN_CAP) { atomicAdd(&(bar)[XB_TMO], 1u); break; } } } } while (0)

struct XcdBarrier {
    unsigned* bar; unsigned x;
    volatile LAS unsigned* st;
};

__device__ __forceinline__ XcdBarrier xcd_barrier_post(unsigned* bar, volatile LAS unsigned* st) {
    XcdBarrier b; b.bar = bar; b.x = xb_xcc_id(); b.st = st;
    if (threadIdx.x == 0) (void)xb_add(&bar[XB_XCNT(b.x)], 1u);
    return b;
}
__device__ __forceinline__ void xcd_barrier_complete(unsigned* bar, unsigned x, unsigned& nloc, unsigned& nx) {
    const unsigned G = gridDim.x * gridDim.y * gridDim.z;
    unsigned sum, cnt, mine, sp = 0u;
    for (;;) {
        sum = 0u; cnt = 0u; mine = 0u;
#pragma unroll
        for (unsigned j = 0; j < 16; ++j) { const unsigned c = xb_ld(&bar[XB_XCNT(j)]); sum += c; cnt += (c > 0u) ? 1u : 0u; mine = (j == x) ? c : mine; }
        if (sum == G) break;
        __builtin_amdgcn_s_sleep(1);
        if ((++sp & 255u) == 0u) { if (xb_ld(&bar[XB_TMO])) break; if (sp > XB_SPIN_CAP) { atomicAdd(&bar[XB_TMO], 1u); break; } }
    }
    nloc = mine > 0u ? mine : 1u; nx = cnt > 0u ? cnt : 1u;
}

__device__ __forceinline__ void xcd_barrier(const XcdBarrier& b) {
    asm volatile("s_waitcnt vmcnt(0)" ::: "memory");
    __syncthreads();
    if (threadIdx.x == 0) {
        unsigned* bar = b.bar;
        __builtin_amdgcn_s_waitcnt(0);
        unsigned nloc = b.st[0], nx = b.st[1];
        if (nloc == 0u) { xcd_barrier_complete(bar, b.x, nloc, nx); b.st[0] = nloc; b.st[1] = nx; }
        const unsigned old = xb_add(&bar[XB_XSUB(b.x)], 1u);
        const unsigned gen = old / nloc;
        if (old + 1u == (gen + 1u) * nloc) {
            __builtin_amdgcn_fence(__ATOMIC_RELEASE, "agent");
            asm volatile("s_waitcnt vmcnt(0)" ::: "memory");
            const unsigned og = xb_add(&bar[XB_TOP], 1u);
            const unsigned tg = og / nx;
            if (og + 1u == (tg + 1u) * nx) xb_add(&bar[XB_TOPGEN], 1u);
            else XB_SPIN(xb_ld(&bar[XB_TOPGEN]) == tg, bar);
            __builtin_amdgcn_fence(__ATOMIC_ACQUIRE, "agent");
            xb_add(&bar[XB_XGEN(b.x)], 1u);
            asm volatile("s_waitcnt vmcnt(0)" ::: "memory");
        } else {
            XB_SPIN(xb_ld(&bar[XB_XGEN(b.x)]) == gen, bar);
            __builtin_amdgcn_fence(__ATOMIC_ACQUIRE, "agent");
            asm volatile("s_waitcnt vmcnt(0)" ::: "memory");
        }
    }
    __syncthreads();
}

#define DI __device__ __forceinline__
#define LAS __attribute__((address_space(3)))
typedef unsigned short bf16;
typedef short bf16x8 __attribute__((ext_vector_type(8)));
typedef float f32x4 __attribute__((ext_vector_type(4)));
typedef unsigned u32x4 __attribute__((ext_vector_type(4)));
typedef unsigned u32x2 __attribute__((ext_vector_type(2)));

#ifndef COOP
#define COOP 1
#endif

constexpr int D = 1024, NBATCH = 4, SEQ = 4096, CTXL = 256, NLAT = NBATCH * SEQ, NCTX = NBATCH * CTXL, MT = NLAT + NCTX;
constexpr int FF = 2816, KEYS = SEQ + CTXL;
constexpr int LDP0 = 2560, LDP1 = 3072;
constexpr int C_AQ = 0, C_AK = 512, C_AV = 640, C_BQ = 768, C_BK = 1024, C_BV = 1280, C_BO = 1792, C_RF = 2304, C_RB = 2320;
constexpr float LOG2E = 1.4426950408889634f, EPS = 1e-6f;
constexpr int NCHUNK = 68;

constexpr size_t MiB = 1u << 20;
constexpr size_t WS_CTL = 0, WS_MOD = 1 * MiB, WS_XC = 2 * MiB, WS_WABI = 6 * MiB, WS_WABO = 11 * MiB, WS_WFI = 13 * MiB, WS_WFO = 35 * MiB, WS_WNI = 46 * MiB, WS_WNO = 52 * MiB;
constexpr size_t WS_HO = 54 * MiB, WS_YF = 88 * MiB, WS_P = 122 * MiB, WS_STC = 224 * MiB, WS_DEC = 228 * MiB, WS_END = 251 * MiB;
constexpr size_t WS_CUM0 = 207 * MiB, WS_CUM1 = 229 * MiB;
constexpr size_t WS_VTA = 246 * MiB;
constexpr size_t WS_PART = 224 * MiB;
constexpr int LDS_BYTES = 147456;
constexpr int NWAVES = 8, NTHR = 512;

DI float bf2f(unsigned short h) { return __uint_as_float(((unsigned)h) << 16); }
typedef float f32x2_t __attribute__((ext_vector_type(2)));
typedef __bf16 bf16x2_t __attribute__((ext_vector_type(2)));
DI unsigned pk2(float lo, float hi) { const f32x2_t v = {lo, hi}; const bf16x2_t b = __builtin_convertvector(v, bf16x2_t); return __builtin_bit_cast(unsigned, b); }
DI float wave_sum(float v) {
#pragma unroll
    for (int o = 1; o < 64; o <<= 1) v += __shfl_xor(v, o);
    return v;
}
DI float fast_exp2(float x) { return __builtin_amdgcn_exp2f(x); }
DI float silu_f(float g) { return g * __builtin_amdgcn_rcpf(1.0f + __expf(-g)); }
DI void unpack8(const bf16x8 v, float (&o)[8]) {
#pragma unroll
    for (int i = 0; i < 8; ++i) o[i] = bf2f((unsigned short)v[i]);
}
DI bf16x8 pack8(const float (&p)[8]) {
    u32x4 w; w.x = pk2(p[0], p[1]); w.y = pk2(p[2], p[3]); w.z = pk2(p[4], p[5]); w.w = pk2(p[6], p[7]);
    return __builtin_bit_cast(bf16x8, w);
}
#define MFMA16(a, b, c) __builtin_amdgcn_mfma_f32_16x16x32_bf16((a), (b), (c), 0, 0, 0)

struct EpiStore {
    static constexpr bool PERM = true, AFTER_DRAIN = false;
    bf16* O; int ldc;
    DI void operator()(const pg8::f32x4 (&acc)[2][2][4][2], const pg8::Unit& u, int wr, int wc, int fr, int fq) const {
        const int row0 = u.pm * 256 + wr * 64 + fr, col0 = u.pn * 256 + wc * 32 + 8 * fq;
#pragma unroll
        for (int ai = 0; ai < 2; ++ai)
#pragma unroll
            for (int m = 0; m < 4; ++m) { bf16* rowp = O + (size_t)(row0 + ai * 128 + m * 16) * ldc + col0;
#pragma unroll
                for (int bj = 0; bj < 2; ++bj) { const pg8::f32x4 v0 = acc[ai][bj][m][0], v1 = acc[ai][bj][m][1];
                    u32x4 w; w.x = pk2(v0[0], v0[1]); w.y = pk2(v0[2], v0[3]); w.z = pk2(v1[0], v1[1]); w.w = pk2(v1[2], v1[3]);
                    *(u32x4*)(rowp + bj * 128) = w; } }
    }
};
struct EpiSwiglu {
    static constexpr bool PERM = true, AFTER_DRAIN = false;
    bf16* O; int ldc;
    DI void operator()(const pg8::f32x4 (&acc)[2][2][4][2], const pg8::Unit& u, int wr, int wc, int fr, int fq) const {
        const int row0 = u.pm * 256 + wr * 64 + fr, col0 = u.pn * 128 + wc * 32 + 8 * fq;
#pragma unroll
        for (int ai = 0; ai < 2; ++ai)
#pragma unroll
            for (int m = 0; m < 4; ++m) { bf16* rowp = O + (size_t)(row0 + ai * 128 + m * 16) * ldc + col0;
                const pg8::f32x4 g0 = acc[ai][0][m][0], g1 = acc[ai][0][m][1], u0 = acc[ai][1][m][0], u1 = acc[ai][1][m][1];
                u32x4 w; w.x = pk2(silu_f(g0[0]) * u0[0], silu_f(g0[1]) * u0[1]); w.y = pk2(silu_f(g0[2]) * u0[2], silu_f(g0[3]) * u0[3]);
                w.z = pk2(silu_f(g1[0]) * u1[0], silu_f(g1[1]) * u1[1]); w.w = pk2(silu_f(g1[2]) * u1[2], silu_f(g1[3]) * u1[3]);
                *(u32x4*)rowp = w; }
    }
};

struct OneUnit {
    int pm, pn; bool has;
    DI bool next(int i, pg8::Unit& u) const { if (i != 0 || !has) return false; u.pm = pm; u.pn = pn; return true; }
    DI void a_ready(const pg8::Unit&) const {}
    DI void done(const pg8::Unit&) const {}
};

struct Args { const float* in[23]; float* out; unsigned char* ws; int ph_lo, ph_hi; };
enum { I_X = 0, I_C, I_CTX, I_CCTX, I_WMOD, I_BMOD, I_GMPRE, I_GMPOST, I_GFPRE, I_GFPOST, I_WFI, I_WFO, I_ABWI, I_ABWO, I_SINK, I_GFW, I_GFB, I_GBW, I_GBB, I_GNORM, I_NAWI, I_NAWO, I_RELB };

DI void transpose_item(const float* W, int K, int N, bf16* WT, int k0, int n0, int drow0, LAS float* scr, int lane) {
#pragma unroll 8
    for (int i = 0; i < 32; ++i) { const int kk = 2 * i + (lane >> 5); scr[kk * 33 + (lane & 31)] = W[(size_t)(k0 + kk) * N + n0 + (lane & 31)]; }
    asm volatile("s_waitcnt lgkmcnt(0)" ::: "memory");
    const int c = lane & 7;
#pragma unroll
    for (int j = 0; j < 4; ++j) { const int n = (lane >> 3) + 8 * j; const LAS float* s = scr + (8 * c) * 33 + n;
        u32x4 o; o.x = pk2(s[0 * 33], s[1 * 33]); o.y = pk2(s[2 * 33], s[3 * 33]); o.z = pk2(s[4 * 33], s[5 * 33]); o.w = pk2(s[6 * 33], s[7 * 33]);
        *(u32x4*)(WT + (size_t)(drow0 + n) * K + k0 + 8 * c) = o; }
    asm volatile("s_waitcnt lgkmcnt(0)" ::: "memory");
}
DI void xpose_plain(const float* W, int K, int N, bf16* WT, int item, LAS float* scr, int lane) {
    const int nblk = N / 32, kb = item / nblk, nb = item % nblk;
    transpose_item(W, K, N, WT, 64 * kb, 32 * nb, 32 * nb, scr, lane);
}
DI void xpose_ffnin(const float* W, bf16* WT, int item, LAS float* scr, int lane) {
    const int nblk = 5632 / 32, kb = item / nblk, nb = item % nblk, n0 = 32 * nb;
    const int bj = n0 >= FF ? 1 : 0, cc = n0 - bj * FF, drow0 = 256 * (cc >> 7) + 128 * bj + (cc & 127);
    transpose_item(W, 1024, 5632, WT, 64 * kb, n0, drow0, scr, lane);
}

DI void phase_prologue(const Args& a, LAS unsigned char* lds, int tid, int lane, int wave) {
    unsigned char* ws = a.ws;
    {
        LAS float* sl = (LAS float*)lds;
        LAS float* red = (LAS float*)(lds + 32768);
        for (int i = tid; i < 5 * 1024; i += NTHR) { const int s = i >> 10, k = i & 1023; const float v = s < 4 ? a.in[I_C][s * 1024 + k] : a.in[I_CCTX][k]; sl[i] = v / (1.0f + __expf(-v)); }
        __syncthreads();
        for (int u = blockIdx.x; u < 192; u += gridDim.x) {
            const int layer = u / 96, col = (u % 96) * 64 + lane;
            const float* W = a.in[I_WMOD] + (size_t)layer * 1024 * 6144 + col;
            float acc[5] = {0.f, 0.f, 0.f, 0.f, 0.f};
            const int kb = wave * 128;
#pragma unroll 8
            for (int k = 0; k < 128; ++k) { const float w = W[(size_t)(kb + k) * 6144];
#pragma unroll
                for (int s = 0; s < 5; ++s) acc[s] += sl[s * 1024 + kb + k] * w; }
#pragma unroll
            for (int s = 0; s < 5; ++s) red[(wave * 5 + s) * 64 + lane] = acc[s];
            __syncthreads();
            if (tid < 320) { const int s = tid >> 6, l = tid & 63; float t = 0.f;
#pragma unroll
                for (int w = 0; w < 8; ++w) t += red[(w * 5 + s) * 64 + l];
                const int c2 = (u % 96) * 64 + l;
                ((float*)(ws + WS_MOD))[(size_t)(layer * 5 + s) * 6144 + c2] = t + a.in[I_BMOD][layer * 6144 + c2]; }
            __syncthreads();
        }
        __syncthreads();
    }
    LAS float* scr = (LAS float*)(lds + wave * 16384);
    const int gw = blockIdx.x * NWAVES + wave, NGW = gridDim.x * NWAVES;
    constexpr int I_1 = 16 * 73, I_2 = 16 * 32, I_3 = 16 * 176, I_4 = 44 * 32, I_5 = 16 * 96, I_6 = 16 * 32;
    constexpr int NITEMS = I_1 + I_2 + 2 * I_3 + 2 * I_4 + I_5 + I_6;
    for (int it = gw; it < NITEMS; it += NGW) {
        int r = it;
        if (r < I_1) { xpose_plain(a.in[I_ABWI], 1024, 2336, (bf16*)(ws + WS_WABI), r, scr, lane); continue; } r -= I_1;
        if (r < I_2) { xpose_plain(a.in[I_ABWO], 1024, 1024, (bf16*)(ws + WS_WABO), r, scr, lane); continue; } r -= I_2;
        if (r < I_3) { xpose_ffnin(a.in[I_WFI], (bf16*)(ws + WS_WFI), r, scr, lane); continue; } r -= I_3;
        if (r < I_3) { xpose_ffnin(a.in[I_WFI] + (size_t)1024 * 5632, (bf16*)(ws + WS_WFI) + (size_t)5632 * 1024, r, scr, lane); continue; } r -= I_3;
        if (r < I_4) { xpose_plain(a.in[I_WFO], FF, 1024, (bf16*)(ws + WS_WFO), r, scr, lane); continue; } r -= I_4;
        if (r < I_4) { xpose_plain(a.in[I_WFO] + (size_t)FF * 1024, FF, 1024, (bf16*)(ws + WS_WFO) + (size_t)1024 * FF, r, scr, lane); continue; } r -= I_4;
        if (r < I_5) { xpose_plain(a.in[I_NAWI], 1024, 3072, (bf16*)(ws + WS_WNI), r, scr, lane); continue; } r -= I_5;
        xpose_plain(a.in[I_NAWO], 1024, 1024, (bf16*)(ws + WS_WNO), r, scr, lane);
    }
    { u32x4* z = (u32x4*)((bf16*)(ws + WS_WABI) + (size_t)2336 * 1024); const u32x4 zero = {0u, 0u, 0u, 0u};
      for (int i = blockIdx.x * NTHR + tid; i < 224 * 128; i += gridDim.x * NTHR) z[i] = zero; }
}

struct RowParams { f32x4 A[4], B[4], C[4]; };
DI void load_row_params(RowParams& p, const float* gpost, const float* gate, const float* gpre, const float* shift, const float* scale, int lane) {
#pragma unroll
    for (int j = 0; j < 4; ++j) {
        if (gate) p.A[j] = *((const f32x4*)gate + lane + 64 * j) * *((const f32x4*)gpost + lane + 64 * j);
        if (gpre) { p.B[j] = *((const f32x4*)gpre + lane + 64 * j) * (*((const f32x4*)scale + lane + 64 * j) + 1.0f); p.C[j] = *((const f32x4*)shift + lane + 64 * j); }
    }
}
DI void row_op(const float* xsrc, const bf16* y, int nslice, float* xdst, bf16* hdst, const RowParams& p, int lane) {
    f32x4 v[4];
#pragma unroll
    for (int j = 0; j < 4; ++j) v[j] = *((const f32x4*)xsrc + lane + 64 * j);
    if (y) {
        f32x4 yv[4]; float s = 0.f;
#pragma unroll
        for (int j = 0; j < 4; ++j) yv[j] = (f32x4){0.f, 0.f, 0.f, 0.f};
        for (int sl = 0; sl < nslice; ++sl) {
#pragma unroll
            for (int j = 0; j < 4; ++j) { const u32x2 w = *((const u32x2*)(y + (size_t)sl * NCTX * D) + lane + 64 * j);
                yv[j] = yv[j] + (f32x4){__uint_as_float(w.x << 16), __uint_as_float(w.x & 0xffff0000u), __uint_as_float(w.y << 16), __uint_as_float(w.y & 0xffff0000u)}; } }
#pragma unroll
        for (int j = 0; j < 4; ++j) s += (yv[j].x * yv[j].x + yv[j].y * yv[j].y) + (yv[j].z * yv[j].z + yv[j].w * yv[j].w);
        const float rstd = __builtin_amdgcn_rsqf(wave_sum(s) * (1.0f / D) + EPS);
#pragma unroll
        for (int j = 0; j < 4; ++j) v[j] = v[j] + p.A[j] * (yv[j] * rstd);
    }
    if (xdst) {
#pragma unroll
        for (int j = 0; j < 4; ++j) *((f32x4*)xdst + lane + 64 * j) = v[j];
    }
    if (hdst) {
        float s = 0.f;
#pragma unroll
        for (int j = 0; j < 4; ++j) s += (v[j].x * v[j].x + v[j].y * v[j].y) + (v[j].z * v[j].z + v[j].w * v[j].w);
        const float rstd = __builtin_amdgcn_rsqf(wave_sum(s) * (1.0f / D) + EPS);
#pragma unroll
        for (int j = 0; j < 4; ++j) { const f32x4 h = v[j] * rstd * p.B[j] + p.C[j];
            u32x2 w; w.x = pk2(h.x, h.y); w.y = pk2(h.z, h.w);
            *((u32x2*)hdst + lane + 64 * j) = w; }
    }
}
DI void phase_rows(const Args& a, int mode, int layer, int lane, int wave) {
    unsigned char* ws = a.ws;
    const float* MOD = (const float*)(ws + WS_MOD);
    bf16* H = (bf16*)(ws + WS_HO); const bf16* YF = (const bf16*)(ws + WS_YF); const bf16* PART = (const bf16*)(ws + WS_PART); float* XC = (float*)(ws + WS_XC);
    const int gw = blockIdx.x * NWAVES + wave, NGW = gridDim.x * NWAVES;
    const int chunk = (NLAT + NGW - 1) / NGW, m0 = gw * chunk, m1 = (m0 + chunk < NLAT) ? m0 + chunk : NLAT;
    RowParams p; int sprev = -1;
    const int mend = (layer == 0) ? MT : NLAT;
    for (int it = 0; ; ++it) {
        int m;
        if (m0 + it < m1) m = m0 + it;
        else { m = NLAT + gw + (it - (m1 > m0 ? m1 - m0 : 0)) * NGW; if (m >= mend) break; }
        const bool lat = m < NLAT; const int s = lat ? (m >> 12) : 4;
        const float* mod = MOD + (size_t)(layer * 5 + s) * 6144;
        if (s != sprev) { sprev = s;
            if (mode == 0) load_row_params(p, nullptr, nullptr, a.in[I_GMPRE], mod, mod + 1024, lane);
            else if (mode == 1) load_row_params(p, a.in[I_GMPOST] + layer * D, mod + 2048, a.in[I_GFPRE] + layer * D, mod + 3072, mod + 4096, lane);
            else if (layer == 0) { const float* mod1 = MOD + (size_t)(5 + s) * 6144; load_row_params(p, a.in[I_GFPOST], mod + 5120, a.in[I_GMPRE] + D, mod1, mod1 + 1024, lane); }
            else load_row_params(p, a.in[I_GFPOST] + D, mod + 5120, nullptr, nullptr, nullptr, lane); }
        float* xcur = lat ? a.out + (size_t)m * D : XC + (size_t)(m - NLAT) * D;
        const float* xin0 = lat ? a.in[I_X] + (size_t)m * D : a.in[I_CTX] + (size_t)(m - NLAT) * D;
        if (mode == 0) row_op(xin0, nullptr, 0, nullptr, H + (size_t)m * D, p, lane);
        else if (mode == 1) row_op(layer == 0 ? xin0 : xcur, (layer == 0 && !lat) ? PART + (size_t)(m - NLAT) * D : YF + (size_t)m * D, (layer == 0 && !lat) ? 4 : 1, xcur, H + (size_t)m * D, p, lane);
        else if (layer == 0) row_op(xcur, lat ? YF + (size_t)m * D : PART + (size_t)(m - NLAT) * D, lat ? 1 : 11, xcur, H + (size_t)m * D, p, lane);
        else row_op(xcur, YF + (size_t)m * D, 1, xcur, nullptr, p, lane);
    }
}

DI float xmax_quads(float x) {
    unsigned u = __float_as_uint(x);
    auto r = __builtin_amdgcn_permlane16_swap(u, u, false, false);
    u = __float_as_uint(fmaxf(__uint_as_float(r[0]), __uint_as_float(r[1])));
    auto r2 = __builtin_amdgcn_permlane32_swap(u, u, false, false);
    return fmaxf(__uint_as_float(r2[0]), __uint_as_float(r2[1]));
}
DI float xsum_quads(float x) {
    unsigned u = __float_as_uint(x);
    auto r = __builtin_amdgcn_permlane16_swap(u, u, false, false);
    u = __float_as_uint(__uint_as_float(r[0]) + __uint_as_float(r[1]));
    auto r2 = __builtin_amdgcn_permlane32_swap(u, u, false, false);
    return __uint_as_float(r2[0]) + __uint_as_float(r2[1]);
}
struct KVFrag { bf16x8 kf[2][2]; bf16x8 vf[4]; };
DI void kv_load(KVFrag& f, const bf16* kp, int kld, const bf16* vp, int vld, int fr, int fq) {
#pragma unroll
    for (int h = 0; h < 2; ++h)
#pragma unroll
        for (int ks = 0; ks < 2; ++ks) f.kf[h][ks] = *(const bf16x8*)(kp + (size_t)((fr >> 2) * 8 + h * 4 + (fr & 3)) * kld + ks * 32 + fq * 8);
#pragma unroll
    for (int nt = 0; nt < 4; ++nt) f.vf[nt] = *(const bf16x8*)(vp + (size_t)(nt * 16 + fr) * vld + fq * 8);
}
template <int MODE>
DI void attn_one(f32x4 (&o)[4], float& mrun, float& lrun, const bf16x8 (&qf)[2], const KVFrag& f, float sc2, int d0, unsigned okmask, const float (&bias)[8]) {
    f32x4 s0 = {0.f, 0.f, 0.f, 0.f}, s1 = {0.f, 0.f, 0.f, 0.f};
    s0 = MFMA16(f.kf[0][0], qf[0], s0); s0 = MFMA16(f.kf[0][1], qf[1], s0);
    s1 = MFMA16(f.kf[1][0], qf[0], s1); s1 = MFMA16(f.kf[1][1], qf[1], s1);
    float sv[8] = {s0[0], s0[1], s0[2], s0[3], s1[0], s1[1], s1[2], s1[3]};
    float mx = -1e30f;
#pragma unroll
    for (int i = 0; i < 8; ++i) {
        float t = sv[i] * sc2;
        if (MODE == 1) { const int dd = d0 - i; t = (dd >= -128 && dd <= 128) ? t : -1e30f; }
        if (MODE == 2) { t = ((okmask >> i) & 1u) ? t + bias[i] : -1e30f; }
        sv[i] = t; mx = fmaxf(mx, t);
    }
    mx = xmax_quads(mx);
    {
        const float mn = fmaxf(mrun, mx), alpha = fast_exp2(mrun - mn);
        lrun *= alpha; mrun = mn;
#pragma unroll
        for (int nt = 0; nt < 4; ++nt) o[nt] = o[nt] * alpha;
    }
    float p[8], ps = 0.f;
#pragma unroll
    for (int i = 0; i < 8; ++i) { p[i] = fast_exp2(sv[i] - mrun); ps += p[i]; }
    lrun += xsum_quads(ps);
    const bf16x8 pf = pack8(p);
#pragma unroll
    for (int nt = 0; nt < 4; ++nt) o[nt] = MFMA16(f.vf[nt], pf, o[nt]);
}
DI void attn_store1(const f32x4 (&o)[4], float lrun, bf16* op, int fq) {
    const float inv = 1.0f / lrun;
#pragma unroll
    for (int nt = 0; nt < 4; ++nt) { u32x2 w; w.x = pk2(o[nt][0] * inv, o[nt][1] * inv); w.y = pk2(o[nt][2] * inv, o[nt][3] * inv);
        *(u32x2*)(op + nt * 16 + fq * 4) = w; }
}

DI void window_attn_tile(const Args& a, int wt, int lane) {
    const bf16* P = (const bf16*)(a.ws + WS_P); const bf16* VtA = (const bf16*)(a.ws + WS_VTA); bf16* O = (bf16*)(a.ws + WS_HO);
    const int fr = lane & 15, fq = lane >> 4;
    const bool isctx = wt >= 2048;
    int b, kvh, q0; size_t qrow;
    if (!isctx) { b = wt >> 9; kvh = (wt >> 8) & 1; q0 = (wt & 255) * 16; qrow = (size_t)b * SEQ + q0 + fr; }
    else { const int ct = wt - 2048; b = ct >> 5; kvh = (ct >> 4) & 1; q0 = (ct & 15) * 16; qrow = (size_t)NLAT + b * CTXL + q0 + fr; }
    bf16x8 qf[4][2]; f32x4 o[4][4]; float mrun[4], lrun[4];
#pragma unroll
    for (int g = 0; g < 4; ++g) {
#pragma unroll
        for (int ks = 0; ks < 2; ++ks) qf[g][ks] = *(const bf16x8*)(P + qrow * LDP0 + C_AQ + (kvh * 4 + g) * 64 + ks * 32 + fq * 8);
#pragma unroll
        for (int nt = 0; nt < 4; ++nt) o[g][nt] = (f32x4){0.f, 0.f, 0.f, 0.f};
        mrun[g] = a.in[I_SINK][kvh * 4 + g] * LOG2E; lrun[g] = 1.0f;
    }
    const float sc2 = 0.125f * LOG2E;
    const float nob[8] = {0.f, 0.f, 0.f, 0.f, 0.f, 0.f, 0.f, 0.f};
    const bf16* vbase = VtA + (size_t)((b * 2 + kvh) * 64) * KEYS;
    const bf16* kctx = P + (size_t)(NLAT + b * CTXL) * LDP0 + C_AK + kvh * 64;
    const bf16* kloc = P + (size_t)(b * SEQ) * LDP0 + C_AK + kvh * 64;
    const int tlo = (q0 - 128 > 0 ? q0 - 128 : 0) & ~31, thi = (q0 + 16 + 128 < SEQ) ? q0 + 16 + 128 : SEQ;
    const int ntile = isctx ? 8 : 8 + (thi - tlo + 31) / 32;
#define WIN_LOAD(F, t) do { const int t_ = (t); const int k0_ = t_ < 8 ? t_ * 32 : tlo + (t_ - 8) * 32; \
        kv_load(F, (t_ < 8 ? kctx : kloc) + (size_t)k0_ * LDP0, LDP0, vbase + (t_ < 8 ? SEQ : 0) + k0_, KEYS, fr, fq); } while (0)
#define WIN_PROC(F, t) do { const int t_ = (t); const int d0_ = t_ < 8 ? 0 : q0 + fr - (tlo + (t_ - 8) * 32) - fq * 8; \
        _Pragma("unroll") for (int g = 0; g < 4; ++g) attn_one<1>(o[g], mrun[g], lrun[g], qf[g], F, sc2, d0_, 0u, nob); } while (0)
    KVFrag A, B;
    WIN_LOAD(A, 0);
    for (int t = 0; t < ntile; t += 2) {
        WIN_LOAD(B, (t + 1 < ntile ? t + 1 : ntile - 1));
        WIN_PROC(A, t);
        WIN_LOAD(A, (t + 2 < ntile ? t + 2 : ntile - 1));
        if (t + 1 < ntile) WIN_PROC(B, t + 1);
    }
#undef WIN_LOAD
#undef WIN_PROC
#pragma unroll
    for (int g = 0; g < 4; ++g) attn_store1(o[g], lrun[g], O + qrow * D + (kvh * 4 + g) * 64, fq);
}

template <int NR>
DI void na_attn_group(const Args& a, int gid, int lane, LAS float* btab  ) {
    const bf16* P = (const bf16*)(a.ws + WS_P); const bf16* VtC = (const bf16*)(a.ws + WS_YF); bf16* O = (bf16*)(a.ws + WS_HO);
    const int fr = lane & 15, fq = lane >> 4;
    constexpr int NRG = 64 / NR; const int j = gid & 3, r0 = ((gid >> 2) % NRG) * NR, h = ((gid >> 2) / NRG) & 15, b = (gid >> 2) / (NRG * 16);
    { const float* relb = a.in[I_RELB] + h * 465;
      for (int i = lane; i < 465; i += 64) btab[i] = relb[i] * LOG2E;
      asm volatile("s_waitcnt vmcnt(0) lgkmcnt(0)" ::: "memory"); }
    bf16x8 qf[NR][2]; f32x4 o[NR][4]; float mrun[NR], lrun[NR];
#pragma unroll
    for (int qi = 0; qi < NR; ++qi) { const size_t qrow = (size_t)b * SEQ + (r0 + qi) * 64 + j * 16 + fr;
#pragma unroll
        for (int ks = 0; ks < 2; ++ks) qf[qi][ks] = *(const bf16x8*)(P + qrow * LDP1 + h * 64 + ks * 32 + fq * 8);
#pragma unroll
        for (int nt = 0; nt < 4; ++nt) o[qi][nt] = (f32x4){0.f, 0.f, 0.f, 0.f};
        mrun[qi] = -1e30f; lrun[qi] = 0.f; }
    const float sc2 = 0.125f * LOG2E;
    const float nob[8] = {0.f, 0.f, 0.f, 0.f, 0.f, 0.f, 0.f, 0.f};
    const bf16* vbase = VtC + (size_t)((b * 16 + h) * 64) * KEYS;
    const bf16* kctx = P + (size_t)(NLAT + b * CTXL) * LDP1 + 1024 + h * 64;
    const bf16* kloc = P + (size_t)(b * SEQ) * LDP1 + 1024 + h * 64;
    const int seg_start = j == 0 ? 0 : (j == 1 ? 8 : (j == 2 ? 24 : 32));
    const int qcol = j * 16 + fr; const int cs = qcol - 8 < 0 ? 0 : (qcol - 8 > 48 ? 48 : qcol - 8);
    unsigned okmask = 0u; int coloff[8];
#pragma unroll
    for (int i = 0; i < 8; ++i) { const int keycol = seg_start + fq * 8 + i; if (keycol >= cs && keycol < cs + 16) okmask |= 1u << i;
        int co = keycol - qcol + 15; co = co < 0 ? 0 : (co > 30 ? 30 : co); coloff[i] = co; }
    const int rsa = r0 - 4 < 0 ? 0 : (r0 - 4 > 56 ? 56 : r0 - 4);
    const int rsb = r0 + NR - 1 - 4 < 0 ? 0 : (r0 + NR - 1 - 4 > 56 ? 56 : r0 + NR - 1 - 4);
    const int nloc = rsb + 8 - rsa, ntile = 8 + nloc;
#define NA_LOAD(F, t) do { const int t_ = (t); const int k0_ = t_ < 8 ? t_ * 32 : (rsa + t_ - 8) * 64 + seg_start; \
        kv_load(F, (t_ < 8 ? kctx : kloc) + (size_t)k0_ * LDP1, LDP1, vbase + (t_ < 8 ? SEQ : 0) + k0_, KEYS, fr, fq); } while (0)
#define NA_PROC(F, t) do { const int t_ = (t); \
        if (t_ < 8) { _Pragma("unroll") for (int qi = 0; qi < NR; ++qi) attn_one<0>(o[qi], mrun[qi], lrun[qi], qf[qi], F, sc2, 0, 0u, nob); } \
        else { const int R_ = rsa + t_ - 8; \
            _Pragma("unroll") for (int qi = 0; qi < NR; ++qi) { const int r_ = r0 + qi; const int rs_ = r_ - 4 < 0 ? 0 : (r_ - 4 > 56 ? 56 : r_ - 4); \
                if (R_ >= rs_ && R_ < rs_ + 8) { const LAS float* rb_ = btab + (R_ - r_ + 7) * 31; float bias_[8]; \
                    _Pragma("unroll") for (int e = 0; e < 8; ++e) bias_[e] = rb_[coloff[e]]; \
                    attn_one<2>(o[qi], mrun[qi], lrun[qi], qf[qi], F, sc2, 0, okmask, bias_); } } } } while (0)
    if (NR <= 2) {
        KVFrag A, B;
        NA_LOAD(A, 0);
        for (int t = 0; t < ntile; t += 2) {
            NA_LOAD(B, (t + 1 < ntile ? t + 1 : ntile - 1));
            NA_PROC(A, t);
            NA_LOAD(A, (t + 2 < ntile ? t + 2 : ntile - 1));
            if (t + 1 < ntile) NA_PROC(B, t + 1);
        }
    } else {
        KVFrag A;
        for (int t = 0; t < ntile; ++t) { NA_LOAD(A, t); NA_PROC(A, t); }
    }
#undef NA_LOAD
#undef NA_PROC
#pragma unroll
    for (int qi = 0; qi < NR; ++qi) attn_store1(o[qi], lrun[qi], O + ((size_t)b * SEQ + (r0 + qi) * 64 + j * 16 + fr) * D + h * 64, fq);
}

constexpr int NA_KC = 0, NA_VC = 36864, NA_KR = 73728, NA_VR = 92160, NA_BT = 110592;
typedef short s16x4 __attribute__((ext_vector_type(4)));
DI void kv_load_lds(KVFrag& f, const LAS unsigned short* kimg, const LAS unsigned short* vimg  , int fr, int fq) {
#pragma unroll
    for (int h = 0; h < 2; ++h)
#pragma unroll
        for (int ks = 0; ks < 2; ++ks) f.kf[h][ks] = *(const LAS bf16x8*)(kimg + ((fr >> 2) * 8 + h * 4 + (fr & 3)) * 72 + ks * 32 + fq * 8);
#ifdef NA_PLAIN_V
#pragma unroll
    for (int nt = 0; nt < 4; ++nt) { bf16x8 v;
#pragma unroll
        for (int j = 0; j < 8; ++j) v[j] = (short)vimg[(fq * 8 + j) * 72 + nt * 16 + fr];
        f.vf[nt] = v; }
    return;
#endif
    typedef LAS s16x4* trp_t;
    const LAS unsigned short* vb = vimg + (fq * 8 + (fr >> 2)) * 72 + (fr & 3) * 4;
    const s16x4 l0 = __builtin_amdgcn_ds_read_tr16_b64_v4i16((trp_t)(vb)),      h0 = __builtin_amdgcn_ds_read_tr16_b64_v4i16((trp_t)(vb + 288));
    const s16x4 l1 = __builtin_amdgcn_ds_read_tr16_b64_v4i16((trp_t)(vb + 16)), h1 = __builtin_amdgcn_ds_read_tr16_b64_v4i16((trp_t)(vb + 304));
    const s16x4 l2 = __builtin_amdgcn_ds_read_tr16_b64_v4i16((trp_t)(vb + 32)), h2 = __builtin_amdgcn_ds_read_tr16_b64_v4i16((trp_t)(vb + 320));
    const s16x4 l3 = __builtin_amdgcn_ds_read_tr16_b64_v4i16((trp_t)(vb + 48)), h3 = __builtin_amdgcn_ds_read_tr16_b64_v4i16((trp_t)(vb + 336));
    f.vf[0] = __builtin_shufflevector(l0, h0, 0, 1, 2, 3, 4, 5, 6, 7); f.vf[1] = __builtin_shufflevector(l1, h1, 0, 1, 2, 3, 4, 5, 6, 7);
    f.vf[2] = __builtin_shufflevector(l2, h2, 0, 1, 2, 3, 4, 5, 6, 7); f.vf[3] = __builtin_shufflevector(l3, h3, 0, 1, 2, 3, 4, 5, 6, 7);
}
DI void na_attn_unit(const Args& a, LAS unsigned char* lds, int unit, int tid, int lane, int wave) {
    const bf16* P = (const bf16*)(a.ws + WS_P); bf16* O = (bf16*)(a.ws + WS_HO);
    LAS unsigned short* KC = (LAS unsigned short*)(lds + NA_KC); LAS unsigned short* VC = (LAS unsigned short*)(lds + NA_VC);
    LAS unsigned short* KR = (LAS unsigned short*)(lds + NA_KR); LAS unsigned short* VR = (LAS unsigned short*)(lds + NA_VR); LAS float* bt = (LAS float*)(lds + NA_BT);
    const int fr = lane & 15, fq = lane >> 4;
    const int r0 = (unit & 15) * 4, h = (unit >> 4) & 15, b = unit >> 8;
    const int qr = r0 + (wave >> 1), jb = (wave & 1) * 2;
    const bf16* kglob = P + (size_t)(b * SEQ) * LDP1 + 1024 + h * 64;
    const bf16* vglob = P + (size_t)(b * SEQ) * LDP1 + 2048 + h * 64;
    const int rsa = r0 - 4 < 0 ? 0 : (r0 - 4 > 56 ? 56 : r0 - 4);
    const int rsb = r0 + 3 - 4 < 0 ? 0 : (r0 + 3 - 4 > 56 ? 56 : r0 + 3 - 4);
    const int nloc = rsb + 8 - rsa;
    for (int i = tid; i < 465; i += NTHR) bt[i] = a.in[I_RELB][h * 465 + i] * LOG2E;
    { const int row = tid >> 1, half = tid & 1; const bf16* src = P + (size_t)(NLAT + b * CTXL + row) * LDP1 + 1024 + h * 64 + half * 32;
#pragma unroll
      for (int i = 0; i < 4; ++i) { *(LAS u32x4*)(KC + row * 72 + half * 32 + i * 8) = *(const u32x4*)(src + i * 8); *(LAS u32x4*)(VC + row * 72 + half * 32 + i * 8) = *(const u32x4*)(src + 1024 + i * 8); } }
    const int srow = tid >> 3, sch = (tid & 7) * 8;
    { const u32x4 kreg = *(const u32x4*)(kglob + (size_t)(rsa * 64 + srow) * LDP1 + sch), vreg = *(const u32x4*)(vglob + (size_t)(rsa * 64 + srow) * LDP1 + sch);
      *(LAS u32x4*)(KR + srow * 72 + sch) = kreg; *(LAS u32x4*)(VR + srow * 72 + sch) = vreg; }
    bf16x8 qf[2][2]; f32x4 o[2][4]; float mrun[2], lrun[2];
#pragma unroll
    for (int qi = 0; qi < 2; ++qi) { const size_t qrow = (size_t)b * SEQ + qr * 64 + (jb + qi) * 16 + fr;
#pragma unroll
        for (int ks = 0; ks < 2; ++ks) qf[qi][ks] = *(const bf16x8*)(P + qrow * LDP1 + h * 64 + ks * 32 + fq * 8);
#pragma unroll
        for (int nt = 0; nt < 4; ++nt) o[qi][nt] = (f32x4){0.f, 0.f, 0.f, 0.f};
        mrun[qi] = -1e30f; lrun[qi] = 0.f; }
    const float sc2 = 0.125f * LOG2E;
    const float nob[8] = {0.f, 0.f, 0.f, 0.f, 0.f, 0.f, 0.f, 0.f};
    __syncthreads();
    for (int t8 = 0; t8 < 8; ++t8) { KVFrag F; kv_load_lds(F, KC + t8 * 32 * 72, VC + t8 * 32 * 72, fr, fq);
#pragma unroll
        for (int qi = 0; qi < 2; ++qi) attn_one<0>(o[qi], mrun[qi], lrun[qi], qf[qi], F, sc2, 0, 0u, nob); }
    int seg_start[2], cbase[2]; unsigned okmask[2];
#pragma unroll
    for (int qi = 0; qi < 2; ++qi) { const int j = jb + qi; seg_start[qi] = j == 0 ? 0 : (j == 1 ? 8 : (j == 2 ? 24 : 32));
        const int qcol = j * 16 + fr; const int cs = qcol - 8 < 0 ? 0 : (qcol - 8 > 48 ? 48 : qcol - 8);
        unsigned m = 0u;
#pragma unroll
        for (int i = 0; i < 8; ++i) { const int keycol = seg_start[qi] + fq * 8 + i; if (keycol >= cs && keycol < cs + 16) m |= 1u << i; }
        okmask[qi] = m; cbase[qi] = seg_start[qi] + fq * 8 - qcol + 15; }
    const int rsq = qr - 4 < 0 ? 0 : (qr - 4 > 56 ? 56 : qr - 4);
    for (int t = 0; t < nloc; ++t) {
        const int R = rsa + t, cur = t & 1;
        u32x4 kreg = {0u, 0u, 0u, 0u}, vreg = {0u, 0u, 0u, 0u};
        if (t + 1 < nloc) { kreg = *(const u32x4*)(kglob + (size_t)((R + 1) * 64 + srow) * LDP1 + sch); vreg = *(const u32x4*)(vglob + (size_t)((R + 1) * 64 + srow) * LDP1 + sch); }
        if (R >= rsq && R < rsq + 8) {
            const LAS float* rb = bt + (R - qr + 7) * 31;
#pragma unroll
            for (int qi = 0; qi < 2; ++qi) { KVFrag F; kv_load_lds(F, KR + cur * 4608 + seg_start[qi] * 72, VR + cur * 4608 + seg_start[qi] * 72, fr, fq);
                float bias[8];
#pragma unroll
                for (int e = 0; e < 8; ++e) { int co = cbase[qi] + e; co = co < 0 ? 0 : (co > 30 ? 30 : co); bias[e] = rb[co]; }
                attn_one<2>(o[qi], mrun[qi], lrun[qi], qf[qi], F, sc2, 0, okmask[qi], bias); }
        }
        if (t + 1 < nloc) { *(LAS u32x4*)(KR + (cur ^ 1) * 4608 + srow * 72 + sch) = kreg; *(LAS u32x4*)(VR + (cur ^ 1) * 4608 + srow * 72 + sch) = vreg; }
        __syncthreads();
    }
#pragma unroll
    for (int qi = 0; qi < 2; ++qi) attn_store1(o[qi], lrun[qi], O + ((size_t)b * SEQ + qr * 64 + (jb + qi) * 16 + fr) * D + h * 64, fq);
}

DI void vt_unit(const bf16* P, int ldp, int vcol, int nh, bf16* Vt, int unit, LAS unsigned char* scr, int lane) {
    const int kb = unit % 68, bh = unit / 68, h = bh % nh, b = bh / nh;
    const size_t row0 = kb < 64 ? (size_t)b * SEQ + kb * 64 : (size_t)NLAT + b * CTXL + (kb - 64) * 64;
    LAS unsigned short* t = (LAS unsigned short*)scr;
#pragma unroll
    for (int i = 0; i < 8; ++i) { const int key = (lane >> 3) + 8 * i, ch = lane & 7;
        const u32x4 v = *(const u32x4*)(P + (row0 + key) * ldp + vcol + h * 64 + ch * 8);
        *(LAS u32x4*)(t + key * 72 + ch * 8) = v; }
    asm volatile("s_waitcnt lgkmcnt(0)" ::: "memory");
    bf16* dst = Vt + (size_t)(bh * 64 + lane) * KEYS + kb * 64;
#pragma unroll
    for (int g8 = 0; g8 < 8; ++g8) { unsigned short e[8];
#pragma unroll
        for (int i = 0; i < 8; ++i) e[i] = t[(g8 * 8 + i) * 72 + lane];
        u32x4 w; w.x = e[0] | ((unsigned)e[1] << 16); w.y = e[2] | ((unsigned)e[3] << 16); w.z = e[4] | ((unsigned)e[5] << 16); w.w = e[6] | ((unsigned)e[7] << 16);
        *(u32x4*)(dst + g8 * 8) = w; }
    asm volatile("s_waitcnt lgkmcnt(0)" ::: "memory");
}

constexpr int L_GW = 0, L_CUM = 4608, L_A = 21248, L_B = 30464, L_ATT = 39680, L_VT = 48896, L_SSQ = 67328, L_TOT = 67840;
DI size_t chunk_row0(int b, int n) { return n < 64 ? (size_t)b * SEQ + n * 64 : (size_t)NLAT + b * CTXL + (n - 64) * 64; }
DI float* cum_ptr(const Args& a, int dir, int bh, int n) { return (float*)(a.ws + (dir ? WS_CUM1 : WS_CUM0)) + (size_t)(bh * NCHUNK + n) * 4096; }
DI bf16* st_ptr(const Args& a, int seq, int n) { return n < 64 ? (bf16*)(a.ws + WS_YF) + (size_t)(seq * 64 + n) * 8192 : (bf16*)(a.ws + WS_STC) + (size_t)(seq * 4 + (n - 64)) * 8192; }

DI void gla_cum(const Args& a, LAS unsigned char* lds, const bf16* P, size_t row0, int h, int dir, int tid) {
    LAS float* rfl = (LAS float*)(lds + L_GW); LAS float* tot = (LAS float*)(lds + L_TOT); LAS float* cum = (LAS float*)(lds + L_CUM);
    const float* gw = a.in[dir ? I_GBW : I_GFW]; const float* gb = a.in[dir ? I_GBB : I_GFB];
    const int lane = tid & 63, w = tid >> 6;
    { const int c = tid >> 3, r2 = (tid & 7) * 2; const unsigned v = *(const unsigned*)(P + (row0 + c) * LDP0 + (dir ? C_RB : C_RF) + r2);
      rfl[c * 16 + r2] = __uint_as_float(v << 16); rfl[c * 16 + r2 + 1] = __uint_as_float(v & 0xffff0000u); }
    float gwr[16];
#pragma unroll
    for (int r = 0; r < 16; ++r) gwr[r] = gw[r * 256 + h * 64 + lane];
    const float gbv = gb[h * 64 + lane];
    __syncthreads();
    float la[8];
#pragma unroll
    for (int i = 0; i < 8; ++i) { const int c = w * 8 + i; float x = gbv;
#pragma unroll
        for (int r = 0; r < 16; ++r) x += rfl[c * 16 + r] * gwr[r];
        la[i] = (fminf(x, 0.f) - __logf(1.0f + __expf(-fabsf(x)))) * (1.0f / 16.0f); }
    if (dir == 0) {
#pragma unroll
        for (int i = 1; i < 8; ++i) la[i] += la[i - 1];
        tot[w * 64 + lane] = la[7];
    } else {
#pragma unroll
        for (int i = 6; i >= 0; --i) la[i] += la[i + 1];
        tot[w * 64 + lane] = la[0];
    }
    __syncthreads();
    float off = 0.f;
#pragma unroll
    for (int w2 = 0; w2 < 8; ++w2) { const float t = tot[w2 * 64 + lane]; off += ((dir == 0) ? (w2 < w) : (w2 > w)) ? t : 0.f; }
#pragma unroll
    for (int i = 0; i < 8; ++i) cum[(w * 8 + i) * 65 + lane] = la[i] + off;
    __syncthreads();
}
DI void gla_load_vt(LAS unsigned char* lds, const bf16* P, size_t row0, int h, int tid) {
    LAS unsigned short* vT = (LAS unsigned short*)(lds + L_VT);
    const int c = tid >> 3, dg = tid & 7;
    const bf16* vp = P + (row0 + c) * LDP0 + C_BV + h * 128 + dg * 16;
    const bf16x8 v0 = *(const bf16x8*)vp, v1 = *(const bf16x8*)(vp + 8);
#pragma unroll
    for (int e = 0; e < 8; ++e) { vT[(dg * 16 + e) * 72 + c] = (unsigned short)v0[e]; vT[(dg * 16 + 8 + e) * 72 + c] = (unsigned short)v1[e]; }
}
DI void gla_g1_unit(const Args& a, LAS unsigned char* lds, int unit, int tid, int lane, int wave) {
    const bf16* P = (const bf16*)(a.ws + WS_P);
    const int n = unit % NCHUNK, seq = unit / NCHUNK, dir = seq & 1, h = (seq >> 1) & 3, b = seq >> 3;
    const size_t row0 = chunk_row0(b, n);
    const bf16x8 kraw = *(const bf16x8*)(P + (row0 + (tid >> 3)) * LDP0 + C_BK + h * 64 + (tid & 7) * 8);
    gla_load_vt(lds, P, row0, h, tid);
    gla_cum(a, lds, P, row0, h, dir, tid);
    LAS float* cum = (LAS float*)(lds + L_CUM); LAS unsigned short* kdT = (LAS unsigned short*)(lds + L_A); LAS unsigned short* vT = (LAS unsigned short*)(lds + L_VT);
    const int cend = dir ? 0 : 63;
    { const int c = tid >> 3, dg = tid & 7; float kk[8]; unpack8(kraw, kk);
#pragma unroll
      for (int dd = 0; dd < 8; ++dd) { const int d = dg * 8 + dd; const float v = kk[dd] * __expf(cum[cend * 65 + d] - cum[c * 65 + d]); kdT[d * 72 + c] = (unsigned short)(pk2(v, 0.f) & 0xffffu); } }
    { const int c = tid >> 3, dg = tid & 7; float* cp = cum_ptr(a, dir, seq >> 1, n) + c * 64 + dg * 8;
      *(f32x4*)cp = (f32x4){cum[c * 65 + dg * 8], cum[c * 65 + dg * 8 + 1], cum[c * 65 + dg * 8 + 2], cum[c * 65 + dg * 8 + 3]};
      *(f32x4*)(cp + 4) = (f32x4){cum[c * 65 + dg * 8 + 4], cum[c * 65 + dg * 8 + 5], cum[c * 65 + dg * 8 + 6], cum[c * 65 + dg * 8 + 7]}; }
    if (tid < 64) ((float*)(a.ws + WS_DEC))[(size_t)(seq * NCHUNK + n) * 64 + tid] = __expf(cum[cend * 65 + tid]);
    __syncthreads();
    const int fr = lane & 15, fq = lane >> 4;
    bf16x8 av[2];
#pragma unroll
    for (int ks = 0; ks < 2; ++ks) av[ks] = *(const LAS bf16x8*)(vT + (wave * 16 + fr) * 72 + ks * 32 + fq * 8);
    bf16* st = st_ptr(a, seq, n);
#pragma unroll
    for (int nt = 0; nt < 4; ++nt) { f32x4 acc = {0.f, 0.f, 0.f, 0.f};
#pragma unroll
        for (int ks = 0; ks < 2; ++ks) { const bf16x8 bk = *(const LAS bf16x8*)(kdT + (nt * 16 + fr) * 72 + ks * 32 + fq * 8); acc = MFMA16(bk, av[ks], acc); }
        u32x2 w; w.x = pk2(acc[0], acc[1]); w.y = pk2(acc[2], acc[3]);
        *(u32x2*)(st + (wave * 16 + fr) * 64 + nt * 16 + fq * 4) = w; }
    __syncthreads();
}
DI void gla_scan(const Args& a, int tid) {
    const float* DEC = (const float*)(a.ws + WS_DEC);
    for (int e2 = blockIdx.x * NTHR + tid; e2 < 32 * 4096; e2 += gridDim.x * NTHR) {
        const int seq = e2 >> 12, el = (e2 & 4095) * 2, dk = el & 63, dir = seq & 1;
        float S0 = 0.f, S1 = 0.f;
        for (int s4 = 0; s4 < NCHUNK; s4 += 4) {
            unsigned* p[4]; unsigned t[4]; float d0[4], d1[4];
#pragma unroll
            for (int i = 0; i < 4; ++i) { const int step = s4 + i; const int n = dir == 0 ? (step < 4 ? 64 + step : step - 4) : 67 - step;
                p[i] = (unsigned*)(st_ptr(a, seq, n) + el); t[i] = *p[i];
                const float* dp = DEC + (size_t)(seq * NCHUNK + n) * 64 + dk; d0[i] = dp[0]; d1[i] = dp[1]; }
#pragma unroll
            for (int i = 0; i < 4; ++i) { *p[i] = pk2(S0, S1); S0 = d0[i] * S0 + __uint_as_float(t[i] << 16); S1 = d1[i] * S1 + __uint_as_float(t[i] & 0xffff0000u); }
        }
    }
}
DI void gla_g3_unit(const Args& a, LAS unsigned char* lds, int unit, int tid, int lane, int wave) {
    const bf16* P = (const bf16*)(a.ws + WS_P); bf16* O = (bf16*)(a.ws + WS_HO);
    const int n = unit % NCHUNK, bh = unit / NCHUNK, h = bh & 3, b = bh >> 2;
    const size_t row0 = chunk_row0(b, n);
    LAS float* cum = (LAS float*)(lds + L_CUM); LAS unsigned short* qg = (LAS unsigned short*)(lds + L_A); LAS unsigned short* kg = (LAS unsigned short*)(lds + L_B);
    LAS unsigned short* att = (LAS unsigned short*)(lds + L_ATT); LAS unsigned short* vT = (LAS unsigned short*)(lds + L_VT); LAS float* ssq = (LAS float*)(lds + L_SSQ);
    const int fr = lane & 15, fq = lane >> 4, ct = wave & 3, dvh = wave >> 2;
    gla_load_vt(lds, P, row0, h, tid);
    f32x4 acc[4];
#pragma unroll
    for (int nt = 0; nt < 4; ++nt) acc[nt] = (f32x4){0.f, 0.f, 0.f, 0.f};
    const bf16x8 qraw = *(const bf16x8*)(P + (row0 + (tid >> 3)) * LDP0 + C_BQ + h * 64 + (tid & 7) * 8), kraw = *(const bf16x8*)(P + (row0 + (tid >> 3)) * LDP0 + C_BK + h * 64 + (tid & 7) * 8);
    for (int dir = 0; dir < 2; ++dir) {
        const float* cp = cum_ptr(a, dir, bh, n) + (tid >> 3) * 64 + (tid & 7) * 8;
        const f32x4 c0 = *(const f32x4*)cp, c1 = *(const f32x4*)(cp + 4);
        const bf16* st = st_ptr(a, (bh * 2 + dir), n);
        bf16x8 sraw[4][2];
#pragma unroll
        for (int nt = 0; nt < 4; ++nt)
#pragma unroll
            for (int ks = 0; ks < 2; ++ks) sraw[nt][ks] = *(const bf16x8*)(st + ((dvh * 4 + nt) * 16 + fr) * 64 + ks * 32 + fq * 8);
        { const int c = tid >> 3, dg = tid & 7; float qq[8], kk[8], oq[8], ok[8];
          const float cu8[8] = {c0[0], c0[1], c0[2], c0[3], c1[0], c1[1], c1[2], c1[3]};
          unpack8(qraw, qq); unpack8(kraw, kk);
#pragma unroll
          for (int dd = 0; dd < 8; ++dd) { const float cu = cu8[dd]; oq[dd] = qq[dd] * 0.125f * __expf(cu); ok[dd] = kk[dd] * __expf(-cu); }
          *(LAS bf16x8*)(qg + c * 72 + dg * 8) = pack8(oq); *(LAS bf16x8*)(kg + c * 72 + dg * 8) = pack8(ok); }
        __syncthreads();
        bf16x8 bq[2];
#pragma unroll
        for (int ks = 0; ks < 2; ++ks) bq[ks] = *(const LAS bf16x8*)(qg + (ct * 16 + fr) * 72 + ks * 32 + fq * 8);
#pragma unroll
        for (int si = 0; si < 2; ++si) { const int st = dvh * 2 + si; f32x4 s = {0.f, 0.f, 0.f, 0.f};
#pragma unroll
            for (int ks = 0; ks < 2; ++ks) { const bf16x8 ak = *(const LAS bf16x8*)(kg + (st * 16 + fr) * 72 + ks * 32 + fq * 8); s = MFMA16(ak, bq[ks], s); }
            const int cpos = ct * 16 + fr; float pv[4];
#pragma unroll
            for (int r = 0; r < 4; ++r) { const int spos = st * 16 + fq * 4 + r; const bool keep = dir == 0 ? (spos <= cpos) : (spos >= cpos); pv[r] = keep ? s[r] : 0.f; }
            u32x2 w; w.x = pk2(pv[0], pv[1]); w.y = pk2(pv[2], pv[3]);
            *(LAS u32x2*)(att + cpos * 72 + st * 16 + fq * 4) = w; }
        __syncthreads();
        bf16x8 ba[2];
#pragma unroll
        for (int ks = 0; ks < 2; ++ks) ba[ks] = *(const LAS bf16x8*)(att + (ct * 16 + fr) * 72 + ks * 32 + fq * 8);
#pragma unroll
        for (int nt = 0; nt < 4; ++nt) { const int dvt = dvh * 4 + nt;
#pragma unroll
            for (int ks = 0; ks < 2; ++ks) {
                const bf16x8 av = *(const LAS bf16x8*)(vT + (dvt * 16 + fr) * 72 + ks * 32 + fq * 8);
                acc[nt] = MFMA16(av, ba[ks], acc[nt]);
                acc[nt] = MFMA16(sraw[nt][ks], bq[ks], acc[nt]); } }
        __syncthreads();
    }
    float sq = 0.f;
#pragma unroll
    for (int nt = 0; nt < 4; ++nt) sq += (acc[nt][0] * acc[nt][0] + acc[nt][1] * acc[nt][1]) + (acc[nt][2] * acc[nt][2] + acc[nt][3] * acc[nt][3]);
    sq += __shfl_xor(sq, 16); sq += __shfl_xor(sq, 32);
    if (fq == 0) ssq[wave * 16 + fr] = sq;
    __syncthreads();
    const float tot = ssq[wave * 16 + fr] + ssq[(wave ^ 4) * 16 + fr];
    const float rstd = __builtin_amdgcn_rsqf(tot * (1.0f / 128.0f) + EPS);
    const size_t row = row0 + ct * 16 + fr;
#pragma unroll
    for (int nt = 0; nt < 4; ++nt) { const int dv0 = (dvh * 4 + nt) * 16 + fq * 4;
        const f32x4 g4 = *(const f32x4*)(a.in[I_GNORM] + h * 128 + dv0);
        const u32x2 bw = *(const u32x2*)(P + row * LDP0 + C_BO + h * 128 + dv0);
        const float g0 = __uint_as_float(bw.x << 16), g1 = __uint_as_float(bw.x & 0xffff0000u), g2 = __uint_as_float(bw.y << 16), g3 = __uint_as_float(bw.y & 0xffff0000u);
        u32x2 w; w.x = pk2(acc[nt][0] * rstd * g4[0] * silu_f(g0), acc[nt][1] * rstd * g4[1] * silu_f(g1));
        w.y = pk2(acc[nt][2] * rstd * g4[2] * silu_f(g2), acc[nt][3] * rstd * g4[3] * silu_f(g3));
        *(u32x2*)(O + row * D + 512 + h * 128 + dv0) = w; }
    __syncthreads();
}

DI void rope_row(bf16* prow, int t, int lane) {
    const int prow_pos = t >> 6, pcol_pos = t & 63;
#pragma unroll
    for (int i = 0; i < 5; ++i) { const int pi = lane + 64 * i, head = pi >> 5, rem = pi & 31, half = rem >> 4, j = rem & 15;
        const int c1 = head * 64 + half * 32 + j, pos = half ? pcol_pos : prow_pos;
        const float cs = ROPE_COS[pos * 16 + j], sn = ROPE_SIN[pos * 16 + j];
        const float u1 = bf2f(prow[c1]), u2 = bf2f(prow[c1 + 16]);
        prow[c1] = (unsigned short)(pk2(u1 * cs - u2 * sn, 0.f) & 0xffffu); prow[c1 + 16] = (unsigned short)(pk2(u2 * cs + u1 * sn, 0.f) & 0xffffu); }
}

constexpr int NPHASE = 19;
#ifndef NA_NR
#define NA_NR 2
#endif
#ifndef PROBE_MASK
#define PROBE_MASK 0u
#endif
#define REPS(k) (((PROBE_MASK >> (k)) & 1u) ? 2 : 1)
__global__ void __launch_bounds__(NTHR, 2) fwd_kernel(Args a) {
    extern __shared__ __attribute__((aligned(16))) unsigned char lds_raw[];
    LAS unsigned char* lds = (LAS unsigned char*)lds_raw;
    const int tid = threadIdx.x, lane = tid & 63, wave = __builtin_amdgcn_readfirstlane(tid >> 6);
    const int G = gridDim.x, gw = blockIdx.x * NWAVES + wave, NGW = G * NWAVES;
    unsigned char* ws = a.ws;
    const int lo = a.ph_lo, hi = a.ph_hi;
#define IN(k) (lo <= (k) && (k) < hi)
#ifndef PROBE_SYNC
#define PROBE_SYNC 1
#endif
    volatile LAS unsigned* MISC = (volatile LAS unsigned*)(lds + 131072 + 320);
    if (tid < 32) MISC[tid] = 0u;
    __syncthreads();
    unsigned* barw = (unsigned*)(ws + WS_CTL);
    XcdBarrier xbar; xbar.bar = barw; xbar.x = 0; xbar.st = MISC + 8;
    if (hi - lo > 1) {
        if (blockIdx.x == 0) { for (int i = tid; i < XCD_BAR_WORDS; i += NTHR) barw[i] = 0u; }
        cg::this_grid().sync();
        xbar = xcd_barrier_post(barw, MISC + 8);
    }
#define SEAM(k) do { if (IN(k) && IN((k) + 1)) { for (int sr_ = 0; sr_ < PROBE_SYNC; ++sr_) xcd_barrier(xbar); } } while (0)
    bf16* H = (bf16*)(ws + WS_HO); bf16* YF = (bf16*)(ws + WS_YF); bf16* P = (bf16*)(ws + WS_P);

    if (IN(0)) { for (int rep = 0; rep < REPS(0); ++rep) { phase_prologue(a, lds, tid, lane, wave); __syncthreads(); } } SEAM(0);
    if (IN(1)) { for (int rep = 0; rep < REPS(1); ++rep) phase_rows(a, 0, 0, lane, wave); } SEAM(1);
    if (IN(2)) { pg8::Gemm g{H, (const bf16*)(ws + WS_WABI), MT, LDP0, D, D}; pg8::StaticOrder S; S.init(MT, LDP0, G, (int)blockIdx.x);
        EpiStore E{P, LDP0}; pg8::gemm_phase<EpiStore, pg8::StaticOrder, true, true>(lds, g, S, E); if (REPS(2) > 1) { pg8::gemm_phase<EpiStore, pg8::StaticOrder, true, true>(lds, g, S, E); } } SEAM(2);
    if (IN(3)) {
        for (int rep = 0; rep < REPS(3); ++rep) for (int u = blockIdx.x; u < 32 * NCHUNK; u += G) gla_g1_unit(a, lds, u, tid, lane, wave);
        __syncthreads();
        for (int m = gw; m < NLAT; m += NGW) rope_row(P + (size_t)m * LDP0, m & 4095, lane);
        for (int u = gw; u < NBATCH * 2 * 68; u += NGW) vt_unit(P, LDP0, C_AV, 2, (bf16*)(ws + WS_VTA), u, lds + wave * 16384, lane);
    } SEAM(3);
    if (IN(4)) {
        for (int rep = 0; rep < REPS(4); ++rep) for (int wt = gw; wt < 2176; wt += NGW) window_attn_tile(a, wt, lane);
        gla_scan(a, tid);
    } SEAM(4);
    if (IN(5)) { for (int rep = 0; rep < REPS(5); ++rep) for (int u = blockIdx.x; u < 16 * NCHUNK; u += G) gla_g3_unit(a, lds, u, tid, lane, wave); } SEAM(5);
    if (IN(6)) { pg8::Gemm g{H, (const bf16*)(ws + WS_WABO), NLAT, D, D, D}; pg8::StaticOrder S; S.init(NLAT, D, G, (int)blockIdx.x);
        EpiStore E{YF, D}; pg8::gemm_phase<EpiStore, pg8::StaticOrder, true, true>(lds, g, S, E); if (REPS(6) > 1) { pg8::gemm_phase<EpiStore, pg8::StaticOrder, true, true>(lds, g, S, E); }
        { const int bx = (int)blockIdx.x, kc = bx >> 4, uu = bx & 15; OneUnit S1{uu >> 2, uu & 3, bx < 64};
          pg8::Gemm g1{H + (size_t)NLAT * D + kc * 256, (const bf16*)(ws + WS_WABO) + kc * 256, NCTX, D, D, 256};
          EpiStore E1{(bf16*)(ws + WS_PART) + (size_t)kc * NCTX * D, D}; pg8::gemm_phase<EpiStore, OneUnit, true, true>(lds, g1, S1, E1); } } SEAM(6);
    if (IN(7)) { for (int rep = 0; rep < REPS(7); ++rep) phase_rows(a, 1, 0, lane, wave); } SEAM(7);
    if (IN(8)) { pg8::Gemm g{H, (const bf16*)(ws + WS_WFI), MT, 2 * FF, D, D}; pg8::StaticOrder S; S.init(MT, 2 * FF, G, (int)blockIdx.x);
        EpiSwiglu E{P, FF}; pg8::gemm_phase<EpiSwiglu, pg8::StaticOrder, true, true>(lds, g, S, E); if (REPS(8) > 1) { pg8::gemm_phase<EpiSwiglu, pg8::StaticOrder, true, true>(lds, g, S, E); } } SEAM(8);
    if (IN(9)) { pg8::Gemm g{P, (const bf16*)(ws + WS_WFO), NLAT, D, FF, FF}; pg8::StaticOrder S; S.init(NLAT, D, G, (int)blockIdx.x);
        EpiStore E{YF, D}; pg8::gemm_phase<EpiStore, pg8::StaticOrder, true, true>(lds, g, S, E); if (REPS(9) > 1) { pg8::gemm_phase<EpiStore, pg8::StaticOrder, true, true>(lds, g, S, E); }
        { const int bx = (int)blockIdx.x, kc = bx >> 4, uu = bx & 15; OneUnit S1{uu >> 2, uu & 3, bx < 176};
          pg8::Gemm g1{P + (size_t)NLAT * FF + kc * 256, (const bf16*)(ws + WS_WFO) + kc * 256, NCTX, D, FF, 256};
          EpiStore E1{(bf16*)(ws + WS_PART) + (size_t)kc * NCTX * D, D}; pg8::gemm_phase<EpiStore, OneUnit, true, true>(lds, g1, S1, E1); } } SEAM(9);
    if (IN(10)) { phase_rows(a, 2, 0, lane, wave); } SEAM(10);
    if (IN(11)) { pg8::Gemm g{H, (const bf16*)(ws + WS_WNI), MT, LDP1, D, D}; pg8::StaticOrder S; S.init(MT, LDP1, G, (int)blockIdx.x);
        EpiStore E{P, LDP1}; pg8::gemm_phase<EpiStore, pg8::StaticOrder, true, true>(lds, g, S, E); if (REPS(11) > 1) { pg8::gemm_phase<EpiStore, pg8::StaticOrder, true, true>(lds, g, S, E); } } SEAM(11);
    if (IN(13)) { for (int rep = 0; rep < REPS(13); ++rep) for (int u = blockIdx.x; u < 1024; u += G) na_attn_unit(a, lds, u, tid, lane, wave); } SEAM(13);
    if (IN(14)) { pg8::Gemm g{H, (const bf16*)(ws + WS_WNO), NLAT, D, D, D}; pg8::StaticOrder S; S.init(NLAT, D, G, (int)blockIdx.x);
        EpiStore E{YF, D}; pg8::gemm_phase<EpiStore, pg8::StaticOrder, true, true>(lds, g, S, E); if (REPS(14) > 1) { pg8::gemm_phase<EpiStore, pg8::StaticOrder, true, true>(lds, g, S, E); } } SEAM(14);
    if (IN(15)) { phase_rows(a, 1, 1, lane, wave); } SEAM(15);
    if (IN(16)) { pg8::Gemm g{H, (const bf16*)(ws + WS_WFI) + (size_t)5632 * 1024, NLAT, 2 * FF, D, D}; pg8::StaticOrder S; S.init(NLAT, 2 * FF, G, (int)blockIdx.x);
        EpiSwiglu E{P, FF}; pg8::gemm_phase<EpiSwiglu, pg8::StaticOrder, true, true>(lds, g, S, E); if (REPS(16) > 1) { pg8::gemm_phase<EpiSwiglu, pg8::StaticOrder, true, true>(lds, g, S, E); } } SEAM(16);
    if (IN(17)) { pg8::Gemm g{P, (const bf16*)(ws + WS_WFO) + (size_t)1024 * FF, NLAT, D, FF, FF}; pg8::StaticOrder S; S.init(NLAT, D, G, (int)blockIdx.x);
        EpiStore E{YF, D}; pg8::gemm_phase<EpiStore, pg8::StaticOrder, true, true>(lds, g, S, E); if (REPS(17) > 1) { pg8::gemm_phase<EpiStore, pg8::StaticOrder, true, true>(lds, g, S, E); } } SEAM(17);
    if (IN(18)) { phase_rows(a, 2, 1, lane, wave); }
#undef IN
#undef SEAM
}

extern "C" void kernel_launch(void* const* d_in, const int* in_sizes, int n_in, void* d_out, int out_size, void* d_ws, size_t ws_size, hipStream_t stream) {
    static int grid = 0;
    if (grid == 0) {
        if (n_in != 23 || out_size != NLAT * D || ws_size < WS_END) { fprintf(stderr, "kernel_launch: unexpected problem shape (n_in %d, out %d, ws %zu)\n", n_in, out_size, ws_size); grid = -1; return; }
        int dev = 0, cus = 0, per_cu = 0;
        (void)hipGetDevice(&dev); (void)hipDeviceGetAttribute(&cus, hipDeviceAttributeMultiprocessorCount, dev);
        if (hipFuncSetAttribute((const void*)fwd_kernel, hipFuncAttributeMaxDynamicSharedMemorySize, LDS_BYTES) != hipSuccess) { fprintf(stderr, "kernel_launch: hipFuncSetAttribute failed\n"); grid = -1; return; }
        (void)hipOccupancyMaxActiveBlocksPerMultiprocessor(&per_cu, (const void*)fwd_kernel, NTHR, LDS_BYTES);
        if (per_cu < 1) per_cu = 1;
        (void)hipGetLastError();
        grid = cus * per_cu;
    }
    if (grid < 0) return;
    Args a{};
    for (int i = 0; i < 23; ++i) a.in[i] = (const float*)d_in[i];
    a.out = (float*)d_out; a.ws = (unsigned char*)d_ws;
#if COOP
    a.ph_lo = 0; a.ph_hi = NPHASE;
    void* args[] = {&a};
    hipError_t e = hipLaunchCooperativeKernel((const void*)fwd_kernel, dim3(grid), dim3(NTHR), args, LDS_BYTES, stream);
    if (e != hipSuccess) fprintf(stderr, "cooperative launch failed: %s (grid %d)\n", hipGetErrorString(e), grid);
#else
    for (int p = 0; p < NPHASE; ++p) { a.ph_lo = p; a.ph_hi = p + 1; hipLaunchKernelGGL(fwd_kernel, dim3(grid), dim3(NTHR), LDS_BYTES, stream, a); }
#endif
}
```

```cpp
#include <hip/hip_runtime.h>
#include <hip/hip_cooperative_groups.h>
#include <cstdio>
#include <cstdint>
namespace cg = cooperative_groups;
namespace pg8 {
#define PG8_LAS __attribute__((address_space(3)))
typedef unsigned short bf16_t;
typedef short bf16x8 __attribute__((ext_vector_type(8)));
typedef float f32x4 __attribute__((ext_vector_type(4)));
typedef unsigned u32x4 __attribute__((ext_vector_type(4)));
constexpr int BM = 256, BK = 64, HALF = 128, HTB = HALF * BK * 2  , STAGE_BYTES = 8 * HTB, NXCD = 8, WGM = 8;

__host__ __device__ __forceinline__ int lds_byte(int r, int c) { const int st = (r >> 4) * 2 + (c >> 5), rr = r & 15, cc = c & 31, ob = rr * 64 + cc * 2; return st * 1024 + (ob ^ (((ob >> 9) & 1) << 5)); }
__host__ __device__ __forceinline__ void stage_rc(int b, int& R, int& C) { const int st = b / 1024, sb = b % 1024, swz = sb ^ (((sb >> 9) & 1) << 5); R = (st >> 1) * 16 + swz / 64; C = (st & 1) * 32 + (swz % 64) / 2; }
__host__ __device__ __forceinline__ int perm32(int rho) { const int n = rho >> 4, i = rho & 15; return 8 * (i >> 2) + 4 * n + (i & 3); }

struct Unit { int pm, pn; };
struct Gemm { const bf16_t* A; const bf16_t* Bt; int M, N, K, Kext; };

struct StaticOrder {
    int nM, nN, nwg, G, c;
    __host__ __device__ void init(int M, int N, int G_, int c_) { nM = M / BM; nN = N / BM; nwg = nM * nN; G = G_; c = c_; }
    __host__ __device__ bool next(int i, Unit& u) const {
        const long L = (long)i * G + c; if (L >= nwg) return false;
        int wgid = (int)L; { const int q = nwg / NXCD, r = nwg % NXCD, xcd = wgid % NXCD, off = wgid / NXCD; wgid = (xcd < r ? xcd * (q + 1) : r * (q + 1) + (xcd - r) * q) + off; }
        const int nig = WGM * nN, gid = wgid / nig, fm = gid * WGM, gsz = (nM - fm) < WGM ? (nM - fm) : WGM;
        u.pm = fm + ((wgid % nig) % gsz); u.pn = (wgid % nig) / gsz; return true;
    }
    __device__ __forceinline__ void a_ready(const Unit&) const {}
    __device__ __forceinline__ void done(const Unit&) const {}
};

__device__ __forceinline__ unsigned cvt_pk_bf16(float lo, float hi) { unsigned r; asm volatile("v_cvt_pk_bf16_f32 %0, %1, %2" : "=v"(r) : "v"(lo), "v"(hi)); return r; }
template <class Epi, class Sched, bool ALIGN_EPI = false, bool SP2 = false>
__device__ __forceinline__ void gemm_phase(PG8_LAS unsigned char* lds, const Gemm g, const Sched& S, const Epi& E) {
    const int tid = threadIdx.x, wid = __builtin_amdgcn_readfirstlane(tid >> 6), lane = tid & 63, wr = wid >> 2, wc = wid & 3, fr = lane & 15, fq = lane >> 4;
    const int K = g.K, nt = g.Kext / BK;
    unsigned voffA[2], voffB[2];
#pragma unroll
    for (int i = 0; i < 2; ++i) { int R, C; stage_rc(tid * 16 + i * 8192, R, C); const int Rb = Epi::PERM ? ((R & ~31) + perm32(R & 31)) : R;
        voffA[i] = (unsigned)(R * K + C) * 2u; voffB[i] = (unsigned)(Rb * K + C) * 2u; }
    const size_t kstep = (size_t)(BK * 2);
    const size_t hstep = (size_t)HALF * K * 2;
    const size_t tstep = 2 * hstep;
    const unsigned ldsw = (unsigned)wid * 1024u;
    const int aoff = lds_byte(wr * 64 + fr, fq * 8), boff = lds_byte(wc * 32 + fr, fq * 8);
#define PG8_SA(b, h) (((b) * 2 + (h)) * HTB)
#define PG8_SB(b, h) ((4 + (b) * 2 + (h)) * HTB)
#define PG8_STAGE(bufoff, gbase, voff) do { _Pragma("unroll") for (int _i = 0; _i < 2; ++_i) \
        __builtin_amdgcn_global_load_lds((const unsigned*)((const char*)(gbase) + (voff)[_i]), (PG8_LAS unsigned*)(lds + (bufoff) + ldsw + _i * 8192), 16, 0, 0); } while (0)
#define PG8_LDA(dst, b, h) do { _Pragma("unroll") for (int m = 0; m < 4; ++m) _Pragma("unroll") for (int k = 0; k < 2; ++k) dst[m][k] = *(const PG8_LAS bf16x8*)(lds + PG8_SA(b, h) + aoff + m * 2048 + k * 1024); } while (0)
#define PG8_LDB(dst, b, h) do { _Pragma("unroll") for (int n = 0; n < 2; ++n) _Pragma("unroll") for (int k = 0; k < 2; ++k) dst[n][k] = *(const PG8_LAS bf16x8*)(lds + PG8_SB(b, h) + boff + n * 2048 + k * 1024); } while (0)
#define PG8_MMA(ai, bj, At, Bt) do { __builtin_amdgcn_s_setprio(1); _Pragma("unroll") for (int m = 0; m < 4; ++m) _Pragma("unroll") for (int n = 0; n < 2; ++n) _Pragma("unroll") for (int k = 0; k < 2; ++k) \
        acc[ai][bj][m][n] = __builtin_amdgcn_mfma_f32_16x16x32_bf16(Bt[n][k], At[m][k], acc[ai][bj][m][n], 0, 0, 0); __builtin_amdgcn_s_setprio(0); } while (0)
#define PG8_WAIT_V(n) asm volatile("s_waitcnt vmcnt(" #n ")" ::: "memory")
#define PG8_WAIT_L(n) asm volatile("s_waitcnt lgkmcnt(" #n ")" ::: "memory")
#define PG8_BAR __builtin_amdgcn_s_barrier()
#define PG8_SCHED __builtin_amdgcn_sched_barrier(0)
    Unit cur, nxt; int ui = 0;
    if (!S.next(0, cur)) return;
    f32x4 acc[2][2][4][2];
#pragma unroll
    for (int a = 0; a < 2; ++a)
#pragma unroll
        for (int b = 0; b < 2; ++b)
#pragma unroll
            for (int m = 0; m < 4; ++m)
#pragma unroll
                for (int n = 0; n < 2; ++n) acc[a][b][m][n] = (f32x4){0.f, 0.f, 0.f, 0.f};
    bf16x8 At[4][2], B0[2][2], B1[2][2];
    const char* cA = (const char*)g.A + (size_t)cur.pm * tstep; const char* cB = (const char*)g.Bt + (size_t)cur.pn * tstep;
    S.a_ready(cur);
    if constexpr (SP2) {
        PG8_STAGE(PG8_SB(0, 0), cB, voffB); PG8_STAGE(PG8_SB(0, 1), cB + hstep, voffB); PG8_STAGE(PG8_SA(0, 0), cA, voffA); PG8_STAGE(PG8_SA(0, 1), cA + hstep, voffA);
        if (wr == 1) PG8_BAR;
        PG8_WAIT_V(2); PG8_BAR;
        PG8_STAGE(PG8_SB(1, 0), cB + kstep, voffB); PG8_STAGE(PG8_SA(1, 0), cA + kstep, voffA); PG8_STAGE(PG8_SB(1, 1), cB + hstep + kstep, voffB);
        PG8_WAIT_V(6); PG8_BAR;
    } else {
        PG8_STAGE(PG8_SB(0, 0), cB, voffB); PG8_STAGE(PG8_SA(0, 0), cA, voffA); PG8_STAGE(PG8_SB(0, 1), cB + hstep, voffB); PG8_STAGE(PG8_SA(0, 1), cA + hstep, voffA);
        if (wr == 1) PG8_BAR;
        PG8_WAIT_V(4); PG8_BAR;
        PG8_STAGE(PG8_SB(1, 0), cB + kstep, voffB); PG8_STAGE(PG8_SA(1, 0), cA + kstep, voffA); PG8_STAGE(PG8_SB(1, 1), cB + hstep + kstep, voffB);
        PG8_WAIT_V(6); PG8_BAR;
    }
    for (;;) {
        const bool has_next = S.next(ui + 1, nxt);
        const char* nA = has_next ? (const char*)g.A + (size_t)nxt.pm * tstep : cA; const char* nB = has_next ? (const char*)g.Bt + (size_t)nxt.pn * tstep : cB;
        for (int t = 0; t < nt; t += 2) {
            const bool last = (t == nt - 2);
            const char* a1 = cA + (size_t)(t + 1) * kstep;
            const char* a2 = last ? nA : cA + (size_t)(t + 2) * kstep; const char* b2 = last ? nB : cB + (size_t)(t + 2) * kstep;
            const char* a3 = a2 + kstep; const char* b3 = b2 + kstep;
            if (last && has_next) S.a_ready(nxt);
            if constexpr (SP2) {
            PG8_LDB(B0, 0, 0); PG8_LDB(B1, 0, 1); PG8_SCHED; PG8_LDA(At, 0, 0); PG8_STAGE(PG8_SA(1, 1), a1 + hstep, voffA);
            PG8_WAIT_V(8); PG8_WAIT_L(0); PG8_BAR; PG8_MMA(0, 0, At, B0); PG8_MMA(0, 1, At, B1); PG8_BAR; PG8_SCHED;
            PG8_LDA(At, 0, 1); PG8_STAGE(PG8_SB(0, 0), b2, voffB); PG8_STAGE(PG8_SB(0, 1), b2 + hstep, voffB); PG8_STAGE(PG8_SA(0, 0), a2, voffA);
            PG8_WAIT_V(8); PG8_WAIT_L(0); PG8_BAR; PG8_MMA(1, 0, At, B0); PG8_MMA(1, 1, At, B1); PG8_BAR; PG8_SCHED;
            PG8_LDB(B0, 1, 0); PG8_LDB(B1, 1, 1); PG8_SCHED; PG8_LDA(At, 1, 0); PG8_STAGE(PG8_SA(0, 1), a2 + hstep, voffA);
            PG8_WAIT_V(8); PG8_WAIT_L(0); PG8_BAR; PG8_MMA(0, 0, At, B0); PG8_MMA(0, 1, At, B1); PG8_BAR; PG8_SCHED;
            PG8_LDA(At, 1, 1); PG8_STAGE(PG8_SB(1, 0), b3, voffB); PG8_STAGE(PG8_SB(1, 1), b3 + hstep, voffB); PG8_STAGE(PG8_SA(1, 0), a3, voffA);
            PG8_WAIT_V(8); PG8_WAIT_L(0); PG8_BAR; PG8_MMA(1, 0, At, B0); PG8_MMA(1, 1, At, B1); PG8_BAR; PG8_SCHED;
            } else {
            PG8_LDB(B0, 0, 0); PG8_SCHED; PG8_LDA(At, 0, 0); PG8_STAGE(PG8_SA(1, 1), a1 + hstep, voffA);
            PG8_WAIT_L(8); PG8_BAR; PG8_WAIT_L(0); PG8_MMA(0, 0, At, B0); PG8_BAR; PG8_SCHED;
            PG8_LDB(B1, 0, 1); PG8_STAGE(PG8_SB(0, 0), b2, voffB);
            PG8_BAR; PG8_WAIT_L(0); PG8_MMA(0, 1, At, B1); PG8_BAR;
            PG8_LDA(At, 0, 1); PG8_STAGE(PG8_SA(0, 0), a2, voffA);
            PG8_BAR; PG8_WAIT_L(0); PG8_MMA(1, 0, At, B0); PG8_BAR; PG8_SCHED;
            PG8_STAGE(PG8_SB(0, 1), b2 + hstep, voffB);
            PG8_WAIT_V(6); PG8_BAR; PG8_MMA(1, 1, At, B1); PG8_BAR;
            PG8_LDB(B0, 1, 0); PG8_SCHED; PG8_LDA(At, 1, 0); PG8_STAGE(PG8_SA(0, 1), a2 + hstep, voffA);
            PG8_WAIT_L(8); PG8_BAR; PG8_WAIT_L(0); PG8_MMA(0, 0, At, B0); PG8_BAR; PG8_SCHED;
            PG8_LDB(B1, 1, 1); PG8_STAGE(PG8_SB(1, 0), b3, voffB);
            PG8_BAR; PG8_WAIT_L(0); PG8_MMA(0, 1, At, B1); PG8_BAR;
            PG8_LDA(At, 1, 1); PG8_STAGE(PG8_SA(1, 0), a3, voffA);
            PG8_BAR; PG8_WAIT_L(0); PG8_MMA(1, 0, At, B0); PG8_BAR; PG8_SCHED;
            PG8_STAGE(PG8_SB(1, 1), b3 + hstep, voffB);
            PG8_WAIT_V(6); PG8_BAR; PG8_MMA(1, 1, At, B1); PG8_BAR;
            }
        }
        if constexpr (ALIGN_EPI) { if (wr == 0) PG8_BAR; }
        if constexpr (!Epi::AFTER_DRAIN) { E(acc, cur, wr, wc, fr, fq); S.done(cur); }
        if (!has_next) break;
#pragma unroll
        for (int a = 0; a < 2; ++a)
#pragma unroll
            for (int b = 0; b < 2; ++b)
#pragma unroll
                for (int m = 0; m < 4; ++m)
#pragma unroll
                    for (int n = 0; n < 2; ++n) acc[a][b][m][n] = (f32x4){0.f, 0.f, 0.f, 0.f};
        cur = nxt; cA = nA; cB = nB; ++ui;
        if constexpr (ALIGN_EPI) { if (wr == 1) PG8_BAR; }
    }
    PG8_WAIT_V(0);
    if constexpr (!ALIGN_EPI) { if (wr == 0) PG8_BAR; }
    PG8_BAR;
    if constexpr (Epi::AFTER_DRAIN) { E.fused(acc, cur, wr, wc, fr, fq, lds, wid, lane); S.done(cur); }
#undef PG8_SA
#undef PG8_SB
#undef PG8_STAGE
#undef PG8_LDA
#undef PG8_LDB
#undef PG8_MMA
#undef PG8_WAIT_V
#undef PG8_WAIT_L
#undef PG8_BAR
#undef PG8_SCHED
}
}
__device__ const float ROPE_COS[1024] = {1.f,1.f,1.f,1.f,1.f,1.f,1.f,1.f,1.f,1.f,1.f,1.f,1.f,1.f,1.f,1.f,0.540302277f,0.846009135f,0.950415254f,0.98423022f,0.995004177f,0.998419285f,0.999500036f,0.999841869f,0.999949992f,0.999984205f,0.999994993f,0.999998391f,0.999999523f,0.999999821f,0.99999994f,1.f,-0.416146845f,0.431462824f,0.806578398f,0.937418282f,0.980066597f,0.993682086f,0.998000681f,0.999367595f,0.999800026f,0.999936759f,0.999979973f,0.999993682f,0.999997973f,0.999999344f,0.999999821f,0.99999994f,-0.989992499f,-0.115966164f,0.582753658f,0.861040652f,0.955336511f,0.985803485f,0.995503366f,0.998577297f,0.999550045f,0.999857724f,0.999954998f,0.999985754f,0.99999553f,0.999998569f,0.999999523f,0.999999881f,-0.653643608f,-0.627679706f,0.301137477f,0.757506192f,0.921060979f,0.974808276f,0.992010653f,0.997471273f,0.999200106f,0.999747038f,0.999920011f,0.999974728f,0.999992013f,0.999997497f,0.999999225f,0.999999762f,0.2836622f,-0.946079254f,-0.0103423381f,0.630080283f,0.87758255f,0.960731268f,0.987526f,0.996049762f,0.998750269f,0.999604762f,0.999875009f,0.999960482f,0.999987483f,0.999996066f,0.999998748f,0.999999583f,0.960170269f,-0.973103702f,-0.3207964f,0.482782036f,0.825335622f,0.943616986f,0.982053936f,0.9943133f,0.998200536f,0.999430835f,0.999819994f,0.999943078f,0.999981999f,0.999994338f,0.999998212f,0.999999404f,0.753902256f,-0.700429797f,-0.599437475f,0.320257008f,0.764842212f,0.923519433f,0.975599885f,0.992262423f,0.997551024f,0.999225318f,0.999755025f,0.999922514f,0.999975502f,0.999992251f,0.999997556f,0.999999225f,-0.145500034f,-0.212036446f,-0.818632424f,0.147631213f,0.696706712f,0.900502324f,0.968170285f,0.989897788f,0.996801734f,0.998988271f,0.999680042f,0.999898791f,0.999967992f,0.999989867f,0.999996781f,0.999998987f,-0.91113025f,0.341660261f,-0.956644177f,-0.0296507962f,0.621609926f,0.874638259f,0.959772646f,0.987220109f,0.995952725f,0.998719573f,0.999595046f,0.99987191f,0.999959528f,0.999987185f,0.999995947f,0.999998748f,-0.839071512f,0.790131867f,-0.999786079f,-0.205997631f,0.540302277f,0.846009135f,0.950415313f,0.98423022f,0.995004177f,0.998419285f,0.999500036f,0.999841869f,0.999949992f,0.999984205f,0.999994993f,0.999998391f,0.00442569796f,0.995257378f,-0.943779767f,-0.375847399f,0.453596085f,0.814705312f,0.940107584f,0.980929136f,0.993956089f,0.998087406f,0.999395072f,0.999808669f,0.999939501f,0.999980867f,0.99999392f,0.999998093f,0.843853951f,0.893861592f,-0.79417938f,-0.53384304f,0.362357706f,0.780825913f,0.92885989f,0.97731787f,0.99280864f,0.997723997f,0.999280095f,0.99977231f,0.999927998f,0.999977231f,0.999992788f,0.999997735f,0.907446802f,0.517172873f,-0.565820515f,-0.675001681f,0.267498761f,0.744477987f,0.916683376f,0.973397553f,0.99156189f,0.997329056f,0.999155104f,0.999732792f,0.999915481f,0.999973297f,0.999991536f,0.999997318f,0.136737213f,-0.0187961515f,-0.28134948f,-0.794870913f,0.16996716f,0.705776393f,0.903590262f,0.969169438f,0.990216017f,0.996902585f,0.999020159f,0.999690115f,0.99990201f,0.999969006f,0.999990225f,0.999996901f,-0.759687901f,-0.548975468f,0.0310223512f,-0.889670432f,0.070737198f,0.6648435f,0.889593601f,0.964634836f,0.988771081f,0.996444523f,0.998875201f,0.999644279f,0.999887526f,0.999964416f,0.999988735f,0.999996424f,-0.957659483f,-0.910081089f,0.340318173f,-0.95641005f,-0.0291995462f,0.621808827f,0.87470746f,0.959795177f,0.987227261f,0.99595499f,0.998720288f,0.999595284f,0.999872029f,0.999959528f,0.999987185f,0.999995947f,-0.275163352f,-0.990897954f,0.615864813f,-0.99298501f,-0.128844544f,0.576808274f,0.858946681f,0.954652011f,0.985584795f,0.995433986f,0.998555362f,0.999543071f,0.999855518f,0.999954283f,0.999985576f,0.99999541f,0.660316706f,-0.766536534f,0.830336154f,-0.998241663f,-0.227202162f,0.529984176f,0.842327058f,0.949207008f,0.983843684f,0.994881511f,0.998380423f,0.999487758f,0.999837995f,0.9999488f,0.999983788f,0.999994874f,0.988704622f,-0.306095392f,0.962463796f,-0.972014248f,-0.323289543f,0.481484592f,0.824865162f,0.943461835f,0.982004225f,0.994297504f,0.998195529f,0.999429286f,0.999819517f,0.999942899f,0.99998194f,0.999994278f,0.408082068f,0.248616725f,0.999144375f,-0.91512996f,-0.416146845f,0.431462824f,0.806578457f,0.937418282f,0.980066597f,0.993682086f,0.998000681f,0.999367595f,0.999800026f,0.999936759f,0.999979973f,0.999993682f,-0.547729254f,0.726760268f,0.936740458f,-0.829382956f,-0.504846215f,0.380077004f,0.787485182f,0.931078374f,0.97803092f,0.993035257f,0.99779582f,0.999302804f,0.999779522f,0.999930263f,0.999977946f,0.999993026f,-0.99996084f,0.981074572f,0.781440377f,-0.717477441f,-0.588501155f,0.327489585f,0.767604589f,0.92444396f,0.975897431f,0.992357016f,0.997581005f,0.999234855f,0.999758005f,0.999923468f,0.999975801f,0.999992371f,-0.53283304f,0.933235765f,0.548645258f,-0.582943261f,-0.666275978f,0.273866832f,0.746956408f,0.917517304f,0.97366637f,0.991647422f,0.997356176f,0.999163687f,0.999735534f,0.999916375f,0.999973536f,0.999991655f,0.424179018f,0.597977161f,0.261441678f,-0.430023283f,-0.737393796f,0.219378278f,0.725561321f,0.910300434f,0.971337974f,0.990906477f,0.997121394f,0.99908942f,0.99971199f,0.999908924f,0.999971211f,0.99999088f,0.991202831f,0.078552261f,-0.0516893305f,-0.263540596f,-0.801143587f,0.164196163f,0.703440726f,0.902795732f,0.968912423f,0.99013412f,0.996876657f,0.999011934f,0.999687493f,0.999901175f,0.999968767f,0.999990106f,0.64691931f,-0.465064496f,-0.359694332f,-0.0887455046f,-0.856888831f,0.108494945f,0.680616796f,0.895005584f,0.966389954f,0.98933053f,0.996621907f,0.998931348f,0.999662042f,0.999893129f,0.999966204f,0.999989331f,-0.292138815f,-0.865450621f,-0.632028639f,0.088848114f,-0.904072165f,0.0524506159f,0.6571123f,0.886932373f,0.963770926f,0.988495648f,0.996357203f,0.998847544f,0.999635518f,0.999884725f,0.999963522f,0.999988496f,-0.962605894f,-0.999293387f,-0.841684937f,0.26363951f,-0.942222297f,-0.00375941908f,0.632950664f,0.878578722f,0.961055458f,0.987629473f,0.996082544f,0.998760641f,0.99960804f,0.999876022f,0.99996078f,0.999987602f,-0.748057544f,-0.825371623f,-0.967871487f,0.430115849f,-0.970958173f,-0.0599575676f,0.608156204f,0.869947195f,0.958243906f,0.986732066f,0.995797932f,0.998670578f,0.999579549f,0.999867022f,0.999957979f,0.999986708f,0.154251456f,-0.397251874f,-0.998075247f,0.583026946f,-0.989992499f,-0.115966164f,0.582753658f,0.861040652f,0.955336511f,0.985803485f,0.995503366f,0.998577297f,0.999550045f,0.999857724f,0.999954998f,0.999985754f,0.914742351f,0.153215483f,-0.929300308f,0.717549205f,-0.999135137f,-0.171608135f,0.556768358f,0.851861775f,0.95233357f,0.984843671f,0.995198846f,0.998480916f,0.999519527f,0.999848068f,0.999951959f,0.999984801f,0.83422339f,0.656495154f,-0.768367112f,0.829440355f,-0.998294771f,-0.226707578f,0.53022635f,0.842413545f,0.949235439f,0.983852804f,0.994884372f,0.998381376f,0.999488056f,0.999838114f,0.9999488f,0.999983788f,-0.0132767474f,0.95758605f,-0.531235278f,0.915171385f,-0.987479806f,-0.281090319f,0.503154159f,0.832698941f,0.946042359f,0.982830763f,0.994559944f,0.998278618f,0.999455571f,0.999827802f,0.999945521f,0.999982774f,-0.848570287f,0.963757515f,-0.241421118f,0.972038329f,-0.966798186f,-0.334584385f,0.475578904f,0.822721004f,0.942754686f,0.981777668f,0.994225562f,0.99817276f,0.999422073f,0.999817252f,0.999942183f,0.999981701f,-0.903692186f,0.673110247f,0.0723346695f,0.998247743f,-0.93645668f,-0.387020677f,0.447528064f,0.812482953f,0.939372718f,0.980693519f,0.993881226f,0.998063743f,0.999387562f,0.999806345f,0.999938726f,0.999980628f,-0.127963692f,0.175156534f,0.378916174f,0.992972851f,-0.896758378f,-0.438233554f,0.419029742f,0.801987886f,0.935896814f,0.979578316f,0.993526995f,0.997951567f,0.999352098f,0.999795079f,0.99993521f,0.999979496f,0.765414059f,-0.376742303f,0.647921681f,0.95638001f,-0.848100007f,-0.488060862f,0.39011243f,0.791239262f,0.93232733f,0.978432178f,0.993162811f,0.997836173f,0.99931556f,0.999783576f,0.999931574f,0.999978364f,0.955073655f,-0.812611222f,0.852673113f,0.889623463f,-0.790967762f,-0.536345184f,0.360805035f,0.780240417f,0.928664625f,0.977255106f,0.992788672f,0.997717679f,0.999278069f,0.999771714f,0.999927819f,0.999977171f,0.266642928f,-0.998210371f,0.972865343f,0.794808388f,-0.72593224f,-0.582933903f,0.331136853f,0.768994927f,0.924909055f,0.976047099f,0.99240464f,0.997596025f,0.999239624f,0.999759495f,0.999923944f,0.999975979f,-0.666938066f,-0.87637943f,0.996578991f,0.674925625f,-0.653643608f,-0.627679706f,0.301137596f,0.757506192f,0.921060979f,0.974808276f,0.992010653f,0.997471273f,0.999200106f,0.999747038f,0.999920011f,0.999974728f,-0.987339258f,-0.484639406f,0.921462357f,0.533756077f,-0.574824035f,-0.670441091f,0.270837069f,0.745777905f,0.917120814f,0.973538578f,0.991606772f,0.997343302f,0.999159634f,0.999734223f,0.999915957f,0.999973416f,-0.399985313f,0.0563609414f,0.754965365f,0.375752151f,-0.490260571f,-0.711082935f,0.240265876f,0.733813822f,0.913088918f,0.972238123f,0.991192937f,0.997212172f,0.999118149f,0.99972111f,0.999911785f,0.999972105f,0.555113316f,0.580003142f,0.513598442f,0.205897167f,-0.400799006f,-0.749476731f,0.209454417f,0.721617639f,0.908965766f,0.970906913f,0.990769207f,0.997077882f,0.999075651f,0.999707639f,0.999907553f,0.999970794f,0.999843299f,0.925014675f,0.221298173f,0.0295478199f,-0.307332784f,-0.785501122f,0.178433523f,0.709193349f,0.904751658f,0.969545007f,0.990335584f,0.996940494f,0.99903214f,0.99969393f,0.999903202f,0.999969363f,0.52532196f,0.985138178f,-0.0929481089f,-0.147732988f,-0.210795805f,-0.819042206f,0.147234216f,0.696544766f,0.90044713f,0.968152404f,0.989892066f,0.996799886f,0.998987675f,0.999679863f,0.999898732f,0.999967992f,-0.432177931f,0.741858006f,-0.397976756f,-0.320354372f,-0.112152621f,-0.849993885f,0.115887694f,0.683675885f,0.89605248f,0.966729224f,0.989438653f,0.996656179f,0.998942196f,0.999665439f,0.999894202f,0.999966562f,-0.992335498f,0.270098448f,-0.663538277f,-0.48287195f,-0.0123883775f,-0.878258407f,0.0844252855f,0.670590878f,0.891568303f,0.965275466f,0.988975346f,0.996509314f,0.998895705f,0.999650776f,0.999889553f,0.999965072f,-0.640144348f,-0.284846604f,-0.863296509f,-0.630159974f,0.0874991715f,-0.903746367f,0.0528784581f,0.657293737f,0.886994898f,0.963791192f,0.988502085f,0.996359289f,0.9988482f,0.999635756f,0.999884784f,0.999963582f,0.300592542f,-0.75206399f,-0.977442741f,-0.757573068f,0.18651247f,-0.926377118f,0.0212787576f,0.643788815f,0.882332861f,0.962276459f,0.98801899f,0.996206105f,0.998799741f,0.999620378f,0.999879956f,0.999962032f,0.964965999f,-0.987659097f,-0.994656444f,-0.861092687f,0.2836622f,-0.946079254f,-0.0103422189f,0.630080283f,0.87758255f,0.960731268f,0.987526f,0.996049762f,0.998750269f,0.999604762f,0.999875009f,0.999960482f,0.742154181f,-0.919073522f,-0.913230121f,-0.937454224f,0.377977669f,-0.96279037f,-0.0419528559f,0.616172493f,0.872744501f,0.959155679f,0.987023175f,0.99589026f,0.998699784f,0.999588788f,0.999869943f,0.999958873f,-0.162990779f,-0.567430019f,-0.741239965f,-0.984248459f,0.468516916f,-0.976457715f,-0.0735215396f,0.602069914f,0.86781919f,0.95754981f,0.986510456f,0.995727658f,0.998648286f,0.999572515f,0.999864817f,0.999957263f,-0.918282807f,-0.0410281904f,-0.495741814f,-1.f,0.554374516f,-0.987038016f,-0.105016708f,0.587776959f,0.862807095f,0.955913603f,0.985987842f,0.995561838f,0.998595834f,0.999555886f,0.999859571f,0.999955595f,-0.829309821f,0.498009592f,-0.201079622f,-0.984212041f,0.634692967f,-0.994497895f,-0.136406869f,0.573298037f,0.857708693f,0.954247177f,0.985455394f,0.995392919f,0.998542368f,0.999538958f,0.999854207f,0.999953866f,0.0221267566f,0.883669317f,0.113521777f,-0.937382519f,0.708669782f,-0.998813629f,-0.167660639f,0.558637917f,0.852524519f,0.95255059f,0.984913111f,0.99522084f,0.99848789f,0.999521732f,0.999848783f,0.999952197f,0.853220105f,0.997174621f,0.416867077f,-0.860988438f,0.775565803f,-0.999971747f,-0.198746875f,0.543801069f,0.847255111f,0.950823903f,0.984360933f,0.995045662f,0.998432398f,0.999504209f,0.99984318f,0.999950409f,0.899866819f,0.803569078f,0.678870201f,-0.757439196f,0.834712923f,-0.997968495f,-0.22963427f,0.528792322f,0.841901004f,0.949067116f,0.983798921f,0.994867265f,0.998375952f,0.999486327f,0.999837577f,0.999948621f,0.119180135f,0.362476677f,0.873550534f,-0.63000071f,0.885519624f,-0.99281019f,-0.260292053f,0.513616323f,0.836462677f,0.947280347f,0.983227074f,0.994685769f,0.998318493f,0.999468148f,0.999831796f,0.999946833f,-0.771080196f,-0.1902491f,0.981602073f,-0.482692331f,0.927478492f,-0.984513164f,-0.290689558f,0.498277903f,0.830940723f,0.945463598f,0.982645452f,0.994501114f,0.998260021f,0.99944967f,0.999825954f,0.999944985f,-0.952412963f,-0.684381902f,0.992308319f,-0.320159167f,0.960170269f,-0.973103702f,-0.3207964f,0.482782036f,0.825335622f,0.943616986f,0.982053936f,0.9943133f,0.998200536f,0.999430835f,0.999819994f,0.999943078f,-0.258101642f,-0.967739642f,0.904607594f,-0.1475292f,0.98326844f,-0.958617806f,-0.350582451f,0.467133403f,0.819648027f,0.941740453f,0.981452644f,0.994122326f,0.998140097f,0.999411702f,0.999813974f,0.99994117f,0.673507154f,-0.953050017f,0.727198064f,0.0297537707f,0.996542096f,-0.941101313f,-0.380017966f,0.451337039f,0.813878477f,0.939834237f,0.980841517f,0.993928254f,0.998078644f,0.999392271f,0.999807835f,0.999939203f,0.985896587f,-0.644837022f,0.477671444f,0.206098333f,0.999858618f,-0.920609534f,-0.409073502f,0.435397953f,0.808027506f,0.937898219f,0.980220556f,0.993731022f,0.998016179f,0.999372482f,0.999801576f,0.999937236f};
__device__ const float ROPE_SIN[1024] = {0.f,0.f,0.f,0.f,0.f,0.f,0.f,0.f,0.f,0.f,0.f,0.f,0.f,0.f,0.f,0.f,0.841470957f,0.533168435f,0.310983598f,0.176892191f,0.0998334214f,0.0562044978f,0.0316175036f,0.0177818574f,0.00999983307f,0.00562338345f,0.00316227227f,0.0017782785f,0.000999999931f,0.000562341243f,0.000316227757f,0.00017782794f,0.909297407f,0.902130723f,0.591127098f,0.348205268f,0.198669329f,0.112231314f,0.0632033944f,0.0355580896f,0.0199986659f,0.011246589f,0.00632451288f,0.00355655141f,0.0019999987f,0.00112468237f,0.000632455456f,0.00035565588f,0.141120002f,0.993253171f,0.812648892f,0.5085361f,0.295520216f,0.167903304f,0.0947260857f,0.0533230826f,0.0299954992f,0.0168694388f,0.00948669016f,0.00533481315f,0.0029999956f,0.00168702309f,0.000948683126f,0.000533483806f,-0.756802499f,0.778471708f,0.953580737f,0.652827978f,0.389418334f,0.223044485f,0.126154065f,0.0710712075f,0.0399893336f,0.0224917568f,0.0126487734f,0.00711305765f,0.00399998948f,0.00224936334f,0.00126491068f,0.000711311703f,-0.958924294f,0.32393527f,0.999946535f,0.776529968f,0.47942555f,0.277480543f,0.157455876f,0.0887968615f,0.0499791652f,0.0281133614f,0.0158107281f,0.00889127981f,0.0049999794f,0.0028117029f,0.00158113812f,0.000889139599f,-0.279415488f,-0.230367512f,0.947148204f,0.875740528f,0.564642489f,0.33103931f,0.188600272f,0.106494442f,0.0599640049f,0.0337340795f,0.0189725272f,0.0106694745f,0.0059999642f,0.00337404152f,0.00189736532f,0.00106696738f,0.656986594f,-0.713721275f,0.800421596f,0.947330713f,0.64421767f,0.383551568f,0.219556093f,0.124158338f,0.0699428469f,0.0393537246f,0.0221341345f,0.0124476347f,0.00699994294f,0.00393637875f,0.00221359241f,0.00124479528f,0.989358246f,-0.977261782f,0.574317753f,0.989042461f,0.717356086f,0.434851229f,0.250292331f,0.141782969f,0.0799146891f,0.0449721329f,0.0252955221f,0.0142257558f,0.0079999147f,0.00449871505f,0.00252981926f,0.00142262306f,0.412118495f,-0.939823508f,0.291259229f,0.999560297f,0.783326924f,0.484776139f,0.280778319f,0.159362778f,0.0898785442f,0.0505891182f,0.0284566563f,0.0160038304f,0.00899987947f,0.00506105041f,0.00284604589f,0.00160045072f,-0.54402113f,-0.612936914f,-0.0206835698f,0.978552461f,0.841470957f,0.533168435f,0.310983568f,0.176892191f,0.099833414f,0.0562044978f,0.0316175036f,0.0177818574f,0.009999834f,0.00562338345f,0.00316227227f,0.0017782785f,-0.999990225f,-0.0972764567f,-0.33057496f,0.926681578f,0.891207397f,0.579875171f,0.340877861f,0.19436565f,0.1097783f,0.0618181042f,0.0347780399f,0.0195598267f,0.0109997792f,0.00618571462f,0.00347849843f,0.00195610616f,-0.536572933f,0.448342979f,-0.60768342f,0.845583618f,0.932039082f,0.624748647f,0.370431304f,0.211777672f,0.119712204f,0.0674297586f,0.0379382223f,0.0213377345f,0.0119997123f,0.0067480444f,0.00379472389f,0.00213393359f,0.420167029f,0.855880976f,-0.824528456f,0.737816215f,0.963558197f,0.667647004f,0.399614304f,0.229122713f,0.129634142f,0.0730392784f,0.0410980321f,0.0231155735f,0.0129996343f,0.00731037185f,0.00411094911f,0.00231176103f,0.990607381f,0.999823332f,-0.959605396f,0.606778562f,0.985449731f,0.708434701f,0.428397775f,0.246395305f,0.139543116f,0.078646481f,0.0442574248f,0.0248933397f,0.0139995432f,0.00787269697f,0.00442717411f,0.00248958869f,0.650287867f,0.835838437f,-0.999518692f,0.456603259f,0.997494996f,0.746982634f,0.456752867f,0.263589978f,0.149438128f,0.0842512026f,0.0474163815f,0.0266710296f,0.0149994381f,0.00843502022f,0.00474339863f,0.00266741589f,-0.287903309f,0.414430231f,-0.940310359f,0.292027086f,0.999573588f,0.783169091f,0.484651238f,0.280701309f,0.159318209f,0.0898532644f,0.0505748577f,0.028448632f,0.015999319f,0.00899733976f,0.00505962269f,0.00284524332f,-0.961397469f,-0.134615138f,-0.78785187f,0.11824052f,0.991664827f,0.81687957f,0.512064993f,0.29772386f,0.169182345f,0.09545248f,0.0537328273f,0.0302261449f,0.0169991814f,0.00955965649f,0.00537584582f,0.00302307028f,-0.750987232f,-0.642200708f,-0.557262897f,-0.0592755191f,0.973847628f,0.84800756f,0.538966715f,0.314652264f,0.179029569f,0.101048686f,0.0568902642f,0.0320035629f,0.0179990288f,0.0101219704f,0.00569206895f,0.00320089748f,0.149877205f,-0.952000856f,-0.271410108f,-0.234921798f,0.946300089f,0.876454532f,0.565329552f,0.331481189f,0.188858896f,0.10664168f,0.060047131f,0.0337808803f,0.0189988576f,0.0106842816f,0.00600829115f,0.00337872445f,0.912945271f,-0.968601942f,0.0413582884f,-0.403158993f,0.909297407f,0.902130723f,0.591127038f,0.348205268f,0.198669314f,0.112231314f,0.0632033944f,0.0355580896f,0.0199986678f,0.011246589f,0.00632451288f,0.00355655141f,0.836655617f,-0.686891198f,0.35002476f,-0.558680534f,0.863209307f,0.924954832f,0.616333544f,0.364819258f,0.208459899f,0.117817394f,0.0663590282f,0.0373351872f,0.0209984574f,0.0118088927f,0.00664073415f,0.00373437814f,-0.00885130931f,-0.193630233f,0.623979926f,-0.696581721f,0.808496356f,0.944854796f,0.640923738f,0.381317884f,0.218229622f,0.123399742f,0.0695140064f,0.0391121693f,0.0219982266f,0.0123711927f,0.00695695449f,0.00391220488f,-0.846220434f,0.359264523f,0.836055279f,-0.812512875f,0.745705247f,0.961767614f,0.664873064f,0.397695929f,0.227977514f,0.128978193f,0.0726682767f,0.0408890247f,0.0229979735f,0.0129334899f,0.00727317436f,0.00409003161f,-0.905578375f,0.801513135f,0.965219259f,-0.902817786f,0.67546314f,0.97563988f,0.688157499f,0.413948208f,0.237702623f,0.134552568f,0.0758218244f,0.0426657498f,0.0239976961f,0.0134957815f,0.0075893933f,0.00426785741f,-0.132351756f,0.996909976f,0.998663187f,-0.964648306f,0.598472118f,0.986427724f,0.710753918f,0.430069596f,0.247403964f,0.140122697f,0.0789746121f,0.0444423407f,0.0249973964f,0.0140580693f,0.00790561177f,0.00444568414f,0.76255846f,0.885276794f,0.933070183f,-0.996054351f,0.515501261f,0.994096994f,0.732639611f,0.446054995f,0.257080555f,0.145688385f,0.0821266174f,0.0462187938f,0.0259970706f,0.0146203535f,0.00822182931f,0.00462350994f,0.956375957f,0.500994205f,0.774945021f,-0.996045172f,0.427379847f,0.99862349f,0.753792703f,0.46189931f,0.266731411f,0.151249468f,0.0852777958f,0.0479951017f,0.0269967206f,0.015182632f,0.00853804592f,0.00480133574f,0.270905793f,-0.0375856608f,0.539968967f,-0.964621305f,0.334988207f,0.999992907f,0.774192095f,0.477597594f,0.276355654f,0.156805754f,0.0884281173f,0.049771253f,0.0279963426f,0.0157449059f,0.0088542616f,0.00497916201f,-0.663633883f,-0.564589798f,0.251445323f,-0.902773678f,0.239249229f,0.998200953f,0.793817401f,0.49314484f,0.28595221f,0.162357092f,0.0915775672f,0.0515472479f,0.0289959367f,0.0163071752f,0.00917047635f,0.00515698735f,-0.988031626f,-0.917709649f,-0.0620148405f,-0.812452853f,0.141120002f,0.993253171f,0.812648892f,0.5085361f,0.295520186f,0.167903304f,0.0947260931f,0.0533230826f,0.029995501f,0.0168694388f,0.00948669016f,0.00533481315f,-0.404037654f,-0.988192797f,-0.369325012f,-0.696507812f,0.0415805206f,0.985165298f,0.830667794f,0.523766637f,0.305058628f,0.173444211f,0.0978736654f,0.055098746f,0.0309950355f,0.0174316969f,0.00980290305f,0.00551263802f,0.551426709f,-0.754330218f,-0.640009403f,-0.5585953f,-0.0583741926f,0.973962843f,0.847856104f,0.538831532f,0.314566553f,0.17897962f,0.101020269f,0.0568742342f,0.0319945402f,0.0179939512f,0.0101191159f,0.00569046335f,0.999911845f,-0.28814739f,-0.847224355f,-0.403064936f,-0.157745644f,0.959681332f,0.864196658f,0.553726017f,0.324043006f,0.184509367f,0.10416586f,0.0586495437f,0.0329940096f,0.0185561981f,0.010435327f,0.00586828869f,0.529082716f,0.266779721f,-0.97042042f,-0.234822124f,-0.255541205f,0.942365825f,0.879673064f,0.568445385f,0.333487093f,0.190033287f,0.107310407f,0.0604246669f,0.0339934528f,0.0191184394f,0.010751537f,0.00604611309f,-0.428182662f,0.739542127f,-0.997380435f,-0.0591726787f,-0.350783229f,0.92207104f,0.894269884f,0.582984984f,0.342897803f,0.195551202f,0.110453881f,0.0621996038f,0.034992855f,0.0196806751f,0.0110677453f,0.00622393796f,-0.991778851f,0.984540582f,-0.925431013f,0.118342586f,-0.442520559f,0.89886117f,0.907972515f,0.597340286f,0.352274209f,0.201062918f,0.113596253f,0.0639743358f,0.0359922275f,0.0202429052f,0.0113839535f,0.0064017619f,-0.643538117f,0.926318109f,-0.761706948f,0.292125374f,-0.529836178f,0.872809589f,0.920767248f,0.611506701f,0.361615449f,0.206568271f,0.116737492f,0.0657488778f,0.036991559f,0.0208051261f,0.0117001599f,0.0065795863f,0.296368569f,0.58280617f,-0.522444785f,0.456694692f,-0.611857831f,0.84399873f,0.932641268f,0.625479698f,0.370920479f,0.212067112f,0.119877554f,0.0675232038f,0.0379908569f,0.0213673431f,0.0120163653f,0.00675741071f,0.963795364f,0.0598003156f,-0.231372014f,0.606860459f,-0.687766254f,0.81251961f,0.943582714f,0.639254928f,0.380188406f,0.217559248f,0.123016424f,0.0692973137f,0.0389901139f,0.0219295528f,0.0123325698f,0.00693523418f,0.745113134f,-0.481621295f,0.0826458037f,0.737885714f,-0.756802499f,0.778471708f,0.953580678f,0.652827978f,0.389418334f,0.223044485f,0.126154065f,0.0710712075f,0.0399893373f,0.0224917568f,0.0126487734f,0.00711305765f,-0.158622667f,-0.874714017f,0.388467699f,0.845638454f,-0.818277061f,0.74196279f,0.962625206f,0.666194677f,0.39860931f,0.228522688f,0.129290432f,0.0728448778f,0.0409885161f,0.0230539497f,0.0129649751f,0.00729088066f,-0.916521549f,-0.998410463f,0.655764699f,0.926720202f,-0.871575892f,0.703108132f,0.970707119f,0.679350674f,0.407760441f,0.233993664f,0.132425532f,0.0746183172f,0.0419876575f,0.0236161388f,0.0132811759f,0.00746870413f,-0.831774771f,-0.814614236f,0.858030677f,0.97857362f,-0.916166008f,0.662030637f,0.977818429f,0.692291796f,0.416870773f,0.23945722f,0.135559291f,0.0763915181f,0.0429867506f,0.0241783205f,0.0135973748f,0.00764652714f,0.0177019257f,-0.37993139f,0.975206196f,0.999563396f,-0.951602101f,0.618860185f,0.983951986f,0.70501405f,0.425939471f,0.244913206f,0.138691694f,0.0781644881f,0.0439858064f,0.0247404929f,0.0139135728f,0.00782434922f,0.850903511f,0.171763569f,0.995670974f,0.989027262f,-0.977530122f,0.57373327f,0.989101648f,0.717513323f,0.434965521f,0.250361472f,0.141822711f,0.0799371973f,0.0449848175f,0.0253026579f,0.0142297689f,0.00800217129f,0.901788354f,0.670557022f,0.917395473f,0.947297752f,-0.993690968f,0.526792526f,0.993262351f,0.72978574f,0.44394809f,0.255801797f,0.144952312f,0.0817096606f,0.0459837839f,0.0258648153f,0.0145459641f,0.0081799943f,0.123573124f,0.962832689f,0.748142362f,0.875690997f,-0.999923289f,0.478186339f,0.996429801f,0.741827428f,0.452886283f,0.261234075f,0.148080453f,0.0834818557f,0.0469827019f,0.0264269635f,0.0148621574f,0.00835781638f,-0.768254638f,0.958573103f,0.504697084f,0.776465356f,-0.99616462f,0.428068399f,0.99860096f,0.753634512f,0.461779177f,0.266658038f,0.151207119f,0.0852537975f,0.0479815714f,0.0269891042f,0.0151783489f,0.00853563752f,-0.953752637f,0.659090102f,0.211200655f,0.652750373f,-0.982452571f,0.376597136f,0.999773562f,0.765203178f,0.470625877f,0.272073567f,0.15433228f,0.087025471f,0.0489803962f,0.0275512375f,0.0154945394f,0.0087134596f,-0.262374848f,0.156619072f,-0.10324046f,0.508447945f,-0.958924294f,0.32393527f,0.999946535f,0.776529968f,0.47942555f,0.277480543f,0.157455891f,0.0887968615f,0.0499791689f,0.0281133596f,0.0158107281f,0.00889127981f,0.670229197f,-0.394086063f,-0.407444149f,0.3481085f,-0.925814748f,0.270249337f,0.99911958f,0.787611187f,0.48817724f,0.282878697f,0.160577938f,0.0905679762f,0.0509778969f,0.0286754742f,0.0161269177f,0.00906910095f,0.986627579f,-0.823421597f,-0.671240151f,0.176790684f,-0.883454502f,0.215709001f,0.997293651f,0.798443377f,0.496880114f,0.28826794f,0.163698375f,0.0923388004f,0.051976569f,0.0292375814f,0.0164431017f,0.00924692024f,0.395925164f,-0.999157965f,-0.868469954f,-0.000103020677f,-0.832267344f,0.160486728f,0.994470477f,0.809023023f,0.505533338f,0.293648034f,0.166817173f,0.0941093415f,0.0529751927f,0.0297996756f,0.0167592876f,0.00942474138f,-0.558789074f,-0.867171526f,-0.979574919f,-0.176993474f,-0.772764444f,0.104756832f,0.990652919f,0.819346905f,0.514135957f,0.29901889f,0.169934288f,0.0958795771f,0.0539737605f,0.0303617641f,0.0170754679f,0.00960256159f,-0.999755144f,-0.468111664f,-0.993535519f,-0.348301649f,-0.705540299f,0.0486960001f,0.985844791f,0.829411685f,0.522687256f,0.304380238f,0.173049718f,0.0976495072f,0.0549722798f,0.0309238415f,0.01739165f,0.00978038087f,-0.521551013f,0.0751182064f,-0.908967435f,-0.508624554f,-0.631266713f,-0.00751878507f,0.980050862f,0.839214146f,0.531186223f,0.30973196f,0.17616342f,0.0994191393f,0.0559707358f,0.0314859077f,0.0177078284f,0.00995820016f,0.436164767f,0.595211506f,-0.734258294f,-0.652905703f,-0.550685287f,-0.0637097955f,0.973276973f,0.848751247f,0.539632022f,0.315073937f,0.179275364f,0.101188451f,0.0569691435f,0.0320479684f,0.0180240069f,0.0101360194f,0.992872655f,0.931992829f,-0.486733496f,-0.776594579f,-0.464602023f,-0.119699396f,0.965529919f,0.858020008f,0.548023939f,0.3204059f,0.182385504f,0.102957435f,0.0579674877f,0.0326100141f,0.0183401816f,0.0103138378f,0.636738002f,0.981735826f,-0.190938011f,-0.87579f,-0.373876572f,-0.175310582f,0.956817448f,0.867017388f,0.55636102f,0.325727791f,0.185493827f,0.104726106f,0.0589657798f,0.0331720486f,0.0186563563f,0.0104916561f,-0.304810613f,0.729123712f,0.12379095f,-0.947363734f,-0.279415488f,-0.230367512f,0.947148204f,0.875740528f,0.564642429f,0.33103931f,0.188600287f,0.106494442f,0.0599640086f,0.0337340795f,0.0189725272f,0.0106694745f,-0.966117799f,0.251952261f,0.426245421f,-0.98905772f,-0.182162598f,-0.284696162f,0.936531842f,0.884186864f,0.572867453f,0.336340427f,0.191704854f,0.108262435f,0.0609621815f,0.0342960916f,0.0192886982f,0.0108472919f,-0.739180684f,-0.302812874f,0.686427653f,-0.999557257f,-0.0830891207f,-0.338124752f,0.924979091f,0.892353535f,0.581035137f,0.341630876f,0.194807529f,0.110030092f,0.0619602874f,0.0348580964f,0.0196048655f,0.0110251084f,0.167355701f,-0.764320076f,0.878538549f,-0.978531301f,0.0168140903f,-0.390484393f,0.912501454f,0.900238097f,0.589144766f,0.346910536f,0.197908238f,0.111797392f,0.0629583374f,0.0354200937f,0.0199210308f,0.0112029258f};
#define LAS __attribute__((address_space(3)))
#define XB_TMO      128
#define XB_XCNT(j)  (256  + 64 * (j))
#define XB_XSUB(j)  (1280 + 64 * (j))
#define XB_XGEN(j)  (2304 + 64 * (j))
#define XB_TOP      3328
#define XB_TOPGEN   3392
#define XCD_BAR_WORDS 3456
#define XB_SPIN_CAP (1u << 18)

__device__ __forceinline__ unsigned xb_ld(unsigned* p)              { return __hip_atomic_load(p, __ATOMIC_RELAXED, __HIP_MEMORY_SCOPE_AGENT); }
__device__ __forceinline__ unsigned xb_add(unsigned* p, unsigned v) { return __hip_atomic_fetch_add(p, v, __ATOMIC_RELAXED, __HIP_MEMORY_SCOPE_AGENT); }
__device__ __forceinline__ unsigned xb_xcc_id() { return (unsigned)__builtin_amdgcn_s_getreg((3 << 11) | 20) & 0xFu; }
#define XB_SPIN(cond, bar) do { unsigned _sp = 0; while (cond) { __builtin_amdgcn_s_sleep(1); \
    if ((++_sp & 255u) == 0u) { if (xb_ld(&(bar)[XB_TMO])) break; if (_sp > XB_SPIN_CAP) { atomicAdd(&(bar)[XB_TMO], 1u); break; } } } } while (0)

struct XcdBarrier {
    unsigned* bar; unsigned x;
    volatile LAS unsigned* st;
};

__device__ __forceinline__ XcdBarrier xcd_barrier_post(unsigned* bar, volatile LAS unsigned* st) {
    XcdBarrier b; b.bar = bar; b.x = xb_xcc_id(); b.st = st;
    if (threadIdx.x == 0) (void)xb_add(&bar[XB_XCNT(b.x)], 1u);
    return b;
}
__device__ __forceinline__ void xcd_barrier_complete(unsigned* bar, unsigned x, unsigned& nloc, unsigned& nx) {
    const unsigned G = gridDim.x * gridDim.y * gridDim.z;
    unsigned sum, cnt, mine, sp = 0u;
    for (;;) {
        sum = 0u; cnt = 0u; mine = 0u;
#pragma unroll
        for (unsigned j = 0; j < 16; ++j) { const unsigned c = xb_ld(&bar[XB_XCNT(j)]); sum += c; cnt += (c > 0u) ? 1u : 0u; mine = (j == x) ? c : mine; }
        if (sum == G) break;
        __builtin_amdgcn_s_sleep(1);
        if ((++sp & 255u) == 0u) { if (xb_ld(&bar[XB_TMO])) break; if (sp > XB_SPIN_CAP) { atomicAdd(&bar[XB_TMO], 1u); break; } }
    }
    nloc = mine > 0u ? mine : 1u; nx = cnt > 0u ? cnt : 1u;
}

__device__ __forceinline__ void xcd_barrier(const XcdBarrier& b) {
    asm volatile("s_waitcnt vmcnt(0)" ::: "memory");
    __syncthreads();
    if (threadIdx.x == 0) {
        unsigned* bar = b.bar;
        __builtin_amdgcn_s_waitcnt(0);
        unsigned nloc = b.st[0], nx = b.st[1];
        if (nloc == 0u) { xcd_barrier_complete(bar, b.x, nloc, nx); b.st[0] = nloc; b.st[1] = nx; }
        const unsigned old = xb_add(&bar[XB_XSUB(b.x)], 1u);
        const unsigned gen = old / nloc;
        if (old + 1u == (gen + 1u) * nloc) {
            __builtin_amdgcn_fence(__ATOMIC_RELEASE, "agent");
            asm volatile("s_waitcnt vmcnt(0)" ::: "memory");
            const unsigned og = xb_add(&bar[XB_TOP], 1u);
            const unsigned tg = og / nx;
            if (og + 1u == (tg + 1u) * nx) xb_add(&bar[XB_TOPGEN], 1u);
            else XB_SPIN(xb_ld(&bar[XB_TOPGEN]) == tg, bar);
            __builtin_amdgcn_fence(__ATOMIC_ACQUIRE, "agent");
            xb_add(&bar[XB_XGEN(b.x)], 1u);
            asm volatile("s_waitcnt vmcnt(0)" ::: "memory");
        } else {
            XB_SPIN(xb_ld(&bar[XB_XGEN(b.x)]) == gen, bar);
            __builtin_amdgcn_fence(__ATOMIC_ACQUIRE, "agent");
            asm volatile("s_waitcnt vmcnt(0)" ::: "memory");
        }
    }
    __syncthreads();
}

#define DI __device__ __forceinline__
#define LAS __attribute__((address_space(3)))
typedef unsigned short bf16;
typedef short bf16x8 __attribute__((ext_vector_type(8)));
typedef float f32x4 __attribute__((ext_vector_type(4)));
typedef unsigned u32x4 __attribute__((ext_vector_type(4)));
typedef unsigned u32x2 __attribute__((ext_vector_type(2)));

#ifndef COOP
#define COOP 1
#endif

constexpr int D = 1024, NBATCH = 4, SEQ = 4096, CTXL = 256, NLAT = NBATCH * SEQ, NCTX = NBATCH * CTXL, MT = NLAT + NCTX;
constexpr int FF = 2816, KEYS = SEQ + CTXL;
constexpr int LDP0 = 2560, LDP1 = 3072;
constexpr int C_AQ = 0, C_AK = 512, C_AV = 640, C_BQ = 768, C_BK = 1024, C_BV = 1280, C_BO = 1792, C_RF = 2304, C_RB = 2320;
constexpr float LOG2E = 1.4426950408889634f, EPS = 1e-6f;
constexpr int NCHUNK = 68;

constexpr size_t MiB = 1u << 20;
constexpr size_t WS_CTL = 0, WS_MOD = 1 * MiB, WS_XC = 2 * MiB, WS_WABI = 6 * MiB, WS_WABO = 11 * MiB, WS_WFI = 13 * MiB, WS_WFO = 35 * MiB, WS_WNI = 46 * MiB, WS_WNO = 52 * MiB;
constexpr size_t WS_HO = 54 * MiB, WS_YF = 88 * MiB, WS_P = 122 * MiB, WS_STC = 224 * MiB, WS_DEC = 228 * MiB, WS_END = 251 * MiB;
constexpr size_t WS_CUM0 = 207 * MiB, WS_CUM1 = 229 * MiB;
constexpr size_t WS_VTA = 246 * MiB;
constexpr size_t WS_PART = 224 * MiB;
constexpr int LDS_BYTES = 147456;
constexpr int NWAVES = 8, NTHR = 512;

DI float bf2f(unsigned short h) { return __uint_as_float(((unsigned)h) << 16); }
typedef float f32x2_t __attribute__((ext_vector_type(2)));
typedef __bf16 bf16x2_t __attribute__((ext_vector_type(2)));
DI unsigned pk2(float lo, float hi) { const f32x2_t v = {lo, hi}; const bf16x2_t b = __builtin_convertvector(v, bf16x2_t); return __builtin_bit_cast(unsigned, b); }
DI float wave_sum(float v) {
#pragma unroll
    for (int o = 1; o < 64; o <<= 1) v += __shfl_xor(v, o);
    return v;
}
DI float fast_exp2(float x) { return __builtin_amdgcn_exp2f(x); }
DI float silu_f(float g) { return g * __builtin_amdgcn_rcpf(1.0f + __expf(-g)); }
DI void unpack8(const bf16x8 v, float (&o)[8]) {
#pragma unroll
    for (int i = 0; i < 8; ++i) o[i] = bf2f((unsigned short)v[i]);
}
DI bf16x8 pack8(const float (&p)[8]) {
    u32x4 w; w.x = pk2(p[0], p[1]); w.y = pk2(p[2], p[3]); w.z = pk2(p[4], p[5]); w.w = pk2(p[6], p[7]);
    return __builtin_bit_cast(bf16x8, w);
}
#define MFMA16(a, b, c) __builtin_amdgcn_mfma_f32_16x16x32_bf16((a), (b), (c), 0, 0, 0)

struct EpiStore {
    static constexpr bool PERM = true, AFTER_DRAIN = false;
    bf16* O; int ldc;
    DI void operator()(const pg8::f32x4 (&acc)[2][2][4][2], const pg8::Unit& u, int wr, int wc, int fr, int fq) const {
        const int row0 = u.pm * 256 + wr * 64 + fr, col0 = u.pn * 256 + wc * 32 + 8 * fq;
#pragma unroll
        for (int ai = 0; ai < 2; ++ai)
#pragma unroll
            for (int m = 0; m < 4; ++m) { bf16* rowp = O + (size_t)(row0 + ai * 128 + m * 16) * ldc + col0;
#pragma unroll
                for (int bj = 0; bj < 2; ++bj) { const pg8::f32x4 v0 = acc[ai][bj][m][0], v1 = acc[ai][bj][m][1];
                    u32x4 w; w.x = pk2(v0[0], v0[1]); w.y = pk2(v0[2], v0[3]); w.z = pk2(v1[0], v1[1]); w.w = pk2(v1[2], v1[3]);
                    *(u32x4*)(rowp + bj * 128) = w; } }
    }
};
struct EpiSwiglu {
    static constexpr bool PERM = true, AFTER_DRAIN = false;
    bf16* O; int ldc;
    DI void operator()(const pg8::f32x4 (&acc)[2][2][4][2], const pg8::Unit& u, int wr, int wc, int fr, int fq) const {
        const int row0 = u.pm * 256 + wr * 64 + fr, col0 = u.pn * 128 + wc * 32 + 8 * fq;
#pragma unroll
        for (int ai = 0; ai < 2; ++ai)
#pragma unroll
            for (int m = 0; m < 4; ++m) { bf16* rowp = O + (size_t)(row0 + ai * 128 + m * 16) * ldc + col0;
                const pg8::f32x4 g0 = acc[ai][0][m][0], g1 = acc[ai][0][m][1], u0 = acc[ai][1][m][0], u1 = acc[ai][1][m][1];
                u32x4 w; w.x = pk2(silu_f(g0[0]) * u0[0], silu_f(g0[1]) * u0[1]); w.y = pk2(silu_f(g0[2]) * u0[2], silu_f(g0[3]) * u0[3]);
                w.z = pk2(silu_f(g1[0]) * u1[0], silu_f(g1[1]) * u1[1]); w.w = pk2(silu_f(g1[2]) * u1[2], silu_f(g1[3]) * u1[3]);
                *(u32x4*)rowp = w; }
    }
};

struct OneUnit {
    int pm, pn; bool has;
    DI bool next(int i, pg8::Unit& u) const { if (i != 0 || !has) return false; u.pm = pm; u.pn = pn; return true; }
    DI void a_ready(const pg8::Unit&) const {}
    DI void done(const pg8::Unit&) const {}
};

struct Args { const float* in[23]; float* out; unsigned char* ws; int ph_lo, ph_hi; };
enum { I_X = 0, I_C, I_CTX, I_CCTX, I_WMOD, I_BMOD, I_GMPRE, I_GMPOST, I_GFPRE, I_GFPOST, I_WFI, I_WFO, I_ABWI, I_ABWO, I_SINK, I_GFW, I_GFB, I_GBW, I_GBB, I_GNORM, I_NAWI, I_NAWO, I_RELB };

DI void transpose_item(const float* W, int K, int N, bf16* WT, int k0, int n0, int drow0, LAS float* scr, int lane) {
#pragma unroll 8
    for (int i = 0; i < 32; ++i) { const int kk = 2 * i + (lane >> 5); scr[kk * 33 + (lane & 31)] = W[(size_t)(k0 + kk) * N + n0 + (lane & 31)]; }
    asm volatile("s_waitcnt lgkmcnt(0)" ::: "memory");
    const int c = lane & 7;
#pragma unroll
    for (int j = 0; j < 4; ++j) { const int n = (lane >> 3) + 8 * j; const LAS float* s = scr + (8 * c) * 33 + n;
        u32x4 o; o.x = pk2(s[0 * 33], s[1 * 33]); o.y = pk2(s[2 * 33], s[3 * 33]); o.z = pk2(s[4 * 33], s[5 * 33]); o.w = pk2(s[6 * 33], s[7 * 33]);
        *(u32x4*)(WT + (size_t)(drow0 + n) * K + k0 + 8 * c) = o; }
    asm volatile("s_waitcnt lgkmcnt(0)" ::: "memory");
}
DI void xpose_plain(const float* W, int K, int N, bf16* WT, int item, LAS float* scr, int lane) {
    const int nblk = N / 32, kb = item / nblk, nb = item % nblk;
    transpose_item(W, K, N, WT, 64 * kb, 32 * nb, 32 * nb, scr, lane);
}
DI void xpose_ffnin(const float* W, bf16* WT, int item, LAS float* scr, int lane) {
    const int nblk = 5632 / 32, kb = item / nblk, nb = item % nblk, n0 = 32 * nb;
    const int bj = n0 >= FF ? 1 : 0, cc = n0 - bj * FF, drow0 = 256 * (cc >> 7) + 128 * bj + (cc & 127);
    transpose_item(W, 1024, 5632, WT, 64 * kb, n0, drow0, scr, lane);
}

DI void phase_prologue(const Args& a, LAS unsigned char* lds, int tid, int lane, int wave) {
    unsigned char* ws = a.ws;
    {
        LAS float* sl = (LAS float*)lds;
        LAS float* red = (LAS float*)(lds + 32768);
        for (int i = tid; i < 5 * 1024; i += NTHR) { const int s = i >> 10, k = i & 1023; const float v = s < 4 ? a.in[I_C][s * 1024 + k] : a.in[I_CCTX][k]; sl[i] = v / (1.0f + __expf(-v)); }
        __syncthreads();
        for (int u = blockIdx.x; u < 192; u += gridDim.x) {
            const int layer = u / 96, col = (u % 96) * 64 + lane;
            const float* W = a.in[I_WMOD] + (size_t)layer * 1024 * 6144 + col;
            float acc[5] = {0.f, 0.f, 0.f, 0.f, 0.f};
            const int kb = wave * 128;
#pragma unroll 8
            for (int k = 0; k < 128; ++k) { const float w = W[(size_t)(kb + k) * 6144];
#pragma unroll
                for (int s = 0; s < 5; ++s) acc[s] += sl[s * 1024 + kb + k] * w; }
#pragma unroll
            for (int s = 0; s < 5; ++s) red[(wave * 5 + s) * 64 + lane] = acc[s];
            __syncthreads();
            if (tid < 320) { const int s = tid >> 6, l = tid & 63; float t = 0.f;
#pragma unroll
                for (int w = 0; w < 8; ++w) t += red[(w * 5 + s) * 64 + l];
                const int c2 = (u % 96) * 64 + l;
                ((float*)(ws + WS_MOD))[(size_t)(layer * 5 + s) * 6144 + c2] = t + a.in[I_BMOD][layer * 6144 + c2]; }
            __syncthreads();
        }
        __syncthreads();
    }
    LAS float* scr = (LAS float*)(lds + wave * 16384);
    const int gw = blockIdx.x * NWAVES + wave, NGW = gridDim.x * NWAVES;
    constexpr int I_1 = 16 * 73, I_2 = 16 * 32, I_3 = 16 * 176, I_4 = 44 * 32, I_5 = 16 * 96, I_6 = 16 * 32;
    constexpr int NITEMS = I_1 + I_2 + 2 * I_3 + 2 * I_4 + I_5 + I_6;
    for (int it = gw; it < NITEMS; it += NGW) {
        int r = it;
        if (r < I_1) { xpose_plain(a.in[I_ABWI], 1024, 2336, (bf16*)(ws + WS_WABI), r, scr, lane); continue; } r -= I_1;
        if (r < I_2) { xpose_plain(a.in[I_ABWO], 1024, 1024, (bf16*)(ws + WS_WABO), r, scr, lane); continue; } r -= I_2;
        if (r < I_3) { xpose_ffnin(a.in[I_WFI], (bf16*)(ws + WS_WFI), r, scr, lane); continue; } r -= I_3;
        if (r < I_3) { xpose_ffnin(a.in[I_WFI] + (size_t)1024 * 5632, (bf16*)(ws + WS_WFI) + (size_t)5632 * 1024, r, scr, lane); continue; } r -= I_3;
        if (r < I_4) { xpose_plain(a.in[I_WFO], FF, 1024, (bf16*)(ws + WS_WFO), r, scr, lane); continue; } r -= I_4;
        if (r < I_4) { xpose_plain(a.in[I_WFO] + (size_t)FF * 1024, FF, 1024, (bf16*)(ws + WS_WFO) + (size_t)1024 * FF, r, scr, lane); continue; } r -= I_4;
        if (r < I_5) { xpose_plain(a.in[I_NAWI], 1024, 3072, (bf16*)(ws + WS_WNI), r, scr, lane); continue; } r -= I_5;
        xpose_plain(a.in[I_NAWO], 1024, 1024, (bf16*)(ws + WS_WNO), r, scr, lane);
    }
    { u32x4* z = (u32x4*)((bf16*)(ws + WS_WABI) + (size_t)2336 * 1024); const u32x4 zero = {0u, 0u, 0u, 0u};
      for (int i = blockIdx.x * NTHR + tid; i < 224 * 128; i += gridDim.x * NTHR) z[i] = zero; }
}

struct RowParams { f32x4 A[4], B[4], C[4]; };
DI void load_row_params(RowParams& p, const float* gpost, const float* gate, const float* gpre, const float* shift, const float* scale, int lane) {
#pragma unroll
    for (int j = 0; j < 4; ++j) {
        if (gate) p.A[j] = *((const f32x4*)gate + lane + 64 * j) * *((const f32x4*)gpost + lane + 64 * j);
        if (gpre) { p.B[j] = *((const f32x4*)gpre + lane + 64 * j) * (*((const f32x4*)scale + lane + 64 * j) + 1.0f); p.C[j] = *((const f32x4*)shift + lane + 64 * j); }
    }
}
DI void row_load(const float* xsrc, const bf16* y, int nslice, f32x4 (&v)[4], f32x4 (&yv)[4], int lane) {
#pragma unroll
    for (int j = 0; j < 4; ++j) { v[j] = *((const f32x4*)xsrc + lane + 64 * j); yv[j] = (f32x4){0.f, 0.f, 0.f, 0.f}; }
    if (y) {
        for (int sl = 0; sl < nslice; ++sl) {
#pragma unroll
            for (int j = 0; j < 4; ++j) { const u32x2 w = *((const u32x2*)(y + (size_t)sl * NCTX * D) + lane + 64 * j);
                yv[j] = yv[j] + (f32x4){__uint_as_float(w.x << 16), __uint_as_float(w.x & 0xffff0000u), __uint_as_float(w.y << 16), __uint_as_float(w.y & 0xffff0000u)}; } }
    }
}
DI void row_finish(f32x4 (&v)[4], const f32x4 (&yv)[4], bool has_y, float* xdst, bf16* hdst, const RowParams& p, int lane) {
    if (has_y) {
        float s = 0.f;
#pragma unroll
        for (int j = 0; j < 4; ++j) s += (yv[j].x * yv[j].x + yv[j].y * yv[j].y) + (yv[j].z * yv[j].z + yv[j].w * yv[j].w);
        const float rstd = __builtin_amdgcn_rsqf(wave_sum(s) * (1.0f / D) + EPS);
#pragma unroll
        for (int j = 0; j < 4; ++j) v[j] = v[j] + p.A[j] * (yv[j] * rstd);
    }
    if (xdst) {
#pragma unroll
        for (int j = 0; j < 4; ++j) *((f32x4*)xdst + lane + 64 * j) = v[j];
    }
    if (hdst) {
        float s = 0.f;
#pragma unroll
        for (int j = 0; j < 4; ++j) s += (v[j].x * v[j].x + v[j].y * v[j].y) + (v[j].z * v[j].z + v[j].w * v[j].w);
        const float rstd = __builtin_amdgcn_rsqf(wave_sum(s) * (1.0f / D) + EPS);
#pragma unroll
        for (int j = 0; j < 4; ++j) { const f32x4 h = v[j] * rstd * p.B[j] + p.C[j];
            u32x2 w; w.x = pk2(h.x, h.y); w.y = pk2(h.z, h.w);
            *((u32x2*)hdst + lane + 64 * j) = w; }
    }
}
DI void row_op(const float* xsrc, const bf16* y, int nslice, float* xdst, bf16* hdst, const RowParams& p, int lane) {
    f32x4 v[4], yv[4]; row_load(xsrc, y, nslice, v, yv, lane); row_finish(v, yv, y != nullptr, xdst, hdst, p, lane);
}
DI void row_op_pair(const float* xs0, const float* xs1, const bf16* y0, const bf16* y1, float* xd0, float* xd1, bf16* h0, bf16* h1, const RowParams& p, int lane) {
    f32x4 v0[4], yv0[4], v1[4], yv1[4];
    row_load(xs0, y0, 1, v0, yv0, lane); row_load(xs1, y1, 1, v1, yv1, lane);
    row_finish(v0, yv0, y0 != nullptr, xd0, h0, p, lane); row_finish(v1, yv1, y1 != nullptr, xd1, h1, p, lane);
}
DI void phase_rows(const Args& a, int mode, int layer, int lane, int wave) {
    unsigned char* ws = a.ws;
    const float* MOD = (const float*)(ws + WS_MOD);
    bf16* H = (bf16*)(ws + WS_HO); const bf16* YF = (const bf16*)(ws + WS_YF); const bf16* PART = (const bf16*)(ws + WS_PART); float* XC = (float*)(ws + WS_XC);
    const int gw = blockIdx.x * NWAVES + wave, NGW = gridDim.x * NWAVES;
    const int chunk = (NLAT + NGW - 1) / NGW, m0 = gw * chunk, m1 = (m0 + chunk < NLAT) ? m0 + chunk : NLAT;
    RowParams p; int sprev = -1;
    const int mend = (layer == 0) ? MT : NLAT;
    for (int it = 0; ; ++it) {
        int m; bool pair = false;
        if (m0 + it < m1) { m = m0 + it; pair = (m + 1 < m1) && ((m >> 12) == ((m + 1) >> 12)); }
        else { m = NLAT + gw + (it - (m1 > m0 ? m1 - m0 : 0)) * NGW; if (m >= mend) break; }
        const bool lat = m < NLAT; const int s = lat ? (m >> 12) : 4;
        const float* mod = MOD + (size_t)(layer * 5 + s) * 6144;
        if (s != sprev) { sprev = s;
            if (mode == 0) load_row_params(p, nullptr, nullptr, a.in[I_GMPRE], mod, mod + 1024, lane);
            else if (mode == 1) load_row_params(p, a.in[I_GMPOST] + layer * D, mod + 2048, a.in[I_GFPRE] + layer * D, mod + 3072, mod + 4096, lane);
            else if (layer == 0) { const float* mod1 = MOD + (size_t)(5 + s) * 6144; load_row_params(p, a.in[I_GFPOST], mod + 5120, a.in[I_GMPRE] + D, mod1, mod1 + 1024, lane); }
            else load_row_params(p, a.in[I_GFPOST] + D, mod + 5120, nullptr, nullptr, nullptr, lane); }
        float* xcur = lat ? a.out + (size_t)m * D : XC + (size_t)(m - NLAT) * D;
        const float* xin0 = lat ? a.in[I_X] + (size_t)m * D : a.in[I_CTX] + (size_t)(m - NLAT) * D;
        if (pair) {
            const float* xs = (mode == 0 || (mode == 1 && layer == 0)) ? xin0 : xcur; const bf16* yy = mode == 0 ? nullptr : YF + (size_t)m * D;
            float* xd = mode == 0 ? nullptr : xcur; bf16* hh = (mode == 2 && layer == 1) ? nullptr : H + (size_t)m * D;
            row_op_pair(xs, xs + D, yy, yy ? yy + D : nullptr, xd, xd ? xd + D : nullptr, hh, hh ? hh + D : nullptr, p, lane);
            ++it; continue;
        }
        if (mode == 0) row_op(xin0, nullptr, 0, nullptr, H + (size_t)m * D, p, lane);
        else if (mode == 1) row_op(layer == 0 ? xin0 : xcur, (layer == 0 && !lat) ? PART + (size_t)(m - NLAT) * D : YF + (size_t)m * D, (layer == 0 && !lat) ? 4 : 1, xcur, H + (size_t)m * D, p, lane);
        else if (layer == 0) row_op(xcur, lat ? YF + (size_t)m * D : PART + (size_t)(m - NLAT) * D, lat ? 1 : 11, xcur, H + (size_t)m * D, p, lane);
        else row_op(xcur, YF + (size_t)m * D, 1, xcur, nullptr, p, lane);
    }
}

DI float xmax_quads(float x) {
    unsigned u = __float_as_uint(x);
    auto r = __builtin_amdgcn_permlane16_swap(u, u, false, false);
    u = __float_as_uint(fmaxf(__uint_as_float(r[0]), __uint_as_float(r[1])));
    auto r2 = __builtin_amdgcn_permlane32_swap(u, u, false, false);
    return fmaxf(__uint_as_float(r2[0]), __uint_as_float(r2[1]));
}
DI float xsum_quads(float x) {
    unsigned u = __float_as_uint(x);
    auto r = __builtin_amdgcn_permlane16_swap(u, u, false, false);
    u = __float_as_uint(__uint_as_float(r[0]) + __uint_as_float(r[1]));
    auto r2 = __builtin_amdgcn_permlane32_swap(u, u, false, false);
    return __uint_as_float(r2[0]) + __uint_as_float(r2[1]);
}
struct KVFrag { bf16x8 kf[2][2]; bf16x8 vf[4]; };
DI void kv_load(KVFrag& f, const bf16* kp, int kld, const bf16* vp, int vld, int fr, int fq) {
#pragma unroll
    for (int h = 0; h < 2; ++h)
#pragma unroll
        for (int ks = 0; ks < 2; ++ks) f.kf[h][ks] = *(const bf16x8*)(kp + (size_t)((fr >> 2) * 8 + h * 4 + (fr & 3)) * kld + ks * 32 + fq * 8);
#pragma unroll
    for (int nt = 0; nt < 4; ++nt) f.vf[nt] = *(const bf16x8*)(vp + (size_t)(nt * 16 + fr) * vld + fq * 8);
}
template <int MODE>
DI void attn_one(f32x4 (&o)[4], float& mrun, float& lrun, const bf16x8 (&qf)[2], const KVFrag& f, float sc2, int d0, unsigned okmask, const float (&bias)[8]) {
    f32x4 s0 = {0.f, 0.f, 0.f, 0.f}, s1 = {0.f, 0.f, 0.f, 0.f};
    s0 = MFMA16(f.kf[0][0], qf[0], s0); s0 = MFMA16(f.kf[0][1], qf[1], s0);
    s1 = MFMA16(f.kf[1][0], qf[0], s1); s1 = MFMA16(f.kf[1][1], qf[1], s1);
    float sv[8] = {s0[0], s0[1], s0[2], s0[3], s1[0], s1[1], s1[2], s1[3]};
    float mx = -1e30f;
#pragma unroll
    for (int i = 0; i < 8; ++i) {
        float t = sv[i] * sc2;
        if (MODE == 1) { const int dd = d0 - i; t = (dd >= -128 && dd <= 128) ? t : -1e30f; }
        if (MODE == 2) { t = ((okmask >> i) & 1u) ? t + bias[i] : -1e30f; }
        sv[i] = t; mx = fmaxf(mx, t);
    }
    mx = xmax_quads(mx);
    {
        const float mn = fmaxf(mrun, mx), alpha = fast_exp2(mrun - mn);
        lrun *= alpha; mrun = mn;
#pragma unroll
        for (int nt = 0; nt < 4; ++nt) o[nt] = o[nt] * alpha;
    }
    float p[8], ps = 0.f;
#pragma unroll
    for (int i = 0; i < 8; ++i) { p[i] = fast_exp2(sv[i] - mrun); ps += p[i]; }
    lrun += xsum_quads(ps);
    const bf16x8 pf = pack8(p);
#pragma unroll
    for (int nt = 0; nt < 4; ++nt) o[nt] = MFMA16(f.vf[nt], pf, o[nt]);
}
DI void attn_store1(const f32x4 (&o)[4], float lrun, bf16* op, int fq) {
    const float inv = 1.0f / lrun;
#pragma unroll
    for (int nt = 0; nt < 4; ++nt) { u32x2 w; w.x = pk2(o[nt][0] * inv, o[nt][1] * inv); w.y = pk2(o[nt][2] * inv, o[nt][3] * inv);
        *(u32x2*)(op + nt * 16 + fq * 4) = w; }
}

DI void window_attn_tile(const Args& a, int wt, int lane) {
    const bf16* P = (const bf16*)(a.ws + WS_P); const bf16* VtA = (const bf16*)(a.ws + WS_VTA); bf16* O = (bf16*)(a.ws + WS_HO);
    const int fr = lane & 15, fq = lane >> 4;
    const bool isctx = wt >= 2048;
    int b, kvh, q0; size_t qrow;
    if (!isctx) { b = wt >> 9; kvh = (wt >> 8) & 1; q0 = (wt & 255) * 16; qrow = (size_t)b * SEQ + q0 + fr; }
    else { const int ct = wt - 2048; b = ct >> 5; kvh = (ct >> 4) & 1; q0 = (ct & 15) * 16; qrow = (size_t)NLAT + b * CTXL + q0 + fr; }
    bf16x8 qf[4][2]; f32x4 o[4][4]; float mrun[4], lrun[4];
#pragma unroll
    for (int g = 0; g < 4; ++g) {
#pragma unroll
        for (int ks = 0; ks < 2; ++ks) qf[g][ks] = *(const bf16x8*)(P + qrow * LDP0 + C_AQ + (kvh * 4 + g) * 64 + ks * 32 + fq * 8);
#pragma unroll
        for (int nt = 0; nt < 4; ++nt) o[g][nt] = (f32x4){0.f, 0.f, 0.f, 0.f};
        mrun[g] = a.in[I_SINK][kvh * 4 + g] * LOG2E; lrun[g] = 1.0f;
    }
    const float sc2 = 0.125f * LOG2E;
    const float nob[8] = {0.f, 0.f, 0.f, 0.f, 0.f, 0.f, 0.f, 0.f};
    const bf16* vbase = VtA + (size_t)((b * 2 + kvh) * 64) * KEYS;
    const bf16* kctx = P + (size_t)(NLAT + b * CTXL) * LDP0 + C_AK + kvh * 64;
    const bf16* kloc = P + (size_t)(b * SEQ) * LDP0 + C_AK + kvh * 64;
    const int tlo = (q0 - 128 > 0 ? q0 - 128 : 0) & ~31, thi = (q0 + 16 + 128 < SEQ) ? q0 + 16 + 128 : SEQ;
    const int ntile = isctx ? 8 : 8 + (thi - tlo + 31) / 32;
#define WIN_LOAD(F, t) do { const int t_ = (t); const int k0_ = t_ < 8 ? t_ * 32 : tlo + (t_ - 8) * 32; \
        kv_load(F, (t_ < 8 ? kctx : kloc) + (size_t)k0_ * LDP0, LDP0, vbase + (t_ < 8 ? SEQ : 0) + k0_, KEYS, fr, fq); } while (0)
#define WIN_PROC(F, t) do { const int t_ = (t); const int d0_ = t_ < 8 ? 0 : q0 + fr - (tlo + (t_ - 8) * 32) - fq * 8; \
        _Pragma("unroll") for (int g = 0; g < 4; ++g) attn_one<1>(o[g], mrun[g], lrun[g], qf[g], F, sc2, d0_, 0u, nob); } while (0)
    KVFrag A, B;
    WIN_LOAD(A, 0);
    for (int t = 0; t < ntile; t += 2) {
        WIN_LOAD(B, (t + 1 < ntile ? t + 1 : ntile - 1));
        WIN_PROC(A, t);
        WIN_LOAD(A, (t + 2 < ntile ? t + 2 : ntile - 1));
        if (t + 1 < ntile) WIN_PROC(B, t + 1);
    }
#undef WIN_LOAD
#undef WIN_PROC
#pragma unroll
    for (int g = 0; g < 4; ++g) attn_store1(o[g], lrun[g], O + qrow * D + (kvh * 4 + g) * 64, fq);
}

template <int NR>
DI void na_attn_group(const Args& a, int gid, int lane, LAS float* btab  ) {
    const bf16* P = (const bf16*)(a.ws + WS_P); const bf16* VtC = (const bf16*)(a.ws + WS_YF); bf16* O = (bf16*)(a.ws + WS_HO);
    const int fr = lane & 15, fq = lane >> 4;
    constexpr int NRG = 64 / NR; const int j = gid & 3, r0 = ((gid >> 2) % NRG) * NR, h = ((gid >> 2) / NRG) & 15, b = (gid >> 2) / (NRG * 16);
    { const float* relb = a.in[I_RELB] + h * 465;
      for (int i = lane; i < 465; i += 64) btab[i] = relb[i] * LOG2E;
      asm volatile("s_waitcnt vmcnt(0) lgkmcnt(0)" ::: "memory"); }
    bf16x8 qf[NR][2]; f32x4 o[NR][4]; float mrun[NR], lrun[NR];
#pragma unroll
    for (int qi = 0; qi < NR; ++qi) { const size_t qrow = (size_t)b * SEQ + (r0 + qi) * 64 + j * 16 + fr;
#pragma unroll
        for (int ks = 0; ks < 2; ++ks) qf[qi][ks] = *(const bf16x8*)(P + qrow * LDP1 + h * 64 + ks * 32 + fq * 8);
#pragma unroll
        for (int nt = 0; nt < 4; ++nt) o[qi][nt] = (f32x4){0.f, 0.f, 0.f, 0.f};
        mrun[qi] = -1e30f; lrun[qi] = 0.f; }
    const float sc2 = 0.125f * LOG2E;
    const float nob[8] = {0.f, 0.f, 0.f, 0.f, 0.f, 0.f, 0.f, 0.f};
    const bf16* vbase = VtC + (size_t)((b * 16 + h) * 64) * KEYS;
    const bf16* kctx = P + (size_t)(NLAT + b * CTXL) * LDP1 + 1024 + h * 64;
    const bf16* kloc = P + (size_t)(b * SEQ) * LDP1 + 1024 + h * 64;
    const int seg_start = j == 0 ? 0 : (j == 1 ? 8 : (j == 2 ? 24 : 32));
    const int qcol = j * 16 + fr; const int cs = qcol - 8 < 0 ? 0 : (qcol - 8 > 48 ? 48 : qcol - 8);
    unsigned okmask = 0u; int coloff[8];
#pragma unroll
    for (int i = 0; i < 8; ++i) { const int keycol = seg_start + fq * 8 + i; if (keycol >= cs && keycol < cs + 16) okmask |= 1u << i;
        int co = keycol - qcol + 15; co = co < 0 ? 0 : (co > 30 ? 30 : co); coloff[i] = co; }
    const int rsa = r0 - 4 < 0 ? 0 : (r0 - 4 > 56 ? 56 : r0 - 4);
    const int rsb = r0 + NR - 1 - 4 < 0 ? 0 : (r0 + NR - 1 - 4 > 56 ? 56 : r0 + NR - 1 - 4);
    const int nloc = rsb + 8 - rsa, ntile = 8 + nloc;
#define NA_LOAD(F, t) do { const int t_ = (t); const int k0_ = t_ < 8 ? t_ * 32 : (rsa + t_ - 8) * 64 + seg_start; \
        kv_load(F, (t_ < 8 ? kctx : kloc) + (size_t)k0_ * LDP1, LDP1, vbase + (t_ < 8 ? SEQ : 0) + k0_, KEYS, fr, fq); } while (0)
#define NA_PROC(F, t) do { const int t_ = (t); \
        if (t_ < 8) { _Pragma("unroll") for (int qi = 0; qi < NR; ++qi) attn_one<0>(o[qi], mrun[qi], lrun[qi], qf[qi], F, sc2, 0, 0u, nob); } \
        else { const int R_ = rsa + t_ - 8; \
            _Pragma("unroll") for (int qi = 0; qi < NR; ++qi) { const int r_ = r0 + qi; const int rs_ = r_ - 4 < 0 ? 0 : (r_ - 4 > 56 ? 56 : r_ - 4); \
                if (R_ >= rs_ && R_ < rs_ + 8) { const LAS float* rb_ = btab + (R_ - r_ + 7) * 31; float bias_[8]; \
                    _Pragma("unroll") for (int e = 0; e < 8; ++e) bias_[e] = rb_[coloff[e]]; \
                    attn_one<2>(o[qi], mrun[qi], lrun[qi], qf[qi], F, sc2, 0, okmask, bias_); } } } } while (0)
    if (NR <= 2) {
        KVFrag A, B;
        NA_LOAD(A, 0);
        for (int t = 0; t < ntile; t += 2) {
            NA_LOAD(B, (t + 1 < ntile ? t + 1 : ntile - 1));
            NA_PROC(A, t);
            NA_LOAD(A, (t + 2 < ntile ? t + 2 : ntile - 1));
            if (t + 1 < ntile) NA_PROC(B, t + 1);
        }
    } else {
        KVFrag A;
        for (int t = 0; t < ntile; ++t) { NA_LOAD(A, t); NA_PROC(A, t); }
    }
#undef NA_LOAD
#undef NA_PROC
#pragma unroll
    for (int qi = 0; qi < NR; ++qi) attn_store1(o[qi], lrun[qi], O + ((size_t)b * SEQ + (r0 + qi) * 64 + j * 16 + fr) * D + h * 64, fq);
}

constexpr int NA_KC = 0, NA_VC = 36864, NA_KR = 73728, NA_VR = 92160, NA_BT = 110592;
typedef short s16x4 __attribute__((ext_vector_type(4)));
DI void kv_load_lds(KVFrag& f, const LAS unsigned short* kimg, const LAS unsigned short* vimg  , int fr, int fq) {
#pragma unroll
    for (int h = 0; h < 2; ++h)
#pragma unroll
        for (int ks = 0; ks < 2; ++ks) f.kf[h][ks] = *(const LAS bf16x8*)(kimg + ((fr >> 2) * 8 + h * 4 + (fr & 3)) * 72 + ks * 32 + fq * 8);
#ifdef NA_PLAIN_V
#pragma unroll
    for (int nt = 0; nt < 4; ++nt) { bf16x8 v;
#pragma unroll
        for (int j = 0; j < 8; ++j) v[j] = (short)vimg[(fq * 8 + j) * 72 + nt * 16 + fr];
        f.vf[nt] = v; }
    return;
#endif
    typedef LAS s16x4* trp_t;
    const LAS unsigned short* vb = vimg + (fq * 8 + (fr >> 2)) * 72 + (fr & 3) * 4;
    const s16x4 l0 = __builtin_amdgcn_ds_read_tr16_b64_v4i16((trp_t)(vb)),      h0 = __builtin_amdgcn_ds_read_tr16_b64_v4i16((trp_t)(vb + 288));
    const s16x4 l1 = __builtin_amdgcn_ds_read_tr16_b64_v4i16((trp_t)(vb + 16)), h1 = __builtin_amdgcn_ds_read_tr16_b64_v4i16((trp_t)(vb + 304));
    const s16x4 l2 = __builtin_amdgcn_ds_read_tr16_b64_v4i16((trp_t)(vb + 32)), h2 = __builtin_amdgcn_ds_read_tr16_b64_v4i16((trp_t)(vb + 320));
    const s16x4 l3 = __builtin_amdgcn_ds_read_tr16_b64_v4i16((trp_t)(vb + 48)), h3 = __builtin_amdgcn_ds_read_tr16_b64_v4i16((trp_t)(vb + 336));
    f.vf[0] = __builtin_shufflevector(l0, h0, 0, 1, 2, 3, 4, 5, 6, 7); f.vf[1] = __builtin_shufflevector(l1, h1, 0, 1, 2, 3, 4, 5, 6, 7);
    f.vf[2] = __builtin_shufflevector(l2, h2, 0, 1, 2, 3, 4, 5, 6, 7); f.vf[3] = __builtin_shufflevector(l3, h3, 0, 1, 2, 3, 4, 5, 6, 7);
}
DI void na_attn_unit(const Args& a, LAS unsigned char* lds, int unit, int tid, int lane, int wave) {
    const bf16* P = (const bf16*)(a.ws + WS_P); bf16* O = (bf16*)(a.ws + WS_HO);
    LAS unsigned short* KC = (LAS unsigned short*)(lds + NA_KC); LAS unsigned short* VC = (LAS unsigned short*)(lds + NA_VC);
    LAS unsigned short* KR = (LAS unsigned short*)(lds + NA_KR); LAS unsigned short* VR = (LAS unsigned short*)(lds + NA_VR); LAS float* bt = (LAS float*)(lds + NA_BT);
    const int fr = lane & 15, fq = lane >> 4;
    const int r0 = (unit & 15) * 4, h = (unit >> 4) & 15, b = unit >> 8;
    const int qr = r0 + (wave >> 1), jb = (wave & 1) * 2;
    const bf16* kglob = P + (size_t)(b * SEQ) * LDP1 + 1024 + h * 64;
    const bf16* vglob = P + (size_t)(b * SEQ) * LDP1 + 2048 + h * 64;
    const int rsa = r0 - 4 < 0 ? 0 : (r0 - 4 > 56 ? 56 : r0 - 4);
    const int rsb = r0 + 3 - 4 < 0 ? 0 : (r0 + 3 - 4 > 56 ? 56 : r0 + 3 - 4);
    const int nloc = rsb + 8 - rsa;
    for (int i = tid; i < 465; i += NTHR) bt[i] = a.in[I_RELB][h * 465 + i] * LOG2E;
    { const int row = tid >> 1, half = tid & 1; const bf16* src = P + (size_t)(NLAT + b * CTXL + row) * LDP1 + 1024 + h * 64 + half * 32;
#pragma unroll
      for (int i = 0; i < 4; ++i) { *(LAS u32x4*)(KC + row * 72 + half * 32 + i * 8) = *(const u32x4*)(src + i * 8); *(LAS u32x4*)(VC + row * 72 + half * 32 + i * 8) = *(const u32x4*)(src + 1024 + i * 8); } }
    const int srow = tid >> 3, sch = (tid & 7) * 8;
    { const u32x4 kreg = *(const u32x4*)(kglob + (size_t)(rsa * 64 + srow) * LDP1 + sch), vreg = *(const u32x4*)(vglob + (size_t)(rsa * 64 + srow) * LDP1 + sch);
      *(LAS u32x4*)(KR + srow * 72 + sch) = kreg; *(LAS u32x4*)(VR + srow * 72 + sch) = vreg; }
    bf16x8 qf[2][2]; f32x4 o[2][4]; float mrun[2], lrun[2];
#pragma unroll
    for (int qi = 0; qi < 2; ++qi) { const size_t qrow = (size_t)b * SEQ + qr * 64 + (jb + qi) * 16 + fr;
#pragma unroll
        for (int ks = 0; ks < 2; ++ks) qf[qi][ks] = *(const bf16x8*)(P + qrow * LDP1 + h * 64 + ks * 32 + fq * 8);
#pragma unroll
        for (int nt = 0; nt < 4; ++nt) o[qi][nt] = (f32x4){0.f, 0.f, 0.f, 0.f};
        mrun[qi] = -1e30f; lrun[qi] = 0.f; }
    const float sc2 = 0.125f * LOG2E;
    const float nob[8] = {0.f, 0.f, 0.f, 0.f, 0.f, 0.f, 0.f, 0.f};
    __syncthreads();
    for (int t8 = 0; t8 < 8; ++t8) { KVFrag F; kv_load_lds(F, KC + t8 * 32 * 72, VC + t8 * 32 * 72, fr, fq);
#pragma unroll
        for (int qi = 0; qi < 2; ++qi) attn_one<0>(o[qi], mrun[qi], lrun[qi], qf[qi], F, sc2, 0, 0u, nob); }
    int seg_start[2], cbase[2]; unsigned okmask[2];
#pragma unroll
    for (int qi = 0; qi < 2; ++qi) { const int j = jb + qi; seg_start[qi] = j == 0 ? 0 : (j == 1 ? 8 : (j == 2 ? 24 : 32));
        const int qcol = j * 16 + fr; const int cs = qcol - 8 < 0 ? 0 : (qcol - 8 > 48 ? 48 : qcol - 8);
        unsigned m = 0u;
#pragma unroll
        for (int i = 0; i < 8; ++i) { const int keycol = seg_start[qi] + fq * 8 + i; if (keycol >= cs && keycol < cs + 16) m |= 1u << i; }
        okmask[qi] = m; cbase[qi] = seg_start[qi] + fq * 8 - qcol + 15; }
    const int rsq = qr - 4 < 0 ? 0 : (qr - 4 > 56 ? 56 : qr - 4);
    for (int t = 0; t < nloc; ++t) {
        const int R = rsa + t, cur = t & 1;
        u32x4 kreg = {0u, 0u, 0u, 0u}, vreg = {0u, 0u, 0u, 0u};
        if (t + 1 < nloc) { kreg = *(const u32x4*)(kglob + (size_t)((R + 1) * 64 + srow) * LDP1 + sch); vreg = *(const u32x4*)(vglob + (size_t)((R + 1) * 64 + srow) * LDP1 + sch); }
        if (R >= rsq && R < rsq + 8) {
            const LAS float* rb = bt + (R - qr + 7) * 31;
#pragma unroll
            for (int qi = 0; qi < 2; ++qi) { KVFrag F; kv_load_lds(F, KR + cur * 4608 + seg_start[qi] * 72, VR + cur * 4608 + seg_start[qi] * 72, fr, fq);
                float bias[8];
#pragma unroll
                for (int e = 0; e < 8; ++e) { int co = cbase[qi] + e; co = co < 0 ? 0 : (co > 30 ? 30 : co); bias[e] = rb[co]; }
                attn_one<2>(o[qi], mrun[qi], lrun[qi], qf[qi], F, sc2, 0, okmask[qi], bias); }
        }
        if (t + 1 < nloc) { *(LAS u32x4*)(KR + (cur ^ 1) * 4608 + srow * 72 + sch) = kreg; *(LAS u32x4*)(VR + (cur ^ 1) * 4608 + srow * 72 + sch) = vreg; }
        __syncthreads();
    }
#pragma unroll
    for (int qi = 0; qi < 2; ++qi) attn_store1(o[qi], lrun[qi], O + ((size_t)b * SEQ + qr * 64 + (jb + qi) * 16 + fr) * D + h * 64, fq);
}

DI void vt_unit(const bf16* P, int ldp, int vcol, int nh, bf16* Vt, int unit, LAS unsigned char* scr, int lane) {
    const int kb = unit % 68, bh = unit / 68, h = bh % nh, b = bh / nh;
    const size_t row0 = kb < 64 ? (size_t)b * SEQ + kb * 64 : (size_t)NLAT + b * CTXL + (kb - 64) * 64;
    LAS unsigned short* t = (LAS unsigned short*)scr;
#pragma unroll
    for (int i = 0; i < 8; ++i) { const int key = (lane >> 3) + 8 * i, ch = lane & 7;
        const u32x4 v = *(const u32x4*)(P + (row0 + key) * ldp + vcol + h * 64 + ch * 8);
        *(LAS u32x4*)(t + key * 72 + ch * 8) = v; }
    asm volatile("s_waitcnt lgkmcnt(0)" ::: "memory");
    bf16* dst = Vt + (size_t)(bh * 64 + lane) * KEYS + kb * 64;
#pragma unroll
    for (int g8 = 0; g8 < 8; ++g8) { unsigned short e[8];
#pragma unroll
        for (int i = 0; i < 8; ++i) e[i] = t[(g8 * 8 + i) * 72 + lane];
        u32x4 w; w.x = e[0] | ((unsigned)e[1] << 16); w.y = e[2] | ((unsigned)e[3] << 16); w.z = e[4] | ((unsigned)e[5] << 16); w.w = e[6] | ((unsigned)e[7] << 16);
        *(u32x4*)(dst + g8 * 8) = w; }
    asm volatile("s_waitcnt lgkmcnt(0)" ::: "memory");
}

constexpr int L_GW = 0, L_CUM = 4608, L_A = 21248, L_B = 30464, L_ATT = 39680, L_VT = 48896, L_SSQ = 67328, L_TOT = 67840;
DI size_t chunk_row0(int b, int n) { return n < 64 ? (size_t)b * SEQ + n * 64 : (size_t)NLAT + b * CTXL + (n - 64) * 64; }
DI float* cum_ptr(const Args& a, int dir, int bh, int n) { return (float*)(a.ws + (dir ? WS_CUM1 : WS_CUM0)) + (size_t)(bh * NCHUNK + n) * 4096; }
DI bf16* st_ptr(const Args& a, int seq, int n) { return n < 64 ? (bf16*)(a.ws + WS_YF) + (size_t)(seq * 64 + n) * 8192 : (bf16*)(a.ws + WS_STC) + (size_t)(seq * 4 + (n - 64)) * 8192; }

DI void gla_cum(const Args& a, LAS unsigned char* lds, const bf16* P, size_t row0, int h, int dir, int tid) {
    LAS float* rfl = (LAS float*)(lds + L_GW); LAS float* tot = (LAS float*)(lds + L_TOT); LAS float* cum = (LAS float*)(lds + L_CUM);
    const float* gw = a.in[dir ? I_GBW : I_GFW]; const float* gb = a.in[dir ? I_GBB : I_GFB];
    const int lane = tid & 63, w = tid >> 6;
    { const int c = tid >> 3, r2 = (tid & 7) * 2; const unsigned v = *(const unsigned*)(P + (row0 + c) * LDP0 + (dir ? C_RB : C_RF) + r2);
      rfl[c * 16 + r2] = __uint_as_float(v << 16); rfl[c * 16 + r2 + 1] = __uint_as_float(v & 0xffff0000u); }
    float gwr[16];
#pragma unroll
    for (int r = 0; r < 16; ++r) gwr[r] = gw[r * 256 + h * 64 + lane];
    const float gbv = gb[h * 64 + lane];
    __syncthreads();
    float la[8];
#pragma unroll
    for (int i = 0; i < 8; ++i) { const int c = w * 8 + i; float x = gbv;
#pragma unroll
        for (int r = 0; r < 16; ++r) x += rfl[c * 16 + r] * gwr[r];
        la[i] = (fminf(x, 0.f) - __logf(1.0f + __expf(-fabsf(x)))) * (1.0f / 16.0f); }
    if (dir == 0) {
#pragma unroll
        for (int i = 1; i < 8; ++i) la[i] += la[i - 1];
        tot[w * 64 + lane] = la[7];
    } else {
#pragma unroll
        for (int i = 6; i >= 0; --i) la[i] += la[i + 1];
        tot[w * 64 + lane] = la[0];
    }
    __syncthreads();
    float off = 0.f;
#pragma unroll
    for (int w2 = 0; w2 < 8; ++w2) { const float t = tot[w2 * 64 + lane]; off += ((dir == 0) ? (w2 < w) : (w2 > w)) ? t : 0.f; }
#pragma unroll
    for (int i = 0; i < 8; ++i) cum[(w * 8 + i) * 65 + lane] = la[i] + off;
    __syncthreads();
}
DI void gla_load_vt(LAS unsigned char* lds, const bf16* P, size_t row0, int h, int tid) {
    LAS unsigned short* vT = (LAS unsigned short*)(lds + L_VT);
    const int c = tid >> 3, dg = tid & 7;
    const bf16* vp = P + (row0 + c) * LDP0 + C_BV + h * 128 + dg * 16;
    const bf16x8 v0 = *(const bf16x8*)vp, v1 = *(const bf16x8*)(vp + 8);
#pragma unroll
    for (int e = 0; e < 8; ++e) { vT[(dg * 16 + e) * 72 + c] = (unsigned short)v0[e]; vT[(dg * 16 + 8 + e) * 72 + c] = (unsigned short)v1[e]; }
}
DI void gla_g1_unit(const Args& a, LAS unsigned char* lds, int unit, int tid, int lane, int wave) {
    const bf16* P = (const bf16*)(a.ws + WS_P);
    const int n = unit % NCHUNK, seq = unit / NCHUNK, dir = seq & 1, h = (seq >> 1) & 3, b = seq >> 3;
    const size_t row0 = chunk_row0(b, n);
    const bf16x8 kraw = *(const bf16x8*)(P + (row0 + (tid >> 3)) * LDP0 + C_BK + h * 64 + (tid & 7) * 8);
    gla_load_vt(lds, P, row0, h, tid);
    gla_cum(a, lds, P, row0, h, dir, tid);
    LAS float* cum = (LAS float*)(lds + L_CUM); LAS unsigned short* kdT = (LAS unsigned short*)(lds + L_A); LAS unsigned short* vT = (LAS unsigned short*)(lds + L_VT);
    const int cend = dir ? 0 : 63;
    { const int c = tid >> 3, dg = tid & 7; float kk[8]; unpack8(kraw, kk);
#pragma unroll
      for (int dd = 0; dd < 8; ++dd) { const int d = dg * 8 + dd; const float v = kk[dd] * __expf(cum[cend * 65 + d] - cum[c * 65 + d]); kdT[d * 72 + c] = (unsigned short)(pk2(v, 0.f) & 0xffffu); } }
    { const int c = tid >> 3, dg = tid & 7; float* cp = cum_ptr(a, dir, seq >> 1, n) + c * 64 + dg * 8;
      *(f32x4*)cp = (f32x4){cum[c * 65 + dg * 8], cum[c * 65 + dg * 8 + 1], cum[c * 65 + dg * 8 + 2], cum[c * 65 + dg * 8 + 3]};
      *(f32x4*)(cp + 4) = (f32x4){cum[c * 65 + dg * 8 + 4], cum[c * 65 + dg * 8 + 5], cum[c * 65 + dg * 8 + 6], cum[c * 65 + dg * 8 + 7]}; }
    if (tid < 64) ((float*)(a.ws + WS_DEC))[(size_t)(seq * NCHUNK + n) * 64 + tid] = __expf(cum[cend * 65 + tid]);
    __syncthreads();
    const int fr = lane & 15, fq = lane >> 4;
    bf16x8 av[2];
#pragma unroll
    for (int ks = 0; ks < 2; ++ks) av[ks] = *(const LAS bf16x8*)(vT + (wave * 16 + fr) * 72 + ks * 32 + fq * 8);
    bf16* st = st_ptr(a, seq, n);
#pragma unroll
    for (int nt = 0; nt < 4; ++nt) { f32x4 acc = {0.f, 0.f, 0.f, 0.f};
#pragma unroll
        for (int ks = 0; ks < 2; ++ks) { const bf16x8 bk = *(const LAS bf16x8*)(kdT + (nt * 16 + fr) * 72 + ks * 32 + fq * 8); acc = MFMA16(bk, av[ks], acc); }
        u32x2 w; w.x = pk2(acc[0], acc[1]); w.y = pk2(acc[2], acc[3]);
        *(u32x2*)(st + (wave * 16 + fr) * 64 + nt * 16 + fq * 4) = w; }
    __syncthreads();
}
DI void gla_scan(const Args& a, int tid) {
    const float* DEC = (const float*)(a.ws + WS_DEC);
    for (int e2 = blockIdx.x * NTHR + tid; e2 < 32 * 4096; e2 += gridDim.x * NTHR) {
        const int seq = e2 >> 12, el = (e2 & 4095) * 2, dk = el & 63, dir = seq & 1;
        float S0 = 0.f, S1 = 0.f;
        for (int s4 = 0; s4 < NCHUNK; s4 += 4) {
            unsigned* p[4]; unsigned t[4]; float d0[4], d1[4];
#pragma unroll
            for (int i = 0; i < 4; ++i) { const int step = s4 + i; const int n = dir == 0 ? (step < 4 ? 64 + step : step - 4) : 67 - step;
                p[i] = (unsigned*)(st_ptr(a, seq, n) + el); t[i] = *p[i];
                const float* dp = DEC + (size_t)(seq * NCHUNK + n) * 64 + dk; d0[i] = dp[0]; d1[i] = dp[1]; }
#pragma unroll
            for (int i = 0; i < 4; ++i) { *p[i] = pk2(S0, S1); S0 = d0[i] * S0 + __uint_as_float(t[i] << 16); S1 = d1[i] * S1 + __uint_as_float(t[i] & 0xffff0000u); }
        }
    }
}
DI void gla_g3_unit(const Args& a, LAS unsigned char* lds, int unit, int tid, int lane, int wave) {
    const bf16* P = (const bf16*)(a.ws + WS_P); bf16* O = (bf16*)(a.ws + WS_HO);
    const int n = unit % NCHUNK, bh = unit / NCHUNK, h = bh & 3, b = bh >> 2;
    const size_t row0 = chunk_row0(b, n);
    LAS float* cum = (LAS float*)(lds + L_CUM); LAS unsigned short* qg = (LAS unsigned short*)(lds + L_A); LAS unsigned short* kg = (LAS unsigned short*)(lds + L_B);
    LAS unsigned short* att = (LAS unsigned short*)(lds + L_ATT); LAS unsigned short* vT = (LAS unsigned short*)(lds + L_VT); LAS float* ssq = (LAS float*)(lds + L_SSQ);
    const int fr = lane & 15, fq = lane >> 4, ct = wave & 3, dvh = wave >> 2;
    gla_load_vt(lds, P, row0, h, tid);
    f32x4 acc[4];
#pragma unroll
    for (int nt = 0; nt < 4; ++nt) acc[nt] = (f32x4){0.f, 0.f, 0.f, 0.f};
    const bf16x8 qraw = *(const bf16x8*)(P + (row0 + (tid >> 3)) * LDP0 + C_BQ + h * 64 + (tid & 7) * 8), kraw = *(const bf16x8*)(P + (row0 + (tid >> 3)) * LDP0 + C_BK + h * 64 + (tid & 7) * 8);
    for (int dir = 0; dir < 2; ++dir) {
        const float* cp = cum_ptr(a, dir, bh, n) + (tid >> 3) * 64 + (tid & 7) * 8;
        const f32x4 c0 = *(const f32x4*)cp, c1 = *(const f32x4*)(cp + 4);
        const bf16* st = st_ptr(a, (bh * 2 + dir), n);
        bf16x8 sraw[4][2];
#pragma unroll
        for (int nt = 0; nt < 4; ++nt)
#pragma unroll
            for (int ks = 0; ks < 2; ++ks) sraw[nt][ks] = *(const bf16x8*)(st + ((dvh * 4 + nt) * 16 + fr) * 64 + ks * 32 + fq * 8);
        { const int c = tid >> 3, dg = tid & 7; float qq[8], kk[8], oq[8], ok[8];
          const float cu8[8] = {c0[0], c0[1], c0[2], c0[3], c1[0], c1[1], c1[2], c1[3]};
          unpack8(qraw, qq); unpack8(kraw, kk);
#pragma unroll
          for (int dd = 0; dd < 8; ++dd) { const float cu = cu8[dd]; oq[dd] = qq[dd] * 0.125f * __expf(cu); ok[dd] = kk[dd] * __expf(-cu); }
          *(LAS bf16x8*)(qg + c * 72 + dg * 8) = pack8(oq); *(LAS bf16x8*)(kg + c * 72 + dg * 8) = pack8(ok); }
        __syncthreads();
        bf16x8 bq[2];
#pragma unroll
        for (int ks = 0; ks < 2; ++ks) bq[ks] = *(const LAS bf16x8*)(qg + (ct * 16 + fr) * 72 + ks * 32 + fq * 8);
#pragma unroll
        for (int si = 0; si < 2; ++si) { const int st = dvh * 2 + si; f32x4 s = {0.f, 0.f, 0.f, 0.f};
#pragma unroll
            for (int ks = 0; ks < 2; ++ks) { const bf16x8 ak = *(const LAS bf16x8*)(kg + (st * 16 + fr) * 72 + ks * 32 + fq * 8); s = MFMA16(ak, bq[ks], s); }
            const int cpos = ct * 16 + fr; float pv[4];
#pragma unroll
            for (int r = 0; r < 4; ++r) { const int spos = st * 16 + fq * 4 + r; const bool keep = dir == 0 ? (spos <= cpos) : (spos >= cpos); pv[r] = keep ? s[r] : 0.f; }
            u32x2 w; w.x = pk2(pv[0], pv[1]); w.y = pk2(pv[2], pv[3]);
            *(LAS u32x2*)(att + cpos * 72 + st * 16 + fq * 4) = w; }
        __syncthreads();
        bf16x8 ba[2];
#pragma unroll
        for (int ks = 0; ks < 2; ++ks) ba[ks] = *(const LAS bf16x8*)(att + (ct * 16 + fr) * 72 + ks * 32 + fq * 8);
#pragma unroll
        for (int nt = 0; nt < 4; ++nt) { const int dvt = dvh * 4 + nt;
#pragma unroll
            for (int ks = 0; ks < 2; ++ks) {
                const bf16x8 av = *(const LAS bf16x8*)(vT + (dvt * 16 + fr) * 72 + ks * 32 + fq * 8);
                acc[nt] = MFMA16(av, ba[ks], acc[nt]);
                acc[nt] = MFMA16(sraw[nt][ks], bq[ks], acc[nt]); } }
        __syncthreads();
    }
    float sq = 0.f;
#pragma unroll
    for (int nt = 0; nt < 4; ++nt) sq += (acc[nt][0] * acc[nt][0] + acc[nt][1] * acc[nt][1]) + (acc[nt][2] * acc[nt][2] + acc[nt][3] * acc[nt][3]);
    sq += __shfl_xor(sq, 16); sq += __shfl_xor(sq, 32);
    if (fq == 0) ssq[wave * 16 + fr] = sq;
    __syncthreads();
    const float tot = ssq[wave * 16 + fr] + ssq[(wave ^ 4) * 16 + fr];
    const float rstd = __builtin_amdgcn_rsqf(tot * (1.0f / 128.0f) + EPS);
    const size_t row = row0 + ct * 16 + fr;
#pragma unroll
    for (int nt = 0; nt < 4; ++nt) { const int dv0 = (dvh * 4 + nt) * 16 + fq * 4;
        const f32x4 g4 = *(const f32x4*)(a.in[I_GNORM] + h * 128 + dv0);
        const u32x2 bw = *(const u32x2*)(P + row * LDP0 + C_BO + h * 128 + dv0);
        const float g0 = __uint_as_float(bw.x << 16), g1 = __uint_as_float(bw.x & 0xffff0000u), g2 = __uint_as_float(bw.y << 16), g3 = __uint_as_float(bw.y & 0xffff0000u);
        u32x2 w; w.x = pk2(acc[nt][0] * rstd * g4[0] * silu_f(g0), acc[nt][1] * rstd * g4[1] * silu_f(g1));
        w.y = pk2(acc[nt][2] * rstd * g4[2] * silu_f(g2), acc[nt][3] * rstd * g4[3] * silu_f(g3));
        *(u32x2*)(O + row * D + 512 + h * 128 + dv0) = w; }
    __syncthreads();
}

DI void rope_row(bf16* prow, int t, int lane) {
    const int prow_pos = t >> 6, pcol_pos = t & 63;
#pragma unroll
    for (int i = 0; i < 5; ++i) { const int pi = lane + 64 * i, head = pi >> 5, rem = pi & 31, half = rem >> 4, j = rem & 15;
        const int c1 = head * 64 + half * 32 + j, pos = half ? pcol_pos : prow_pos;
        const float cs = ROPE_COS[pos * 16 + j], sn = ROPE_SIN[pos * 16 + j];
        const float u1 = bf2f(prow[c1]), u2 = bf2f(prow[c1 + 16]);
        prow[c1] = (unsigned short)(pk2(u1 * cs - u2 * sn, 0.f) & 0xffffu); prow[c1 + 16] = (unsigned short)(pk2(u2 * cs + u1 * sn, 0.f) & 0xffffu); }
}

constexpr int NPHASE = 19;
#ifndef NA_NR
#define NA_NR 2
#endif
#ifndef PROBE_MASK
#define PROBE_MASK 0u
#endif
#define REPS(k) (((PROBE_MASK >> (k)) & 1u) ? 2 : 1)
__global__ void __launch_bounds__(NTHR, 2) fwd_kernel(Args a) {
    extern __shared__ __attribute__((aligned(16))) unsigned char lds_raw[];
    LAS unsigned char* lds = (LAS unsigned char*)lds_raw;
    const int tid = threadIdx.x, lane = tid & 63, wave = __builtin_amdgcn_readfirstlane(tid >> 6);
    const int G = gridDim.x, gw = blockIdx.x * NWAVES + wave, NGW = G * NWAVES;
    unsigned char* ws = a.ws;
    const int lo = a.ph_lo, hi = a.ph_hi;
#define IN(k) (lo <= (k) && (k) < hi)
#ifndef PROBE_SYNC
#define PROBE_SYNC 1
#endif
    volatile LAS unsigned* MISC = (volatile LAS unsigned*)(lds + 131072 + 320);
    if (tid < 32) MISC[tid] = 0u;
    __syncthreads();
    unsigned* barw = (unsigned*)(ws + WS_CTL);
    XcdBarrier xbar; xbar.bar = barw; xbar.x = 0; xbar.st = MISC + 8;
    if (hi - lo > 1) {
        if (blockIdx.x == 0) { for (int i = tid; i < XCD_BAR_WORDS; i += NTHR) barw[i] = 0u; }
        cg::this_grid().sync();
        xbar = xcd_barrier_post(barw, MISC + 8);
    }
#define SEAM(k) do { if (IN(k) && IN((k) + 1)) { for (int sr_ = 0; sr_ < PROBE_SYNC; ++sr_) xcd_barrier(xbar); } } while (0)
    bf16* H = (bf16*)(ws + WS_HO); bf16* YF = (bf16*)(ws + WS_YF); bf16* P = (bf16*)(ws + WS_P);

    if (IN(0)) { for (int rep = 0; rep < REPS(0); ++rep) { phase_prologue(a, lds, tid, lane, wave); __syncthreads(); } } SEAM(0);
    if (IN(1)) { for (int rep = 0; rep < REPS(1); ++rep) phase_rows(a, 0, 0, lane, wave); } SEAM(1);
    if (IN(2)) { pg8::Gemm g{H, (const bf16*)(ws + WS_WABI), MT, LDP0, D, D}; pg8::StaticOrder S; S.init(MT, LDP0, G, (int)blockIdx.x);
        EpiStore E{P, LDP0}; pg8::gemm_phase<EpiStore, pg8::StaticOrder, true, true>(lds, g, S, E); if (REPS(2) > 1) { pg8::gemm_phase<EpiStore, pg8::StaticOrder, true, true>(lds, g, S, E); } } SEAM(2);
    if (IN(3)) {
        for (int rep = 0; rep < REPS(3); ++rep) for (int u = blockIdx.x; u < 32 * NCHUNK; u += G) gla_g1_unit(a, lds, u, tid, lane, wave);
        __syncthreads();
        for (int m = gw; m < NLAT; m += NGW) rope_row(P + (size_t)m * LDP0, m & 4095, lane);
        for (int u = gw; u < NBATCH * 2 * 68; u += NGW) vt_unit(P, LDP0, C_AV, 2, (bf16*)(ws + WS_VTA), u, lds + wave * 16384, lane);
    } SEAM(3);
    if (IN(4)) {
        for (int rep = 0; rep < REPS(4); ++rep) for (int wt = gw; wt < 2176; wt += NGW) window_attn_tile(a, wt, lane);
        gla_scan(a, tid);
    } SEAM(4);
    if (IN(5)) { for (int rep = 0; rep < REPS(5); ++rep) for (int u = blockIdx.x; u < 16 * NCHUNK; u += G) gla_g3_unit(a, lds, u, tid, lane, wave); } SEAM(5);
    if (IN(6)) { pg8::Gemm g{H, (const bf16*)(ws + WS_WABO), NLAT, D, D, D}; pg8::StaticOrder S; S.init(NLAT, D, G, (int)blockIdx.x);
        EpiStore E{YF, D}; pg8::gemm_phase<EpiStore, pg8::StaticOrder, true, true>(lds, g, S, E); if (REPS(6) > 1) { pg8::gemm_phase<EpiStore, pg8::StaticOrder, true, true>(lds, g, S, E); }
        { const int bx = (int)blockIdx.x, kc = bx >> 4, uu = bx & 15; OneUnit S1{uu >> 2, uu & 3, bx < 64};
          pg8::Gemm g1{H + (size_t)NLAT * D + kc * 256, (const bf16*)(ws + WS_WABO) + kc * 256, NCTX, D, D, 256};
          EpiStore E1{(bf16*)(ws + WS_PART) + (size_t)kc * NCTX * D, D}; pg8::gemm_phase<EpiStore, OneUnit, true, true>(lds, g1, S1, E1); } } SEAM(6);
    if (IN(7)) { for (int rep = 0; rep < REPS(7); ++rep) phase_rows(a, 1, 0, lane, wave); } SEAM(7);
    if (IN(8)) { pg8::Gemm g{H, (const bf16*)(ws + WS_WFI), MT, 2 * FF, D, D}; pg8::StaticOrder S; S.init(MT, 2 * FF, G, (int)blockIdx.x);
        EpiSwiglu E{P, FF}; pg8::gemm_phase<EpiSwiglu, pg8::StaticOrder, true, true>(lds, g, S, E); if (REPS(8) > 1) { pg8::gemm_phase<EpiSwiglu, pg8::StaticOrder, true, true>(lds, g, S, E); } } SEAM(8);
    if (IN(9)) { pg8::Gemm g{P, (const bf16*)(ws + WS_WFO), NLAT, D, FF, FF}; pg8::StaticOrder S; S.init(NLAT, D, G, (int)blockIdx.x);
        EpiStore E{YF, D}; pg8::gemm_phase<EpiStore, pg8::StaticOrder, true, true>(lds, g, S, E); if (REPS(9) > 1) { pg8::gemm_phase<EpiStore, pg8::StaticOrder, true, true>(lds, g, S, E); }
        { const int bx = (int)blockIdx.x, kc = bx >> 4, uu = bx & 15; OneUnit S1{uu >> 2, uu & 3, bx < 176};
          pg8::Gemm g1{P + (size_t)NLAT * FF + kc * 256, (const bf16*)(ws + WS_WFO) + kc * 256, NCTX, D, FF, 256};
          EpiStore E1{(bf16*)(ws + WS_PART) + (size_t)kc * NCTX * D, D}; pg8::gemm_phase<EpiStore, OneUnit, true, true>(lds, g1, S1, E1); } } SEAM(9);
    if (IN(10)) { phase_rows(a, 2, 0, lane, wave); } SEAM(10);
    if (IN(11)) { pg8::Gemm g{H, (const bf16*)(ws + WS_WNI), MT, LDP1, D, D}; pg8::StaticOrder S; S.init(MT, LDP1, G, (int)blockIdx.x);
        EpiStore E{P, LDP1}; pg8::gemm_phase<EpiStore, pg8::StaticOrder, true, true>(lds, g, S, E); if (REPS(11) > 1) { pg8::gemm_phase<EpiStore, pg8::StaticOrder, true, true>(lds, g, S, E); } } SEAM(11);
    if (IN(13)) { for (int rep = 0; rep < REPS(13); ++rep) for (int u = blockIdx.x; u < 1024; u += G) na_attn_unit(a, lds, u, tid, lane, wave); } SEAM(13);
    if (IN(14)) { pg8::Gemm g{H, (const bf16*)(ws + WS_WNO), NLAT, D, D, D}; pg8::StaticOrder S; S.init(NLAT, D, G, (int)blockIdx.x);
        EpiStore E{YF, D}; pg8::gemm_phase<EpiStore, pg8::StaticOrder, true, true>(lds, g, S, E); if (REPS(14) > 1) { pg8::gemm_phase<EpiStore, pg8::StaticOrder, true, true>(lds, g, S, E); } } SEAM(14);
    if (IN(15)) { phase_rows(a, 1, 1, lane, wave); } SEAM(15);
    if (IN(16)) { pg8::Gemm g{H, (const bf16*)(ws + WS_WFI) + (size_t)5632 * 1024, NLAT, 2 * FF, D, D}; pg8::StaticOrder S; S.init(NLAT, 2 * FF, G, (int)blockIdx.x);
        EpiSwiglu E{P, FF}; pg8::gemm_phase<EpiSwiglu, pg8::StaticOrder, true, true>(lds, g, S, E); if (REPS(16) > 1) { pg8::gemm_phase<EpiSwiglu, pg8::StaticOrder, true, true>(lds, g, S, E); } } SEAM(16);
    if (IN(17)) { pg8::Gemm g{P, (const bf16*)(ws + WS_WFO) + (size_t)1024 * FF, NLAT, D, FF, FF}; pg8::StaticOrder S; S.init(NLAT, D, G, (int)blockIdx.x);
        EpiStore E{YF, D}; pg8::gemm_phase<EpiStore, pg8::StaticOrder, true, true>(lds, g, S, E); if (REPS(17) > 1) { pg8::gemm_phase<EpiStore, pg8::StaticOrder, true, true>(lds, g, S, E); } } SEAM(17);
    if (IN(18)) { phase_rows(a, 2, 1, lane, wave); }
#undef IN
#undef SEAM
}

extern "C" void kernel_launch(void* const* d_in, const int* in_sizes, int n_in, void* d_out, int out_size, void* d_ws, size_t ws_size, hipStream_t stream) {
    static int grid = 0;
    if (grid == 0) {
        if (n_in != 23 || out_size != NLAT * D || ws_size < WS_END) { fprintf(stderr, "kernel_launch: unexpected problem shape (n_in %d, out %d, ws %zu)\n", n_in, out_size, ws_size); grid = -1; return; }
        int dev = 0, cus = 0, per_cu = 0;
        (void)hipGetDevice(&dev); (void)hipDeviceGetAttribute(&cus, hipDeviceAttributeMultiprocessorCount, dev);
        if (hipFuncSetAttribute((const void*)fwd_kernel, hipFuncAttributeMaxDynamicSharedMemorySize, LDS_BYTES) != hipSuccess) { fprintf(stderr, "kernel_launch: hipFuncSetAttribute failed\n"); grid = -1; return; }
        (void)hipOccupancyMaxActiveBlocksPerMultiprocessor(&per_cu, (const void*)fwd_kernel, NTHR, LDS_BYTES);
        if (per_cu < 1) per_cu = 1;
        (void)hipGetLastError();
        grid = cus * per_cu;
    }
    if (grid < 0) return;
    Args a{};
    for (int i = 0; i < 23; ++i) a.in[i] = (const float*)d_in[i];
    a.out = (float*)d_out; a.ws = (unsigned char*)d_ws;
#if COOP
    a.ph_lo = 0; a.ph_hi = NPHASE;
    void* args[] = {&a};
    hipError_t e = hipLaunchCooperativeKernel((const void*)fwd_kernel, dim3(grid), dim3(NTHR), args, LDS_BYTES, stream);
    if (e != hipSuccess) fprintf(stderr, "cooperative launch failed: %s (grid %d)\n", hipGetErrorString(e), grid);
#else
    for (int p = 0; p < NPHASE; ++p) { a.ph_lo = p; a.ph_hi = p + 1; hipLaunchKernelGGL(fwd_kernel, dim3(grid), dim3(NTHR), LDS_BYTES, stream, a); }
#endif
}
```
